# Optimizing an MI355X kernel written in HIP

```python
import math
import jax, jax.numpy as jnp
from jax import lax
import numpy as np

D_MODEL = 1024
BATCH = 4
SEQ = 4096
DEPTH = 1

NORM_EPS = 1e-6
RW_HEADS = 8
RW_HEAD_DIM = 64
RW_WIDTH = RW_HEADS * RW_HEAD_DIM
DECAY_LORA = 64
AAA_LORA = 64
GATE_LORA = 160
RW_GN_EPS = 64e-5
RW_SHIFT_WIDTH = 3 * RW_WIDTH + DECAY_LORA + AAA_LORA + GATE_LORA
MLA_HEADS = 8
QK_NOPE = 64
QK_ROPE = 32
V_DIM = 64
Q_LORA = 384
KV_LORA = 256
ROPE_BASE = 10000.0
Q_BLOCK = 128
ATTN_SCALE = 1.0 / math.sqrt(QK_NOPE + QK_ROPE)
IN_WIDTH = RW_SHIFT_WIDTH + Q_LORA + KV_LORA + QK_ROPE + 2 * D_MODEL
PEER_HEADS = 8
N_KEYS = 128
N_EXPERTS = N_KEYS * N_KEYS
PEER_TOPK = 16
D_QUERY = 256
TOKEN_BLOCK = 128

kernel_name = "hybrid_rwkv7_mla_peer_block"


def rms_norm(x, w, eps=NORM_EPS):
    xf = x.astype(jnp.float32)
    y = xf * lax.rsqrt(jnp.mean(xf * xf, axis=-1, keepdims=True) + eps)
    return (y * w.astype(jnp.float32)).astype(x.dtype)


def apply_rope(x, pos):
    half = x.shape[-1] // 2
    inv_freq = ROPE_BASE ** (-jnp.arange(half, dtype=jnp.float32) / half)
    ang = pos.astype(jnp.float32)[..., None] * inv_freq
    ang = ang.reshape(ang.shape[:2] + (1,) * (x.ndim - 3) + (half,))
    cos, sin = jnp.cos(ang), jnp.sin(ang)
    xf = x.astype(jnp.float32)
    x1, x2 = xf[..., :half], xf[..., half:]
    return jnp.concatenate([x1 * cos - x2 * sin, x2 * cos + x1 * sin], axis=-1).astype(x.dtype)


def rwkv7_branch(p_rw, rw_mu, rw_w0, rw_w2, rw_a0, rw_a2, rw_g2, rw_k_k, rw_k_a, rw_r_k,
                 rw_ln_w, rw_ln_b, rw_w_o):
    B, S, _ = p_rw.shape
    p_prev = jnp.pad(p_rw, ((0, 0), (1, 0), (0, 0)))[:, :-1]
    p_mix = p_rw + rw_mu * (p_prev - p_rw)
    offs = np.cumsum([RW_WIDTH, RW_WIDTH, RW_WIDTH, DECAY_LORA, AAA_LORA]).tolist()
    r, k, v, wd, ad, gd = jnp.split(p_mix, offs, axis=-1)
    w = -jax.nn.softplus(-(rw_w0 + jnp.tanh(wd) @ rw_w2)) - 0.5
    decay = jnp.exp(-jnp.exp(w.astype(jnp.float32)))
    a = jax.nn.sigmoid(rw_a0 + ad @ rw_a2)
    g = jax.nn.sigmoid(gd) @ rw_g2
    kk = (k * rw_k_k).reshape(B, S, RW_HEADS, RW_HEAD_DIM).astype(jnp.float32)
    kk = kk / jnp.maximum(jnp.linalg.norm(kk, axis=-1, keepdims=True), 1e-12)
    k = k * (1.0 + (a - 1.0) * rw_k_a)
    hs = lambda t: t.reshape(B, S, RW_HEADS, RW_HEAD_DIM).astype(jnp.float32)
    r_h, k_h, v_h, a_h, w_h = hs(r), hs(k), hs(v), hs(a), hs(decay)

    def step(state, inp):
        r_t, w_t, k_t, v_t, kk_t, a_t = inp
        sa = jnp.einsum("bhvk,bhk->bhv", state, -kk_t)
        state = (state * w_t[:, :, None, :]
                 + sa[..., None] * (kk_t * a_t)[:, :, None, :]
                 + v_t[..., None] * k_t[:, :, None, :])
        return state, jnp.einsum("bhvk,bhk->bhv", state, r_t)

    xs = tuple(jnp.moveaxis(t, 1, 0) for t in (r_h, w_h, k_h, v_h, kk, a_h))
    s0 = jnp.zeros((B, RW_HEADS, RW_HEAD_DIM, RW_HEAD_DIM), jnp.float32)
    _, ys = lax.scan(step, s0, xs)
    y = jnp.moveaxis(ys, 0, 1)
    mu = jnp.mean(y, axis=-1, keepdims=True)
    var = jnp.mean(jnp.square(y - mu), axis=-1, keepdims=True)
    y = ((y - mu) * lax.rsqrt(var + RW_GN_EPS)).reshape(B, S, RW_WIDTH)
    y = y * rw_ln_w + rw_ln_b
    bonus = jnp.sum(r_h * k_h * rw_r_k.astype(jnp.float32), axis=-1, keepdims=True) * v_h
    y = (y + bonus.reshape(B, S, RW_WIDTH)).astype(p_rw.dtype) * g
    return y @ rw_w_o


def mla_branch(q_down, kv_down, k_pe_raw, positions, mla_q_norm_w, mla_w_uq, mla_kv_norm_w,
               mla_w_ukv, mla_qn_nope_w, mla_qn_pe_w, mla_kn_nope_w, mla_kn_pe_w, mla_w_o):
    B, S, _ = q_down.shape
    q = (rms_norm(q_down, mla_q_norm_w) @ mla_w_uq).reshape(B, S, MLA_HEADS, QK_NOPE + QK_ROPE)
    kv = (rms_norm(kv_down, mla_kv_norm_w) @ mla_w_ukv).reshape(B, S, MLA_HEADS, QK_NOPE + V_DIM)
    q_nope, q_pe = q[..., :QK_NOPE], q[..., QK_NOPE:]
    k_nope, v = kv[..., :QK_NOPE], kv[..., QK_NOPE:]
    q_nope = rms_norm(q_nope, mla_qn_nope_w)
    k_nope = rms_norm(k_nope, mla_kn_nope_w)
    q_pe = apply_rope(rms_norm(q_pe, mla_qn_pe_w), positions)
    k_pe = apply_rope(rms_norm(k_pe_raw, mla_kn_pe_w)[:, :, None, :], positions)
    q = jnp.concatenate([q_nope, q_pe], axis=-1)
    k = jnp.concatenate([k_nope, jnp.broadcast_to(k_pe, (B, S, MLA_HEADS, QK_ROPE))], axis=-1)
    nb = S // Q_BLOCK
    q_blocks = jnp.moveaxis(q.reshape(B, nb, Q_BLOCK, MLA_HEADS, QK_NOPE + QK_ROPE), 1, 0)
    k_pos = jnp.arange(S)

    def attend(args):
        q_blk, blk = args
        s = jnp.einsum("bqhd,bkhd->bhqk", q_blk, k).astype(jnp.float32) * ATTN_SCALE
        q_pos = blk * Q_BLOCK + jnp.arange(Q_BLOCK)
        s = jnp.where(k_pos[None, :] <= q_pos[:, None], s, jnp.finfo(jnp.float32).min)
        p = jax.nn.softmax(s, axis=-1).astype(v.dtype)
        return jnp.einsum("bhqk,bkhd->bqhd", p, v)

    o = lax.map(attend, (q_blocks, jnp.arange(nb)))
    o = jnp.moveaxis(o, 0, 1).reshape(B, S, MLA_HEADS * V_DIM)
    return o @ mla_w_o


def peer_ffn(hn, peer_w_query, peer_sub_keys, peer_u, peer_v):
    B, S, D = hn.shape
    T = B * S
    xt = hn.reshape(T, D)
    q = (xt @ peer_w_query).reshape(T, PEER_HEADS, 2, D_QUERY // 2)
    sc = jnp.einsum("thpd,hpnd->thpn", q, peer_sub_keys).astype(jnp.float32)
    s_top, i_top = lax.top_k(sc, PEER_TOPK)
    cand_s = (s_top[:, :, 0, :, None] + s_top[:, :, 1, None, :]).reshape(T, PEER_HEADS, PEER_TOPK * PEER_TOPK)
    cand_i = (i_top[:, :, 0, :, None] * N_KEYS + i_top[:, :, 1, None, :]).reshape(T, PEER_HEADS, PEER_TOPK * PEER_TOPK)
    best_s, best_pos = lax.top_k(cand_s, PEER_TOPK)
    expert_idx = jnp.take_along_axis(cand_i, best_pos, axis=-1)
    gates = jax.nn.softmax(best_s, axis=-1).astype(hn.dtype)
    nb = T // TOKEN_BLOCK
    xb = xt.reshape(nb, TOKEN_BLOCK, D)
    ib = expert_idx.reshape(nb, TOKEN_BLOCK, PEER_HEADS * PEER_TOPK)
    gb = gates.reshape(nb, TOKEN_BLOCK, PEER_HEADS * PEER_TOPK)

    def expert_block(args):
        x_blk, idx, g = args
        u = peer_u[idx]
        act = jax.nn.gelu(jnp.einsum("td,ted->te", x_blk, u), approximate=False)
        return jnp.einsum("te,ted->td", g * act, peer_v[idx])

    y = lax.map(expert_block, (xb, ib, gb))
    return y.reshape(B, S, D)


def setup_inputs(seed: int = 0) -> dict:
    key = jax.random.key(seed)
    ks = jax.random.split(key, 40)
    nrm = lambda i, shape, scale: jax.random.normal(ks[i], shape, jnp.float32) * scale
    gain = lambda i, n: 1.0 + 0.02 * jax.random.normal(ks[i], (n,), jnp.float32)
    return {
        "x": nrm(0, (BATCH, SEQ, D_MODEL), 1.0),
        "positions": (jnp.arange(SEQ, dtype=jnp.int32)[None, :]
                      + jax.random.randint(ks[1], (BATCH, 1), 0, 1024, jnp.int32)),
        "norm1_w": gain(2, D_MODEL),
        "w_in": nrm(3, (D_MODEL, IN_WIDTH), D_MODEL ** -0.5),
        "rw_mu": jax.random.uniform(ks[4], (RW_SHIFT_WIDTH,), jnp.float32),
        "rw_w0": jax.random.uniform(ks[5], (RW_WIDTH,), jnp.float32, -6.0, -1.0),
        "rw_w2": nrm(6, (DECAY_LORA, RW_WIDTH), 0.1),
        "rw_a0": nrm(7, (RW_WIDTH,), 0.1),
        "rw_a2": nrm(8, (AAA_LORA, RW_WIDTH), 0.1),
        "rw_g2": nrm(9, (GATE_LORA, RW_WIDTH), GATE_LORA ** -0.5),
        "rw_k_k": 0.85 + 0.05 * jax.random.normal(ks[10], (RW_WIDTH,), jnp.float32),
        "rw_k_a": 1.0 + 0.05 * jax.random.normal(ks[11], (RW_WIDTH,), jnp.float32),
        "rw_r_k": nrm(12, (RW_HEADS, RW_HEAD_DIM), 0.1),
        "rw_ln_w": gain(13, RW_WIDTH),
        "rw_ln_b": nrm(14, (RW_WIDTH,), 0.02),
        "rw_w_o": nrm(15, (RW_WIDTH, D_MODEL), RW_WIDTH ** -0.5),
        "mla_q_norm_w": gain(16, Q_LORA),
        "mla_w_uq": nrm(17, (Q_LORA, MLA_HEADS * (QK_NOPE + QK_ROPE)), Q_LORA ** -0.5),
        "mla_kv_norm_w": gain(18, KV_LORA),
        "mla_w_ukv": nrm(19, (KV_LORA, MLA_HEADS * (QK_NOPE + V_DIM)), KV_LORA ** -0.5),
        "mla_qn_nope_w": gain(20, QK_NOPE),
        "mla_qn_pe_w": gain(21, QK_ROPE),
        "mla_kn_nope_w": gain(22, QK_NOPE),
        "mla_kn_pe_w": gain(23, QK_ROPE),
        "mla_w_o": nrm(24, (MLA_HEADS * V_DIM, D_MODEL), (MLA_HEADS * V_DIM) ** -0.5),
        "w_out": nrm(25, (D_MODEL, D_MODEL), D_MODEL ** -0.5),
        "norm2_w": gain(26, D_MODEL),
        "peer_w_query": nrm(27, (D_MODEL, PEER_HEADS * D_QUERY), D_MODEL ** -0.5),
        "peer_sub_keys": nrm(28, (PEER_HEADS, 2, N_KEYS, D_QUERY // 2), (D_QUERY // 2) ** -0.5),
        "peer_u": nrm(29, (N_EXPERTS, D_MODEL), D_MODEL ** -0.5),
        "peer_v": nrm(30, (N_EXPERTS, D_MODEL), PEER_HEADS ** -0.5),
    }


def reference(x, positions, norm1_w, w_in, rw_mu, rw_w0, rw_w2, rw_a0, rw_a2, rw_g2, rw_k_k,
              rw_k_a, rw_r_k, rw_ln_w, rw_ln_b, rw_w_o, mla_q_norm_w, mla_w_uq, mla_kv_norm_w,
              mla_w_ukv, mla_qn_nope_w, mla_qn_pe_w, mla_kn_nope_w, mla_kn_pe_w, mla_w_o, w_out,
              norm2_w, peer_w_query, peer_sub_keys, peer_u, peer_v):
    h = x
    for _ in range(DEPTH):
        xn = rms_norm(h, norm1_w)
        p = xn @ w_in
        offs = np.cumsum([RW_SHIFT_WIDTH, Q_LORA, KV_LORA, QK_ROPE, D_MODEL]).tolist()
        p_rw, q_down, kv_down, k_pe_raw, g_a, g_b = jnp.split(p, offs, axis=-1)
        y_a = rwkv7_branch(p_rw, rw_mu, rw_w0, rw_w2, rw_a0, rw_a2, rw_g2, rw_k_k, rw_k_a,
                           rw_r_k, rw_ln_w, rw_ln_b, rw_w_o)
        y_b = mla_branch(q_down, kv_down, k_pe_raw, positions, mla_q_norm_w, mla_w_uq,
                         mla_kv_norm_w, mla_w_ukv, mla_qn_nope_w, mla_qn_pe_w, mla_kn_nope_w,
                         mla_kn_pe_w, mla_w_o)
        mixed = jax.nn.sigmoid(g_a) * y_a + jax.nn.sigmoid(g_b) * y_b
        h = h + mixed @ w_out
        h = h + peer_ffn(rms_norm(h, norm2_w), peer_w_query, peer_sub_keys, peer_u, peer_v)
    return h
```

```cpp
#include <hip/hip_runtime.h>
#include <hip/hip_cooperative_groups.h>
#include <cstdio>
#include <cstdint>
namespace cg = cooperative_groups;

#define DEVI __device__ __forceinline__
typedef unsigned short bf16_t;
typedef short bf16x8 __attribute__((ext_vector_type(8)));
typedef float f32x4 __attribute__((ext_vector_type(4)));
typedef float f32x16 __attribute__((ext_vector_type(16)));
typedef unsigned u32x2 __attribute__((ext_vector_type(2)));
typedef unsigned u32x4 __attribute__((ext_vector_type(4)));

constexpr int T = 16384, SEQ = 4096, DM = 1024;
constexpr int NWAVES = 8, NT = 512;
constexpr int LDS_BYTES = 147456;
constexpr float EPS = 1e-6f;
constexpr float LOG2E = 1.4426950408889634f;
constexpr float QSCALE = 0.10206207261596575f * 1.4426950408889634f;

constexpr size_t MiB = 1u << 20;
constexpr size_t WS_SS2 = 0;
constexpr size_t WS_CNT = 512 * 1024;
constexpr size_t WS_SSQ = 64 * 1024, WS_SSKV = 128 * 1024;
constexpr size_t WS_WIN = 1 * MiB;
constexpr size_t WS_WUQ = 10 * MiB + 512 * 1024;
constexpr size_t WS_WUKV = 11 * MiB + 256 * 1024;
constexpr size_t WS_RWO = 12 * MiB;
constexpr size_t WS_MWO = 13 * MiB;
constexpr size_t WS_WOUT = 14 * MiB;
constexpr size_t WS_PWQ = 16 * MiB;
constexpr size_t WS_SUBK = 20 * MiB;
constexpr size_t WS_W2T = 20 * MiB + 512 * 1024;
constexpr size_t WS_A2T = WS_W2T + 64 * 1024;
constexpr size_t WS_G2T = WS_A2T + 64 * 1024;
constexpr size_t WS_G = 24 * MiB;
constexpr size_t WS_UB = 56 * MiB, WS_VB = 72 * MiB;
constexpr size_t WS_SC = 176 * MiB;
constexpr size_t WS_PRW = 88 * MiB;
constexpr size_t WS_Q = 88 * MiB, WS_K = 112 * MiB, WS_VT = 136 * MiB;
constexpr size_t WS_HB = 88 * MiB;
constexpr size_t WS_QD = 152 * MiB, WS_KVD = 164 * MiB, WS_KPE = 172 * MiB;
constexpr size_t WS_O = 152 * MiB;
constexpr size_t WS_R = 176 * MiB, WS_W = 192 * MiB, WS_KS = 208 * MiB, WS_V = 224 * MiB, WS_KK = 240 * MiB;
constexpr size_t WS_YA = 176 * MiB;
constexpr size_t WS_MIXED = 192 * MiB;
constexpr size_t WS_PQ = 184 * MiB;
constexpr size_t WS_TAB = 240 * MiB;
constexpr size_t DO_XN = 0;
constexpr size_t DO_BV = 0, DO_GT = 16 * MiB, DO_BONUS = 32 * MiB, DO_Y = 33 * MiB, DO_KRAW = 33 * MiB, DO_GL = 50 * MiB;

struct Params {
    const float* in[31];
    float* out;
    unsigned char* ws;
};

DEVI unsigned f2bf(float f) { unsigned u = __float_as_uint(f); return (u + 0x7fffu + ((u >> 16) & 1u)) >> 16; }
typedef float f32x2_t __attribute__((ext_vector_type(2)));
typedef __bf16 bf16x2_t __attribute__((ext_vector_type(2)));
DEVI unsigned pk2(float lo, float hi) { f32x2_t v = {lo, hi}; bf16x2_t b = __builtin_convertvector(v, bf16x2_t); return __builtin_bit_cast(unsigned, b); }
DEVI float bflo(unsigned u) { return __uint_as_float(u << 16); }
DEVI float bfhi(unsigned u) { return __uint_as_float(u & 0xffff0000u); }
DEVI float bf1(bf16_t u) { return __uint_as_float(((unsigned)u) << 16); }
DEVI float wave_sum(float v) {
#pragma unroll
    for (int o = 32; o >= 1; o >>= 1) v += __shfl_xor(v, o);
    return v;
}
DEVI float sigmoidf_(float x) { return __builtin_amdgcn_rcpf(1.f + __builtin_amdgcn_exp2f(-1.4426950408889634f * x)); }
DEVI float tanhf_(float x) { return 1.f - 2.f * __builtin_amdgcn_rcpf(__builtin_amdgcn_exp2f(2.885390081777927f * x) + 1.f); }
DEVI void st_bf4(bf16_t* p, float a, float b, float c, float d) { u32x2 w; w.x = pk2(a, b); w.y = pk2(c, d); *(u32x2*)p = w; }
DEVI void ld_bf4(const bf16_t* p, float (&o)[4]) { u32x2 w = *(const u32x2*)p; o[0] = bflo(w.x); o[1] = bfhi(w.x); o[2] = bflo(w.y); o[3] = bfhi(w.y); }
DEVI void ld_bf8(const bf16_t* p, float (&o)[8]) { u32x4 w = *(const u32x4*)p; o[0] = bflo(w.x); o[1] = bfhi(w.x); o[2] = bflo(w.y); o[3] = bfhi(w.y); o[4] = bflo(w.z); o[5] = bfhi(w.z); o[6] = bflo(w.w); o[7] = bfhi(w.w); }
DEVI bf16x8 pack8(const float (&v)[8]) { u32x4 w; w.x = pk2(v[0], v[1]); w.y = pk2(v[2], v[3]); w.z = pk2(v[4], v[5]); w.w = pk2(v[6], v[7]); return __builtin_bit_cast(bf16x8, w); }
DEVI f32x4 mfma16(bf16x8 a, bf16x8 b, f32x4 c) { return __builtin_amdgcn_mfma_f32_16x16x32_bf16(a, b, c, 0, 0, 0); }
DEVI f32x16 mfma32(bf16x8 a, bf16x8 b, f32x16 c) { return __builtin_amdgcn_mfma_f32_32x32x16_bf16(a, b, c, 0, 0, 0); }
DEVI int crow(int r, int hi) { return (r & 3) + 8 * (r >> 2) + 4 * hi; }


template <int CTRL> DEVI float dpp_f(float v) { return __builtin_bit_cast(float, __builtin_amdgcn_update_dpp(0, __builtin_bit_cast(int, v), CTRL, 0xf, 0xf, true)); }
template <int CTRL> DEVI unsigned dpp_u(unsigned v) { return (unsigned)__builtin_amdgcn_update_dpp(0, (int)v, CTRL, 0xf, 0xf, true); }
DEVI float sum8(float v) { v += dpp_f<0xB1>(v); v += dpp_f<0x4E>(v); v += dpp_f<0x141>(v); return v; }
DEVI float sum16(float v) { v = sum8(v); v += dpp_f<0x140>(v); return v; }
DEVI unsigned umax2(unsigned a, unsigned b) { return a > b ? a : b; }
DEVI unsigned umax16(unsigned v) { v = umax2(v, dpp_u<0xB1>(v)); v = umax2(v, dpp_u<0x4E>(v)); v = umax2(v, dpp_u<0x141>(v)); v = umax2(v, dpp_u<0x140>(v)); return v; }
DEVI unsigned rdlane(unsigned v, int l) { return (unsigned)__builtin_amdgcn_readlane((int)v, l); }
#define LAS __attribute__((address_space(3)))

DEVI unsigned pk4_fp8(float a, float b, float c, float d) { int w = 0; w = __builtin_amdgcn_cvt_pk_fp8_f32(a, b, w, false); w = __builtin_amdgcn_cvt_pk_fp8_f32(c, d, w, true); return (unsigned)w; }
DEVI f32x4 mfma16_fp8(u32x2 a, u32x2 b, f32x4 c) { return __builtin_amdgcn_mfma_f32_16x16x32_fp8_fp8(__builtin_bit_cast(long, a), __builtin_bit_cast(long, b), c, 0, 0, 0); }
DEVI unsigned pk4_u8(float a, float b, float c, float d) { unsigned w = 0; w = __builtin_amdgcn_cvt_pk_u8_f32(a, 0, w); w = __builtin_amdgcn_cvt_pk_u8_f32(b, 1, w); w = __builtin_amdgcn_cvt_pk_u8_f32(c, 2, w); w = __builtin_amdgcn_cvt_pk_u8_f32(d, 3, w); return w; }
constexpr float U8_SCALE = 32.f, V8_SCALE = 4.f;

template <int OFF> DEVI f32x4 lds_rd128(unsigned a) { f32x4 r; asm volatile("ds_read_b128 %0, %1 offset:%2" : "=v"(r) : "v"(a), "i"(OFF)); return r; }
template <int OFF> DEVI float lds_rd32(unsigned a) { float r; asm volatile("ds_read_b32 %0, %1 offset:%2" : "=v"(r) : "v"(a), "i"(OFF)); return r; }
DEVI void lds_wr32(unsigned a, float v) { asm volatile("ds_write_b32 %0, %1" ::"v"(a), "v"(v) : "memory"); }

#define SW64(r, k) ((r) * 64 + (((((k) >> 3) ^ ((r) & 7))) << 3) + ((k) & 7))
#define SW32(r, c) ((r) * 32 + (((((c) >> 3) ^ (((r) >> 2) & 3))) << 3) + ((c) & 7))
DEVI int swz_off(int r, int chunk, int ld) { return ld == 64 ? r * 64 + ((chunk ^ (r & 7)) << 3) : r * 32 + ((chunk ^ ((r >> 2) & 3)) << 3); }
template <int MT, int NTL, int KS>
DEVI void gemm_lds(const LAS bf16_t* A, int lda, const LAS bf16_t* B, int ldb, f32x4 (&acc)[MT][NTL], int fr, int fq) {
#pragma unroll
    for (int ks = 0; ks < KS; ++ks) {
        bf16x8 a[MT], b[NTL];
#pragma unroll
        for (int m = 0; m < MT; ++m) a[m] = *(const LAS bf16x8*)(A + swz_off(16 * m + fr, 4 * ks + fq, lda));
#pragma unroll
        for (int n = 0; n < NTL; ++n) b[n] = *(const LAS bf16x8*)(B + swz_off(16 * n + fr, 4 * ks + fq, ldb));
#pragma unroll
        for (int m = 0; m < MT; ++m)
#pragma unroll
            for (int n = 0; n < NTL; ++n) acc[m][n] = mfma16(b[n], a[m], acc[m][n]);
    }
}
DEVI bf16_t bf1of(float x) { return (bf16_t)(pk2(x, x) & 0xffffu); }
DEVI void gemm_tile_acc(const bf16_t* __restrict__ A, int lda, const bf16_t* __restrict__ Bt, int ldb, int K, int m0, int n0, int lane, f32x4 (&acc)[4][4]) {
    const int fr = lane & 15, fq = lane >> 4;
    const bf16_t* ap = A + (size_t)(m0 + fr) * lda + fq * 8;
    const bf16_t* bp = Bt + (size_t)(n0 + fr) * ldb + fq * 8;
#pragma unroll 2
    for (int k0 = 0; k0 < K; k0 += 32) {
        bf16x8 a[4], b[4];
#pragma unroll
        for (int m = 0; m < 4; ++m) a[m] = *(const bf16x8*)(ap + (size_t)m * 16 * lda + k0);
#pragma unroll
        for (int n = 0; n < 4; ++n) b[n] = *(const bf16x8*)(bp + (size_t)n * 16 * ldb + k0);
#pragma unroll
        for (int m = 0; m < 4; ++m)
#pragma unroll
            for (int n = 0; n < 4; ++n) acc[m][n] = mfma16(b[n], a[m], acc[m][n]);
    }
}
DEVI void zero_acc(f32x4 (&acc)[4][4]) {
#pragma unroll
    for (int m = 0; m < 4; ++m)
#pragma unroll
        for (int n = 0; n < 4; ++n) acc[m][n] = (f32x4){0.f, 0.f, 0.f, 0.f};
}


namespace pg8 {
#define PG8_LAS __attribute__((address_space(3)))
typedef unsigned short bf16_t;
typedef short bf16x8 __attribute__((ext_vector_type(8)));
typedef float f32x4 __attribute__((ext_vector_type(4)));
typedef unsigned u32x4 __attribute__((ext_vector_type(4)));
constexpr int BM = 256, BK = 64, HALF = 128, HTB = HALF * BK * 2  , STAGE_BYTES = 8 * HTB, NXCD = 8, WGM = 8;

__host__ __device__ __forceinline__ int lds_byte(int r, int c) { const int st = (r >> 4) * 2 + (c >> 5), rr = r & 15, cc = c & 31, ob = rr * 64 + cc * 2; return st * 1024 + (ob ^ (((ob >> 9) & 1) << 5)); }
__host__ __device__ __forceinline__ void stage_rc(int b, int& R, int& C) { const int st = b / 1024, sb = b % 1024, swz = sb ^ (((sb >> 9) & 1) << 5); R = (st >> 1) * 16 + swz / 64; C = (st & 1) * 32 + (swz % 64) / 2; }
__host__ __device__ __forceinline__ int perm32(int rho) { const int n = rho >> 4, i = rho & 15; return 8 * (i >> 2) + 4 * n + (i & 3); }

struct Unit { int pm, pn; };
struct Gemm { const bf16_t* A; const bf16_t* Bt; int M, N, K; };

struct StaticOrder {
    int nM, nN, nwg, G, c;
    __host__ __device__ void init(int M, int N, int G_, int c_) { nM = M / BM; nN = N / BM; nwg = nM * nN; G = G_; c = c_; }
    __host__ __device__ bool next(int i, Unit& u) const {
        const long L = (long)i * G + c; if (L >= nwg) return false;
        int wgid = (int)L; { const int q = nwg / NXCD, r = nwg % NXCD, xcd = wgid % NXCD, off = wgid / NXCD; wgid = (xcd < r ? xcd * (q + 1) : r * (q + 1) + (xcd - r) * q) + off; }
        const int nig = WGM * nN, gid = wgid / nig, fm = gid * WGM, gsz = (nM - fm) < WGM ? (nM - fm) : WGM;
        u.pm = fm + ((wgid % nig) % gsz); u.pn = (wgid % nig) / gsz; return true;
    }
    __device__ __forceinline__ void a_ready(const Unit&) const {}
    __device__ __forceinline__ void done(const Unit&) const {}
};


DEVI float sigm(float x) { return __builtin_amdgcn_rcpf(1.f + __builtin_amdgcn_exp2f(-1.4426950408889634f * x)); }
DEVI u32x4 pack8v(f32x4 a, f32x4 b) { u32x4 w; w.x = pk2(a[0], a[1]); w.y = pk2(a[2], a[3]); w.z = pk2(b[0], b[1]); w.w = pk2(b[2], b[3]); return w; }
struct EpiP1 {
    static constexpr bool PERM = true, AFTER_DRAIN = false;
    unsigned char* ws;
    __device__ __forceinline__ void operator()(const f32x4 (&acc)[2][2][4][2], const Unit& u, int wr, int wc, int fr_in, int fq_in) const {
        int fr = fr_in, fq = fq_in; asm volatile("" : "+v"(fr), "+v"(fq));
        const int row0 = u.pm * BM + wr * 64 + fr;
        if (u.pn >= 8 && u.pn < 11) {
#pragma unroll
            for (int bj = 0; bj < 2; ++bj) {
                const int c = (u.pn - 8) * 256 + bj * HALF + wc * 32 + 8 * fq;
                const size_t off = c < 384 ? WS_QD : (c < 640 ? WS_KVD : WS_KPE);
                const int ld = c < 384 ? 384 : (c < 640 ? 256 : 32), cc = c < 384 ? c : (c < 640 ? c - 384 : c - 640);
                if (c < 672) {
#pragma unroll
                    for (int ai = 0; ai < 2; ++ai)
#pragma unroll
                        for (int m = 0; m < 4; ++m) { const size_t row = (size_t)(row0 + ai * HALF + m * 16);
                            *(u32x4*)(ws + off + (row * ld + cc) * 2) = pack8v(acc[ai][bj][m][0], acc[ai][bj][m][1]); }
                }
            }
            return;
        }
        if (u.pn >= 11) {
            const int col0 = (u.pn - 11) * 256 + wc * 32 + 8 * fq;
#pragma unroll
            for (int ai = 0; ai < 2; ++ai)
#pragma unroll
                for (int m = 0; m < 4; ++m) { unsigned char* rowp = ws + WS_G + ((size_t)(row0 + ai * HALF + m * 16) * 2048 + col0);
#pragma unroll
                    for (int bj = 0; bj < 2; ++bj) { const f32x4 v0 = acc[ai][bj][m][0], v1 = acc[ai][bj][m][1];
                        u32x2 w; w.x = pk4_u8(sigm(v0[0]) * 255.f, sigm(v0[1]) * 255.f, sigm(v0[2]) * 255.f, sigm(v0[3]) * 255.f);
                        w.y = pk4_u8(sigm(v1[0]) * 255.f, sigm(v1[1]) * 255.f, sigm(v1[2]) * 255.f, sigm(v1[3]) * 255.f);
                        *(u32x2*)(rowp + bj * HALF) = w; } }
            return;
        }
        const int col0 = u.pn * 256 + wc * 32 + 8 * fq;
#pragma unroll
        for (int ai = 0; ai < 2; ++ai)
#pragma unroll
            for (int m = 0; m < 4; ++m) { unsigned char* rowp = ws + WS_PRW + ((size_t)(row0 + ai * HALF + m * 16) * 2048 + col0) * 2;
#pragma unroll
                for (int bj = 0; bj < 2; ++bj) *(u32x4*)(rowp + bj * HALF * 2) = pack8v(acc[ai][bj][m][0], acc[ai][bj][m][1]); }
    }
};
struct EpiQraw {
    static constexpr bool PERM = true, AFTER_DRAIN = false;
    bf16_t* q; const float* ssq;
    __device__ __forceinline__ void operator()(const f32x4 (&acc)[2][2][4][2], const Unit& u, int wr, int wc, int fr_in, int fq_in) const {
        int fr = fr_in, fq = fq_in; asm volatile("" : "+v"(fr), "+v"(fq));
        const int row0 = u.pm * BM + wr * 64 + fr, col0 = u.pn * BM + wc * 32 + 8 * fq;
#pragma unroll
        for (int ai = 0; ai < 2; ++ai)
#pragma unroll
            for (int m = 0; m < 4; ++m) { const size_t row = (size_t)(row0 + ai * HALF + m * 16); const float rs = ssq[row];
#pragma unroll
                for (int bj = 0; bj < 2; ++bj) *(u32x4*)(q + row * 768 + col0 + bj * HALF) = pack8v(acc[ai][bj][m][0] * rs, acc[ai][bj][m][1] * rs); }
    }
};
struct EpiKVraw {
    static constexpr bool PERM = true, AFTER_DRAIN = false;
    bf16_t* kraw; bf16_t* vt; const float* sskv;
    __device__ __forceinline__ void operator()(const f32x4 (&acc)[2][2][4][2], const Unit& u, int wr, int wc, int fr_in, int fq_in) const {
        int fr = fr_in, fq = fq_in; asm volatile("" : "+v"(fr), "+v"(fq));
        const int row0 = u.pm * BM + wr * 64 + fr;
#pragma unroll
        for (int ai = 0; ai < 2; ++ai)
#pragma unroll
            for (int m = 0; m < 4; ++m) { const int row = row0 + ai * HALF + m * 16; const float rs = sskv[row];
#pragma unroll
                for (int bj = 0; bj < 2; ++bj) { const f32x4 v0 = acc[ai][bj][m][0] * rs, v1 = acc[ai][bj][m][1] * rs;
                    if (u.pn < 2) *(u32x4*)(kraw + (size_t)row * 512 + u.pn * BM + bj * HALF + wc * 32 + 8 * fq) = pack8v(v0, v1);
                    else { const int c = (u.pn - 2) * BM + bj * HALF + wc * 32 + 8 * fq, h = c >> 6, d = c & 63; const int bb = row >> 12, s = row & 4095;
                        const int kt = s >> 5, k4 = s & 15, jj = 4 * (k4 >> 3) + (k4 & 3), hv = (k4 >> 2) & 1;
                        bf16_t* vp = vt + ((((size_t)(bb * 8 + h) * 128 + kt) * 2 + (d >> 5)) * 2 + ((s >> 4) & 1)) * 512 + ((d & 31) + 32 * hv) * 8 + jj; const u32x4 w = pack8v(v0, v1);
                        vp[0] = (bf16_t)(w.x & 0xffffu); vp[8] = (bf16_t)(w.x >> 16); vp[16] = (bf16_t)(w.y & 0xffffu); vp[24] = (bf16_t)(w.y >> 16);
                        vp[32] = (bf16_t)(w.z & 0xffffu); vp[40] = (bf16_t)(w.z >> 16); vp[48] = (bf16_t)(w.w & 0xffffu); vp[56] = (bf16_t)(w.w >> 16); } } }
    }
};
struct EpiGate {
    static constexpr bool PERM = true, AFTER_DRAIN = false;
    bf16_t* mixed; const unsigned char* gg; int goff; int add;
    __device__ __forceinline__ void operator()(const f32x4 (&acc)[2][2][4][2], const Unit& u, int wr, int wc, int fr_in, int fq_in) const {
        int fr = fr_in, fq = fq_in; asm volatile("" : "+v"(fr), "+v"(fq));
        const int row0 = u.pm * BM + wr * 64 + fr, col0 = u.pn * BM + wc * 32 + 8 * fq;
#pragma unroll
        for (int ai = 0; ai < 2; ++ai)
#pragma unroll
            for (int m = 0; m < 4; ++m) { const size_t row = (size_t)(row0 + ai * HALF + m * 16);
#pragma unroll
                for (int bj = 0; bj < 2; ++bj) { const int col = col0 + bj * HALF;
                    const u32x2 gw = *(const u32x2*)(gg + row * 2048 + goff + col);
                    const f32x4 g0 = (f32x4){(float)(gw.x & 0xffu), (float)((gw.x >> 8) & 0xffu), (float)((gw.x >> 16) & 0xffu), (float)(gw.x >> 24)};
                    const f32x4 g1 = (f32x4){(float)(gw.y & 0xffu), (float)((gw.y >> 8) & 0xffu), (float)((gw.y >> 16) & 0xffu), (float)(gw.y >> 24)};
                    f32x4 v0 = g0 * (acc[ai][bj][m][0] * (1.f / 255.f)), v1 = g1 * (acc[ai][bj][m][1] * (1.f / 255.f));
                    if (add) { const u32x4 pw = *(const u32x4*)(mixed + row * 1024 + col);
                        v0 += (f32x4){__uint_as_float(pw.x << 16), __uint_as_float(pw.x & 0xffff0000u), __uint_as_float(pw.y << 16), __uint_as_float(pw.y & 0xffff0000u)};
                        v1 += (f32x4){__uint_as_float(pw.z << 16), __uint_as_float(pw.z & 0xffff0000u), __uint_as_float(pw.w << 16), __uint_as_float(pw.w & 0xffff0000u)}; }
                    *(u32x4*)(mixed + row * 1024 + col) = pack8v(v0, v1); } }
    }
};
struct EpiRes {
    static constexpr bool PERM = true, AFTER_DRAIN = false;
    const float* x; float* out; bf16_t* hb; float* ss2;
    __device__ __forceinline__ void operator()(const f32x4 (&acc)[2][2][4][2], const Unit& u, int wr, int wc, int fr_in, int fq_in) const {
        int fr = fr_in, fq = fq_in; asm volatile("" : "+v"(fr), "+v"(fq));
        const int row0 = u.pm * BM + wr * 64 + fr, col0 = u.pn * BM + wc * 32 + 8 * fq;
#pragma unroll
        for (int ai = 0; ai < 2; ++ai)
#pragma unroll
            for (int m = 0; m < 4; ++m) { const size_t row = (size_t)(row0 + ai * HALF + m * 16); float sq = 0.f;
#pragma unroll
                for (int bj = 0; bj < 2; ++bj) { const size_t o = row * 1024 + col0 + bj * HALF;
                    const f32x4 h0 = *(const f32x4*)(x + o) + acc[ai][bj][m][0], h1 = *(const f32x4*)(x + o + 4) + acc[ai][bj][m][1];
                    *(f32x4*)(out + o) = h0; *(f32x4*)(out + o + 4) = h1; *(u32x4*)(hb + o) = pack8v(h0, h1);
                    sq += (h0[0] * h0[0] + h0[1] * h0[1]) + (h0[2] * h0[2] + h0[3] * h0[3]) + (h1[0] * h1[0] + h1[1] * h1[1]) + (h1[2] * h1[2] + h1[3] * h1[3]); }
                sq += __shfl_xor(sq, 16); sq += __shfl_xor(sq, 32);
                if (fq == 0) atomicAdd(ss2 + row, sq); }
    }
};
struct EpiScale {
    static constexpr bool PERM = true, AFTER_DRAIN = false;
    bf16_t* pq; const float* ss2;
    __device__ __forceinline__ void operator()(const f32x4 (&acc)[2][2][4][2], const Unit& u, int wr, int wc, int fr_in, int fq_in) const {
        int fr = fr_in, fq = fq_in; asm volatile("" : "+v"(fr), "+v"(fq));
        const int row0 = u.pm * BM + wr * 64 + fr, col0 = u.pn * BM + wc * 32 + 8 * fq;
#pragma unroll
        for (int ai = 0; ai < 2; ++ai)
#pragma unroll
            for (int m = 0; m < 4; ++m) { const size_t row = (size_t)(row0 + ai * HALF + m * 16); const float rs = rsqrtf(ss2[row] * (1.f / 1024.f) + 1e-6f);
#pragma unroll
                for (int bj = 0; bj < 2; ++bj) *(u32x4*)(pq + row * 2048 + col0 + bj * HALF) = pack8v(acc[ai][bj][m][0] * rs, acc[ai][bj][m][1] * rs); }
    }
};
template <class Epi, class Sched, bool ALIGN_EPI = false, bool SP2 = false>
__device__ __forceinline__ void gemm_phase(PG8_LAS unsigned char* lds, const Gemm g, const Sched& S, const Epi& E) {
    int tid_l = threadIdx.x; asm volatile("" : "+v"(tid_l));
    const int tid = tid_l, wid = __builtin_amdgcn_readfirstlane(tid >> 6), lane = tid & 63, wr = wid >> 2, wc = wid & 3, fr = lane & 15, fq = lane >> 4;
    const int K = g.K, nt = K / BK;
    unsigned voffA[2], voffB[2];
#pragma unroll
    for (int i = 0; i < 2; ++i) { int R, C; stage_rc(tid * 16 + i * 8192, R, C); const int Rb = Epi::PERM ? ((R & ~31) + perm32(R & 31)) : R;
        voffA[i] = (unsigned)(R * K + C) * 2u; voffB[i] = (unsigned)(Rb * K + C) * 2u; }
    const size_t kstep = (size_t)(BK * 2);
    const size_t hstep = (size_t)HALF * K * 2;
    const size_t tstep = 2 * hstep;
    const unsigned ldsw = (unsigned)wid * 1024u;
    const int aoff = lds_byte(wr * 64 + fr, fq * 8), boff = lds_byte(wc * 32 + fr, fq * 8);
#define PG8_SA(b, h) (((b) * 2 + (h)) * HTB)
#define PG8_SB(b, h) ((4 + (b) * 2 + (h)) * HTB)
#define PG8_STAGE(bufoff, gbase, voff) do { _Pragma("unroll") for (int _i = 0; _i < 2; ++_i) \
        __builtin_amdgcn_global_load_lds((const unsigned*)((const char*)(gbase) + (voff)[_i]), (PG8_LAS unsigned*)(lds + (bufoff) + ldsw + _i * 8192), 16, 0, 0); } while (0)
#define PG8_LDA(dst, b, h) do { _Pragma("unroll") for (int m = 0; m < 4; ++m) _Pragma("unroll") for (int k = 0; k < 2; ++k) dst[m][k] = *(const PG8_LAS bf16x8*)(lds + PG8_SA(b, h) + aoff + m * 2048 + k * 1024); } while (0)
#define PG8_LDB(dst, b, h) do { _Pragma("unroll") for (int n = 0; n < 2; ++n) _Pragma("unroll") for (int k = 0; k < 2; ++k) dst[n][k] = *(const PG8_LAS bf16x8*)(lds + PG8_SB(b, h) + boff + n * 2048 + k * 1024); } while (0)
#define PG8_MMA(ai, bj, At, Bt) do { __builtin_amdgcn_s_setprio(1); _Pragma("unroll") for (int m = 0; m < 4; ++m) _Pragma("unroll") for (int n = 0; n < 2; ++n) _Pragma("unroll") for (int k = 0; k < 2; ++k) \
        acc[ai][bj][m][n] = __builtin_amdgcn_mfma_f32_16x16x32_bf16(Bt[n][k], At[m][k], acc[ai][bj][m][n], 0, 0, 0); __builtin_amdgcn_s_setprio(0); } while (0)
#define PG8_WAIT_V(n) asm volatile("s_waitcnt vmcnt(" #n ")" ::: "memory")
#define PG8_WAIT_L(n) asm volatile("s_waitcnt lgkmcnt(" #n ")" ::: "memory")
#define PG8_BAR __builtin_amdgcn_s_barrier()
#define PG8_SCHED __builtin_amdgcn_sched_barrier(0)
    Unit cur, nxt; int ui = 0;
    if (!S.next(0, cur)) return;
    f32x4 acc[2][2][4][2];
#pragma unroll
    for (int a = 0; a < 2; ++a)
#pragma unroll
        for (int b = 0; b < 2; ++b)
#pragma unroll
            for (int m = 0; m < 4; ++m)
#pragma unroll
                for (int n = 0; n < 2; ++n) acc[a][b][m][n] = (f32x4){0.f, 0.f, 0.f, 0.f};
    bf16x8 At[4][2], B0[2][2], B1[2][2];
    const char* cA = (const char*)g.A + (size_t)cur.pm * tstep; const char* cB = (const char*)g.Bt + (size_t)cur.pn * tstep;
    S.a_ready(cur);
    if constexpr (SP2) {
        PG8_STAGE(PG8_SB(0, 0), cB, voffB); PG8_STAGE(PG8_SB(0, 1), cB + hstep, voffB); PG8_STAGE(PG8_SA(0, 0), cA, voffA); PG8_STAGE(PG8_SA(0, 1), cA + hstep, voffA);
        if (wr == 1) PG8_BAR;
        PG8_WAIT_V(2); PG8_BAR;
        PG8_STAGE(PG8_SB(1, 0), cB + kstep, voffB); PG8_STAGE(PG8_SA(1, 0), cA + kstep, voffA); PG8_STAGE(PG8_SB(1, 1), cB + hstep + kstep, voffB);
        PG8_WAIT_V(6); PG8_BAR;
    } else {
        PG8_STAGE(PG8_SB(0, 0), cB, voffB); PG8_STAGE(PG8_SA(0, 0), cA, voffA); PG8_STAGE(PG8_SB(0, 1), cB + hstep, voffB); PG8_STAGE(PG8_SA(0, 1), cA + hstep, voffA);
        if (wr == 1) PG8_BAR;
        PG8_WAIT_V(4); PG8_BAR;
        PG8_STAGE(PG8_SB(1, 0), cB + kstep, voffB); PG8_STAGE(PG8_SA(1, 0), cA + kstep, voffA); PG8_STAGE(PG8_SB(1, 1), cB + hstep + kstep, voffB);
        PG8_WAIT_V(6); PG8_BAR;
    }
    for (;;) {
        const bool has_next = S.next(ui + 1, nxt);
        const char* nA = has_next ? (const char*)g.A + (size_t)nxt.pm * tstep : cA; const char* nB = has_next ? (const char*)g.Bt + (size_t)nxt.pn * tstep : cB;
        for (int t = 0; t < nt; t += 2) {
            const bool last = (t == nt - 2);
            const char* a1 = cA + (size_t)(t + 1) * kstep;
            const char* a2 = last ? nA : cA + (size_t)(t + 2) * kstep; const char* b2 = last ? nB : cB + (size_t)(t + 2) * kstep;
            const char* a3 = a2 + kstep; const char* b3 = b2 + kstep;
            if (last && has_next) S.a_ready(nxt);
            if constexpr (SP2) {
            PG8_LDB(B0, 0, 0); PG8_LDB(B1, 0, 1); PG8_SCHED; PG8_LDA(At, 0, 0); PG8_STAGE(PG8_SA(1, 1), a1 + hstep, voffA);
            PG8_WAIT_V(8); PG8_WAIT_L(0); PG8_BAR; PG8_MMA(0, 0, At, B0); PG8_MMA(0, 1, At, B1); PG8_BAR; PG8_SCHED;
            PG8_LDA(At, 0, 1); PG8_STAGE(PG8_SB(0, 0), b2, voffB); PG8_STAGE(PG8_SB(0, 1), b2 + hstep, voffB); PG8_STAGE(PG8_SA(0, 0), a2, voffA);
            PG8_WAIT_V(8); PG8_WAIT_L(0); PG8_BAR; PG8_MMA(1, 0, At, B0); PG8_MMA(1, 1, At, B1); PG8_BAR; PG8_SCHED;
            PG8_LDB(B0, 1, 0); PG8_LDB(B1, 1, 1); PG8_SCHED; PG8_LDA(At, 1, 0); PG8_STAGE(PG8_SA(0, 1), a2 + hstep, voffA);
            PG8_WAIT_V(8); PG8_WAIT_L(0); PG8_BAR; PG8_MMA(0, 0, At, B0); PG8_MMA(0, 1, At, B1); PG8_BAR; PG8_SCHED;
            PG8_LDA(At, 1, 1); PG8_STAGE(PG8_SB(1, 0), b3, voffB); PG8_STAGE(PG8_SB(1, 1), b3 + hstep, voffB); PG8_STAGE(PG8_SA(1, 0), a3, voffA);
            PG8_WAIT_V(8); PG8_WAIT_L(0); PG8_BAR; PG8_MMA(1, 0, At, B0); PG8_MMA(1, 1, At, B1); PG8_BAR; PG8_SCHED;
            } else {
            PG8_LDB(B0, 0, 0); PG8_SCHED; PG8_LDA(At, 0, 0); PG8_STAGE(PG8_SA(1, 1), a1 + hstep, voffA);
            PG8_WAIT_L(8); PG8_BAR; PG8_WAIT_L(0); PG8_MMA(0, 0, At, B0); PG8_BAR; PG8_SCHED;
            PG8_LDB(B1, 0, 1); PG8_STAGE(PG8_SB(0, 0), b2, voffB);
            PG8_BAR; PG8_WAIT_L(0); PG8_MMA(0, 1, At, B1); PG8_BAR;
            PG8_LDA(At, 0, 1); PG8_STAGE(PG8_SA(0, 0), a2, voffA);
            PG8_BAR; PG8_WAIT_L(0); PG8_MMA(1, 0, At, B0); PG8_BAR; PG8_SCHED;
            PG8_STAGE(PG8_SB(0, 1), b2 + hstep, voffB);
            PG8_WAIT_V(6); PG8_BAR; PG8_MMA(1, 1, At, B1); PG8_BAR;
            PG8_LDB(B0, 1, 0); PG8_SCHED; PG8_LDA(At, 1, 0); PG8_STAGE(PG8_SA(0, 1), a2 + hstep, voffA);
            PG8_WAIT_L(8); PG8_BAR; PG8_WAIT_L(0); PG8_MMA(0, 0, At, B0); PG8_BAR; PG8_SCHED;
            PG8_LDB(B1, 1, 1); PG8_STAGE(PG8_SB(1, 0), b3, voffB);
            PG8_BAR; PG8_WAIT_L(0); PG8_MMA(0, 1, At, B1); PG8_BAR;
            PG8_LDA(At, 1, 1); PG8_STAGE(PG8_SA(1, 0), a3, voffA);
            PG8_BAR; PG8_WAIT_L(0); PG8_MMA(1, 0, At, B0); PG8_BAR; PG8_SCHED;
            PG8_STAGE(PG8_SB(1, 1), b3 + hstep, voffB);
            PG8_WAIT_V(6); PG8_BAR; PG8_MMA(1, 1, At, B1); PG8_BAR;
            }
        }
        if constexpr (ALIGN_EPI) { if (wr == 0) PG8_BAR; }
        if constexpr (!Epi::AFTER_DRAIN) { E(acc, cur, wr, wc, fr, fq); S.done(cur); }
        if (!has_next) break;
#pragma unroll
        for (int a = 0; a < 2; ++a)
#pragma unroll
            for (int b = 0; b < 2; ++b)
#pragma unroll
                for (int m = 0; m < 4; ++m)
#pragma unroll
                    for (int n = 0; n < 2; ++n) acc[a][b][m][n] = (f32x4){0.f, 0.f, 0.f, 0.f};
        cur = nxt; cA = nA; cB = nB; ++ui;
        if constexpr (ALIGN_EPI) { if (wr == 1) PG8_BAR; }
    }
    PG8_WAIT_V(0);
    if constexpr (!ALIGN_EPI) { if (wr == 0) PG8_BAR; }
    PG8_BAR;
    if constexpr (Epi::AFTER_DRAIN) { E.fused(acc, cur, wr, wc, fr, fq, lds, wid, lane); S.done(cur); }
#undef PG8_SA
#undef PG8_SB
#undef PG8_STAGE
#undef PG8_LDA
#undef PG8_LDB
#undef PG8_MMA
#undef PG8_WAIT_V
#undef PG8_WAIT_L
#undef PG8_BAR
#undef PG8_SCHED
}
}


#define RLX_AGENT __ATOMIC_RELAXED, __HIP_MEMORY_SCOPE_AGENT
#define XB_TMO      128
#define XB_XCNT(j)  (256  + 64 * (j))
#define XB_XSUB(j)  (1280 + 64 * (j))
#define XB_XGEN(j)  (2304 + 64 * (j))
#define XB_TOP      3328
#define XB_TOPGEN   3392
#define XCD_BAR_WORDS 3456
#define XB_SPIN_CAP (1u << 18)

__device__ __forceinline__ unsigned xb_ld(unsigned* p)              { return __hip_atomic_load(p, __ATOMIC_RELAXED, __HIP_MEMORY_SCOPE_AGENT); }
__device__ __forceinline__ unsigned xb_add(unsigned* p, unsigned v) { return __hip_atomic_fetch_add(p, v, __ATOMIC_RELAXED, __HIP_MEMORY_SCOPE_AGENT); }
__device__ __forceinline__ unsigned xb_xcc_id() { return (unsigned)__builtin_amdgcn_s_getreg((3 << 11) | 20) & 0xFu; }
#define XB_SPIN(cond, bar) do { unsigned _sp = 0; while (cond) { __builtin_amdgcn_s_sleep(1); \
    if ((++_sp & 255u) == 0u) { if (xb_ld(&(bar)[XB_TMO])) break; if (_sp > XB_SPIN_CAP) { atomicAdd(&(bar)[XB_TMO], 1u); break; } } } } while (0)

struct XcdBarrier {
    unsigned* bar; unsigned x;
    volatile LAS unsigned* st;
};

__device__ __forceinline__ XcdBarrier xcd_barrier_post(unsigned* bar, volatile LAS unsigned* st) {
    XcdBarrier b; b.bar = bar; b.x = xb_xcc_id(); b.st = st;
    if (threadIdx.x == 0) (void)xb_add(&bar[XB_XCNT(b.x)], 1u);
    return b;
}
__device__ __forceinline__ void xcd_barrier_complete(unsigned* bar, unsigned x, unsigned& nloc, unsigned& nx) {
    const unsigned G = gridDim.x * gridDim.y * gridDim.z;
    unsigned sum, cnt, mine, sp = 0u;
    for (;;) {
        sum = 0u; cnt = 0u; mine = 0u;
#pragma unroll
        for (unsigned j = 0; j < 16; ++j) { const unsigned c = xb_ld(&bar[XB_XCNT(j)]); sum += c; cnt += (c > 0u) ? 1u : 0u; mine = (j == x) ? c : mine; }
        if (sum == G) break;
        __builtin_amdgcn_s_sleep(1);
        if ((++sp & 255u) == 0u) { if (xb_ld(&bar[XB_TMO])) break; if (sp > XB_SPIN_CAP) { atomicAdd(&bar[XB_TMO], 1u); break; } }
    }
    nloc = mine > 0u ? mine : 1u; nx = cnt > 0u ? cnt : 1u;
}

__device__ __forceinline__ void xcd_barrier(const XcdBarrier& b) {
    asm volatile("s_waitcnt vmcnt(0)" ::: "memory");
    __syncthreads();
    if (threadIdx.x == 0) {
        unsigned* bar = b.bar;
        __builtin_amdgcn_s_waitcnt(0);
        unsigned nloc = b.st[0], nx = b.st[1];
        if (nloc == 0u) { xcd_barrier_complete(bar, b.x, nloc, nx); b.st[0] = nloc; b.st[1] = nx; }
        const unsigned old = xb_add(&bar[XB_XSUB(b.x)], 1u);
        const unsigned gen = old / nloc;
        if (old + 1u == (gen + 1u) * nloc) {
            __builtin_amdgcn_fence(__ATOMIC_RELEASE, "agent");
            asm volatile("s_waitcnt vmcnt(0)" ::: "memory");
            const unsigned og = xb_add(&bar[XB_TOP], 1u);
            const unsigned tg = og / nx;
            if (og + 1u == (tg + 1u) * nx) xb_add(&bar[XB_TOPGEN], 1u);
            else XB_SPIN(xb_ld(&bar[XB_TOPGEN]) == tg, bar);
            __builtin_amdgcn_fence(__ATOMIC_ACQUIRE, "agent");
            xb_add(&bar[XB_XGEN(b.x)], 1u);
            asm volatile("s_waitcnt vmcnt(0)" ::: "memory");
        } else {
            XB_SPIN(xb_ld(&bar[XB_XGEN(b.x)]) == gen, bar);
            __builtin_amdgcn_fence(__ATOMIC_ACQUIRE, "agent");
            asm volatile("s_waitcnt vmcnt(0)" ::: "memory");
        }
    }
    __syncthreads();
}

DEVI void transpose_item(const float* __restrict__ W, int ldw, int c0, bf16_t* WT, int ldk, int r0, int Kmax, int kb, int nb, const float* kscale, float* scr, int lane) {
    const int k0 = 64 * kb, n0 = 32 * nb;
#pragma unroll 8
    for (int i = 0; i < 32; ++i) {
        const int kk = 2 * i + (lane >> 5);
        float v = 0.f;
        if (k0 + kk < Kmax) { v = W[(size_t)(k0 + kk) * ldw + c0 + n0 + (lane & 31)]; if (kscale) v *= kscale[k0 + kk]; }
        scr[kk * 33 + (lane & 31)] = v;
    }
    asm volatile("s_waitcnt lgkmcnt(0)" ::: "memory");
    asm volatile("" ::: "memory");
    const int c = lane & 7;
    if (k0 + 8 * c < Kmax) {
#pragma unroll
        for (int j = 0; j < 4; ++j) {
            const int n = (lane >> 3) + 8 * j;
            const float* s = scr + (8 * c) * 33 + n;
            u32x4 o; o.x = pk2(s[0], s[33]); o.y = pk2(s[66], s[99]); o.z = pk2(s[132], s[165]); o.w = pk2(s[198], s[231]);
            *(u32x4*)(WT + (size_t)(r0 + n0 + n) * ldk + k0 + 8 * c) = o;
        }
    }
    asm volatile("s_waitcnt lgkmcnt(0)" ::: "memory");
    asm volatile("" ::: "memory");
}


DEVI void wcomb_item(const float* __restrict__ Wq, const float* __restrict__ Sk, const float* __restrict__ n2w, bf16_t* WcT, int it, int lane) {
    const int fr = lane & 15, fq = lane >> 4;
    const int hp = it >> 6, nt = (it >> 4) & 3, kt = it & 15;
    const float* ap = Sk + ((size_t)hp * 128 + nt * 32 + fr) * 128 + fq * 8;
    const float* bp = Wq + (size_t)(kt * 64 + fr) * 2048 + hp * 128 + fq * 8;
    f32x4 acc[2][4];
#pragma unroll
    for (int m = 0; m < 2; ++m)
#pragma unroll
        for (int n = 0; n < 4; ++n) acc[m][n] = (f32x4){0.f, 0.f, 0.f, 0.f};
#pragma unroll
    for (int k0 = 0; k0 < 128; k0 += 32) {
        bf16x8 a[2], b[4];
#pragma unroll
        for (int m = 0; m < 2; ++m) { const f32x4 lo = *(const f32x4*)(ap + (size_t)m * 16 * 128 + k0), hi = *(const f32x4*)(ap + (size_t)m * 16 * 128 + k0 + 4);
            u32x4 w; w.x = pk2(lo.x, lo.y); w.y = pk2(lo.z, lo.w); w.z = pk2(hi.x, hi.y); w.w = pk2(hi.z, hi.w); a[m] = __builtin_bit_cast(bf16x8, w); }
#pragma unroll
        for (int n = 0; n < 4; ++n) { const f32x4 lo = *(const f32x4*)(bp + (size_t)n * 16 * 2048 + k0), hi = *(const f32x4*)(bp + (size_t)n * 16 * 2048 + k0 + 4);
            u32x4 w; w.x = pk2(lo.x, lo.y); w.y = pk2(lo.z, lo.w); w.z = pk2(hi.x, hi.y); w.w = pk2(hi.z, hi.w); b[n] = __builtin_bit_cast(bf16x8, w); }
#pragma unroll
        for (int m = 0; m < 2; ++m)
#pragma unroll
            for (int n = 0; n < 4; ++n) acc[m][n] = mfma16(b[n], a[m], acc[m][n]);
    }
#pragma unroll
    for (int n = 0; n < 4; ++n) {
        const int col = kt * 64 + 16 * n + 4 * fq; const f32x4 w = *(const f32x4*)(n2w + col);
#pragma unroll
        for (int m = 0; m < 2; ++m) { const int row = hp * 128 + nt * 32 + 16 * m + fr; st_bf4(WcT + (size_t)row * 1024 + col, acc[m][n][0] * w.x, acc[m][n][1] * w.y, acc[m][n][2] * w.z, acc[m][n][3] * w.w); }
    }
}

#define KARG __attribute__((address_space(4)))
DEVI const KARG Params* kargs() { unsigned long long k = (unsigned long long)__builtin_amdgcn_kernarg_segment_ptr(); asm volatile("" : "+s"(k)); return (const KARG Params*)k; }
#define PHASE_PTRS \
    int tid_l_ = threadIdx.x; asm volatile("" : "+v"(tid_l_)); \
    [[maybe_unused]] const int tid = tid_l_, lane = tid & 63, wave = __builtin_amdgcn_readfirstlane(tid >> 6), gw = blockIdx.x * NWAVES + wave, fr = lane & 15, fq = lane >> 4; \
    const KARG Params* kp = kargs(); unsigned char* ws = kp->ws; unsigned char* dob = (unsigned char*)kp->out; (void)ws; (void)dob; \
    [[maybe_unused]] const float* x = kp->in[0]; [[maybe_unused]] const int* positions = (const int*)kp->in[1]; [[maybe_unused]] const float* norm1_w = kp->in[2]; [[maybe_unused]] const float* w_in = kp->in[3]; \
    [[maybe_unused]] const float* rw_mu = kp->in[4]; [[maybe_unused]] const float* rw_w0 = kp->in[5]; [[maybe_unused]] const float* rw_a0 = kp->in[7]; [[maybe_unused]] const float* rw_k_k = kp->in[10]; \
    [[maybe_unused]] const float* rw_k_a = kp->in[11]; [[maybe_unused]] const float* rw_r_k = kp->in[12]; [[maybe_unused]] const float* rw_ln_w = kp->in[13]; [[maybe_unused]] const float* rw_ln_b = kp->in[14]; \
    [[maybe_unused]] const float* q_norm_w = kp->in[16]; [[maybe_unused]] const float* kv_norm_w = kp->in[18]; [[maybe_unused]] const float* qn_nope_w = kp->in[20]; [[maybe_unused]] const float* qn_pe_w = kp->in[21]; \
    [[maybe_unused]] const float* kn_nope_w = kp->in[22]; [[maybe_unused]] const float* kn_pe_w = kp->in[23]; [[maybe_unused]] const float* norm2_w = kp->in[26]; \
    [[maybe_unused]] float* ss2 = (float*)(ws + WS_SS2); [[maybe_unused]] unsigned* cnt = (unsigned*)(ws + WS_CNT); [[maybe_unused]] unsigned* xbar_words = (unsigned*)(ws + WS_CNT + 4096); \
    [[maybe_unused]] bf16_t* WinT = (bf16_t*)(ws + WS_WIN); [[maybe_unused]] bf16_t* WuqT = (bf16_t*)(ws + WS_WUQ); [[maybe_unused]] bf16_t* WukvT = (bf16_t*)(ws + WS_WUKV); [[maybe_unused]] bf16_t* RwoT = (bf16_t*)(ws + WS_RWO); \
    [[maybe_unused]] bf16_t* MwoT = (bf16_t*)(ws + WS_MWO); [[maybe_unused]] bf16_t* WoutT = (bf16_t*)(ws + WS_WOUT); [[maybe_unused]] bf16_t* PwqT = (bf16_t*)(ws + WS_PWQ); [[maybe_unused]] bf16_t* SubK = (bf16_t*)(ws + WS_SUBK); \
    [[maybe_unused]] bf16_t* W2T = (bf16_t*)(ws + WS_W2T); [[maybe_unused]] bf16_t* A2T = (bf16_t*)(ws + WS_A2T); [[maybe_unused]] bf16_t* G2T = (bf16_t*)(ws + WS_G2T); [[maybe_unused]] const unsigned char* Gg = ws + WS_G; \
    [[maybe_unused]] bf16_t* Prw = (bf16_t*)(ws + WS_PRW); [[maybe_unused]] bf16_t* QD = (bf16_t*)(ws + WS_QD); [[maybe_unused]] bf16_t* KVD = (bf16_t*)(ws + WS_KVD); [[maybe_unused]] bf16_t* KPE = (bf16_t*)(ws + WS_KPE); \
    [[maybe_unused]] float* ssq = (float*)(ws + WS_SSQ); [[maybe_unused]] float* sskv = (float*)(ws + WS_SSKV); [[maybe_unused]] bf16_t* XN = (bf16_t*)(dob + DO_XN); \
    [[maybe_unused]] bf16_t* Rb = (bf16_t*)(ws + WS_R); [[maybe_unused]] bf16_t* Wb = (bf16_t*)(ws + WS_W); [[maybe_unused]] bf16_t* Kb = (bf16_t*)(ws + WS_KS); [[maybe_unused]] bf16_t* Vb = (bf16_t*)(ws + WS_V); [[maybe_unused]] bf16_t* KKb = (bf16_t*)(ws + WS_KK); \
    [[maybe_unused]] bf16_t* Bvb = (bf16_t*)(dob + DO_BV); [[maybe_unused]] bf16_t* Gtb = (bf16_t*)(dob + DO_GT); [[maybe_unused]] float* bonus = (float*)(dob + DO_BONUS); [[maybe_unused]] bf16_t* Yb = (bf16_t*)(dob + DO_Y); \
    [[maybe_unused]] bf16_t* Qb = (bf16_t*)(ws + WS_Q); [[maybe_unused]] bf16_t* Kab = (bf16_t*)(ws + WS_K); [[maybe_unused]] bf16_t* Vt = (bf16_t*)(ws + WS_VT); [[maybe_unused]] bf16_t* Kraw = (bf16_t*)(dob + DO_KRAW); \
    [[maybe_unused]] bf16_t* Ob = (bf16_t*)(ws + WS_O); [[maybe_unused]] bf16_t* YA = (bf16_t*)(ws + WS_YA); [[maybe_unused]] bf16_t* MIXED = (bf16_t*)(ws + WS_MIXED); [[maybe_unused]] bf16_t* HB = (bf16_t*)(ws + WS_HB); \
    [[maybe_unused]] bf16_t* UB = (bf16_t*)(ws + WS_UB); [[maybe_unused]] bf16_t* VBp = (bf16_t*)(ws + WS_VB); [[maybe_unused]] bf16_t* PQ = (bf16_t*)(ws + WS_PQ); [[maybe_unused]] bf16_t* SC = (bf16_t*)(ws + WS_SC);

__global__ void __launch_bounds__(NT, 2) mega(Params p) {
    extern __shared__ __attribute__((aligned(16))) unsigned char lds[];
    cg::grid_group grid = cg::this_grid();
    const int G = gridDim.x, NGW = G * NWAVES;
    volatile LAS unsigned* bst = (volatile LAS unsigned*)((LAS unsigned char*)lds + LDS_BYTES - 16);
    if (threadIdx.x < 2) bst[threadIdx.x] = 0u;
    if (threadIdx.x >= 8 && threadIdx.x < 16) ((volatile LAS unsigned*)((LAS unsigned char*)lds + LDS_BYTES - 64))[threadIdx.x - 8] = 0u;
    if (threadIdx.x >= 16 && threadIdx.x < 32) ((volatile LAS unsigned*)((LAS unsigned char*)lds + LDS_BYTES - 128))[threadIdx.x - 16] = 0u;
    __syncthreads();

    {
        PHASE_PTRS
        if (blockIdx.x == 0 && tid < 64) cnt[tid] = 0u;
        if (blockIdx.x == 0) for (int i = tid; i < XCD_BAR_WORDS; i += NT) xbar_words[i] = 0u;
        for (int i = blockIdx.x * NT + tid; i < T; i += G * NT) ss2[i] = 0.f;
        for (int t = gw; t < T; t += NGW) {
            const f32x4* xr = (const f32x4*)(x + (size_t)t * DM) + lane;
            f32x4 v[4]; float s = 0.f;
#pragma unroll
            for (int j = 0; j < 4; ++j) { v[j] = xr[64 * j]; s += v[j].x * v[j].x + v[j].y * v[j].y + v[j].z * v[j].z + v[j].w * v[j].w; }
            const float rstd = rsqrtf(wave_sum(s) * (1.f / DM) + EPS);
            const f32x4* wr = (const f32x4*)norm1_w + lane;
#pragma unroll
            for (int j = 0; j < 4; ++j) { const f32x4 w = wr[64 * j]; st_bf4(XN + (size_t)t * DM + (lane + 64 * j) * 4, v[j].x * rstd * w.x, v[j].y * rstd * w.y, v[j].z * rstd * w.z, v[j].w * rstd * w.w); }
        }
        float* scr = (float*)lds + wave * (64 * 33);
        int it = gw;
#define TR_SEG(W_, ldw_, c0_, WT_, ldk_, r0_, Kmax_, nkb_, nnb_, ksc_) \
        { const int cntI = (nkb_) * (nnb_); for (; it < cntI; it += NGW) transpose_item(W_, ldw_, c0_, WT_, ldk_, r0_, Kmax_, it / (nnb_), it % (nnb_), ksc_, scr, lane); it -= cntI; }
        TR_SEG(w_in, 4544, 0, WinT, 1024, 0, 1024, 16, 57, nullptr)
        TR_SEG(w_in, 4544, 1824, WinT, 1024, 2048, 1024, 16, 21, nullptr)
        TR_SEG(w_in, 4544, 2496, WinT, 1024, 2816, 1024, 16, 64, nullptr)
        TR_SEG(kp->in[6], 512, 0, W2T, 64, 0, 64, 1, 16, nullptr)
        TR_SEG(kp->in[8], 512, 0, A2T, 64, 0, 64, 1, 16, nullptr)
        TR_SEG(kp->in[9], 512, 0, G2T, 160, 0, 160, 3, 16, nullptr)
#pragma unroll 1
        for (int hh = 0; hh < 8; ++hh) {
            TR_SEG(kp->in[17], 768, hh * 96, WuqT, 384, hh * 64, 384, 6, 2, q_norm_w)
            TR_SEG(kp->in[17], 768, hh * 96 + 64, WuqT, 384, 512 + hh * 32, 384, 6, 1, q_norm_w)
            TR_SEG(kp->in[19], 1024, hh * 128, WukvT, 256, hh * 64, 256, 4, 2, kv_norm_w)
            TR_SEG(kp->in[19], 1024, hh * 128 + 64, WukvT, 256, 512 + hh * 64, 256, 4, 2, kv_norm_w)
        }
        TR_SEG(kp->in[15], 1024, 0, RwoT, 512, 0, 512, 8, 32, nullptr)
        TR_SEG(kp->in[24], 1024, 0, MwoT, 512, 0, 512, 8, 32, nullptr)
        TR_SEG(kp->in[25], 1024, 0, WoutT, 1024, 0, 1024, 16, 32, nullptr)
#undef TR_SEG
        for (; it < 1024; it += NGW) wcomb_item(kp->in[27], kp->in[28], norm2_w, PwqT, it, lane);
        for (int i = blockIdx.x * NT + tid; i < (224 + 96) * 128; i += G * NT) {
            const int r = i >> 7, c = i & 127; const int row = r < 224 ? 1824 + r : 2720 + (r - 224);
            *(u32x4*)(WinT + (size_t)row * 1024 + c * 8) = (u32x4){0u, 0u, 0u, 0u};
        }
    }
    grid.sync();
    const XcdBarrier xb = xcd_barrier_post((unsigned*)(kargs()->ws + WS_CNT + 4096), bst);

    {
        PHASE_PTRS
        pg8::Gemm g{XN, WinT, T, 4864, DM}; pg8::StaticOrder S; S.init(T, 4864, G, (int)blockIdx.x);
        pg8::EpiP1 E{ws};
        pg8::gemm_phase<pg8::EpiP1, pg8::StaticOrder, true, true>((PG8_LAS unsigned char*)lds, g, S, E);
    }
    xcd_barrier(xb);


    {
        PHASE_PTRS
        for (int t = gw; t < T; t += NGW) {
            float a6[8]; ld_bf8(QD + (size_t)t * 384 + 8 * (lane & 47), a6); float s = 0.f;
#pragma unroll
            for (int i = 0; i < 8; ++i) s += a6[i] * a6[i];
            if (lane >= 48) s = 0.f;
            float b4[4]; ld_bf4(KVD + (size_t)t * 256 + 4 * lane, b4); const float s2 = (b4[0] * b4[0] + b4[1] * b4[1]) + (b4[2] * b4[2] + b4[3] * b4[3]);
            const float sq = wave_sum(s), skv = wave_sum(s2);
            if (lane == 0) { ssq[t] = rsqrtf(sq * (1.f / 384.f) + EPS); sskv[t] = rsqrtf(skv * (1.f / 256.f) + EPS); }
        }
    }
    {
        PHASE_PTRS
        LAS bf16_t* MIX = (LAS bf16_t*)lds; LAS bf16_t* LOR = (LAS bf16_t*)((LAS unsigned char*)lds + 49152);
        for (int tt = blockIdx.x; tt < T / 16; tt += G) {
            const int h = wave;
            __syncthreads();
            {
                u32x4 pw[8], ppw[8];
#pragma unroll
                for (int u = 0; u < 8; ++u) {
                    const int ci = tid + u * NT < 16 * 228 ? tid + u * NT : 16 * 228 - 1; const int row = ci / 228, cc = (ci - row * 228) * 8; const int tk = tt * 16 + row;
                    pw[u] = *(const u32x4*)(Prw + (size_t)tk * 2048 + cc);
                    ppw[u] = *(const u32x4*)(Prw + (size_t)((tk & (SEQ - 1)) != 0 ? tk - 1 : tk) * 2048 + cc);
                }
                __builtin_amdgcn_sched_barrier(0);
#pragma unroll
                for (int u = 0; u < 8; ++u) {
                    const int ci = tid + u * NT; if (ci < 16 * 228) {
                        const int row = ci / 228, cc = (ci - row * 228) * 8; const bool hp_ = ((tt * 16 + row) & (SEQ - 1)) != 0;
                        const float pv[8] = {bflo(pw[u].x), bfhi(pw[u].x), bflo(pw[u].y), bfhi(pw[u].y), bflo(pw[u].z), bfhi(pw[u].z), bflo(pw[u].w), bfhi(pw[u].w)};
                        float ppv[8] = {bflo(ppw[u].x), bfhi(ppw[u].x), bflo(ppw[u].y), bfhi(ppw[u].y), bflo(ppw[u].z), bfhi(ppw[u].z), bflo(ppw[u].w), bfhi(ppw[u].w)};
                        if (!hp_) {
#pragma unroll
                            for (int j = 0; j < 8; ++j) ppv[j] = 0.f; }
                        const f32x4 mu0 = *(const f32x4*)(rw_mu + cc), mu1 = *(const f32x4*)(rw_mu + cc + 4); float xm[8];
#pragma unroll
                        for (int j = 0; j < 8; ++j) { const float mu = j < 4 ? mu0[j & 3] : mu1[j & 3]; const float v = pv[j] + mu * (ppv[j] - pv[j]);
                            xm[j] = cc < 1600 ? (cc < 1536 ? v : tanhf_(v)) : (cc < 1664 ? v : sigmoidf_(v)); }
                        if (cc < 1536) *(LAS bf16x8*)(MIX + row * 1536 + cc) = pack8(xm); else *(LAS bf16x8*)(LOR + row * 288 + (cc - 1536)) = pack8(xm);
                    }
                }
            }
            __syncthreads();
            const int tok = tt * 16 + fr;
            f32x4 accw[4], acca[4], accg[4];
#pragma unroll
            for (int n = 0; n < 4; ++n) { accw[n] = (f32x4){0.f, 0.f, 0.f, 0.f}; acca[n] = accw[n]; accg[n] = accw[n]; }
#define LORA_STEP(lcol_, Wt_, ldw_, koff_, accv_) { \
                const bf16x8 a = *(const LAS bf16x8*)(LOR + fr * 288 + (lcol_) + 8 * fq); \
                _Pragma("unroll") for (int n = 0; n < 4; ++n) { const bf16x8 b = *(const bf16x8*)((Wt_) + (size_t)(64 * h + 16 * n + fr) * (ldw_) + (koff_) + 8 * fq); accv_[n] = mfma16(b, a, accv_[n]); } }
#pragma unroll
            for (int ks = 0; ks < 2; ++ks) LORA_STEP(32 * ks, W2T, 64, 32 * ks, accw)
#pragma unroll
            for (int ks = 0; ks < 2; ++ks) LORA_STEP(64 + 32 * ks, A2T, 64, 32 * ks, acca)
#pragma unroll
            for (int ks = 0; ks < 5; ++ks) LORA_STEP(128 + 32 * ks, G2T, 160, 32 * ks, accg)
#undef LORA_STEP
            float kkv[4][4], av[4][4]; float ssq = 0.f, bon = 0.f;
#pragma unroll
            for (int n = 0; n < 4; ++n) {
                const int ch = 64 * h + 16 * n + 4 * fq;
                float r4[4], k4[4], v4[4];
#pragma unroll
                for (int seg = 0; seg < 3; ++seg) {
                    const u32x2 w = *(const LAS u32x2*)(MIX + fr * 1536 + seg * 512 + ch);
                    const float m4[4] = {bflo(w.x), bfhi(w.x), bflo(w.y), bfhi(w.y)};
#pragma unroll
                    for (int i = 0; i < 4; ++i) { if (seg == 0) r4[i] = m4[i]; else if (seg == 1) k4[i] = m4[i]; else v4[i] = m4[i]; }
                }
                const f32x4 w0 = *(const f32x4*)(rw_w0 + ch), a0 = *(const f32x4*)(rw_a0 + ch), kkw = *(const f32x4*)(rw_k_k + ch), kaw = *(const f32x4*)(rw_k_a + ch), rkw = *(const f32x4*)(rw_r_k + ch);
                float dd[4], kf[4];
#pragma unroll
                for (int i = 0; i < 4; ++i) {
                    const float z = -(w0[i] + accw[n][i]);
                    const float sp = z > 20.f ? z : __logf(1.f + __expf(z));
                    const float wlog = -sp - 0.5f;
                    dd[i] = -__expf(wlog);
                    const float a = sigmoidf_(a0[i] + acca[n][i]); av[n][i] = a;
                    kkv[n][i] = k4[i] * kkw[i]; ssq += kkv[n][i] * kkv[n][i];
                    kf[i] = k4[i] * (1.f + (a - 1.f) * kaw[i]);
                    bon += r4[i] * kf[i] * rkw[i];
                }
                const size_t o = (size_t)tok * 512 + ch;
                st_bf4(Rb + o, r4[0], r4[1], r4[2], r4[3]);
                st_bf4(Wb + o, dd[0], dd[1], dd[2], dd[3]);
                st_bf4(Kb + o, kf[0], kf[1], kf[2], kf[3]);
                st_bf4(Vb + o, v4[0], v4[1], v4[2], v4[3]);
                st_bf4(Gtb + o, accg[n][0], accg[n][1], accg[n][2], accg[n][3]);
            }
            ssq += __shfl_xor(ssq, 16); ssq += __shfl_xor(ssq, 32);
            bon += __shfl_xor(bon, 16); bon += __shfl_xor(bon, 32);
            const float inv = 1.f / fmaxf(sqrtf(ssq), 1e-12f);
#pragma unroll
            for (int n = 0; n < 4; ++n) {
                const size_t o = (size_t)tok * 512 + 64 * h + 16 * n + 4 * fq;
                float kk[4], bb[4];
#pragma unroll
                for (int i = 0; i < 4; ++i) { kk[i] = kkv[n][i] * inv; bb[i] = kk[i] * av[n][i]; }
                st_bf4(KKb + o, kk[0], kk[1], kk[2], kk[3]);
                st_bf4(Bvb + o, bb[0], bb[1], bb[2], bb[3]);
            }
            if (fq == 0) bonus[(size_t)tok * 8 + h] = bon;
        }
    }
    xcd_barrier(xb);

    {
        PHASE_PTRS
        { int Kq = 384; asm volatile("" : "+s"(Kq));
          pg8::Gemm g{QD, WuqT, T, 768, Kq}; pg8::StaticOrder S; S.init(T, 768, G, (int)blockIdx.x); pg8::EpiQraw E{Qb, ssq};
          pg8::gemm_phase<pg8::EpiQraw, pg8::StaticOrder, true, true>((PG8_LAS unsigned char*)lds, g, S, E); }
        { int Kkv = 256; asm volatile("" : "+s"(Kkv));
          pg8::Gemm g{KVD, WukvT, T, 1024, Kkv}; pg8::StaticOrder S; S.init(T, 1024, G, (int)blockIdx.x); pg8::EpiKVraw E{Kraw, Vt, sskv};
          pg8::gemm_phase<pg8::EpiKVraw, pg8::StaticOrder, true, true>((PG8_LAS unsigned char*)lds, g, S, E); }
    }
    xcd_barrier(xb);
    {
        PHASE_PTRS
        for (int t = gw; t < T; t += NGW) {
            const int hh = lane >> 3, l8 = lane & 7;
            const float pos = (float)positions[t];
            float cs[4], sn[4];
#pragma unroll
            for (int i = 0; i < 4; ++i) { const float invf = exp2f(-(float)(4 * (l8 & 3) + i) * (13.287712379549449f / 16.f)); float rev = pos * invf * 0.15915494309189535f; rev -= rintf(rev);
                sn[i] = __builtin_amdgcn_sinf(rev); cs[i] = __builtin_amdgcn_cosf(rev); }
            bf16_t* qrow = Qb + (size_t)t * 768;
            float qn[8], qp[4]; ld_bf8(qrow + 8 * lane, qn); ld_bf4(qrow + 512 + 4 * lane, qp);
            float kn[8], kp4[4]; ld_bf8(Kraw + (size_t)t * 512 + 8 * lane, kn); ld_bf4(KPE + (size_t)t * 32 + 4 * l8, kp4);
            float s1 = 0.f, s2 = 0.f, s3 = 0.f, s4 = 0.f;
#pragma unroll
            for (int i = 0; i < 8; ++i) { s1 += qn[i] * qn[i]; s3 += kn[i] * kn[i]; }
#pragma unroll
            for (int i = 0; i < 4; ++i) { s2 += qp[i] * qp[i]; s4 += kp4[i] * kp4[i]; }
            s1 = sum8(s1); s2 = sum8(s2); s3 = sum8(s3); s4 = sum8(s4);
            const float r1 = rsqrtf(s1 * (1.f / 64.f) + EPS) * QSCALE, r2 = rsqrtf(s2 * (1.f / 32.f) + EPS), r3 = rsqrtf(s3 * (1.f / 64.f) + EPS), r4 = rsqrtf(s4 * (1.f / 32.f) + EPS);
            const f32x4 wq0 = *(const f32x4*)(qn_nope_w + 8 * l8), wq1 = *(const f32x4*)(qn_nope_w + 8 * l8 + 4), wk0 = *(const f32x4*)(kn_nope_w + 8 * l8), wk1 = *(const f32x4*)(kn_nope_w + 8 * l8 + 4);
            const f32x4 wqp = *(const f32x4*)(qn_pe_w + 4 * l8), wkp = *(const f32x4*)(kn_pe_w + 4 * l8);
            float oq[8], ok[8], oqp[4], okp[4];
#pragma unroll
            for (int i = 0; i < 8; ++i) { oq[i] = qn[i] * r1 * (i < 4 ? wq0[i & 3] : wq1[i & 3]); ok[i] = kn[i] * r3 * (i < 4 ? wk0[i & 3] : wk1[i & 3]); }
#pragma unroll
            for (int i = 0; i < 4; ++i) {
                const float xq = qp[i] * r2 * wqp[i], xk = kp4[i] * r4 * wkp[i];
                const float pq = dpp_f<0x141>(xq), pk_ = dpp_f<0x141>(xk);
                (void)pq; (void)pk_;
                oqp[i] = xq; okp[i] = xk;
            }
#pragma unroll
            for (int i = 0; i < 4; ++i) {
                const float pq = __shfl_xor(oqp[i], 4), pk_ = __shfl_xor(okp[i], 4);
                const float xq = oqp[i], xk = okp[i];
                oqp[i] = l8 < 4 ? (xq * cs[i] - pq * sn[i]) : (xq * cs[i] + pq * sn[i]);
                okp[i] = l8 < 4 ? (xk * cs[i] - pk_ * sn[i]) : (xk * cs[i] + pk_ * sn[i]);
                oqp[i] *= QSCALE;
            }
            bf16_t* qo = Qb + ((size_t)t * 8 + hh) * 96;
            *(bf16x8*)(qo + 8 * l8) = pack8(oq); st_bf4(qo + 64 + 4 * l8, oqp[0], oqp[1], oqp[2], oqp[3]);
            { const int bb = t >> 12, pos = t & 4095; bf16_t* kfb = Kab + (((size_t)(bb * 8 + hh) * 128 + (pos >> 5)) * 6) * 512 + (pos & 31) * 8;
              *(bf16x8*)(kfb + (l8 >> 1) * 512 + 256 * (l8 & 1)) = pack8(ok);
              st_bf4(kfb + (4 + (l8 >> 2)) * 512 + 256 * ((l8 >> 1) & 1) + 4 * (l8 & 1), okp[0], okp[1], okp[2], okp[3]); }
        }
    }
    xcd_barrier(xb);

    {
        PHASE_PTRS
        float* GL = (float*)(dob + DO_GL);
        const int fr_o = fr, fq_o = fq, lane_o = lane;
        if (wave < 3) {
            LAS unsigned char* wb = (LAS unsigned char*)lds + wave * 49152;
            LAS bf16_t* At = (LAS bf16_t*)(wb + 0);      LAS bf16_t* Btm = (LAS bf16_t*)(wb + 4096);  LAS bf16_t* Ktm = (LAS bf16_t*)(wb + 8192); LAS bf16_t* Rtm = (LAS bf16_t*)(wb + 12288);
            LAS bf16_t* AtT = (LAS bf16_t*)(wb + 16384); LAS bf16_t* BtT = (LAS bf16_t*)(wb + 20480); LAS bf16_t* KtT = (LAS bf16_t*)(wb + 24576); LAS bf16_t* VmT = (LAS bf16_t*)(wb + 28672);
            LAS bf16_t* Nm = (LAS bf16_t*)(wb + 32768);  LAS bf16_t* NmT = (LAS bf16_t*)(wb + 34816); LAS bf16_t* Tm = (LAS bf16_t*)(wb + 36864);  LAS bf16_t* TmT = (LAS bf16_t*)(wb + 38912);
            LAS bf16_t* MmT = (LAS bf16_t*)(wb + 40960); LAS bf16_t* NBT = (LAS bf16_t*)(wb + 43008); LAS bf16_t* MKT = (LAS bf16_t*)(wb + 45056); LAS float* gLs = (LAS float*)(wb + 47104);
            LAS bf16_t* W1 = At; LAS bf16_t* W1T = Btm; LAS bf16_t* ATm = Ktm;
#pragma unroll 1
            for (int it = blockIdx.x * 3 + wave; it < 4096; it += G * 3) {
                const int bh = it >> 7, c = it & 127, b = bh >> 3, h = bh & 7;
                int fr = fr_o, fq = fq_o, lane = lane_o; asm volatile("" : "+v"(fr), "+v"(fq), "+v"(lane));
                const int lpA = (4 * (fr >> 3) + (fr & 3)) + 32 * (fq & 1) + ((fq >> 1) + 4 * ((fr >> 2) & 1)) * 512;
                const int lpB = ((fr >> 1) + 16 * (fq & 1)) * 512 + 16 * (fr & 1) + 4 * (fq >> 1);
                const int lpC = 4 * (fq >> 1) + 16 * (fr & 3) + ((fr >> 2) + 8 * (fq & 1)) * 512;
                const size_t sbase = ((size_t)b * SEQ + c * 32) * 512 + h * 64;
                {
                    float cs = 0.f; unsigned aT[16], bT[16], kT[16], vT[16];
#pragma unroll
                    for (int t = 0; t < 32; ++t) {
                        const size_t o = sbase + (size_t)t * 512 + lane;
                        const float ldv = bf1(Wb[o]), rr = bf1(Rb[o]), kv = bf1(Kb[o]), qv = bf1(KKb[o]), bv = bf1(Bvb[o]); const unsigned vraw = Vb[o];
                        const float ep = __expf(cs); cs += ldv; const float ec = __expf(cs), en = __expf(-cs);
                        const unsigned a_ = bf1of(-qv * ep), b_ = bf1of(bv * en), k_ = bf1of(kv * en), r_ = bf1of(rr * ec);
                        At[SW64(t, lane)] = (bf16_t)a_; Btm[SW64(t, lane)] = (bf16_t)b_; Ktm[SW64(t, lane)] = (bf16_t)k_; Rtm[SW64(t, lane)] = (bf16_t)r_;
                        if (t & 1) { aT[t >> 1] |= a_ << 16; bT[t >> 1] |= b_ << 16; kT[t >> 1] |= k_ << 16; vT[t >> 1] |= vraw << 16; }
                        else { aT[t >> 1] = a_; bT[t >> 1] = b_; kT[t >> 1] = k_; vT[t >> 1] = vraw; }
                    }
#pragma unroll
                    for (int q = 0; q < 4; ++q) {
                        *(LAS u32x4*)(AtT + lane * 32 + ((q ^ ((lane >> 2) & 3)) << 3)) = (u32x4){aT[4 * q], aT[4 * q + 1], aT[4 * q + 2], aT[4 * q + 3]};
                        *(LAS u32x4*)(BtT + lane * 32 + ((q ^ ((lane >> 2) & 3)) << 3)) = (u32x4){bT[4 * q], bT[4 * q + 1], bT[4 * q + 2], bT[4 * q + 3]};
                        *(LAS u32x4*)(KtT + lane * 32 + ((q ^ ((lane >> 2) & 3)) << 3)) = (u32x4){kT[4 * q], kT[4 * q + 1], kT[4 * q + 2], kT[4 * q + 3]};
                        *(LAS u32x4*)(VmT + lane * 32 + ((q ^ ((lane >> 2) & 3)) << 3)) = (u32x4){vT[4 * q], vT[4 * q + 1], vT[4 * q + 2], vT[4 * q + 3]};
                    }
                    const float gl = __expf(cs); gLs[lane] = gl;
                    { const int k5 = lane & 31; GL[(size_t)it * 64 + (lane >> 5) * 32 + ((k5 >> 2) & 1) * 16 + (k5 & 3) + 4 * (k5 >> 3)] = gl; }
                }
                {
                    f32x4 acc[2][2];
#define ZACC(MT_, NT_) _Pragma("unroll") for (int m = 0; m < MT_; ++m) _Pragma("unroll") for (int n = 0; n < NT_; ++n) acc[m][n] = (f32x4){0.f, 0.f, 0.f, 0.f};
                    ZACC(2, 2) gemm_lds<2, 2, 2>(Btm, 64, At, 64, acc, fr, fq);
#pragma unroll
                    for (int m = 0; m < 2; ++m)
#pragma unroll
                        for (int n = 0; n < 2; ++n)
#pragma unroll
                            for (int j = 0; j < 4; ++j) { const int i = 16 * m + fr, tt = 16 * n + 4 * fq + j; const float v = i < tt ? acc[m][n][j] : 0.f; const bf16_t w = bf1of(v), w1 = bf1of(v + (i == tt ? 1.f : 0.f));
                                Nm[SW32(i, tt)] = w; NmT[SW32(tt, i)] = w; Tm[SW32(i, tt)] = w1; TmT[SW32(tt, i)] = w1; }
                    ZACC(2, 2) gemm_lds<2, 2, 2>(Ktm, 64, At, 64, acc, fr, fq);
#pragma unroll
                    for (int m = 0; m < 2; ++m)
#pragma unroll
                        for (int n = 0; n < 2; ++n)
#pragma unroll
                            for (int j = 0; j < 4; ++j) { const int i = 16 * m + fr, tt = 16 * n + 4 * fq + j; MmT[SW32(tt, i)] = bf1of(i < tt ? acc[m][n][j] : 0.f); }
                    ZACC(2, 2) gemm_lds<2, 2, 2>(Btm, 64, Rtm, 64, acc, fr, fq);
#pragma unroll
                    for (int m = 0; m < 2; ++m)
#pragma unroll
                        for (int n = 0; n < 2; ++n)
#pragma unroll
                            for (int j = 0; j < 4; ++j) { const int i = 16 * m + fr, tt = 16 * n + 4 * fq + j; NBT[SW32(tt, i)] = bf1of(i <= tt ? acc[m][n][j] : 0.f); }
                    ZACC(2, 2) gemm_lds<2, 2, 2>(Ktm, 64, Rtm, 64, acc, fr, fq);
#pragma unroll
                    for (int m = 0; m < 2; ++m)
#pragma unroll
                        for (int n = 0; n < 2; ++n)
#pragma unroll
                            for (int j = 0; j < 4; ++j) { const int i = 16 * m + fr, tt = 16 * n + 4 * fq + j; MKT[SW32(tt, i)] = bf1of(i <= tt ? acc[m][n][j] : 0.f); }
#pragma unroll 1
                    for (int rd = 0; rd < 4; ++rd) {
                        ZACC(2, 2) gemm_lds<2, 2, 1>(Nm, 32, NmT, 32, acc, fr, fq);
#pragma unroll
                        for (int m = 0; m < 2; ++m)
#pragma unroll
                            for (int n = 0; n < 2; ++n)
#pragma unroll
                                for (int j = 0; j < 4; ++j) { const int i = 16 * m + fr, tt = 16 * n + 4 * fq + j; const bf16_t w = bf1of(acc[m][n][j]); Nm[SW32(i, tt)] = w; NmT[SW32(tt, i)] = w; }
                        ZACC(2, 2) gemm_lds<2, 2, 1>(Tm, 32, NmT, 32, acc, fr, fq);
#pragma unroll
                        for (int m = 0; m < 2; ++m)
#pragma unroll
                            for (int n = 0; n < 2; ++n)
#pragma unroll
                                for (int j = 0; j < 4; ++j) { const int i = 16 * m + fr, tt = 16 * n + 4 * fq + j; const bf16_t w = bf1of(acc[m][n][j] + bf1(Tm[SW32(i, tt)])); Tm[SW32(i, tt)] = w; TmT[SW32(tt, i)] = w; }
                    }
                }
                asm volatile("" : "+v"(fr), "+v"(fq));
                {
                    f32x4 acc[4][2];
                    ZACC(4, 2) gemm_lds<4, 2, 1>(AtT, 32, TmT, 32, acc, fr, fq);
#pragma unroll
                    for (int m = 0; m < 4; ++m)
#pragma unroll
                        for (int n = 0; n < 2; ++n)
#pragma unroll
                            for (int j = 0; j < 4; ++j) ATm[SW32(16 * m + fr, 16 * n + 4 * fq + j)] = bf1of(acc[m][n][j]);
                    ZACC(4, 2) gemm_lds<4, 2, 1>(VmT, 32, MmT, 32, acc, fr, fq);
#pragma unroll
                    for (int m = 0; m < 4; ++m)
#pragma unroll
                        for (int n = 0; n < 2; ++n)
#pragma unroll
                            for (int j = 0; j < 4; ++j) W1[SW32(16 * m + fr, 16 * n + 4 * fq + j)] = bf1of(acc[m][n][j]);
                    ZACC(4, 2) gemm_lds<4, 2, 1>(W1, 32, TmT, 32, acc, fr, fq);
#pragma unroll
                    for (int m = 0; m < 4; ++m)
#pragma unroll
                        for (int n = 0; n < 2; ++n)
#pragma unroll
                            for (int j = 0; j < 4; ++j) W1T[SW32(16 * m + fr, 16 * n + 4 * fq + j)] = bf1of(acc[m][n][j]);
                    ZACC(4, 2) gemm_lds<4, 2, 1>(ATm, 32, NBT, 32, acc, fr, fq);
#pragma unroll
                    for (int m = 0; m < 4; ++m)
#pragma unroll
                        for (int n = 0; n < 2; ++n)
#pragma unroll
                            for (int j = 0; j < 4; ++j) { const int k = 16 * m + fr, tp = 16 * n + 4 * fq + j; const float v = acc[m][n][j] + bf1(Rtm[SW64(tp, k)]);
                                Rb[sbase + lpA + (size_t)(j * 8 + (2 * n + 8 * m) * 512)] = bf1of(v); }
                    ZACC(4, 2) gemm_lds<4, 2, 1>(W1T, 32, NBT, 32, acc, fr, fq); gemm_lds<4, 2, 1>(VmT, 32, MKT, 32, acc, fr, fq);
#pragma unroll
                    for (int m = 0; m < 4; ++m)
#pragma unroll
                        for (int n = 0; n < 2; ++n)
#pragma unroll
                            for (int j = 0; j < 4; ++j) Yb[sbase + lpB + (size_t)((8 * (m & 1)) * 512 + 32 * (m >> 1) + j + 8 * n)] = bf1of(acc[m][n][j]);
                }
                asm volatile("" : "+v"(fr), "+v"(fq));
                {
                    f32x4 acc[4][4];
                    ZACC(4, 4) gemm_lds<4, 4, 1>(ATm, 32, BtT, 32, acc, fr, fq);
#pragma unroll
                    for (int m = 0; m < 4; ++m)
#pragma unroll
                        for (int n = 0; n < 4; ++n)
#pragma unroll
                            for (int j = 0; j < 4; ++j) { const float v = acc[m][n][j] * gLs[16 * n + 4 * fq + j];
                                (n < 2 ? Wb : Kb)[sbase + lpA + (size_t)(j * 8 + (2 * (n & 1) + 8 * m) * 512)] = bf1of(v); }
                    ZACC(4, 4) gemm_lds<4, 4, 1>(W1T, 32, BtT, 32, acc, fr, fq); gemm_lds<4, 4, 1>(VmT, 32, KtT, 32, acc, fr, fq);
#pragma unroll
                    for (int m = 0; m < 4; ++m)
#pragma unroll
                        for (int n = 0; n < 4; ++n)
#pragma unroll
                            for (int j = 0; j < 4; ++j) { const float v = acc[m][n][j] * gLs[16 * n + 4 * fq + j];
                                (m < 2 ? KKb : Bvb)[sbase + lpC + (size_t)(j + 8 * (n & 1) + (4 * (m & 1) + 16 * (n >> 1)) * 512)] = bf1of(v); }
                }
#undef ZACC
            }
        }
    }
    xcd_barrier(xb);

    {
        PHASE_PTRS
        if (wave < 5 && blockIdx.x < 64) {
            const int item = blockIdx.x, bh = item >> 1, wv = item & 1, b = bh >> 3, h = bh & 7;
            const int hi = lane >> 5, vcol = lane & 31;
            float* GL = (float*)(dob + DO_GL);
            volatile LAS unsigned* ctr = (volatile LAS unsigned*)((LAS unsigned char*)lds + LDS_BYTES - 64);
#define SLICE(arr, sb, li) ((arr) + (sb) + (size_t)((li) >> 6) * 512 + ((li) & 63))
#define DMA16(src_, dst_) __builtin_amdgcn_global_load_lds((const unsigned*)(src_), (LAS unsigned*)(dst_), 16, 0, 0)
            if (wave >= 1 && wave <= 3) {
                __builtin_amdgcn_s_setprio(2);
#pragma unroll 1
                for (int c = 0; c < 128; ++c) {
                    if (c >= 4) { while ((int)ctr[3] < c - 3) __builtin_amdgcn_s_sleep(1); }
                    asm volatile("" ::: "memory");
                    const size_t sb = ((size_t)b * SEQ + c * 32) * 512 + h * 64; LAS unsigned char* lb = (LAS unsigned char*)lds + (c & 3) * 19712;
                    if (wave == 1) {
#pragma unroll
                        for (int q = 0; q < 4; ++q) DMA16(SLICE(Wb, sb, (q * 64 + lane) * 8), lb + q * 1024);
#pragma unroll
                        for (int q = 0; q < 2; ++q) DMA16(SLICE(Kb, sb, (q * 64 + lane) * 8), lb + 4096 + q * 1024);
                        asm volatile("s_waitcnt vmcnt(12)" ::: "memory");
                    } else if (wave == 2) {
#pragma unroll
                        for (int q = 2; q < 4; ++q) DMA16(SLICE(Kb, sb, (q * 64 + lane) * 8), lb + 4096 + q * 1024);
#pragma unroll
                        for (int q = 0; q < 4; ++q) DMA16(SLICE(Rb, sb, (q * 64 + lane) * 8), lb + 8192 + q * 1024);
                        asm volatile("s_waitcnt vmcnt(12)" ::: "memory");
                    } else {
#pragma unroll
                        for (int kb = 0; kb < 2; ++kb)
#pragma unroll
                            for (int hf = 0; hf < 2; ++hf) DMA16(SLICE(wv ? Bvb : KKb, sb, (kb * 64 + lane) * 16 + 8 * hf), lb + 12288 + kb * 2048 + hf * 1024);
#pragma unroll
                        for (int hf = 0; hf < 2; ++hf) DMA16(Yb + sb + (size_t)(lane >> 1) * 512 + 32 * wv + 16 * (lane & 1) + 8 * hf, lb + 16384 + hf * 1024);
                        __builtin_amdgcn_global_load_lds((const unsigned*)(GL + ((size_t)(bh * 128 + c)) * 64 + lane), (LAS unsigned*)(lb + 18432), 4, 0, 0);
                        asm volatile("s_waitcnt vmcnt(14)" ::: "memory");
                    }
                    if (c >= 2 && lane == 0) ctr[wave - 1] = (unsigned)(c - 1);
                }
                asm volatile("s_waitcnt vmcnt(0)" ::: "memory");
                if (lane == 0) ctr[wave - 1] = 128u;
                __builtin_amdgcn_s_setprio(0);
            } else if (wave == 4) {
#pragma unroll 1
                for (int c = 0; c < 128; ++c) {
                    while ((int)ctr[4] <= c) __builtin_amdgcn_s_sleep(2);
                    asm volatile("" ::: "memory");
                    const LAS u32x4* ys = (const LAS u32x4*)((LAS unsigned char*)lds + 81920 + (c & 7) * 2048 + lane * 32);
                    const u32x4 ya = ys[0], yb = ys[1];
                    u32x4* yo = (u32x4*)(Yb + ((size_t)b * SEQ + c * 32 + (lane >> 1)) * 512 + h * 64 + 32 * wv + 16 * (lane & 1));
                    yo[0] = ya; yo[1] = yb;
                    asm volatile("s_waitcnt lgkmcnt(0)" ::: "memory");
                    if (lane == 0) ctr[5] = (unsigned)(c + 1);
                }
            } else {
                __builtin_amdgcn_s_setprio(3);
                f32x16 S0t, S1t;
#pragma unroll
                for (int r = 0; r < 16; ++r) { S0t[r] = 0.f; S1t[r] = 0.f; }
#pragma unroll 1
                for (int c = 0; c < 128; ++c) {
                    while ((int)ctr[0] <= c || (int)ctr[1] <= c || (int)ctr[2] <= c) __builtin_amdgcn_s_sleep(1);
                    asm volatile("" ::: "memory");
                    const LAS unsigned char* lb = (const LAS unsigned char*)lds + (c & 3) * 19712;
                    bf16x8 sf[4];
#pragma unroll
                    for (int s = 0; s < 4; ++s) { float t8[8];
#pragma unroll
                        for (int j = 0; j < 8; ++j) t8[j] = (s < 2 ? S0t : S1t)[8 * (s & 1) + j];
                        sf[s] = pack8(t8); }
                    f32x16 yt;
                    { const u32x4 c0 = *(const LAS u32x4*)(lb + 16384 + lane * 16), c1 = *(const LAS u32x4*)(lb + 16384 + 1024 + lane * 16);
                      yt[0] = bflo(c0.x); yt[1] = bfhi(c0.x); yt[2] = bflo(c0.y); yt[3] = bfhi(c0.y); yt[4] = bflo(c0.z); yt[5] = bfhi(c0.z); yt[6] = bflo(c0.w); yt[7] = bfhi(c0.w);
                      yt[8] = bflo(c1.x); yt[9] = bfhi(c1.x); yt[10] = bflo(c1.y); yt[11] = bfhi(c1.y); yt[12] = bflo(c1.z); yt[13] = bfhi(c1.z); yt[14] = bflo(c1.w); yt[15] = bfhi(c1.w); }
                    f32x16 n0, n1;
#pragma unroll
                    for (int kb = 0; kb < 2; ++kb) {
                        const u32x4 c0 = *(const LAS u32x4*)(lb + 12288 + kb * 2048 + lane * 16), c1 = *(const LAS u32x4*)(lb + 12288 + kb * 2048 + 1024 + lane * 16);
                        const LAS float* gp = (const LAS float*)(lb + 18432) + kb * 32 + hi * 16;
                        f32x16 nn; const f32x16 so = kb ? S1t : S0t;
                        nn[0] = bflo(c0.x); nn[1] = bfhi(c0.x); nn[2] = bflo(c0.y); nn[3] = bfhi(c0.y); nn[4] = bflo(c0.z); nn[5] = bfhi(c0.z); nn[6] = bflo(c0.w); nn[7] = bfhi(c0.w);
                        nn[8] = bflo(c1.x); nn[9] = bfhi(c1.x); nn[10] = bflo(c1.y); nn[11] = bfhi(c1.y); nn[12] = bflo(c1.z); nn[13] = bfhi(c1.z); nn[14] = bflo(c1.w); nn[15] = bfhi(c1.w);
#pragma unroll
                        for (int r = 0; r < 16; ++r) nn[r] += gp[r] * so[r];
                        if (kb) n1 = nn; else n0 = nn;
                    }
#pragma unroll
                    for (int s = 0; s < 4; ++s) {
                        const bf16x8 ra = *(const LAS bf16x8*)(lb + 8192 + s * 1024 + lane * 16);
                        const bf16x8 p0 = *(const LAS bf16x8*)(lb + s * 1024 + lane * 16), p1 = *(const LAS bf16x8*)(lb + 4096 + s * 1024 + lane * 16);
                        yt = mfma32(ra, sf[s], yt); n0 = mfma32(p0, sf[s], n0); n1 = mfma32(p1, sf[s], n1);
                    }
                    S0t = n0; S1t = n1;
                    asm volatile("s_waitcnt lgkmcnt(0)" ::: "memory");
                    if (lane == 0) ctr[3] = (unsigned)(c + 1);
                    if (c >= 8) { while ((int)ctr[5] < c - 7) __builtin_amdgcn_s_sleep(1); }
                    asm volatile("" ::: "memory");
                    { LAS bf16_t* ys = (LAS bf16_t*)((LAS unsigned char*)lds + 81920 + (c & 7) * 2048) + vcol;
#pragma unroll
                      for (int r = 0; r < 16; ++r) ys[crow(r, hi) * 32] = bf1of(yt[r]);
                      asm volatile("s_waitcnt lgkmcnt(0)" ::: "memory");
                      if (lane == 0) ctr[4] = (unsigned)(c + 1); }
                }
                __builtin_amdgcn_s_setprio(0);
            }
#undef DMA16
#undef SLICE
        }
        for (;;) {
            unsigned item = 0;
            const int xg = blockIdx.x & 7;
            if (lane == 0) item = atomicAdd(&cnt[xg], 1u);
            item = __builtin_amdgcn_readfirstlane(item);
            if (item >= 256u) break;
            const int qt = 63 - (int)(item >> 2), bh = 8 * (int)(item & 3) + xg, b = bh >> 3, h = bh & 7;
            const int qi = lane & 31, hi = lane >> 5;
            const size_t tokq = (size_t)b * SEQ + qt * 64 + qi;
            bf16x8 qfa[6], qfb[6];
#pragma unroll
            for (int s = 0; s < 6; ++s) { qfa[s] = *(const bf16x8*)(Qb + (tokq * 8 + h) * 96 + 16 * s + 8 * hi); qfb[s] = *(const bf16x8*)(Qb + ((tokq + 32) * 8 + h) * 96 + 16 * s + 8 * hi); }
            float ma = -1e30f, la = 0.f, mb = -1e30f, lb = 0.f;
            f32x16 oa0, oa1, ob0, ob1;
#pragma unroll
            for (int r = 0; r < 16; ++r) { oa0[r] = 0.f; oa1[r] = 0.f; ob0[r] = 0.f; ob1[r] = 0.f; }
            const bf16_t* kfb = Kab + ((size_t)(b * 8 + h) * 128) * 6 * 512 + lane * 8;
            const bf16_t* vfb = Vt + ((size_t)(b * 8 + h) * 128) * 4 * 512 + lane * 8;
            const int nt = 2 * qt + 2;
#define ATT_GROUP(QF, M_, L_, O0, O1, DIAG) { \
                f32x16 xs; _Pragma("unroll") for (int r = 0; r < 16; ++r) xs[r] = 0.f; \
                _Pragma("unroll") for (int s = 0; s < 6; ++s) xs = mfma32(kf[s], QF[s], xs); \
                if (DIAG) { _Pragma("unroll") for (int r = 0; r < 16; ++r) if (crow(r, hi) > qi) xs[r] = -1e30f; } \
                float mx = xs[0]; _Pragma("unroll") for (int r = 1; r < 16; ++r) mx = fmaxf(mx, xs[r]); \
                mx = fmaxf(mx, __shfl_xor(mx, 32)); \
                if (__any(mx > M_)) { const float mn = fmaxf(M_, mx), alpha = __builtin_amdgcn_exp2f(M_ - mn); L_ *= alpha; M_ = mn; \
                    _Pragma("unroll") for (int r = 0; r < 16; ++r) { O0[r] *= alpha; O1[r] *= alpha; } } \
                float ps = 0.f; _Pragma("unroll") for (int r = 0; r < 16; ++r) { xs[r] = __builtin_amdgcn_exp2f(xs[r] - M_); ps += xs[r]; } \
                L_ += ps; \
                _Pragma("unroll") for (int s = 0; s < 2; ++s) { float t8[8]; _Pragma("unroll") for (int j = 0; j < 8; ++j) t8[j] = xs[8 * s + j]; const bf16x8 pbs = pack8(t8); \
                    O0 = mfma32(vf[0][s], pbs, O0); O1 = mfma32(vf[1][s], pbs, O1); } }
#pragma unroll 1
            for (int kt = 0; kt < nt; ++kt) {
                bf16x8 kf[6], vf[2][2];
#pragma unroll
                for (int s = 0; s < 6; ++s) kf[s] = *(const bf16x8*)(kfb + (size_t)(kt * 6 + s) * 512);
#pragma unroll
                for (int d0 = 0; d0 < 2; ++d0)
#pragma unroll
                    for (int s = 0; s < 2; ++s) vf[d0][s] = *(const bf16x8*)(vfb + (size_t)((kt * 2 + d0) * 2 + s) * 512);
                if (kt < nt - 1) ATT_GROUP(qfa, ma, la, oa0, oa1, kt == nt - 2)
                ATT_GROUP(qfb, mb, lb, ob0, ob1, kt == nt - 1)
            }
#undef ATT_GROUP
            la += __shfl_xor(la, 32); lb += __shfl_xor(lb, 32);
            const float ila = 1.f / la, ilb = 1.f / lb;
            bf16_t* orow = Ob + tokq * 512 + h * 64;
#pragma unroll
            for (int g = 0; g < 4; ++g) {
                st_bf4(orow + 8 * g + 4 * hi, oa0[4 * g] * ila, oa0[4 * g + 1] * ila, oa0[4 * g + 2] * ila, oa0[4 * g + 3] * ila);
                st_bf4(orow + 32 + 8 * g + 4 * hi, oa1[4 * g] * ila, oa1[4 * g + 1] * ila, oa1[4 * g + 2] * ila, oa1[4 * g + 3] * ila);
                st_bf4(orow + (size_t)32 * 512 + 8 * g + 4 * hi, ob0[4 * g] * ilb, ob0[4 * g + 1] * ilb, ob0[4 * g + 2] * ilb, ob0[4 * g + 3] * ilb);
                st_bf4(orow + (size_t)32 * 512 + 32 + 8 * g + 4 * hi, ob1[4 * g] * ilb, ob1[4 * g + 1] * ilb, ob1[4 * g + 2] * ilb, ob1[4 * g + 3] * ilb);
            }
        }
    }
    xcd_barrier(xb);

    {
        PHASE_PTRS
        for (int t = gw; t < T; t += NGW) {
            const int ch = 8 * lane, h = lane >> 3;
            float y[8], v[8], g[8]; ld_bf8(Yb + (size_t)t * 512 + ch, y); ld_bf8(Vb + (size_t)t * 512 + ch, v); ld_bf8(Gtb + (size_t)t * 512 + ch, g);
            float s = 0.f;
#pragma unroll
            for (int i = 0; i < 8; ++i) s += y[i];
            s += __shfl_xor(s, 1); s += __shfl_xor(s, 2); s += __shfl_xor(s, 4);
            const float mu = s * (1.f / 64.f); float q = 0.f;
#pragma unroll
            for (int i = 0; i < 8; ++i) { y[i] -= mu; q += y[i] * y[i]; }
            q += __shfl_xor(q, 1); q += __shfl_xor(q, 2); q += __shfl_xor(q, 4);
            const float rstd = rsqrtf(q * (1.f / 64.f) + 64e-5f);
            const float bo = bonus[(size_t)t * 8 + h];
            const f32x4 lw0 = *(const f32x4*)(rw_ln_w + ch), lw1 = *(const f32x4*)(rw_ln_w + ch + 4), lb0 = *(const f32x4*)(rw_ln_b + ch), lb1 = *(const f32x4*)(rw_ln_b + ch + 4);
            float o[8];
#pragma unroll
            for (int i = 0; i < 8; ++i) { const float lw = i < 4 ? lw0[i & 3] : lw1[i & 3], lb = i < 4 ? lb0[i & 3] : lb1[i & 3]; o[i] = (y[i] * rstd * lw + lb + bo * v[i]) * g[i]; }
            *(bf16x8*)(YA + (size_t)t * 512 + ch) = pack8(o);
        }
    }
    xcd_barrier(xb);

    {
        PHASE_PTRS
        pg8::StaticOrder S; S.init(T, 1024, G, (int)blockIdx.x);
        { pg8::Gemm g{YA, RwoT, T, 1024, 512}; pg8::EpiGate E{MIXED, Gg, 0, 0};
          pg8::gemm_phase<pg8::EpiGate, pg8::StaticOrder, true, true>((PG8_LAS unsigned char*)lds, g, S, E); }
        { pg8::Gemm g{Ob, MwoT, T, 1024, 512}; pg8::EpiGate E{MIXED, Gg, 1024, 1};
          pg8::gemm_phase<pg8::EpiGate, pg8::StaticOrder, true, true>((PG8_LAS unsigned char*)lds, g, S, E); }
    }
    xcd_barrier(xb);

    {
        PHASE_PTRS
        { pg8::Gemm g{MIXED, WoutT, T, 1024, 1024}; pg8::StaticOrder S; S.init(T, 1024, G, (int)blockIdx.x);
          pg8::EpiRes E{x, kp->out, HB, ss2};
          pg8::gemm_phase<pg8::EpiRes, pg8::StaticOrder, true, true>((PG8_LAS unsigned char*)lds, g, S, E); }
        { const float* pu = kp->in[29]; const float* pv = kp->in[30];
          for (size_t i = (size_t)blockIdx.x * NT + tid; i < (size_t)16384 * 1024 / 16; i += (size_t)G * NT) {
              u32x4 uo, vo;
#pragma unroll
              for (int q = 0; q < 4; ++q) {
                  const f32x4 u = ((const f32x4*)pu)[i * 4 + q]; const f32x4 w = ((const f32x4*)norm2_w)[(i & 63) * 4 + q];
                  uo[q] = pk4_fp8(u.x * w.x * U8_SCALE, u.y * w.y * U8_SCALE, u.z * w.z * U8_SCALE, u.w * w.w * U8_SCALE);
                  const f32x4 v = ((const f32x4*)pv)[i * 4 + q]; vo[q] = pk4_fp8(v.x * V8_SCALE, v.y * V8_SCALE, v.z * V8_SCALE, v.w * V8_SCALE);
              }
              ((u32x4*)UB)[i] = uo;
              { const size_t e = i >> 6; const int d0 = (int)(i & 63) * 16; *(u32x4*)((unsigned char*)VBp + ((size_t)(d0 >> 7) * 16384 + e) * 128 + (d0 & 127)) = vo; } } }
    }
    xcd_barrier(xb);

    {
        PHASE_PTRS
        pg8::Gemm g{HB, PwqT, T, 2048, 1024}; pg8::StaticOrder S; S.init(T, 2048, G, (int)blockIdx.x);
        pg8::EpiScale E{SC, ss2};
        pg8::gemm_phase<pg8::EpiScale, pg8::StaticOrder, true, true>((PG8_LAS unsigned char*)lds, g, S, E);
    }
    xcd_barrier(xb);

    {
        PHASE_PTRS
        const int wp = wave & 3; const bool producer = wave < 4;
        volatile LAS unsigned* pc = (volatile LAS unsigned*)((LAS unsigned char*)lds + LDS_BYTES - 128) + 2 * wp;
        int kq = 0;
        for (int t = blockIdx.x * 4 + wp; t < T; t += G * 4, ++kq) {
            LAS unsigned char* wl = (LAS unsigned char*)lds + wp * 4096 + (kq & 1) * 2048;
            LAS u32x2* tab = (LAS u32x2*)wl;
            const float rs = rsqrtf(ss2[t] * (1.f / DM) + EPS);
            if (producer) {
            if (kq >= 2) { while ((int)pc[1] < kq - 1) __builtin_amdgcn_s_sleep(2); }
            asm volatile("" ::: "memory");
            { float xa[8], xb[8]; ld_bf8(HB + (size_t)t * DM + 16 * lane, xa); ld_bf8(HB + (size_t)t * DM + 16 * lane + 8, xb);
              u32x4 w; w.x = pk4_fp8(xa[0], xa[1], xa[2], xa[3]); w.y = pk4_fp8(xa[4], xa[5], xa[6], xa[7]); w.z = pk4_fp8(xb[0], xb[1], xb[2], xb[3]); w.w = pk4_fp8(xb[4], xb[5], xb[6], xb[7]);
              *(LAS u32x4*)(wl + 1024 + lane * 16) = w; }
#define SORT4(k) { unsigned hi_, lo_; \
                    hi_ = umax2(k[0], k[1]); lo_ = k[0] < k[1] ? k[0] : k[1]; k[0] = hi_; k[1] = lo_; hi_ = umax2(k[2], k[3]); lo_ = k[2] < k[3] ? k[2] : k[3]; k[2] = hi_; k[3] = lo_; \
                    hi_ = umax2(k[0], k[2]); lo_ = k[0] < k[2] ? k[0] : k[2]; k[0] = hi_; k[2] = lo_; hi_ = umax2(k[1], k[3]); lo_ = k[1] < k[3] ? k[1] : k[3]; k[1] = hi_; k[3] = lo_; \
                    hi_ = umax2(k[1], k[2]); lo_ = k[1] < k[2] ? k[1] : k[2]; k[1] = hi_; k[2] = lo_; }
#pragma unroll 1
            for (int hg = 0; hg < 8; hg += 4) {
                unsigned key[4][4], top[4];
#pragma unroll
                for (int q = 0; q < 4; ++q) {
                    const u32x2 w = *(const u32x2*)(SC + (size_t)t * 2048 + (hg + q) * 256 + 4 * lane);
                    const float f[4] = {bflo(w.x), bfhi(w.x), bflo(w.y), bfhi(w.y)};
#pragma unroll
                    for (int c = 0; c < 4; ++c) { unsigned u = __float_as_uint(f[c]); u = (u & 0x80000000u) ? ~u : (u | 0x80000000u); key[q][c] = (u & ~127u) | (unsigned)(127 - (4 * (lane & 31) + c)); }
                    SORT4(key[q])
                    top[q] = 0u;
                }
#pragma unroll 1
                for (int r = 0; r < 16; ++r) {
                    const bool isr = (lane & 31) == r;
#pragma unroll
                    for (int q = 0; q < 4; ++q) {
                        unsigned m = umax16(key[q][0]);
                        { const auto rr = __builtin_amdgcn_permlane16_swap(m, m, false, false); m = umax2(rr[0], rr[1]); }
                        const bool win = key[q][0] == m;
                        key[q][0] = win ? key[q][1] : key[q][0]; key[q][1] = win ? key[q][2] : key[q][1]; key[q][2] = win ? key[q][3] : key[q][2]; key[q][3] = win ? 0u : key[q][3];
                        top[q] = isr ? m : top[q];
                    }
                }
                unsigned ck[4][4], best[4];
#pragma unroll
                for (int q = 0; q < 4; ++q) {
                    float sval; { unsigned u = top[q] & ~127u; u = (u & 0x80000000u) ? (u & 0x7fffffffu) : ~u; sval = __uint_as_float(u); }
                    const float a = __shfl(sval, lane >> 2);
#pragma unroll
                    for (int c = 0; c < 4; ++c) { const float bsc = __shfl(sval, 32 + 4 * (lane & 3) + c); unsigned u = __float_as_uint(a + bsc); u = (u & 0x80000000u) ? ~u : (u | 0x80000000u);
                        ck[q][c] = (u & ~255u) | (unsigned)(255 - ((lane >> 2) * 16 + 4 * (lane & 3) + c)); }
                    SORT4(ck[q])
                    best[q] = 0u;
                }
#pragma unroll 1
                for (int r = 0; r < 16; ++r) {
                    const bool isr = lane == r;
#pragma unroll
                    for (int q = 0; q < 4; ++q) {
                        unsigned m = umax16(ck[q][0]);
                        { const auto rr = __builtin_amdgcn_permlane16_swap(m, m, false, false); m = umax2(rr[0], rr[1]); }
                        { const auto rr = __builtin_amdgcn_permlane32_swap(m, m, false, false); m = umax2(rr[0], rr[1]); }
                        const bool win = ck[q][0] == m;
                        ck[q][0] = win ? ck[q][1] : ck[q][0]; ck[q][1] = win ? ck[q][2] : ck[q][1]; ck[q][2] = win ? ck[q][3] : ck[q][2]; ck[q][3] = win ? 0u : ck[q][3];
                        best[q] = isr ? m : best[q];
                    }
                }
#pragma unroll
                for (int q = 0; q < 4; ++q) {
                    float bs; { unsigned u = best[q] & ~255u; u = (u & 0x80000000u) ? (u & 0x7fffffffu) : ~u; bs = __uint_as_float(u); }
                    const int pos = 255 - (int)(best[q] & 255u);
                    const float bmax = __uint_as_float(rdlane(__float_as_uint(bs), 0));
                    const float e = lane < 16 ? __expf(bs - bmax) : 0.f;
                    const float gate = e / sum16(e);
                    const unsigned t1 = (unsigned)__shfl((int)top[q], (pos >> 4) & 15), t2 = (unsigned)__shfl((int)top[q], 32 + (pos & 15));
                    const unsigned eid = (127u - (t1 & 127u)) * 128u + (127u - (t2 & 127u));
                    if (lane < 16) tab[16 * (hg + q) + lane] = (u32x2){eid, __float_as_uint(gate)};
                }
            }
#undef SORT4
            asm volatile("s_waitcnt lgkmcnt(0)" ::: "memory");
            if (lane == 0) pc[0] = (unsigned)(kq + 1);
            } else {
            while ((int)pc[0] <= kq) __builtin_amdgcn_s_sleep(2);
            asm volatile("" ::: "memory");
            const unsigned char* UB8 = (const unsigned char*)UB; const unsigned char* VB8 = (const unsigned char*)VBp;
            u32x4 ua[16];
            { const unsigned char* up = UB8 + (size_t)tab[fr].x * DM + 16 * fq;
#pragma unroll
              for (int s = 0; s < 16; ++s) ua[s] = *(const u32x4*)(up + 64 * s); }
#pragma unroll 1
            for (int h = 0; h < 8; ++h) {
                u32x4 uc[16];
#pragma unroll
                for (int s = 0; s < 16; ++s) uc[s] = ua[s];
                { const int hn = h + 1 < 8 ? h + 1 : 7; const unsigned char* up = UB8 + (size_t)tab[16 * hn + fr].x * DM + 16 * fq;
#pragma unroll
                  for (int s = 0; s < 16; ++s) ua[s] = *(const u32x4*)(up + 64 * s); }
                f32x4 ac0 = (f32x4){0.f, 0.f, 0.f, 0.f}, ac1 = ac0, ac2 = ac0, ac3 = ac0;
#pragma unroll
                for (int s = 0; s < 16; s += 2) {
                    const u32x4 b0 = *(const LAS u32x4*)(wl + 1024 + 64 * s + 16 * fq), b1 = *(const LAS u32x4*)(wl + 1024 + 64 * (s + 1) + 16 * fq);
                    ac0 = mfma16_fp8((u32x2){uc[s].x, uc[s].y}, (u32x2){b0.x, b0.y}, ac0);
                    ac1 = mfma16_fp8((u32x2){uc[s].z, uc[s].w}, (u32x2){b0.z, b0.w}, ac1);
                    ac2 = mfma16_fp8((u32x2){uc[s + 1].x, uc[s + 1].y}, (u32x2){b1.x, b1.y}, ac2);
                    ac3 = mfma16_fp8((u32x2){uc[s + 1].z, uc[s + 1].w}, (u32x2){b1.z, b1.w}, ac3);
                }
                const f32x4 acc = (ac0 + ac1) + (ac2 + ac3);
                const int j = fr & 3;
                const float d = (j == 0 ? acc[0] : (j == 1 ? acc[1] : (j == 2 ? acc[2] : acc[3]))) * (rs * (1.f / U8_SCALE));
                const float act = 0.5f * d * (1.f + erff(d * 0.7071067811865476f));
                if (fr < 4) { const int i = 16 * h + 4 * fq + fr; const float g = __uint_as_float(tab[i].y); tab[i].y = __float_as_uint(g * act * (1.f / V8_SCALE)); }
            }
            asm volatile("s_waitcnt lgkmcnt(0)" ::: "memory");
            { const u32x4 tv = *(const LAS u32x4*)(wl + lane * 16); *(u32x4*)(ws + WS_TAB + (size_t)t * 1024 + lane * 16) = tv; }
            asm volatile("s_waitcnt lgkmcnt(0)" ::: "memory");
            if (lane == 0) pc[1] = (unsigned)(kq + 1);
            }
        }
    }
    xcd_barrier(xb);

    {
        PHASE_PTRS
        const unsigned sl = blockIdx.x & 7;
        const unsigned char* VS = (const unsigned char*)VBp + (size_t)sl * 16384 * 128;
        const int rho = lane >> 3, chi = lane & 7;
        constexpr float CSCALE = 256.f;
        LAS unsigned char* wl8 = (LAS unsigned char*)lds + wave * 4096;
        unsigned selLo[4], selHi[4];
#pragma unroll
        for (int k = 0; k < 4; ++k) { const unsigned sh = 8u * (unsigned)(chi & 3); const unsigned v = (0x0c0c0c0cu & ~(0xffu << sh)) | ((unsigned)k << sh);
            selLo[k] = chi < 4 ? v : 0x0c0c0c0cu; selHi[k] = chi < 4 ? 0x0c0c0c0cu : v; }
        const bool olane = (lane & 0x28) == 0;
        const unsigned voff0 = 16u * (unsigned)chi;
        for (int tg = (blockIdx.x >> 3) * NWAVES + wave; tg < T / 8; tg += (G >> 3) * NWAVES) {
            const int t0 = tg * 8;
#pragma unroll
            for (int q = 0; q < 8; ++q) {
                const u32x4 tv = *(const u32x4*)(ws + WS_TAB + (size_t)(t0 + q) * 1024 + lane * 16);
                LAS unsigned char* tq = wl8 + q * 384; const int r0 = 2 * (lane & 3), l0 = lane >> 2;
                *(LAS unsigned short*)(tq + (r0 * 16 + l0) * 2) = (unsigned short)tv.x; *(LAS unsigned short*)(tq + ((r0 + 1) * 16 + l0) * 2) = (unsigned short)tv.z;
                const float c0 = fminf(fmaxf(__uint_as_float(tv.y) * CSCALE, -440.f), 440.f), c1 = fminf(fmaxf(__uint_as_float(tv.w) * CSCALE, -440.f), 440.f);
                const unsigned c8 = (unsigned)__builtin_amdgcn_cvt_pk_fp8_f32(c0, c1, 0, false);
                *(tq + 256 + r0 * 16 + l0) = (unsigned char)(c8 & 0xffu); *(tq + 256 + (r0 + 1) * 16 + l0) = (unsigned char)((c8 >> 8) & 0xffu);
            }
            asm volatile("s_waitcnt lgkmcnt(0)" ::: "memory");
            u32x4 vvA[8], vvB[8];
            u32x4 erL, erH, cw;
#define P6C_TAB(q_) { const LAS unsigned char* tq_ = wl8 + (q_) * 384; erL = *(const LAS u32x4*)(tq_ + rho * 32); erH = *(const LAS u32x4*)(tq_ + rho * 32 + 16); cw = *(const LAS u32x4*)(tq_ + 256 + rho * 16); }
#define P6C_EID(ER, j_) (((j_) & 1) ? (ER[(j_) >> 1] >> 16) : (ER[(j_) >> 1] & 0xffffu))
#define P6C_LOAD(VV, ER) { _Pragma("unroll") for (int j = 0; j < 8; ++j) VV[j] = *(const u32x4*)(VS + (size_t)((P6C_EID(ER, j) << 7) | voff0)); }
#define P6C_USE(VV, CWA, CWB) { _Pragma("unroll") for (int j = 0; j < 8; ++j) { const unsigned cwd = (j < 4) ? CWA : CWB; \
                       u32x2 xo; xo.x = __builtin_amdgcn_perm(cwd, cwd, selLo[j & 3]); xo.y = __builtin_amdgcn_perm(cwd, cwd, selHi[j & 3]); \
                       acc0 = mfma16_fp8(xo, (u32x2){VV[j].x, VV[j].y}, acc0); acc1 = mfma16_fp8(xo, (u32x2){VV[j].z, VV[j].w}, acc1); } }
            P6C_TAB(0)
            P6C_LOAD(vvA, erL)
#pragma unroll 1
            for (int q = 0; q < 8; ++q) {
                float* orow = kp->out + (size_t)(t0 + q) * DM + 128 * sl + 16 * chi + 4 * ((lane >> 4) & 1);
                f32x4 h0 = (f32x4){0.f, 0.f, 0.f, 0.f}, h1 = h0;
                if (olane) { h0 = *(const f32x4*)orow; h1 = *(const f32x4*)(orow + 8); }
                P6C_LOAD(vvB, erH)
                const u32x4 cwq = cw;
                __builtin_amdgcn_sched_barrier(0);
                f32x4 acc0 = (f32x4){0.f, 0.f, 0.f, 0.f}, acc1 = acc0;
                P6C_USE(vvA, cwq.x, cwq.y)
                __builtin_amdgcn_sched_barrier(0);
                { const int qn = q + 1 < 8 ? q + 1 : 7; P6C_TAB(qn) }
                P6C_LOAD(vvA, erL)
                __builtin_amdgcn_sched_barrier(0);
                P6C_USE(vvB, cwq.z, cwq.w)
                float s[8];
#pragma unroll
                for (int r = 0; r < 4; ++r) {
                    { const auto rr = __builtin_amdgcn_permlane32_swap(__float_as_uint(acc0[r]), __float_as_uint(acc0[r]), false, false); s[r] = acc0[r] + dpp_f<0x128>(__uint_as_float(rr[1])); }
                    { const auto rr = __builtin_amdgcn_permlane32_swap(__float_as_uint(acc1[r]), __float_as_uint(acc1[r]), false, false); s[4 + r] = acc1[r] + dpp_f<0x128>(__uint_as_float(rr[1])); }
                }
                constexpr float OSC = 1.f / CSCALE;
                if (olane) { *(f32x4*)orow = h0 + (f32x4){s[0], s[1], s[2], s[3]} * OSC; *(f32x4*)(orow + 8) = h1 + (f32x4){s[4], s[5], s[6], s[7]} * OSC; }
                __builtin_amdgcn_sched_barrier(0);
            }
#undef P6C_USE
#undef P6C_LOAD
#undef P6C_EID
#undef P6C_TAB
            asm volatile("s_waitcnt lgkmcnt(0)" ::: "memory");
        }
    }
}

extern "C" void kernel_launch(void* const* d_in, const int* in_sizes, int n_in, void* d_out, int out_size,
                              void* d_ws, size_t ws_size, hipStream_t stream) {
    static int grid_blocks = 0;
    if (!grid_blocks) {
        int dev = 0, cus = 0, per_cu = 0;
        (void)hipGetDevice(&dev);
        (void)hipDeviceGetAttribute(&cus, hipDeviceAttributeMultiprocessorCount, dev);
        (void)hipFuncSetAttribute((const void*)mega, hipFuncAttributeMaxDynamicSharedMemorySize, LDS_BYTES);
        (void)hipOccupancyMaxActiveBlocksPerMultiprocessor(&per_cu, (const void*)mega, NT, LDS_BYTES);
        if (per_cu < 1) per_cu = 1;
        if (per_cu > 1) per_cu = 1;
        grid_blocks = cus * per_cu;
        if (ws_size < 256 * MiB) fprintf(stderr, "kernel_launch: workspace too small: %zu\n", ws_size);
    }
    Params p{};
    for (int i = 0; i < 31; ++i) p.in[i] = (const float*)d_in[i];
    p.out = (float*)d_out;
    p.ws = (unsigned char*)d_ws;
    void* args[] = {&p};
    hipError_t e = hipLaunchCooperativeKernel((const void*)mega, dim3(grid_blocks), dim3(NT), args, LDS_BYTES, stream);
    if (e != hipSuccess) fprintf(stderr, "cooperative launch failed: %s (grid %d)\n", hipGetErrorString(e), grid_blocks);
}
```

```cpp
#include <hip/hip_runtime.h>
#include <hip/hip_cooperative_groups.h>
#include <cstdio>
#include <cstdint>
namespace cg = cooperative_groups;

#define DEVI __device__ __forceinline__
typedef unsigned short bf16_t;
typedef short bf16x8 __attribute__((ext_vector_type(8)));
typedef float f32x4 __attribute__((ext_vector_type(4)));
typedef float f32x16 __attribute__((ext_vector_type(16)));
typedef unsigned u32x2 __attribute__((ext_vector_type(2)));
typedef unsigned u32x4 __attribute__((ext_vector_type(4)));

constexpr int T = 16384, SEQ = 4096, DM = 1024;
constexpr int NWAVES = 8, NT = 512;
constexpr int LDS_BYTES = 147456;
constexpr float EPS = 1e-6f;
constexpr float LOG2E = 1.4426950408889634f;
constexpr float QSCALE = 0.10206207261596575f * 1.4426950408889634f;

constexpr size_t MiB = 1u << 20;
constexpr size_t WS_SS2 = 0;
constexpr size_t WS_CNT = 512 * 1024;
constexpr size_t WS_SSQ = 64 * 1024, WS_SSKV = 128 * 1024;
constexpr size_t WS_WIN = 1 * MiB;
constexpr size_t WS_WUQ = 10 * MiB + 512 * 1024;
constexpr size_t WS_WUKV = 11 * MiB + 256 * 1024;
constexpr size_t WS_RWO = 12 * MiB;
constexpr size_t WS_MWO = 13 * MiB;
constexpr size_t WS_WOUT = 14 * MiB;
constexpr size_t WS_PWQ = 16 * MiB;
constexpr size_t WS_SUBK = 20 * MiB;
constexpr size_t WS_W2T = 20 * MiB + 512 * 1024;
constexpr size_t WS_A2T = WS_W2T + 64 * 1024;
constexpr size_t WS_G2T = WS_A2T + 64 * 1024;
constexpr size_t WS_G = 24 * MiB;
constexpr size_t WS_UB = 56 * MiB, WS_VB = 72 * MiB;
constexpr size_t WS_SC = 176 * MiB;
constexpr size_t WS_PRW = 88 * MiB;
constexpr size_t WS_Q = 88 * MiB, WS_K = 112 * MiB, WS_VT = 136 * MiB;
constexpr size_t WS_HB = 88 * MiB;
constexpr size_t WS_QD = 152 * MiB, WS_KVD = 164 * MiB, WS_KPE = 172 * MiB;
constexpr size_t WS_O = 152 * MiB;
constexpr size_t WS_R = 176 * MiB, WS_W = 192 * MiB, WS_KS = 208 * MiB, WS_V = 224 * MiB, WS_KK = 240 * MiB;
constexpr size_t WS_YA = 176 * MiB;
constexpr size_t WS_MIXED = 192 * MiB;
constexpr size_t WS_PQ = 184 * MiB;
constexpr size_t WS_TAB = 240 * MiB;
constexpr size_t DO_XN = 0;
constexpr size_t DO_BV = 0, DO_GT = 16 * MiB, DO_BONUS = 32 * MiB, DO_Y = 33 * MiB, DO_KRAW = 33 * MiB, DO_GL = 50 * MiB;

struct Params {
    const float* in[31];
    float* out;
    unsigned char* ws;
};

DEVI unsigned f2bf(float f) { unsigned u = __float_as_uint(f); return (u + 0x7fffu + ((u >> 16) & 1u)) >> 16; }
typedef float f32x2_t __attribute__((ext_vector_type(2)));
typedef __bf16 bf16x2_t __attribute__((ext_vector_type(2)));
DEVI unsigned pk2(float lo, float hi) { f32x2_t v = {lo, hi}; bf16x2_t b = __builtin_convertvector(v, bf16x2_t); return __builtin_bit_cast(unsigned, b); }
DEVI float bflo(unsigned u) { return __uint_as_float(u << 16); }
DEVI float bfhi(unsigned u) { return __uint_as_float(u & 0xffff0000u); }
DEVI float bf1(bf16_t u) { return __uint_as_float(((unsigned)u) << 16); }
DEVI float wave_sum(float v) {
#pragma unroll
    for (int o = 32; o >= 1; o >>= 1) v += __shfl_xor(v, o);
    return v;
}
DEVI float sigmoidf_(float x) { return __builtin_amdgcn_rcpf(1.f + __builtin_amdgcn_exp2f(-1.4426950408889634f * x)); }
DEVI float tanhf_(float x) { return 1.f - 2.f * __builtin_amdgcn_rcpf(__builtin_amdgcn_exp2f(2.885390081777927f * x) + 1.f); }
DEVI void st_bf4(bf16_t* p, float a, float b, float c, float d) { u32x2 w; w.x = pk2(a, b); w.y = pk2(c, d); *(u32x2*)p = w; }
DEVI void ld_bf4(const bf16_t* p, float (&o)[4]) { u32x2 w = *(const u32x2*)p; o[0] = bflo(w.x); o[1] = bfhi(w.x); o[2] = bflo(w.y); o[3] = bfhi(w.y); }
DEVI void ld_bf8(const bf16_t* p, float (&o)[8]) { u32x4 w = *(const u32x4*)p; o[0] = bflo(w.x); o[1] = bfhi(w.x); o[2] = bflo(w.y); o[3] = bfhi(w.y); o[4] = bflo(w.z); o[5] = bfhi(w.z); o[6] = bflo(w.w); o[7] = bfhi(w.w); }
DEVI bf16x8 pack8(const float (&v)[8]) { u32x4 w; w.x = pk2(v[0], v[1]); w.y = pk2(v[2], v[3]); w.z = pk2(v[4], v[5]); w.w = pk2(v[6], v[7]); return __builtin_bit_cast(bf16x8, w); }
DEVI f32x4 mfma16(bf16x8 a, bf16x8 b, f32x4 c) { return __builtin_amdgcn_mfma_f32_16x16x32_bf16(a, b, c, 0, 0, 0); }
DEVI f32x16 mfma32(bf16x8 a, bf16x8 b, f32x16 c) { return __builtin_amdgcn_mfma_f32_32x32x16_bf16(a, b, c, 0, 0, 0); }
DEVI int crow(int r, int hi) { return (r & 3) + 8 * (r >> 2) + 4 * hi; }


template <int CTRL> DEVI float dpp_f(float v) { return __builtin_bit_cast(float, __builtin_amdgcn_update_dpp(0, __builtin_bit_cast(int, v), CTRL, 0xf, 0xf, true)); }
template <int CTRL> DEVI unsigned dpp_u(unsigned v) { return (unsigned)__builtin_amdgcn_update_dpp(0, (int)v, CTRL, 0xf, 0xf, true); }
DEVI float sum8(float v) { v += dpp_f<0xB1>(v); v += dpp_f<0x4E>(v); v += dpp_f<0x141>(v); return v; }
DEVI float sum16(float v) { v = sum8(v); v += dpp_f<0x140>(v); return v; }
DEVI unsigned umax2(unsigned a, unsigned b) { return a > b ? a : b; }
DEVI unsigned umax16(unsigned v) { v = umax2(v, dpp_u<0xB1>(v)); v = umax2(v, dpp_u<0x4E>(v)); v = umax2(v, dpp_u<0x141>(v)); v = umax2(v, dpp_u<0x140>(v)); return v; }
DEVI unsigned rdlane(unsigned v, int l) { return (unsigned)__builtin_amdgcn_readlane((int)v, l); }
#define LAS __attribute__((address_space(3)))

DEVI unsigned pk4_fp8(float a, float b, float c, float d) { int w = 0; w = __builtin_amdgcn_cvt_pk_fp8_f32(a, b, w, false); w = __builtin_amdgcn_cvt_pk_fp8_f32(c, d, w, true); return (unsigned)w; }
DEVI f32x4 mfma16_fp8(u32x2 a, u32x2 b, f32x4 c) { return __builtin_amdgcn_mfma_f32_16x16x32_fp8_fp8(__builtin_bit_cast(long, a), __builtin_bit_cast(long, b), c, 0, 0, 0); }
DEVI unsigned pk4_u8(float a, float b, float c, float d) { unsigned w = 0; w = __builtin_amdgcn_cvt_pk_u8_f32(a, 0, w); w = __builtin_amdgcn_cvt_pk_u8_f32(b, 1, w); w = __builtin_amdgcn_cvt_pk_u8_f32(c, 2, w); w = __builtin_amdgcn_cvt_pk_u8_f32(d, 3, w); return w; }
constexpr float U8_SCALE = 32.f, V8_SCALE = 4.f;

template <int OFF> DEVI f32x4 lds_rd128(unsigned a) { f32x4 r; asm volatile("ds_read_b128 %0, %1 offset:%2" : "=v"(r) : "v"(a), "i"(OFF)); return r; }
template <int OFF> DEVI float lds_rd32(unsigned a) { float r; asm volatile("ds_read_b32 %0, %1 offset:%2" : "=v"(r) : "v"(a), "i"(OFF)); return r; }
DEVI void lds_wr32(unsigned a, float v) { asm volatile("ds_write_b32 %0, %1" ::"v"(a), "v"(v) : "memory"); }

#define SW64(r, k) ((r) * 64 + (((((k) >> 3) ^ ((r) & 7))) << 3) + ((k) & 7))
#define SW32(r, c) ((r) * 32 + (((((c) >> 3) ^ (((r) >> 2) & 3))) << 3) + ((c) & 7))
DEVI int swz_off(int r, int chunk, int ld) { return ld == 64 ? r * 64 + ((chunk ^ (r & 7)) << 3) : r * 32 + ((chunk ^ ((r >> 2) & 3)) << 3); }
template <int MT, int NTL, int KS>
DEVI void gemm_lds(const LAS bf16_t* A, int lda, const LAS bf16_t* B, int ldb, f32x4 (&acc)[MT][NTL], int fr, int fq) {
#pragma unroll
    for (int ks = 0; ks < KS; ++ks) {
        bf16x8 a[MT], b[NTL];
#pragma unroll
        for (int m = 0; m < MT; ++m) a[m] = *(const LAS bf16x8*)(A + swz_off(16 * m + fr, 4 * ks + fq, lda));
#pragma unroll
        for (int n = 0; n < NTL; ++n) b[n] = *(const LAS bf16x8*)(B + swz_off(16 * n + fr, 4 * ks + fq, ldb));
#pragma unroll
        for (int m = 0; m < MT; ++m)
#pragma unroll
            for (int n = 0; n < NTL; ++n) acc[m][n] = mfma16(b[n], a[m], acc[m][n]);
    }
}
DEVI bf16_t bf1of(float x) { return (bf16_t)(pk2(x, x) & 0xffffu); }
DEVI void gemm_tile_acc(const bf16_t* __restrict__ A, int lda, const bf16_t* __restrict__ Bt, int ldb, int K, int m0, int n0, int lane, f32x4 (&acc)[4][4]) {
    const int fr = lane & 15, fq = lane >> 4;
    const bf16_t* ap = A + (size_t)(m0 + fr) * lda + fq * 8;
    const bf16_t* bp = Bt + (size_t)(n0 + fr) * ldb + fq * 8;
#pragma unroll 2
    for (int k0 = 0; k0 < K; k0 += 32) {
        bf16x8 a[4], b[4];
#pragma unroll
        for (int m = 0; m < 4; ++m) a[m] = *(const bf16x8*)(ap + (size_t)m * 16 * lda + k0);
#pragma unroll
        for (int n = 0; n < 4; ++n) b[n] = *(const bf16x8*)(bp + (size_t)n * 16 * ldb + k0);
#pragma unroll
        for (int m = 0; m < 4; ++m)
#pragma unroll
            for (int n = 0; n < 4; ++n) acc[m][n] = mfma16(b[n], a[m], acc[m][n]);
    }
}
DEVI void zero_acc(f32x4 (&acc)[4][4]) {
#pragma unroll
    for (int m = 0; m < 4; ++m)
#pragma unroll
        for (int n = 0; n < 4; ++n) acc[m][n] = (f32x4){0.f, 0.f, 0.f, 0.f};
}


namespace pg8 {
#define PG8_LAS __attribute__((address_space(3)))
typedef unsigned short bf16_t;
typedef short bf16x8 __attribute__((ext_vector_type(8)));
typedef float f32x4 __attribute__((ext_vector_type(4)));
typedef unsigned u32x4 __attribute__((ext_vector_type(4)));
constexpr int BM = 256, BK = 64, HALF = 128, HTB = HALF * BK * 2  , STAGE_BYTES = 8 * HTB, NXCD = 8, WGM = 8;

__host__ __device__ __forceinline__ int lds_byte(int r, int c) { const int st = (r >> 4) * 2 + (c >> 5), rr = r & 15, cc = c & 31, ob = rr * 64 + cc * 2; return st * 1024 + (ob ^ (((ob >> 9) & 1) << 5)); }
__host__ __device__ __forceinline__ void stage_rc(int b, int& R, int& C) { const int st = b / 1024, sb = b % 1024, swz = sb ^ (((sb >> 9) & 1) << 5); R = (st >> 1) * 16 + swz / 64; C = (st & 1) * 32 + (swz % 64) / 2; }
__host__ __device__ __forceinline__ int perm32(int rho) { const int n = rho >> 4, i = rho & 15; return 8 * (i >> 2) + 4 * n + (i & 3); }

struct Unit { int pm, pn; };
struct Gemm { const bf16_t* A; const bf16_t* Bt; int M, N, K; };

struct StaticOrder {
    int nM, nN, nwg, G, c;
    __host__ __device__ void init(int M, int N, int G_, int c_) { nM = M / BM; nN = N / BM; nwg = nM * nN; G = G_; c = c_; }
    __host__ __device__ bool next(int i, Unit& u) const {
        const long L = (long)i * G + c; if (L >= nwg) return false;
        int wgid = (int)L; { const int q = nwg / NXCD, r = nwg % NXCD, xcd = wgid % NXCD, off = wgid / NXCD; wgid = (xcd < r ? xcd * (q + 1) : r * (q + 1) + (xcd - r) * q) + off; }
        const int nig = WGM * nN, gid = wgid / nig, fm = gid * WGM, gsz = (nM - fm) < WGM ? (nM - fm) : WGM;
        u.pm = fm + ((wgid % nig) % gsz); u.pn = (wgid % nig) / gsz; return true;
    }
    __device__ __forceinline__ void a_ready(const Unit&) const {}
    __device__ __forceinline__ void done(const Unit&) const {}
};


DEVI float sigm(float x) { return __builtin_amdgcn_rcpf(1.f + __builtin_amdgcn_exp2f(-1.4426950408889634f * x)); }
DEVI u32x4 pack8v(f32x4 a, f32x4 b) { u32x4 w; w.x = pk2(a[0], a[1]); w.y = pk2(a[2], a[3]); w.z = pk2(b[0], b[1]); w.w = pk2(b[2], b[3]); return w; }
struct EpiP1 {
    static constexpr bool PERM = true, AFTER_DRAIN = false;
    unsigned char* ws;
    __device__ __forceinline__ void operator()(const f32x4 (&acc)[2][2][4][2], const Unit& u, int wr, int wc, int fr_in, int fq_in) const {
        int fr = fr_in, fq = fq_in; asm volatile("" : "+v"(fr), "+v"(fq));
        const int row0 = u.pm * BM + wr * 64 + fr;
        if (u.pn >= 8 && u.pn < 11) {
#pragma unroll
            for (int bj = 0; bj < 2; ++bj) {
                const int c = (u.pn - 8) * 256 + bj * HALF + wc * 32 + 8 * fq;
                const size_t off = c < 384 ? WS_QD : (c < 640 ? WS_KVD : WS_KPE);
                const int ld = c < 384 ? 384 : (c < 640 ? 256 : 32), cc = c < 384 ? c : (c < 640 ? c - 384 : c - 640);
                if (c < 672) {
#pragma unroll
                    for (int ai = 0; ai < 2; ++ai)
#pragma unroll
                        for (int m = 0; m < 4; ++m) { const size_t row = (size_t)(row0 + ai * HALF + m * 16);
                            *(u32x4*)(ws + off + (row * ld + cc) * 2) = pack8v(acc[ai][bj][m][0], acc[ai][bj][m][1]); }
                }
            }
            return;
        }
        if (u.pn >= 11) {
            const int col0 = (u.pn - 11) * 256 + wc * 32 + 8 * fq;
#pragma unroll
            for (int ai = 0; ai < 2; ++ai)
#pragma unroll
                for (int m = 0; m < 4; ++m) { unsigned char* rowp = ws + WS_G + ((size_t)(row0 + ai * HALF + m * 16) * 2048 + col0);
#pragma unroll
                    for (int bj = 0; bj < 2; ++bj) { const f32x4 v0 = acc[ai][bj][m][0], v1 = acc[ai][bj][m][1];
                        u32x2 w; w.x = pk4_u8(sigm(v0[0]) * 255.f, sigm(v0[1]) * 255.f, sigm(v0[2]) * 255.f, sigm(v0[3]) * 255.f);
                        w.y = pk4_u8(sigm(v1[0]) * 255.f, sigm(v1[1]) * 255.f, sigm(v1[2]) * 255.f, sigm(v1[3]) * 255.f);
                        *(u32x2*)(rowp + bj * HALF) = w; } }
            return;
        }
        const int col0 = u.pn * 256 + wc * 32 + 8 * fq;
#pragma unroll
        for (int ai = 0; ai < 2; ++ai)
#pragma unroll
            for (int m = 0; m < 4; ++m) { unsigned char* rowp = ws + WS_PRW + ((size_t)(row0 + ai * HALF + m * 16) * 2048 + col0) * 2;
#pragma unroll
                for (int bj = 0; bj < 2; ++bj) *(u32x4*)(rowp + bj * HALF * 2) = pack8v(acc[ai][bj][m][0], acc[ai][bj][m][1]); }
    }
};
struct EpiQraw {
    static constexpr bool PERM = true, AFTER_DRAIN = false;
    bf16_t* q; const float* ssq;
    __device__ __forceinline__ void operator()(const f32x4 (&acc)[2][2][4][2], const Unit& u, int wr, int wc, int fr_in, int fq_in) const {
        int fr = fr_in, fq = fq_in; asm volatile("" : "+v"(fr), "+v"(fq));
        const int row0 = u.pm * BM + wr * 64 + fr, col0 = u.pn * BM + wc * 32 + 8 * fq;
#pragma unroll
        for (int ai = 0; ai < 2; ++ai)
#pragma unroll
            for (int m = 0; m < 4; ++m) { const size_t row = (size_t)(row0 + ai * HALF + m * 16); const float rs = ssq[row];
#pragma unroll
                for (int bj = 0; bj < 2; ++bj) *(u32x4*)(q + row * 768 + col0 + bj * HALF) = pack8v(acc[ai][bj][m][0] * rs, acc[ai][bj][m][1] * rs); }
    }
};
struct EpiKVraw {
    static constexpr bool PERM = true, AFTER_DRAIN = false;
    bf16_t* kraw; bf16_t* vt; const float* sskv;
    __device__ __forceinline__ void operator()(const f32x4 (&acc)[2][2][4][2], const Unit& u, int wr, int wc, int fr_in, int fq_in) const {
        int fr = fr_in, fq = fq_in; asm volatile("" : "+v"(fr), "+v"(fq));
        const int row0 = u.pm * BM + wr * 64 + fr;
#pragma unroll
        for (int ai = 0; ai < 2; ++ai)
#pragma unroll
            for (int m = 0; m < 4; ++m) { const int row = row0 + ai * HALF + m * 16; const float rs = sskv[row];
#pragma unroll
                for (int bj = 0; bj < 2; ++bj) { const f32x4 v0 = acc[ai][bj][m][0] * rs, v1 = acc[ai][bj][m][1] * rs;
                    if (u.pn < 2) *(u32x4*)(kraw + (size_t)row * 512 + u.pn * BM + bj * HALF + wc * 32 + 8 * fq) = pack8v(v0, v1);
                    else { const int c = (u.pn - 2) * BM + bj * HALF + wc * 32 + 8 * fq, h = c >> 6, d = c & 63; const int bb = row >> 12, s = row & 4095;
                        const int kt = s >> 5, k4 = s & 15, jj = 4 * (k4 >> 3) + (k4 & 3), hv = (k4 >> 2) & 1;
                        bf16_t* vp = vt + ((((size_t)(bb * 8 + h) * 128 + kt) * 2 + (d >> 5)) * 2 + ((s >> 4) & 1)) * 512 + ((d & 31) + 32 * hv) * 8 + jj; const u32x4 w = pack8v(v0, v1);
                        vp[0] = (bf16_t)(w.x & 0xffffu); vp[8] = (bf16_t)(w.x >> 16); vp[16] = (bf16_t)(w.y & 0xffffu); vp[24] = (bf16_t)(w.y >> 16);
                        vp[32] = (bf16_t)(w.z & 0xffffu); vp[40] = (bf16_t)(w.z >> 16); vp[48] = (bf16_t)(w.w & 0xffffu); vp[56] = (bf16_t)(w.w >> 16); } } }
    }
};
struct EpiGate {
    static constexpr bool PERM = true, AFTER_DRAIN = false;
    bf16_t* mixed; const unsigned char* gg; int goff; int add;
    __device__ __forceinline__ void operator()(const f32x4 (&acc)[2][2][4][2], const Unit& u, int wr, int wc, int fr_in, int fq_in) const {
        int fr = fr_in, fq = fq_in; asm volatile("" : "+v"(fr), "+v"(fq));
        const int row0 = u.pm * BM + wr * 64 + fr, col0 = u.pn * BM + wc * 32 + 8 * fq;
#pragma unroll
        for (int ai = 0; ai < 2; ++ai)
#pragma unroll
            for (int m = 0; m < 4; ++m) { const size_t row = (size_t)(row0 + ai * HALF + m * 16);
#pragma unroll
                for (int bj = 0; bj < 2; ++bj) { const int col = col0 + bj * HALF;
                    const u32x2 gw = *(const u32x2*)(gg + row * 2048 + goff + col);
                    const f32x4 g0 = (f32x4){(float)(gw.x & 0xffu), (float)((gw.x >> 8) & 0xffu), (float)((gw.x >> 16) & 0xffu), (float)(gw.x >> 24)};
                    const f32x4 g1 = (f32x4){(float)(gw.y & 0xffu), (float)((gw.y >> 8) & 0xffu), (float)((gw.y >> 16) & 0xffu), (float)(gw.y >> 24)};
                    f32x4 v0 = g0 * (acc[ai][bj][m][0] * (1.f / 255.f)), v1 = g1 * (acc[ai][bj][m][1] * (1.f / 255.f));
                    if (add) { const u32x4 pw = *(const u32x4*)(mixed + row * 1024 + col);
                        v0 += (f32x4){__uint_as_float(pw.x << 16), __uint_as_float(pw.x & 0xffff0000u), __uint_as_float(pw.y << 16), __uint_as_float(pw.y & 0xffff0000u)};
                        v1 += (f32x4){__uint_as_float(pw.z << 16), __uint_as_float(pw.z & 0xffff0000u), __uint_as_float(pw.w << 16), __uint_as_float(pw.w & 0xffff0000u)}; }
                    *(u32x4*)(mixed + row * 1024 + col) = pack8v(v0, v1); } }
    }
};
struct EpiRes {
    static constexpr bool PERM = true, AFTER_DRAIN = false;
    const float* x; float* out; bf16_t* hb; float* ss2;
    __device__ __forceinline__ void operator()(const f32x4 (&acc)[2][2][4][2], const Unit& u, int wr, int wc, int fr_in, int fq_in) const {
        int fr = fr_in, fq = fq_in; asm volatile("" : "+v"(fr), "+v"(fq));
        const int row0 = u.pm * BM + wr * 64 + fr, col0 = u.pn * BM + wc * 32 + 8 * fq;
#pragma unroll
        for (int ai = 0; ai < 2; ++ai)
#pragma unroll
            for (int m = 0; m < 4; ++m) { const size_t row = (size_t)(row0 + ai * HALF + m * 16); float sq = 0.f;
#pragma unroll
                for (int bj = 0; bj < 2; ++bj) { const size_t o = row * 1024 + col0 + bj * HALF;
                    const f32x4 h0 = *(const f32x4*)(x + o) + acc[ai][bj][m][0], h1 = *(const f32x4*)(x + o + 4) + acc[ai][bj][m][1];
                    *(f32x4*)(out + o) = h0; *(f32x4*)(out + o + 4) = h1; *(u32x4*)(hb + o) = pack8v(h0, h1);
                    sq += (h0[0] * h0[0] + h0[1] * h0[1]) + (h0[2] * h0[2] + h0[3] * h0[3]) + (h1[0] * h1[0] + h1[1] * h1[1]) + (h1[2] * h1[2] + h1[3] * h1[3]); }
                sq += __shfl_xor(sq, 16); sq += __shfl_xor(sq, 32);
                if (fq == 0) atomicAdd(ss2 + row, sq); }
    }
};
struct EpiScale {
    static constexpr bool PERM = true, AFTER_DRAIN = false;
    bf16_t* pq; const float* ss2;
    __device__ __forceinline__ void operator()(const f32x4 (&acc)[2][2][4][2], const Unit& u, int wr, int wc, int fr_in, int fq_in) const {
        int fr = fr_in, fq = fq_in; asm volatile("" : "+v"(fr), "+v"(fq));
        const int row0 = u.pm * BM + wr * 64 + fr, col0 = u.pn * BM + wc * 32 + 8 * fq;
#pragma unroll
        for (int ai = 0; ai < 2; ++ai)
#pragma unroll
            for (int m = 0; m < 4; ++m) { const size_t row = (size_t)(row0 + ai * HALF + m * 16); const float rs = rsqrtf(ss2[row] * (1.f / 1024.f) + 1e-6f);
#pragma unroll
                for (int bj = 0; bj < 2; ++bj) *(u32x4*)(pq + row * 2048 + col0 + bj * HALF) = pack8v(acc[ai][bj][m][0] * rs, acc[ai][bj][m][1] * rs); }
    }
};
template <class Epi, class Sched, bool ALIGN_EPI = false, bool SP2 = false>
__device__ __forceinline__ void gemm_phase(PG8_LAS unsigned char* lds, const Gemm g, const Sched& S, const Epi& E) {
    int tid_l = threadIdx.x; asm volatile("" : "+v"(tid_l));
    const int tid = tid_l, wid = __builtin_amdgcn_readfirstlane(tid >> 6), lane = tid & 63, wr = wid >> 2, wc = wid & 3, fr = lane & 15, fq = lane >> 4;
    const int K = g.K, nt = K / BK;
    unsigned voffA[2], voffB[2];
#pragma unroll
    for (int i = 0; i < 2; ++i) { int R, C; stage_rc(tid * 16 + i * 8192, R, C); const int Rb = Epi::PERM ? ((R & ~31) + perm32(R & 31)) : R;
        voffA[i] = (unsigned)(R * K + C) * 2u; voffB[i] = (unsigned)(Rb * K + C) * 2u; }
    const size_t kstep = (size_t)(BK * 2);
    const size_t hstep = (size_t)HALF * K * 2;
    const size_t tstep = 2 * hstep;
    const unsigned ldsw = (unsigned)wid * 1024u;
    const int aoff = lds_byte(wr * 64 + fr, fq * 8), boff = lds_byte(wc * 32 + fr, fq * 8);
#define PG8_SA(b, h) (((b) * 2 + (h)) * HTB)
#define PG8_SB(b, h) ((4 + (b) * 2 + (h)) * HTB)
#define PG8_STAGE(bufoff, gbase, voff) do { _Pragma("unroll") for (int _i = 0; _i < 2; ++_i) \
        __builtin_amdgcn_global_load_lds((const unsigned*)((const char*)(gbase) + (voff)[_i]), (PG8_LAS unsigned*)(lds + (bufoff) + ldsw + _i * 8192), 16, 0, 0); } while (0)
#define PG8_LDA(dst, b, h) do { _Pragma("unroll") for (int m = 0; m < 4; ++m) _Pragma("unroll") for (int k = 0; k < 2; ++k) dst[m][k] = *(const PG8_LAS bf16x8*)(lds + PG8_SA(b, h) + aoff + m * 2048 + k * 1024); } while (0)
#define PG8_LDB(dst, b, h) do { _Pragma("unroll") for (int n = 0; n < 2; ++n) _Pragma("unroll") for (int k = 0; k < 2; ++k) dst[n][k] = *(const PG8_LAS bf16x8*)(lds + PG8_SB(b, h) + boff + n * 2048 + k * 1024); } while (0)
#define PG8_MMA(ai, bj, At, Bt) do { __builtin_amdgcn_s_setprio(1); _Pragma("unroll") for (int m = 0; m < 4; ++m) _Pragma("unroll") for (int n = 0; n < 2; ++n) _Pragma("unroll") for (int k = 0; k < 2; ++k) \
        acc[ai][bj][m][n] = __builtin_amdgcn_mfma_f32_16x16x32_bf16(Bt[n][k], At[m][k], acc[ai][bj][m][n], 0, 0, 0); __builtin_amdgcn_s_setprio(0); } while (0)
#define PG8_WAIT_V(n) asm volatile("s_waitcnt vmcnt(" #n ")" ::: "memory")
#define PG8_WAIT_L(n) asm volatile("s_waitcnt lgkmcnt(" #n ")" ::: "memory")
#define PG8_BAR __builtin_amdgcn_s_barrier()
#define PG8_SCHED __builtin_amdgcn_sched_barrier(0)
    Unit cur, nxt; int ui = 0;
    if (!S.next(0, cur)) return;
    f32x4 acc[2][2][4][2];
#pragma unroll
    for (int a = 0; a < 2; ++a)
#pragma unroll
        for (int b = 0; b < 2; ++b)
#pragma unroll
            for (int m = 0; m < 4; ++m)
#pragma unroll
                for (int n = 0; n < 2; ++n) acc[a][b][m][n] = (f32x4){0.f, 0.f, 0.f, 0.f};
    bf16x8 At[4][2], B0[2][2], B1[2][2];
    const char* cA = (const char*)g.A + (size_t)cur.pm * tstep; const char* cB = (const char*)g.Bt + (size_t)cur.pn * tstep;
    S.a_ready(cur);
    if constexpr (SP2) {
        PG8_STAGE(PG8_SB(0, 0), cB, voffB); PG8_STAGE(PG8_SB(0, 1), cB + hstep, voffB); PG8_STAGE(PG8_SA(0, 0), cA, voffA); PG8_STAGE(PG8_SA(0, 1), cA + hstep, voffA);
        if (wr == 1) PG8_BAR;
        PG8_WAIT_V(2); PG8_BAR;
        PG8_STAGE(PG8_SB(1, 0), cB + kstep, voffB); PG8_STAGE(PG8_SA(1, 0), cA + kstep, voffA); PG8_STAGE(PG8_SB(1, 1), cB + hstep + kstep, voffB);
        PG8_WAIT_V(6); PG8_BAR;
    } else {
        PG8_STAGE(PG8_SB(0, 0), cB, voffB); PG8_STAGE(PG8_SA(0, 0), cA, voffA); PG8_STAGE(PG8_SB(0, 1), cB + hstep, voffB); PG8_STAGE(PG8_SA(0, 1), cA + hstep, voffA);
        if (wr == 1) PG8_BAR;
        PG8_WAIT_V(4); PG8_BAR;
        PG8_STAGE(PG8_SB(1, 0), cB + kstep, voffB); PG8_STAGE(PG8_SA(1, 0), cA + kstep, voffA); PG8_STAGE(PG8_SB(1, 1), cB + hstep + kstep, voffB);
        PG8_WAIT_V(6); PG8_BAR;
    }
    for (;;) {
        const bool has_next = S.next(ui + 1, nxt);
        const char* nA = has_next ? (const char*)g.A + (size_t)nxt.pm * tstep : cA; const char* nB = has_next ? (const char*)g.Bt + (size_t)nxt.pn * tstep : cB;
        for (int t = 0; t < nt; t += 2) {
            const bool last = (t == nt - 2);
            const char* a1 = cA + (size_t)(t + 1) * kstep;
            const char* a2 = last ? nA : cA + (size_t)(t + 2) * kstep; const char* b2 = last ? nB : cB + (size_t)(t + 2) * kstep;
            const char* a3 = a2 + kstep; const char* b3 = b2 + kstep;
            if (last && has_next) S.a_ready(nxt);
            if constexpr (SP2) {
            PG8_LDB(B0, 0, 0); PG8_LDB(B1, 0, 1); PG8_SCHED; PG8_LDA(At, 0, 0); PG8_STAGE(PG8_SA(1, 1), a1 + hstep, voffA);
            PG8_WAIT_V(8); PG8_WAIT_L(0); PG8_BAR; PG8_MMA(0, 0, At, B0); PG8_MMA(0, 1, At, B1); PG8_BAR; PG8_SCHED;
            PG8_LDA(At, 0, 1); PG8_STAGE(PG8_SB(0, 0), b2, voffB); PG8_STAGE(PG8_SB(0, 1), b2 + hstep, voffB); PG8_STAGE(PG8_SA(0, 0), a2, voffA);
            PG8_WAIT_V(8); PG8_WAIT_L(0); PG8_BAR; PG8_MMA(1, 0, At, B0); PG8_MMA(1, 1, At, B1); PG8_BAR; PG8_SCHED;
            PG8_LDB(B0, 1, 0); PG8_LDB(B1, 1, 1); PG8_SCHED; PG8_LDA(At, 1, 0); PG8_STAGE(PG8_SA(0, 1), a2 + hstep, voffA);
            PG8_WAIT_V(8); PG8_WAIT_L(0); PG8_BAR; PG8_MMA(0, 0, At, B0); PG8_MMA(0, 1, At, B1); PG8_BAR; PG8_SCHED;
            PG8_LDA(At, 1, 1); PG8_STAGE(PG8_SB(1, 0), b3, voffB); PG8_STAGE(PG8_SB(1, 1), b3 + hstep, voffB); PG8_STAGE(PG8_SA(1, 0), a3, voffA);
            PG8_WAIT_V(8); PG8_WAIT_L(0); PG8_BAR; PG8_MMA(1, 0, At, B0); PG8_MMA(1, 1, At, B1); PG8_BAR; PG8_SCHED;
            } else {
            PG8_LDB(B0, 0, 0); PG8_SCHED; PG8_LDA(At, 0, 0); PG8_STAGE(PG8_SA(1, 1), a1 + hstep, voffA);
            PG8_WAIT_L(8); PG8_BAR; PG8_WAIT_L(0); PG8_MMA(0, 0, At, B0); PG8_BAR; PG8_SCHED;
            PG8_LDB(B1, 0, 1); PG8_STAGE(PG8_SB(0, 0), b2, voffB);
            PG8_BAR; PG8_WAIT_L(0); PG8_MMA(0, 1, At, B1); PG8_BAR;
            PG8_LDA(At, 0, 1); PG8_STAGE(PG8_SA(0, 0), a2, voffA);
            PG8_BAR; PG8_WAIT_L(0); PG8_MMA(1, 0, At, B0); PG8_BAR; PG8_SCHED;
            PG8_STAGE(PG8_SB(0, 1), b2 + hstep, voffB);
            PG8_WAIT_V(6); PG8_BAR; PG8_MMA(1, 1, At, B1); PG8_BAR;
            PG8_LDB(B0, 1, 0); PG8_SCHED; PG8_LDA(At, 1, 0); PG8_STAGE(PG8_SA(0, 1), a2 + hstep, voffA);
            PG8_WAIT_L(8); PG8_BAR; PG8_WAIT_L(0); PG8_MMA(0, 0, At, B0); PG8_BAR; PG8_SCHED;
            PG8_LDB(B1, 1, 1); PG8_STAGE(PG8_SB(1, 0), b3, voffB);
            PG8_BAR; PG8_WAIT_L(0); PG8_MMA(0, 1, At, B1); PG8_BAR;
            PG8_LDA(At, 1, 1); PG8_STAGE(PG8_SA(1, 0), a3, voffA);
            PG8_BAR; PG8_WAIT_L(0); PG8_MMA(1, 0, At, B0); PG8_BAR; PG8_SCHED;
            PG8_STAGE(PG8_SB(1, 1), b3 + hstep, voffB);
            PG8_WAIT_V(6); PG8_BAR; PG8_MMA(1, 1, At, B1); PG8_BAR;
            }
        }
        if constexpr (ALIGN_EPI) { if (wr == 0) PG8_BAR; }
        if constexpr (!Epi::AFTER_DRAIN) { E(acc, cur, wr, wc, fr, fq); S.done(cur); }
        if (!has_next) break;
#pragma unroll
        for (int a = 0; a < 2; ++a)
#pragma unroll
            for (int b = 0; b < 2; ++b)
#pragma unroll
                for (int m = 0; m < 4; ++m)
#pragma unroll
                    for (int n = 0; n < 2; ++n) acc[a][b][m][n] = (f32x4){0.f, 0.f, 0.f, 0.f};
        cur = nxt; cA = nA; cB = nB; ++ui;
        if constexpr (ALIGN_EPI) { if (wr == 1) PG8_BAR; }
    }
    PG8_WAIT_V(0);
    if constexpr (!ALIGN_EPI) { if (wr == 0) PG8_BAR; }
    PG8_BAR;
    if constexpr (Epi::AFTER_DRAIN) { E.fused(acc, cur, wr, wc, fr, fq, lds, wid, lane); S.done(cur); }
#undef PG8_SA
#undef PG8_SB
#undef PG8_STAGE
#undef PG8_LDA
#undef PG8_LDB
#undef PG8_MMA
#undef PG8_WAIT_V
#undef PG8_WAIT_L
#undef PG8_BAR
#undef PG8_SCHED
}
}


#define RLX_AGENT __ATOMIC_RELAXED, __HIP_MEMORY_SCOPE_AGENT
#define XB_TMO      128
#define XB_XCNT(j)  (256  + 64 * (j))
#define XB_XSUB(j)  (1280 + 64 * (j))
#define XB_XGEN(j)  (2304 + 64 * (j))
#define XB_TOP      3328
#define XB_TOPGEN   3392
#define XCD_BAR_WORDS 3456
#define XB_SPIN_CAP (1u << 18)

__device__ __forceinline__ unsigned xb_ld(unsigned* p)              { return __hip_atomic_load(p, __ATOMIC_RELAXED, __HIP_MEMORY_SCOPE_AGENT); }
__device__ __forceinline__ unsigned xb_add(unsigned* p, unsigned v) { return __hip_atomic_fetch_add(p, v, __ATOMIC_RELAXED, __HIP_MEMORY_SCOPE_AGENT); }
__device__ __forceinline__ unsigned xb_xcc_id() { return (unsigned)__builtin_amdgcn_s_getreg((3 << 11) | 20) & 0xFu; }
#define XB_SPIN(cond, bar) do { unsigned _sp = 0; while (cond) { __builtin_amdgcn_s_sleep(1); \
    if ((++_sp & 255u) == 0u) { if (xb_ld(&(bar)[XB_TMO])) break; if (_sp > XB_SPIN_CAP) { atomicAdd(&(bar)[XB_TMO], 1u); break; } } } } while (0)

struct XcdBarrier {
    unsigned* bar; unsigned x;
    volatile LAS unsigned* st;
};

__device__ __forceinline__ XcdBarrier xcd_barrier_post(unsigned* bar, volatile LAS unsigned* st) {
    XcdBarrier b; b.bar = bar; b.x = xb_xcc_id(); b.st = st;
    if (threadIdx.x == 0) (void)xb_add(&bar[XB_XCNT(b.x)], 1u);
    return b;
}
__device__ __forceinline__ void xcd_barrier_complete(unsigned* bar, unsigned x, unsigned& nloc, unsigned& nx) {
    const unsigned G = gridDim.x * gridDim.y * gridDim.z;
    unsigned sum, cnt, mine, sp = 0u;
    for (;;) {
        sum = 0u; cnt = 0u; mine = 0u;
#pragma unroll
        for (unsigned j = 0; j < 16; ++j) { const unsigned c = xb_ld(&bar[XB_XCNT(j)]); sum += c; cnt += (c > 0u) ? 1u : 0u; mine = (j == x) ? c : mine; }
        if (sum == G) break;
        __builtin_amdgcn_s_sleep(1);
        if ((++sp & 255u) == 0u) { if (xb_ld(&bar[XB_TMO])) break; if (sp > XB_SPIN_CAP) { atomicAdd(&bar[XB_TMO], 1u); break; } }
    }
    nloc = mine > 0u ? mine : 1u; nx = cnt > 0u ? cnt : 1u;
}

__device__ __forceinline__ void xcd_barrier(const XcdBarrier& b) {
    asm volatile("s_waitcnt vmcnt(0)" ::: "memory");
    __syncthreads();
    if (threadIdx.x == 0) {
        unsigned* bar = b.bar;
        __builtin_amdgcn_s_waitcnt(0);
        unsigned nloc = b.st[0], nx = b.st[1];
        if (nloc == 0u) { xcd_barrier_complete(bar, b.x, nloc, nx); b.st[0] = nloc; b.st[1] = nx; }
        const unsigned old = xb_add(&bar[XB_XSUB(b.x)], 1u);
        const unsigned gen = old / nloc;
        if (old + 1u == (gen + 1u) * nloc) {
            __builtin_amdgcn_fence(__ATOMIC_RELEASE, "agent");
            asm volatile("s_waitcnt vmcnt(0)" ::: "memory");
            const unsigned og = xb_add(&bar[XB_TOP], 1u);
            const unsigned tg = og / nx;
            if (og + 1u == (tg + 1u) * nx) xb_add(&bar[XB_TOPGEN], 1u);
            else XB_SPIN(xb_ld(&bar[XB_TOPGEN]) == tg, bar);
            __builtin_amdgcn_fence(__ATOMIC_ACQUIRE, "agent");
            xb_add(&bar[XB_XGEN(b.x)], 1u);
            asm volatile("s_waitcnt vmcnt(0)" ::: "memory");
        } else {
            XB_SPIN(xb_ld(&bar[XB_XGEN(b.x)]) == gen, bar);
            __builtin_amdgcn_fence(__ATOMIC_ACQUIRE, "agent");
            asm volatile("s_waitcnt vmcnt(0)" ::: "memory");
        }
    }
    __syncthreads();
}

DEVI void transpose_item(const float* __restrict__ W, int ldw, int c0, bf16_t* WT, int ldk, int r0, int Kmax, int kb, int nb, const float* kscale, float* scr, int lane) {
    const int k0 = 64 * kb, n0 = 32 * nb;
#pragma unroll 8
    for (int i = 0; i < 32; ++i) {
        const int kk = 2 * i + (lane >> 5);
        float v = 0.f;
        if (k0 + kk < Kmax) { v = W[(size_t)(k0 + kk) * ldw + c0 + n0 + (lane & 31)]; if (kscale) v *= kscale[k0 + kk]; }
        scr[kk * 33 + (lane & 31)] = v;
    }
    asm volatile("s_waitcnt lgkmcnt(0)" ::: "memory");
    asm volatile("" ::: "memory");
    const int c = lane & 7;
    if (k0 + 8 * c < Kmax) {
#pragma unroll
        for (int j = 0; j < 4; ++j) {
            const int n = (lane >> 3) + 8 * j;
            const float* s = scr + (8 * c) * 33 + n;
            u32x4 o; o.x = pk2(s[0], s[33]); o.y = pk2(s[66], s[99]); o.z = pk2(s[132], s[165]); o.w = pk2(s[198], s[231]);
            *(u32x4*)(WT + (size_t)(r0 + n0 + n) * ldk + k0 + 8 * c) = o;
        }
    }
    asm volatile("s_waitcnt lgkmcnt(0)" ::: "memory");
    asm volatile("" ::: "memory");
}


DEVI void wcomb_item(const float* __restrict__ Wq, const float* __restrict__ Sk, const float* __restrict__ n2w, bf16_t* WcT, int it, int lane) {
    const int fr = lane & 15, fq = lane >> 4;
    const int hp = it >> 6, nt = (it >> 4) & 3, kt = it & 15;
    const float* ap = Sk + ((size_t)hp * 128 + nt * 32 + fr) * 128 + fq * 8;
    const float* bp = Wq + (size_t)(kt * 64 + fr) * 2048 + hp * 128 + fq * 8;
    f32x4 acc[2][4];
#pragma unroll
    for (int m = 0; m < 2; ++m)
#pragma unroll
        for (int n = 0; n < 4; ++n) acc[m][n] = (f32x4){0.f, 0.f, 0.f, 0.f};
#pragma unroll
    for (int k0 = 0; k0 < 128; k0 += 32) {
        bf16x8 a[2], b[4];
#pragma unroll
        for (int m = 0; m < 2; ++m) { const f32x4 lo = *(const f32x4*)(ap + (size_t)m * 16 * 128 + k0), hi = *(const f32x4*)(ap + (size_t)m * 16 * 128 + k0 + 4);
            u32x4 w; w.x = pk2(lo.x, lo.y); w.y = pk2(lo.z, lo.w); w.z = pk2(hi.x, hi.y); w.w = pk2(hi.z, hi.w); a[m] = __builtin_bit_cast(bf16x8, w); }
#pragma unroll
        for (int n = 0; n < 4; ++n) { const f32x4 lo = *(const f32x4*)(bp + (size_t)n * 16 * 2048 + k0), hi = *(const f32x4*)(bp + (size_t)n * 16 * 2048 + k0 + 4);
            u32x4 w; w.x = pk2(lo.x, lo.y); w.y = pk2(lo.z, lo.w); w.z = pk2(hi.x, hi.y); w.w = pk2(hi.z, hi.w); b[n] = __builtin_bit_cast(bf16x8, w); }
#pragma unroll
        for (int m = 0; m < 2; ++m)
#pragma unroll
            for (int n = 0; n < 4; ++n) acc[m][n] = mfma16(b[n], a[m], acc[m][n]);
    }
#pragma unroll
    for (int n = 0; n < 4; ++n) {
        const int col = kt * 64 + 16 * n + 4 * fq; const f32x4 w = *(const f32x4*)(n2w + col);
#pragma unroll
        for (int m = 0; m < 2; ++m) { const int row = hp * 128 + nt * 32 + 16 * m + fr; st_bf4(WcT + (size_t)row * 1024 + col, acc[m][n][0] * w.x, acc[m][n][1] * w.y, acc[m][n][2] * w.z, acc[m][n][3] * w.w); }
    }
}

#define KARG __attribute__((address_space(4)))
DEVI const KARG Params* kargs() { unsigned long long k = (unsigned long long)__builtin_amdgcn_kernarg_segment_ptr(); asm volatile("" : "+s"(k)); return (const KARG Params*)k; }
#define PHASE_PTRS \
    int tid_l_ = threadIdx.x; asm volatile("" : "+v"(tid_l_)); \
    [[maybe_unused]] const int tid = tid_l_, lane = tid & 63, wave = __builtin_amdgcn_readfirstlane(tid >> 6), gw = blockIdx.x * NWAVES + wave, fr = lane & 15, fq = lane >> 4; \
    const KARG Params* kp = kargs(); unsigned char* ws = kp->ws; unsigned char* dob = (unsigned char*)kp->out; (void)ws; (void)dob; \
    [[maybe_unused]] const float* x = kp->in[0]; [[maybe_unused]] const int* positions = (const int*)kp->in[1]; [[maybe_unused]] const float* norm1_w = kp->in[2]; [[maybe_unused]] const float* w_in = kp->in[3]; \
    [[maybe_unused]] const float* rw_mu = kp->in[4]; [[maybe_unused]] const float* rw_w0 = kp->in[5]; [[maybe_unused]] const float* rw_a0 = kp->in[7]; [[maybe_unused]] const float* rw_k_k = kp->in[10]; \
    [[maybe_unused]] const float* rw_k_a = kp->in[11]; [[maybe_unused]] const float* rw_r_k = kp->in[12]; [[maybe_unused]] const float* rw_ln_w = kp->in[13]; [[maybe_unused]] const float* rw_ln_b = kp->in[14]; \
    [[maybe_unused]] const float* q_norm_w = kp->in[16]; [[maybe_unused]] const float* kv_norm_w = kp->in[18]; [[maybe_unused]] const float* qn_nope_w = kp->in[20]; [[maybe_unused]] const float* qn_pe_w = kp->in[21]; \
    [[maybe_unused]] const float* kn_nope_w = kp->in[22]; [[maybe_unused]] const float* kn_pe_w = kp->in[23]; [[maybe_unused]] const float* norm2_w = kp->in[26]; \
    [[maybe_unused]] float* ss2 = (float*)(ws + WS_SS2); [[maybe_unused]] unsigned* cnt = (unsigned*)(ws + WS_CNT); [[maybe_unused]] unsigned* xbar_words = (unsigned*)(ws + WS_CNT + 4096); \
    [[maybe_unused]] bf16_t* WinT = (bf16_t*)(ws + WS_WIN); [[maybe_unused]] bf16_t* WuqT = (bf16_t*)(ws + WS_WUQ); [[maybe_unused]] bf16_t* WukvT = (bf16_t*)(ws + WS_WUKV); [[maybe_unused]] bf16_t* RwoT = (bf16_t*)(ws + WS_RWO); \
    [[maybe_unused]] bf16_t* MwoT = (bf16_t*)(ws + WS_MWO); [[maybe_unused]] bf16_t* WoutT = (bf16_t*)(ws + WS_WOUT); [[maybe_unused]] bf16_t* PwqT = (bf16_t*)(ws + WS_PWQ); [[maybe_unused]] bf16_t* SubK = (bf16_t*)(ws + WS_SUBK); \
    [[maybe_unused]] bf16_t* W2T = (bf16_t*)(ws + WS_W2T); [[maybe_unused]] bf16_t* A2T = (bf16_t*)(ws + WS_A2T); [[maybe_unused]] bf16_t* G2T = (bf16_t*)(ws + WS_G2T); [[maybe_unused]] const unsigned char* Gg = ws + WS_G; \
    [[maybe_unused]] bf16_t* Prw = (bf16_t*)(ws + WS_PRW); [[maybe_unused]] bf16_t* QD = (bf16_t*)(ws + WS_QD); [[maybe_unused]] bf16_t* KVD = (bf16_t*)(ws + WS_KVD); [[maybe_unused]] bf16_t* KPE = (bf16_t*)(ws + WS_KPE); \
    [[maybe_unused]] float* ssq = (float*)(ws + WS_SSQ); [[maybe_unused]] float* sskv = (float*)(ws + WS_SSKV); [[maybe_unused]] bf16_t* XN = (bf16_t*)(dob + DO_XN); \
    [[maybe_unused]] bf16_t* Rb = (bf16_t*)(ws + WS_R); [[maybe_unused]] bf16_t* Wb = (bf16_t*)(ws + WS_W); [[maybe_unused]] bf16_t* Kb = (bf16_t*)(ws + WS_KS); [[maybe_unused]] bf16_t* Vb = (bf16_t*)(ws + WS_V); [[maybe_unused]] bf16_t* KKb = (bf16_t*)(ws + WS_KK); \
    [[maybe_unused]] bf16_t* Bvb = (bf16_t*)(dob + DO_BV); [[maybe_unused]] bf16_t* Gtb = (bf16_t*)(dob + DO_GT); [[maybe_unused]] float* bonus = (float*)(dob + DO_BONUS); [[maybe_unused]] bf16_t* Yb = (bf16_t*)(dob + DO_Y); \
    [[maybe_unused]] bf16_t* Qb = (bf16_t*)(ws + WS_Q); [[maybe_unused]] bf16_t* Kab = (bf16_t*)(ws + WS_K); [[maybe_unused]] bf16_t* Vt = (bf16_t*)(ws + WS_VT); [[maybe_unused]] bf16_t* Kraw = (bf16_t*)(dob + DO_KRAW); \
    [[maybe_unused]] bf16_t* Ob = (bf16_t*)(ws + WS_O); [[maybe_unused]] bf16_t* YA = (bf16_t*)(ws + WS_YA); [[maybe_unused]] bf16_t* MIXED = (bf16_t*)(ws + WS_MIXED); [[maybe_unused]] bf16_t* HB = (bf16_t*)(ws + WS_HB); \
    [[maybe_unused]] bf16_t* UB = (bf16_t*)(ws + WS_UB); [[maybe_unused]] bf16_t* VBp = (bf16_t*)(ws + WS_VB); [[maybe_unused]] bf16_t* PQ = (bf16_t*)(ws + WS_PQ); [[maybe_unused]] bf16_t* SC = (bf16_t*)(ws + WS_SC);

__global__ void __launch_bounds__(NT, 2) mega(Params p) {
    extern __shared__ __attribute__((aligned(16))) unsigned char lds[];
    cg::grid_group grid = cg::this_grid();
    const int G = gridDim.x, NGW = G * NWAVES;
    volatile LAS unsigned* bst = (volatile LAS unsigned*)((LAS unsigned char*)lds + LDS_BYTES - 16);
    if (threadIdx.x < 2) bst[threadIdx.x] = 0u;
    if (threadIdx.x >= 8 && threadIdx.x < 16) ((volatile LAS unsigned*)((LAS unsigned char*)lds + LDS_BYTES - 64))[threadIdx.x - 8] = 0u;
    if (threadIdx.x >= 16 && threadIdx.x < 32) ((volatile LAS unsigned*)((LAS unsigned char*)lds + LDS_BYTES - 128))[threadIdx.x - 16] = 0u;
    __syncthreads();

    {
        PHASE_PTRS
        if (blockIdx.x == 0 && tid < 64) cnt[tid] = 0u;
        if (blockIdx.x == 0) for (int i = tid; i < XCD_BAR_WORDS; i += NT) xbar_words[i] = 0u;
        for (int i = blockIdx.x * NT + tid; i < T; i += G * NT) ss2[i] = 0.f;
        for (int t = gw; t < T; t += NGW) {
            const f32x4* xr = (const f32x4*)(x + (size_t)t * DM) + lane;
            f32x4 v[4]; float s = 0.f;
#pragma unroll
            for (int j = 0; j < 4; ++j) { v[j] = xr[64 * j]; s += v[j].x * v[j].x + v[j].y * v[j].y + v[j].z * v[j].z + v[j].w * v[j].w; }
            const float rstd = rsqrtf(wave_sum(s) * (1.f / DM) + EPS);
            const f32x4* wr = (const f32x4*)norm1_w + lane;
#pragma unroll
            for (int j = 0; j < 4; ++j) { const f32x4 w = wr[64 * j]; st_bf4(XN + (size_t)t * DM + (lane + 64 * j) * 4, v[j].x * rstd * w.x, v[j].y * rstd * w.y, v[j].z * rstd * w.z, v[j].w * rstd * w.w); }
        }
        float* scr = (float*)lds + wave * (64 * 33);
        int it = gw;
#define TR_SEG(W_, ldw_, c0_, WT_, ldk_, r0_, Kmax_, nkb_, nnb_, ksc_) \
        { const int cntI = (nkb_) * (nnb_); for (; it < cntI; it += NGW) transpose_item(W_, ldw_, c0_, WT_, ldk_, r0_, Kmax_, it / (nnb_), it % (nnb_), ksc_, scr, lane); it -= cntI; }
        TR_SEG(w_in, 4544, 0, WinT, 1024, 0, 1024, 16, 57, nullptr)
        TR_SEG(w_in, 4544, 1824, WinT, 1024, 2048, 1024, 16, 21, nullptr)
        TR_SEG(w_in, 4544, 2496, WinT, 1024, 2816, 1024, 16, 64, nullptr)
        TR_SEG(kp->in[6], 512, 0, W2T, 64, 0, 64, 1, 16, nullptr)
        TR_SEG(kp->in[8], 512, 0, A2T, 64, 0, 64, 1, 16, nullptr)
        TR_SEG(kp->in[9], 512, 0, G2T, 160, 0, 160, 3, 16, nullptr)
#pragma unroll 1
        for (int hh = 0; hh < 8; ++hh) {
            TR_SEG(kp->in[17], 768, hh * 96, WuqT, 384, hh * 64, 384, 6, 2, q_norm_w)
            TR_SEG(kp->in[17], 768, hh * 96 + 64, WuqT, 384, 512 + hh * 32, 384, 6, 1, q_norm_w)
            TR_SEG(kp->in[19], 1024, hh * 128, WukvT, 256, hh * 64, 256, 4, 2, kv_norm_w)
            TR_SEG(kp->in[19], 1024, hh * 128 + 64, WukvT, 256, 512 + hh * 64, 256, 4, 2, kv_norm_w)
        }
        TR_SEG(kp->in[15], 1024, 0, RwoT, 512, 0, 512, 8, 32, nullptr)
        TR_SEG(kp->in[24], 1024, 0, MwoT, 512, 0, 512, 8, 32, nullptr)
        TR_SEG(kp->in[25], 1024, 0, WoutT, 1024, 0, 1024, 16, 32, nullptr)
#undef TR_SEG
        for (; it < 1024; it += NGW) wcomb_item(kp->in[27], kp->in[28], norm2_w, PwqT, it, lane);
        for (int i = blockIdx.x * NT + tid; i < (224 + 96) * 128; i += G * NT) {
            const int r = i >> 7, c = i & 127; const int row = r < 224 ? 1824 + r : 2720 + (r - 224);
            *(u32x4*)(WinT + (size_t)row * 1024 + c * 8) = (u32x4){0u, 0u, 0u, 0u};
        }
    }
    grid.sync();
    const XcdBarrier xb = xcd_barrier_post((unsigned*)(kargs()->ws + WS_CNT + 4096), bst);

    {
        PHASE_PTRS
        pg8::Gemm g{XN, WinT, T, 4864, DM}; pg8::StaticOrder S; S.init(T, 4864, G, (int)blockIdx.x);
        pg8::EpiP1 E{ws};
        pg8::gemm_phase<pg8::EpiP1, pg8::StaticOrder, true, true>((PG8_LAS unsigned char*)lds, g, S, E);
    }
    xcd_barrier(xb);


    {
        PHASE_PTRS
        for (int t = gw; t < T; t += NGW) {
            float a6[8]; ld_bf8(QD + (size_t)t * 384 + 8 * (lane & 47), a6); float s = 0.f;
#pragma unroll
            for (int i = 0; i < 8; ++i) s += a6[i] * a6[i];
            if (lane >= 48) s = 0.f;
            float b4[4]; ld_bf4(KVD + (size_t)t * 256 + 4 * lane, b4); const float s2 = (b4[0] * b4[0] + b4[1] * b4[1]) + (b4[2] * b4[2] + b4[3] * b4[3]);
            const float sq = wave_sum(s), skv = wave_sum(s2);
            if (lane == 0) { ssq[t] = rsqrtf(sq * (1.f / 384.f) + EPS); sskv[t] = rsqrtf(skv * (1.f / 256.f) + EPS); }
        }
    }
    {
        PHASE_PTRS
        LAS bf16_t* MIX = (LAS bf16_t*)lds; LAS bf16_t* LOR = (LAS bf16_t*)((LAS unsigned char*)lds + 49152);
        for (int tt = blockIdx.x; tt < T / 16; tt += G) {
            const int h = wave;
            __syncthreads();
            {
                u32x4 pw[8], ppw[8];
#pragma unroll
                for (int u = 0; u < 8; ++u) {
                    const int ci = tid + u * NT < 16 * 228 ? tid + u * NT : 16 * 228 - 1; const int row = ci / 228, cc = (ci - row * 228) * 8; const int tk = tt * 16 + row;
                    pw[u] = *(const u32x4*)(Prw + (size_t)tk * 2048 + cc);
                    ppw[u] = *(const u32x4*)(Prw + (size_t)((tk & (SEQ - 1)) != 0 ? tk - 1 : tk) * 2048 + cc);
                }
                __builtin_amdgcn_sched_barrier(0);
#pragma unroll
                for (int u = 0; u < 8; ++u) {
                    const int ci = tid + u * NT; if (ci < 16 * 228) {
                        const int row = ci / 228, cc = (ci - row * 228) * 8; const bool hp_ = ((tt * 16 + row) & (SEQ - 1)) != 0;
                        const float pv[8] = {bflo(pw[u].x), bfhi(pw[u].x), bflo(pw[u].y), bfhi(pw[u].y), bflo(pw[u].z), bfhi(pw[u].z), bflo(pw[u].w), bfhi(pw[u].w)};
                        float ppv[8] = {bflo(ppw[u].x), bfhi(ppw[u].x), bflo(ppw[u].y), bfhi(ppw[u].y), bflo(ppw[u].z), bfhi(ppw[u].z), bflo(ppw[u].w), bfhi(ppw[u].w)};
                        if (!hp_) {
#pragma unroll
                            for (int j = 0; j < 8; ++j) ppv[j] = 0.f; }
                        const f32x4 mu0 = *(const f32x4*)(rw_mu + cc), mu1 = *(const f32x4*)(rw_mu + cc + 4); float xm[8];
#pragma unroll
                        for (int j = 0; j < 8; ++j) { const float mu = j < 4 ? mu0[j & 3] : mu1[j & 3]; const float v = pv[j] + mu * (ppv[j] - pv[j]);
                            xm[j] = cc < 1600 ? (cc < 1536 ? v : tanhf_(v)) : (cc < 1664 ? v : sigmoidf_(v)); }
                        if (cc < 1536) *(LAS bf16x8*)(MIX + row * 1536 + cc) = pack8(xm); else *(LAS bf16x8*)(LOR + row * 288 + (cc - 1536)) = pack8(xm);
                    }
                }
            }
            __syncthreads();
            const int tok = tt * 16 + fr;
            f32x4 accw[4], acca[4], accg[4];
#pragma unroll
            for (int n = 0; n < 4; ++n) { accw[n] = (f32x4){0.f, 0.f, 0.f, 0.f}; acca[n] = accw[n]; accg[n] = accw[n]; }
#define LORA_STEP(lcol_, Wt_, ldw_, koff_, accv_) { \
                const bf16x8 a = *(const LAS bf16x8*)(LOR + fr * 288 + (lcol_) + 8 * fq); \
                _Pragma("unroll") for (int n = 0; n < 4; ++n) { const bf16x8 b = *(const bf16x8*)((Wt_) + (size_t)(64 * h + 16 * n + fr) * (ldw_) + (koff_) + 8 * fq); accv_[n] = mfma16(b, a, accv_[n]); } }
#pragma unroll
            for (int ks = 0; ks < 2; ++ks) LORA_STEP(32 * ks, W2T, 64, 32 * ks, accw)
#pragma unroll
            for (int ks = 0; ks < 2; ++ks) LORA_STEP(64 + 32 * ks, A2T, 64, 32 * ks, acca)
#pragma unroll
            for (int ks = 0; ks < 5; ++ks) LORA_STEP(128 + 32 * ks, G2T, 160, 32 * ks, accg)
#undef LORA_STEP
            float kkv[4][4], av[4][4]; float ssq = 0.f, bon = 0.f;
#pragma unroll
            for (int n = 0; n < 4; ++n) {
                const int ch = 64 * h + 16 * n + 4 * fq;
                float r4[4], k4[4], v4[4];
#pragma unroll
                for (int seg = 0; seg < 3; ++seg) {
                    const u32x2 w = *(const LAS u32x2*)(MIX + fr * 1536 + seg * 512 + ch);
                    const float m4[4] = {bflo(w.x), bfhi(w.x), bflo(w.y), bfhi(w.y)};
#pragma unroll
                    for (int i = 0; i < 4; ++i) { if (seg == 0) r4[i] = m4[i]; else if (seg == 1) k4[i] = m4[i]; else v4[i] = m4[i]; }
                }
                const f32x4 w0 = *(const f32x4*)(rw_w0 + ch), a0 = *(const f32x4*)(rw_a0 + ch), kkw = *(const f32x4*)(rw_k_k + ch), kaw = *(const f32x4*)(rw_k_a + ch), rkw = *(const f32x4*)(rw_r_k + ch);
                float dd[4], kf[4];
#pragma unroll
                for (int i = 0; i < 4; ++i) {
                    const float z = -(w0[i] + accw[n][i]);
                    const float sp = z > 20.f ? z : __logf(1.f + __expf(z));
                    const float wlog = -sp - 0.5f;
                    dd[i] = -__expf(wlog);
                    const float a = sigmoidf_(a0[i] + acca[n][i]); av[n][i] = a;
                    kkv[n][i] = k4[i] * kkw[i]; ssq += kkv[n][i] * kkv[n][i];
                    kf[i] = k4[i] * (1.f + (a - 1.f) * kaw[i]);
                    bon += r4[i] * kf[i] * rkw[i];
                }
                const size_t o = (size_t)tok * 512 + ch;
                st_bf4(Rb + o, r4[0], r4[1], r4[2], r4[3]);
                st_bf4(Wb + o, dd[0], dd[1], dd[2], dd[3]);
                st_bf4(Kb + o, kf[0], kf[1], kf[2], kf[3]);
                st_bf4(Vb + o, v4[0], v4[1], v4[2], v4[3]);
                st_bf4(Gtb + o, accg[n][0], accg[n][1], accg[n][2], accg[n][3]);
            }
            ssq += __shfl_xor(ssq, 16); ssq += __shfl_xor(ssq, 32);
            bon += __shfl_xor(bon, 16); bon += __shfl_xor(bon, 32);
            const float inv = 1.f / fmaxf(sqrtf(ssq), 1e-12f);
#pragma unroll
            for (int n = 0; n < 4; ++n) {
                const size_t o = (size_t)tok * 512 + 64 * h + 16 * n + 4 * fq;
                float kk[4], bb[4];
#pragma unroll
                for (int i = 0; i < 4; ++i) { kk[i] = kkv[n][i] * inv; bb[i] = kk[i] * av[n][i]; }
                st_bf4(KKb + o, kk[0], kk[1], kk[2], kk[3]);
                st_bf4(Bvb + o, bb[0], bb[1], bb[2], bb[3]);
            }
            if (fq == 0) bonus[(size_t)tok * 8 + h] = bon;
        }
    }
    xcd_barrier(xb);

    {
        PHASE_PTRS
        { int Kq = 384; asm volatile("" : "+s"(Kq));
          pg8::Gemm g{QD, WuqT, T, 768, Kq}; pg8::StaticOrder S; S.init(T, 768, G, (int)blockIdx.x); pg8::EpiQraw E{Qb, ssq};
          pg8::gemm_phase<pg8::EpiQraw, pg8::StaticOrder, true, true>((PG8_LAS unsigned char*)lds, g, S, E); }
        { int Kkv = 256; asm volatile("" : "+s"(Kkv));
          pg8::Gemm g{KVD, WukvT, T, 1024, Kkv}; pg8::StaticOrder S; S.init(T, 1024, G, (int)blockIdx.x); pg8::EpiKVraw E{Kraw, Vt, sskv};
          pg8::gemm_phase<pg8::EpiKVraw, pg8::StaticOrder, true, true>((PG8_LAS unsigned char*)lds, g, S, E); }
    }
    xcd_barrier(xb);
    {
        PHASE_PTRS
        for (int t = gw; t < T; t += NGW) {
            const int hh = lane >> 3, l8 = lane & 7;
            const float pos = (float)positions[t];
            float cs[4], sn[4];
#pragma unroll
            for (int i = 0; i < 4; ++i) { const float invf = exp2f(-(float)(4 * (l8 & 3) + i) * (13.287712379549449f / 16.f)); float rev = pos * invf * 0.15915494309189535f; rev -= rintf(rev);
                sn[i] = __builtin_amdgcn_sinf(rev); cs[i] = __builtin_amdgcn_cosf(rev); }
            bf16_t* qrow = Qb + (size_t)t * 768;
            float qn[8], qp[4]; ld_bf8(qrow + 8 * lane, qn); ld_bf4(qrow + 512 + 4 * lane, qp);
            float kn[8], kp4[4]; ld_bf8(Kraw + (size_t)t * 512 + 8 * lane, kn); ld_bf4(KPE + (size_t)t * 32 + 4 * l8, kp4);
            float s1 = 0.f, s2 = 0.f, s3 = 0.f, s4 = 0.f;
#pragma unroll
            for (int i = 0; i < 8; ++i) { s1 += qn[i] * qn[i]; s3 += kn[i] * kn[i]; }
#pragma unroll
            for (int i = 0; i < 4; ++i) { s2 += qp[i] * qp[i]; s4 += kp4[i] * kp4[i]; }
            s1 = sum8(s1); s2 = sum8(s2); s3 = sum8(s3); s4 = sum8(s4);
            const float r1 = rsqrtf(s1 * (1.f / 64.f) + EPS) * QSCALE, r2 = rsqrtf(s2 * (1.f / 32.f) + EPS), r3 = rsqrtf(s3 * (1.f / 64.f) + EPS), r4 = rsqrtf(s4 * (1.f / 32.f) + EPS);
            const f32x4 wq0 = *(const f32x4*)(qn_nope_w + 8 * l8), wq1 = *(const f32x4*)(qn_nope_w + 8 * l8 + 4), wk0 = *(const f32x4*)(kn_nope_w + 8 * l8), wk1 = *(const f32x4*)(kn_nope_w + 8 * l8 + 4);
            const f32x4 wqp = *(const f32x4*)(qn_pe_w + 4 * l8), wkp = *(const f32x4*)(kn_pe_w + 4 * l8);
            float oq[8], ok[8], oqp[4], okp[4];
#pragma unroll
            for (int i = 0; i < 8; ++i) { oq[i] = qn[i] * r1 * (i < 4 ? wq0[i & 3] : wq1[i & 3]); ok[i] = kn[i] * r3 * (i < 4 ? wk0[i & 3] : wk1[i & 3]); }
#pragma unroll
            for (int i = 0; i < 4; ++i) {
                const float xq = qp[i] * r2 * wqp[i], xk = kp4[i] * r4 * wkp[i];
                const float pq = dpp_f<0x141>(xq), pk_ = dpp_f<0x141>(xk);
                (void)pq; (void)pk_;
                oqp[i] = xq; okp[i] = xk;
            }
#pragma unroll
            for (int i = 0; i < 4; ++i) {
                const float pq = __shfl_xor(oqp[i], 4), pk_ = __shfl_xor(okp[i], 4);
                const float xq = oqp[i], xk = okp[i];
                oqp[i] = l8 < 4 ? (xq * cs[i] - pq * sn[i]) : (xq * cs[i] + pq * sn[i]);
                okp[i] = l8 < 4 ? (xk * cs[i] - pk_ * sn[i]) : (xk * cs[i] + pk_ * sn[i]);
                oqp[i] *= QSCALE;
            }
            bf16_t* qo = Qb + ((size_t)t * 8 + hh) * 96;
            *(bf16x8*)(qo + 8 * l8) = pack8(oq); st_bf4(qo + 64 + 4 * l8, oqp[0], oqp[1], oqp[2], oqp[3]);
            { const int bb = t >> 12, pos = t & 4095; bf16_t* kfb = Kab + (((size_t)(bb * 8 + hh) * 128 + (pos >> 5)) * 6) * 512 + (pos & 31) * 8;
              *(bf16x8*)(kfb + (l8 >> 1) * 512 + 256 * (l8 & 1)) = pack8(ok);
              st_bf4(kfb + (4 + (l8 >> 2)) * 512 + 256 * ((l8 >> 1) & 1) + 4 * (l8 & 1), okp[0], okp[1], okp[2], okp[3]); }
        }
    }
    xcd_barrier(xb);

    {
        PHASE_PTRS
        float* GL = (float*)(dob + DO_GL);
        const int fr_o = fr, fq_o = fq, lane_o = lane;
        if (wave < 3) {
            LAS unsigned char* wb = (LAS unsigned char*)lds + wave * 49152;
            LAS bf16_t* At = (LAS bf16_t*)(wb + 0);      LAS bf16_t* Btm = (LAS bf16_t*)(wb + 4096);  LAS bf16_t* Ktm = (LAS bf16_t*)(wb + 8192); LAS bf16_t* Rtm = (LAS bf16_t*)(wb + 12288);
            LAS bf16_t* AtT = (LAS bf16_t*)(wb + 16384); LAS bf16_t* BtT = (LAS bf16_t*)(wb + 20480); LAS bf16_t* KtT = (LAS bf16_t*)(wb + 24576); LAS bf16_t* VmT = (LAS bf16_t*)(wb + 28672);
            LAS bf16_t* Nm = (LAS bf16_t*)(wb + 32768);  LAS bf16_t* NmT = (LAS bf16_t*)(wb + 34816); LAS bf16_t* Tm = (LAS bf16_t*)(wb + 36864);  LAS bf16_t* TmT = (LAS bf16_t*)(wb + 38912);
            LAS bf16_t* MmT = (LAS bf16_t*)(wb + 40960); LAS bf16_t* NBT = (LAS bf16_t*)(wb + 43008); LAS bf16_t* MKT = (LAS bf16_t*)(wb + 45056); LAS float* gLs = (LAS float*)(wb + 47104);
            LAS bf16_t* W1 = At; LAS bf16_t* W1T = Btm; LAS bf16_t* ATm = Ktm;
#pragma unroll 1
            for (int it = blockIdx.x * 3 + wave; it < 4096; it += G * 3) {
                const int bh = it >> 7, c = it & 127, b = bh >> 3, h = bh & 7;
                int fr = fr_o, fq = fq_o, lane = lane_o; asm volatile("" : "+v"(fr), "+v"(fq), "+v"(lane));
                const int lpA = (4 * (fr >> 3) + (fr & 3)) + 32 * (fq & 1) + ((fq >> 1) + 4 * ((fr >> 2) & 1)) * 512;
                const int lpB = ((fr >> 1) + 16 * (fq & 1)) * 512 + 16 * (fr & 1) + 4 * (fq >> 1);
                const int lpC = 4 * (fq >> 1) + 16 * (fr & 3) + ((fr >> 2) + 8 * (fq & 1)) * 512;
                const size_t sbase = ((size_t)b * SEQ + c * 32) * 512 + h * 64;
                {
                    float cs = 0.f; unsigned aT[16], bT[16], kT[16], vT[16];
#pragma unroll
                    for (int t = 0; t < 32; ++t) {
                        const size_t o = sbase + (size_t)t * 512 + lane;
                        const float ldv = bf1(Wb[o]), rr = bf1(Rb[o]), kv = bf1(Kb[o]), qv = bf1(KKb[o]), bv = bf1(Bvb[o]); const unsigned vraw = Vb[o];
                        const float ep = __expf(cs); cs += ldv; const float ec = __expf(cs), en = __expf(-cs);
                        const unsigned a_ = bf1of(-qv * ep), b_ = bf1of(bv * en), k_ = bf1of(kv * en), r_ = bf1of(rr * ec);
                        At[SW64(t, lane)] = (bf16_t)a_; Btm[SW64(t, lane)] = (bf16_t)b_; Ktm[SW64(t, lane)] = (bf16_t)k_; Rtm[SW64(t, lane)] = (bf16_t)r_;
                        if (t & 1) { aT[t >> 1] |= a_ << 16; bT[t >> 1] |= b_ << 16; kT[t >> 1] |= k_ << 16; vT[t >> 1] |= vraw << 16; }
                        else { aT[t >> 1] = a_; bT[t >> 1] = b_; kT[t >> 1] = k_; vT[t >> 1] = vraw; }
                    }
#pragma unroll
                    for (int q = 0; q < 4; ++q) {
                        *(LAS u32x4*)(AtT + lane * 32 + ((q ^ ((lane >> 2) & 3)) << 3)) = (u32x4){aT[4 * q], aT[4 * q + 1], aT[4 * q + 2], aT[4 * q + 3]};
                        *(LAS u32x4*)(BtT + lane * 32 + ((q ^ ((lane >> 2) & 3)) << 3)) = (u32x4){bT[4 * q], bT[4 * q + 1], bT[4 * q + 2], bT[4 * q + 3]};
                        *(LAS u32x4*)(KtT + lane * 32 + ((q ^ ((lane >> 2) & 3)) << 3)) = (u32x4){kT[4 * q], kT[4 * q + 1], kT[4 * q + 2], kT[4 * q + 3]};
                        *(LAS u32x4*)(VmT + lane * 32 + ((q ^ ((lane >> 2) & 3)) << 3)) = (u32x4){vT[4 * q], vT[4 * q + 1], vT[4 * q + 2], vT[4 * q + 3]};
                    }
                    const float gl = __expf(cs); gLs[lane] = gl;
                    { const int k5 = lane & 31; GL[(size_t)it * 64 + (lane >> 5) * 32 + ((k5 >> 2) & 1) * 16 + (k5 & 3) + 4 * (k5 >> 3)] = gl; }
                }
                {
                    f32x4 acc[2][2];
#define ZACC(MT_, NT_) _Pragma("unroll") for (int m = 0; m < MT_; ++m) _Pragma("unroll") for (int n = 0; n < NT_; ++n) acc[m][n] = (f32x4){0.f, 0.f, 0.f, 0.f};
                    ZACC(2, 2) gemm_lds<2, 2, 2>(Btm, 64, At, 64, acc, fr, fq);
#pragma unroll
                    for (int m = 0; m < 2; ++m)
#pragma unroll
                        for (int n = 0; n < 2; ++n)
#pragma unroll
                            for (int j = 0; j < 4; ++j) { const int i = 16 * m + fr, tt = 16 * n + 4 * fq + j; const float v = i < tt ? acc[m][n][j] : 0.f; const bf16_t w = bf1of(v), w1 = bf1of(v + (i == tt ? 1.f : 0.f));
                                Nm[SW32(i, tt)] = w; NmT[SW32(tt, i)] = w; Tm[SW32(i, tt)] = w1; TmT[SW32(tt, i)] = w1; }
                    ZACC(2, 2) gemm_lds<2, 2, 2>(Ktm, 64, At, 64, acc, fr, fq);
#pragma unroll
                    for (int m = 0; m < 2; ++m)
#pragma unroll
                        for (int n = 0; n < 2; ++n)
#pragma unroll
                            for (int j = 0; j < 4; ++j) { const int i = 16 * m + fr, tt = 16 * n + 4 * fq + j; MmT[SW32(tt, i)] = bf1of(i < tt ? acc[m][n][j] : 0.f); }
                    ZACC(2, 2) gemm_lds<2, 2, 2>(Btm, 64, Rtm, 64, acc, fr, fq);
#pragma unroll
                    for (int m = 0; m < 2; ++m)
#pragma unroll
                        for (int n = 0; n < 2; ++n)
#pragma unroll
                            for (int j = 0; j < 4; ++j) { const int i = 16 * m + fr, tt = 16 * n + 4 * fq + j; NBT[SW32(tt, i)] = bf1of(i <= tt ? acc[m][n][j] : 0.f); }
                    ZACC(2, 2) gemm_lds<2, 2, 2>(Ktm, 64, Rtm, 64, acc, fr, fq);
#pragma unroll
                    for (int m = 0; m < 2; ++m)
#pragma unroll
                        for (int n = 0; n < 2; ++n)
#pragma unroll
                            for (int j = 0; j < 4; ++j) { const int i = 16 * m + fr, tt = 16 * n + 4 * fq + j; MKT[SW32(tt, i)] = bf1of(i <= tt ? acc[m][n][j] : 0.f); }
#pragma unroll 1
                    for (int rd = 0; rd < 4; ++rd) {
                        ZACC(2, 2) gemm_lds<2, 2, 1>(Nm, 32, NmT, 32, acc, fr, fq);
#pragma unroll
                        for (int m = 0; m < 2; ++m)
#pragma unroll
                            for (int n = 0; n < 2; ++n)
#pragma unroll
                                for (int j = 0; j < 4; ++j) { const int i = 16 * m + fr, tt = 16 * n + 4 * fq + j; const bf16_t w = bf1of(acc[m][n][j]); Nm[SW32(i, tt)] = w; NmT[SW32(tt, i)] = w; }
                        ZACC(2, 2) gemm_lds<2, 2, 1>(Tm, 32, NmT, 32, acc, fr, fq);
#pragma unroll
                        for (int m = 0; m < 2; ++m)
#pragma unroll
                            for (int n = 0; n < 2; ++n)
#pragma unroll
                                for (int j = 0; j < 4; ++j) { const int i = 16 * m + fr, tt = 16 * n + 4 * fq + j; const bf16_t w = bf1of(acc[m][n][j] + bf1(Tm[SW32(i, tt)])); Tm[SW32(i, tt)] = w; TmT[SW32(tt, i)] = w; }
                    }
                }
                asm volatile("" : "+v"(fr), "+v"(fq));
                {
                    f32x4 acc[4][2];
                    ZACC(4, 2) gemm_lds<4, 2, 1>(AtT, 32, TmT, 32, acc, fr, fq);
#pragma unroll
                    for (int m = 0; m < 4; ++m)
#pragma unroll
                        for (int n = 0; n < 2; ++n)
#pragma unroll
                            for (int j = 0; j < 4; ++j) ATm[SW32(16 * m + fr, 16 * n + 4 * fq + j)] = bf1of(acc[m][n][j]);
                    ZACC(4, 2) gemm_lds<4, 2, 1>(VmT, 32, MmT, 32, acc, fr, fq);
#pragma unroll
                    for (int m = 0; m < 4; ++m)
#pragma unroll
                        for (int n = 0; n < 2; ++n)
#pragma unroll
                            for (int j = 0; j < 4; ++j) W1[SW32(16 * m + fr, 16 * n + 4 * fq + j)] = bf1of(acc[m][n][j]);
                    ZACC(4, 2) gemm_lds<4, 2, 1>(W1, 32, TmT, 32, acc, fr, fq);
#pragma unroll
                    for (int m = 0; m < 4; ++m)
#pragma unroll
                        for (int n = 0; n < 2; ++n)
#pragma unroll
                            for (int j = 0; j < 4; ++j) W1T[SW32(16 * m + fr, 16 * n + 4 * fq + j)] = bf1of(acc[m][n][j]);
                    ZACC(4, 2) gemm_lds<4, 2, 1>(ATm, 32, NBT, 32, acc, fr, fq);
#pragma unroll
                    for (int m = 0; m < 4; ++m)
#pragma unroll
                        for (int n = 0; n < 2; ++n)
#pragma unroll
                            for (int j = 0; j < 4; ++j) { const int k = 16 * m + fr, tp = 16 * n + 4 * fq + j; const float v = acc[m][n][j] + bf1(Rtm[SW64(tp, k)]);
                                Rb[sbase + lpA + (size_t)(j * 8 + (2 * n + 8 * m) * 512)] = bf1of(v); }
                    ZACC(4, 2) gemm_lds<4, 2, 1>(W1T, 32, NBT, 32, acc, fr, fq); gemm_lds<4, 2, 1>(VmT, 32, MKT, 32, acc, fr, fq);
#pragma unroll
                    for (int m = 0; m < 4; ++m)
#pragma unroll
                        for (int n = 0; n < 2; ++n)
#pragma unroll
                            for (int j = 0; j < 4; ++j) Yb[sbase + lpB + (size_t)((8 * (m & 1)) * 512 + 32 * (m >> 1) + j + 8 * n)] = bf1of(acc[m][n][j]);
                }
                asm volatile("" : "+v"(fr), "+v"(fq));
                {
                    f32x4 acc[4][4];
                    ZACC(4, 4) gemm_lds<4, 4, 1>(ATm, 32, BtT, 32, acc, fr, fq);
#pragma unroll
                    for (int m = 0; m < 4; ++m)
#pragma unroll
                        for (int n = 0; n < 4; ++n)
#pragma unroll
                            for (int j = 0; j < 4; ++j) { const float v = acc[m][n][j] * gLs[16 * n + 4 * fq + j];
                                (n < 2 ? Wb : Kb)[sbase + lpA + (size_t)(j * 8 + (2 * (n & 1) + 8 * m) * 512)] = bf1of(v); }
                    ZACC(4, 4) gemm_lds<4, 4, 1>(W1T, 32, BtT, 32, acc, fr, fq); gemm_lds<4, 4, 1>(VmT, 32, KtT, 32, acc, fr, fq);
#pragma unroll
                    for (int m = 0; m < 4; ++m)
#pragma unroll
                        for (int n = 0; n < 4; ++n)
#pragma unroll
                            for (int j = 0; j < 4; ++j) { const float v = acc[m][n][j] * gLs[16 * n + 4 * fq + j];
                                (m < 2 ? KKb : Bvb)[sbase + lpC + (size_t)(j + 8 * (n & 1) + (4 * (m & 1) + 16 * (n >> 1)) * 512)] = bf1of(v); }
                }
#undef ZACC
            }
        }
    }
    xcd_barrier(xb);

    {
        PHASE_PTRS
        if (wave < 5 && blockIdx.x < 64) {
            const int item = blockIdx.x, bh = item >> 1, wv = item & 1, b = bh >> 3, h = bh & 7;
            const int hi = lane >> 5, vcol = lane & 31;
            float* GL = (float*)(dob + DO_GL);
            volatile LAS unsigned* ctr = (volatile LAS unsigned*)((LAS unsigned char*)lds + LDS_BYTES - 64);
#define SLICE(arr, sb, li) ((arr) + (sb) + (size_t)((li) >> 6) * 512 + ((li) & 63))
#define DMA16(src_, dst_) __builtin_amdgcn_global_load_lds((const unsigned*)(src_), (LAS unsigned*)(dst_), 16, 0, 0)
            if (wave >= 1 && wave <= 3) {
                __builtin_amdgcn_s_setprio(2);
#pragma unroll 1
                for (int c = 0; c < 128; ++c) {
                    if (c >= 4) { while ((int)ctr[3] < c - 3) __builtin_amdgcn_s_sleep(1); }
                    asm volatile("" ::: "memory");
                    const size_t sb = ((size_t)b * SEQ + c * 32) * 512 + h * 64; LAS unsigned char* lb = (LAS unsigned char*)lds + (c & 3) * 19712;
                    if (wave == 1) {
#pragma unroll
                        for (int q = 0; q < 4; ++q) DMA16(SLICE(Wb, sb, (q * 64 + lane) * 8), lb + q * 1024);
#pragma unroll
                        for (int q = 0; q < 2; ++q) DMA16(SLICE(Kb, sb, (q * 64 + lane) * 8), lb + 4096 + q * 1024);
                        asm volatile("s_waitcnt vmcnt(12)" ::: "memory");
                    } else if (wave == 2) {
#pragma unroll
                        for (int q = 2; q < 4; ++q) DMA16(SLICE(Kb, sb, (q * 64 + lane) * 8), lb + 4096 + q * 1024);
#pragma unroll
                        for (int q = 0; q < 4; ++q) DMA16(SLICE(Rb, sb, (q * 64 + lane) * 8), lb + 8192 + q * 1024);
                        asm volatile("s_waitcnt vmcnt(12)" ::: "memory");
                    } else {
#pragma unroll
                        for (int kb = 0; kb < 2; ++kb)
#pragma unroll
                            for (int hf = 0; hf < 2; ++hf) DMA16(SLICE(wv ? Bvb : KKb, sb, (kb * 64 + lane) * 16 + 8 * hf), lb + 12288 + kb * 2048 + hf * 1024);
#pragma unroll
                        for (int hf = 0; hf < 2; ++hf) DMA16(Yb + sb + (size_t)(lane >> 1) * 512 + 32 * wv + 16 * (lane & 1) + 8 * hf, lb + 16384 + hf * 1024);
                        __builtin_amdgcn_global_load_lds((const unsigned*)(GL + ((size_t)(bh * 128 + c)) * 64 + lane), (LAS unsigned*)(lb + 18432), 4, 0, 0);
                        asm volatile("s_waitcnt vmcnt(14)" ::: "memory");
                    }
                    if (c >= 2 && lane == 0) ctr[wave - 1] = (unsigned)(c - 1);
                }
                asm volatile("s_waitcnt vmcnt(0)" ::: "memory");
                if (lane == 0) ctr[wave - 1] = 128u;
                __builtin_amdgcn_s_setprio(0);
            } else if (wave == 4) {
#pragma unroll 1
                for (int c = 0; c < 128; ++c) {
                    while ((int)ctr[4] <= c) __builtin_amdgcn_s_sleep(2);
                    asm volatile("" ::: "memory");
                    const LAS u32x4* ys = (const LAS u32x4*)((LAS unsigned char*)lds + 81920 + (c & 7) * 2048 + lane * 32);
                    const u32x4 ya = ys[0], yb = ys[1];
                    u32x4* yo = (u32x4*)(Yb + ((size_t)b * SEQ + c * 32 + (lane >> 1)) * 512 + h * 64 + 32 * wv + 16 * (lane & 1));
                    yo[0] = ya; yo[1] = yb;
                    asm volatile("s_waitcnt lgkmcnt(0)" ::: "memory");
                    if (lane == 0) ctr[5] = (unsigned)(c + 1);
                }
            } else {
                __builtin_amdgcn_s_setprio(3);
                f32x16 S0t, S1t;
#pragma unroll
                for (int r = 0; r < 16; ++r) { S0t[r] = 0.f; S1t[r] = 0.f; }
#pragma unroll 1
                for (int c = 0; c < 128; ++c) {
                    while ((int)ctr[0] <= c || (int)ctr[1] <= c || (int)ctr[2] <= c) __builtin_amdgcn_s_sleep(1);
                    asm volatile("" ::: "memory");
                    const LAS unsigned char* lb = (const LAS unsigned char*)lds + (c & 3) * 19712;
                    bf16x8 sf[4];
#pragma unroll
                    for (int s = 0; s < 4; ++s) { float t8[8];
#pragma unroll
                        for (int j = 0; j < 8; ++j) t8[j] = (s < 2 ? S0t : S1t)[8 * (s & 1) + j];
                        sf[s] = pack8(t8); }
                    f32x16 yt;
                    { const u32x4 c0 = *(const LAS u32x4*)(lb + 16384 + lane * 16), c1 = *(const LAS u32x4*)(lb + 16384 + 1024 + lane * 16);
                      yt[0] = bflo(c0.x); yt[1] = bfhi(c0.x); yt[2] = bflo(c0.y); yt[3] = bfhi(c0.y); yt[4] = bflo(c0.z); yt[5] = bfhi(c0.z); yt[6] = bflo(c0.w); yt[7] = bfhi(c0.w);
                      yt[8] = bflo(c1.x); yt[9] = bfhi(c1.x); yt[10] = bflo(c1.y); yt[11] = bfhi(c1.y); yt[12] = bflo(c1.z); yt[13] = bfhi(c1.z); yt[14] = bflo(c1.w); yt[15] = bfhi(c1.w); }
                    f32x16 n0, n1;
#pragma unroll
                    for (int kb = 0; kb < 2; ++kb) {
                        const u32x4 c0 = *(const LAS u32x4*)(lb + 12288 + kb * 2048 + lane * 16), c1 = *(const LAS u32x4*)(lb + 12288 + kb * 2048 + 1024 + lane * 16);
                        const LAS float* gp = (const LAS float*)(lb + 18432) + kb * 32 + hi * 16;
                        f32x16 nn; const f32x16 so = kb ? S1t : S0t;
                        nn[0] = bflo(c0.x); nn[1] = bfhi(c0.x); nn[2] = bflo(c0.y); nn[3] = bfhi(c0.y); nn[4] = bflo(c0.z); nn[5] = bfhi(c0.z); nn[6] = bflo(c0.w); nn[7] = bfhi(c0.w);
                        nn[8] = bflo(c1.x); nn[9] = bfhi(c1.x); nn[10] = bflo(c1.y); nn[11] = bfhi(c1.y); nn[12] = bflo(c1.z); nn[13] = bfhi(c1.z); nn[14] = bflo(c1.w); nn[15] = bfhi(c1.w);
#pragma unroll
                        for (int r = 0; r < 16; ++r) nn[r] += gp[r] * so[r];
                        if (kb) n1 = nn; else n0 = nn;
                    }
#pragma unroll
                    for (int s = 0; s < 4; ++s) {
                        const bf16x8 ra = *(const LAS bf16x8*)(lb + 8192 + s * 1024 + lane * 16);
                        const bf16x8 p0 = *(const LAS bf16x8*)(lb + s * 1024 + lane * 16), p1 = *(const LAS bf16x8*)(lb + 4096 + s * 1024 + lane * 16);
                        yt = mfma32(ra, sf[s], yt); n0 = mfma32(p0, sf[s], n0); n1 = mfma32(p1, sf[s], n1);
                    }
                    S0t = n0; S1t = n1;
                    asm volatile("s_waitcnt lgkmcnt(0)" ::: "memory");
                    if (lane == 0) ctr[3] = (unsigned)(c + 1);
                    if (c >= 8) { while ((int)ctr[5] < c - 7) __builtin_amdgcn_s_sleep(1); }
                    asm volatile("" ::: "memory");
                    { LAS bf16_t* ys = (LAS bf16_t*)((LAS unsigned char*)lds + 81920 + (c & 7) * 2048) + vcol;
#pragma unroll
                      for (int r = 0; r < 16; ++r) ys[crow(r, hi) * 32] = bf1of(yt[r]);
                      asm volatile("s_waitcnt lgkmcnt(0)" ::: "memory");
                      if (lane == 0) ctr[4] = (unsigned)(c + 1); }
                }
                __builtin_amdgcn_s_setprio(0);
            }
#undef DMA16
#undef SLICE
        }
        for (;;) {
            unsigned item = 0;
            const int xg = blockIdx.x & 7;
            if (lane == 0) item = atomicAdd(&cnt[xg], 1u);
            item = __builtin_amdgcn_readfirstlane(item);
            if (item >= 256u) break;
            const int qt = 63 - (int)(item >> 2), bh = 8 * (int)(item & 3) + xg, b = bh >> 3, h = bh & 7;
            const int qi = lane & 31, hi = lane >> 5;
            const size_t tokq = (size_t)b * SEQ + qt * 64 + qi;
            bf16x8 qfa[6], qfb[6];
#pragma unroll
            for (int s = 0; s < 6; ++s) { qfa[s] = *(const bf16x8*)(Qb + (tokq * 8 + h) * 96 + 16 * s + 8 * hi); qfb[s] = *(const bf16x8*)(Qb + ((tokq + 32) * 8 + h) * 96 + 16 * s + 8 * hi); }
            float ma = -1e30f, la = 0.f, mb = -1e30f, lb = 0.f;
            f32x16 oa0, oa1, ob0, ob1;
#pragma unroll
            for (int r = 0; r < 16; ++r) { oa0[r] = 0.f; oa1[r] = 0.f; ob0[r] = 0.f; ob1[r] = 0.f; }
            const bf16_t* kfb = Kab + ((size_t)(b * 8 + h) * 128) * 6 * 512 + lane * 8;
            const bf16_t* vfb = Vt + ((size_t)(b * 8 + h) * 128) * 4 * 512 + lane * 8;
            const int nt = 2 * qt + 2;
#define ATT_GROUP(QF, M_, L_, O0, O1, DIAG) { \
                f32x16 xs; _Pragma("unroll") for (int r = 0; r < 16; ++r) xs[r] = 0.f; \
                _Pragma("unroll") for (int s = 0; s < 6; ++s) xs = mfma32(kf[s], QF[s], xs); \
                if (DIAG) { _Pragma("unroll") for (int r = 0; r < 16; ++r) if (crow(r, hi) > qi) xs[r] = -1e30f; } \
                float mx = xs[0]; _Pragma("unroll") for (int r = 1; r < 16; ++r) mx = fmaxf(mx, xs[r]); \
                mx = fmaxf(mx, __shfl_xor(mx, 32)); \
                if (__any(mx > M_)) { const float mn = fmaxf(M_, mx), alpha = __builtin_amdgcn_exp2f(M_ - mn); L_ *= alpha; M_ = mn; \
                    _Pragma("unroll") for (int r = 0; r < 16; ++r) { O0[r] *= alpha; O1[r] *= alpha; } } \
                float ps = 0.f; _Pragma("unroll") for (int r = 0; r < 16; ++r) { xs[r] = __builtin_amdgcn_exp2f(xs[r] - M_); ps += xs[r]; } \
                L_ += ps; \
                _Pragma("unroll") for (int s = 0; s < 2; ++s) { float t8[8]; _Pragma("unroll") for (int j = 0; j < 8; ++j) t8[j] = xs[8 * s + j]; const bf16x8 pbs = pack8(t8); \
                    O0 = mfma32(vf[0][s], pbs, O0); O1 = mfma32(vf[1][s], pbs, O1); } }
#pragma unroll 1
            for (int kt = 0; kt < nt; ++kt) {
                bf16x8 kf[6], vf[2][2];
#pragma unroll
                for (int s = 0; s < 6; ++s) kf[s] = *(const bf16x8*)(kfb + (size_t)(kt * 6 + s) * 512);
#pragma unroll
                for (int d0 = 0; d0 < 2; ++d0)
#pragma unroll
                    for (int s = 0; s < 2; ++s) vf[d0][s] = *(const bf16x8*)(vfb + (size_t)((kt * 2 + d0) * 2 + s) * 512);
                if (kt < nt - 1) ATT_GROUP(qfa, ma, la, oa0, oa1, kt == nt - 2)
                ATT_GROUP(qfb, mb, lb, ob0, ob1, kt == nt - 1)
            }
#undef ATT_GROUP
            la += __shfl_xor(la, 32); lb += __shfl_xor(lb, 32);
            const float ila = 1.f / la, ilb = 1.f / lb;
            bf16_t* orow = Ob + tokq * 512 + h * 64;
#pragma unroll
            for (int g = 0; g < 4; ++g) {
                st_bf4(orow + 8 * g + 4 * hi, oa0[4 * g] * ila, oa0[4 * g + 1] * ila, oa0[4 * g + 2] * ila, oa0[4 * g + 3] * ila);
                st_bf4(orow + 32 + 8 * g + 4 * hi, oa1[4 * g] * ila, oa1[4 * g + 1] * ila, oa1[4 * g + 2] * ila, oa1[4 * g + 3] * ila);
                st_bf4(orow + (size_t)32 * 512 + 8 * g + 4 * hi, ob0[4 * g] * ilb, ob0[4 * g + 1] * ilb, ob0[4 * g + 2] * ilb, ob0[4 * g + 3] * ilb);
                st_bf4(orow + (size_t)32 * 512 + 32 + 8 * g + 4 * hi, ob1[4 * g] * ilb, ob1[4 * g + 1] * ilb, ob1[4 * g + 2] * ilb, ob1[4 * g + 3] * ilb);
            }
        }
    }
    xcd_barrier(xb);

    {
        PHASE_PTRS
        for (int t = gw; t < T; t += NGW) {
            const int ch = 8 * lane, h = lane >> 3;
            float y[8], v[8], g[8]; ld_bf8(Yb + (size_t)t * 512 + ch, y); ld_bf8(Vb + (size_t)t * 512 + ch, v); ld_bf8(Gtb + (size_t)t * 512 + ch, g);
            float s = 0.f;
#pragma unroll
            for (int i = 0; i < 8; ++i) s += y[i];
            s += __shfl_xor(s, 1); s += __shfl_xor(s, 2); s += __shfl_xor(s, 4);
            const float mu = s * (1.f / 64.f); float q = 0.f;
#pragma unroll
            for (int i = 0; i < 8; ++i) { y[i] -= mu; q += y[i] * y[i]; }
            q += __shfl_xor(q, 1); q += __shfl_xor(q, 2); q += __shfl_xor(q, 4);
            const float rstd = rsqrtf(q * (1.f / 64.f) + 64e-5f);
            const float bo = bonus[(size_t)t * 8 + h];
            const f32x4 lw0 = *(const f32x4*)(rw_ln_w + ch), lw1 = *(const f32x4*)(rw_ln_w + ch + 4), lb0 = *(const f32x4*)(rw_ln_b + ch), lb1 = *(const f32x4*)(rw_ln_b + ch + 4);
            float o[8];
#pragma unroll
            for (int i = 0; i < 8; ++i) { const float lw = i < 4 ? lw0[i & 3] : lw1[i & 3], lb = i < 4 ? lb0[i & 3] : lb1[i & 3]; o[i] = (y[i] * rstd * lw + lb + bo * v[i]) * g[i]; }
            *(bf16x8*)(YA + (size_t)t * 512 + ch) = pack8(o);
        }
    }
    xcd_barrier(xb);

    {
        PHASE_PTRS
        pg8::StaticOrder S; S.init(T, 1024, G, (int)blockIdx.x);
        { pg8::Gemm g{YA, RwoT, T, 1024, 512}; pg8::EpiGate E{MIXED, Gg, 0, 0};
          pg8::gemm_phase<pg8::EpiGate, pg8::StaticOrder, true, true>((PG8_LAS unsigned char*)lds, g, S, E); }
        { pg8::Gemm g{Ob, MwoT, T, 1024, 512}; pg8::EpiGate E{MIXED, Gg, 1024, 1};
          pg8::gemm_phase<pg8::EpiGate, pg8::StaticOrder, true, true>((PG8_LAS unsigned char*)lds, g, S, E); }
    }
    xcd_barrier(xb);

    {
        PHASE_PTRS
        { pg8::Gemm g{MIXED, WoutT, T, 1024, 1024}; pg8::StaticOrder S; S.init(T, 1024, G, (int)blockIdx.x);
          pg8::EpiRes E{x, kp->out, HB, ss2};
          pg8::gemm_phase<pg8::EpiRes, pg8::StaticOrder, true, true>((PG8_LAS unsigned char*)lds, g, S, E); }
        { const float* pu = kp->in[29]; const float* pv = kp->in[30];
          for (size_t i = (size_t)blockIdx.x * NT + tid; i < (size_t)16384 * 1024 / 16; i += (size_t)G * NT) {
              u32x4 uo, vo;
#pragma unroll
              for (int q = 0; q < 4; ++q) {
                  const f32x4 u = ((const f32x4*)pu)[i * 4 + q]; const f32x4 w = ((const f32x4*)norm2_w)[(i & 63) * 4 + q];
                  uo[q] = pk4_fp8(u.x * w.x * U8_SCALE, u.y * w.y * U8_SCALE, u.z * w.z * U8_SCALE, u.w * w.w * U8_SCALE);
                  const f32x4 v = ((const f32x4*)pv)[i * 4 + q]; vo[q] = pk4_fp8(v.x * V8_SCALE, v.y * V8_SCALE, v.z * V8_SCALE, v.w * V8_SCALE);
              }
              ((u32x4*)UB)[i] = uo;
              { const size_t e = i >> 6; const int d0 = (int)(i & 63) * 16; *(u32x4*)((unsigned char*)VBp + ((size_t)(d0 >> 7) * 16384 + e) * 128 + (d0 & 127)) = vo; } } }
    }
    xcd_barrier(xb);

    {
        PHASE_PTRS
        pg8::Gemm g{HB, PwqT, T, 2048, 1024}; pg8::StaticOrder S; S.init(T, 2048, G, (int)blockIdx.x);
        pg8::EpiScale E{SC, ss2};
        pg8::gemm_phase<pg8::EpiScale, pg8::StaticOrder, true, true>((PG8_LAS unsigned char*)lds, g, S, E);
    }
    xcd_barrier(xb);

    {
        PHASE_PTRS
        const int wp = wave & 3; const bool producer = wave < 4;
        volatile LAS unsigned* pc = (volatile LAS unsigned*)((LAS unsigned char*)lds + LDS_BYTES - 128) + 2 * wp;
        int kq = 0;
        for (int t = blockIdx.x * 4 + wp; t < T; t += G * 4, ++kq) {
            LAS unsigned char* wl = (LAS unsigned char*)lds + wp * 4096 + (kq & 1) * 2048;
            LAS u32x2* tab = (LAS u32x2*)wl;
            const float rs = rsqrtf(ss2[t] * (1.f / DM) + EPS);
            if (producer) {
            if (kq >= 2) { while ((int)pc[1] < kq - 1) __builtin_amdgcn_s_sleep(2); }
            asm volatile("" ::: "memory");
            { float xa[8], xb[8]; ld_bf8(HB + (size_t)t * DM + 16 * lane, xa); ld_bf8(HB + (size_t)t * DM + 16 * lane + 8, xb);
              u32x4 w; w.x = pk4_fp8(xa[0], xa[1], xa[2], xa[3]); w.y = pk4_fp8(xa[4], xa[5], xa[6], xa[7]); w.z = pk4_fp8(xb[0], xb[1], xb[2], xb[3]); w.w = pk4_fp8(xb[4], xb[5], xb[6], xb[7]);
              *(LAS u32x4*)(wl + 1024 + lane * 16) = w; }
#define SORT4(k) { unsigned hi_, lo_; \
                    hi_ = umax2(k[0], k[1]); lo_ = k[0] < k[1] ? k[0] : k[1]; k[0] = hi_; k[1] = lo_; hi_ = umax2(k[2], k[3]); lo_ = k[2] < k[3] ? k[2] : k[3]; k[2] = hi_; k[3] = lo_; \
                    hi_ = umax2(k[0], k[2]); lo_ = k[0] < k[2] ? k[0] : k[2]; k[0] = hi_; k[2] = lo_; hi_ = umax2(k[1], k[3]); lo_ = k[1] < k[3] ? k[1] : k[3]; k[1] = hi_; k[3] = lo_; \
                    hi_ = umax2(k[1], k[2]); lo_ = k[1] < k[2] ? k[1] : k[2]; k[1] = hi_; k[2] = lo_; }
#pragma unroll 1
            for (int hg = 0; hg < 8; hg += 4) {
                unsigned key[4][4], top[4];
#pragma unroll
                for (int q = 0; q < 4; ++q) {
                    const u32x2 w = *(const u32x2*)(SC + (size_t)t * 2048 + (hg + q) * 256 + 4 * lane);
                    const float f[4] = {bflo(w.x), bfhi(w.x), bflo(w.y), bfhi(w.y)};
#pragma unroll
                    for (int c = 0; c < 4; ++c) { unsigned u = __float_as_uint(f[c]); u = (u & 0x80000000u) ? ~u : (u | 0x80000000u); key[q][c] = (u & ~127u) | (unsigned)(127 - (4 * (lane & 31) + c)); }
                    SORT4(key[q])
                    top[q] = 0u;
                }
#pragma unroll 1
                for (int r = 0; r < 16; ++r) {
                    const bool isr = (lane & 31) == r;
#pragma unroll
                    for (int q = 0; q < 4; ++q) {
                        unsigned m = umax16(key[q][0]);
                        { const auto rr = __builtin_amdgcn_permlane16_swap(m, m, false, false); m = umax2(rr[0], rr[1]); }
                        const bool win = key[q][0] == m;
                        key[q][0] = win ? key[q][1] : key[q][0]; key[q][1] = win ? key[q][2] : key[q][1]; key[q][2] = win ? key[q][3] : key[q][2]; key[q][3] = win ? 0u : key[q][3];
                        top[q] = isr ? m : top[q];
                    }
                }
                unsigned ck[4][4], best[4];
#pragma unroll
                for (int q = 0; q < 4; ++q) {
                    float sval; { unsigned u = top[q] & ~127u; u = (u & 0x80000000u) ? (u & 0x7fffffffu) : ~u; sval = __uint_as_float(u); }
                    const float a = __shfl(sval, lane >> 2);
#pragma unroll
                    for (int c = 0; c < 4; ++c) { const float bsc = __shfl(sval, 32 + 4 * (lane & 3) + c); unsigned u = __float_as_uint(a + bsc); u = (u & 0x80000000u) ? ~u : (u | 0x80000000u);
                        ck[q][c] = (u & ~255u) | (unsigned)(255 - ((lane >> 2) * 16 + 4 * (lane & 3) + c)); }
                    SORT4(ck[q])
                    best[q] = 0u;
                }
#pragma unroll 1
                for (int r = 0; r < 16; ++r) {
                    const bool isr = lane == r;
#pragma unroll
                    for (int q = 0; q < 4; ++q) {
                        unsigned m = umax16(ck[q][0]);
                        { const auto rr = __builtin_amdgcn_permlane16_swap(m, m, false, false); m = umax2(rr[0], rr[1]); }
                        { const auto rr = __builtin_amdgcn_permlane32_swap(m, m, false, false); m = umax2(rr[0], rr[1]); }
                        const bool win = ck[q][0] == m;
                        ck[q][0] = win ? ck[q][1] : ck[q][0]; ck[q][1] = win ? ck[q][2] : ck[q][1]; ck[q][2] = win ? ck[q][3] : ck[q][2]; ck[q][3] = win ? 0u : ck[q][3];
                        best[q] = isr ? m : best[q];
                    }
                }
#pragma unroll
                for (int q = 0; q < 4; ++q) {
                    float bs; { unsigned u = best[q] & ~255u; u = (u & 0x80000000u) ? (u & 0x7fffffffu) : ~u; bs = __uint_as_float(u); }
                    const int pos = 255 - (int)(best[q] & 255u);
                    const float bmax = __uint_as_float(rdlane(__float_as_uint(bs), 0));
                    const float e = lane < 16 ? __expf(bs - bmax) : 0.f;
                    const float gate = e / sum16(e);
                    const unsigned t1 = (unsigned)__shfl((int)top[q], (pos >> 4) & 15), t2 = (unsigned)__shfl((int)top[q], 32 + (pos & 15));
                    const unsigned eid = (127u - (t1 & 127u)) * 128u + (127u - (t2 & 127u));
                    if (lane < 16) tab[16 * (hg + q) + lane] = (u32x2){eid, __float_as_uint(gate)};
                }
            }
#undef SORT4
            asm volatile("s_waitcnt lgkmcnt(0)" ::: "memory");
            if (lane == 0) pc[0] = (unsigned)(kq + 1);
            } else {
            while ((int)pc[0] <= kq) __builtin_amdgcn_s_sleep(2);
            asm volatile("" ::: "memory");
            const unsigned char* UB8 = (const unsigned char*)UB; const unsigned char* VB8 = (const unsigned char*)VBp;
            u32x4 ua[16];
            { const unsigned char* up = UB8 + (size_t)tab[fr].x * DM + 16 * fq;
#pragma unroll
              for (int s = 0; s < 16; ++s) ua[s] = *(const u32x4*)(up + 64 * s); }
#pragma unroll 1
            for (int h = 0; h < 8; ++h) {
                u32x4 uc[16];
#pragma unroll
                for (int s = 0; s < 16; ++s) uc[s] = ua[s];
                { const int hn = h + 1 < 8 ? h + 1 : 7; const unsigned char* up = UB8 + (size_t)tab[16 * hn + fr].x * DM + 16 * fq;
#pragma unroll
                  for (int s = 0; s < 16; ++s) ua[s] = *(const u32x4*)(up + 64 * s); }
                f32x4 ac0 = (f32x4){0.f, 0.f, 0.f, 0.f}, ac1 = ac0, ac2 = ac0, ac3 = ac0;
#pragma unroll
                for (int s = 0; s < 16; s += 2) {
                    const u32x4 b0 = *(const LAS u32x4*)(wl + 1024 + 64 * s + 16 * fq), b1 = *(const LAS u32x4*)(wl + 1024 + 64 * (s + 1) + 16 * fq);
                    ac0 = mfma16_fp8((u32x2){uc[s].x, uc[s].y}, (u32x2){b0.x, b0.y}, ac0);
                    ac1 = mfma16_fp8((u32x2){uc[s].z, uc[s].w}, (u32x2){b0.z, b0.w}, ac1);
                    ac2 = mfma16_fp8((u32x2){uc[s + 1].x, uc[s + 1].y}, (u32x2){b1.x, b1.y}, ac2);
                    ac3 = mfma16_fp8((u32x2){uc[s + 1].z, uc[s + 1].w}, (u32x2){b1.z, b1.w}, ac3);
                }
                const f32x4 acc = (ac0 + ac1) + (ac2 + ac3);
                const int j = fr & 3;
                const float d = (j == 0 ? acc[0] : (j == 1 ? acc[1] : (j == 2 ? acc[2] : acc[3]))) * (rs * (1.f / U8_SCALE));
                const float act = 0.5f * d * (1.f + erff(d * 0.7071067811865476f));
                if (fr < 4) { const int i = 16 * h + 4 * fq + fr; const float g = __uint_as_float(tab[i].y); tab[i].y = __float_as_uint(g * act * (1.f / V8_SCALE)); }
            }
            asm volatile("s_waitcnt lgkmcnt(0)" ::: "memory");
            { const u32x4 tv = *(const LAS u32x4*)(wl + lane * 16); *(u32x4*)(ws + WS_TAB + (size_t)t * 1024 + lane * 16) = tv; }
            asm volatile("s_waitcnt lgkmcnt(0)" ::: "memory");
            if (lane == 0) pc[1] = (unsigned)(kq + 1);
            }
        }
    }
    xcd_barrier(xb);

    {
        PHASE_PTRS
        const unsigned sl = blockIdx.x & 7;
        const unsigned char* VS = (const unsigned char*)VBp + (size_t)sl * 16384 * 128;
        const int rho = lane >> 3, chi = lane & 7;
        constexpr float CSCALE = 256.f;
        unsigned selLo[4], selHi[4];
#pragma unroll
        for (int k = 0; k < 4; ++k) { const unsigned sh = 8u * (unsigned)(chi & 3); const unsigned v = (0x0c0c0c0cu & ~(0xffu << sh)) | ((unsigned)k << sh);
            selLo[k] = chi < 4 ? v : 0x0c0c0c0cu; selHi[k] = chi < 4 ? 0x0c0c0c0cu : v; }
        const bool olane = (lane & 0x28) == 0;
        const unsigned voff0 = 16u * (unsigned)chi;
        LAS unsigned char* wraw = (LAS unsigned char*)lds + wave * 18432; LAS unsigned char* wl8 = wraw + 8192;
        const int wstride = (G >> 3) * NWAVES, tg0 = (blockIdx.x >> 3) * NWAVES + wave;
        const int nb = tg0 < T / 8 ? (T / 8 - tg0 + wstride - 1) / wstride : 0, ntok = nb * 8;
#define P6C_TOK(i_) ((tg0 + ((i_) >> 3) * wstride) * 8 + ((i_) & 7))
#define P6C_DMA(b_) { _Pragma("unroll") for (int q = 0; q < 8; ++q) __builtin_amdgcn_global_load_lds((const unsigned*)(ws + WS_TAB + (size_t)((tg0 + (b_) * wstride) * 8 + q) * 1024 + lane * 16), (LAS unsigned*)(wraw + q * 1024), 16, 0, 0); }
#define P6C_XPOSE(b_) { _Pragma("unroll") for (int q = 0; q < 8; ++q) { const u32x4 tv = *(const LAS u32x4*)(wraw + q * 1024 + lane * 16); \
            LAS unsigned char* tq = wl8 + ((b_) & 1) * 3072 + q * 384; const int r0 = 2 * (lane & 3), l0 = lane >> 2; \
            *(LAS unsigned short*)(tq + (r0 * 16 + l0) * 2) = (unsigned short)tv.x; *(LAS unsigned short*)(tq + ((r0 + 1) * 16 + l0) * 2) = (unsigned short)tv.z; \
            const float c0 = fminf(fmaxf(__uint_as_float(tv.y) * CSCALE, -440.f), 440.f), c1 = fminf(fmaxf(__uint_as_float(tv.w) * CSCALE, -440.f), 440.f); \
            const unsigned c8 = (unsigned)__builtin_amdgcn_cvt_pk_fp8_f32(c0, c1, 0, false); \
            *(tq + 256 + r0 * 16 + l0) = (unsigned char)(c8 & 0xffu); *(tq + 256 + (r0 + 1) * 16 + l0) = (unsigned char)((c8 >> 8) & 0xffu); } }
#define P6C_TAB(EL, EH, CW, i_) { const int ii_ = (i_) < ntok ? (i_) : ntok - 1; const LAS unsigned char* tq_ = wl8 + ((ii_ >> 3) & 1) * 3072 + (ii_ & 7) * 384; \
            EL = *(const LAS u32x4*)(tq_ + rho * 32); EH = *(const LAS u32x4*)(tq_ + rho * 32 + 16); CW = *(const LAS u32x4*)(tq_ + 256 + rho * 16); }
#define P6C_EID(ER, j_) (((j_) & 1) ? (ER[(j_) >> 1] >> 16) : (ER[(j_) >> 1] & 0xffffu))
#define P6C_LOAD(VV, ER) { _Pragma("unroll") for (int j = 0; j < 8; ++j) VV[j] = *(const u32x4*)(VS + (size_t)((P6C_EID(ER, j) << 7) | voff0)); }
#define P6C_USE(VV, CWA, CWB) { _Pragma("unroll") for (int j = 0; j < 8; ++j) { const unsigned cwd = (j < 4) ? CWA : CWB; \
            u32x2 xo; xo.x = __builtin_amdgcn_perm(cwd, cwd, selLo[j & 3]); xo.y = __builtin_amdgcn_perm(cwd, cwd, selHi[j & 3]); \
            acc0 = mfma16_fp8(xo, (u32x2){VV[j].x, VV[j].y}, acc0); acc1 = mfma16_fp8(xo, (u32x2){VV[j].z, VV[j].w}, acc1); } }
#define P6C_BODY(i_, VA, VB, EL, EH, CW, VBo, EHo) { \
            float* orow = kp->out + (size_t)P6C_TOK(i_) * DM + 128 * sl + 16 * chi + 4 * ((lane >> 4) & 1); \
            f32x4 h0 = (f32x4){0.f, 0.f, 0.f, 0.f}, h1 = h0; \
            if (olane) { h0 = *(const f32x4*)orow; h1 = *(const f32x4*)(orow + 8); } \
            P6C_LOAD(VBo, EHo)                                     \
            const u32x4 cwq = CW; \
            __builtin_amdgcn_sched_barrier(0); \
            f32x4 acc0 = (f32x4){0.f, 0.f, 0.f, 0.f}, acc1 = acc0; \
            P6C_USE(VA, cwq.x, cwq.y) \
            __builtin_amdgcn_sched_barrier(0); \
            P6C_TAB(EL, EH, CW, (i_) + 2) \
            P6C_LOAD(VA, EL)                                       \
            __builtin_amdgcn_sched_barrier(0); \
            P6C_USE(VB, cwq.z, cwq.w) \
            float s[8]; \
            _Pragma("unroll") for (int r = 0; r < 4; ++r) {        \
                { const auto rr = __builtin_amdgcn_permlane32_swap(__float_as_uint(acc0[r]), __float_as_uint(acc0[r]), false, false); s[r] = acc0[r] + dpp_f<0x128>(__uint_as_float(rr[1])); } \
                { const auto rr = __builtin_amdgcn_permlane32_swap(__float_as_uint(acc1[r]), __float_as_uint(acc1[r]), false, false); s[4 + r] = acc1[r] + dpp_f<0x128>(__uint_as_float(rr[1])); } } \
            if (olane) { *(f32x4*)orow = h0 + (f32x4){s[0], s[1], s[2], s[3]} * (1.f / CSCALE); *(f32x4*)(orow + 8) = h1 + (f32x4){s[4], s[5], s[6], s[7]} * (1.f / CSCALE); } \
            __builtin_amdgcn_sched_barrier(0); }
        if (nb > 0) {
            u32x4 vA0[8], vB0[8], vA1[8], vB1[8];
            u32x4 eL0, eH0, cw0, eL1, eH1, cw1;
            P6C_DMA(0)
            asm volatile("s_waitcnt vmcnt(0)" ::: "memory");
            P6C_XPOSE(0)
            asm volatile("s_waitcnt lgkmcnt(0)" ::: "memory");
            if (nb > 1) P6C_DMA(1)
            P6C_TAB(eL0, eH0, cw0, 0)
            P6C_LOAD(vA0, eL0)
            P6C_LOAD(vB0, eH0)
            P6C_TAB(eL1, eH1, cw1, 1)
            P6C_LOAD(vA1, eL1)
#pragma unroll 1
            for (int i = 0; i < ntok; i += 2) {
                if ((i & 7) == 4 && (i >> 3) + 1 < nb) {
                    asm volatile("s_waitcnt vmcnt(40)" ::: "memory");
                    P6C_XPOSE((i >> 3) + 1)
                    asm volatile("s_waitcnt lgkmcnt(0)" ::: "memory");
                    if ((i >> 3) + 2 < nb) P6C_DMA((i >> 3) + 2)
                }
                P6C_BODY(i, vA0, vB0, eL0, eH0, cw0, vB1, eH1)
                P6C_BODY(i + 1, vA1, vB1, eL1, eH1, cw1, vB0, eH0)
            }
            asm volatile("s_waitcnt vmcnt(0) lgkmcnt(0)" ::: "memory");
        }
#undef P6C_BODY
#undef P6C_USE
#undef P6C_LOAD
#undef P6C_EID
#undef P6C_TAB
#undef P6C_XPOSE
#undef P6C_DMA
#undef P6C_TOK
    }
}

extern "C" void kernel_launch(void* const* d_in, const int* in_sizes, int n_in, void* d_out, int out_size,
                              void* d_ws, size_t ws_size, hipStream_t stream) {
    static int grid_blocks = 0;
    if (!grid_blocks) {
        int dev = 0, cus = 0, per_cu = 0;
        (void)hipGetDevice(&dev);
        (void)hipDeviceGetAttribute(&cus, hipDeviceAttributeMultiprocessorCount, dev);
        (void)hipFuncSetAttribute((const void*)mega, hipFuncAttributeMaxDynamicSharedMemorySize, LDS_BYTES);
        (void)hipOccupancyMaxActiveBlocksPerMultiprocessor(&per_cu, (const void*)mega, NT, LDS_BYTES);
        if (per_cu < 1) per_cu = 1;
        if (per_cu > 1) per_cu = 1;
        grid_blocks = cus * per_cu;
        if (ws_size < 256 * MiB) fprintf(stderr, "kernel_launch: workspace too small: %zu\n", ws_size);
    }
    Params p{};
    for (int i = 0; i < 31; ++i) p.in[i] = (const float*)d_in[i];
    p.out = (float*)d_out;
    p.ws = (unsigned char*)d_ws;
    void* args[] = {&p};
    hipError_t e = hipLaunchCooperativeKernel((const void*)mega, dim3(grid_blocks), dim3(NT), args, LDS_BYTES, stream);
    if (e != hipSuccess) fprintf(stderr, "cooperative launch failed: %s (grid %d)\n", hipGetErrorString(e), grid_blocks);
}
```

```cpp
#include <hip/hip_runtime.h>
#include <hip/hip_cooperative_groups.h>
#include <cstdio>
#include <cstdint>
namespace cg = cooperative_groups;

#define DEVI __device__ __forceinline__
typedef unsigned short bf16_t;
typedef short bf16x8 __attribute__((ext_vector_type(8)));
typedef float f32x4 __attribute__((ext_vector_type(4)));
typedef float f32x16 __attribute__((ext_vector_type(16)));
typedef unsigned u32x2 __attribute__((ext_vector_type(2)));
typedef unsigned u32x4 __attribute__((ext_vector_type(4)));

constexpr int T = 16384, SEQ = 4096, DM = 1024;
constexpr int NWAVES = 8, NT = 512;
constexpr int LDS_BYTES = 147456;
constexpr float EPS = 1e-6f;
constexpr float LOG2E = 1.4426950408889634f;
constexpr float QSCALE = 0.10206207261596575f * 1.4426950408889634f;

constexpr size_t MiB = 1u << 20;
constexpr size_t WS_SS2 = 0;
constexpr size_t WS_CNT = 512 * 1024;
constexpr size_t WS_SSQ = 64 * 1024, WS_SSKV = 128 * 1024;
constexpr size_t WS_WIN = 1 * MiB;
constexpr size_t WS_WUQ = 10 * MiB + 512 * 1024;
constexpr size_t WS_WUKV = 11 * MiB + 256 * 1024;
constexpr size_t WS_RWO = 12 * MiB;
constexpr size_t WS_MWO = 13 * MiB;
constexpr size_t WS_WOUT = 14 * MiB;
constexpr size_t WS_PWQ = 16 * MiB;
constexpr size_t WS_SUBK = 20 * MiB;
constexpr size_t WS_W2T = 20 * MiB + 512 * 1024;
constexpr size_t WS_A2T = WS_W2T + 64 * 1024;
constexpr size_t WS_G2T = WS_A2T + 64 * 1024;
constexpr size_t WS_G = 24 * MiB;
constexpr size_t WS_UB = 56 * MiB, WS_VB = 72 * MiB;
constexpr size_t WS_SC = 176 * MiB;
constexpr size_t WS_PRW = 88 * MiB;
constexpr size_t WS_Q = 88 * MiB, WS_K = 112 * MiB, WS_VT = 136 * MiB;
constexpr size_t WS_HB = 88 * MiB;
constexpr size_t WS_QD = 152 * MiB, WS_KVD = 164 * MiB, WS_KPE = 172 * MiB;
constexpr size_t WS_O = 152 * MiB;
constexpr size_t WS_R = 176 * MiB, WS_W = 192 * MiB, WS_KS = 208 * MiB, WS_V = 224 * MiB, WS_KK = 240 * MiB;
constexpr size_t WS_YA = 176 * MiB;
constexpr size_t WS_MIXED = 192 * MiB;
constexpr size_t WS_PQ = 184 * MiB;
constexpr size_t WS_TAB = 240 * MiB;
constexpr size_t DO_XN = 0;
constexpr size_t DO_BV = 0, DO_GT = 16 * MiB, DO_BONUS = 32 * MiB, DO_Y = 33 * MiB, DO_KRAW = 33 * MiB, DO_GL = 50 * MiB;

struct Params {
    const float* in[31];
    float* out;
    unsigned char* ws;
};

DEVI unsigned f2bf(float f) { unsigned u = __float_as_uint(f); return (u + 0x7fffu + ((u >> 16) & 1u)) >> 16; }
typedef float f32x2_t __attribute__((ext_vector_type(2)));
typedef __bf16 bf16x2_t __attribute__((ext_vector_type(2)));
DEVI unsigned pk2(float lo, float hi) { f32x2_t v = {lo, hi}; bf16x2_t b = __builtin_convertvector(v, bf16x2_t); return __builtin_bit_cast(unsigned, b); }
DEVI float bflo(unsigned u) { return __uint_as_float(u << 16); }
DEVI float bfhi(unsigned u) { return __uint_as_float(u & 0xffff0000u); }
DEVI float bf1(bf16_t u) { return __uint_as_float(((unsigned)u) << 16); }
DEVI float wave_sum(float v) {
#pragma unroll
    for (int o = 32; o >= 1; o >>= 1) v += __shfl_xor(v, o);
    return v;
}
DEVI float sigmoidf_(float x) { return __builtin_amdgcn_rcpf(1.f + __builtin_amdgcn_exp2f(-1.4426950408889634f * x)); }
DEVI float tanhf_(float x) { return 1.f - 2.f * __builtin_amdgcn_rcpf(__builtin_amdgcn_exp2f(2.885390081777927f * x) + 1.f); }
DEVI void st_bf4(bf16_t* p, float a, float b, float c, float d) { u32x2 w; w.x = pk2(a, b); w.y = pk2(c, d); *(u32x2*)p = w; }
DEVI void ld_bf4(const bf16_t* p, float (&o)[4]) { u32x2 w = *(const u32x2*)p; o[0] = bflo(w.x); o[1] = bfhi(w.x); o[2] = bflo(w.y); o[3] = bfhi(w.y); }
DEVI void ld_bf8(const bf16_t* p, float (&o)[8]) { u32x4 w = *(const u32x4*)p; o[0] = bflo(w.x); o[1] = bfhi(w.x); o[2] = bflo(w.y); o[3] = bfhi(w.y); o[4] = bflo(w.z); o[5] = bfhi(w.z); o[6] = bflo(w.w); o[7] = bfhi(w.w); }
DEVI bf16x8 pack8(const float (&v)[8]) { u32x4 w; w.x = pk2(v[0], v[1]); w.y = pk2(v[2], v[3]); w.z = pk2(v[4], v[5]); w.w = pk2(v[6], v[7]); return __builtin_bit_cast(bf16x8, w); }
DEVI f32x4 mfma16(bf16x8 a, bf16x8 b, f32x4 c) { return __builtin_amdgcn_mfma_f32_16x16x32_bf16(a, b, c, 0, 0, 0); }
DEVI f32x16 mfma32(bf16x8 a, bf16x8 b, f32x16 c) { return __builtin_amdgcn_mfma_f32_32x32x16_bf16(a, b, c, 0, 0, 0); }
DEVI int crow(int r, int hi) { return (r & 3) + 8 * (r >> 2) + 4 * hi; }


template <int CTRL> DEVI float dpp_f(float v) { return __builtin_bit_cast(float, __builtin_amdgcn_update_dpp(0, __builtin_bit_cast(int, v), CTRL, 0xf, 0xf, true)); }
template <int CTRL> DEVI unsigned dpp_u(unsigned v) { return (unsigned)__builtin_amdgcn_update_dpp(0, (int)v, CTRL, 0xf, 0xf, true); }
DEVI float sum8(float v) { v += dpp_f<0xB1>(v); v += dpp_f<0x4E>(v); v += dpp_f<0x141>(v); return v; }
DEVI float sum16(float v) { v = sum8(v); v += dpp_f<0x140>(v); return v; }
DEVI unsigned umax2(unsigned a, unsigned b) { return a > b ? a : b; }
DEVI unsigned umax16(unsigned v) { v = umax2(v, dpp_u<0xB1>(v)); v = umax2(v, dpp_u<0x4E>(v)); v = umax2(v, dpp_u<0x141>(v)); v = umax2(v, dpp_u<0x140>(v)); return v; }
DEVI unsigned rdlane(unsigned v, int l) { return (unsigned)__builtin_amdgcn_readlane((int)v, l); }
#define LAS __attribute__((address_space(3)))

DEVI unsigned pk4_fp8(float a, float b, float c, float d) { int w = 0; w = __builtin_amdgcn_cvt_pk_fp8_f32(a, b, w, false); w = __builtin_amdgcn_cvt_pk_fp8_f32(c, d, w, true); return (unsigned)w; }
DEVI f32x4 mfma16_fp8(u32x2 a, u32x2 b, f32x4 c) { return __builtin_amdgcn_mfma_f32_16x16x32_fp8_fp8(__builtin_bit_cast(long, a), __builtin_bit_cast(long, b), c, 0, 0, 0); }
DEVI unsigned pk4_u8(float a, float b, float c, float d) { unsigned w = 0; w = __builtin_amdgcn_cvt_pk_u8_f32(a, 0, w); w = __builtin_amdgcn_cvt_pk_u8_f32(b, 1, w); w = __builtin_amdgcn_cvt_pk_u8_f32(c, 2, w); w = __builtin_amdgcn_cvt_pk_u8_f32(d, 3, w); return w; }
constexpr float U8_SCALE = 32.f, V8_SCALE = 4.f;
constexpr float C8_SCALE = 256.f;

template <int OFF> DEVI f32x4 lds_rd128(unsigned a) { f32x4 r; asm volatile("ds_read_b128 %0, %1 offset:%2" : "=v"(r) : "v"(a), "i"(OFF)); return r; }
template <int OFF> DEVI float lds_rd32(unsigned a) { float r; asm volatile("ds_read_b32 %0, %1 offset:%2" : "=v"(r) : "v"(a), "i"(OFF)); return r; }
DEVI void lds_wr32(unsigned a, float v) { asm volatile("ds_write_b32 %0, %1" ::"v"(a), "v"(v) : "memory"); }

#define SW64(r, k) ((r) * 64 + (((((k) >> 3) ^ ((r) & 7))) << 3) + ((k) & 7))
#define SW32(r, c) ((r) * 32 + (((((c) >> 3) ^ (((r) >> 2) & 3))) << 3) + ((c) & 7))
DEVI int swz_off(int r, int chunk, int ld) { return ld == 64 ? r * 64 + ((chunk ^ (r & 7)) << 3) : r * 32 + ((chunk ^ ((r >> 2) & 3)) << 3); }
template <int MT, int NTL, int KS>
DEVI void gemm_lds(const LAS bf16_t* A, int lda, const LAS bf16_t* B, int ldb, f32x4 (&acc)[MT][NTL], int fr, int fq) {
#pragma unroll
    for (int ks = 0; ks < KS; ++ks) {
        bf16x8 a[MT], b[NTL];
#pragma unroll
        for (int m = 0; m < MT; ++m) a[m] = *(const LAS bf16x8*)(A + swz_off(16 * m + fr, 4 * ks + fq, lda));
#pragma unroll
        for (int n = 0; n < NTL; ++n) b[n] = *(const LAS bf16x8*)(B + swz_off(16 * n + fr, 4 * ks + fq, ldb));
#pragma unroll
        for (int m = 0; m < MT; ++m)
#pragma unroll
            for (int n = 0; n < NTL; ++n) acc[m][n] = mfma16(b[n], a[m], acc[m][n]);
    }
}
DEVI bf16_t bf1of(float x) { return (bf16_t)(pk2(x, x) & 0xffffu); }
DEVI void gemm_tile_acc(const bf16_t* __restrict__ A, int lda, const bf16_t* __restrict__ Bt, int ldb, int K, int m0, int n0, int lane, f32x4 (&acc)[4][4]) {
    const int fr = lane & 15, fq = lane >> 4;
    const bf16_t* ap = A + (size_t)(m0 + fr) * lda + fq * 8;
    const bf16_t* bp = Bt + (size_t)(n0 + fr) * ldb + fq * 8;
#pragma unroll 2
    for (int k0 = 0; k0 < K; k0 += 32) {
        bf16x8 a[4], b[4];
#pragma unroll
        for (int m = 0; m < 4; ++m) a[m] = *(const bf16x8*)(ap + (size_t)m * 16 * lda + k0);
#pragma unroll
        for (int n = 0; n < 4; ++n) b[n] = *(const bf16x8*)(bp + (size_t)n * 16 * ldb + k0);
#pragma unroll
        for (int m = 0; m < 4; ++m)
#pragma unroll
            for (int n = 0; n < 4; ++n) acc[m][n] = mfma16(b[n], a[m], acc[m][n]);
    }
}
DEVI void zero_acc(f32x4 (&acc)[4][4]) {
#pragma unroll
    for (int m = 0; m < 4; ++m)
#pragma unroll
        for (int n = 0; n < 4; ++n) acc[m][n] = (f32x4){0.f, 0.f, 0.f, 0.f};
}


namespace pg8 {
#define PG8_LAS __attribute__((address_space(3)))
typedef unsigned short bf16_t;
typedef short bf16x8 __attribute__((ext_vector_type(8)));
typedef float f32x4 __attribute__((ext_vector_type(4)));
typedef unsigned u32x4 __attribute__((ext_vector_type(4)));
constexpr int BM = 256, BK = 64, HALF = 128, HTB = HALF * BK * 2  , STAGE_BYTES = 8 * HTB, NXCD = 8, WGM = 8;

__host__ __device__ __forceinline__ int lds_byte(int r, int c) { const int st = (r >> 4) * 2 + (c >> 5), rr = r & 15, cc = c & 31, ob = rr * 64 + cc * 2; return st * 1024 + (ob ^ (((ob >> 9) & 1) << 5)); }
__host__ __device__ __forceinline__ void stage_rc(int b, int& R, int& C) { const int st = b / 1024, sb = b % 1024, swz = sb ^ (((sb >> 9) & 1) << 5); R = (st >> 1) * 16 + swz / 64; C = (st & 1) * 32 + (swz % 64) / 2; }
__host__ __device__ __forceinline__ int perm32(int rho) { const int n = rho >> 4, i = rho & 15; return 8 * (i >> 2) + 4 * n + (i & 3); }

struct Unit { int pm, pn; };
struct Gemm { const bf16_t* A; const bf16_t* Bt; int M, N, K; };

struct StaticOrder {
    int nM, nN, nwg, G, c;
    __host__ __device__ void init(int M, int N, int G_, int c_) { nM = M / BM; nN = N / BM; nwg = nM * nN; G = G_; c = c_; }
    __host__ __device__ bool next(int i, Unit& u) const {
        const long L = (long)i * G + c; if (L >= nwg) return false;
        int wgid = (int)L; { const int q = nwg / NXCD, r = nwg % NXCD, xcd = wgid % NXCD, off = wgid / NXCD; wgid = (xcd < r ? xcd * (q + 1) : r * (q + 1) + (xcd - r) * q) + off; }
        const int nig = WGM * nN, gid = wgid / nig, fm = gid * WGM, gsz = (nM - fm) < WGM ? (nM - fm) : WGM;
        u.pm = fm + ((wgid % nig) % gsz); u.pn = (wgid % nig) / gsz; return true;
    }
    __device__ __forceinline__ void a_ready(const Unit&) const {}
    __device__ __forceinline__ void done(const Unit&) const {}
};


DEVI float sigm(float x) { return __builtin_amdgcn_rcpf(1.f + __builtin_amdgcn_exp2f(-1.4426950408889634f * x)); }
DEVI u32x4 pack8v(f32x4 a, f32x4 b) { u32x4 w; w.x = pk2(a[0], a[1]); w.y = pk2(a[2], a[3]); w.z = pk2(b[0], b[1]); w.w = pk2(b[2], b[3]); return w; }
struct EpiP1 {
    static constexpr bool PERM = true, AFTER_DRAIN = false;
    unsigned char* ws;
    __device__ __forceinline__ void operator()(const f32x4 (&acc)[2][2][4][2], const Unit& u, int wr, int wc, int fr_in, int fq_in) const {
        int fr = fr_in, fq = fq_in; asm volatile("" : "+v"(fr), "+v"(fq));
        const int row0 = u.pm * BM + wr * 64 + fr;
        if (u.pn >= 8 && u.pn < 11) {
#pragma unroll
            for (int bj = 0; bj < 2; ++bj) {
                const int c = (u.pn - 8) * 256 + bj * HALF + wc * 32 + 8 * fq;
                const size_t off = c < 384 ? WS_QD : (c < 640 ? WS_KVD : WS_KPE);
                const int ld = c < 384 ? 384 : (c < 640 ? 256 : 32), cc = c < 384 ? c : (c < 640 ? c - 384 : c - 640);
                if (c < 672) {
#pragma unroll
                    for (int ai = 0; ai < 2; ++ai)
#pragma unroll
                        for (int m = 0; m < 4; ++m) { const size_t row = (size_t)(row0 + ai * HALF + m * 16);
                            *(u32x4*)(ws + off + (row * ld + cc) * 2) = pack8v(acc[ai][bj][m][0], acc[ai][bj][m][1]); }
                }
            }
            return;
        }
        if (u.pn >= 11) {
            const int col0 = (u.pn - 11) * 256 + wc * 32 + 8 * fq;
#pragma unroll
            for (int ai = 0; ai < 2; ++ai)
#pragma unroll
                for (int m = 0; m < 4; ++m) { unsigned char* rowp = ws + WS_G + ((size_t)(row0 + ai * HALF + m * 16) * 2048 + col0);
#pragma unroll
                    for (int bj = 0; bj < 2; ++bj) { const f32x4 v0 = acc[ai][bj][m][0], v1 = acc[ai][bj][m][1];
                        u32x2 w; w.x = pk4_u8(sigm(v0[0]) * 255.f, sigm(v0[1]) * 255.f, sigm(v0[2]) * 255.f, sigm(v0[3]) * 255.f);
                        w.y = pk4_u8(sigm(v1[0]) * 255.f, sigm(v1[1]) * 255.f, sigm(v1[2]) * 255.f, sigm(v1[3]) * 255.f);
                        *(u32x2*)(rowp + bj * HALF) = w; } }
            return;
        }
        const int col0 = u.pn * 256 + wc * 32 + 8 * fq;
#pragma unroll
        for (int ai = 0; ai < 2; ++ai)
#pragma unroll
            for (int m = 0; m < 4; ++m) { unsigned char* rowp = ws + WS_PRW + ((size_t)(row0 + ai * HALF + m * 16) * 2048 + col0) * 2;
#pragma unroll
                for (int bj = 0; bj < 2; ++bj) *(u32x4*)(rowp + bj * HALF * 2) = pack8v(acc[ai][bj][m][0], acc[ai][bj][m][1]); }
    }
};
struct EpiQraw {
    static constexpr bool PERM = true, AFTER_DRAIN = false;
    bf16_t* q; const float* ssq;
    __device__ __forceinline__ void operator()(const f32x4 (&acc)[2][2][4][2], const Unit& u, int wr, int wc, int fr_in, int fq_in) const {
        int fr = fr_in, fq = fq_in; asm volatile("" : "+v"(fr), "+v"(fq));
        const int row0 = u.pm * BM + wr * 64 + fr, col0 = u.pn * BM + wc * 32 + 8 * fq;
#pragma unroll
        for (int ai = 0; ai < 2; ++ai)
#pragma unroll
            for (int m = 0; m < 4; ++m) { const size_t row = (size_t)(row0 + ai * HALF + m * 16); const float rs = ssq[row];
#pragma unroll
                for (int bj = 0; bj < 2; ++bj) *(u32x4*)(q + row * 768 + col0 + bj * HALF) = pack8v(acc[ai][bj][m][0] * rs, acc[ai][bj][m][1] * rs); }
    }
};
struct EpiKVraw {
    static constexpr bool PERM = true, AFTER_DRAIN = false;
    bf16_t* kraw; bf16_t* vt; const float* sskv;
    __device__ __forceinline__ void operator()(const f32x4 (&acc)[2][2][4][2], const Unit& u, int wr, int wc, int fr_in, int fq_in) const {
        int fr = fr_in, fq = fq_in; asm volatile("" : "+v"(fr), "+v"(fq));
        const int row0 = u.pm * BM + wr * 64 + fr;
#pragma unroll
        for (int ai = 0; ai < 2; ++ai)
#pragma unroll
            for (int m = 0; m < 4; ++m) { const int row = row0 + ai * HALF + m * 16; const float rs = sskv[row];
#pragma unroll
                for (int bj = 0; bj < 2; ++bj) { const f32x4 v0 = acc[ai][bj][m][0] * rs, v1 = acc[ai][bj][m][1] * rs;
                    if (u.pn < 2) *(u32x4*)(kraw + (size_t)row * 512 + u.pn * BM + bj * HALF + wc * 32 + 8 * fq) = pack8v(v0, v1);
                    else { const int c = (u.pn - 2) * BM + bj * HALF + wc * 32 + 8 * fq, h = c >> 6, d = c & 63; const int bb = row >> 12, s = row & 4095;
                        const int kt = s >> 5, k4 = s & 15, jj = 4 * (k4 >> 3) + (k4 & 3), hv = (k4 >> 2) & 1;
                        bf16_t* vp = vt + ((((size_t)(bb * 8 + h) * 128 + kt) * 2 + (d >> 5)) * 2 + ((s >> 4) & 1)) * 512 + ((d & 31) + 32 * hv) * 8 + jj; const u32x4 w = pack8v(v0, v1);
                        vp[0] = (bf16_t)(w.x & 0xffffu); vp[8] = (bf16_t)(w.x >> 16); vp[16] = (bf16_t)(w.y & 0xffffu); vp[24] = (bf16_t)(w.y >> 16);
                        vp[32] = (bf16_t)(w.z & 0xffffu); vp[40] = (bf16_t)(w.z >> 16); vp[48] = (bf16_t)(w.w & 0xffffu); vp[56] = (bf16_t)(w.w >> 16); } } }
    }
};
struct EpiGate {
    static constexpr bool PERM = true, AFTER_DRAIN = false;
    bf16_t* mixed; const unsigned char* gg; int goff; int add;
    __device__ __forceinline__ void operator()(const f32x4 (&acc)[2][2][4][2], const Unit& u, int wr, int wc, int fr_in, int fq_in) const {
        int fr = fr_in, fq = fq_in; asm volatile("" : "+v"(fr), "+v"(fq));
        const int row0 = u.pm * BM + wr * 64 + fr, col0 = u.pn * BM + wc * 32 + 8 * fq;
#pragma unroll
        for (int ai = 0; ai < 2; ++ai)
#pragma unroll
            for (int m = 0; m < 4; ++m) { const size_t row = (size_t)(row0 + ai * HALF + m * 16);
#pragma unroll
                for (int bj = 0; bj < 2; ++bj) { const int col = col0 + bj * HALF;
                    const u32x2 gw = *(const u32x2*)(gg + row * 2048 + goff + col);
                    const f32x4 g0 = (f32x4){(float)(gw.x & 0xffu), (float)((gw.x >> 8) & 0xffu), (float)((gw.x >> 16) & 0xffu), (float)(gw.x >> 24)};
                    const f32x4 g1 = (f32x4){(float)(gw.y & 0xffu), (float)((gw.y >> 8) & 0xffu), (float)((gw.y >> 16) & 0xffu), (float)(gw.y >> 24)};
                    f32x4 v0 = g0 * (acc[ai][bj][m][0] * (1.f / 255.f)), v1 = g1 * (acc[ai][bj][m][1] * (1.f / 255.f));
                    if (add) { const u32x4 pw = *(const u32x4*)(mixed + row * 1024 + col);
                        v0 += (f32x4){__uint_as_float(pw.x << 16), __uint_as_float(pw.x & 0xffff0000u), __uint_as_float(pw.y << 16), __uint_as_float(pw.y & 0xffff0000u)};
                        v1 += (f32x4){__uint_as_float(pw.z << 16), __uint_as_float(pw.z & 0xffff0000u), __uint_as_float(pw.w << 16), __uint_as_float(pw.w & 0xffff0000u)}; }
                    *(u32x4*)(mixed + row * 1024 + col) = pack8v(v0, v1); } }
    }
};
struct EpiRes {
    static constexpr bool PERM = true, AFTER_DRAIN = false;
    const float* x; bf16_t* hb; float* ss2;
    __device__ __forceinline__ void operator()(const f32x4 (&acc)[2][2][4][2], const Unit& u, int wr, int wc, int fr_in, int fq_in) const {
        int fr = fr_in, fq = fq_in; asm volatile("" : "+v"(fr), "+v"(fq));
        const int row0 = u.pm * BM + wr * 64 + fr, col0 = u.pn * BM + wc * 32 + 8 * fq;
#pragma unroll
        for (int ai = 0; ai < 2; ++ai)
#pragma unroll
            for (int m = 0; m < 4; ++m) { const size_t row = (size_t)(row0 + ai * HALF + m * 16); float sq = 0.f;
#pragma unroll
                for (int bj = 0; bj < 2; ++bj) { const size_t o = row * 1024 + col0 + bj * HALF;
                    const f32x4 h0 = *(const f32x4*)(x + o) + acc[ai][bj][m][0], h1 = *(const f32x4*)(x + o + 4) + acc[ai][bj][m][1];
                    *(u32x4*)(hb + o) = pack8v(h0, h1);
                    sq += (h0[0] * h0[0] + h0[1] * h0[1]) + (h0[2] * h0[2] + h0[3] * h0[3]) + (h1[0] * h1[0] + h1[1] * h1[1]) + (h1[2] * h1[2] + h1[3] * h1[3]); }
                sq += __shfl_xor(sq, 16); sq += __shfl_xor(sq, 32);
                if (fq == 0) atomicAdd(ss2 + row, sq); }
    }
};
struct EpiScale {
    static constexpr bool PERM = true, AFTER_DRAIN = false;
    bf16_t* pq; const float* ss2;
    __device__ __forceinline__ void operator()(const f32x4 (&acc)[2][2][4][2], const Unit& u, int wr, int wc, int fr_in, int fq_in) const {
        int fr = fr_in, fq = fq_in; asm volatile("" : "+v"(fr), "+v"(fq));
        const int row0 = u.pm * BM + wr * 64 + fr, col0 = u.pn * BM + wc * 32 + 8 * fq;
#pragma unroll
        for (int ai = 0; ai < 2; ++ai)
#pragma unroll
            for (int m = 0; m < 4; ++m) { const size_t row = (size_t)(row0 + ai * HALF + m * 16); const float rs = rsqrtf(ss2[row] * (1.f / 1024.f) + 1e-6f);
#pragma unroll
                for (int bj = 0; bj < 2; ++bj) *(u32x4*)(pq + row * 2048 + col0 + bj * HALF) = pack8v(acc[ai][bj][m][0] * rs, acc[ai][bj][m][1] * rs); }
    }
};
template <class Epi, class Sched, bool ALIGN_EPI = false, bool SP2 = false>
__device__ __forceinline__ void gemm_phase(PG8_LAS unsigned char* lds, const Gemm g, const Sched& S, const Epi& E) {
    int tid_l = threadIdx.x; asm volatile("" : "+v"(tid_l));
    const int tid = tid_l, wid = __builtin_amdgcn_readfirstlane(tid >> 6), lane = tid & 63, wr = wid >> 2, wc = wid & 3, fr = lane & 15, fq = lane >> 4;
    const int K = g.K, nt = K / BK;
    unsigned voffA[2], voffB[2];
#pragma unroll
    for (int i = 0; i < 2; ++i) { int R, C; stage_rc(tid * 16 + i * 8192, R, C); const int Rb = Epi::PERM ? ((R & ~31) + perm32(R & 31)) : R;
        voffA[i] = (unsigned)(R * K + C) * 2u; voffB[i] = (unsigned)(Rb * K + C) * 2u; }
    const size_t kstep = (size_t)(BK * 2);
    const size_t hstep = (size_t)HALF * K * 2;
    const size_t tstep = 2 * hstep;
    const unsigned ldsw = (unsigned)wid * 1024u;
    const int aoff = lds_byte(wr * 64 + fr, fq * 8), boff = lds_byte(wc * 32 + fr, fq * 8);
#define PG8_SA(b, h) (((b) * 2 + (h)) * HTB)
#define PG8_SB(b, h) ((4 + (b) * 2 + (h)) * HTB)
#define PG8_STAGE(bufoff, gbase, voff) do { _Pragma("unroll") for (int _i = 0; _i < 2; ++_i) \
        __builtin_amdgcn_global_load_lds((const unsigned*)((const char*)(gbase) + (voff)[_i]), (PG8_LAS unsigned*)(lds + (bufoff) + ldsw + _i * 8192), 16, 0, 0); } while (0)
#define PG8_LDA(dst, b, h) do { _Pragma("unroll") for (int m = 0; m < 4; ++m) _Pragma("unroll") for (int k = 0; k < 2; ++k) dst[m][k] = *(const PG8_LAS bf16x8*)(lds + PG8_SA(b, h) + aoff + m * 2048 + k * 1024); } while (0)
#define PG8_LDB(dst, b, h) do { _Pragma("unroll") for (int n = 0; n < 2; ++n) _Pragma("unroll") for (int k = 0; k < 2; ++k) dst[n][k] = *(const PG8_LAS bf16x8*)(lds + PG8_SB(b, h) + boff + n * 2048 + k * 1024); } while (0)
#define PG8_MMA(ai, bj, At, Bt) do { __builtin_amdgcn_s_setprio(1); _Pragma("unroll") for (int m = 0; m < 4; ++m) _Pragma("unroll") for (int n = 0; n < 2; ++n) _Pragma("unroll") for (int k = 0; k < 2; ++k) \
        acc[ai][bj][m][n] = __builtin_amdgcn_mfma_f32_16x16x32_bf16(Bt[n][k], At[m][k], acc[ai][bj][m][n], 0, 0, 0); __builtin_amdgcn_s_setprio(0); } while (0)
#define PG8_WAIT_V(n) asm volatile("s_waitcnt vmcnt(" #n ")" ::: "memory")
#define PG8_WAIT_L(n) asm volatile("s_waitcnt lgkmcnt(" #n ")" ::: "memory")
#define PG8_BAR __builtin_amdgcn_s_barrier()
#define PG8_SCHED __builtin_amdgcn_sched_barrier(0)
    Unit cur, nxt; int ui = 0;
    if (!S.next(0, cur)) return;
    f32x4 acc[2][2][4][2];
#pragma unroll
    for (int a = 0; a < 2; ++a)
#pragma unroll
        for (int b = 0; b < 2; ++b)
#pragma unroll
            for (int m = 0; m < 4; ++m)
#pragma unroll
                for (int n = 0; n < 2; ++n) acc[a][b][m][n] = (f32x4){0.f, 0.f, 0.f, 0.f};
    bf16x8 At[4][2], B0[2][2], B1[2][2];
    const char* cA = (const char*)g.A + (size_t)cur.pm * tstep; const char* cB = (const char*)g.Bt + (size_t)cur.pn * tstep;
    S.a_ready(cur);
    if constexpr (SP2) {
        PG8_STAGE(PG8_SB(0, 0), cB, voffB); PG8_STAGE(PG8_SB(0, 1), cB + hstep, voffB); PG8_STAGE(PG8_SA(0, 0), cA, voffA); PG8_STAGE(PG8_SA(0, 1), cA + hstep, voffA);
        if (wr == 1) PG8_BAR;
        PG8_WAIT_V(2); PG8_BAR;
        PG8_STAGE(PG8_SB(1, 0), cB + kstep, voffB); PG8_STAGE(PG8_SA(1, 0), cA + kstep, voffA); PG8_STAGE(PG8_SB(1, 1), cB + hstep + kstep, voffB);
        PG8_WAIT_V(6); PG8_BAR;
    } else {
        PG8_STAGE(PG8_SB(0, 0), cB, voffB); PG8_STAGE(PG8_SA(0, 0), cA, voffA); PG8_STAGE(PG8_SB(0, 1), cB + hstep, voffB); PG8_STAGE(PG8_SA(0, 1), cA + hstep, voffA);
        if (wr == 1) PG8_BAR;
        PG8_WAIT_V(4); PG8_BAR;
        PG8_STAGE(PG8_SB(1, 0), cB + kstep, voffB); PG8_STAGE(PG8_SA(1, 0), cA + kstep, voffA); PG8_STAGE(PG8_SB(1, 1), cB + hstep + kstep, voffB);
        PG8_WAIT_V(6); PG8_BAR;
    }
    for (;;) {
        const bool has_next = S.next(ui + 1, nxt);
        const char* nA = has_next ? (const char*)g.A + (size_t)nxt.pm * tstep : cA; const char* nB = has_next ? (const char*)g.Bt + (size_t)nxt.pn * tstep : cB;
        for (int t = 0; t < nt; t += 2) {
            const bool last = (t == nt - 2);
            const char* a1 = cA + (size_t)(t + 1) * kstep;
            const char* a2 = last ? nA : cA + (size_t)(t + 2) * kstep; const char* b2 = last ? nB : cB + (size_t)(t + 2) * kstep;
            const char* a3 = a2 + kstep; const char* b3 = b2 + kstep;
            if (last && has_next) S.a_ready(nxt);
            if constexpr (SP2) {
            PG8_LDB(B0, 0, 0); PG8_LDB(B1, 0, 1); PG8_SCHED; PG8_LDA(At, 0, 0); PG8_STAGE(PG8_SA(1, 1), a1 + hstep, voffA);
            PG8_WAIT_V(8); PG8_WAIT_L(0); PG8_BAR; PG8_MMA(0, 0, At, B0); PG8_MMA(0, 1, At, B1); PG8_BAR; PG8_SCHED;
            PG8_LDA(At, 0, 1); PG8_STAGE(PG8_SB(0, 0), b2, voffB); PG8_STAGE(PG8_SB(0, 1), b2 + hstep, voffB); PG8_STAGE(PG8_SA(0, 0), a2, voffA);
            PG8_WAIT_V(8); PG8_WAIT_L(0); PG8_BAR; PG8_MMA(1, 0, At, B0); PG8_MMA(1, 1, At, B1); PG8_BAR; PG8_SCHED;
            PG8_LDB(B0, 1, 0); PG8_LDB(B1, 1, 1); PG8_SCHED; PG8_LDA(At, 1, 0); PG8_STAGE(PG8_SA(0, 1), a2 + hstep, voffA);
            PG8_WAIT_V(8); PG8_WAIT_L(0); PG8_BAR; PG8_MMA(0, 0, At, B0); PG8_MMA(0, 1, At, B1); PG8_BAR; PG8_SCHED;
            PG8_LDA(At, 1, 1); PG8_STAGE(PG8_SB(1, 0), b3, voffB); PG8_STAGE(PG8_SB(1, 1), b3 + hstep, voffB); PG8_STAGE(PG8_SA(1, 0), a3, voffA);
            PG8_WAIT_V(8); PG8_WAIT_L(0); PG8_BAR; PG8_MMA(1, 0, At, B0); PG8_MMA(1, 1, At, B1); PG8_BAR; PG8_SCHED;
            } else {
            PG8_LDB(B0, 0, 0); PG8_SCHED; PG8_LDA(At, 0, 0); PG8_STAGE(PG8_SA(1, 1), a1 + hstep, voffA);
            PG8_WAIT_L(8); PG8_BAR; PG8_WAIT_L(0); PG8_MMA(0, 0, At, B0); PG8_BAR; PG8_SCHED;
            PG8_LDB(B1, 0, 1); PG8_STAGE(PG8_SB(0, 0), b2, voffB);
            PG8_BAR; PG8_WAIT_L(0); PG8_MMA(0, 1, At, B1); PG8_BAR;
            PG8_LDA(At, 0, 1); PG8_STAGE(PG8_SA(0, 0), a2, voffA);
            PG8_BAR; PG8_WAIT_L(0); PG8_MMA(1, 0, At, B0); PG8_BAR; PG8_SCHED;
            PG8_STAGE(PG8_SB(0, 1), b2 + hstep, voffB);
            PG8_WAIT_V(6); PG8_BAR; PG8_MMA(1, 1, At, B1); PG8_BAR;
            PG8_LDB(B0, 1, 0); PG8_SCHED; PG8_LDA(At, 1, 0); PG8_STAGE(PG8_SA(0, 1), a2 + hstep, voffA);
            PG8_WAIT_L(8); PG8_BAR; PG8_WAIT_L(0); PG8_MMA(0, 0, At, B0); PG8_BAR; PG8_SCHED;
            PG8_LDB(B1, 1, 1); PG8_STAGE(PG8_SB(1, 0), b3, voffB);
            PG8_BAR; PG8_WAIT_L(0); PG8_MMA(0, 1, At, B1); PG8_BAR;
            PG8_LDA(At, 1, 1); PG8_STAGE(PG8_SA(1, 0), a3, voffA);
            PG8_BAR; PG8_WAIT_L(0); PG8_MMA(1, 0, At, B0); PG8_BAR; PG8_SCHED;
            PG8_STAGE(PG8_SB(1, 1), b3 + hstep, voffB);
            PG8_WAIT_V(6); PG8_BAR; PG8_MMA(1, 1, At, B1); PG8_BAR;
            }
        }
        if constexpr (ALIGN_EPI) { if (wr == 0) PG8_BAR; }
        if constexpr (!Epi::AFTER_DRAIN) { E(acc, cur, wr, wc, fr, fq); S.done(cur); }
        if (!has_next) break;
#pragma unroll
        for (int a = 0; a < 2; ++a)
#pragma unroll
            for (int b = 0; b < 2; ++b)
#pragma unroll
                for (int m = 0; m < 4; ++m)
#pragma unroll
                    for (int n = 0; n < 2; ++n) acc[a][b][m][n] = (f32x4){0.f, 0.f, 0.f, 0.f};
        cur = nxt; cA = nA; cB = nB; ++ui;
        if constexpr (ALIGN_EPI) { if (wr == 1) PG8_BAR; }
    }
    PG8_WAIT_V(0);
    if constexpr (!ALIGN_EPI) { if (wr == 0) PG8_BAR; }
    PG8_BAR;
    if constexpr (Epi::AFTER_DRAIN) { E.fused(acc, cur, wr, wc, fr, fq, lds, wid, lane); S.done(cur); }
#undef PG8_SA
#undef PG8_SB
#undef PG8_STAGE
#undef PG8_LDA
#undef PG8_LDB
#undef PG8_MMA
#undef PG8_WAIT_V
#undef PG8_WAIT_L
#undef PG8_BAR
#undef PG8_SCHED
}
}


#define RLX_AGENT __ATOMIC_RELAXED, __HIP_MEMORY_SCOPE_AGENT
#define XB_TMO      128
#define XB_XCNT(j)  (256  + 64 * (j))
#define XB_XSUB(j)  (1280 + 64 * (j))
#define XB_XGEN(j)  (2304 + 64 * (j))
#define XB_TOP      3328
#define XB_TOPGEN   3392
#define XCD_BAR_WORDS 3456
#define XB_SPIN_CAP (1u << 18)

__device__ __forceinline__ unsigned xb_ld(unsigned* p)              { return __hip_atomic_load(p, __ATOMIC_RELAXED, __HIP_MEMORY_SCOPE_AGENT); }
__device__ __forceinline__ unsigned xb_add(unsigned* p, unsigned v) { return __hip_atomic_fetch_add(p, v, __ATOMIC_RELAXED, __HIP_MEMORY_SCOPE_AGENT); }
__device__ __forceinline__ unsigned xb_xcc_id() { return (unsigned)__builtin_amdgcn_s_getreg((3 << 11) | 20) & 0xFu; }
#define XB_SPIN(cond, bar) do { unsigned _sp = 0; while (cond) { __builtin_amdgcn_s_sleep(1); \
    if ((++_sp & 255u) == 0u) { if (xb_ld(&(bar)[XB_TMO])) break; if (_sp > XB_SPIN_CAP) { atomicAdd(&(bar)[XB_TMO], 1u); break; } } } } while (0)

struct XcdBarrier {
    unsigned* bar; unsigned x;
    volatile LAS unsigned* st;
};

__device__ __forceinline__ XcdBarrier xcd_barrier_post(unsigned* bar, volatile LAS unsigned* st) {
    XcdBarrier b; b.bar = bar; b.x = xb_xcc_id(); b.st = st;
    if (threadIdx.x == 0) (void)xb_add(&bar[XB_XCNT(b.x)], 1u);
    return b;
}
__device__ __forceinline__ void xcd_barrier_complete(unsigned* bar, unsigned x, unsigned& nloc, unsigned& nx) {
    const unsigned G = gridDim.x * gridDim.y * gridDim.z;
    unsigned sum, cnt, mine, sp = 0u;
    for (;;) {
        sum = 0u; cnt = 0u; mine = 0u;
#pragma unroll
        for (unsigned j = 0; j < 16; ++j) { const unsigned c = xb_ld(&bar[XB_XCNT(j)]); sum += c; cnt += (c > 0u) ? 1u : 0u; mine = (j == x) ? c : mine; }
        if (sum == G) break;
        __builtin_amdgcn_s_sleep(1);
        if ((++sp & 255u) == 0u) { if (xb_ld(&bar[XB_TMO])) break; if (sp > XB_SPIN_CAP) { atomicAdd(&bar[XB_TMO], 1u); break; } }
    }
    nloc = mine > 0u ? mine : 1u; nx = cnt > 0u ? cnt : 1u;
}

__device__ __forceinline__ void xcd_barrier(const XcdBarrier& b) {
    asm volatile("s_waitcnt vmcnt(0)" ::: "memory");
    __syncthreads();
    if (threadIdx.x == 0) {
        unsigned* bar = b.bar;
        __builtin_amdgcn_s_waitcnt(0);
        unsigned nloc = b.st[0], nx = b.st[1];
        if (nloc == 0u) { xcd_barrier_complete(bar, b.x, nloc, nx); b.st[0] = nloc; b.st[1] = nx; }
        const unsigned old = xb_add(&bar[XB_XSUB(b.x)], 1u);
        const unsigned gen = old / nloc;
        if (old + 1u == (gen + 1u) * nloc) {
            __builtin_amdgcn_fence(__ATOMIC_RELEASE, "agent");
            asm volatile("s_waitcnt vmcnt(0)" ::: "memory");
            const unsigned og = xb_add(&bar[XB_TOP], 1u);
            const unsigned tg = og / nx;
            if (og + 1u == (tg + 1u) * nx) xb_add(&bar[XB_TOPGEN], 1u);
            else XB_SPIN(xb_ld(&bar[XB_TOPGEN]) == tg, bar);
            __builtin_amdgcn_fence(__ATOMIC_ACQUIRE, "agent");
            xb_add(&bar[XB_XGEN(b.x)], 1u);
            asm volatile("s_waitcnt vmcnt(0)" ::: "memory");
        } else {
            XB_SPIN(xb_ld(&bar[XB_XGEN(b.x)]) == gen, bar);
            __builtin_amdgcn_fence(__ATOMIC_ACQUIRE, "agent");
            asm volatile("s_waitcnt vmcnt(0)" ::: "memory");
        }
    }
    __syncthreads();
}

DEVI void transpose_item(const float* __restrict__ W, int ldw, int c0, bf16_t* WT, int ldk, int r0, int Kmax, int kb, int nb, const float* kscale, float* scr, int lane) {
    const int k0 = 64 * kb, n0 = 32 * nb;
#pragma unroll 8
    for (int i = 0; i < 32; ++i) {
        const int kk = 2 * i + (lane >> 5);
        float v = 0.f;
        if (k0 + kk < Kmax) { v = W[(size_t)(k0 + kk) * ldw + c0 + n0 + (lane & 31)]; if (kscale) v *= kscale[k0 + kk]; }
        scr[kk * 33 + (lane & 31)] = v;
    }
    asm volatile("s_waitcnt lgkmcnt(0)" ::: "memory");
    asm volatile("" ::: "memory");
    const int c = lane & 7;
    if (k0 + 8 * c < Kmax) {
#pragma unroll
        for (int j = 0; j < 4; ++j) {
            const int n = (lane >> 3) + 8 * j;
            const float* s = scr + (8 * c) * 33 + n;
            u32x4 o; o.x = pk2(s[0], s[33]); o.y = pk2(s[66], s[99]); o.z = pk2(s[132], s[165]); o.w = pk2(s[198], s[231]);
            *(u32x4*)(WT + (size_t)(r0 + n0 + n) * ldk + k0 + 8 * c) = o;
        }
    }
    asm volatile("s_waitcnt lgkmcnt(0)" ::: "memory");
    asm volatile("" ::: "memory");
}


DEVI void wcomb_item(const float* __restrict__ Wq, const float* __restrict__ Sk, const float* __restrict__ n2w, bf16_t* WcT, int it, int lane) {
    const int fr = lane & 15, fq = lane >> 4;
    const int hp = it >> 6, nt = (it >> 4) & 3, kt = it & 15;
    const float* ap = Sk + ((size_t)hp * 128 + nt * 32 + fr) * 128 + fq * 8;
    const float* bp = Wq + (size_t)(kt * 64 + fr) * 2048 + hp * 128 + fq * 8;
    f32x4 acc[2][4];
#pragma unroll
    for (int m = 0; m < 2; ++m)
#pragma unroll
        for (int n = 0; n < 4; ++n) acc[m][n] = (f32x4){0.f, 0.f, 0.f, 0.f};
#pragma unroll
    for (int k0 = 0; k0 < 128; k0 += 32) {
        bf16x8 a[2], b[4];
#pragma unroll
        for (int m = 0; m < 2; ++m) { const f32x4 lo = *(const f32x4*)(ap + (size_t)m * 16 * 128 + k0), hi = *(const f32x4*)(ap + (size_t)m * 16 * 128 + k0 + 4);
            u32x4 w; w.x = pk2(lo.x, lo.y); w.y = pk2(lo.z, lo.w); w.z = pk2(hi.x, hi.y); w.w = pk2(hi.z, hi.w); a[m] = __builtin_bit_cast(bf16x8, w); }
#pragma unroll
        for (int n = 0; n < 4; ++n) { const f32x4 lo = *(const f32x4*)(bp + (size_t)n * 16 * 2048 + k0), hi = *(const f32x4*)(bp + (size_t)n * 16 * 2048 + k0 + 4);
            u32x4 w; w.x = pk2(lo.x, lo.y); w.y = pk2(lo.z, lo.w); w.z = pk2(hi.x, hi.y); w.w = pk2(hi.z, hi.w); b[n] = __builtin_bit_cast(bf16x8, w); }
#pragma unroll
        for (int m = 0; m < 2; ++m)
#pragma unroll
            for (int n = 0; n < 4; ++n) acc[m][n] = mfma16(b[n], a[m], acc[m][n]);
    }
#pragma unroll
    for (int n = 0; n < 4; ++n) {
        const int col = kt * 64 + 16 * n + 4 * fq; const f32x4 w = *(const f32x4*)(n2w + col);
#pragma unroll
        for (int m = 0; m < 2; ++m) { const int row = hp * 128 + nt * 32 + 16 * m + fr; st_bf4(WcT + (size_t)row * 1024 + col, acc[m][n][0] * w.x, acc[m][n][1] * w.y, acc[m][n][2] * w.z, acc[m][n][3] * w.w); }
    }
}

#define KARG __attribute__((address_space(4)))
DEVI const KARG Params* kargs() { unsigned long long k = (unsigned long long)__builtin_amdgcn_kernarg_segment_ptr(); asm volatile("" : "+s"(k)); return (const KARG Params*)k; }
#define PHASE_PTRS \
    int tid_l_ = threadIdx.x; asm volatile("" : "+v"(tid_l_)); \
    [[maybe_unused]] const int tid = tid_l_, lane = tid & 63, wave = __builtin_amdgcn_readfirstlane(tid >> 6), gw = blockIdx.x * NWAVES + wave, fr = lane & 15, fq = lane >> 4; \
    const KARG Params* kp = kargs(); unsigned char* ws = kp->ws; unsigned char* dob = (unsigned char*)kp->out; (void)ws; (void)dob; \
    [[maybe_unused]] const float* x = kp->in[0]; [[maybe_unused]] const int* positions = (const int*)kp->in[1]; [[maybe_unused]] const float* norm1_w = kp->in[2]; [[maybe_unused]] const float* w_in = kp->in[3]; \
    [[maybe_unused]] const float* rw_mu = kp->in[4]; [[maybe_unused]] const float* rw_w0 = kp->in[5]; [[maybe_unused]] const float* rw_a0 = kp->in[7]; [[maybe_unused]] const float* rw_k_k = kp->in[10]; \
    [[maybe_unused]] const float* rw_k_a = kp->in[11]; [[maybe_unused]] const float* rw_r_k = kp->in[12]; [[maybe_unused]] const float* rw_ln_w = kp->in[13]; [[maybe_unused]] const float* rw_ln_b = kp->in[14]; \
    [[maybe_unused]] const float* q_norm_w = kp->in[16]; [[maybe_unused]] const float* kv_norm_w = kp->in[18]; [[maybe_unused]] const float* qn_nope_w = kp->in[20]; [[maybe_unused]] const float* qn_pe_w = kp->in[21]; \
    [[maybe_unused]] const float* kn_nope_w = kp->in[22]; [[maybe_unused]] const float* kn_pe_w = kp->in[23]; [[maybe_unused]] const float* norm2_w = kp->in[26]; \
    [[maybe_unused]] float* ss2 = (float*)(ws + WS_SS2); [[maybe_unused]] unsigned* cnt = (unsigned*)(ws + WS_CNT); [[maybe_unused]] unsigned* xbar_words = (unsigned*)(ws + WS_CNT + 4096); \
    [[maybe_unused]] bf16_t* WinT = (bf16_t*)(ws + WS_WIN); [[maybe_unused]] bf16_t* WuqT = (bf16_t*)(ws + WS_WUQ); [[maybe_unused]] bf16_t* WukvT = (bf16_t*)(ws + WS_WUKV); [[maybe_unused]] bf16_t* RwoT = (bf16_t*)(ws + WS_RWO); \
    [[maybe_unused]] bf16_t* MwoT = (bf16_t*)(ws + WS_MWO); [[maybe_unused]] bf16_t* WoutT = (bf16_t*)(ws + WS_WOUT); [[maybe_unused]] bf16_t* PwqT = (bf16_t*)(ws + WS_PWQ); [[maybe_unused]] bf16_t* SubK = (bf16_t*)(ws + WS_SUBK); \
    [[maybe_unused]] bf16_t* W2T = (bf16_t*)(ws + WS_W2T); [[maybe_unused]] bf16_t* A2T = (bf16_t*)(ws + WS_A2T); [[maybe_unused]] bf16_t* G2T = (bf16_t*)(ws + WS_G2T); [[maybe_unused]] const unsigned char* Gg = ws + WS_G; \
    [[maybe_unused]] bf16_t* Prw = (bf16_t*)(ws + WS_PRW); [[maybe_unused]] bf16_t* QD = (bf16_t*)(ws + WS_QD); [[maybe_unused]] bf16_t* KVD = (bf16_t*)(ws + WS_KVD); [[maybe_unused]] bf16_t* KPE = (bf16_t*)(ws + WS_KPE); \
    [[maybe_unused]] float* ssq = (float*)(ws + WS_SSQ); [[maybe_unused]] float* sskv = (float*)(ws + WS_SSKV); [[maybe_unused]] bf16_t* XN = (bf16_t*)(dob + DO_XN); \
    [[maybe_unused]] bf16_t* Rb = (bf16_t*)(ws + WS_R); [[maybe_unused]] bf16_t* Wb = (bf16_t*)(ws + WS_W); [[maybe_unused]] bf16_t* Kb = (bf16_t*)(ws + WS_KS); [[maybe_unused]] bf16_t* Vb = (bf16_t*)(ws + WS_V); [[maybe_unused]] bf16_t* KKb = (bf16_t*)(ws + WS_KK); \
    [[maybe_unused]] bf16_t* Bvb = (bf16_t*)(dob + DO_BV); [[maybe_unused]] bf16_t* Gtb = (bf16_t*)(dob + DO_GT); [[maybe_unused]] float* bonus = (float*)(dob + DO_BONUS); [[maybe_unused]] bf16_t* Yb = (bf16_t*)(dob + DO_Y); \
    [[maybe_unused]] bf16_t* Qb = (bf16_t*)(ws + WS_Q); [[maybe_unused]] bf16_t* Kab = (bf16_t*)(ws + WS_K); [[maybe_unused]] bf16_t* Vt = (bf16_t*)(ws + WS_VT); [[maybe_unused]] bf16_t* Kraw = (bf16_t*)(dob + DO_KRAW); \
    [[maybe_unused]] bf16_t* Ob = (bf16_t*)(ws + WS_O); [[maybe_unused]] bf16_t* YA = (bf16_t*)(ws + WS_YA); [[maybe_unused]] bf16_t* MIXED = (bf16_t*)(ws + WS_MIXED); [[maybe_unused]] bf16_t* HB = (bf16_t*)(ws + WS_HB); \
    [[maybe_unused]] bf16_t* UB = (bf16_t*)(ws + WS_UB); [[maybe_unused]] bf16_t* VBp = (bf16_t*)(ws + WS_VB); [[maybe_unused]] bf16_t* PQ = (bf16_t*)(ws + WS_PQ); [[maybe_unused]] bf16_t* SC = (bf16_t*)(ws + WS_SC);

__global__ void __launch_bounds__(NT, 2) mega(Params p) {
    extern __shared__ __attribute__((aligned(16))) unsigned char lds[];
    cg::grid_group grid = cg::this_grid();
    const int G = gridDim.x, NGW = G * NWAVES;
    volatile LAS unsigned* bst = (volatile LAS unsigned*)((LAS unsigned char*)lds + LDS_BYTES - 16);
    if (threadIdx.x < 2) bst[threadIdx.x] = 0u;
    if (threadIdx.x >= 8 && threadIdx.x < 16) ((volatile LAS unsigned*)((LAS unsigned char*)lds + LDS_BYTES - 64))[threadIdx.x - 8] = 0u;
    if (threadIdx.x >= 16 && threadIdx.x < 32) ((volatile LAS unsigned*)((LAS unsigned char*)lds + LDS_BYTES - 128))[threadIdx.x - 16] = 0u;
    __syncthreads();

    {
        PHASE_PTRS
        if (blockIdx.x == 0 && tid < 64) cnt[tid] = 0u;
        if (blockIdx.x == 0) for (int i = tid; i < XCD_BAR_WORDS; i += NT) xbar_words[i] = 0u;
        for (int i = blockIdx.x * NT + tid; i < T; i += G * NT) ss2[i] = 0.f;
        for (int t = gw; t < T; t += NGW) {
            const f32x4* xr = (const f32x4*)(x + (size_t)t * DM) + lane;
            f32x4 v[4]; float s = 0.f;
#pragma unroll
            for (int j = 0; j < 4; ++j) { v[j] = xr[64 * j]; s += v[j].x * v[j].x + v[j].y * v[j].y + v[j].z * v[j].z + v[j].w * v[j].w; }
            const float rstd = rsqrtf(wave_sum(s) * (1.f / DM) + EPS);
            const f32x4* wr = (const f32x4*)norm1_w + lane;
#pragma unroll
            for (int j = 0; j < 4; ++j) { const f32x4 w = wr[64 * j]; st_bf4(XN + (size_t)t * DM + (lane + 64 * j) * 4, v[j].x * rstd * w.x, v[j].y * rstd * w.y, v[j].z * rstd * w.z, v[j].w * rstd * w.w); }
        }
        float* scr = (float*)lds + wave * (64 * 33);
        int it = gw;
#define TR_SEG(W_, ldw_, c0_, WT_, ldk_, r0_, Kmax_, nkb_, nnb_, ksc_) \
        { const int cntI = (nkb_) * (nnb_); for (; it < cntI; it += NGW) transpose_item(W_, ldw_, c0_, WT_, ldk_, r0_, Kmax_, it / (nnb_), it % (nnb_), ksc_, scr, lane); it -= cntI; }
        TR_SEG(w_in, 4544, 0, WinT, 1024, 0, 1024, 16, 57, nullptr)
        TR_SEG(w_in, 4544, 1824, WinT, 1024, 2048, 1024, 16, 21, nullptr)
        TR_SEG(w_in, 4544, 2496, WinT, 1024, 2816, 1024, 16, 64, nullptr)
        TR_SEG(kp->in[6], 512, 0, W2T, 64, 0, 64, 1, 16, nullptr)
        TR_SEG(kp->in[8], 512, 0, A2T, 64, 0, 64, 1, 16, nullptr)
        TR_SEG(kp->in[9], 512, 0, G2T, 160, 0, 160, 3, 16, nullptr)
#pragma unroll 1
        for (int hh = 0; hh < 8; ++hh) {
            TR_SEG(kp->in[17], 768, hh * 96, WuqT, 384, hh * 64, 384, 6, 2, q_norm_w)
            TR_SEG(kp->in[17], 768, hh * 96 + 64, WuqT, 384, 512 + hh * 32, 384, 6, 1, q_norm_w)
            TR_SEG(kp->in[19], 1024, hh * 128, WukvT, 256, hh * 64, 256, 4, 2, kv_norm_w)
            TR_SEG(kp->in[19], 1024, hh * 128 + 64, WukvT, 256, 512 + hh * 64, 256, 4, 2, kv_norm_w)
        }
        TR_SEG(kp->in[15], 1024, 0, RwoT, 512, 0, 512, 8, 32, nullptr)
        TR_SEG(kp->in[24], 1024, 0, MwoT, 512, 0, 512, 8, 32, nullptr)
        TR_SEG(kp->in[25], 1024, 0, WoutT, 1024, 0, 1024, 16, 32, nullptr)
#undef TR_SEG
        for (; it < 1024; it += NGW) wcomb_item(kp->in[27], kp->in[28], norm2_w, PwqT, it, lane);
        for (int i = blockIdx.x * NT + tid; i < (224 + 96) * 128; i += G * NT) {
            const int r = i >> 7, c = i & 127; const int row = r < 224 ? 1824 + r : 2720 + (r - 224);
            *(u32x4*)(WinT + (size_t)row * 1024 + c * 8) = (u32x4){0u, 0u, 0u, 0u};
        }
    }
    grid.sync();
    const XcdBarrier xb = xcd_barrier_post((unsigned*)(kargs()->ws + WS_CNT + 4096), bst);

    {
        PHASE_PTRS
        pg8::Gemm g{XN, WinT, T, 4864, DM}; pg8::StaticOrder S; S.init(T, 4864, G, (int)blockIdx.x);
        pg8::EpiP1 E{ws};
        pg8::gemm_phase<pg8::EpiP1, pg8::StaticOrder, true, true>((PG8_LAS unsigned char*)lds, g, S, E);
    }
    xcd_barrier(xb);


    {
        PHASE_PTRS
        for (int t = gw; t < T; t += NGW) {
            float a6[8]; ld_bf8(QD + (size_t)t * 384 + 8 * (lane & 47), a6); float s = 0.f;
#pragma unroll
            for (int i = 0; i < 8; ++i) s += a6[i] * a6[i];
            if (lane >= 48) s = 0.f;
            float b4[4]; ld_bf4(KVD + (size_t)t * 256 + 4 * lane, b4); const float s2 = (b4[0] * b4[0] + b4[1] * b4[1]) + (b4[2] * b4[2] + b4[3] * b4[3]);
            const float sq = wave_sum(s), skv = wave_sum(s2);
            if (lane == 0) { ssq[t] = rsqrtf(sq * (1.f / 384.f) + EPS); sskv[t] = rsqrtf(skv * (1.f / 256.f) + EPS); }
        }
    }
    {
        PHASE_PTRS
        LAS bf16_t* MIX = (LAS bf16_t*)lds; LAS bf16_t* LOR = (LAS bf16_t*)((LAS unsigned char*)lds + 49152);
        for (int tt = blockIdx.x; tt < T / 16; tt += G) {
            const int h = wave;
            __syncthreads();
            {
                u32x4 pw[8], ppw[8];
#pragma unroll
                for (int u = 0; u < 8; ++u) {
                    const int ci = tid + u * NT < 16 * 228 ? tid + u * NT : 16 * 228 - 1; const int row = ci / 228, cc = (ci - row * 228) * 8; const int tk = tt * 16 + row;
                    pw[u] = *(const u32x4*)(Prw + (size_t)tk * 2048 + cc);
                    ppw[u] = *(const u32x4*)(Prw + (size_t)((tk & (SEQ - 1)) != 0 ? tk - 1 : tk) * 2048 + cc);
                }
                __builtin_amdgcn_sched_barrier(0);
#pragma unroll
                for (int u = 0; u < 8; ++u) {
                    const int ci = tid + u * NT; if (ci < 16 * 228) {
                        const int row = ci / 228, cc = (ci - row * 228) * 8; const bool hp_ = ((tt * 16 + row) & (SEQ - 1)) != 0;
                        const float pv[8] = {bflo(pw[u].x), bfhi(pw[u].x), bflo(pw[u].y), bfhi(pw[u].y), bflo(pw[u].z), bfhi(pw[u].z), bflo(pw[u].w), bfhi(pw[u].w)};
                        float ppv[8] = {bflo(ppw[u].x), bfhi(ppw[u].x), bflo(ppw[u].y), bfhi(ppw[u].y), bflo(ppw[u].z), bfhi(ppw[u].z), bflo(ppw[u].w), bfhi(ppw[u].w)};
                        if (!hp_) {
#pragma unroll
                            for (int j = 0; j < 8; ++j) ppv[j] = 0.f; }
                        const f32x4 mu0 = *(const f32x4*)(rw_mu + cc), mu1 = *(const f32x4*)(rw_mu + cc + 4); float xm[8];
#pragma unroll
                        for (int j = 0; j < 8; ++j) { const float mu = j < 4 ? mu0[j & 3] : mu1[j & 3]; const float v = pv[j] + mu * (ppv[j] - pv[j]);
                            xm[j] = cc < 1600 ? (cc < 1536 ? v : tanhf_(v)) : (cc < 1664 ? v : sigmoidf_(v)); }
                        if (cc < 1536) *(LAS bf16x8*)(MIX + row * 1536 + cc) = pack8(xm); else *(LAS bf16x8*)(LOR + row * 288 + (cc - 1536)) = pack8(xm);
                    }
                }
            }
            __syncthreads();
            const int tok = tt * 16 + fr;
            f32x4 accw[4], acca[4], accg[4];
#pragma unroll
            for (int n = 0; n < 4; ++n) { accw[n] = (f32x4){0.f, 0.f, 0.f, 0.f}; acca[n] = accw[n]; accg[n] = accw[n]; }
#define LORA_STEP(lcol_, Wt_, ldw_, koff_, accv_) { \
                const bf16x8 a = *(const LAS bf16x8*)(LOR + fr * 288 + (lcol_) + 8 * fq); \
                _Pragma("unroll") for (int n = 0; n < 4; ++n) { const bf16x8 b = *(const bf16x8*)((Wt_) + (size_t)(64 * h + 16 * n + fr) * (ldw_) + (koff_) + 8 * fq); accv_[n] = mfma16(b, a, accv_[n]); } }
#pragma unroll
            for (int ks = 0; ks < 2; ++ks) LORA_STEP(32 * ks, W2T, 64, 32 * ks, accw)
#pragma unroll
            for (int ks = 0; ks < 2; ++ks) LORA_STEP(64 + 32 * ks, A2T, 64, 32 * ks, acca)
#pragma unroll
            for (int ks = 0; ks < 5; ++ks) LORA_STEP(128 + 32 * ks, G2T, 160, 32 * ks, accg)
#undef LORA_STEP
            float kkv[4][4], av[4][4]; float ssq = 0.f, bon = 0.f;
#pragma unroll
            for (int n = 0; n < 4; ++n) {
                const int ch = 64 * h + 16 * n + 4 * fq;
                float r4[4], k4[4], v4[4];
#pragma unroll
                for (int seg = 0; seg < 3; ++seg) {
                    const u32x2 w = *(const LAS u32x2*)(MIX + fr * 1536 + seg * 512 + ch);
                    const float m4[4] = {bflo(w.x), bfhi(w.x), bflo(w.y), bfhi(w.y)};
#pragma unroll
                    for (int i = 0; i < 4; ++i) { if (seg == 0) r4[i] = m4[i]; else if (seg == 1) k4[i] = m4[i]; else v4[i] = m4[i]; }
                }
                const f32x4 w0 = *(const f32x4*)(rw_w0 + ch), a0 = *(const f32x4*)(rw_a0 + ch), kkw = *(const f32x4*)(rw_k_k + ch), kaw = *(const f32x4*)(rw_k_a + ch), rkw = *(const f32x4*)(rw_r_k + ch);
                float dd[4], kf[4];
#pragma unroll
                for (int i = 0; i < 4; ++i) {
                    const float z = -(w0[i] + accw[n][i]);
                    const float sp = z > 20.f ? z : __logf(1.f + __expf(z));
                    const float wlog = -sp - 0.5f;
                    dd[i] = -__expf(wlog);
                    const float a = sigmoidf_(a0[i] + acca[n][i]); av[n][i] = a;
                    kkv[n][i] = k4[i] * kkw[i]; ssq += kkv[n][i] * kkv[n][i];
                    kf[i] = k4[i] * (1.f + (a - 1.f) * kaw[i]);
                    bon += r4[i] * kf[i] * rkw[i];
                }
                const size_t o = (size_t)tok * 512 + ch;
                st_bf4(Rb + o, r4[0], r4[1], r4[2], r4[3]);
                st_bf4(Wb + o, dd[0], dd[1], dd[2], dd[3]);
                st_bf4(Kb + o, kf[0], kf[1], kf[2], kf[3]);
                st_bf4(Vb + o, v4[0], v4[1], v4[2], v4[3]);
                st_bf4(Gtb + o, accg[n][0], accg[n][1], accg[n][2], accg[n][3]);
            }
            ssq += __shfl_xor(ssq, 16); ssq += __shfl_xor(ssq, 32);
            bon += __shfl_xor(bon, 16); bon += __shfl_xor(bon, 32);
            const float inv = 1.f / fmaxf(sqrtf(ssq), 1e-12f);
#pragma unroll
            for (int n = 0; n < 4; ++n) {
                const size_t o = (size_t)tok * 512 + 64 * h + 16 * n + 4 * fq;
                float kk[4], bb[4];
#pragma unroll
                for (int i = 0; i < 4; ++i) { kk[i] = kkv[n][i] * inv; bb[i] = kk[i] * av[n][i]; }
                st_bf4(KKb + o, kk[0], kk[1], kk[2], kk[3]);
                st_bf4(Bvb + o, bb[0], bb[1], bb[2], bb[3]);
            }
            if (fq == 0) bonus[(size_t)tok * 8 + h] = bon;
        }
    }
    xcd_barrier(xb);

    {
        PHASE_PTRS
        { int Kq = 384; asm volatile("" : "+s"(Kq));
          pg8::Gemm g{QD, WuqT, T, 768, Kq}; pg8::StaticOrder S; S.init(T, 768, G, (int)blockIdx.x); pg8::EpiQraw E{Qb, ssq};
          pg8::gemm_phase<pg8::EpiQraw, pg8::StaticOrder, true, true>((PG8_LAS unsigned char*)lds, g, S, E); }
        { int Kkv = 256; asm volatile("" : "+s"(Kkv));
          pg8::Gemm g{KVD, WukvT, T, 1024, Kkv}; pg8::StaticOrder S; S.init(T, 1024, G, (int)blockIdx.x); pg8::EpiKVraw E{Kraw, Vt, sskv};
          pg8::gemm_phase<pg8::EpiKVraw, pg8::StaticOrder, true, true>((PG8_LAS unsigned char*)lds, g, S, E); }
    }
    xcd_barrier(xb);
    {
        PHASE_PTRS
        for (int t = gw; t < T; t += NGW) {
            const int hh = lane >> 3, l8 = lane & 7;
            const float pos = (float)positions[t];
            float cs[4], sn[4];
#pragma unroll
            for (int i = 0; i < 4; ++i) { const float invf = exp2f(-(float)(4 * (l8 & 3) + i) * (13.287712379549449f / 16.f)); float rev = pos * invf * 0.15915494309189535f; rev -= rintf(rev);
                sn[i] = __builtin_amdgcn_sinf(rev); cs[i] = __builtin_amdgcn_cosf(rev); }
            bf16_t* qrow = Qb + (size_t)t * 768;
            float qn[8], qp[4]; ld_bf8(qrow + 8 * lane, qn); ld_bf4(qrow + 512 + 4 * lane, qp);
            float kn[8], kp4[4]; ld_bf8(Kraw + (size_t)t * 512 + 8 * lane, kn); ld_bf4(KPE + (size_t)t * 32 + 4 * l8, kp4);
            float s1 = 0.f, s2 = 0.f, s3 = 0.f, s4 = 0.f;
#pragma unroll
            for (int i = 0; i < 8; ++i) { s1 += qn[i] * qn[i]; s3 += kn[i] * kn[i]; }
#pragma unroll
            for (int i = 0; i < 4; ++i) { s2 += qp[i] * qp[i]; s4 += kp4[i] * kp4[i]; }
            s1 = sum8(s1); s2 = sum8(s2); s3 = sum8(s3); s4 = sum8(s4);
            const float r1 = rsqrtf(s1 * (1.f / 64.f) + EPS) * QSCALE, r2 = rsqrtf(s2 * (1.f / 32.f) + EPS), r3 = rsqrtf(s3 * (1.f / 64.f) + EPS), r4 = rsqrtf(s4 * (1.f / 32.f) + EPS);
            const f32x4 wq0 = *(const f32x4*)(qn_nope_w + 8 * l8), wq1 = *(const f32x4*)(qn_nope_w + 8 * l8 + 4), wk0 = *(const f32x4*)(kn_nope_w + 8 * l8), wk1 = *(const f32x4*)(kn_nope_w + 8 * l8 + 4);
            const f32x4 wqp = *(const f32x4*)(qn_pe_w + 4 * l8), wkp = *(const f32x4*)(kn_pe_w + 4 * l8);
            float oq[8], ok[8], oqp[4], okp[4];
#pragma unroll
            for (int i = 0; i < 8; ++i) { oq[i] = qn[i] * r1 * (i < 4 ? wq0[i & 3] : wq1[i & 3]); ok[i] = kn[i] * r3 * (i < 4 ? wk0[i & 3] : wk1[i & 3]); }
#pragma unroll
            for (int i = 0; i < 4; ++i) {
                const float xq = qp[i] * r2 * wqp[i], xk = kp4[i] * r4 * wkp[i];
                const float pq = dpp_f<0x141>(xq), pk_ = dpp_f<0x141>(xk);
                (void)pq; (void)pk_;
                oqp[i] = xq; okp[i] = xk;
            }
#pragma unroll
            for (int i = 0; i < 4; ++i) {
                const float pq = __shfl_xor(oqp[i], 4), pk_ = __shfl_xor(okp[i], 4);
                const float xq = oqp[i], xk = okp[i];
                oqp[i] = l8 < 4 ? (xq * cs[i] - pq * sn[i]) : (xq * cs[i] + pq * sn[i]);
                okp[i] = l8 < 4 ? (xk * cs[i] - pk_ * sn[i]) : (xk * cs[i] + pk_ * sn[i]);
                oqp[i] *= QSCALE;
            }
            bf16_t* qo = Qb + ((size_t)t * 8 + hh) * 96;
            *(bf16x8*)(qo + 8 * l8) = pack8(oq); st_bf4(qo + 64 + 4 * l8, oqp[0], oqp[1], oqp[2], oqp[3]);
            { const int bb = t >> 12, pos = t & 4095; bf16_t* kfb = Kab + (((size_t)(bb * 8 + hh) * 128 + (pos >> 5)) * 6) * 512 + (pos & 31) * 8;
              *(bf16x8*)(kfb + (l8 >> 1) * 512 + 256 * (l8 & 1)) = pack8(ok);
              st_bf4(kfb + (4 + (l8 >> 2)) * 512 + 256 * ((l8 >> 1) & 1) + 4 * (l8 & 1), okp[0], okp[1], okp[2], okp[3]); }
        }
    }
    xcd_barrier(xb);

    {
        PHASE_PTRS
        float* GL = (float*)(dob + DO_GL);
        const int fr_o = fr, fq_o = fq, lane_o = lane;
        if (wave < 3) {
            LAS unsigned char* wb = (LAS unsigned char*)lds + wave * 49152;
            LAS bf16_t* At = (LAS bf16_t*)(wb + 0);      LAS bf16_t* Btm = (LAS bf16_t*)(wb + 4096);  LAS bf16_t* Ktm = (LAS bf16_t*)(wb + 8192); LAS bf16_t* Rtm = (LAS bf16_t*)(wb + 12288);
            LAS bf16_t* AtT = (LAS bf16_t*)(wb + 16384); LAS bf16_t* BtT = (LAS bf16_t*)(wb + 20480); LAS bf16_t* KtT = (LAS bf16_t*)(wb + 24576); LAS bf16_t* VmT = (LAS bf16_t*)(wb + 28672);
            LAS bf16_t* Nm = (LAS bf16_t*)(wb + 32768);  LAS bf16_t* NmT = (LAS bf16_t*)(wb + 34816); LAS bf16_t* Tm = (LAS bf16_t*)(wb + 36864);  LAS bf16_t* TmT = (LAS bf16_t*)(wb + 38912);
            LAS bf16_t* MmT = (LAS bf16_t*)(wb + 40960); LAS bf16_t* NBT = (LAS bf16_t*)(wb + 43008); LAS bf16_t* MKT = (LAS bf16_t*)(wb + 45056); LAS float* gLs = (LAS float*)(wb + 47104);
            LAS bf16_t* W1 = At; LAS bf16_t* W1T = Btm; LAS bf16_t* ATm = Ktm;
#pragma unroll 1
            for (int it = blockIdx.x * 3 + wave; it < 4096; it += G * 3) {
                const int bh = it >> 7, c = it & 127, b = bh >> 3, h = bh & 7;
                int fr = fr_o, fq = fq_o, lane = lane_o; asm volatile("" : "+v"(fr), "+v"(fq), "+v"(lane));
                const int lpA = (4 * (fr >> 3) + (fr & 3)) + 32 * (fq & 1) + ((fq >> 1) + 4 * ((fr >> 2) & 1)) * 512;
                const int lpB = ((fr >> 1) + 16 * (fq & 1)) * 512 + 16 * (fr & 1) + 4 * (fq >> 1);
                const int lpC = 4 * (fq >> 1) + 16 * (fr & 3) + ((fr >> 2) + 8 * (fq & 1)) * 512;
                const size_t sbase = ((size_t)b * SEQ + c * 32) * 512 + h * 64;
                {
                    float cs = 0.f; unsigned aT[16], bT[16], kT[16], vT[16];
#pragma unroll
                    for (int t = 0; t < 32; ++t) {
                        const size_t o = sbase + (size_t)t * 512 + lane;
                        const float ldv = bf1(Wb[o]), rr = bf1(Rb[o]), kv = bf1(Kb[o]), qv = bf1(KKb[o]), bv = bf1(Bvb[o]); const unsigned vraw = Vb[o];
                        const float ep = __expf(cs); cs += ldv; const float ec = __expf(cs), en = __expf(-cs);
                        const unsigned a_ = bf1of(-qv * ep), b_ = bf1of(bv * en), k_ = bf1of(kv * en), r_ = bf1of(rr * ec);
                        At[SW64(t, lane)] = (bf16_t)a_; Btm[SW64(t, lane)] = (bf16_t)b_; Ktm[SW64(t, lane)] = (bf16_t)k_; Rtm[SW64(t, lane)] = (bf16_t)r_;
                        if (t & 1) { aT[t >> 1] |= a_ << 16; bT[t >> 1] |= b_ << 16; kT[t >> 1] |= k_ << 16; vT[t >> 1] |= vraw << 16; }
                        else { aT[t >> 1] = a_; bT[t >> 1] = b_; kT[t >> 1] = k_; vT[t >> 1] = vraw; }
                    }
#pragma unroll
                    for (int q = 0; q < 4; ++q) {
                        *(LAS u32x4*)(AtT + lane * 32 + ((q ^ ((lane >> 2) & 3)) << 3)) = (u32x4){aT[4 * q], aT[4 * q + 1], aT[4 * q + 2], aT[4 * q + 3]};
                        *(LAS u32x4*)(BtT + lane * 32 + ((q ^ ((lane >> 2) & 3)) << 3)) = (u32x4){bT[4 * q], bT[4 * q + 1], bT[4 * q + 2], bT[4 * q + 3]};
                        *(LAS u32x4*)(KtT + lane * 32 + ((q ^ ((lane >> 2) & 3)) << 3)) = (u32x4){kT[4 * q], kT[4 * q + 1], kT[4 * q + 2], kT[4 * q + 3]};
                        *(LAS u32x4*)(VmT + lane * 32 + ((q ^ ((lane >> 2) & 3)) << 3)) = (u32x4){vT[4 * q], vT[4 * q + 1], vT[4 * q + 2], vT[4 * q + 3]};
                    }
                    const float gl = __expf(cs); gLs[lane] = gl;
                    { const int k5 = lane & 31; GL[(size_t)it * 64 + (lane >> 5) * 32 + ((k5 >> 2) & 1) * 16 + (k5 & 3) + 4 * (k5 >> 3)] = gl; }
                }
                {
                    f32x4 acc[2][2];
#define ZACC(MT_, NT_) _Pragma("unroll") for (int m = 0; m < MT_; ++m) _Pragma("unroll") for (int n = 0; n < NT_; ++n) acc[m][n] = (f32x4){0.f, 0.f, 0.f, 0.f};
                    ZACC(2, 2) gemm_lds<2, 2, 2>(Btm, 64, At, 64, acc, fr, fq);
#pragma unroll
                    for (int m = 0; m < 2; ++m)
#pragma unroll
                        for (int n = 0; n < 2; ++n)
#pragma unroll
                            for (int j = 0; j < 4; ++j) { const int i = 16 * m + fr, tt = 16 * n + 4 * fq + j; const float v = i < tt ? acc[m][n][j] : 0.f; const bf16_t w = bf1of(v), w1 = bf1of(v + (i == tt ? 1.f : 0.f));
                                Nm[SW32(i, tt)] = w; NmT[SW32(tt, i)] = w; Tm[SW32(i, tt)] = w1; TmT[SW32(tt, i)] = w1; }
                    ZACC(2, 2) gemm_lds<2, 2, 2>(Ktm, 64, At, 64, acc, fr, fq);
#pragma unroll
                    for (int m = 0; m < 2; ++m)
#pragma unroll
                        for (int n = 0; n < 2; ++n)
#pragma unroll
                            for (int j = 0; j < 4; ++j) { const int i = 16 * m + fr, tt = 16 * n + 4 * fq + j; MmT[SW32(tt, i)] = bf1of(i < tt ? acc[m][n][j] : 0.f); }
                    ZACC(2, 2) gemm_lds<2, 2, 2>(Btm, 64, Rtm, 64, acc, fr, fq);
#pragma unroll
                    for (int m = 0; m < 2; ++m)
#pragma unroll
                        for (int n = 0; n < 2; ++n)
#pragma unroll
                            for (int j = 0; j < 4; ++j) { const int i = 16 * m + fr, tt = 16 * n + 4 * fq + j; NBT[SW32(tt, i)] = bf1of(i <= tt ? acc[m][n][j] : 0.f); }
                    ZACC(2, 2) gemm_lds<2, 2, 2>(Ktm, 64, Rtm, 64, acc, fr, fq);
#pragma unroll
                    for (int m = 0; m < 2; ++m)
#pragma unroll
                        for (int n = 0; n < 2; ++n)
#pragma unroll
                            for (int j = 0; j < 4; ++j) { const int i = 16 * m + fr, tt = 16 * n + 4 * fq + j; MKT[SW32(tt, i)] = bf1of(i <= tt ? acc[m][n][j] : 0.f); }
#pragma unroll 1
                    for (int rd = 0; rd < 4; ++rd) {
                        ZACC(2, 2) gemm_lds<2, 2, 1>(Nm, 32, NmT, 32, acc, fr, fq);
#pragma unroll
                        for (int m = 0; m < 2; ++m)
#pragma unroll
                            for (int n = 0; n < 2; ++n)
#pragma unroll
                                for (int j = 0; j < 4; ++j) { const int i = 16 * m + fr, tt = 16 * n + 4 * fq + j; const bf16_t w = bf1of(acc[m][n][j]); Nm[SW32(i, tt)] = w; NmT[SW32(tt, i)] = w; }
                        ZACC(2, 2) gemm_lds<2, 2, 1>(Tm, 32, NmT, 32, acc, fr, fq);
#pragma unroll
                        for (int m = 0; m < 2; ++m)
#pragma unroll
                            for (int n = 0; n < 2; ++n)
#pragma unroll
                                for (int j = 0; j < 4; ++j) { const int i = 16 * m + fr, tt = 16 * n + 4 * fq + j; const bf16_t w = bf1of(acc[m][n][j] + bf1(Tm[SW32(i, tt)])); Tm[SW32(i, tt)] = w; TmT[SW32(tt, i)] = w; }
                    }
                }
                asm volatile("" : "+v"(fr), "+v"(fq));
                {
                    f32x4 acc[4][2];
                    ZACC(4, 2) gemm_lds<4, 2, 1>(AtT, 32, TmT, 32, acc, fr, fq);
#pragma unroll
                    for (int m = 0; m < 4; ++m)
#pragma unroll
                        for (int n = 0; n < 2; ++n)
#pragma unroll
                            for (int j = 0; j < 4; ++j) ATm[SW32(16 * m + fr, 16 * n + 4 * fq + j)] = bf1of(acc[m][n][j]);
                    ZACC(4, 2) gemm_lds<4, 2, 1>(VmT, 32, MmT, 32, acc, fr, fq);
#pragma unroll
                    for (int m = 0; m < 4; ++m)
#pragma unroll
                        for (int n = 0; n < 2; ++n)
#pragma unroll
                            for (int j = 0; j < 4; ++j) W1[SW32(16 * m + fr, 16 * n + 4 * fq + j)] = bf1of(acc[m][n][j]);
                    ZACC(4, 2) gemm_lds<4, 2, 1>(W1, 32, TmT, 32, acc, fr, fq);
#pragma unroll
                    for (int m = 0; m < 4; ++m)
#pragma unroll
                        for (int n = 0; n < 2; ++n)
#pragma unroll
                            for (int j = 0; j < 4; ++j) W1T[SW32(16 * m + fr, 16 * n + 4 * fq + j)] = bf1of(acc[m][n][j]);
                    ZACC(4, 2) gemm_lds<4, 2, 1>(ATm, 32, NBT, 32, acc, fr, fq);
#pragma unroll
                    for (int m = 0; m < 4; ++m)
#pragma unroll
                        for (int n = 0; n < 2; ++n)
#pragma unroll
                            for (int j = 0; j < 4; ++j) { const int k = 16 * m + fr, tp = 16 * n + 4 * fq + j; const float v = acc[m][n][j] + bf1(Rtm[SW64(tp, k)]);
                                Rb[sbase + lpA + (size_t)(j * 8 + (2 * n + 8 * m) * 512)] = bf1of(v); }
                    ZACC(4, 2) gemm_lds<4, 2, 1>(W1T, 32, NBT, 32, acc, fr, fq); gemm_lds<4, 2, 1>(VmT, 32, MKT, 32, acc, fr, fq);
#pragma unroll
                    for (int m = 0; m < 4; ++m)
#pragma unroll
                        for (int n = 0; n < 2; ++n)
#pragma unroll
                            for (int j = 0; j < 4; ++j) Yb[sbase + lpB + (size_t)((8 * (m & 1)) * 512 + 32 * (m >> 1) + j + 8 * n)] = bf1of(acc[m][n][j]);
                }
                asm volatile("" : "+v"(fr), "+v"(fq));
                {
                    f32x4 acc[4][4];
                    ZACC(4, 4) gemm_lds<4, 4, 1>(ATm, 32, BtT, 32, acc, fr, fq);
#pragma unroll
                    for (int m = 0; m < 4; ++m)
#pragma unroll
                        for (int n = 0; n < 4; ++n)
#pragma unroll
                            for (int j = 0; j < 4; ++j) { const float v = acc[m][n][j] * gLs[16 * n + 4 * fq + j];
                                (n < 2 ? Wb : Kb)[sbase + lpA + (size_t)(j * 8 + (2 * (n & 1) + 8 * m) * 512)] = bf1of(v); }
                    ZACC(4, 4) gemm_lds<4, 4, 1>(W1T, 32, BtT, 32, acc, fr, fq); gemm_lds<4, 4, 1>(VmT, 32, KtT, 32, acc, fr, fq);
#pragma unroll
                    for (int m = 0; m < 4; ++m)
#pragma unroll
                        for (int n = 0; n < 4; ++n)
#pragma unroll
                            for (int j = 0; j < 4; ++j) { const float v = acc[m][n][j] * gLs[16 * n + 4 * fq + j];
                                (m < 2 ? KKb : Bvb)[sbase + lpC + (size_t)(j + 8 * (n & 1) + (4 * (m & 1) + 16 * (n >> 1)) * 512)] = bf1of(v); }
                }
#undef ZACC
            }
        }
    }
    xcd_barrier(xb);

    {
        PHASE_PTRS
        if (wave < 5 && blockIdx.x < 64) {
            const int item = blockIdx.x, bh = item >> 1, wv = item & 1, b = bh >> 3, h = bh & 7;
            const int hi = lane >> 5, vcol = lane & 31;
            float* GL = (float*)(dob + DO_GL);
            volatile LAS unsigned* ctr = (volatile LAS unsigned*)((LAS unsigned char*)lds + LDS_BYTES - 64);
#define SLICE(arr, sb, li) ((arr) + (sb) + (size_t)((li) >> 6) * 512 + ((li) & 63))
#define DMA16(src_, dst_) __builtin_amdgcn_global_load_lds((const unsigned*)(src_), (LAS unsigned*)(dst_), 16, 0, 0)
            if (wave >= 1 && wave <= 3) {
                __builtin_amdgcn_s_setprio(2);
#pragma unroll 1
                for (int c = 0; c < 128; ++c) {
                    if (c >= 4) { while ((int)ctr[3] < c - 3) __builtin_amdgcn_s_sleep(1); }
                    asm volatile("" ::: "memory");
                    const size_t sb = ((size_t)b * SEQ + c * 32) * 512 + h * 64; LAS unsigned char* lb = (LAS unsigned char*)lds + (c & 3) * 19712;
                    if (wave == 1) {
#pragma unroll
                        for (int q = 0; q < 4; ++q) DMA16(SLICE(Wb, sb, (q * 64 + lane) * 8), lb + q * 1024);
#pragma unroll
                        for (int q = 0; q < 2; ++q) DMA16(SLICE(Kb, sb, (q * 64 + lane) * 8), lb + 4096 + q * 1024);
                        asm volatile("s_waitcnt vmcnt(12)" ::: "memory");
                    } else if (wave == 2) {
#pragma unroll
                        for (int q = 2; q < 4; ++q) DMA16(SLICE(Kb, sb, (q * 64 + lane) * 8), lb + 4096 + q * 1024);
#pragma unroll
                        for (int q = 0; q < 4; ++q) DMA16(SLICE(Rb, sb, (q * 64 + lane) * 8), lb + 8192 + q * 1024);
                        asm volatile("s_waitcnt vmcnt(12)" ::: "memory");
                    } else {
#pragma unroll
                        for (int kb = 0; kb < 2; ++kb)
#pragma unroll
                            for (int hf = 0; hf < 2; ++hf) DMA16(SLICE(wv ? Bvb : KKb, sb, (kb * 64 + lane) * 16 + 8 * hf), lb + 12288 + kb * 2048 + hf * 1024);
#pragma unroll
                        for (int hf = 0; hf < 2; ++hf) DMA16(Yb + sb + (size_t)(lane >> 1) * 512 + 32 * wv + 16 * (lane & 1) + 8 * hf, lb + 16384 + hf * 1024);
                        __builtin_amdgcn_global_load_lds((const unsigned*)(GL + ((size_t)(bh * 128 + c)) * 64 + lane), (LAS unsigned*)(lb + 18432), 4, 0, 0);
                        asm volatile("s_waitcnt vmcnt(14)" ::: "memory");
                    }
                    if (c >= 2 && lane == 0) ctr[wave - 1] = (unsigned)(c - 1);
                }
                asm volatile("s_waitcnt vmcnt(0)" ::: "memory");
                if (lane == 0) ctr[wave - 1] = 128u;
                __builtin_amdgcn_s_setprio(0);
            } else if (wave == 4) {
#pragma unroll 1
                for (int c = 0; c < 128; ++c) {
                    while ((int)ctr[4] <= c) __builtin_amdgcn_s_sleep(2);
                    asm volatile("" ::: "memory");
                    const LAS u32x4* ys = (const LAS u32x4*)((LAS unsigned char*)lds + 81920 + (c & 7) * 2048 + lane * 32);
                    const u32x4 ya = ys[0], yb = ys[1];
                    u32x4* yo = (u32x4*)(Yb + ((size_t)b * SEQ + c * 32 + (lane >> 1)) * 512 + h * 64 + 32 * wv + 16 * (lane & 1));
                    yo[0] = ya; yo[1] = yb;
                    asm volatile("s_waitcnt lgkmcnt(0)" ::: "memory");
                    if (lane == 0) ctr[5] = (unsigned)(c + 1);
                }
            } else {
                __builtin_amdgcn_s_setprio(3);
                f32x16 S0t, S1t;
#pragma unroll
                for (int r = 0; r < 16; ++r) { S0t[r] = 0.f; S1t[r] = 0.f; }
#pragma unroll 1
                for (int c = 0; c < 128; ++c) {
                    while ((int)ctr[0] <= c || (int)ctr[1] <= c || (int)ctr[2] <= c) __builtin_amdgcn_s_sleep(1);
                    asm volatile("" ::: "memory");
                    const LAS unsigned char* lb = (const LAS unsigned char*)lds + (c & 3) * 19712;
                    bf16x8 sf[4];
#pragma unroll
                    for (int s = 0; s < 4; ++s) { float t8[8];
#pragma unroll
                        for (int j = 0; j < 8; ++j) t8[j] = (s < 2 ? S0t : S1t)[8 * (s & 1) + j];
                        sf[s] = pack8(t8); }
                    f32x16 yt;
                    { const u32x4 c0 = *(const LAS u32x4*)(lb + 16384 + lane * 16), c1 = *(const LAS u32x4*)(lb + 16384 + 1024 + lane * 16);
                      yt[0] = bflo(c0.x); yt[1] = bfhi(c0.x); yt[2] = bflo(c0.y); yt[3] = bfhi(c0.y); yt[4] = bflo(c0.z); yt[5] = bfhi(c0.z); yt[6] = bflo(c0.w); yt[7] = bfhi(c0.w);
                      yt[8] = bflo(c1.x); yt[9] = bfhi(c1.x); yt[10] = bflo(c1.y); yt[11] = bfhi(c1.y); yt[12] = bflo(c1.z); yt[13] = bfhi(c1.z); yt[14] = bflo(c1.w); yt[15] = bfhi(c1.w); }
                    f32x16 n0, n1;
#pragma unroll
                    for (int kb = 0; kb < 2; ++kb) {
                        const u32x4 c0 = *(const LAS u32x4*)(lb + 12288 + kb * 2048 + lane * 16), c1 = *(const LAS u32x4*)(lb + 12288 + kb * 2048 + 1024 + lane * 16);
                        const LAS float* gp = (const LAS float*)(lb + 18432) + kb * 32 + hi * 16;
                        f32x16 nn; const f32x16 so = kb ? S1t : S0t;
                        nn[0] = bflo(c0.x); nn[1] = bfhi(c0.x); nn[2] = bflo(c0.y); nn[3] = bfhi(c0.y); nn[4] = bflo(c0.z); nn[5] = bfhi(c0.z); nn[6] = bflo(c0.w); nn[7] = bfhi(c0.w);
                        nn[8] = bflo(c1.x); nn[9] = bfhi(c1.x); nn[10] = bflo(c1.y); nn[11] = bfhi(c1.y); nn[12] = bflo(c1.z); nn[13] = bfhi(c1.z); nn[14] = bflo(c1.w); nn[15] = bfhi(c1.w);
#pragma unroll
                        for (int r = 0; r < 16; ++r) nn[r] += gp[r] * so[r];
                        if (kb) n1 = nn; else n0 = nn;
                    }
#pragma unroll
                    for (int s = 0; s < 4; ++s) {
                        const bf16x8 ra = *(const LAS bf16x8*)(lb + 8192 + s * 1024 + lane * 16);
                        const bf16x8 p0 = *(const LAS bf16x8*)(lb + s * 1024 + lane * 16), p1 = *(const LAS bf16x8*)(lb + 4096 + s * 1024 + lane * 16);
                        yt = mfma32(ra, sf[s], yt); n0 = mfma32(p0, sf[s], n0); n1 = mfma32(p1, sf[s], n1);
                    }
                    S0t = n0; S1t = n1;
                    asm volatile("s_waitcnt lgkmcnt(0)" ::: "memory");
                    if (lane == 0) ctr[3] = (unsigned)(c + 1);
                    if (c >= 8) { while ((int)ctr[5] < c - 7) __builtin_amdgcn_s_sleep(1); }
                    asm volatile("" ::: "memory");
                    { LAS bf16_t* ys = (LAS bf16_t*)((LAS unsigned char*)lds + 81920 + (c & 7) * 2048) + vcol;
#pragma unroll
                      for (int r = 0; r < 16; ++r) ys[crow(r, hi) * 32] = bf1of(yt[r]);
                      asm volatile("s_waitcnt lgkmcnt(0)" ::: "memory");
                      if (lane == 0) ctr[4] = (unsigned)(c + 1); }
                }
                __builtin_amdgcn_s_setprio(0);
            }
#undef DMA16
#undef SLICE
        }
        for (;;) {
            unsigned item = 0;
            const int xg = blockIdx.x & 7;
            if (lane == 0) item = atomicAdd(&cnt[xg], 1u);
            item = __builtin_amdgcn_readfirstlane(item);
            if (item >= 256u) break;
            const int qt = 63 - (int)(item >> 2), bh = 8 * (int)(item & 3) + xg, b = bh >> 3, h = bh & 7;
            const int qi = lane & 31, hi = lane >> 5;
            const size_t tokq = (size_t)b * SEQ + qt * 64 + qi;
            bf16x8 qfa[6], qfb[6];
#pragma unroll
            for (int s = 0; s < 6; ++s) { qfa[s] = *(const bf16x8*)(Qb + (tokq * 8 + h) * 96 + 16 * s + 8 * hi); qfb[s] = *(const bf16x8*)(Qb + ((tokq + 32) * 8 + h) * 96 + 16 * s + 8 * hi); }
            float ma = -1e30f, la = 0.f, mb = -1e30f, lb = 0.f;
            f32x16 oa0, oa1, ob0, ob1;
#pragma unroll
            for (int r = 0; r < 16; ++r) { oa0[r] = 0.f; oa1[r] = 0.f; ob0[r] = 0.f; ob1[r] = 0.f; }
            const bf16_t* kfb = Kab + ((size_t)(b * 8 + h) * 128) * 6 * 512 + lane * 8;
            const bf16_t* vfb = Vt + ((size_t)(b * 8 + h) * 128) * 4 * 512 + lane * 8;
            const int nt = 2 * qt + 2;
#define ATT_GROUP(QF, M_, L_, O0, O1, DIAG) { \
                f32x16 xs; _Pragma("unroll") for (int r = 0; r < 16; ++r) xs[r] = 0.f; \
                _Pragma("unroll") for (int s = 0; s < 6; ++s) xs = mfma32(kf[s], QF[s], xs); \
                if (DIAG) { _Pragma("unroll") for (int r = 0; r < 16; ++r) if (crow(r, hi) > qi) xs[r] = -1e30f; } \
                float mx = xs[0]; _Pragma("unroll") for (int r = 1; r < 16; ++r) mx = fmaxf(mx, xs[r]); \
                mx = fmaxf(mx, __shfl_xor(mx, 32)); \
                if (__any(mx > M_)) { const float mn = fmaxf(M_, mx), alpha = __builtin_amdgcn_exp2f(M_ - mn); L_ *= alpha; M_ = mn; \
                    _Pragma("unroll") for (int r = 0; r < 16; ++r) { O0[r] *= alpha; O1[r] *= alpha; } } \
                float ps = 0.f; _Pragma("unroll") for (int r = 0; r < 16; ++r) { xs[r] = __builtin_amdgcn_exp2f(xs[r] - M_); ps += xs[r]; } \
                L_ += ps; \
                _Pragma("unroll") for (int s = 0; s < 2; ++s) { float t8[8]; _Pragma("unroll") for (int j = 0; j < 8; ++j) t8[j] = xs[8 * s + j]; const bf16x8 pbs = pack8(t8); \
                    O0 = mfma32(vf[0][s], pbs, O0); O1 = mfma32(vf[1][s], pbs, O1); } }
#pragma unroll 1
            for (int kt = 0; kt < nt; ++kt) {
                bf16x8 kf[6], vf[2][2];
#pragma unroll
                for (int s = 0; s < 6; ++s) kf[s] = *(const bf16x8*)(kfb + (size_t)(kt * 6 + s) * 512);
#pragma unroll
                for (int d0 = 0; d0 < 2; ++d0)
#pragma unroll
                    for (int s = 0; s < 2; ++s) vf[d0][s] = *(const bf16x8*)(vfb + (size_t)((kt * 2 + d0) * 2 + s) * 512);
                if (kt < nt - 1) ATT_GROUP(qfa, ma, la, oa0, oa1, kt == nt - 2)
                ATT_GROUP(qfb, mb, lb, ob0, ob1, kt == nt - 1)
            }
#undef ATT_GROUP
            la += __shfl_xor(la, 32); lb += __shfl_xor(lb, 32);
            const float ila = 1.f / la, ilb = 1.f / lb;
            bf16_t* orow = Ob + tokq * 512 + h * 64;
#pragma unroll
            for (int g = 0; g < 4; ++g) {
                st_bf4(orow + 8 * g + 4 * hi, oa0[4 * g] * ila, oa0[4 * g + 1] * ila, oa0[4 * g + 2] * ila, oa0[4 * g + 3] * ila);
                st_bf4(orow + 32 + 8 * g + 4 * hi, oa1[4 * g] * ila, oa1[4 * g + 1] * ila, oa1[4 * g + 2] * ila, oa1[4 * g + 3] * ila);
                st_bf4(orow + (size_t)32 * 512 + 8 * g + 4 * hi, ob0[4 * g] * ilb, ob0[4 * g + 1] * ilb, ob0[4 * g + 2] * ilb, ob0[4 * g + 3] * ilb);
                st_bf4(orow + (size_t)32 * 512 + 32 + 8 * g + 4 * hi, ob1[4 * g] * ilb, ob1[4 * g + 1] * ilb, ob1[4 * g + 2] * ilb, ob1[4 * g + 3] * ilb);
            }
        }
    }
    xcd_barrier(xb);

    {
        PHASE_PTRS
        for (int t = gw; t < T; t += NGW) {
            const int ch = 8 * lane, h = lane >> 3;
            float y[8], v[8], g[8]; ld_bf8(Yb + (size_t)t * 512 + ch, y); ld_bf8(Vb + (size_t)t * 512 + ch, v); ld_bf8(Gtb + (size_t)t * 512 + ch, g);
            float s = 0.f;
#pragma unroll
            for (int i = 0; i < 8; ++i) s += y[i];
            s += __shfl_xor(s, 1); s += __shfl_xor(s, 2); s += __shfl_xor(s, 4);
            const float mu = s * (1.f / 64.f); float q = 0.f;
#pragma unroll
            for (int i = 0; i < 8; ++i) { y[i] -= mu; q += y[i] * y[i]; }
            q += __shfl_xor(q, 1); q += __shfl_xor(q, 2); q += __shfl_xor(q, 4);
            const float rstd = rsqrtf(q * (1.f / 64.f) + 64e-5f);
            const float bo = bonus[(size_t)t * 8 + h];
            const f32x4 lw0 = *(const f32x4*)(rw_ln_w + ch), lw1 = *(const f32x4*)(rw_ln_w + ch + 4), lb0 = *(const f32x4*)(rw_ln_b + ch), lb1 = *(const f32x4*)(rw_ln_b + ch + 4);
            float o[8];
#pragma unroll
            for (int i = 0; i < 8; ++i) { const float lw = i < 4 ? lw0[i & 3] : lw1[i & 3], lb = i < 4 ? lb0[i & 3] : lb1[i & 3]; o[i] = (y[i] * rstd * lw + lb + bo * v[i]) * g[i]; }
            *(bf16x8*)(YA + (size_t)t * 512 + ch) = pack8(o);
        }
    }
    xcd_barrier(xb);

    {
        PHASE_PTRS
        pg8::StaticOrder S; S.init(T, 1024, G, (int)blockIdx.x);
        { pg8::Gemm g{YA, RwoT, T, 1024, 512}; pg8::EpiGate E{MIXED, Gg, 0, 0};
          pg8::gemm_phase<pg8::EpiGate, pg8::StaticOrder, true, true>((PG8_LAS unsigned char*)lds, g, S, E); }
        { pg8::Gemm g{Ob, MwoT, T, 1024, 512}; pg8::EpiGate E{MIXED, Gg, 1024, 1};
          pg8::gemm_phase<pg8::EpiGate, pg8::StaticOrder, true, true>((PG8_LAS unsigned char*)lds, g, S, E); }
    }
    xcd_barrier(xb);

    {
        PHASE_PTRS
        { pg8::Gemm g{MIXED, WoutT, T, 1024, 1024}; pg8::StaticOrder S; S.init(T, 1024, G, (int)blockIdx.x);
          pg8::EpiRes E{x, HB, ss2};
          pg8::gemm_phase<pg8::EpiRes, pg8::StaticOrder, true, true>((PG8_LAS unsigned char*)lds, g, S, E); }
        { const float* pu = kp->in[29]; const float* pv = kp->in[30];
          for (size_t i = (size_t)blockIdx.x * NT + tid; i < (size_t)16384 * 1024 / 16; i += (size_t)G * NT) {
              u32x4 uo, vo;
#pragma unroll
              for (int q = 0; q < 4; ++q) {
                  const f32x4 u = ((const f32x4*)pu)[i * 4 + q]; const f32x4 w = ((const f32x4*)norm2_w)[(i & 63) * 4 + q];
                  uo[q] = pk4_fp8(u.x * w.x * U8_SCALE, u.y * w.y * U8_SCALE, u.z * w.z * U8_SCALE, u.w * w.w * U8_SCALE);
                  const f32x4 v = ((const f32x4*)pv)[i * 4 + q]; vo[q] = pk4_fp8(v.x * V8_SCALE, v.y * V8_SCALE, v.z * V8_SCALE, v.w * V8_SCALE);
              }
              ((u32x4*)UB)[i] = uo;
              { const size_t e = i >> 6; const int d0 = (int)(i & 63) * 16; *(u32x4*)((unsigned char*)VBp + ((size_t)(d0 >> 7) * 16384 + e) * 128 + (d0 & 127)) = vo; } } }
    }
    xcd_barrier(xb);

    {
        PHASE_PTRS
        pg8::Gemm g{HB, PwqT, T, 2048, 1024}; pg8::StaticOrder S; S.init(T, 2048, G, (int)blockIdx.x);
        pg8::EpiScale E{SC, ss2};
        pg8::gemm_phase<pg8::EpiScale, pg8::StaticOrder, true, true>((PG8_LAS unsigned char*)lds, g, S, E);
    }
    xcd_barrier(xb);

    {
        PHASE_PTRS
        const int wp = wave & 3; const bool producer = wave < 4;
        volatile LAS unsigned* pc = (volatile LAS unsigned*)((LAS unsigned char*)lds + LDS_BYTES - 128) + 2 * wp;
        int kq = 0;
        for (int t = blockIdx.x * 4 + wp; t < T; t += G * 4, ++kq) {
            LAS unsigned char* wl = (LAS unsigned char*)lds + wp * 4096 + (kq & 1) * 2048;
            LAS u32x2* tab = (LAS u32x2*)wl;
            const float rs = rsqrtf(ss2[t] * (1.f / DM) + EPS);
            if (producer) {
            if (kq >= 2) { while ((int)pc[1] < kq - 1) __builtin_amdgcn_s_sleep(2); }
            asm volatile("" ::: "memory");
            { float xa[8], xb[8]; ld_bf8(HB + (size_t)t * DM + 16 * lane, xa); ld_bf8(HB + (size_t)t * DM + 16 * lane + 8, xb);
              u32x4 w; w.x = pk4_fp8(xa[0], xa[1], xa[2], xa[3]); w.y = pk4_fp8(xa[4], xa[5], xa[6], xa[7]); w.z = pk4_fp8(xb[0], xb[1], xb[2], xb[3]); w.w = pk4_fp8(xb[4], xb[5], xb[6], xb[7]);
              *(LAS u32x4*)(wl + 1024 + lane * 16) = w; }
#define SORT4(k) { unsigned hi_, lo_; \
                    hi_ = umax2(k[0], k[1]); lo_ = k[0] < k[1] ? k[0] : k[1]; k[0] = hi_; k[1] = lo_; hi_ = umax2(k[2], k[3]); lo_ = k[2] < k[3] ? k[2] : k[3]; k[2] = hi_; k[3] = lo_; \
                    hi_ = umax2(k[0], k[2]); lo_ = k[0] < k[2] ? k[0] : k[2]; k[0] = hi_; k[2] = lo_; hi_ = umax2(k[1], k[3]); lo_ = k[1] < k[3] ? k[1] : k[3]; k[1] = hi_; k[3] = lo_; \
                    hi_ = umax2(k[1], k[2]); lo_ = k[1] < k[2] ? k[1] : k[2]; k[1] = hi_; k[2] = lo_; }
#pragma unroll 1
            for (int hg = 0; hg < 8; hg += 4) {
                unsigned key[4][4], top[4];
#pragma unroll
                for (int q = 0; q < 4; ++q) {
                    const u32x2 w = *(const u32x2*)(SC + (size_t)t * 2048 + (hg + q) * 256 + 4 * lane);
                    const float f[4] = {bflo(w.x), bfhi(w.x), bflo(w.y), bfhi(w.y)};
#pragma unroll
                    for (int c = 0; c < 4; ++c) { unsigned u = __float_as_uint(f[c]); u = (u & 0x80000000u) ? ~u : (u | 0x80000000u); key[q][c] = (u & ~127u) | (unsigned)(127 - (4 * (lane & 31) + c)); }
                    SORT4(key[q])
                    top[q] = 0u;
                }
#pragma unroll 1
                for (int r = 0; r < 16; ++r) {
                    const bool isr = (lane & 31) == r;
#pragma unroll
                    for (int q = 0; q < 4; ++q) {
                        unsigned m = umax16(key[q][0]);
                        { const auto rr = __builtin_amdgcn_permlane16_swap(m, m, false, false); m = umax2(rr[0], rr[1]); }
                        const bool win = key[q][0] == m;
                        key[q][0] = win ? key[q][1] : key[q][0]; key[q][1] = win ? key[q][2] : key[q][1]; key[q][2] = win ? key[q][3] : key[q][2]; key[q][3] = win ? 0u : key[q][3];
                        top[q] = isr ? m : top[q];
                    }
                }
                unsigned ck[4][4], best[4];
#pragma unroll
                for (int q = 0; q < 4; ++q) {
                    float sval; { unsigned u = top[q] & ~127u; u = (u & 0x80000000u) ? (u & 0x7fffffffu) : ~u; sval = __uint_as_float(u); }
                    const float a = __shfl(sval, lane >> 2);
#pragma unroll
                    for (int c = 0; c < 4; ++c) { const float bsc = __shfl(sval, 32 + 4 * (lane & 3) + c); unsigned u = __float_as_uint(a + bsc); u = (u & 0x80000000u) ? ~u : (u | 0x80000000u);
                        ck[q][c] = (u & ~255u) | (unsigned)(255 - ((lane >> 2) * 16 + 4 * (lane & 3) + c)); }
                    SORT4(ck[q])
                    best[q] = 0u;
                }
#pragma unroll 1
                for (int r = 0; r < 16; ++r) {
                    const bool isr = lane == r;
#pragma unroll
                    for (int q = 0; q < 4; ++q) {
                        unsigned m = umax16(ck[q][0]);
                        { const auto rr = __builtin_amdgcn_permlane16_swap(m, m, false, false); m = umax2(rr[0], rr[1]); }
                        { const auto rr = __builtin_amdgcn_permlane32_swap(m, m, false, false); m = umax2(rr[0], rr[1]); }
                        const bool win = ck[q][0] == m;
                        ck[q][0] = win ? ck[q][1] : ck[q][0]; ck[q][1] = win ? ck[q][2] : ck[q][1]; ck[q][2] = win ? ck[q][3] : ck[q][2]; ck[q][3] = win ? 0u : ck[q][3];
                        best[q] = isr ? m : best[q];
                    }
                }
#pragma unroll
                for (int q = 0; q < 4; ++q) {
                    float bs; { unsigned u = best[q] & ~255u; u = (u & 0x80000000u) ? (u & 0x7fffffffu) : ~u; bs = __uint_as_float(u); }
                    const int pos = 255 - (int)(best[q] & 255u);
                    const float bmax = __uint_as_float(rdlane(__float_as_uint(bs), 0));
                    const float e = lane < 16 ? __expf(bs - bmax) : 0.f;
                    const float gate = e / sum16(e);
                    const unsigned t1 = (unsigned)__shfl((int)top[q], (pos >> 4) & 15), t2 = (unsigned)__shfl((int)top[q], 32 + (pos & 15));
                    const unsigned eid = (127u - (t1 & 127u)) * 128u + (127u - (t2 & 127u));
                    if (lane < 16) tab[16 * (hg + q) + lane] = (u32x2){eid, __float_as_uint(gate)};
                }
            }
#undef SORT4
            asm volatile("s_waitcnt lgkmcnt(0)" ::: "memory");
            if (lane == 0) pc[0] = (unsigned)(kq + 1);
            } else {
            while ((int)pc[0] <= kq) __builtin_amdgcn_s_sleep(2);
            asm volatile("" ::: "memory");
            const unsigned char* UB8 = (const unsigned char*)UB; const unsigned char* VB8 = (const unsigned char*)VBp;
            u32x4 ua[16];
            { const unsigned char* up = UB8 + (size_t)tab[fr].x * DM + 16 * fq;
#pragma unroll
              for (int s = 0; s < 16; ++s) ua[s] = *(const u32x4*)(up + 64 * s); }
#pragma unroll 1
            for (int h = 0; h < 8; ++h) {
                u32x4 uc[16];
#pragma unroll
                for (int s = 0; s < 16; ++s) uc[s] = ua[s];
                { const int hn = h + 1 < 8 ? h + 1 : 7; const unsigned char* up = UB8 + (size_t)tab[16 * hn + fr].x * DM + 16 * fq;
#pragma unroll
                  for (int s = 0; s < 16; ++s) ua[s] = *(const u32x4*)(up + 64 * s); }
                f32x4 ac0 = (f32x4){0.f, 0.f, 0.f, 0.f}, ac1 = ac0, ac2 = ac0, ac3 = ac0;
#pragma unroll
                for (int s = 0; s < 16; s += 2) {
                    const u32x4 b0 = *(const LAS u32x4*)(wl + 1024 + 64 * s + 16 * fq), b1 = *(const LAS u32x4*)(wl + 1024 + 64 * (s + 1) + 16 * fq);
                    ac0 = mfma16_fp8((u32x2){uc[s].x, uc[s].y}, (u32x2){b0.x, b0.y}, ac0);
                    ac1 = mfma16_fp8((u32x2){uc[s].z, uc[s].w}, (u32x2){b0.z, b0.w}, ac1);
                    ac2 = mfma16_fp8((u32x2){uc[s + 1].x, uc[s + 1].y}, (u32x2){b1.x, b1.y}, ac2);
                    ac3 = mfma16_fp8((u32x2){uc[s + 1].z, uc[s + 1].w}, (u32x2){b1.z, b1.w}, ac3);
                }
                const f32x4 acc = (ac0 + ac1) + (ac2 + ac3);
                const int j = fr & 3;
                const float d = (j == 0 ? acc[0] : (j == 1 ? acc[1] : (j == 2 ? acc[2] : acc[3]))) * (rs * (1.f / U8_SCALE));
                const float act = 0.5f * d * (1.f + erff(d * 0.7071067811865476f));
                if (fr < 4) { const int i = 16 * h + 4 * fq + fr; const float g = __uint_as_float(tab[i].y); tab[i].y = __float_as_uint(g * act * (1.f / V8_SCALE)); }
            }
            asm volatile("s_waitcnt lgkmcnt(0)" ::: "memory");
            {
                const u32x4 tv = *(const LAS u32x4*)(wl + lane * 16);
                LAS unsigned char* tq = wl + 1024; const int r0 = 2 * (lane & 3), l0 = lane >> 2;
                *(LAS unsigned short*)(tq + (r0 * 16 + l0) * 2) = (unsigned short)tv.x; *(LAS unsigned short*)(tq + ((r0 + 1) * 16 + l0) * 2) = (unsigned short)tv.z;
                const float c0 = fminf(fmaxf(__uint_as_float(tv.y) * C8_SCALE, -440.f), 440.f), c1 = fminf(fmaxf(__uint_as_float(tv.w) * C8_SCALE, -440.f), 440.f);
                const unsigned c8 = (unsigned)__builtin_amdgcn_cvt_pk_fp8_f32(c0, c1, 0, false);
                *(tq + 256 + r0 * 16 + l0) = (unsigned char)(c8 & 0xffu); *(tq + 256 + (r0 + 1) * 16 + l0) = (unsigned char)((c8 >> 8) & 0xffu);
                asm volatile("s_waitcnt lgkmcnt(0)" ::: "memory");
                if (lane < 24) { const u32x4 o = *(const LAS u32x4*)(tq + lane * 16); *(u32x4*)(ws + WS_TAB + (size_t)t * 384 + lane * 16) = o; }
            }
            asm volatile("s_waitcnt lgkmcnt(0)" ::: "memory");
            if (lane == 0) pc[1] = (unsigned)(kq + 1);
            }
        }
    }
    xcd_barrier(xb);

    {
        PHASE_PTRS
        const unsigned sl = blockIdx.x & 7;
        const unsigned char* VS = (const unsigned char*)VBp + (size_t)sl * 16384 * 128;
        const int rho = lane >> 3, chi = lane & 7;
        constexpr float CSCALE = C8_SCALE;
        unsigned selLo[4], selHi[4];
#pragma unroll
        for (int k = 0; k < 4; ++k) { const unsigned sh = 8u * (unsigned)(chi & 3); const unsigned v = (0x0c0c0c0cu & ~(0xffu << sh)) | ((unsigned)k << sh);
            selLo[k] = chi < 4 ? v : 0x0c0c0c0cu; selHi[k] = chi < 4 ? 0x0c0c0c0cu : v; }
        const bool olane = (lane & 0x28) == 0;
        const unsigned voff0 = 16u * (unsigned)chi;
        LAS unsigned char* wl8 = (LAS unsigned char*)lds + wave * 6144;
        const int wstride = (G >> 3) * NWAVES, tg0 = (blockIdx.x >> 3) * NWAVES + wave;
        const int nb = tg0 < T / 8 ? (T / 8 - tg0 + wstride - 1) / wstride : 0, ntok = nb * 8;
#define P6C_TOK(i_) ((tg0 + ((i_) >> 3) * wstride) * 8 + ((i_) & 7))
#define P6C_DMA(b_) { _Pragma("unroll") for (int k = 0; k < 3; ++k) __builtin_amdgcn_global_load_lds((const unsigned*)(ws + WS_TAB + (size_t)((tg0 + (b_) * wstride) * 8) * 384 + k * 1024 + lane * 16), (LAS unsigned*)(wl8 + ((b_) & 1) * 3072 + k * 1024), 16, 0, 0); }
#define P6C_TAB(EL, EH, CW, i_) { const int ii_ = (i_) < ntok ? (i_) : ntok - 1; const LAS unsigned char* tq_ = wl8 + ((ii_ >> 3) & 1) * 3072 + (ii_ & 7) * 384; \
            EL = *(const LAS u32x4*)(tq_ + rho * 32); EH = *(const LAS u32x4*)(tq_ + rho * 32 + 16); CW = *(const LAS u32x4*)(tq_ + 256 + rho * 16); }
#define P6C_EID(ER, j_) (((j_) & 1) ? (ER[(j_) >> 1] >> 16) : (ER[(j_) >> 1] & 0xffffu))
#define P6C_LOAD(VV, ER) { _Pragma("unroll") for (int j = 0; j < 8; ++j) VV[j] = *(const u32x4*)(VS + (size_t)((P6C_EID(ER, j) << 7) | voff0)); }
#define P6C_USE(VV, CWA, CWB) { _Pragma("unroll") for (int j = 0; j < 8; ++j) { const unsigned cwd = (j < 4) ? CWA : CWB; \
            u32x2 xo; xo.x = __builtin_amdgcn_perm(cwd, cwd, selLo[j & 3]); xo.y = __builtin_amdgcn_perm(cwd, cwd, selHi[j & 3]); \
            acc0 = mfma16_fp8(xo, (u32x2){VV[j].x, VV[j].y}, acc0); acc1 = mfma16_fp8(xo, (u32x2){VV[j].z, VV[j].w}, acc1); } }
#define P6C_BODY(i_, VA, VB, EL, EH, CW, VBo, EHo) { \
            const size_t oo_ = (size_t)P6C_TOK(i_) * DM + 128 * sl + 16 * chi + 4 * ((lane >> 4) & 1); float* orow = kp->out + oo_; \
            u32x2 hw0 = (u32x2){0u, 0u}, hw1 = hw0; \
            if (olane) { hw0 = *(const u32x2*)(HB + oo_); hw1 = *(const u32x2*)(HB + oo_ + 8); }        \
            P6C_LOAD(VBo, EHo)                                     \
            const u32x4 cwq = CW; \
            __builtin_amdgcn_sched_barrier(0); \
            f32x4 acc0 = (f32x4){0.f, 0.f, 0.f, 0.f}, acc1 = acc0; \
            P6C_USE(VA, cwq.x, cwq.y) \
            __builtin_amdgcn_sched_barrier(0); \
            P6C_TAB(EL, EH, CW, (i_) + 2) \
            P6C_LOAD(VA, EL)                                       \
            __builtin_amdgcn_sched_barrier(0); \
            P6C_USE(VB, cwq.z, cwq.w) \
            float s[8]; \
            _Pragma("unroll") for (int r = 0; r < 4; ++r) {        \
                { const auto rr = __builtin_amdgcn_permlane32_swap(__float_as_uint(acc0[r]), __float_as_uint(acc0[r]), false, false); s[r] = acc0[r] + dpp_f<0x128>(__uint_as_float(rr[1])); } \
                { const auto rr = __builtin_amdgcn_permlane32_swap(__float_as_uint(acc1[r]), __float_as_uint(acc1[r]), false, false); s[4 + r] = acc1[r] + dpp_f<0x128>(__uint_as_float(rr[1])); } } \
            if (olane) { const f32x4 h0 = (f32x4){bflo(hw0.x), bfhi(hw0.x), bflo(hw0.y), bfhi(hw0.y)}, h1 = (f32x4){bflo(hw1.x), bfhi(hw1.x), bflo(hw1.y), bfhi(hw1.y)}; \
                *(f32x4*)orow = h0 + (f32x4){s[0], s[1], s[2], s[3]} * (1.f / CSCALE); *(f32x4*)(orow + 8) = h1 + (f32x4){s[4], s[5], s[6], s[7]} * (1.f / CSCALE); } \
            __builtin_amdgcn_sched_barrier(0); }
        if (nb > 0) {
            u32x4 vA0[8], vB0[8], vA1[8], vB1[8];
            u32x4 eL0, eH0, cw0, eL1, eH1, cw1;
            P6C_DMA(0)
            if (nb > 1) P6C_DMA(1)
            asm volatile("s_waitcnt vmcnt(0)" ::: "memory");
            P6C_TAB(eL0, eH0, cw0, 0)
            P6C_LOAD(vA0, eL0)
            P6C_LOAD(vB0, eH0)
            P6C_TAB(eL1, eH1, cw1, 1)
            P6C_LOAD(vA1, eL1)
#pragma unroll 1
            for (int i = 0; i < ntok; i += 2) {
                if ((i & 7) == 0 && i > 0 && (i >> 3) + 1 < nb) P6C_DMA((i >> 3) + 1)
                if ((i & 7) == 4) asm volatile("s_waitcnt vmcnt(40)" ::: "memory");
                P6C_BODY(i, vA0, vB0, eL0, eH0, cw0, vB1, eH1)
                P6C_BODY(i + 1, vA1, vB1, eL1, eH1, cw1, vB0, eH0)
            }
            asm volatile("s_waitcnt vmcnt(0) lgkmcnt(0)" ::: "memory");
        }
#undef P6C_BODY
#undef P6C_USE
#undef P6C_LOAD
#undef P6C_EID
#undef P6C_TAB
#undef P6C_DMA
#undef P6C_TOK
    }
}

extern "C" void kernel_launch(void* const* d_in, const int* in_sizes, int n_in, void* d_out, int out_size,
                              void* d_ws, size_t ws_size, hipStream_t stream) {
    static int grid_blocks = 0;
    if (!grid_blocks) {
        int dev = 0, cus = 0, per_cu = 0;
        (void)hipGetDevice(&dev);
        (void)hipDeviceGetAttribute(&cus, hipDeviceAttributeMultiprocessorCount, dev);
        (void)hipFuncSetAttribute((const void*)mega, hipFuncAttributeMaxDynamicSharedMemorySize, LDS_BYTES);
        (void)hipOccupancyMaxActiveBlocksPerMultiprocessor(&per_cu, (const void*)mega, NT, LDS_BYTES);
        if (per_cu < 1) per_cu = 1;
        if (per_cu > 1) per_cu = 1;
        grid_blocks = cus * per_cu;
        if (ws_size < 256 * MiB) fprintf(stderr, "kernel_launch: workspace too small: %zu\n", ws_size);
    }
    Params p{};
    for (int i = 0; i < 31; ++i) p.in[i] = (const float*)d_in[i];
    p.out = (float*)d_out;
    p.ws = (unsigned char*)d_ws;
    void* args[] = {&p};
    hipError_t e = hipLaunchCooperativeKernel((const void*)mega, dim3(grid_blocks), dim3(NT), args, LDS_BYTES, stream);
    if (e != hipSuccess) fprintf(stderr, "cooperative launch failed: %s (grid %d)\n", hipGetErrorString(e), grid_blocks);
}
```

```cpp
#include <hip/hip_runtime.h>
#include <hip/hip_cooperative_groups.h>
#include <cstdio>
#include <cstdint>
namespace cg = cooperative_groups;

#define DEVI __device__ __forceinline__
typedef unsigned short bf16_t;
typedef short bf16x8 __attribute__((ext_vector_type(8)));
typedef float f32x4 __attribute__((ext_vector_type(4)));
typedef float f32x16 __attribute__((ext_vector_type(16)));
typedef unsigned u32x2 __attribute__((ext_vector_type(2)));
typedef unsigned u32x4 __attribute__((ext_vector_type(4)));

constexpr int T = 16384, SEQ = 4096, DM = 1024;
constexpr int NWAVES = 8, NT = 512;
constexpr int LDS_BYTES = 147456;
constexpr float EPS = 1e-6f;
constexpr float LOG2E = 1.4426950408889634f;
constexpr float QSCALE = 0.10206207261596575f * 1.4426950408889634f;

constexpr size_t MiB = 1u << 20;
constexpr size_t WS_SS2 = 0;
constexpr size_t WS_CNT = 512 * 1024;
constexpr size_t WS_SSQ = 64 * 1024, WS_SSKV = 128 * 1024;
constexpr size_t WS_WIN = 1 * MiB;
constexpr size_t WS_WUQ = 10 * MiB + 512 * 1024;
constexpr size_t WS_WUKV = 11 * MiB + 256 * 1024;
constexpr size_t WS_RWO = 12 * MiB;
constexpr size_t WS_MWO = 13 * MiB;
constexpr size_t WS_WOUT = 14 * MiB;
constexpr size_t WS_PWQ = 16 * MiB;
constexpr size_t WS_SUBK = 20 * MiB;
constexpr size_t WS_W2T = 20 * MiB + 512 * 1024;
constexpr size_t WS_A2T = WS_W2T + 64 * 1024;
constexpr size_t WS_G2T = WS_A2T + 64 * 1024;
constexpr size_t WS_G = 24 * MiB;
constexpr size_t WS_UB = 56 * MiB, WS_VB = 72 * MiB;
constexpr size_t WS_SC = 176 * MiB;
constexpr size_t WS_PRW = 88 * MiB;
constexpr size_t WS_Q = 88 * MiB, WS_K = 112 * MiB, WS_VT = 136 * MiB;
constexpr size_t WS_HB = 88 * MiB;
constexpr size_t WS_QD = 152 * MiB, WS_KVD = 164 * MiB, WS_KPE = 172 * MiB;
constexpr size_t WS_O = 152 * MiB;
constexpr size_t WS_R = 176 * MiB, WS_W = 192 * MiB, WS_KS = 208 * MiB, WS_V = 224 * MiB, WS_KK = 240 * MiB;
constexpr size_t WS_YA = 176 * MiB;
constexpr size_t WS_MIXED = 192 * MiB;
constexpr size_t WS_PQ = 184 * MiB;
constexpr size_t WS_TAB = 240 * MiB;
constexpr size_t DO_XN = 0;
constexpr size_t DO_BV = 0, DO_GT = 16 * MiB, DO_BONUS = 32 * MiB, DO_Y = 33 * MiB, DO_KRAW = 33 * MiB, DO_GL = 50 * MiB;

struct Params {
    const float* in[31];
    float* out;
    unsigned char* ws;
};

DEVI unsigned f2bf(float f) { unsigned u = __float_as_uint(f); return (u + 0x7fffu + ((u >> 16) & 1u)) >> 16; }
typedef float f32x2_t __attribute__((ext_vector_type(2)));
typedef __bf16 bf16x2_t __attribute__((ext_vector_type(2)));
DEVI unsigned pk2(float lo, float hi) { f32x2_t v = {lo, hi}; bf16x2_t b = __builtin_convertvector(v, bf16x2_t); return __builtin_bit_cast(unsigned, b); }
DEVI float bflo(unsigned u) { return __uint_as_float(u << 16); }
DEVI float bfhi(unsigned u) { return __uint_as_float(u & 0xffff0000u); }
DEVI float bf1(bf16_t u) { return __uint_as_float(((unsigned)u) << 16); }
DEVI float wave_sum(float v) {
#pragma unroll
    for (int o = 32; o >= 1; o >>= 1) v += __shfl_xor(v, o);
    return v;
}
DEVI float sigmoidf_(float x) { return __builtin_amdgcn_rcpf(1.f + __builtin_amdgcn_exp2f(-1.4426950408889634f * x)); }
DEVI float tanhf_(float x) { return 1.f - 2.f * __builtin_amdgcn_rcpf(__builtin_amdgcn_exp2f(2.885390081777927f * x) + 1.f); }
DEVI void st_bf4(bf16_t* p, float a, float b, float c, float d) { u32x2 w; w.x = pk2(a, b); w.y = pk2(c, d); *(u32x2*)p = w; }
DEVI void ld_bf4(const bf16_t* p, float (&o)[4]) { u32x2 w = *(const u32x2*)p; o[0] = bflo(w.x); o[1] = bfhi(w.x); o[2] = bflo(w.y); o[3] = bfhi(w.y); }
DEVI void ld_bf8(const bf16_t* p, float (&o)[8]) { u32x4 w = *(const u32x4*)p; o[0] = bflo(w.x); o[1] = bfhi(w.x); o[2] = bflo(w.y); o[3] = bfhi(w.y); o[4] = bflo(w.z); o[5] = bfhi(w.z); o[6] = bflo(w.w); o[7] = bfhi(w.w); }
DEVI bf16x8 pack8(const float (&v)[8]) { u32x4 w; w.x = pk2(v[0], v[1]); w.y = pk2(v[2], v[3]); w.z = pk2(v[4], v[5]); w.w = pk2(v[6], v[7]); return __builtin_bit_cast(bf16x8, w); }
DEVI f32x4 mfma16(bf16x8 a, bf16x8 b, f32x4 c) { return __builtin_amdgcn_mfma_f32_16x16x32_bf16(a, b, c, 0, 0, 0); }
DEVI f32x16 mfma32(bf16x8 a, bf16x8 b, f32x16 c) { return __builtin_amdgcn_mfma_f32_32x32x16_bf16(a, b, c, 0, 0, 0); }
DEVI int crow(int r, int hi) { return (r & 3) + 8 * (r >> 2) + 4 * hi; }


template <int CTRL> DEVI float dpp_f(float v) { return __builtin_bit_cast(float, __builtin_amdgcn_update_dpp(0, __builtin_bit_cast(int, v), CTRL, 0xf, 0xf, true)); }
template <int CTRL> DEVI unsigned dpp_u(unsigned v) { return (unsigned)__builtin_amdgcn_update_dpp(0, (int)v, CTRL, 0xf, 0xf, true); }
DEVI float sum8(float v) { v += dpp_f<0xB1>(v); v += dpp_f<0x4E>(v); v += dpp_f<0x141>(v); return v; }
DEVI float sum16(float v) { v = sum8(v); v += dpp_f<0x140>(v); return v; }
DEVI unsigned umax2(unsigned a, unsigned b) { return a > b ? a : b; }
DEVI unsigned umax16(unsigned v) { v = umax2(v, dpp_u<0xB1>(v)); v = umax2(v, dpp_u<0x4E>(v)); v = umax2(v, dpp_u<0x141>(v)); v = umax2(v, dpp_u<0x140>(v)); return v; }
DEVI unsigned rdlane(unsigned v, int l) { return (unsigned)__builtin_amdgcn_readlane((int)v, l); }
#define LAS __attribute__((address_space(3)))

DEVI unsigned pk4_fp8(float a, float b, float c, float d) { int w = 0; w = __builtin_amdgcn_cvt_pk_fp8_f32(a, b, w, false); w = __builtin_amdgcn_cvt_pk_fp8_f32(c, d, w, true); return (unsigned)w; }
DEVI f32x4 mfma16_fp8(u32x2 a, u32x2 b, f32x4 c) { return __builtin_amdgcn_mfma_f32_16x16x32_fp8_fp8(__builtin_bit_cast(long, a), __builtin_bit_cast(long, b), c, 0, 0, 0); }
DEVI unsigned pk4_u8(float a, float b, float c, float d) { unsigned w = 0; w = __builtin_amdgcn_cvt_pk_u8_f32(a, 0, w); w = __builtin_amdgcn_cvt_pk_u8_f32(b, 1, w); w = __builtin_amdgcn_cvt_pk_u8_f32(c, 2, w); w = __builtin_amdgcn_cvt_pk_u8_f32(d, 3, w); return w; }
constexpr float U8_SCALE = 32.f, V8_SCALE = 4.f;
constexpr float C8_SCALE = 256.f;

template <int OFF> DEVI f32x4 lds_rd128(unsigned a) { f32x4 r; asm volatile("ds_read_b128 %0, %1 offset:%2" : "=v"(r) : "v"(a), "i"(OFF)); return r; }
template <int OFF> DEVI float lds_rd32(unsigned a) { float r; asm volatile("ds_read_b32 %0, %1 offset:%2" : "=v"(r) : "v"(a), "i"(OFF)); return r; }
DEVI void lds_wr32(unsigned a, float v) { asm volatile("ds_write_b32 %0, %1" ::"v"(a), "v"(v) : "memory"); }

#define SW64(r, k) ((r) * 64 + (((((k) >> 3) ^ ((r) & 7))) << 3) + ((k) & 7))
#define SW32(r, c) ((r) * 32 + (((((c) >> 3) ^ (((r) >> 2) & 3))) << 3) + ((c) & 7))
DEVI int swz_off(int r, int chunk, int ld) { return ld == 64 ? r * 64 + ((chunk ^ (r & 7)) << 3) : r * 32 + ((chunk ^ ((r >> 2) & 3)) << 3); }
template <int MT, int NTL, int KS>
DEVI void gemm_lds(const LAS bf16_t* A, int lda, const LAS bf16_t* B, int ldb, f32x4 (&acc)[MT][NTL], int fr, int fq) {
#pragma unroll
    for (int ks = 0; ks < KS; ++ks) {
        bf16x8 a[MT], b[NTL];
#pragma unroll
        for (int m = 0; m < MT; ++m) a[m] = *(const LAS bf16x8*)(A + swz_off(16 * m + fr, 4 * ks + fq, lda));
#pragma unroll
        for (int n = 0; n < NTL; ++n) b[n] = *(const LAS bf16x8*)(B + swz_off(16 * n + fr, 4 * ks + fq, ldb));
#pragma unroll
        for (int m = 0; m < MT; ++m)
#pragma unroll
            for (int n = 0; n < NTL; ++n) acc[m][n] = mfma16(b[n], a[m], acc[m][n]);
    }
}
DEVI bf16_t bf1of(float x) { return (bf16_t)(pk2(x, x) & 0xffffu); }
DEVI void gemm_tile_acc(const bf16_t* __restrict__ A, int lda, const bf16_t* __restrict__ Bt, int ldb, int K, int m0, int n0, int lane, f32x4 (&acc)[4][4]) {
    const int fr = lane & 15, fq = lane >> 4;
    const bf16_t* ap = A + (size_t)(m0 + fr) * lda + fq * 8;
    const bf16_t* bp = Bt + (size_t)(n0 + fr) * ldb + fq * 8;
#pragma unroll 2
    for (int k0 = 0; k0 < K; k0 += 32) {
        bf16x8 a[4], b[4];
#pragma unroll
        for (int m = 0; m < 4; ++m) a[m] = *(const bf16x8*)(ap + (size_t)m * 16 * lda + k0);
#pragma unroll
        for (int n = 0; n < 4; ++n) b[n] = *(const bf16x8*)(bp + (size_t)n * 16 * ldb + k0);
#pragma unroll
        for (int m = 0; m < 4; ++m)
#pragma unroll
            for (int n = 0; n < 4; ++n) acc[m][n] = mfma16(b[n], a[m], acc[m][n]);
    }
}
DEVI void zero_acc(f32x4 (&acc)[4][4]) {
#pragma unroll
    for (int m = 0; m < 4; ++m)
#pragma unroll
        for (int n = 0; n < 4; ++n) acc[m][n] = (f32x4){0.f, 0.f, 0.f, 0.f};
}


namespace pg8 {
#define PG8_LAS __attribute__((address_space(3)))
typedef unsigned short bf16_t;
typedef short bf16x8 __attribute__((ext_vector_type(8)));
typedef float f32x4 __attribute__((ext_vector_type(4)));
typedef unsigned u32x4 __attribute__((ext_vector_type(4)));
constexpr int BM = 256, BK = 64, HALF = 128, HTB = HALF * BK * 2  , STAGE_BYTES = 8 * HTB, NXCD = 8, WGM = 8;

__host__ __device__ __forceinline__ int lds_byte(int r, int c) { const int st = (r >> 4) * 2 + (c >> 5), rr = r & 15, cc = c & 31, ob = rr * 64 + cc * 2; return st * 1024 + (ob ^ (((ob >> 9) & 1) << 5)); }
__host__ __device__ __forceinline__ void stage_rc(int b, int& R, int& C) { const int st = b / 1024, sb = b % 1024, swz = sb ^ (((sb >> 9) & 1) << 5); R = (st >> 1) * 16 + swz / 64; C = (st & 1) * 32 + (swz % 64) / 2; }
__host__ __device__ __forceinline__ int perm32(int rho) { const int n = rho >> 4, i = rho & 15; return 8 * (i >> 2) + 4 * n + (i & 3); }

struct Unit { int pm, pn; };
struct Gemm { const bf16_t* A; const bf16_t* Bt; int M, N, K; };

struct StaticOrder {
    int nM, nN, nwg, G, c;
    __host__ __device__ void init(int M, int N, int G_, int c_) { nM = M / BM; nN = N / BM; nwg = nM * nN; G = G_; c = c_; }
    __host__ __device__ bool next(int i, Unit& u) const {
        const long L = (long)i * G + c; if (L >= nwg) return false;
        int wgid = (int)L; { const int q = nwg / NXCD, r = nwg % NXCD, xcd = wgid % NXCD, off = wgid / NXCD; wgid = (xcd < r ? xcd * (q + 1) : r * (q + 1) + (xcd - r) * q) + off; }
        const int nig = WGM * nN, gid = wgid / nig, fm = gid * WGM, gsz = (nM - fm) < WGM ? (nM - fm) : WGM;
        u.pm = fm + ((wgid % nig) % gsz); u.pn = (wgid % nig) / gsz; return true;
    }
    __device__ __forceinline__ void a_ready(const Unit&) const {}
    __device__ __forceinline__ void done(const Unit&) const {}
};


DEVI float sigm(float x) { return __builtin_amdgcn_rcpf(1.f + __builtin_amdgcn_exp2f(-1.4426950408889634f * x)); }
DEVI u32x4 pack8v(f32x4 a, f32x4 b) { u32x4 w; w.x = pk2(a[0], a[1]); w.y = pk2(a[2], a[3]); w.z = pk2(b[0], b[1]); w.w = pk2(b[2], b[3]); return w; }
struct EpiP1 {
    static constexpr bool PERM = true, AFTER_DRAIN = false;
    unsigned char* ws;
    __device__ __forceinline__ void operator()(const f32x4 (&acc)[2][2][4][2], const Unit& u, int wr, int wc, int fr_in, int fq_in) const {
        int fr = fr_in, fq = fq_in; asm volatile("" : "+v"(fr), "+v"(fq));
        const int row0 = u.pm * BM + wr * 64 + fr;
        if (u.pn >= 8 && u.pn < 11) {
#pragma unroll
            for (int bj = 0; bj < 2; ++bj) {
                const int c = (u.pn - 8) * 256 + bj * HALF + wc * 32 + 8 * fq;
                const size_t off = c < 384 ? WS_QD : (c < 640 ? WS_KVD : WS_KPE);
                const int ld = c < 384 ? 384 : (c < 640 ? 256 : 32), cc = c < 384 ? c : (c < 640 ? c - 384 : c - 640);
                if (c < 672) {
#pragma unroll
                    for (int ai = 0; ai < 2; ++ai)
#pragma unroll
                        for (int m = 0; m < 4; ++m) { const size_t row = (size_t)(row0 + ai * HALF + m * 16);
                            *(u32x4*)(ws + off + (row * ld + cc) * 2) = pack8v(acc[ai][bj][m][0], acc[ai][bj][m][1]); }
                }
            }
            return;
        }
        if (u.pn >= 11) {
            const int col0 = (u.pn - 11) * 256 + wc * 32 + 8 * fq;
#pragma unroll
            for (int ai = 0; ai < 2; ++ai)
#pragma unroll
                for (int m = 0; m < 4; ++m) { unsigned char* rowp = ws + WS_G + ((size_t)(row0 + ai * HALF + m * 16) * 2048 + col0);
#pragma unroll
                    for (int bj = 0; bj < 2; ++bj) { const f32x4 v0 = acc[ai][bj][m][0], v1 = acc[ai][bj][m][1];
                        u32x2 w; w.x = pk4_u8(sigm(v0[0]) * 255.f, sigm(v0[1]) * 255.f, sigm(v0[2]) * 255.f, sigm(v0[3]) * 255.f);
                        w.y = pk4_u8(sigm(v1[0]) * 255.f, sigm(v1[1]) * 255.f, sigm(v1[2]) * 255.f, sigm(v1[3]) * 255.f);
                        *(u32x2*)(rowp + bj * HALF) = w; } }
            return;
        }
        const int col0 = u.pn * 256 + wc * 32 + 8 * fq;
#pragma unroll
        for (int ai = 0; ai < 2; ++ai)
#pragma unroll
            for (int m = 0; m < 4; ++m) { unsigned char* rowp = ws + WS_PRW + ((size_t)(row0 + ai * HALF + m * 16) * 2048 + col0) * 2;
#pragma unroll
                for (int bj = 0; bj < 2; ++bj) *(u32x4*)(rowp + bj * HALF * 2) = pack8v(acc[ai][bj][m][0], acc[ai][bj][m][1]); }
    }
};
struct EpiQraw {
    static constexpr bool PERM = true, AFTER_DRAIN = false;
    bf16_t* q; const float* ssq;
    __device__ __forceinline__ void operator()(const f32x4 (&acc)[2][2][4][2], const Unit& u, int wr, int wc, int fr_in, int fq_in) const {
        int fr = fr_in, fq = fq_in; asm volatile("" : "+v"(fr), "+v"(fq));
        const int row0 = u.pm * BM + wr * 64 + fr, col0 = u.pn * BM + wc * 32 + 8 * fq;
#pragma unroll
        for (int ai = 0; ai < 2; ++ai)
#pragma unroll
            for (int m = 0; m < 4; ++m) { const size_t row = (size_t)(row0 + ai * HALF + m * 16); const float rs = ssq[row];
#pragma unroll
                for (int bj = 0; bj < 2; ++bj) *(u32x4*)(q + row * 768 + col0 + bj * HALF) = pack8v(acc[ai][bj][m][0] * rs, acc[ai][bj][m][1] * rs); }
    }
};
struct EpiKVraw {
    static constexpr bool PERM = true, AFTER_DRAIN = false;
    bf16_t* kraw; bf16_t* vt; const float* sskv;
    __device__ __forceinline__ void operator()(const f32x4 (&acc)[2][2][4][2], const Unit& u, int wr, int wc, int fr_in, int fq_in) const {
        int fr = fr_in, fq = fq_in; asm volatile("" : "+v"(fr), "+v"(fq));
        const int row0 = u.pm * BM + wr * 64 + fr;
#pragma unroll
        for (int ai = 0; ai < 2; ++ai)
#pragma unroll
            for (int m = 0; m < 4; ++m) { const int row = row0 + ai * HALF + m * 16; const float rs = sskv[row];
#pragma unroll
                for (int bj = 0; bj < 2; ++bj) { const f32x4 v0 = acc[ai][bj][m][0] * rs, v1 = acc[ai][bj][m][1] * rs;
                    if (u.pn < 2) *(u32x4*)(kraw + (size_t)row * 512 + u.pn * BM + bj * HALF + wc * 32 + 8 * fq) = pack8v(v0, v1);
                    else { const int c = (u.pn - 2) * BM + bj * HALF + wc * 32 + 8 * fq, h = c >> 6, d = c & 63; const int bb = row >> 12, s = row & 4095;
                        const int kt = s >> 5, k4 = s & 15, jj = 4 * (k4 >> 3) + (k4 & 3), hv = (k4 >> 2) & 1;
                        bf16_t* vp = vt + ((((size_t)(bb * 8 + h) * 128 + kt) * 2 + (d >> 5)) * 2 + ((s >> 4) & 1)) * 512 + ((d & 31) + 32 * hv) * 8 + jj; const u32x4 w = pack8v(v0, v1);
                        vp[0] = (bf16_t)(w.x & 0xffffu); vp[8] = (bf16_t)(w.x >> 16); vp[16] = (bf16_t)(w.y & 0xffffu); vp[24] = (bf16_t)(w.y >> 16);
                        vp[32] = (bf16_t)(w.z & 0xffffu); vp[40] = (bf16_t)(w.z >> 16); vp[48] = (bf16_t)(w.w & 0xffffu); vp[56] = (bf16_t)(w.w >> 16); } } }
    }
};
struct EpiGate {
    static constexpr bool PERM = true, AFTER_DRAIN = false;
    bf16_t* mixed; const unsigned char* gg; int goff; int add;
    __device__ __forceinline__ void operator()(const f32x4 (&acc)[2][2][4][2], const Unit& u, int wr, int wc, int fr_in, int fq_in) const {
        int fr = fr_in, fq = fq_in; asm volatile("" : "+v"(fr), "+v"(fq));
        const int row0 = u.pm * BM + wr * 64 + fr, col0 = u.pn * BM + wc * 32 + 8 * fq;
#pragma unroll
        for (int ai = 0; ai < 2; ++ai)
#pragma unroll
            for (int m = 0; m < 4; ++m) { const size_t row = (size_t)(row0 + ai * HALF + m * 16);
#pragma unroll
                for (int bj = 0; bj < 2; ++bj) { const int col = col0 + bj * HALF;
                    const u32x2 gw = *(const u32x2*)(gg + row * 2048 + goff + col);
                    const f32x4 g0 = (f32x4){(float)(gw.x & 0xffu), (float)((gw.x >> 8) & 0xffu), (float)((gw.x >> 16) & 0xffu), (float)(gw.x >> 24)};
                    const f32x4 g1 = (f32x4){(float)(gw.y & 0xffu), (float)((gw.y >> 8) & 0xffu), (float)((gw.y >> 16) & 0xffu), (float)(gw.y >> 24)};
                    f32x4 v0 = g0 * (acc[ai][bj][m][0] * (1.f / 255.f)), v1 = g1 * (acc[ai][bj][m][1] * (1.f / 255.f));
                    if (add) { const u32x4 pw = *(const u32x4*)(mixed + row * 1024 + col);
                        v0 += (f32x4){__uint_as_float(pw.x << 16), __uint_as_float(pw.x & 0xffff0000u), __uint_as_float(pw.y << 16), __uint_as_float(pw.y & 0xffff0000u)};
                        v1 += (f32x4){__uint_as_float(pw.z << 16), __uint_as_float(pw.z & 0xffff0000u), __uint_as_float(pw.w << 16), __uint_as_float(pw.w & 0xffff0000u)}; }
                    *(u32x4*)(mixed + row * 1024 + col) = pack8v(v0, v1); } }
    }
};
struct EpiRes {
    static constexpr bool PERM = true, AFTER_DRAIN = false;
    const float* x; bf16_t* hb; float* ss2;
    __device__ __forceinline__ void operator()(const f32x4 (&acc)[2][2][4][2], const Unit& u, int wr, int wc, int fr_in, int fq_in) const {
        int fr = fr_in, fq = fq_in; asm volatile("" : "+v"(fr), "+v"(fq));
        const int row0 = u.pm * BM + wr * 64 + fr, col0 = u.pn * BM + wc * 32 + 8 * fq;
#pragma unroll
        for (int ai = 0; ai < 2; ++ai)
#pragma unroll
            for (int m = 0; m < 4; ++m) { const size_t row = (size_t)(row0 + ai * HALF + m * 16); float sq = 0.f;
#pragma unroll
                for (int bj = 0; bj < 2; ++bj) { const size_t o = row * 1024 + col0 + bj * HALF;
                    const f32x4 h0 = *(const f32x4*)(x + o) + acc[ai][bj][m][0], h1 = *(const f32x4*)(x + o + 4) + acc[ai][bj][m][1];
                    *(u32x4*)(hb + o) = pack8v(h0, h1);
                    sq += (h0[0] * h0[0] + h0[1] * h0[1]) + (h0[2] * h0[2] + h0[3] * h0[3]) + (h1[0] * h1[0] + h1[1] * h1[1]) + (h1[2] * h1[2] + h1[3] * h1[3]); }
                sq += __shfl_xor(sq, 16); sq += __shfl_xor(sq, 32);
                if (fq == 0) atomicAdd(ss2 + row, sq); }
    }
};
struct EpiScale {
    static constexpr bool PERM = true, AFTER_DRAIN = false;
    bf16_t* pq; const float* ss2;
    __device__ __forceinline__ void operator()(const f32x4 (&acc)[2][2][4][2], const Unit& u, int wr, int wc, int fr_in, int fq_in) const {
        int fr = fr_in, fq = fq_in; asm volatile("" : "+v"(fr), "+v"(fq));
        const int row0 = u.pm * BM + wr * 64 + fr, col0 = u.pn * BM + wc * 32 + 8 * fq;
#pragma unroll
        for (int ai = 0; ai < 2; ++ai)
#pragma unroll
            for (int m = 0; m < 4; ++m) { const size_t row = (size_t)(row0 + ai * HALF + m * 16); const float rs = rsqrtf(ss2[row] * (1.f / 1024.f) + 1e-6f);
#pragma unroll
                for (int bj = 0; bj < 2; ++bj) *(u32x4*)(pq + row * 2048 + col0 + bj * HALF) = pack8v(acc[ai][bj][m][0] * rs, acc[ai][bj][m][1] * rs); }
    }
};
template <class Epi, class Sched, bool ALIGN_EPI = false, bool SP2 = false>
__device__ __forceinline__ void gemm_phase(PG8_LAS unsigned char* lds, const Gemm g, const Sched& S, const Epi& E) {
    int tid_l = threadIdx.x; asm volatile("" : "+v"(tid_l));
    const int tid = tid_l, wid = __builtin_amdgcn_readfirstlane(tid >> 6), lane = tid & 63, wr = wid >> 2, wc = wid & 3, fr = lane & 15, fq = lane >> 4;
    const int K = g.K, nt = K / BK;
    unsigned voffA[2], voffB[2];
#pragma unroll
    for (int i = 0; i < 2; ++i) { int R, C; stage_rc(tid * 16 + i * 8192, R, C); const int Rb = Epi::PERM ? ((R & ~31) + perm32(R & 31)) : R;
        voffA[i] = (unsigned)(R * K + C) * 2u; voffB[i] = (unsigned)(Rb * K + C) * 2u; }
    const size_t kstep = (size_t)(BK * 2);
    const size_t hstep = (size_t)HALF * K * 2;
    const size_t tstep = 2 * hstep;
    const unsigned ldsw = (unsigned)wid * 1024u;
    const int aoff = lds_byte(wr * 64 + fr, fq * 8), boff = lds_byte(wc * 32 + fr, fq * 8);
#define PG8_SA(b, h) (((b) * 2 + (h)) * HTB)
#define PG8_SB(b, h) ((4 + (b) * 2 + (h)) * HTB)
#define PG8_STAGE(bufoff, gbase, voff) do { _Pragma("unroll") for (int _i = 0; _i < 2; ++_i) \
        __builtin_amdgcn_global_load_lds((const unsigned*)((const char*)(gbase) + (voff)[_i]), (PG8_LAS unsigned*)(lds + (bufoff) + ldsw + _i * 8192), 16, 0, 0); } while (0)
#define PG8_LDA(dst, b, h) do { _Pragma("unroll") for (int m = 0; m < 4; ++m) _Pragma("unroll") for (int k = 0; k < 2; ++k) dst[m][k] = *(const PG8_LAS bf16x8*)(lds + PG8_SA(b, h) + aoff + m * 2048 + k * 1024); } while (0)
#define PG8_LDB(dst, b, h) do { _Pragma("unroll") for (int n = 0; n < 2; ++n) _Pragma("unroll") for (int k = 0; k < 2; ++k) dst[n][k] = *(const PG8_LAS bf16x8*)(lds + PG8_SB(b, h) + boff + n * 2048 + k * 1024); } while (0)
#define PG8_MMA(ai, bj, At, Bt) do { __builtin_amdgcn_s_setprio(1); _Pragma("unroll") for (int m = 0; m < 4; ++m) _Pragma("unroll") for (int n = 0; n < 2; ++n) _Pragma("unroll") for (int k = 0; k < 2; ++k) \
        acc[ai][bj][m][n] = __builtin_amdgcn_mfma_f32_16x16x32_bf16(Bt[n][k], At[m][k], acc[ai][bj][m][n], 0, 0, 0); __builtin_amdgcn_s_setprio(0); } while (0)
#define PG8_WAIT_V(n) asm volatile("s_waitcnt vmcnt(" #n ")" ::: "memory")
#define PG8_WAIT_L(n) asm volatile("s_waitcnt lgkmcnt(" #n ")" ::: "memory")
#define PG8_BAR __builtin_amdgcn_s_barrier()
#define PG8_SCHED __builtin_amdgcn_sched_barrier(0)
    Unit cur, nxt; int ui = 0;
    if (!S.next(0, cur)) return;
    f32x4 acc[2][2][4][2];
#pragma unroll
    for (int a = 0; a < 2; ++a)
#pragma unroll
        for (int b = 0; b < 2; ++b)
#pragma unroll
            for (int m = 0; m < 4; ++m)
#pragma unroll
                for (int n = 0; n < 2; ++n) acc[a][b][m][n] = (f32x4){0.f, 0.f, 0.f, 0.f};
    bf16x8 At[4][2], B0[2][2], B1[2][2];
    const char* cA = (const char*)g.A + (size_t)cur.pm * tstep; const char* cB = (const char*)g.Bt + (size_t)cur.pn * tstep;
    S.a_ready(cur);
    if constexpr (SP2) {
        PG8_STAGE(PG8_SB(0, 0), cB, voffB); PG8_STAGE(PG8_SB(0, 1), cB + hstep, voffB); PG8_STAGE(PG8_SA(0, 0), cA, voffA); PG8_STAGE(PG8_SA(0, 1), cA + hstep, voffA);
        if (wr == 1) PG8_BAR;
        PG8_WAIT_V(2); PG8_BAR;
        PG8_STAGE(PG8_SB(1, 0), cB + kstep, voffB); PG8_STAGE(PG8_SA(1, 0), cA + kstep, voffA); PG8_STAGE(PG8_SB(1, 1), cB + hstep + kstep, voffB);
        PG8_WAIT_V(6); PG8_BAR;
    } else {
        PG8_STAGE(PG8_SB(0, 0), cB, voffB); PG8_STAGE(PG8_SA(0, 0), cA, voffA); PG8_STAGE(PG8_SB(0, 1), cB + hstep, voffB); PG8_STAGE(PG8_SA(0, 1), cA + hstep, voffA);
        if (wr == 1) PG8_BAR;
        PG8_WAIT_V(4); PG8_BAR;
        PG8_STAGE(PG8_SB(1, 0), cB + kstep, voffB); PG8_STAGE(PG8_SA(1, 0), cA + kstep, voffA); PG8_STAGE(PG8_SB(1, 1), cB + hstep + kstep, voffB);
        PG8_WAIT_V(6); PG8_BAR;
    }
    for (;;) {
        const bool has_next = S.next(ui + 1, nxt);
        const char* nA = has_next ? (const char*)g.A + (size_t)nxt.pm * tstep : cA; const char* nB = has_next ? (const char*)g.Bt + (size_t)nxt.pn * tstep : cB;
        for (int t = 0; t < nt; t += 2) {
            const bool last = (t == nt - 2);
            const char* a1 = cA + (size_t)(t + 1) * kstep;
            const char* a2 = last ? nA : cA + (size_t)(t + 2) * kstep; const char* b2 = last ? nB : cB + (size_t)(t + 2) * kstep;
            const char* a3 = a2 + kstep; const char* b3 = b2 + kstep;
            if (last && has_next) S.a_ready(nxt);
            if constexpr (SP2) {
            PG8_LDB(B0, 0, 0); PG8_LDB(B1, 0, 1); PG8_SCHED; PG8_LDA(At, 0, 0); PG8_STAGE(PG8_SA(1, 1), a1 + hstep, voffA);
            PG8_WAIT_V(8); PG8_WAIT_L(0); PG8_BAR; PG8_MMA(0, 0, At, B0); PG8_MMA(0, 1, At, B1); PG8_BAR; PG8_SCHED;
            PG8_LDA(At, 0, 1); PG8_STAGE(PG8_SB(0, 0), b2, voffB); PG8_STAGE(PG8_SB(0, 1), b2 + hstep, voffB); PG8_STAGE(PG8_SA(0, 0), a2, voffA);
            PG8_WAIT_V(8); PG8_WAIT_L(0); PG8_BAR; PG8_MMA(1, 0, At, B0); PG8_MMA(1, 1, At, B1); PG8_BAR; PG8_SCHED;
            PG8_LDB(B0, 1, 0); PG8_LDB(B1, 1, 1); PG8_SCHED; PG8_LDA(At, 1, 0); PG8_STAGE(PG8_SA(0, 1), a2 + hstep, voffA);
            PG8_WAIT_V(8); PG8_WAIT_L(0); PG8_BAR; PG8_MMA(0, 0, At, B0); PG8_MMA(0, 1, At, B1); PG8_BAR; PG8_SCHED;
            PG8_LDA(At, 1, 1); PG8_STAGE(PG8_SB(1, 0), b3, voffB); PG8_STAGE(PG8_SB(1, 1), b3 + hstep, voffB); PG8_STAGE(PG8_SA(1, 0), a3, voffA);
            PG8_WAIT_V(8); PG8_WAIT_L(0); PG8_BAR; PG8_MMA(1, 0, At, B0); PG8_MMA(1, 1, At, B1); PG8_BAR; PG8_SCHED;
            } else {
            PG8_LDB(B0, 0, 0); PG8_SCHED; PG8_LDA(At, 0, 0); PG8_STAGE(PG8_SA(1, 1), a1 + hstep, voffA);
            PG8_WAIT_L(8); PG8_BAR; PG8_WAIT_L(0); PG8_MMA(0, 0, At, B0); PG8_BAR; PG8_SCHED;
            PG8_LDB(B1, 0, 1); PG8_STAGE(PG8_SB(0, 0), b2, voffB);
            PG8_BAR; PG8_WAIT_L(0); PG8_MMA(0, 1, At, B1); PG8_BAR;
            PG8_LDA(At, 0, 1); PG8_STAGE(PG8_SA(0, 0), a2, voffA);
            PG8_BAR; PG8_WAIT_L(0); PG8_MMA(1, 0, At, B0); PG8_BAR; PG8_SCHED;
            PG8_STAGE(PG8_SB(0, 1), b2 + hstep, voffB);
            PG8_WAIT_V(6); PG8_BAR; PG8_MMA(1, 1, At, B1); PG8_BAR;
            PG8_LDB(B0, 1, 0); PG8_SCHED; PG8_LDA(At, 1, 0); PG8_STAGE(PG8_SA(0, 1), a2 + hstep, voffA);
            PG8_WAIT_L(8); PG8_BAR; PG8_WAIT_L(0); PG8_MMA(0, 0, At, B0); PG8_BAR; PG8_SCHED;
            PG8_LDB(B1, 1, 1); PG8_STAGE(PG8_SB(1, 0), b3, voffB);
            PG8_BAR; PG8_WAIT_L(0); PG8_MMA(0, 1, At, B1); PG8_BAR;
            PG8_LDA(At, 1, 1); PG8_STAGE(PG8_SA(1, 0), a3, voffA);
            PG8_BAR; PG8_WAIT_L(0); PG8_MMA(1, 0, At, B0); PG8_BAR; PG8_SCHED;
            PG8_STAGE(PG8_SB(1, 1), b3 + hstep, voffB);
            PG8_WAIT_V(6); PG8_BAR; PG8_MMA(1, 1, At, B1); PG8_BAR;
            }
        }
        if constexpr (ALIGN_EPI) { if (wr == 0) PG8_BAR; }
        if constexpr (!Epi::AFTER_DRAIN) { E(acc, cur, wr, wc, fr, fq); S.done(cur); }
        if (!has_next) break;
#pragma unroll
        for (int a = 0; a < 2; ++a)
#pragma unroll
            for (int b = 0; b < 2; ++b)
#pragma unroll
                for (int m = 0; m < 4; ++m)
#pragma unroll
                    for (int n = 0; n < 2; ++n) acc[a][b][m][n] = (f32x4){0.f, 0.f, 0.f, 0.f};
        cur = nxt; cA = nA; cB = nB; ++ui;
        if constexpr (ALIGN_EPI) { if (wr == 1) PG8_BAR; }
    }
    PG8_WAIT_V(0);
    if constexpr (!ALIGN_EPI) { if (wr == 0) PG8_BAR; }
    PG8_BAR;
    if constexpr (Epi::AFTER_DRAIN) { E.fused(acc, cur, wr, wc, fr, fq, lds, wid, lane); S.done(cur); }
#undef PG8_SA
#undef PG8_SB
#undef PG8_STAGE
#undef PG8_LDA
#undef PG8_LDB
#undef PG8_MMA
#undef PG8_WAIT_V
#undef PG8_WAIT_L
#undef PG8_BAR
#undef PG8_SCHED
}
}


#define RLX_AGENT __ATOMIC_RELAXED, __HIP_MEMORY_SCOPE_AGENT
#define XB_TMO      128
#define XB_XCNT(j)  (256  + 64 * (j))
#define XB_XSUB(j)  (1280 + 64 * (j))
#define XB_XGEN(j)  (2304 + 64 * (j))
#define XB_TOP      3328
#define XB_TOPGEN   3392
#define XCD_BAR_WORDS 3456
#define XB_SPIN_CAP (1u << 18)

__device__ __forceinline__ unsigned xb_ld(unsigned* p)              { return __hip_atomic_load(p, __ATOMIC_RELAXED, __HIP_MEMORY_SCOPE_AGENT); }
__device__ __forceinline__ unsigned xb_add(unsigned* p, unsigned v) { return __hip_atomic_fetch_add(p, v, __ATOMIC_RELAXED, __HIP_MEMORY_SCOPE_AGENT); }
__device__ __forceinline__ unsigned xb_xcc_id() { return (unsigned)__builtin_amdgcn_s_getreg((3 << 11) | 20) & 0xFu; }
#define XB_SPIN(cond, bar) do { unsigned _sp = 0; while (cond) { __builtin_amdgcn_s_sleep(1); \
    if ((++_sp & 255u) == 0u) { if (xb_ld(&(bar)[XB_TMO])) break; if (_sp > XB_SPIN_CAP) { atomicAdd(&(bar)[XB_TMO], 1u); break; } } } } while (0)

struct XcdBarrier {
    unsigned* bar; unsigned x;
    volatile LAS unsigned* st;
};

__device__ __forceinline__ XcdBarrier xcd_barrier_post(unsigned* bar, volatile LAS unsigned* st) {
    XcdBarrier b; b.bar = bar; b.x = xb_xcc_id(); b.st = st;
    if (threadIdx.x == 0) (void)xb_add(&bar[XB_XCNT(b.x)], 1u);
    return b;
}
__device__ __forceinline__ void xcd_barrier_complete(unsigned* bar, unsigned x, unsigned& nloc, unsigned& nx) {
    const unsigned G = gridDim.x * gridDim.y * gridDim.z;
    unsigned sum, cnt, mine, sp = 0u;
    for (;;) {
        sum = 0u; cnt = 0u; mine = 0u;
#pragma unroll
        for (unsigned j = 0; j < 16; ++j) { const unsigned c = xb_ld(&bar[XB_XCNT(j)]); sum += c; cnt += (c > 0u) ? 1u : 0u; mine = (j == x) ? c : mine; }
        if (sum == G) break;
        __builtin_amdgcn_s_sleep(1);
        if ((++sp & 255u) == 0u) { if (xb_ld(&bar[XB_TMO])) break; if (sp > XB_SPIN_CAP) { atomicAdd(&bar[XB_TMO], 1u); break; } }
    }
    nloc = mine > 0u ? mine : 1u; nx = cnt > 0u ? cnt : 1u;
}

__device__ __forceinline__ void xcd_barrier(const XcdBarrier& b) {
    asm volatile("s_waitcnt vmcnt(0)" ::: "memory");
    __syncthreads();
    if (threadIdx.x == 0) {
        unsigned* bar = b.bar;
        __builtin_amdgcn_s_waitcnt(0);
        unsigned nloc = b.st[0], nx = b.st[1];
        if (nloc == 0u) { xcd_barrier_complete(bar, b.x, nloc, nx); b.st[0] = nloc; b.st[1] = nx; }
        const unsigned old = xb_add(&bar[XB_XSUB(b.x)], 1u);
        const unsigned gen = old / nloc;
        if (old + 1u == (gen + 1u) * nloc) {
            __builtin_amdgcn_fence(__ATOMIC_RELEASE, "agent");
            asm volatile("s_waitcnt vmcnt(0)" ::: "memory");
            const unsigned og = xb_add(&bar[XB_TOP], 1u);
            const unsigned tg = og / nx;
            if (og + 1u == (tg + 1u) * nx) xb_add(&bar[XB_TOPGEN], 1u);
            else XB_SPIN(xb_ld(&bar[XB_TOPGEN]) == tg, bar);
            __builtin_amdgcn_fence(__ATOMIC_ACQUIRE, "agent");
            xb_add(&bar[XB_XGEN(b.x)], 1u);
            asm volatile("s_waitcnt vmcnt(0)" ::: "memory");
        } else {
            XB_SPIN(xb_ld(&bar[XB_XGEN(b.x)]) == gen, bar);
            __builtin_amdgcn_fence(__ATOMIC_ACQUIRE, "agent");
            asm volatile("s_waitcnt vmcnt(0)" ::: "memory");
        }
    }
    __syncthreads();
}

DEVI void transpose_item(const float* __restrict__ W, int ldw, int c0, bf16_t* WT, int ldk, int r0, int Kmax, int kb, int nb, const float* kscale, float* scr, int lane, int fragKS = 0) {
    const int k0 = 64 * kb, n0 = 32 * nb;
#pragma unroll 8
    for (int i = 0; i < 32; ++i) {
        const int kk = 2 * i + (lane >> 5);
        float v = 0.f;
        if (k0 + kk < Kmax) { v = W[(size_t)(k0 + kk) * ldw + c0 + n0 + (lane & 31)]; if (kscale) v *= kscale[k0 + kk]; }
        scr[kk * 33 + (lane & 31)] = v;
    }
    asm volatile("s_waitcnt lgkmcnt(0)" ::: "memory");
    asm volatile("" ::: "memory");
    const int c = lane & 7;
    if (k0 + 8 * c < Kmax) {
#pragma unroll
        for (int j = 0; j < 4; ++j) {
            const int n = (lane >> 3) + 8 * j;
            const float* s = scr + (8 * c) * 33 + n;
            u32x4 o; o.x = pk2(s[0], s[33]); o.y = pk2(s[66], s[99]); o.z = pk2(s[132], s[165]); o.w = pk2(s[198], s[231]);
            if (fragKS > 0) { const int row = r0 + n0 + n, k = k0 + 8 * c, hd = row >> 6, rr = row & 63;
                *(u32x4*)(WT + ((size_t)(((hd * fragKS + (k >> 5)) * 4 + ((rr >> 2) & 3)) * 64 + ((k >> 3) & 3) * 16 + 4 * (rr >> 4) + (rr & 3))) * 8) = o; }
            else *(u32x4*)(WT + (size_t)(r0 + n0 + n) * ldk + k0 + 8 * c) = o;
        }
    }
    asm volatile("s_waitcnt lgkmcnt(0)" ::: "memory");
    asm volatile("" ::: "memory");
}


DEVI void wcomb_item(const float* __restrict__ Wq, const float* __restrict__ Sk, const float* __restrict__ n2w, bf16_t* WcT, int it, int lane) {
    const int fr = lane & 15, fq = lane >> 4;
    const int hp = it >> 6, nt = (it >> 4) & 3, kt = it & 15;
    const float* ap = Sk + ((size_t)hp * 128 + nt * 32 + fr) * 128 + fq * 8;
    const float* bp = Wq + (size_t)(kt * 64 + fr) * 2048 + hp * 128 + fq * 8;
    f32x4 acc[2][4];
#pragma unroll
    for (int m = 0; m < 2; ++m)
#pragma unroll
        for (int n = 0; n < 4; ++n) acc[m][n] = (f32x4){0.f, 0.f, 0.f, 0.f};
#pragma unroll
    for (int k0 = 0; k0 < 128; k0 += 32) {
        bf16x8 a[2], b[4];
#pragma unroll
        for (int m = 0; m < 2; ++m) { const f32x4 lo = *(const f32x4*)(ap + (size_t)m * 16 * 128 + k0), hi = *(const f32x4*)(ap + (size_t)m * 16 * 128 + k0 + 4);
            u32x4 w; w.x = pk2(lo.x, lo.y); w.y = pk2(lo.z, lo.w); w.z = pk2(hi.x, hi.y); w.w = pk2(hi.z, hi.w); a[m] = __builtin_bit_cast(bf16x8, w); }
#pragma unroll
        for (int n = 0; n < 4; ++n) { const f32x4 lo = *(const f32x4*)(bp + (size_t)n * 16 * 2048 + k0), hi = *(const f32x4*)(bp + (size_t)n * 16 * 2048 + k0 + 4);
            u32x4 w; w.x = pk2(lo.x, lo.y); w.y = pk2(lo.z, lo.w); w.z = pk2(hi.x, hi.y); w.w = pk2(hi.z, hi.w); b[n] = __builtin_bit_cast(bf16x8, w); }
#pragma unroll
        for (int m = 0; m < 2; ++m)
#pragma unroll
            for (int n = 0; n < 4; ++n) acc[m][n] = mfma16(b[n], a[m], acc[m][n]);
    }
#pragma unroll
    for (int n = 0; n < 4; ++n) {
        const int col = kt * 64 + 16 * n + 4 * fq; const f32x4 w = *(const f32x4*)(n2w + col);
#pragma unroll
        for (int m = 0; m < 2; ++m) { const int row = hp * 128 + nt * 32 + 16 * m + fr; st_bf4(WcT + (size_t)row * 1024 + col, acc[m][n][0] * w.x, acc[m][n][1] * w.y, acc[m][n][2] * w.z, acc[m][n][3] * w.w); }
    }
}

#define KARG __attribute__((address_space(4)))
DEVI const KARG Params* kargs() { unsigned long long k = (unsigned long long)__builtin_amdgcn_kernarg_segment_ptr(); asm volatile("" : "+s"(k)); return (const KARG Params*)k; }
#define PHASE_PTRS \
    int tid_l_ = threadIdx.x; asm volatile("" : "+v"(tid_l_)); \
    [[maybe_unused]] const int tid = tid_l_, lane = tid & 63, wave = __builtin_amdgcn_readfirstlane(tid >> 6), gw = blockIdx.x * NWAVES + wave, fr = lane & 15, fq = lane >> 4; \
    const KARG Params* kp = kargs(); unsigned char* ws = kp->ws; unsigned char* dob = (unsigned char*)kp->out; (void)ws; (void)dob; \
    [[maybe_unused]] const float* x = kp->in[0]; [[maybe_unused]] const int* positions = (const int*)kp->in[1]; [[maybe_unused]] const float* norm1_w = kp->in[2]; [[maybe_unused]] const float* w_in = kp->in[3]; \
    [[maybe_unused]] const float* rw_mu = kp->in[4]; [[maybe_unused]] const float* rw_w0 = kp->in[5]; [[maybe_unused]] const float* rw_a0 = kp->in[7]; [[maybe_unused]] const float* rw_k_k = kp->in[10]; \
    [[maybe_unused]] const float* rw_k_a = kp->in[11]; [[maybe_unused]] const float* rw_r_k = kp->in[12]; [[maybe_unused]] const float* rw_ln_w = kp->in[13]; [[maybe_unused]] const float* rw_ln_b = kp->in[14]; \
    [[maybe_unused]] const float* q_norm_w = kp->in[16]; [[maybe_unused]] const float* kv_norm_w = kp->in[18]; [[maybe_unused]] const float* qn_nope_w = kp->in[20]; [[maybe_unused]] const float* qn_pe_w = kp->in[21]; \
    [[maybe_unused]] const float* kn_nope_w = kp->in[22]; [[maybe_unused]] const float* kn_pe_w = kp->in[23]; [[maybe_unused]] const float* norm2_w = kp->in[26]; \
    [[maybe_unused]] float* ss2 = (float*)(ws + WS_SS2); [[maybe_unused]] unsigned* cnt = (unsigned*)(ws + WS_CNT); [[maybe_unused]] unsigned* xbar_words = (unsigned*)(ws + WS_CNT + 4096); \
    [[maybe_unused]] bf16_t* WinT = (bf16_t*)(ws + WS_WIN); [[maybe_unused]] bf16_t* WuqT = (bf16_t*)(ws + WS_WUQ); [[maybe_unused]] bf16_t* WukvT = (bf16_t*)(ws + WS_WUKV); [[maybe_unused]] bf16_t* RwoT = (bf16_t*)(ws + WS_RWO); \
    [[maybe_unused]] bf16_t* MwoT = (bf16_t*)(ws + WS_MWO); [[maybe_unused]] bf16_t* WoutT = (bf16_t*)(ws + WS_WOUT); [[maybe_unused]] bf16_t* PwqT = (bf16_t*)(ws + WS_PWQ); [[maybe_unused]] bf16_t* SubK = (bf16_t*)(ws + WS_SUBK); \
    [[maybe_unused]] bf16_t* W2T = (bf16_t*)(ws + WS_W2T); [[maybe_unused]] bf16_t* A2T = (bf16_t*)(ws + WS_A2T); [[maybe_unused]] bf16_t* G2T = (bf16_t*)(ws + WS_G2T); [[maybe_unused]] const unsigned char* Gg = ws + WS_G; \
    [[maybe_unused]] bf16_t* Prw = (bf16_t*)(ws + WS_PRW); [[maybe_unused]] bf16_t* QD = (bf16_t*)(ws + WS_QD); [[maybe_unused]] bf16_t* KVD = (bf16_t*)(ws + WS_KVD); [[maybe_unused]] bf16_t* KPE = (bf16_t*)(ws + WS_KPE); \
    [[maybe_unused]] float* ssq = (float*)(ws + WS_SSQ); [[maybe_unused]] float* sskv = (float*)(ws + WS_SSKV); [[maybe_unused]] bf16_t* XN = (bf16_t*)(dob + DO_XN); \
    [[maybe_unused]] bf16_t* Rb = (bf16_t*)(ws + WS_R); [[maybe_unused]] bf16_t* Wb = (bf16_t*)(ws + WS_W); [[maybe_unused]] bf16_t* Kb = (bf16_t*)(ws + WS_KS); [[maybe_unused]] bf16_t* Vb = (bf16_t*)(ws + WS_V); [[maybe_unused]] bf16_t* KKb = (bf16_t*)(ws + WS_KK); \
    [[maybe_unused]] bf16_t* Bvb = (bf16_t*)(dob + DO_BV); [[maybe_unused]] bf16_t* Gtb = (bf16_t*)(dob + DO_GT); [[maybe_unused]] float* bonus = (float*)(dob + DO_BONUS); [[maybe_unused]] bf16_t* Yb = (bf16_t*)(dob + DO_Y); \
    [[maybe_unused]] bf16_t* Qb = (bf16_t*)(ws + WS_Q); [[maybe_unused]] bf16_t* Kab = (bf16_t*)(ws + WS_K); [[maybe_unused]] bf16_t* Vt = (bf16_t*)(ws + WS_VT); [[maybe_unused]] bf16_t* Kraw = (bf16_t*)(dob + DO_KRAW); \
    [[maybe_unused]] bf16_t* Ob = (bf16_t*)(ws + WS_O); [[maybe_unused]] bf16_t* YA = (bf16_t*)(ws + WS_YA); [[maybe_unused]] bf16_t* MIXED = (bf16_t*)(ws + WS_MIXED); [[maybe_unused]] bf16_t* HB = (bf16_t*)(ws + WS_HB); \
    [[maybe_unused]] bf16_t* UB = (bf16_t*)(ws + WS_UB); [[maybe_unused]] bf16_t* VBp = (bf16_t*)(ws + WS_VB); [[maybe_unused]] bf16_t* PQ = (bf16_t*)(ws + WS_PQ); [[maybe_unused]] bf16_t* SC = (bf16_t*)(ws + WS_SC);

__global__ void __launch_bounds__(NT, 2) mega(Params p) {
    extern __shared__ __attribute__((aligned(16))) unsigned char lds[];
    cg::grid_group grid = cg::this_grid();
    const int G = gridDim.x, NGW = G * NWAVES;
    volatile LAS unsigned* bst = (volatile LAS unsigned*)((LAS unsigned char*)lds + LDS_BYTES - 16);
    if (threadIdx.x < 2) bst[threadIdx.x] = 0u;
    if (threadIdx.x >= 8 && threadIdx.x < 16) ((volatile LAS unsigned*)((LAS unsigned char*)lds + LDS_BYTES - 64))[threadIdx.x - 8] = 0u;
    if (threadIdx.x >= 16 && threadIdx.x < 32) ((volatile LAS unsigned*)((LAS unsigned char*)lds + LDS_BYTES - 128))[threadIdx.x - 16] = 0u;
    __syncthreads();

    {
        PHASE_PTRS
        if (blockIdx.x == 0 && tid < 64) cnt[tid] = 0u;
        if (blockIdx.x == 0) for (int i = tid; i < XCD_BAR_WORDS; i += NT) xbar_words[i] = 0u;
        for (int i = blockIdx.x * NT + tid; i < T; i += G * NT) ss2[i] = 0.f;
        for (int t = gw; t < T; t += NGW) {
            const f32x4* xr = (const f32x4*)(x + (size_t)t * DM) + lane;
            f32x4 v[4]; float s = 0.f;
#pragma unroll
            for (int j = 0; j < 4; ++j) { v[j] = xr[64 * j]; s += v[j].x * v[j].x + v[j].y * v[j].y + v[j].z * v[j].z + v[j].w * v[j].w; }
            const float rstd = rsqrtf(wave_sum(s) * (1.f / DM) + EPS);
            const f32x4* wr = (const f32x4*)norm1_w + lane;
#pragma unroll
            for (int j = 0; j < 4; ++j) { const f32x4 w = wr[64 * j]; st_bf4(XN + (size_t)t * DM + (lane + 64 * j) * 4, v[j].x * rstd * w.x, v[j].y * rstd * w.y, v[j].z * rstd * w.z, v[j].w * rstd * w.w); }
        }
        float* scr = (float*)lds + wave * (64 * 33);
        int it = gw;
#define TR_SEG(W_, ldw_, c0_, WT_, ldk_, r0_, Kmax_, nkb_, nnb_, ksc_) \
        { const int cntI = (nkb_) * (nnb_); for (; it < cntI; it += NGW) transpose_item(W_, ldw_, c0_, WT_, ldk_, r0_, Kmax_, it / (nnb_), it % (nnb_), ksc_, scr, lane); it -= cntI; }
        TR_SEG(w_in, 4544, 0, WinT, 1024, 0, 1024, 16, 57, nullptr)
        TR_SEG(w_in, 4544, 1824, WinT, 1024, 2048, 1024, 16, 21, nullptr)
        TR_SEG(w_in, 4544, 2496, WinT, 1024, 2816, 1024, 16, 64, nullptr)
#define TR_SEGF(W_, ldw_, WT_, Kmax_, nkb_, nnb_, fks_) \
        { const int cntI = (nkb_) * (nnb_); for (; it < cntI; it += NGW) transpose_item(W_, ldw_, 0, WT_, 0, 0, Kmax_, it / (nnb_), it % (nnb_), nullptr, scr, lane, fks_); it -= cntI; }
        TR_SEGF(kp->in[6], 512, W2T, 64, 1, 16, 2)
        TR_SEGF(kp->in[8], 512, A2T, 64, 1, 16, 2)
        TR_SEGF(kp->in[9], 512, G2T, 160, 3, 16, 5)
#undef TR_SEGF
#pragma unroll 1
        for (int hh = 0; hh < 8; ++hh) {
            TR_SEG(kp->in[17], 768, hh * 96, WuqT, 384, hh * 64, 384, 6, 2, q_norm_w)
            TR_SEG(kp->in[17], 768, hh * 96 + 64, WuqT, 384, 512 + hh * 32, 384, 6, 1, q_norm_w)
            TR_SEG(kp->in[19], 1024, hh * 128, WukvT, 256, hh * 64, 256, 4, 2, kv_norm_w)
            TR_SEG(kp->in[19], 1024, hh * 128 + 64, WukvT, 256, 512 + hh * 64, 256, 4, 2, kv_norm_w)
        }
        TR_SEG(kp->in[15], 1024, 0, RwoT, 512, 0, 512, 8, 32, nullptr)
        TR_SEG(kp->in[24], 1024, 0, MwoT, 512, 0, 512, 8, 32, nullptr)
        TR_SEG(kp->in[25], 1024, 0, WoutT, 1024, 0, 1024, 16, 32, nullptr)
#undef TR_SEG
        for (; it < 1024; it += NGW) wcomb_item(kp->in[27], kp->in[28], norm2_w, PwqT, it, lane);
        for (int i = blockIdx.x * NT + tid; i < (224 + 96) * 128; i += G * NT) {
            const int r = i >> 7, c = i & 127; const int row = r < 224 ? 1824 + r : 2720 + (r - 224);
            *(u32x4*)(WinT + (size_t)row * 1024 + c * 8) = (u32x4){0u, 0u, 0u, 0u};
        }
    }
    grid.sync();
    const XcdBarrier xb = xcd_barrier_post((unsigned*)(kargs()->ws + WS_CNT + 4096), bst);

    {
        PHASE_PTRS
        pg8::Gemm g{XN, WinT, T, 4864, DM}; pg8::StaticOrder S; S.init(T, 4864, G, (int)blockIdx.x);
        pg8::EpiP1 E{ws};
        pg8::gemm_phase<pg8::EpiP1, pg8::StaticOrder, true, true>((PG8_LAS unsigned char*)lds, g, S, E);
    }
    xcd_barrier(xb);


    {
        PHASE_PTRS
        for (int t = gw; t < T; t += NGW) {
            float a6[8]; ld_bf8(QD + (size_t)t * 384 + 8 * (lane & 47), a6); float s = 0.f;
#pragma unroll
            for (int i = 0; i < 8; ++i) s += a6[i] * a6[i];
            if (lane >= 48) s = 0.f;
            float b4[4]; ld_bf4(KVD + (size_t)t * 256 + 4 * lane, b4); const float s2 = (b4[0] * b4[0] + b4[1] * b4[1]) + (b4[2] * b4[2] + b4[3] * b4[3]);
            const float sq = wave_sum(s), skv = wave_sum(s2);
            if (lane == 0) { ssq[t] = rsqrtf(sq * (1.f / 384.f) + EPS); sskv[t] = rsqrtf(skv * (1.f / 256.f) + EPS); }
        }
    }
    {
        PHASE_PTRS
        LAS bf16_t* MIX = (LAS bf16_t*)lds; LAS bf16_t* LOR = (LAS bf16_t*)((LAS unsigned char*)lds + 49152);
        for (int tt = blockIdx.x; tt < T / 16; tt += G) {
            int h = wave; asm volatile("" : "+s"(h));
            __syncthreads();
            {
                u32x4 pw[8], ppw[8];
#pragma unroll
                for (int u = 0; u < 8; ++u) {
                    const int ci = tid + u * NT < 16 * 228 ? tid + u * NT : 16 * 228 - 1; const int row = ci / 228, cc = (ci - row * 228) * 8; const int tk = tt * 16 + row;
                    pw[u] = *(const u32x4*)(Prw + (size_t)tk * 2048 + cc);
                    ppw[u] = *(const u32x4*)(Prw + (size_t)((tk & (SEQ - 1)) != 0 ? tk - 1 : tk) * 2048 + cc);
                }
                __builtin_amdgcn_sched_barrier(0);
#pragma unroll
                for (int u = 0; u < 8; ++u) {
                    const int ci = tid + u * NT; if (ci < 16 * 228) {
                        const int row = ci / 228, cc = (ci - row * 228) * 8; const bool hp_ = ((tt * 16 + row) & (SEQ - 1)) != 0;
                        const float pv[8] = {bflo(pw[u].x), bfhi(pw[u].x), bflo(pw[u].y), bfhi(pw[u].y), bflo(pw[u].z), bfhi(pw[u].z), bflo(pw[u].w), bfhi(pw[u].w)};
                        float ppv[8] = {bflo(ppw[u].x), bfhi(ppw[u].x), bflo(ppw[u].y), bfhi(ppw[u].y), bflo(ppw[u].z), bfhi(ppw[u].z), bflo(ppw[u].w), bfhi(ppw[u].w)};
                        if (!hp_) {
#pragma unroll
                            for (int j = 0; j < 8; ++j) ppv[j] = 0.f; }
                        const f32x4 mu0 = *(const f32x4*)(rw_mu + cc), mu1 = *(const f32x4*)(rw_mu + cc + 4); float xm[8];
#pragma unroll
                        for (int j = 0; j < 8; ++j) { const float mu = j < 4 ? mu0[j & 3] : mu1[j & 3]; const float v = pv[j] + mu * (ppv[j] - pv[j]);
                            xm[j] = cc < 1600 ? (cc < 1536 ? v : tanhf_(v)) : (cc < 1664 ? v : sigmoidf_(v)); }
                        if (cc < 1536) *(LAS bf16x8*)(MIX + row * 1536 + cc) = pack8(xm); else *(LAS bf16x8*)(LOR + row * 288 + (cc - 1536)) = pack8(xm);
                    }
                }
            }
            __syncthreads();
            const int tok = tt * 16 + fr;
            f32x4 accw[4], acca[4], accg[4];
#pragma unroll
            for (int n = 0; n < 4; ++n) { accw[n] = (f32x4){0.f, 0.f, 0.f, 0.f}; acca[n] = accw[n]; accg[n] = accw[n]; }
#define LORA_STEP(lcol_, Wt_, KS_, ks_, accv_) { \
                const bf16x8 a = *(const LAS bf16x8*)(LOR + fr * 288 + (lcol_) + 8 * fq); \
                _Pragma("unroll") for (int n = 0; n < 4; ++n) { const bf16x8 b = *(const bf16x8*)((Wt_) + ((size_t)(((h * (KS_) + (ks_)) * 4 + n) * 64 + lane)) * 8); accv_[n] = mfma16(b, a, accv_[n]); } }
#pragma unroll
            for (int ks = 0; ks < 2; ++ks) LORA_STEP(32 * ks, W2T, 2, ks, accw)
#pragma unroll
            for (int ks = 0; ks < 2; ++ks) LORA_STEP(64 + 32 * ks, A2T, 2, ks, acca)
#pragma unroll
            for (int ks = 0; ks < 5; ++ks) LORA_STEP(128 + 32 * ks, G2T, 5, ks, accg)
#undef LORA_STEP
            float kkv[4][4], av[4][4]; float ssq = 0.f, bon = 0.f;
            u32x2 Rp[4], Wp[4], Kp[4], Vp[4], Gp[4];
#pragma unroll
            for (int n = 0; n < 4; ++n) {
                const int ch = 64 * h + 16 * fq + 4 * n;
                float r4[4], k4[4], v4[4];
#pragma unroll
                for (int seg = 0; seg < 3; ++seg) {
                    const u32x2 w = *(const LAS u32x2*)(MIX + fr * 1536 + seg * 512 + ch);
                    const float m4[4] = {bflo(w.x), bfhi(w.x), bflo(w.y), bfhi(w.y)};
#pragma unroll
                    for (int i = 0; i < 4; ++i) { if (seg == 0) r4[i] = m4[i]; else if (seg == 1) k4[i] = m4[i]; else v4[i] = m4[i]; }
                }
                const f32x4 w0 = *(const f32x4*)(rw_w0 + ch), a0 = *(const f32x4*)(rw_a0 + ch), kkw = *(const f32x4*)(rw_k_k + ch), kaw = *(const f32x4*)(rw_k_a + ch), rkw = *(const f32x4*)(rw_r_k + ch);
                float dd[4], kf[4];
#pragma unroll
                for (int i = 0; i < 4; ++i) {
                    const float z = -(w0[i] + accw[n][i]);
                    const float sp = z > 20.f ? z : __logf(1.f + __expf(z));
                    const float wlog = -sp - 0.5f;
                    dd[i] = -__expf(wlog);
                    const float a = sigmoidf_(a0[i] + acca[n][i]); av[n][i] = a;
                    kkv[n][i] = k4[i] * kkw[i]; ssq += kkv[n][i] * kkv[n][i];
                    kf[i] = k4[i] * (1.f + (a - 1.f) * kaw[i]);
                    bon += r4[i] * kf[i] * rkw[i];
                }
                Rp[n] = (u32x2){pk2(r4[0], r4[1]), pk2(r4[2], r4[3])}; Wp[n] = (u32x2){pk2(dd[0], dd[1]), pk2(dd[2], dd[3])}; Kp[n] = (u32x2){pk2(kf[0], kf[1]), pk2(kf[2], kf[3])};
                Vp[n] = (u32x2){pk2(v4[0], v4[1]), pk2(v4[2], v4[3])}; Gp[n] = (u32x2){pk2(accg[n][0], accg[n][1]), pk2(accg[n][2], accg[n][3])};
            }
            const size_t o = (size_t)tok * 512 + 64 * h + 16 * fq;
#define ST16(P_, X_) { *(u32x4*)((P_) + o) = (u32x4){X_[0].x, X_[0].y, X_[1].x, X_[1].y}; *(u32x4*)((P_) + o + 8) = (u32x4){X_[2].x, X_[2].y, X_[3].x, X_[3].y}; }
            ST16(Rb, Rp) ST16(Wb, Wp) ST16(Kb, Kp) ST16(Vb, Vp) ST16(Gtb, Gp)
            ssq += __shfl_xor(ssq, 16); ssq += __shfl_xor(ssq, 32);
            bon += __shfl_xor(bon, 16); bon += __shfl_xor(bon, 32);
            const float inv = 1.f / fmaxf(sqrtf(ssq), 1e-12f);
            u32x2 KKp[4], Bp[4];
#pragma unroll
            for (int n = 0; n < 4; ++n) {
                float kk[4], bb[4];
#pragma unroll
                for (int i = 0; i < 4; ++i) { kk[i] = kkv[n][i] * inv; bb[i] = kk[i] * av[n][i]; }
                KKp[n] = (u32x2){pk2(kk[0], kk[1]), pk2(kk[2], kk[3])}; Bp[n] = (u32x2){pk2(bb[0], bb[1]), pk2(bb[2], bb[3])};
            }
            ST16(KKb, KKp) ST16(Bvb, Bp)
#undef ST16
            if (fq == 0) bonus[(size_t)tok * 8 + h] = bon;
        }
    }
    xcd_barrier(xb);

    {
        PHASE_PTRS
        { int Kq = 384; asm volatile("" : "+s"(Kq));
          pg8::Gemm g{QD, WuqT, T, 768, Kq}; pg8::StaticOrder S; S.init(T, 768, G, (int)blockIdx.x); pg8::EpiQraw E{Qb, ssq};
          pg8::gemm_phase<pg8::EpiQraw, pg8::StaticOrder, true, true>((PG8_LAS unsigned char*)lds, g, S, E); }
        { int Kkv = 256; asm volatile("" : "+s"(Kkv));
          pg8::Gemm g{KVD, WukvT, T, 1024, Kkv}; pg8::StaticOrder S; S.init(T, 1024, G, (int)blockIdx.x); pg8::EpiKVraw E{Kraw, Vt, sskv};
          pg8::gemm_phase<pg8::EpiKVraw, pg8::StaticOrder, true, true>((PG8_LAS unsigned char*)lds, g, S, E); }
    }
    xcd_barrier(xb);
    {
        PHASE_PTRS
        for (int t = gw; t < T; t += NGW) {
            const int hh = lane >> 3, l8 = lane & 7;
            const float pos = (float)positions[t];
            float cs[4], sn[4];
#pragma unroll
            for (int i = 0; i < 4; ++i) { const float invf = exp2f(-(float)(4 * (l8 & 3) + i) * (13.287712379549449f / 16.f)); float rev = pos * invf * 0.15915494309189535f; rev -= rintf(rev);
                sn[i] = __builtin_amdgcn_sinf(rev); cs[i] = __builtin_amdgcn_cosf(rev); }
            bf16_t* qrow = Qb + (size_t)t * 768;
            float qn[8], qp[4]; ld_bf8(qrow + 8 * lane, qn); ld_bf4(qrow + 512 + 4 * lane, qp);
            float kn[8], kp4[4]; ld_bf8(Kraw + (size_t)t * 512 + 8 * lane, kn); ld_bf4(KPE + (size_t)t * 32 + 4 * l8, kp4);
            float s1 = 0.f, s2 = 0.f, s3 = 0.f, s4 = 0.f;
#pragma unroll
            for (int i = 0; i < 8; ++i) { s1 += qn[i] * qn[i]; s3 += kn[i] * kn[i]; }
#pragma unroll
            for (int i = 0; i < 4; ++i) { s2 += qp[i] * qp[i]; s4 += kp4[i] * kp4[i]; }
            s1 = sum8(s1); s2 = sum8(s2); s3 = sum8(s3); s4 = sum8(s4);
            const float r1 = rsqrtf(s1 * (1.f / 64.f) + EPS) * QSCALE, r2 = rsqrtf(s2 * (1.f / 32.f) + EPS), r3 = rsqrtf(s3 * (1.f / 64.f) + EPS), r4 = rsqrtf(s4 * (1.f / 32.f) + EPS);
            const f32x4 wq0 = *(const f32x4*)(qn_nope_w + 8 * l8), wq1 = *(const f32x4*)(qn_nope_w + 8 * l8 + 4), wk0 = *(const f32x4*)(kn_nope_w + 8 * l8), wk1 = *(const f32x4*)(kn_nope_w + 8 * l8 + 4);
            const f32x4 wqp = *(const f32x4*)(qn_pe_w + 4 * l8), wkp = *(const f32x4*)(kn_pe_w + 4 * l8);
            float oq[8], ok[8], oqp[4], okp[4];
#pragma unroll
            for (int i = 0; i < 8; ++i) { oq[i] = qn[i] * r1 * (i < 4 ? wq0[i & 3] : wq1[i & 3]); ok[i] = kn[i] * r3 * (i < 4 ? wk0[i & 3] : wk1[i & 3]); }
#pragma unroll
            for (int i = 0; i < 4; ++i) {
                const float xq = qp[i] * r2 * wqp[i], xk = kp4[i] * r4 * wkp[i];
                const float pq = dpp_f<0x141>(xq), pk_ = dpp_f<0x141>(xk);
                (void)pq; (void)pk_;
                oqp[i] = xq; okp[i] = xk;
            }
#pragma unroll
            for (int i = 0; i < 4; ++i) {
                const float pq = __shfl_xor(oqp[i], 4), pk_ = __shfl_xor(okp[i], 4);
                const float xq = oqp[i], xk = okp[i];
                oqp[i] = l8 < 4 ? (xq * cs[i] - pq * sn[i]) : (xq * cs[i] + pq * sn[i]);
                okp[i] = l8 < 4 ? (xk * cs[i] - pk_ * sn[i]) : (xk * cs[i] + pk_ * sn[i]);
                oqp[i] *= QSCALE;
            }
            bf16_t* qo = Qb + ((size_t)t * 8 + hh) * 96;
            *(bf16x8*)(qo + 8 * l8) = pack8(oq); st_bf4(qo + 64 + 4 * l8, oqp[0], oqp[1], oqp[2], oqp[3]);
            { const int bb = t >> 12, pos = t & 4095; bf16_t* kfb = Kab + (((size_t)(bb * 8 + hh) * 128 + (pos >> 5)) * 6) * 512 + (pos & 31) * 8;
              *(bf16x8*)(kfb + (l8 >> 1) * 512 + 256 * (l8 & 1)) = pack8(ok);
              st_bf4(kfb + (4 + (l8 >> 2)) * 512 + 256 * ((l8 >> 1) & 1) + 4 * (l8 & 1), okp[0], okp[1], okp[2], okp[3]); }
        }
    }
    xcd_barrier(xb);

    {
        PHASE_PTRS
        float* GL = (float*)(dob + DO_GL);
        const int fr_o = fr, fq_o = fq, lane_o = lane;
        if (wave < 3) {
            LAS unsigned char* wb = (LAS unsigned char*)lds + wave * 49152;
            LAS bf16_t* At = (LAS bf16_t*)(wb + 0);      LAS bf16_t* Btm = (LAS bf16_t*)(wb + 4096);  LAS bf16_t* Ktm = (LAS bf16_t*)(wb + 8192); LAS bf16_t* Rtm = (LAS bf16_t*)(wb + 12288);
            LAS bf16_t* AtT = (LAS bf16_t*)(wb + 16384); LAS bf16_t* BtT = (LAS bf16_t*)(wb + 20480); LAS bf16_t* KtT = (LAS bf16_t*)(wb + 24576); LAS bf16_t* VmT = (LAS bf16_t*)(wb + 28672);
            LAS bf16_t* Nm = (LAS bf16_t*)(wb + 32768);  LAS bf16_t* NmT = (LAS bf16_t*)(wb + 34816); LAS bf16_t* Tm = (LAS bf16_t*)(wb + 36864);  LAS bf16_t* TmT = (LAS bf16_t*)(wb + 38912);
            LAS bf16_t* MmT = (LAS bf16_t*)(wb + 40960); LAS bf16_t* NBT = (LAS bf16_t*)(wb + 43008); LAS bf16_t* MKT = (LAS bf16_t*)(wb + 45056); LAS float* gLs = (LAS float*)(wb + 47104);
            LAS bf16_t* W1 = At; LAS bf16_t* W1T = Btm; LAS bf16_t* ATm = Ktm;
#pragma unroll 1
            for (int it = blockIdx.x * 3 + wave; it < 4096; it += G * 3) {
                const int bh = it >> 7, c = it & 127, b = bh >> 3, h = bh & 7;
                int fr = fr_o, fq = fq_o, lane = lane_o; asm volatile("" : "+v"(fr), "+v"(fq), "+v"(lane));
                const int lpA = (4 * (fr >> 3) + (fr & 3)) + 32 * (fq & 1) + ((fq >> 1) + 4 * ((fr >> 2) & 1)) * 512;
                const int lpB = ((fr >> 1) + 16 * (fq & 1)) * 512 + 16 * (fr & 1) + 4 * (fq >> 1);
                const int lpC = 4 * (fq >> 1) + 16 * (fr & 3) + ((fr >> 2) + 8 * (fq & 1)) * 512;
                const size_t sbase = ((size_t)b * SEQ + c * 32) * 512 + h * 64;
                {
                    float cs = 0.f; unsigned aT[16], bT[16], kT[16], vT[16];
#pragma unroll
                    for (int t = 0; t < 32; ++t) {
                        const size_t o = sbase + (size_t)t * 512 + lane;
                        const float ldv = bf1(Wb[o]), rr = bf1(Rb[o]), kv = bf1(Kb[o]), qv = bf1(KKb[o]), bv = bf1(Bvb[o]); const unsigned vraw = Vb[o];
                        const float ep = __expf(cs); cs += ldv; const float ec = __expf(cs), en = __expf(-cs);
                        const unsigned a_ = bf1of(-qv * ep), b_ = bf1of(bv * en), k_ = bf1of(kv * en), r_ = bf1of(rr * ec);
                        At[SW64(t, lane)] = (bf16_t)a_; Btm[SW64(t, lane)] = (bf16_t)b_; Ktm[SW64(t, lane)] = (bf16_t)k_; Rtm[SW64(t, lane)] = (bf16_t)r_;
                        if (t & 1) { aT[t >> 1] |= a_ << 16; bT[t >> 1] |= b_ << 16; kT[t >> 1] |= k_ << 16; vT[t >> 1] |= vraw << 16; }
                        else { aT[t >> 1] = a_; bT[t >> 1] = b_; kT[t >> 1] = k_; vT[t >> 1] = vraw; }
                    }
#pragma unroll
                    for (int q = 0; q < 4; ++q) {
                        *(LAS u32x4*)(AtT + lane * 32 + ((q ^ ((lane >> 2) & 3)) << 3)) = (u32x4){aT[4 * q], aT[4 * q + 1], aT[4 * q + 2], aT[4 * q + 3]};
                        *(LAS u32x4*)(BtT + lane * 32 + ((q ^ ((lane >> 2) & 3)) << 3)) = (u32x4){bT[4 * q], bT[4 * q + 1], bT[4 * q + 2], bT[4 * q + 3]};
                        *(LAS u32x4*)(KtT + lane * 32 + ((q ^ ((lane >> 2) & 3)) << 3)) = (u32x4){kT[4 * q], kT[4 * q + 1], kT[4 * q + 2], kT[4 * q + 3]};
                        *(LAS u32x4*)(VmT + lane * 32 + ((q ^ ((lane >> 2) & 3)) << 3)) = (u32x4){vT[4 * q], vT[4 * q + 1], vT[4 * q + 2], vT[4 * q + 3]};
                    }
                    const float gl = __expf(cs); gLs[lane] = gl;
                    { const int k5 = lane & 31; GL[(size_t)it * 64 + (lane >> 5) * 32 + ((k5 >> 2) & 1) * 16 + (k5 & 3) + 4 * (k5 >> 3)] = gl; }
                }
                {
                    f32x4 acc[2][2];
#define ZACC(MT_, NT_) _Pragma("unroll") for (int m = 0; m < MT_; ++m) _Pragma("unroll") for (int n = 0; n < NT_; ++n) acc[m][n] = (f32x4){0.f, 0.f, 0.f, 0.f};
                    ZACC(2, 2) gemm_lds<2, 2, 2>(Btm, 64, At, 64, acc, fr, fq);
#pragma unroll
                    for (int m = 0; m < 2; ++m)
#pragma unroll
                        for (int n = 0; n < 2; ++n)
#pragma unroll
                            for (int j = 0; j < 4; ++j) { const int i = 16 * m + fr, tt = 16 * n + 4 * fq + j; const float v = i < tt ? acc[m][n][j] : 0.f; const bf16_t w = bf1of(v), w1 = bf1of(v + (i == tt ? 1.f : 0.f));
                                Nm[SW32(i, tt)] = w; NmT[SW32(tt, i)] = w; Tm[SW32(i, tt)] = w1; TmT[SW32(tt, i)] = w1; }
                    ZACC(2, 2) gemm_lds<2, 2, 2>(Ktm, 64, At, 64, acc, fr, fq);
#pragma unroll
                    for (int m = 0; m < 2; ++m)
#pragma unroll
                        for (int n = 0; n < 2; ++n)
#pragma unroll
                            for (int j = 0; j < 4; ++j) { const int i = 16 * m + fr, tt = 16 * n + 4 * fq + j; MmT[SW32(tt, i)] = bf1of(i < tt ? acc[m][n][j] : 0.f); }
                    ZACC(2, 2) gemm_lds<2, 2, 2>(Btm, 64, Rtm, 64, acc, fr, fq);
#pragma unroll
                    for (int m = 0; m < 2; ++m)
#pragma unroll
                        for (int n = 0; n < 2; ++n)
#pragma unroll
                            for (int j = 0; j < 4; ++j) { const int i = 16 * m + fr, tt = 16 * n + 4 * fq + j; NBT[SW32(tt, i)] = bf1of(i <= tt ? acc[m][n][j] : 0.f); }
                    ZACC(2, 2) gemm_lds<2, 2, 2>(Ktm, 64, Rtm, 64, acc, fr, fq);
#pragma unroll
                    for (int m = 0; m < 2; ++m)
#pragma unroll
                        for (int n = 0; n < 2; ++n)
#pragma unroll
                            for (int j = 0; j < 4; ++j) { const int i = 16 * m + fr, tt = 16 * n + 4 * fq + j; MKT[SW32(tt, i)] = bf1of(i <= tt ? acc[m][n][j] : 0.f); }
#pragma unroll 1
                    for (int rd = 0; rd < 4; ++rd) {
                        ZACC(2, 2) gemm_lds<2, 2, 1>(Nm, 32, NmT, 32, acc, fr, fq);
#pragma unroll
                        for (int m = 0; m < 2; ++m)
#pragma unroll
                            for (int n = 0; n < 2; ++n)
#pragma unroll
                                for (int j = 0; j < 4; ++j) { const int i = 16 * m + fr, tt = 16 * n + 4 * fq + j; const bf16_t w = bf1of(acc[m][n][j]); Nm[SW32(i, tt)] = w; NmT[SW32(tt, i)] = w; }
                        ZACC(2, 2) gemm_lds<2, 2, 1>(Tm, 32, NmT, 32, acc, fr, fq);
#pragma unroll
                        for (int m = 0; m < 2; ++m)
#pragma unroll
                            for (int n = 0; n < 2; ++n)
#pragma unroll
                                for (int j = 0; j < 4; ++j) { const int i = 16 * m + fr, tt = 16 * n + 4 * fq + j; const bf16_t w = bf1of(acc[m][n][j] + bf1(Tm[SW32(i, tt)])); Tm[SW32(i, tt)] = w; TmT[SW32(tt, i)] = w; }
                    }
                }
                asm volatile("" : "+v"(fr), "+v"(fq));
                {
                    f32x4 acc[4][2];
                    ZACC(4, 2) gemm_lds<4, 2, 1>(AtT, 32, TmT, 32, acc, fr, fq);
#pragma unroll
                    for (int m = 0; m < 4; ++m)
#pragma unroll
                        for (int n = 0; n < 2; ++n)
#pragma unroll
                            for (int j = 0; j < 4; ++j) ATm[SW32(16 * m + fr, 16 * n + 4 * fq + j)] = bf1of(acc[m][n][j]);
                    ZACC(4, 2) gemm_lds<4, 2, 1>(VmT, 32, MmT, 32, acc, fr, fq);
#pragma unroll
                    for (int m = 0; m < 4; ++m)
#pragma unroll
                        for (int n = 0; n < 2; ++n)
#pragma unroll
                            for (int j = 0; j < 4; ++j) W1[SW32(16 * m + fr, 16 * n + 4 * fq + j)] = bf1of(acc[m][n][j]);
                    ZACC(4, 2) gemm_lds<4, 2, 1>(W1, 32, TmT, 32, acc, fr, fq);
#pragma unroll
                    for (int m = 0; m < 4; ++m)
#pragma unroll
                        for (int n = 0; n < 2; ++n)
#pragma unroll
                            for (int j = 0; j < 4; ++j) W1T[SW32(16 * m + fr, 16 * n + 4 * fq + j)] = bf1of(acc[m][n][j]);
                    ZACC(4, 2) gemm_lds<4, 2, 1>(ATm, 32, NBT, 32, acc, fr, fq);
#pragma unroll
                    for (int m = 0; m < 4; ++m)
#pragma unroll
                        for (int n = 0; n < 2; ++n)
#pragma unroll
                            for (int j = 0; j < 4; ++j) { const int k = 16 * m + fr, tp = 16 * n + 4 * fq + j; const float v = acc[m][n][j] + bf1(Rtm[SW64(tp, k)]);
                                Rb[sbase + lpA + (size_t)(j * 8 + (2 * n + 8 * m) * 512)] = bf1of(v); }
                    ZACC(4, 2) gemm_lds<4, 2, 1>(W1T, 32, NBT, 32, acc, fr, fq); gemm_lds<4, 2, 1>(VmT, 32, MKT, 32, acc, fr, fq);
#pragma unroll
                    for (int m = 0; m < 4; ++m)
#pragma unroll
                        for (int n = 0; n < 2; ++n)
#pragma unroll
                            for (int j = 0; j < 4; ++j) Yb[sbase + lpB + (size_t)((8 * (m & 1)) * 512 + 32 * (m >> 1) + j + 8 * n)] = bf1of(acc[m][n][j]);
                }
                asm volatile("" : "+v"(fr), "+v"(fq));
                {
                    f32x4 acc[4][4];
                    ZACC(4, 4) gemm_lds<4, 4, 1>(ATm, 32, BtT, 32, acc, fr, fq);
#pragma unroll
                    for (int m = 0; m < 4; ++m)
#pragma unroll
                        for (int n = 0; n < 4; ++n)
#pragma unroll
                            for (int j = 0; j < 4; ++j) { const float v = acc[m][n][j] * gLs[16 * n + 4 * fq + j];
                                (n < 2 ? Wb : Kb)[sbase + lpA + (size_t)(j * 8 + (2 * (n & 1) + 8 * m) * 512)] = bf1of(v); }
                    ZACC(4, 4) gemm_lds<4, 4, 1>(W1T, 32, BtT, 32, acc, fr, fq); gemm_lds<4, 4, 1>(VmT, 32, KtT, 32, acc, fr, fq);
#pragma unroll
                    for (int m = 0; m < 4; ++m)
#pragma unroll
                        for (int n = 0; n < 4; ++n)
#pragma unroll
                            for (int j = 0; j < 4; ++j) { const float v = acc[m][n][j] * gLs[16 * n + 4 * fq + j];
                                (m < 2 ? KKb : Bvb)[sbase + lpC + (size_t)(j + 8 * (n & 1) + (4 * (m & 1) + 16 * (n >> 1)) * 512)] = bf1of(v); }
                }
#undef ZACC
            }
        }
    }
    xcd_barrier(xb);

    {
        PHASE_PTRS
        if (wave < 5 && blockIdx.x < 64) {
            const int item = blockIdx.x, bh = item >> 1, wv = item & 1, b = bh >> 3, h = bh & 7;
            const int hi = lane >> 5, vcol = lane & 31;
            float* GL = (float*)(dob + DO_GL);
            volatile LAS unsigned* ctr = (volatile LAS unsigned*)((LAS unsigned char*)lds + LDS_BYTES - 64);
#define SLICE(arr, sb, li) ((arr) + (sb) + (size_t)((li) >> 6) * 512 + ((li) & 63))
#define DMA16(src_, dst_) __builtin_amdgcn_global_load_lds((const unsigned*)(src_), (LAS unsigned*)(dst_), 16, 0, 0)
            if (wave >= 1 && wave <= 3) {
                __builtin_amdgcn_s_setprio(2);
#pragma unroll 1
                for (int c = 0; c < 128; ++c) {
                    if (c >= 4) { while ((int)ctr[3] < c - 3) __builtin_amdgcn_s_sleep(1); }
                    asm volatile("" ::: "memory");
                    const size_t sb = ((size_t)b * SEQ + c * 32) * 512 + h * 64; LAS unsigned char* lb = (LAS unsigned char*)lds + (c & 3) * 19712;
                    if (wave == 1) {
#pragma unroll
                        for (int q = 0; q < 4; ++q) DMA16(SLICE(Wb, sb, (q * 64 + lane) * 8), lb + q * 1024);
#pragma unroll
                        for (int q = 0; q < 2; ++q) DMA16(SLICE(Kb, sb, (q * 64 + lane) * 8), lb + 4096 + q * 1024);
                        asm volatile("s_waitcnt vmcnt(12)" ::: "memory");
                    } else if (wave == 2) {
#pragma unroll
                        for (int q = 2; q < 4; ++q) DMA16(SLICE(Kb, sb, (q * 64 + lane) * 8), lb + 4096 + q * 1024);
#pragma unroll
                        for (int q = 0; q < 4; ++q) DMA16(SLICE(Rb, sb, (q * 64 + lane) * 8), lb + 8192 + q * 1024);
                        asm volatile("s_waitcnt vmcnt(12)" ::: "memory");
                    } else {
#pragma unroll
                        for (int kb = 0; kb < 2; ++kb)
#pragma unroll
                            for (int hf = 0; hf < 2; ++hf) DMA16(SLICE(wv ? Bvb : KKb, sb, (kb * 64 + lane) * 16 + 8 * hf), lb + 12288 + kb * 2048 + hf * 1024);
#pragma unroll
                        for (int hf = 0; hf < 2; ++hf) DMA16(Yb + sb + (size_t)(lane >> 1) * 512 + 32 * wv + 16 * (lane & 1) + 8 * hf, lb + 16384 + hf * 1024);
                        __builtin_amdgcn_global_load_lds((const unsigned*)(GL + ((size_t)(bh * 128 + c)) * 64 + lane), (LAS unsigned*)(lb + 18432), 4, 0, 0);
                        asm volatile("s_waitcnt vmcnt(14)" ::: "memory");
                    }
                    if (c >= 2 && lane == 0) ctr[wave - 1] = (unsigned)(c - 1);
                }
                asm volatile("s_waitcnt vmcnt(0)" ::: "memory");
                if (lane == 0) ctr[wave - 1] = 128u;
                __builtin_amdgcn_s_setprio(0);
            } else if (wave == 4) {
#pragma unroll 1
                for (int c = 0; c < 128; ++c) {
                    while ((int)ctr[4] <= c) __builtin_amdgcn_s_sleep(2);
                    asm volatile("" ::: "memory");
                    const LAS u32x4* ys = (const LAS u32x4*)((LAS unsigned char*)lds + 81920 + (c & 7) * 2048 + lane * 32);
                    const u32x4 ya = ys[0], yb = ys[1];
                    u32x4* yo = (u32x4*)(Yb + ((size_t)b * SEQ + c * 32 + (lane >> 1)) * 512 + h * 64 + 32 * wv + 16 * (lane & 1));
                    yo[0] = ya; yo[1] = yb;
                    asm volatile("s_waitcnt lgkmcnt(0)" ::: "memory");
                    if (lane == 0) ctr[5] = (unsigned)(c + 1);
                }
            } else {
                __builtin_amdgcn_s_setprio(3);
                f32x16 S0t, S1t;
#pragma unroll
                for (int r = 0; r < 16; ++r) { S0t[r] = 0.f; S1t[r] = 0.f; }
#pragma unroll 1
                for (int c = 0; c < 128; ++c) {
                    while ((int)ctr[0] <= c || (int)ctr[1] <= c || (int)ctr[2] <= c) __builtin_amdgcn_s_sleep(1);
                    asm volatile("" ::: "memory");
                    const LAS unsigned char* lb = (const LAS unsigned char*)lds + (c & 3) * 19712;
                    bf16x8 sf[4];
#pragma unroll
                    for (int s = 0; s < 4; ++s) { float t8[8];
#pragma unroll
                        for (int j = 0; j < 8; ++j) t8[j] = (s < 2 ? S0t : S1t)[8 * (s & 1) + j];
                        sf[s] = pack8(t8); }
                    f32x16 yt;
                    { const u32x4 c0 = *(const LAS u32x4*)(lb + 16384 + lane * 16), c1 = *(const LAS u32x4*)(lb + 16384 + 1024 + lane * 16);
                      yt[0] = bflo(c0.x); yt[1] = bfhi(c0.x); yt[2] = bflo(c0.y); yt[3] = bfhi(c0.y); yt[4] = bflo(c0.z); yt[5] = bfhi(c0.z); yt[6] = bflo(c0.w); yt[7] = bfhi(c0.w);
                      yt[8] = bflo(c1.x); yt[9] = bfhi(c1.x); yt[10] = bflo(c1.y); yt[11] = bfhi(c1.y); yt[12] = bflo(c1.z); yt[13] = bfhi(c1.z); yt[14] = bflo(c1.w); yt[15] = bfhi(c1.w); }
                    f32x16 n0, n1;
#pragma unroll
                    for (int kb = 0; kb < 2; ++kb) {
                        const u32x4 c0 = *(const LAS u32x4*)(lb + 12288 + kb * 2048 + lane * 16), c1 = *(const LAS u32x4*)(lb + 12288 + kb * 2048 + 1024 + lane * 16);
                        const LAS float* gp = (const LAS float*)(lb + 18432) + kb * 32 + hi * 16;
                        f32x16 nn; const f32x16 so = kb ? S1t : S0t;
                        nn[0] = bflo(c0.x); nn[1] = bfhi(c0.x); nn[2] = bflo(c0.y); nn[3] = bfhi(c0.y); nn[4] = bflo(c0.z); nn[5] = bfhi(c0.z); nn[6] = bflo(c0.w); nn[7] = bfhi(c0.w);
                        nn[8] = bflo(c1.x); nn[9] = bfhi(c1.x); nn[10] = bflo(c1.y); nn[11] = bfhi(c1.y); nn[12] = bflo(c1.z); nn[13] = bfhi(c1.z); nn[14] = bflo(c1.w); nn[15] = bfhi(c1.w);
#pragma unroll
                        for (int r = 0; r < 16; ++r) nn[r] += gp[r] * so[r];
                        if (kb) n1 = nn; else n0 = nn;
                    }
#pragma unroll
                    for (int s = 0; s < 4; ++s) {
                        const bf16x8 ra = *(const LAS bf16x8*)(lb + 8192 + s * 1024 + lane * 16);
                        const bf16x8 p0 = *(const LAS bf16x8*)(lb + s * 1024 + lane * 16), p1 = *(const LAS bf16x8*)(lb + 4096 + s * 1024 + lane * 16);
                        yt = mfma32(ra, sf[s], yt); n0 = mfma32(p0, sf[s], n0); n1 = mfma32(p1, sf[s], n1);
                    }
                    S0t = n0; S1t = n1;
                    asm volatile("s_waitcnt lgkmcnt(0)" ::: "memory");
                    if (lane == 0) ctr[3] = (unsigned)(c + 1);
                    if (c >= 8) { while ((int)ctr[5] < c - 7) __builtin_amdgcn_s_sleep(1); }
                    asm volatile("" ::: "memory");
                    { LAS bf16_t* ys = (LAS bf16_t*)((LAS unsigned char*)lds + 81920 + (c & 7) * 2048) + vcol;
#pragma unroll
                      for (int r = 0; r < 16; ++r) ys[crow(r, hi) * 32] = bf1of(yt[r]);
                      asm volatile("s_waitcnt lgkmcnt(0)" ::: "memory");
                      if (lane == 0) ctr[4] = (unsigned)(c + 1); }
                }
                __builtin_amdgcn_s_setprio(0);
            }
#undef DMA16
#undef SLICE
        }
        for (;;) {
            unsigned item = 0;
            const int xg = blockIdx.x & 7;
            if (lane == 0) item = atomicAdd(&cnt[xg], 1u);
            item = __builtin_amdgcn_readfirstlane(item);
            if (item >= 256u) break;
            const int qt = 63 - (int)(item >> 2), bh = 8 * (int)(item & 3) + xg, b = bh >> 3, h = bh & 7;
            const int qi = lane & 31, hi = lane >> 5;
            const size_t tokq = (size_t)b * SEQ + qt * 64 + qi;
            bf16x8 qfa[6], qfb[6];
#pragma unroll
            for (int s = 0; s < 6; ++s) { qfa[s] = *(const bf16x8*)(Qb + (tokq * 8 + h) * 96 + 16 * s + 8 * hi); qfb[s] = *(const bf16x8*)(Qb + ((tokq + 32) * 8 + h) * 96 + 16 * s + 8 * hi); }
            float ma = -1e30f, la = 0.f, mb = -1e30f, lb = 0.f;
            f32x16 oa0, oa1, ob0, ob1;
#pragma unroll
            for (int r = 0; r < 16; ++r) { oa0[r] = 0.f; oa1[r] = 0.f; ob0[r] = 0.f; ob1[r] = 0.f; }
            const bf16_t* kfb = Kab + ((size_t)(b * 8 + h) * 128) * 6 * 512 + lane * 8;
            const bf16_t* vfb = Vt + ((size_t)(b * 8 + h) * 128) * 4 * 512 + lane * 8;
            const int nt = 2 * qt + 2;
#define ATT_GROUP(QF, M_, L_, O0, O1, DIAG) { \
                f32x16 xs; _Pragma("unroll") for (int r = 0; r < 16; ++r) xs[r] = 0.f; \
                _Pragma("unroll") for (int s = 0; s < 6; ++s) xs = mfma32(kf[s], QF[s], xs); \
                if (DIAG) { _Pragma("unroll") for (int r = 0; r < 16; ++r) if (crow(r, hi) > qi) xs[r] = -1e30f; } \
                float mx = xs[0]; _Pragma("unroll") for (int r = 1; r < 16; ++r) mx = fmaxf(mx, xs[r]); \
                mx = fmaxf(mx, __shfl_xor(mx, 32)); \
                if (__any(mx > M_)) { const float mn = fmaxf(M_, mx), alpha = __builtin_amdgcn_exp2f(M_ - mn); L_ *= alpha; M_ = mn; \
                    _Pragma("unroll") for (int r = 0; r < 16; ++r) { O0[r] *= alpha; O1[r] *= alpha; } } \
                float ps = 0.f; _Pragma("unroll") for (int r = 0; r < 16; ++r) { xs[r] = __builtin_amdgcn_exp2f(xs[r] - M_); ps += xs[r]; } \
                L_ += ps; \
                _Pragma("unroll") for (int s = 0; s < 2; ++s) { float t8[8]; _Pragma("unroll") for (int j = 0; j < 8; ++j) t8[j] = xs[8 * s + j]; const bf16x8 pbs = pack8(t8); \
                    O0 = mfma32(vf[0][s], pbs, O0); O1 = mfma32(vf[1][s], pbs, O1); } }
#pragma unroll 1
            for (int kt = 0; kt < nt; ++kt) {
                bf16x8 kf[6], vf[2][2];
#pragma unroll
                for (int s = 0; s < 6; ++s) kf[s] = *(const bf16x8*)(kfb + (size_t)(kt * 6 + s) * 512);
#pragma unroll
                for (int d0 = 0; d0 < 2; ++d0)
#pragma unroll
                    for (int s = 0; s < 2; ++s) vf[d0][s] = *(const bf16x8*)(vfb + (size_t)((kt * 2 + d0) * 2 + s) * 512);
                if (kt < nt - 1) ATT_GROUP(qfa, ma, la, oa0, oa1, kt == nt - 2)
                ATT_GROUP(qfb, mb, lb, ob0, ob1, kt == nt - 1)
            }
#undef ATT_GROUP
            la += __shfl_xor(la, 32); lb += __shfl_xor(lb, 32);
            const float ila = 1.f / la, ilb = 1.f / lb;
            bf16_t* orow = Ob + tokq * 512 + h * 64;
#pragma unroll
            for (int g = 0; g < 4; ++g) {
                st_bf4(orow + 8 * g + 4 * hi, oa0[4 * g] * ila, oa0[4 * g + 1] * ila, oa0[4 * g + 2] * ila, oa0[4 * g + 3] * ila);
                st_bf4(orow + 32 + 8 * g + 4 * hi, oa1[4 * g] * ila, oa1[4 * g + 1] * ila, oa1[4 * g + 2] * ila, oa1[4 * g + 3] * ila);
                st_bf4(orow + (size_t)32 * 512 + 8 * g + 4 * hi, ob0[4 * g] * ilb, ob0[4 * g + 1] * ilb, ob0[4 * g + 2] * ilb, ob0[4 * g + 3] * ilb);
                st_bf4(orow + (size_t)32 * 512 + 32 + 8 * g + 4 * hi, ob1[4 * g] * ilb, ob1[4 * g + 1] * ilb, ob1[4 * g + 2] * ilb, ob1[4 * g + 3] * ilb);
            }
        }
    }
    xcd_barrier(xb);

    {
        PHASE_PTRS
        for (int t = gw; t < T; t += NGW) {
            const int ch = 8 * lane, h = lane >> 3;
            float y[8], v[8], g[8]; ld_bf8(Yb + (size_t)t * 512 + ch, y); ld_bf8(Vb + (size_t)t * 512 + ch, v); ld_bf8(Gtb + (size_t)t * 512 + ch, g);
            float s = 0.f;
#pragma unroll
            for (int i = 0; i < 8; ++i) s += y[i];
            s += __shfl_xor(s, 1); s += __shfl_xor(s, 2); s += __shfl_xor(s, 4);
            const float mu = s * (1.f / 64.f); float q = 0.f;
#pragma unroll
            for (int i = 0; i < 8; ++i) { y[i] -= mu; q += y[i] * y[i]; }
            q += __shfl_xor(q, 1); q += __shfl_xor(q, 2); q += __shfl_xor(q, 4);
            const float rstd = rsqrtf(q * (1.f / 64.f) + 64e-5f);
            const float bo = bonus[(size_t)t * 8 + h];
            const f32x4 lw0 = *(const f32x4*)(rw_ln_w + ch), lw1 = *(const f32x4*)(rw_ln_w + ch + 4), lb0 = *(const f32x4*)(rw_ln_b + ch), lb1 = *(const f32x4*)(rw_ln_b + ch + 4);
            float o[8];
#pragma unroll
            for (int i = 0; i < 8; ++i) { const float lw = i < 4 ? lw0[i & 3] : lw1[i & 3], lb = i < 4 ? lb0[i & 3] : lb1[i & 3]; o[i] = (y[i] * rstd * lw + lb + bo * v[i]) * g[i]; }
            *(bf16x8*)(YA + (size_t)t * 512 + ch) = pack8(o);
        }
    }
    xcd_barrier(xb);

    {
        PHASE_PTRS
        pg8::StaticOrder S; S.init(T, 1024, G, (int)blockIdx.x);
        { pg8::Gemm g{YA, RwoT, T, 1024, 512}; pg8::EpiGate E{MIXED, Gg, 0, 0};
          pg8::gemm_phase<pg8::EpiGate, pg8::StaticOrder, true, true>((PG8_LAS unsigned char*)lds, g, S, E); }
        { pg8::Gemm g{Ob, MwoT, T, 1024, 512}; pg8::EpiGate E{MIXED, Gg, 1024, 1};
          pg8::gemm_phase<pg8::EpiGate, pg8::StaticOrder, true, true>((PG8_LAS unsigned char*)lds, g, S, E); }
    }
    xcd_barrier(xb);

    {
        PHASE_PTRS
        { pg8::Gemm g{MIXED, WoutT, T, 1024, 1024}; pg8::StaticOrder S; S.init(T, 1024, G, (int)blockIdx.x);
          pg8::EpiRes E{x, HB, ss2};
          pg8::gemm_phase<pg8::EpiRes, pg8::StaticOrder, true, true>((PG8_LAS unsigned char*)lds, g, S, E); }
        { const float* pu = kp->in[29]; const float* pv = kp->in[30];
          for (size_t i = (size_t)blockIdx.x * NT + tid; i < (size_t)16384 * 1024 / 16; i += (size_t)G * NT) {
              u32x4 uo, vo;
#pragma unroll
              for (int q = 0; q < 4; ++q) {
                  const f32x4 u = ((const f32x4*)pu)[i * 4 + q]; const f32x4 w = ((const f32x4*)norm2_w)[(i & 63) * 4 + q];
                  uo[q] = pk4_fp8(u.x * w.x * U8_SCALE, u.y * w.y * U8_SCALE, u.z * w.z * U8_SCALE, u.w * w.w * U8_SCALE);
                  const f32x4 v = ((const f32x4*)pv)[i * 4 + q]; vo[q] = pk4_fp8(v.x * V8_SCALE, v.y * V8_SCALE, v.z * V8_SCALE, v.w * V8_SCALE);
              }
              ((u32x4*)UB)[i] = uo;
              { const size_t e = i >> 6; const int d0 = (int)(i & 63) * 16; *(u32x4*)((unsigned char*)VBp + ((size_t)(d0 >> 7) * 16384 + e) * 128 + (d0 & 127)) = vo; } } }
    }
    xcd_barrier(xb);

    {
        PHASE_PTRS
        pg8::Gemm g{HB, PwqT, T, 2048, 1024}; pg8::StaticOrder S; S.init(T, 2048, G, (int)blockIdx.x);
        pg8::EpiScale E{SC, ss2};
        pg8::gemm_phase<pg8::EpiScale, pg8::StaticOrder, true, true>((PG8_LAS unsigned char*)lds, g, S, E);
    }
    xcd_barrier(xb);

    {
        PHASE_PTRS
        const int wp = wave & 3; const bool producer = wave < 4;
        volatile LAS unsigned* pc = (volatile LAS unsigned*)((LAS unsigned char*)lds + LDS_BYTES - 128) + 2 * wp;
        int kq = 0;
        for (int t = blockIdx.x * 4 + wp; t < T; t += G * 4, ++kq) {
            LAS unsigned char* wl = (LAS unsigned char*)lds + wp * 4096 + (kq & 1) * 2048;
            LAS u32x2* tab = (LAS u32x2*)wl;
            const float rs = rsqrtf(ss2[t] * (1.f / DM) + EPS);
            if (producer) {
            if (kq >= 2) { while ((int)pc[1] < kq - 1) __builtin_amdgcn_s_sleep(2); }
            asm volatile("" ::: "memory");
            { float xa[8], xb[8]; ld_bf8(HB + (size_t)t * DM + 16 * lane, xa); ld_bf8(HB + (size_t)t * DM + 16 * lane + 8, xb);
              u32x4 w; w.x = pk4_fp8(xa[0], xa[1], xa[2], xa[3]); w.y = pk4_fp8(xa[4], xa[5], xa[6], xa[7]); w.z = pk4_fp8(xb[0], xb[1], xb[2], xb[3]); w.w = pk4_fp8(xb[4], xb[5], xb[6], xb[7]);
              *(LAS u32x4*)(wl + 1024 + lane * 16) = w; }
#define SORT4(k) { unsigned hi_, lo_; \
                    hi_ = umax2(k[0], k[1]); lo_ = k[0] < k[1] ? k[0] : k[1]; k[0] = hi_; k[1] = lo_; hi_ = umax2(k[2], k[3]); lo_ = k[2] < k[3] ? k[2] : k[3]; k[2] = hi_; k[3] = lo_; \
                    hi_ = umax2(k[0], k[2]); lo_ = k[0] < k[2] ? k[0] : k[2]; k[0] = hi_; k[2] = lo_; hi_ = umax2(k[1], k[3]); lo_ = k[1] < k[3] ? k[1] : k[3]; k[1] = hi_; k[3] = lo_; \
                    hi_ = umax2(k[1], k[2]); lo_ = k[1] < k[2] ? k[1] : k[2]; k[1] = hi_; k[2] = lo_; }
#pragma unroll 1
            for (int hg = 0; hg < 8; hg += 4) {
                unsigned key[4][4], top[4];
#pragma unroll
                for (int q = 0; q < 4; ++q) {
                    const u32x2 w = *(const u32x2*)(SC + (size_t)t * 2048 + (hg + q) * 256 + 4 * lane);
                    const float f[4] = {bflo(w.x), bfhi(w.x), bflo(w.y), bfhi(w.y)};
#pragma unroll
                    for (int c = 0; c < 4; ++c) { unsigned u = __float_as_uint(f[c]); u = (u & 0x80000000u) ? ~u : (u | 0x80000000u); key[q][c] = (u & ~127u) | (unsigned)(127 - (4 * (lane & 31) + c)); }
                    SORT4(key[q])
                    top[q] = 0u;
                }
#pragma unroll 1
                for (int r = 0; r < 16; ++r) {
                    const bool isr = (lane & 31) == r;
#pragma unroll
                    for (int q = 0; q < 4; ++q) {
                        unsigned m = umax16(key[q][0]);
                        { const auto rr = __builtin_amdgcn_permlane16_swap(m, m, false, false); m = umax2(rr[0], rr[1]); }
                        const bool win = key[q][0] == m;
                        key[q][0] = win ? key[q][1] : key[q][0]; key[q][1] = win ? key[q][2] : key[q][1]; key[q][2] = win ? key[q][3] : key[q][2]; key[q][3] = win ? 0u : key[q][3];
                        top[q] = isr ? m : top[q];
                    }
                }
                unsigned ck[4][4], best[4];
#pragma unroll
                for (int q = 0; q < 4; ++q) {
                    float sval; { unsigned u = top[q] & ~127u; u = (u & 0x80000000u) ? (u & 0x7fffffffu) : ~u; sval = __uint_as_float(u); }
                    const float a = __shfl(sval, lane >> 2);
#pragma unroll
                    for (int c = 0; c < 4; ++c) { const float bsc = __shfl(sval, 32 + 4 * (lane & 3) + c); unsigned u = __float_as_uint(a + bsc); u = (u & 0x80000000u) ? ~u : (u | 0x80000000u);
                        ck[q][c] = (u & ~255u) | (unsigned)(255 - ((lane >> 2) * 16 + 4 * (lane & 3) + c)); }
                    SORT4(ck[q])
                    best[q] = 0u;
                }
#pragma unroll 1
                for (int r = 0; r < 16; ++r) {
                    const bool isr = lane == r;
#pragma unroll
                    for (int q = 0; q < 4; ++q) {
                        unsigned m = umax16(ck[q][0]);
                        { const auto rr = __builtin_amdgcn_permlane16_swap(m, m, false, false); m = umax2(rr[0], rr[1]); }
                        { const auto rr = __builtin_amdgcn_permlane32_swap(m, m, false, false); m = umax2(rr[0], rr[1]); }
                        const bool win = ck[q][0] == m;
                        ck[q][0] = win ? ck[q][1] : ck[q][0]; ck[q][1] = win ? ck[q][2] : ck[q][1]; ck[q][2] = win ? ck[q][3] : ck[q][2]; ck[q][3] = win ? 0u : ck[q][3];
                        best[q] = isr ? m : best[q];
                    }
                }
#pragma unroll
                for (int q = 0; q < 4; ++q) {
                    float bs; { unsigned u = best[q] & ~255u; u = (u & 0x80000000u) ? (u & 0x7fffffffu) : ~u; bs = __uint_as_float(u); }
                    const int pos = 255 - (int)(best[q] & 255u);
                    const float bmax = __uint_as_float(rdlane(__float_as_uint(bs), 0));
                    const float e = lane < 16 ? __expf(bs - bmax) : 0.f;
                    const float gate = e / sum16(e);
                    const unsigned t1 = (unsigned)__shfl((int)top[q], (pos >> 4) & 15), t2 = (unsigned)__shfl((int)top[q], 32 + (pos & 15));
                    const unsigned eid = (127u - (t1 & 127u)) * 128u + (127u - (t2 & 127u));
                    if (lane < 16) tab[16 * (hg + q) + lane] = (u32x2){eid, __float_as_uint(gate)};
                }
            }
#undef SORT4
            asm volatile("s_waitcnt lgkmcnt(0)" ::: "memory");
            if (lane == 0) pc[0] = (unsigned)(kq + 1);
            } else {
            while ((int)pc[0] <= kq) __builtin_amdgcn_s_sleep(2);
            asm volatile("" ::: "memory");
            const unsigned char* UB8 = (const unsigned char*)UB; const unsigned char* VB8 = (const unsigned char*)VBp;
            u32x4 ua[16];
            { const unsigned char* up = UB8 + (size_t)tab[fr].x * DM + 16 * fq;
#pragma unroll
              for (int s = 0; s < 16; ++s) ua[s] = *(const u32x4*)(up + 64 * s); }
#pragma unroll 1
            for (int h = 0; h < 8; ++h) {
                u32x4 uc[16];
#pragma unroll
                for (int s = 0; s < 16; ++s) uc[s] = ua[s];
                { const int hn = h + 1 < 8 ? h + 1 : 7; const unsigned char* up = UB8 + (size_t)tab[16 * hn + fr].x * DM + 16 * fq;
#pragma unroll
                  for (int s = 0; s < 16; ++s) ua[s] = *(const u32x4*)(up + 64 * s); }
                f32x4 ac0 = (f32x4){0.f, 0.f, 0.f, 0.f}, ac1 = ac0, ac2 = ac0, ac3 = ac0;
#pragma unroll
                for (int s = 0; s < 16; s += 2) {
                    const u32x4 b0 = *(const LAS u32x4*)(wl + 1024 + 64 * s + 16 * fq), b1 = *(const LAS u32x4*)(wl + 1024 + 64 * (s + 1) + 16 * fq);
                    ac0 = mfma16_fp8((u32x2){uc[s].x, uc[s].y}, (u32x2){b0.x, b0.y}, ac0);
                    ac1 = mfma16_fp8((u32x2){uc[s].z, uc[s].w}, (u32x2){b0.z, b0.w}, ac1);
                    ac2 = mfma16_fp8((u32x2){uc[s + 1].x, uc[s + 1].y}, (u32x2){b1.x, b1.y}, ac2);
                    ac3 = mfma16_fp8((u32x2){uc[s + 1].z, uc[s + 1].w}, (u32x2){b1.z, b1.w}, ac3);
                }
                const f32x4 acc = (ac0 + ac1) + (ac2 + ac3);
                const int j = fr & 3;
                const float d = (j == 0 ? acc[0] : (j == 1 ? acc[1] : (j == 2 ? acc[2] : acc[3]))) * (rs * (1.f / U8_SCALE));
                const float act = 0.5f * d * (1.f + erff(d * 0.7071067811865476f));
                if (fr < 4) { const int i = 16 * h + 4 * fq + fr; const float g = __uint_as_float(tab[i].y); tab[i].y = __float_as_uint(g * act * (1.f / V8_SCALE)); }
            }
            asm volatile("s_waitcnt lgkmcnt(0)" ::: "memory");
            {
                const u32x4 tv = *(const LAS u32x4*)(wl + lane * 16);
                LAS unsigned char* tq = wl + 1024; const int r0 = 2 * (lane & 3), l0 = lane >> 2;
                *(LAS unsigned short*)(tq + (r0 * 16 + l0) * 2) = (unsigned short)tv.x; *(LAS unsigned short*)(tq + ((r0 + 1) * 16 + l0) * 2) = (unsigned short)tv.z;
                const float c0 = fminf(fmaxf(__uint_as_float(tv.y) * C8_SCALE, -440.f), 440.f), c1 = fminf(fmaxf(__uint_as_float(tv.w) * C8_SCALE, -440.f), 440.f);
                const unsigned c8 = (unsigned)__builtin_amdgcn_cvt_pk_fp8_f32(c0, c1, 0, false);
                *(tq + 256 + r0 * 16 + l0) = (unsigned char)(c8 & 0xffu); *(tq + 256 + (r0 + 1) * 16 + l0) = (unsigned char)((c8 >> 8) & 0xffu);
                asm volatile("s_waitcnt lgkmcnt(0)" ::: "memory");
                if (lane < 24) { const u32x4 o = *(const LAS u32x4*)(tq + lane * 16); *(u32x4*)(ws + WS_TAB + (size_t)t * 384 + lane * 16) = o; }
            }
            asm volatile("s_waitcnt lgkmcnt(0)" ::: "memory");
            if (lane == 0) pc[1] = (unsigned)(kq + 1);
            }
        }
    }
    xcd_barrier(xb);

    {
        PHASE_PTRS
        const unsigned sl = blockIdx.x & 7;
        const unsigned char* VS = (const unsigned char*)VBp + (size_t)sl * 16384 * 128;
        const int rho = lane >> 3, chi = lane & 7;
        constexpr float CSCALE = C8_SCALE;
        unsigned selLo[4], selHi[4];
#pragma unroll
        for (int k = 0; k < 4; ++k) { const unsigned sh = 8u * (unsigned)(chi & 3); const unsigned v = (0x0c0c0c0cu & ~(0xffu << sh)) | ((unsigned)k << sh);
            selLo[k] = chi < 4 ? v : 0x0c0c0c0cu; selHi[k] = chi < 4 ? 0x0c0c0c0cu : v; }
        const bool olane = (lane & 0x28) == 0;
        const unsigned voff0 = 16u * (unsigned)chi;
        LAS unsigned char* wl8 = (LAS unsigned char*)lds + wave * 6144;
        const int wstride = (G >> 3) * NWAVES, tg0 = (blockIdx.x >> 3) * NWAVES + wave;
        const int nb = tg0 < T / 8 ? (T / 8 - tg0 + wstride - 1) / wstride : 0, ntok = nb * 8;
#define P6C_TOK(i_) ((tg0 + ((i_) >> 3) * wstride) * 8 + ((i_) & 7))
#define P6C_DMA(b_) { _Pragma("unroll") for (int k = 0; k < 3; ++k) __builtin_amdgcn_global_load_lds((const unsigned*)(ws + WS_TAB + (size_t)((tg0 + (b_) * wstride) * 8) * 384 + k * 1024 + lane * 16), (LAS unsigned*)(wl8 + ((b_) & 1) * 3072 + k * 1024), 16, 0, 0); }
#define P6C_TAB(EL, EH, CW, i_) { const int ii_ = (i_) < ntok ? (i_) : ntok - 1; const LAS unsigned char* tq_ = wl8 + ((ii_ >> 3) & 1) * 3072 + (ii_ & 7) * 384; \
            EL = *(const LAS u32x4*)(tq_ + rho * 32); EH = *(const LAS u32x4*)(tq_ + rho * 32 + 16); CW = *(const LAS u32x4*)(tq_ + 256 + rho * 16); }
#define P6C_EID(ER, j_) (((j_) & 1) ? (ER[(j_) >> 1] >> 16) : (ER[(j_) >> 1] & 0xffffu))
#define P6C_LOAD(VV, ER) { _Pragma("unroll") for (int j = 0; j < 8; ++j) VV[j] = *(const u32x4*)(VS + (size_t)((P6C_EID(ER, j) << 7) | voff0)); }
#define P6C_USE(VV, CWA, CWB) { _Pragma("unroll") for (int j = 0; j < 8; ++j) { const unsigned cwd = (j < 4) ? CWA : CWB; \
            u32x2 xo; xo.x = __builtin_amdgcn_perm(cwd, cwd, selLo[j & 3]); xo.y = __builtin_amdgcn_perm(cwd, cwd, selHi[j & 3]); \
            acc0 = mfma16_fp8(xo, (u32x2){VV[j].x, VV[j].y}, acc0); acc1 = mfma16_fp8(xo, (u32x2){VV[j].z, VV[j].w}, acc1); } }
#define P6C_BODY(i_, VA, VB, EL, EH, CW, VBo, EHo) { \
            const size_t oo_ = (size_t)P6C_TOK(i_) * DM + 128 * sl + 16 * chi + 4 * ((lane >> 4) & 1); float* orow = kp->out + oo_; \
            u32x2 hw0 = (u32x2){0u, 0u}, hw1 = hw0; \
            if (olane) { hw0 = *(const u32x2*)(HB + oo_); hw1 = *(const u32x2*)(HB + oo_ + 8); }        \
            P6C_LOAD(VBo, EHo)                                     \
            const u32x4 cwq = CW; \
            __builtin_amdgcn_sched_barrier(0); \
            f32x4 acc0 = (f32x4){0.f, 0.f, 0.f, 0.f}, acc1 = acc0; \
            P6C_USE(VA, cwq.x, cwq.y) \
            __builtin_amdgcn_sched_barrier(0); \
            P6C_TAB(EL, EH, CW, (i_) + 2) \
            P6C_LOAD(VA, EL)                                       \
            __builtin_amdgcn_sched_barrier(0); \
            P6C_USE(VB, cwq.z, cwq.w) \
            float s[8]; \
            _Pragma("unroll") for (int r = 0; r < 4; ++r) {        \
                { const auto rr = __builtin_amdgcn_permlane32_swap(__float_as_uint(acc0[r]), __float_as_uint(acc0[r]), false, false); s[r] = acc0[r] + dpp_f<0x128>(__uint_as_float(rr[1])); } \
                { const auto rr = __builtin_amdgcn_permlane32_swap(__float_as_uint(acc1[r]), __float_as_uint(acc1[r]), false, false); s[4 + r] = acc1[r] + dpp_f<0x128>(__uint_as_float(rr[1])); } } \
            if (olane) { const f32x4 h0 = (f32x4){bflo(hw0.x), bfhi(hw0.x), bflo(hw0.y), bfhi(hw0.y)}, h1 = (f32x4){bflo(hw1.x), bfhi(hw1.x), bflo(hw1.y), bfhi(hw1.y)}; \
                *(f32x4*)orow = h0 + (f32x4){s[0], s[1], s[2], s[3]} * (1.f / CSCALE); *(f32x4*)(orow + 8) = h1 + (f32x4){s[4], s[5], s[6], s[7]} * (1.f / CSCALE); } \
            __builtin_amdgcn_sched_barrier(0); }
        if (nb > 0) {
            u32x4 vA0[8], vB0[8], vA1[8], vB1[8];
            u32x4 eL0, eH0, cw0, eL1, eH1, cw1;
            P6C_DMA(0)
            if (nb > 1) P6C_DMA(1)
            asm volatile("s_waitcnt vmcnt(0)" ::: "memory");
            P6C_TAB(eL0, eH0, cw0, 0)
            P6C_LOAD(vA0, eL0)
            P6C_LOAD(vB0, eH0)
            P6C_TAB(eL1, eH1, cw1, 1)
            P6C_LOAD(vA1, eL1)
#pragma unroll 1
            for (int i = 0; i < ntok; i += 2) {
                if ((i & 7) == 0 && i > 0 && (i >> 3) + 1 < nb) P6C_DMA((i >> 3) + 1)
                if ((i & 7) == 4) asm volatile("s_waitcnt vmcnt(40)" ::: "memory");
                P6C_BODY(i, vA0, vB0, eL0, eH0, cw0, vB1, eH1)
                P6C_BODY(i + 1, vA1, vB1, eL1, eH1, cw1, vB0, eH0)
            }
            asm volatile("s_waitcnt vmcnt(0) lgkmcnt(0)" ::: "memory");
        }
#undef P6C_BODY
#undef P6C_USE
#undef P6C_LOAD
#undef P6C_EID
#undef P6C_TAB
#undef P6C_DMA
#undef P6C_TOK
    }
}

extern "C" void kernel_launch(void* const* d_in, const int* in_sizes, int n_in, void* d_out, int out_size,
                              void* d_ws, size_t ws_size, hipStream_t stream) {
    static int grid_blocks = 0;
    if (!grid_blocks) {
        int dev = 0, cus = 0, per_cu = 0;
        (void)hipGetDevice(&dev);
        (void)hipDeviceGetAttribute(&cus, hipDeviceAttributeMultiprocessorCount, dev);
        (void)hipFuncSetAttribute((const void*)mega, hipFuncAttributeMaxDynamicSharedMemorySize, LDS_BYTES);
        (void)hipOccupancyMaxActiveBlocksPerMultiprocessor(&per_cu, (const void*)mega, NT, LDS_BYTES);
        if (per_cu < 1) per_cu = 1;
        if (per_cu > 1) per_cu = 1;
        grid_blocks = cus * per_cu;
        if (ws_size < 256 * MiB) fprintf(stderr, "kernel_launch: workspace too small: %zu\n", ws_size);
    }
    Params p{};
    for (int i = 0; i < 31; ++i) p.in[i] = (const float*)d_in[i];
    p.out = (float*)d_out;
    p.ws = (unsigned char*)d_ws;
    void* args[] = {&p};
    hipError_t e = hipLaunchCooperativeKernel((const void*)mega, dim3(grid_blocks), dim3(NT), args, LDS_BYTES, stream);
    if (e != hipSuccess) fprintf(stderr, "cooperative launch failed: %s (grid %d)\n", hipGetErrorString(e), grid_blocks);
}
```

```cpp
#include <hip/hip_runtime.h>
#include <hip/hip_cooperative_groups.h>
#include <cstdio>
#include <cstdint>
namespace cg = cooperative_groups;

#define DEVI __device__ __forceinline__
typedef unsigned short bf16_t;
typedef short bf16x8 __attribute__((ext_vector_type(8)));
typedef float f32x4 __attribute__((ext_vector_type(4)));
typedef float f32x16 __attribute__((ext_vector_type(16)));
typedef unsigned u32x2 __attribute__((ext_vector_type(2)));
typedef unsigned u32x4 __attribute__((ext_vector_type(4)));

constexpr int T = 16384, SEQ = 4096, DM = 1024;
constexpr int NWAVES = 8, NT = 512;
constexpr int LDS_BYTES = 147456;
constexpr float EPS = 1e-6f;
constexpr float LOG2E = 1.4426950408889634f;
constexpr float QSCALE = 0.10206207261596575f * 1.4426950408889634f;

constexpr size_t MiB = 1u << 20;
constexpr size_t WS_SS2 = 0;
constexpr size_t WS_CNT = 512 * 1024;
constexpr size_t WS_SSQ = 64 * 1024, WS_SSKV = 128 * 1024;
constexpr size_t WS_WIN = 1 * MiB;
constexpr size_t WS_WUQ = 10 * MiB + 512 * 1024;
constexpr size_t WS_WUKV = 11 * MiB + 256 * 1024;
constexpr size_t WS_RWO = 12 * MiB;
constexpr size_t WS_MWO = 13 * MiB;
constexpr size_t WS_WOUT = 14 * MiB;
constexpr size_t WS_PWQ = 16 * MiB;
constexpr size_t WS_SUBK = 20 * MiB;
constexpr size_t WS_W2T = 20 * MiB + 512 * 1024;
constexpr size_t WS_A2T = WS_W2T + 64 * 1024;
constexpr size_t WS_G2T = WS_A2T + 64 * 1024;
constexpr size_t WS_G = 24 * MiB;
constexpr size_t WS_UB = 56 * MiB, WS_VB = 72 * MiB;
constexpr size_t WS_SC = 176 * MiB;
constexpr size_t WS_PRW = 88 * MiB;
constexpr size_t WS_Q = 88 * MiB, WS_K = 112 * MiB, WS_VT = 136 * MiB;
constexpr size_t WS_HB = 88 * MiB;
constexpr size_t WS_QD = 152 * MiB, WS_KVD = 164 * MiB, WS_KPE = 172 * MiB;
constexpr size_t WS_O = 152 * MiB;
constexpr size_t WS_R = 176 * MiB, WS_W = 192 * MiB, WS_KS = 208 * MiB, WS_V = 224 * MiB, WS_KK = 240 * MiB;
constexpr size_t WS_YA = 176 * MiB;
constexpr size_t WS_MIXED = 192 * MiB;
constexpr size_t WS_PQ = 184 * MiB;
constexpr size_t WS_TAB = 240 * MiB;
constexpr size_t DO_XN = 0;
constexpr size_t DO_BV = 0, DO_GT = 16 * MiB, DO_BONUS = 32 * MiB, DO_Y = 33 * MiB, DO_KRAW = 33 * MiB, DO_GL = 50 * MiB;

struct Params {
    const float* in[31];
    float* out;
    unsigned char* ws;
};

DEVI unsigned f2bf(float f) { unsigned u = __float_as_uint(f); return (u + 0x7fffu + ((u >> 16) & 1u)) >> 16; }
typedef float f32x2_t __attribute__((ext_vector_type(2)));
typedef __bf16 bf16x2_t __attribute__((ext_vector_type(2)));
DEVI unsigned pk2(float lo, float hi) { f32x2_t v = {lo, hi}; bf16x2_t b = __builtin_convertvector(v, bf16x2_t); return __builtin_bit_cast(unsigned, b); }
DEVI float bflo(unsigned u) { return __uint_as_float(u << 16); }
DEVI float bfhi(unsigned u) { return __uint_as_float(u & 0xffff0000u); }
DEVI float bf1(bf16_t u) { return __uint_as_float(((unsigned)u) << 16); }
DEVI float wave_sum(float v) {
#pragma unroll
    for (int o = 32; o >= 1; o >>= 1) v += __shfl_xor(v, o);
    return v;
}
DEVI float sigmoidf_(float x) { return __builtin_amdgcn_rcpf(1.f + __builtin_amdgcn_exp2f(-1.4426950408889634f * x)); }
DEVI float tanhf_(float x) { return 1.f - 2.f * __builtin_amdgcn_rcpf(__builtin_amdgcn_exp2f(2.885390081777927f * x) + 1.f); }
DEVI void st_bf4(bf16_t* p, float a, float b, float c, float d) { u32x2 w; w.x = pk2(a, b); w.y = pk2(c, d); *(u32x2*)p = w; }
DEVI void ld_bf4(const bf16_t* p, float (&o)[4]) { u32x2 w = *(const u32x2*)p; o[0] = bflo(w.x); o[1] = bfhi(w.x); o[2] = bflo(w.y); o[3] = bfhi(w.y); }
DEVI void ld_bf8(const bf16_t* p, float (&o)[8]) { u32x4 w = *(const u32x4*)p; o[0] = bflo(w.x); o[1] = bfhi(w.x); o[2] = bflo(w.y); o[3] = bfhi(w.y); o[4] = bflo(w.z); o[5] = bfhi(w.z); o[6] = bflo(w.w); o[7] = bfhi(w.w); }
DEVI bf16x8 pack8(const float (&v)[8]) { u32x4 w; w.x = pk2(v[0], v[1]); w.y = pk2(v[2], v[3]); w.z = pk2(v[4], v[5]); w.w = pk2(v[6], v[7]); return __builtin_bit_cast(bf16x8, w); }
DEVI f32x4 mfma16(bf16x8 a, bf16x8 b, f32x4 c) { return __builtin_amdgcn_mfma_f32_16x16x32_bf16(a, b, c, 0, 0, 0); }
DEVI f32x16 mfma32(bf16x8 a, bf16x8 b, f32x16 c) { return __builtin_amdgcn_mfma_f32_32x32x16_bf16(a, b, c, 0, 0, 0); }
DEVI int crow(int r, int hi) { return (r & 3) + 8 * (r >> 2) + 4 * hi; }


template <int CTRL> DEVI float dpp_f(float v) { return __builtin_bit_cast(float, __builtin_amdgcn_update_dpp(0, __builtin_bit_cast(int, v), CTRL, 0xf, 0xf, true)); }
template <int CTRL> DEVI unsigned dpp_u(unsigned v) { return (unsigned)__builtin_amdgcn_update_dpp(0, (int)v, CTRL, 0xf, 0xf, true); }
DEVI float sum8(float v) { v += dpp_f<0xB1>(v); v += dpp_f<0x4E>(v); v += dpp_f<0x141>(v); return v; }
DEVI float sum16(float v) { v = sum8(v); v += dpp_f<0x140>(v); return v; }
DEVI unsigned umax2(unsigned a, unsigned b) { return a > b ? a : b; }
DEVI unsigned umax16(unsigned v) { v = umax2(v, dpp_u<0xB1>(v)); v = umax2(v, dpp_u<0x4E>(v)); v = umax2(v, dpp_u<0x141>(v)); v = umax2(v, dpp_u<0x140>(v)); return v; }
DEVI unsigned rdlane(unsigned v, int l) { return (unsigned)__builtin_amdgcn_readlane((int)v, l); }
#define LAS __attribute__((address_space(3)))

DEVI unsigned pk4_fp8(float a, float b, float c, float d) { int w = 0; w = __builtin_amdgcn_cvt_pk_fp8_f32(a, b, w, false); w = __builtin_amdgcn_cvt_pk_fp8_f32(c, d, w, true); return (unsigned)w; }
DEVI f32x4 mfma16_fp8(u32x2 a, u32x2 b, f32x4 c) { return __builtin_amdgcn_mfma_f32_16x16x32_fp8_fp8(__builtin_bit_cast(long, a), __builtin_bit_cast(long, b), c, 0, 0, 0); }
DEVI unsigned pk4_u8(float a, float b, float c, float d) { unsigned w = 0; w = __builtin_amdgcn_cvt_pk_u8_f32(a, 0, w); w = __builtin_amdgcn_cvt_pk_u8_f32(b, 1, w); w = __builtin_amdgcn_cvt_pk_u8_f32(c, 2, w); w = __builtin_amdgcn_cvt_pk_u8_f32(d, 3, w); return w; }
constexpr float U8_SCALE = 32.f, V8_SCALE = 4.f;
constexpr float C8_SCALE = 256.f;

template <int OFF> DEVI f32x4 lds_rd128(unsigned a) { f32x4 r; asm volatile("ds_read_b128 %0, %1 offset:%2" : "=v"(r) : "v"(a), "i"(OFF)); return r; }
template <int OFF> DEVI float lds_rd32(unsigned a) { float r; asm volatile("ds_read_b32 %0, %1 offset:%2" : "=v"(r) : "v"(a), "i"(OFF)); return r; }
DEVI void lds_wr32(unsigned a, float v) { asm volatile("ds_write_b32 %0, %1" ::"v"(a), "v"(v) : "memory"); }

#define SW64(r, k) ((r) * 64 + (((((k) >> 3) ^ ((r) & 7))) << 3) + ((k) & 7))
#define SW32(r, c) ((r) * 32 + (((((c) >> 3) ^ (((r) >> 2) & 3))) << 3) + ((c) & 7))
DEVI int swz_off(int r, int chunk, int ld) { return ld == 64 ? r * 64 + ((chunk ^ (r & 7)) << 3) : r * 32 + ((chunk ^ ((r >> 2) & 3)) << 3); }
template <int MT, int NTL, int KS>
DEVI void gemm_lds(const LAS bf16_t* A, int lda, const LAS bf16_t* B, int ldb, f32x4 (&acc)[MT][NTL], int fr, int fq) {
#pragma unroll
    for (int ks = 0; ks < KS; ++ks) {
        bf16x8 a[MT], b[NTL];
#pragma unroll
        for (int m = 0; m < MT; ++m) a[m] = *(const LAS bf16x8*)(A + swz_off(16 * m + fr, 4 * ks + fq, lda));
#pragma unroll
        for (int n = 0; n < NTL; ++n) b[n] = *(const LAS bf16x8*)(B + swz_off(16 * n + fr, 4 * ks + fq, ldb));
#pragma unroll
        for (int m = 0; m < MT; ++m)
#pragma unroll
            for (int n = 0; n < NTL; ++n) acc[m][n] = mfma16(b[n], a[m], acc[m][n]);
    }
}
DEVI bf16_t bf1of(float x) { return (bf16_t)(pk2(x, x) & 0xffffu); }
DEVI void gemm_tile_acc(const bf16_t* __restrict__ A, int lda, const bf16_t* __restrict__ Bt, int ldb, int K, int m0, int n0, int lane, f32x4 (&acc)[4][4]) {
    const int fr = lane & 15, fq = lane >> 4;
    const bf16_t* ap = A + (size_t)(m0 + fr) * lda + fq * 8;
    const bf16_t* bp = Bt + (size_t)(n0 + fr) * ldb + fq * 8;
#pragma unroll 2
    for (int k0 = 0; k0 < K; k0 += 32) {
        bf16x8 a[4], b[4];
#pragma unroll
        for (int m = 0; m < 4; ++m) a[m] = *(const bf16x8*)(ap + (size_t)m * 16 * lda + k0);
#pragma unroll
        for (int n = 0; n < 4; ++n) b[n] = *(const bf16x8*)(bp + (size_t)n * 16 * ldb + k0);
#pragma unroll
        for (int m = 0; m < 4; ++m)
#pragma unroll
            for (int n = 0; n < 4; ++n) acc[m][n] = mfma16(b[n], a[m], acc[m][n]);
    }
}
DEVI void zero_acc(f32x4 (&acc)[4][4]) {
#pragma unroll
    for (int m = 0; m < 4; ++m)
#pragma unroll
        for (int n = 0; n < 4; ++n) acc[m][n] = (f32x4){0.f, 0.f, 0.f, 0.f};
}


namespace pg8 {
#define PG8_LAS __attribute__((address_space(3)))
typedef unsigned short bf16_t;
typedef short bf16x8 __attribute__((ext_vector_type(8)));
typedef float f32x4 __attribute__((ext_vector_type(4)));
typedef unsigned u32x4 __attribute__((ext_vector_type(4)));
constexpr int BM = 256, BK = 64, HALF = 128, HTB = HALF * BK * 2  , STAGE_BYTES = 8 * HTB, NXCD = 8, WGM = 8;

__host__ __device__ __forceinline__ int lds_byte(int r, int c) { const int st = (r >> 4) * 2 + (c >> 5), rr = r & 15, cc = c & 31, ob = rr * 64 + cc * 2; return st * 1024 + (ob ^ (((ob >> 9) & 1) << 5)); }
__host__ __device__ __forceinline__ void stage_rc(int b, int& R, int& C) { const int st = b / 1024, sb = b % 1024, swz = sb ^ (((sb >> 9) & 1) << 5); R = (st >> 1) * 16 + swz / 64; C = (st & 1) * 32 + (swz % 64) / 2; }
__host__ __device__ __forceinline__ int perm32(int rho) { const int n = rho >> 4, i = rho & 15; return 8 * (i >> 2) + 4 * n + (i & 3); }

struct Unit { int pm, pn; };
struct Gemm { const bf16_t* A; const bf16_t* Bt; int M, N, K; };

struct StaticOrder {
    int nM, nN, nwg, G, c;
    __host__ __device__ void init(int M, int N, int G_, int c_) { nM = M / BM; nN = N / BM; nwg = nM * nN; G = G_; c = c_; }
    __host__ __device__ bool next(int i, Unit& u) const {
        const long L = (long)i * G + c; if (L >= nwg) return false;
        int wgid = (int)L; { const int q = nwg / NXCD, r = nwg % NXCD, xcd = wgid % NXCD, off = wgid / NXCD; wgid = (xcd < r ? xcd * (q + 1) : r * (q + 1) + (xcd - r) * q) + off; }
        const int nig = WGM * nN, gid = wgid / nig, fm = gid * WGM, gsz = (nM - fm) < WGM ? (nM - fm) : WGM;
        u.pm = fm + ((wgid % nig) % gsz); u.pn = (wgid % nig) / gsz; return true;
    }
    __device__ __forceinline__ void a_ready(const Unit&) const {}
    __device__ __forceinline__ void done(const Unit&) const {}
};


DEVI float sigm(float x) { return __builtin_amdgcn_rcpf(1.f + __builtin_amdgcn_exp2f(-1.4426950408889634f * x)); }
DEVI u32x4 pack8v(f32x4 a, f32x4 b) { u32x4 w; w.x = pk2(a[0], a[1]); w.y = pk2(a[2], a[3]); w.z = pk2(b[0], b[1]); w.w = pk2(b[2], b[3]); return w; }
struct EpiP1 {
    static constexpr bool PERM = true, AFTER_DRAIN = false;
    unsigned char* ws;
    __device__ __forceinline__ void operator()(const f32x4 (&acc)[2][2][4][2], const Unit& u, int wr, int wc, int fr_in, int fq_in) const {
        int fr = fr_in, fq = fq_in; asm volatile("" : "+v"(fr), "+v"(fq));
        const int row0 = u.pm * BM + wr * 64 + fr;
        if (u.pn >= 8 && u.pn < 11) {
#pragma unroll
            for (int bj = 0; bj < 2; ++bj) {
                const int c = (u.pn - 8) * 256 + bj * HALF + wc * 32 + 8 * fq;
                const size_t off = c < 384 ? WS_QD : (c < 640 ? WS_KVD : WS_KPE);
                const int ld = c < 384 ? 384 : (c < 640 ? 256 : 32), cc = c < 384 ? c : (c < 640 ? c - 384 : c - 640);
                if (c < 672) {
#pragma unroll
                    for (int ai = 0; ai < 2; ++ai)
#pragma unroll
                        for (int m = 0; m < 4; ++m) { const size_t row = (size_t)(row0 + ai * HALF + m * 16);
                            *(u32x4*)(ws + off + (row * ld + cc) * 2) = pack8v(acc[ai][bj][m][0], acc[ai][bj][m][1]); }
                }
            }
            return;
        }
        if (u.pn >= 11) {
            const int col0 = (u.pn - 11) * 256 + wc * 32 + 8 * fq;
#pragma unroll
            for (int ai = 0; ai < 2; ++ai)
#pragma unroll
                for (int m = 0; m < 4; ++m) { unsigned char* rowp = ws + WS_G + ((size_t)(row0 + ai * HALF + m * 16) * 2048 + col0);
#pragma unroll
                    for (int bj = 0; bj < 2; ++bj) { const f32x4 v0 = acc[ai][bj][m][0], v1 = acc[ai][bj][m][1];
                        u32x2 w; w.x = pk4_u8(sigm(v0[0]) * 255.f, sigm(v0[1]) * 255.f, sigm(v0[2]) * 255.f, sigm(v0[3]) * 255.f);
                        w.y = pk4_u8(sigm(v1[0]) * 255.f, sigm(v1[1]) * 255.f, sigm(v1[2]) * 255.f, sigm(v1[3]) * 255.f);
                        *(u32x2*)(rowp + bj * HALF) = w; } }
            return;
        }
        const int col0 = u.pn * 256 + wc * 32 + 8 * fq;
#pragma unroll
        for (int ai = 0; ai < 2; ++ai)
#pragma unroll
            for (int m = 0; m < 4; ++m) { unsigned char* rowp = ws + WS_PRW + ((size_t)(row0 + ai * HALF + m * 16) * 2048 + col0) * 2;
#pragma unroll
                for (int bj = 0; bj < 2; ++bj) *(u32x4*)(rowp + bj * HALF * 2) = pack8v(acc[ai][bj][m][0], acc[ai][bj][m][1]); }
    }
};
struct EpiQraw {
    static constexpr bool PERM = true, AFTER_DRAIN = false;
    bf16_t* q; const float* ssq;
    __device__ __forceinline__ void operator()(const f32x4 (&acc)[2][2][4][2], const Unit& u, int wr, int wc, int fr_in, int fq_in) const {
        int fr = fr_in, fq = fq_in; asm volatile("" : "+v"(fr), "+v"(fq));
        const int row0 = u.pm * BM + wr * 64 + fr, col0 = u.pn * BM + wc * 32 + 8 * fq;
#pragma unroll
        for (int ai = 0; ai < 2; ++ai)
#pragma unroll
            for (int m = 0; m < 4; ++m) { const size_t row = (size_t)(row0 + ai * HALF + m * 16); const float rs = ssq[row];
#pragma unroll
                for (int bj = 0; bj < 2; ++bj) *(u32x4*)(q + row * 768 + col0 + bj * HALF) = pack8v(acc[ai][bj][m][0] * rs, acc[ai][bj][m][1] * rs); }
    }
};
struct EpiKVraw {
    static constexpr bool PERM = true, AFTER_DRAIN = false;
    bf16_t* kraw; bf16_t* vt; const float* sskv;
    __device__ __forceinline__ void operator()(const f32x4 (&acc)[2][2][4][2], const Unit& u, int wr, int wc, int fr_in, int fq_in) const {
        int fr = fr_in, fq = fq_in; asm volatile("" : "+v"(fr), "+v"(fq));
        const int row0 = u.pm * BM + wr * 64 + fr;
#pragma unroll
        for (int ai = 0; ai < 2; ++ai)
#pragma unroll
            for (int m = 0; m < 4; ++m) { const int row = row0 + ai * HALF + m * 16; const float rs = sskv[row];
#pragma unroll
                for (int bj = 0; bj < 2; ++bj) { const f32x4 v0 = acc[ai][bj][m][0] * rs, v1 = acc[ai][bj][m][1] * rs;
                    if (u.pn < 2) *(u32x4*)(kraw + (size_t)row * 512 + u.pn * BM + bj * HALF + wc * 32 + 8 * fq) = pack8v(v0, v1);
                    else { const int c = (u.pn - 2) * BM + bj * HALF + wc * 32 + 8 * fq, h = c >> 6, d = c & 63; const int bb = row >> 12, s = row & 4095;
                        const int kt = s >> 5, k4 = s & 15, jj = 4 * (k4 >> 3) + (k4 & 3), hv = (k4 >> 2) & 1;
                        bf16_t* vp = vt + ((((size_t)(bb * 8 + h) * 128 + kt) * 2 + (d >> 5)) * 2 + ((s >> 4) & 1)) * 512 + ((d & 31) + 32 * hv) * 8 + jj; const u32x4 w = pack8v(v0, v1);
                        vp[0] = (bf16_t)(w.x & 0xffffu); vp[8] = (bf16_t)(w.x >> 16); vp[16] = (bf16_t)(w.y & 0xffffu); vp[24] = (bf16_t)(w.y >> 16);
                        vp[32] = (bf16_t)(w.z & 0xffffu); vp[40] = (bf16_t)(w.z >> 16); vp[48] = (bf16_t)(w.w & 0xffffu); vp[56] = (bf16_t)(w.w >> 16); } } }
    }
};
struct EpiGate {
    static constexpr bool PERM = true, AFTER_DRAIN = false;
    bf16_t* mixed; const unsigned char* gg; int goff; int add;
    __device__ __forceinline__ void operator()(const f32x4 (&acc)[2][2][4][2], const Unit& u, int wr, int wc, int fr_in, int fq_in) const {
        int fr = fr_in, fq = fq_in; asm volatile("" : "+v"(fr), "+v"(fq));
        const int row0 = u.pm * BM + wr * 64 + fr, col0 = u.pn * BM + wc * 32 + 8 * fq;
#pragma unroll
        for (int ai = 0; ai < 2; ++ai)
#pragma unroll
            for (int m = 0; m < 4; ++m) { const size_t row = (size_t)(row0 + ai * HALF + m * 16);
#pragma unroll
                for (int bj = 0; bj < 2; ++bj) { const int col = col0 + bj * HALF;
                    const u32x2 gw = *(const u32x2*)(gg + row * 2048 + goff + col);
                    const f32x4 g0 = (f32x4){(float)(gw.x & 0xffu), (float)((gw.x >> 8) & 0xffu), (float)((gw.x >> 16) & 0xffu), (float)(gw.x >> 24)};
                    const f32x4 g1 = (f32x4){(float)(gw.y & 0xffu), (float)((gw.y >> 8) & 0xffu), (float)((gw.y >> 16) & 0xffu), (float)(gw.y >> 24)};
                    f32x4 v0 = g0 * (acc[ai][bj][m][0] * (1.f / 255.f)), v1 = g1 * (acc[ai][bj][m][1] * (1.f / 255.f));
                    if (add) { const u32x4 pw = *(const u32x4*)(mixed + row * 1024 + col);
                        v0 += (f32x4){__uint_as_float(pw.x << 16), __uint_as_float(pw.x & 0xffff0000u), __uint_as_float(pw.y << 16), __uint_as_float(pw.y & 0xffff0000u)};
                        v1 += (f32x4){__uint_as_float(pw.z << 16), __uint_as_float(pw.z & 0xffff0000u), __uint_as_float(pw.w << 16), __uint_as_float(pw.w & 0xffff0000u)}; }
                    *(u32x4*)(mixed + row * 1024 + col) = pack8v(v0, v1); } }
    }
};
struct EpiRes {
    static constexpr bool PERM = true, AFTER_DRAIN = false;
    const float* x; bf16_t* hb; float* ss2;
    __device__ __forceinline__ void operator()(const f32x4 (&acc)[2][2][4][2], const Unit& u, int wr, int wc, int fr_in, int fq_in) const {
        int fr = fr_in, fq = fq_in; asm volatile("" : "+v"(fr), "+v"(fq));
        const int row0 = u.pm * BM + wr * 64 + fr, col0 = u.pn * BM + wc * 32 + 8 * fq;
#pragma unroll
        for (int ai = 0; ai < 2; ++ai)
#pragma unroll
            for (int m = 0; m < 4; ++m) { const size_t row = (size_t)(row0 + ai * HALF + m * 16); float sq = 0.f;
#pragma unroll
                for (int bj = 0; bj < 2; ++bj) { const size_t o = row * 1024 + col0 + bj * HALF;
                    const f32x4 h0 = *(const f32x4*)(x + o) + acc[ai][bj][m][0], h1 = *(const f32x4*)(x + o + 4) + acc[ai][bj][m][1];
                    *(u32x4*)(hb + o) = pack8v(h0, h1);
                    sq += (h0[0] * h0[0] + h0[1] * h0[1]) + (h0[2] * h0[2] + h0[3] * h0[3]) + (h1[0] * h1[0] + h1[1] * h1[1]) + (h1[2] * h1[2] + h1[3] * h1[3]); }
                sq += __shfl_xor(sq, 16); sq += __shfl_xor(sq, 32);
                if (fq == 0) atomicAdd(ss2 + row, sq); }
    }
};
struct EpiScale {
    static constexpr bool PERM = true, AFTER_DRAIN = false;
    bf16_t* pq; const float* ss2;
    __device__ __forceinline__ void operator()(const f32x4 (&acc)[2][2][4][2], const Unit& u, int wr, int wc, int fr_in, int fq_in) const {
        int fr = fr_in, fq = fq_in; asm volatile("" : "+v"(fr), "+v"(fq));
        const int row0 = u.pm * BM + wr * 64 + fr, col0 = u.pn * BM + wc * 32 + 8 * fq;
#pragma unroll
        for (int ai = 0; ai < 2; ++ai)
#pragma unroll
            for (int m = 0; m < 4; ++m) { const size_t row = (size_t)(row0 + ai * HALF + m * 16); const float rs = rsqrtf(ss2[row] * (1.f / 1024.f) + 1e-6f);
#pragma unroll
                for (int bj = 0; bj < 2; ++bj) *(u32x4*)(pq + row * 2048 + col0 + bj * HALF) = pack8v(acc[ai][bj][m][0] * rs, acc[ai][bj][m][1] * rs); }
    }
};
template <class Epi, class Sched, bool ALIGN_EPI = false, bool SP2 = false>
__device__ __forceinline__ void gemm_phase(PG8_LAS unsigned char* lds, const Gemm g, const Sched& S, const Epi& E) {
    int tid_l = threadIdx.x; asm volatile("" : "+v"(tid_l));
    const int tid = tid_l, wid = __builtin_amdgcn_readfirstlane(tid >> 6), lane = tid & 63, wr = wid >> 2, wc = wid & 3, fr = lane & 15, fq = lane >> 4;
    const int K = g.K, nt = K / BK;
    unsigned voffA[2], voffB[2];
#pragma unroll
    for (int i = 0; i < 2; ++i) { int R, C; stage_rc(tid * 16 + i * 8192, R, C); const int Rb = Epi::PERM ? ((R & ~31) + perm32(R & 31)) : R;
        voffA[i] = (unsigned)(R * K + C) * 2u; voffB[i] = (unsigned)(Rb * K + C) * 2u; }
    const size_t kstep = (size_t)(BK * 2);
    const size_t hstep = (size_t)HALF * K * 2;
    const size_t tstep = 2 * hstep;
    const unsigned ldsw = (unsigned)wid * 1024u;
    const int aoff = lds_byte(wr * 64 + fr, fq * 8), boff = lds_byte(wc * 32 + fr, fq * 8);
#define PG8_SA(b, h) (((b) * 2 + (h)) * HTB)
#define PG8_SB(b, h) ((4 + (b) * 2 + (h)) * HTB)
#define PG8_STAGE(bufoff, gbase, voff) do { _Pragma("unroll") for (int _i = 0; _i < 2; ++_i) \
        __builtin_amdgcn_global_load_lds((const unsigned*)((const char*)(gbase) + (voff)[_i]), (PG8_LAS unsigned*)(lds + (bufoff) + ldsw + _i * 8192), 16, 0, 0); } while (0)
#define PG8_LDA(dst, b, h) do { _Pragma("unroll") for (int m = 0; m < 4; ++m) _Pragma("unroll") for (int k = 0; k < 2; ++k) dst[m][k] = *(const PG8_LAS bf16x8*)(lds + PG8_SA(b, h) + aoff + m * 2048 + k * 1024); } while (0)
#define PG8_LDB(dst, b, h) do { _Pragma("unroll") for (int n = 0; n < 2; ++n) _Pragma("unroll") for (int k = 0; k < 2; ++k) dst[n][k] = *(const PG8_LAS bf16x8*)(lds + PG8_SB(b, h) + boff + n * 2048 + k * 1024); } while (0)
#define PG8_MMA(ai, bj, At, Bt) do { __builtin_amdgcn_s_setprio(1); _Pragma("unroll") for (int m = 0; m < 4; ++m) _Pragma("unroll") for (int n = 0; n < 2; ++n) _Pragma("unroll") for (int k = 0; k < 2; ++k) \
        acc[ai][bj][m][n] = __builtin_amdgcn_mfma_f32_16x16x32_bf16(Bt[n][k], At[m][k], acc[ai][bj][m][n], 0, 0, 0); __builtin_amdgcn_s_setprio(0); } while (0)
#define PG8_WAIT_V(n) asm volatile("s_waitcnt vmcnt(" #n ")" ::: "memory")
#define PG8_WAIT_L(n) asm volatile("s_waitcnt lgkmcnt(" #n ")" ::: "memory")
#define PG8_BAR __builtin_amdgcn_s_barrier()
#define PG8_SCHED __builtin_amdgcn_sched_barrier(0)
    Unit cur, nxt; int ui = 0;
    if (!S.next(0, cur)) return;
    f32x4 acc[2][2][4][2];
#pragma unroll
    for (int a = 0; a < 2; ++a)
#pragma unroll
        for (int b = 0; b < 2; ++b)
#pragma unroll
            for (int m = 0; m < 4; ++m)
#pragma unroll
                for (int n = 0; n < 2; ++n) acc[a][b][m][n] = (f32x4){0.f, 0.f, 0.f, 0.f};
    bf16x8 At[4][2], B0[2][2], B1[2][2];
    const char* cA = (const char*)g.A + (size_t)cur.pm * tstep; const char* cB = (const char*)g.Bt + (size_t)cur.pn * tstep;
    S.a_ready(cur);
    if constexpr (SP2) {
        PG8_STAGE(PG8_SB(0, 0), cB, voffB); PG8_STAGE(PG8_SB(0, 1), cB + hstep, voffB); PG8_STAGE(PG8_SA(0, 0), cA, voffA); PG8_STAGE(PG8_SA(0, 1), cA + hstep, voffA);
        if (wr == 1) PG8_BAR;
        PG8_WAIT_V(2); PG8_BAR;
        PG8_STAGE(PG8_SB(1, 0), cB + kstep, voffB); PG8_STAGE(PG8_SA(1, 0), cA + kstep, voffA); PG8_STAGE(PG8_SB(1, 1), cB + hstep + kstep, voffB);
        PG8_WAIT_V(6); PG8_BAR;
    } else {
        PG8_STAGE(PG8_SB(0, 0), cB, voffB); PG8_STAGE(PG8_SA(0, 0), cA, voffA); PG8_STAGE(PG8_SB(0, 1), cB + hstep, voffB); PG8_STAGE(PG8_SA(0, 1), cA + hstep, voffA);
        if (wr == 1) PG8_BAR;
        PG8_WAIT_V(4); PG8_BAR;
        PG8_STAGE(PG8_SB(1, 0), cB + kstep, voffB); PG8_STAGE(PG8_SA(1, 0), cA + kstep, voffA); PG8_STAGE(PG8_SB(1, 1), cB + hstep + kstep, voffB);
        PG8_WAIT_V(6); PG8_BAR;
    }
    for (;;) {
        const bool has_next = S.next(ui + 1, nxt);
        const char* nA = has_next ? (const char*)g.A + (size_t)nxt.pm * tstep : cA; const char* nB = has_next ? (const char*)g.Bt + (size_t)nxt.pn * tstep : cB;
        for (int t = 0; t < nt; t += 2) {
            const bool last = (t == nt - 2);
            const char* a1 = cA + (size_t)(t + 1) * kstep;
            const char* a2 = last ? nA : cA + (size_t)(t + 2) * kstep; const char* b2 = last ? nB : cB + (size_t)(t + 2) * kstep;
            const char* a3 = a2 + kstep; const char* b3 = b2 + kstep;
            if (last && has_next) S.a_ready(nxt);
            if constexpr (SP2) {
            PG8_LDB(B0, 0, 0); PG8_LDB(B1, 0, 1); PG8_SCHED; PG8_LDA(At, 0, 0); PG8_STAGE(PG8_SA(1, 1), a1 + hstep, voffA);
            PG8_WAIT_V(8); PG8_WAIT_L(0); PG8_BAR; PG8_MMA(0, 0, At, B0); PG8_MMA(0, 1, At, B1); PG8_BAR; PG8_SCHED;
            PG8_LDA(At, 0, 1); PG8_STAGE(PG8_SB(0, 0), b2, voffB); PG8_STAGE(PG8_SB(0, 1), b2 + hstep, voffB); PG8_STAGE(PG8_SA(0, 0), a2, voffA);
            PG8_WAIT_V(8); PG8_WAIT_L(0); PG8_BAR; PG8_MMA(1, 0, At, B0); PG8_MMA(1, 1, At, B1); PG8_BAR; PG8_SCHED;
            PG8_LDB(B0, 1, 0); PG8_LDB(B1, 1, 1); PG8_SCHED; PG8_LDA(At, 1, 0); PG8_STAGE(PG8_SA(0, 1), a2 + hstep, voffA);
            PG8_WAIT_V(8); PG8_WAIT_L(0); PG8_BAR; PG8_MMA(0, 0, At, B0); PG8_MMA(0, 1, At, B1); PG8_BAR; PG8_SCHED;
            PG8_LDA(At, 1, 1); PG8_STAGE(PG8_SB(1, 0), b3, voffB); PG8_STAGE(PG8_SB(1, 1), b3 + hstep, voffB); PG8_STAGE(PG8_SA(1, 0), a3, voffA);
            PG8_WAIT_V(8); PG8_WAIT_L(0); PG8_BAR; PG8_MMA(1, 0, At, B0); PG8_MMA(1, 1, At, B1); PG8_BAR; PG8_SCHED;
            } else {
            PG8_LDB(B0, 0, 0); PG8_SCHED; PG8_LDA(At, 0, 0); PG8_STAGE(PG8_SA(1, 1), a1 + hstep, voffA);
            PG8_WAIT_L(8); PG8_BAR; PG8_WAIT_L(0); PG8_MMA(0, 0, At, B0); PG8_BAR; PG8_SCHED;
            PG8_LDB(B1, 0, 1); PG8_STAGE(PG8_SB(0, 0), b2, voffB);
            PG8_BAR; PG8_WAIT_L(0); PG8_MMA(0, 1, At, B1); PG8_BAR;
            PG8_LDA(At, 0, 1); PG8_STAGE(PG8_SA(0, 0), a2, voffA);
            PG8_BAR; PG8_WAIT_L(0); PG8_MMA(1, 0, At, B0); PG8_BAR; PG8_SCHED;
            PG8_STAGE(PG8_SB(0, 1), b2 + hstep, voffB);
            PG8_WAIT_V(6); PG8_BAR; PG8_MMA(1, 1, At, B1); PG8_BAR;
            PG8_LDB(B0, 1, 0); PG8_SCHED; PG8_LDA(At, 1, 0); PG8_STAGE(PG8_SA(0, 1), a2 + hstep, voffA);
            PG8_WAIT_L(8); PG8_BAR; PG8_WAIT_L(0); PG8_MMA(0, 0, At, B0); PG8_BAR; PG8_SCHED;
            PG8_LDB(B1, 1, 1); PG8_STAGE(PG8_SB(1, 0), b3, voffB);
            PG8_BAR; PG8_WAIT_L(0); PG8_MMA(0, 1, At, B1); PG8_BAR;
            PG8_LDA(At, 1, 1); PG8_STAGE(PG8_SA(1, 0), a3, voffA);
            PG8_BAR; PG8_WAIT_L(0); PG8_MMA(1, 0, At, B0); PG8_BAR; PG8_SCHED;
            PG8_STAGE(PG8_SB(1, 1), b3 + hstep, voffB);
            PG8_WAIT_V(6); PG8_BAR; PG8_MMA(1, 1, At, B1); PG8_BAR;
            }
        }
        if constexpr (ALIGN_EPI) { if (wr == 0) PG8_BAR; }
        if constexpr (!Epi::AFTER_DRAIN) { E(acc, cur, wr, wc, fr, fq); S.done(cur); }
        if (!has_next) break;
#pragma unroll
        for (int a = 0; a < 2; ++a)
#pragma unroll
            for (int b = 0; b < 2; ++b)
#pragma unroll
                for (int m = 0; m < 4; ++m)
#pragma unroll
                    for (int n = 0; n < 2; ++n) acc[a][b][m][n] = (f32x4){0.f, 0.f, 0.f, 0.f};
        cur = nxt; cA = nA; cB = nB; ++ui;
        if constexpr (ALIGN_EPI) { if (wr == 1) PG8_BAR; }
    }
    PG8_WAIT_V(0);
    if constexpr (!ALIGN_EPI) { if (wr == 0) PG8_BAR; }
    PG8_BAR;
    if constexpr (Epi::AFTER_DRAIN) { E.fused(acc, cur, wr, wc, fr, fq, lds, wid, lane); S.done(cur); }
#undef PG8_SA
#undef PG8_SB
#undef PG8_STAGE
#undef PG8_LDA
#undef PG8_LDB
#undef PG8_MMA
#undef PG8_WAIT_V
#undef PG8_WAIT_L
#undef PG8_BAR
#undef PG8_SCHED
}
}


#define RLX_AGENT __ATOMIC_RELAXED, __HIP_MEMORY_SCOPE_AGENT
#define XB_TMO      128
#define XB_XCNT(j)  (256  + 64 * (j))
#define XB_XSUB(j)  (1280 + 64 * (j))
#define XB_XGEN(j)  (2304 + 64 * (j))
#define XB_TOP      3328
#define XB_TOPGEN   3392
#define XCD_BAR_WORDS 3456
#define XB_SPIN_CAP (1u << 18)

__device__ __forceinline__ unsigned xb_ld(unsigned* p)              { return __hip_atomic_load(p, __ATOMIC_RELAXED, __HIP_MEMORY_SCOPE_AGENT); }
__device__ __forceinline__ unsigned xb_add(unsigned* p, unsigned v) { return __hip_atomic_fetch_add(p, v, __ATOMIC_RELAXED, __HIP_MEMORY_SCOPE_AGENT); }
__device__ __forceinline__ unsigned xb_xcc_id() { return (unsigned)__builtin_amdgcn_s_getreg((3 << 11) | 20) & 0xFu; }
#define XB_SPIN(cond, bar) do { unsigned _sp = 0; while (cond) { __builtin_amdgcn_s_sleep(1); \
    if ((++_sp & 255u) == 0u) { if (xb_ld(&(bar)[XB_TMO])) break; if (_sp > XB_SPIN_CAP) { atomicAdd(&(bar)[XB_TMO], 1u); break; } } } } while (0)

struct XcdBarrier {
    unsigned* bar; unsigned x;
    volatile LAS unsigned* st;
};

__device__ __forceinline__ XcdBarrier xcd_barrier_post(unsigned* bar, volatile LAS unsigned* st) {
    XcdBarrier b; b.bar = bar; b.x = xb_xcc_id(); b.st = st;
    if (threadIdx.x == 0) (void)xb_add(&bar[XB_XCNT(b.x)], 1u);
    return b;
}
__device__ __forceinline__ void xcd_barrier_complete(unsigned* bar, unsigned x, unsigned& nloc, unsigned& nx) {
    const unsigned G = gridDim.x * gridDim.y * gridDim.z;
    unsigned sum, cnt, mine, sp = 0u;
    for (;;) {
        sum = 0u; cnt = 0u; mine = 0u;
#pragma unroll
        for (unsigned j = 0; j < 16; ++j) { const unsigned c = xb_ld(&bar[XB_XCNT(j)]); sum += c; cnt += (c > 0u) ? 1u : 0u; mine = (j == x) ? c : mine; }
        if (sum == G) break;
        __builtin_amdgcn_s_sleep(1);
        if ((++sp & 255u) == 0u) { if (xb_ld(&bar[XB_TMO])) break; if (sp > XB_SPIN_CAP) { atomicAdd(&bar[XB_TMO], 1u); break; } }
    }
    nloc = mine > 0u ? mine : 1u; nx = cnt > 0u ? cnt : 1u;
}

__device__ __forceinline__ void xcd_barrier(const XcdBarrier& b) {
    asm volatile("s_waitcnt vmcnt(0)" ::: "memory");
    __syncthreads();
    if (threadIdx.x == 0) {
        unsigned* bar = b.bar;
        __builtin_amdgcn_s_waitcnt(0);
        unsigned nloc = b.st[0], nx = b.st[1];
        if (nloc == 0u) { xcd_barrier_complete(bar, b.x, nloc, nx); b.st[0] = nloc; b.st[1] = nx; }
        const unsigned old = xb_add(&bar[XB_XSUB(b.x)], 1u);
        const unsigned gen = old / nloc;
        if (old + 1u == (gen + 1u) * nloc) {
            __builtin_amdgcn_fence(__ATOMIC_RELEASE, "agent");
            asm volatile("s_waitcnt vmcnt(0)" ::: "memory");
            const unsigned og = xb_add(&bar[XB_TOP], 1u);
            const unsigned tg = og / nx;
            if (og + 1u == (tg + 1u) * nx) xb_add(&bar[XB_TOPGEN], 1u);
            else XB_SPIN(xb_ld(&bar[XB_TOPGEN]) == tg, bar);
            __builtin_amdgcn_fence(__ATOMIC_ACQUIRE, "agent");
            xb_add(&bar[XB_XGEN(b.x)], 1u);
            asm volatile("s_waitcnt vmcnt(0)" ::: "memory");
        } else {
            XB_SPIN(xb_ld(&bar[XB_XGEN(b.x)]) == gen, bar);
            __builtin_amdgcn_fence(__ATOMIC_ACQUIRE, "agent");
            asm volatile("s_waitcnt vmcnt(0)" ::: "memory");
        }
    }
    __syncthreads();
}

DEVI void transpose_item(const float* __restrict__ W, int ldw, int c0, bf16_t* WT, int ldk, int r0, int Kmax, int kb, int nb, const float* kscale, float* scr, int lane, int fragKS = 0) {
    const int k0 = 64 * kb, n0 = 32 * nb;
#pragma unroll 8
    for (int i = 0; i < 32; ++i) {
        const int kk = 2 * i + (lane >> 5);
        float v = 0.f;
        if (k0 + kk < Kmax) { v = W[(size_t)(k0 + kk) * ldw + c0 + n0 + (lane & 31)]; if (kscale) v *= kscale[k0 + kk]; }
        scr[kk * 33 + (lane & 31)] = v;
    }
    asm volatile("s_waitcnt lgkmcnt(0)" ::: "memory");
    asm volatile("" ::: "memory");
    const int c = lane & 7;
    if (k0 + 8 * c < Kmax) {
#pragma unroll
        for (int j = 0; j < 4; ++j) {
            const int n = (lane >> 3) + 8 * j;
            const float* s = scr + (8 * c) * 33 + n;
            u32x4 o; o.x = pk2(s[0], s[33]); o.y = pk2(s[66], s[99]); o.z = pk2(s[132], s[165]); o.w = pk2(s[198], s[231]);
            if (fragKS > 0) { const int row = r0 + n0 + n, k = k0 + 8 * c, hd = row >> 6, rr = row & 63;
                *(u32x4*)(WT + ((size_t)(((hd * fragKS + (k >> 5)) * 4 + ((rr >> 2) & 3)) * 64 + ((k >> 3) & 3) * 16 + 4 * (rr >> 4) + (rr & 3))) * 8) = o; }
            else *(u32x4*)(WT + (size_t)(r0 + n0 + n) * ldk + k0 + 8 * c) = o;
        }
    }
    asm volatile("s_waitcnt lgkmcnt(0)" ::: "memory");
    asm volatile("" ::: "memory");
}


DEVI void wcomb_item(const float* __restrict__ Wq, const float* __restrict__ Sk, const float* __restrict__ n2w, bf16_t* WcT, int it, int lane) {
    const int fr = lane & 15, fq = lane >> 4;
    const int hp = it >> 6, nt = (it >> 4) & 3, kt = it & 15;
    const float* ap = Sk + ((size_t)hp * 128 + nt * 32 + fr) * 128 + fq * 8;
    const float* bp = Wq + (size_t)(kt * 64 + fr) * 2048 + hp * 128 + fq * 8;
    f32x4 acc[2][4];
#pragma unroll
    for (int m = 0; m < 2; ++m)
#pragma unroll
        for (int n = 0; n < 4; ++n) acc[m][n] = (f32x4){0.f, 0.f, 0.f, 0.f};
#pragma unroll
    for (int k0 = 0; k0 < 128; k0 += 32) {
        bf16x8 a[2], b[4];
#pragma unroll
        for (int m = 0; m < 2; ++m) { const f32x4 lo = *(const f32x4*)(ap + (size_t)m * 16 * 128 + k0), hi = *(const f32x4*)(ap + (size_t)m * 16 * 128 + k0 + 4);
            u32x4 w; w.x = pk2(lo.x, lo.y); w.y = pk2(lo.z, lo.w); w.z = pk2(hi.x, hi.y); w.w = pk2(hi.z, hi.w); a[m] = __builtin_bit_cast(bf16x8, w); }
#pragma unroll
        for (int n = 0; n < 4; ++n) { const f32x4 lo = *(const f32x4*)(bp + (size_t)n * 16 * 2048 + k0), hi = *(const f32x4*)(bp + (size_t)n * 16 * 2048 + k0 + 4);
            u32x4 w; w.x = pk2(lo.x, lo.y); w.y = pk2(lo.z, lo.w); w.z = pk2(hi.x, hi.y); w.w = pk2(hi.z, hi.w); b[n] = __builtin_bit_cast(bf16x8, w); }
#pragma unroll
        for (int m = 0; m < 2; ++m)
#pragma unroll
            for (int n = 0; n < 4; ++n) acc[m][n] = mfma16(b[n], a[m], acc[m][n]);
    }
#pragma unroll
    for (int n = 0; n < 4; ++n) {
        const int col = kt * 64 + 16 * n + 4 * fq; const f32x4 w = *(const f32x4*)(n2w + col);
#pragma unroll
        for (int m = 0; m < 2; ++m) { const int row = hp * 128 + nt * 32 + 16 * m + fr; st_bf4(WcT + (size_t)row * 1024 + col, acc[m][n][0] * w.x, acc[m][n][1] * w.y, acc[m][n][2] * w.z, acc[m][n][3] * w.w); }
    }
}

#define KARG __attribute__((address_space(4)))
DEVI const KARG Params* kargs() { unsigned long long k = (unsigned long long)__builtin_amdgcn_kernarg_segment_ptr(); asm volatile("" : "+s"(k)); return (const KARG Params*)k; }
#define PHASE_PTRS \
    int tid_l_ = threadIdx.x; asm volatile("" : "+v"(tid_l_)); \
    [[maybe_unused]] const int tid = tid_l_, lane = tid & 63, wave = __builtin_amdgcn_readfirstlane(tid >> 6), gw = blockIdx.x * NWAVES + wave, fr = lane & 15, fq = lane >> 4; \
    const KARG Params* kp = kargs(); unsigned char* ws = kp->ws; unsigned char* dob = (unsigned char*)kp->out; (void)ws; (void)dob; \
    [[maybe_unused]] const float* x = kp->in[0]; [[maybe_unused]] const int* positions = (const int*)kp->in[1]; [[maybe_unused]] const float* norm1_w = kp->in[2]; [[maybe_unused]] const float* w_in = kp->in[3]; \
    [[maybe_unused]] const float* rw_mu = kp->in[4]; [[maybe_unused]] const float* rw_w0 = kp->in[5]; [[maybe_unused]] const float* rw_a0 = kp->in[7]; [[maybe_unused]] const float* rw_k_k = kp->in[10]; \
    [[maybe_unused]] const float* rw_k_a = kp->in[11]; [[maybe_unused]] const float* rw_r_k = kp->in[12]; [[maybe_unused]] const float* rw_ln_w = kp->in[13]; [[maybe_unused]] const float* rw_ln_b = kp->in[14]; \
    [[maybe_unused]] const float* q_norm_w = kp->in[16]; [[maybe_unused]] const float* kv_norm_w = kp->in[18]; [[maybe_unused]] const float* qn_nope_w = kp->in[20]; [[maybe_unused]] const float* qn_pe_w = kp->in[21]; \
    [[maybe_unused]] const float* kn_nope_w = kp->in[22]; [[maybe_unused]] const float* kn_pe_w = kp->in[23]; [[maybe_unused]] const float* norm2_w = kp->in[26]; \
    [[maybe_unused]] float* ss2 = (float*)(ws + WS_SS2); [[maybe_unused]] unsigned* cnt = (unsigned*)(ws + WS_CNT); [[maybe_unused]] unsigned* xbar_words = (unsigned*)(ws + WS_CNT + 4096); \
    [[maybe_unused]] bf16_t* WinT = (bf16_t*)(ws + WS_WIN); [[maybe_unused]] bf16_t* WuqT = (bf16_t*)(ws + WS_WUQ); [[maybe_unused]] bf16_t* WukvT = (bf16_t*)(ws + WS_WUKV); [[maybe_unused]] bf16_t* RwoT = (bf16_t*)(ws + WS_RWO); \
    [[maybe_unused]] bf16_t* MwoT = (bf16_t*)(ws + WS_MWO); [[maybe_unused]] bf16_t* WoutT = (bf16_t*)(ws + WS_WOUT); [[maybe_unused]] bf16_t* PwqT = (bf16_t*)(ws + WS_PWQ); [[maybe_unused]] bf16_t* SubK = (bf16_t*)(ws + WS_SUBK); \
    [[maybe_unused]] bf16_t* W2T = (bf16_t*)(ws + WS_W2T); [[maybe_unused]] bf16_t* A2T = (bf16_t*)(ws + WS_A2T); [[maybe_unused]] bf16_t* G2T = (bf16_t*)(ws + WS_G2T); [[maybe_unused]] const unsigned char* Gg = ws + WS_G; \
    [[maybe_unused]] bf16_t* Prw = (bf16_t*)(ws + WS_PRW); [[maybe_unused]] bf16_t* QD = (bf16_t*)(ws + WS_QD); [[maybe_unused]] bf16_t* KVD = (bf16_t*)(ws + WS_KVD); [[maybe_unused]] bf16_t* KPE = (bf16_t*)(ws + WS_KPE); \
    [[maybe_unused]] float* ssq = (float*)(ws + WS_SSQ); [[maybe_unused]] float* sskv = (float*)(ws + WS_SSKV); [[maybe_unused]] bf16_t* XN = (bf16_t*)(dob + DO_XN); \
    [[maybe_unused]] bf16_t* Rb = (bf16_t*)(ws + WS_R); [[maybe_unused]] bf16_t* Wb = (bf16_t*)(ws + WS_W); [[maybe_unused]] bf16_t* Kb = (bf16_t*)(ws + WS_KS); [[maybe_unused]] bf16_t* Vb = (bf16_t*)(ws + WS_V); [[maybe_unused]] bf16_t* KKb = (bf16_t*)(ws + WS_KK); \
    [[maybe_unused]] bf16_t* Bvb = (bf16_t*)(dob + DO_BV); [[maybe_unused]] bf16_t* Gtb = (bf16_t*)(dob + DO_GT); [[maybe_unused]] float* bonus = (float*)(dob + DO_BONUS); [[maybe_unused]] bf16_t* Yb = (bf16_t*)(dob + DO_Y); \
    [[maybe_unused]] bf16_t* Qb = (bf16_t*)(ws + WS_Q); [[maybe_unused]] bf16_t* Kab = (bf16_t*)(ws + WS_K); [[maybe_unused]] bf16_t* Vt = (bf16_t*)(ws + WS_VT); [[maybe_unused]] bf16_t* Kraw = (bf16_t*)(dob + DO_KRAW); \
    [[maybe_unused]] bf16_t* Ob = (bf16_t*)(ws + WS_O); [[maybe_unused]] bf16_t* YA = (bf16_t*)(ws + WS_YA); [[maybe_unused]] bf16_t* MIXED = (bf16_t*)(ws + WS_MIXED); [[maybe_unused]] bf16_t* HB = (bf16_t*)(ws + WS_HB); \
    [[maybe_unused]] bf16_t* UB = (bf16_t*)(ws + WS_UB); [[maybe_unused]] bf16_t* VBp = (bf16_t*)(ws + WS_VB); [[maybe_unused]] bf16_t* PQ = (bf16_t*)(ws + WS_PQ); [[maybe_unused]] bf16_t* SC = (bf16_t*)(ws + WS_SC);

__global__ void __launch_bounds__(NT, 2) mega(Params p) {
    extern __shared__ __attribute__((aligned(16))) unsigned char lds[];
    cg::grid_group grid = cg::this_grid();
    const int G = gridDim.x, NGW = G * NWAVES;
    volatile LAS unsigned* bst = (volatile LAS unsigned*)((LAS unsigned char*)lds + LDS_BYTES - 16);
    if (threadIdx.x < 2) bst[threadIdx.x] = 0u;
    if (threadIdx.x >= 8 && threadIdx.x < 16) ((volatile LAS unsigned*)((LAS unsigned char*)lds + LDS_BYTES - 64))[threadIdx.x - 8] = 0u;
    if (threadIdx.x >= 16 && threadIdx.x < 32) ((volatile LAS unsigned*)((LAS unsigned char*)lds + LDS_BYTES - 128))[threadIdx.x - 16] = 0u;
    __syncthreads();
    if (kargs()->ws == nullptr) grid.sync();
    const XcdBarrier xb = xcd_barrier_post((unsigned*)(kargs()->ws + WS_CNT + 4096), bst);

    {
        PHASE_PTRS
        for (int i = blockIdx.x * NT + tid; i < T; i += G * NT) ss2[i] = 0.f;
        for (int t = gw; t < T; t += NGW) {
            const f32x4* xr = (const f32x4*)(x + (size_t)t * DM) + lane;
            f32x4 v[4]; float s = 0.f;
#pragma unroll
            for (int j = 0; j < 4; ++j) { v[j] = xr[64 * j]; s += v[j].x * v[j].x + v[j].y * v[j].y + v[j].z * v[j].z + v[j].w * v[j].w; }
            const float rstd = rsqrtf(wave_sum(s) * (1.f / DM) + EPS);
            const f32x4* wr = (const f32x4*)norm1_w + lane;
#pragma unroll
            for (int j = 0; j < 4; ++j) { const f32x4 w = wr[64 * j]; st_bf4(XN + (size_t)t * DM + (lane + 64 * j) * 4, v[j].x * rstd * w.x, v[j].y * rstd * w.y, v[j].z * rstd * w.z, v[j].w * rstd * w.w); }
        }
        float* scr = (float*)lds + wave * (64 * 33);
        int it = gw;
#define TR_SEG(W_, ldw_, c0_, WT_, ldk_, r0_, Kmax_, nkb_, nnb_, ksc_) \
        { const int cntI = (nkb_) * (nnb_); for (; it < cntI; it += NGW) transpose_item(W_, ldw_, c0_, WT_, ldk_, r0_, Kmax_, it / (nnb_), it % (nnb_), ksc_, scr, lane); it -= cntI; }
        TR_SEG(w_in, 4544, 0, WinT, 1024, 0, 1024, 16, 57, nullptr)
        TR_SEG(w_in, 4544, 1824, WinT, 1024, 2048, 1024, 16, 21, nullptr)
        TR_SEG(w_in, 4544, 2496, WinT, 1024, 2816, 1024, 16, 64, nullptr)
#define TR_SEGF(W_, ldw_, WT_, Kmax_, nkb_, nnb_, fks_) \
        { const int cntI = (nkb_) * (nnb_); for (; it < cntI; it += NGW) transpose_item(W_, ldw_, 0, WT_, 0, 0, Kmax_, it / (nnb_), it % (nnb_), nullptr, scr, lane, fks_); it -= cntI; }
        TR_SEGF(kp->in[6], 512, W2T, 64, 1, 16, 2)
        TR_SEGF(kp->in[8], 512, A2T, 64, 1, 16, 2)
        TR_SEGF(kp->in[9], 512, G2T, 160, 3, 16, 5)
#undef TR_SEGF
#pragma unroll 1
        for (int hh = 0; hh < 8; ++hh) {
            TR_SEG(kp->in[17], 768, hh * 96, WuqT, 384, hh * 64, 384, 6, 2, q_norm_w)
            TR_SEG(kp->in[17], 768, hh * 96 + 64, WuqT, 384, 512 + hh * 32, 384, 6, 1, q_norm_w)
            TR_SEG(kp->in[19], 1024, hh * 128, WukvT, 256, hh * 64, 256, 4, 2, kv_norm_w)
            TR_SEG(kp->in[19], 1024, hh * 128 + 64, WukvT, 256, 512 + hh * 64, 256, 4, 2, kv_norm_w)
        }
        TR_SEG(kp->in[15], 1024, 0, RwoT, 512, 0, 512, 8, 32, nullptr)
        TR_SEG(kp->in[24], 1024, 0, MwoT, 512, 0, 512, 8, 32, nullptr)
        TR_SEG(kp->in[25], 1024, 0, WoutT, 1024, 0, 1024, 16, 32, nullptr)
#undef TR_SEG
        for (; it < 1024; it += NGW) wcomb_item(kp->in[27], kp->in[28], norm2_w, PwqT, it, lane);
        for (int i = blockIdx.x * NT + tid; i < (224 + 96) * 128; i += G * NT) {
            const int r = i >> 7, c = i & 127; const int row = r < 224 ? 1824 + r : 2720 + (r - 224);
            *(u32x4*)(WinT + (size_t)row * 1024 + c * 8) = (u32x4){0u, 0u, 0u, 0u};
        }
    }
    xcd_barrier(xb);

    {
        PHASE_PTRS
        pg8::Gemm g{XN, WinT, T, 4864, DM}; pg8::StaticOrder S; S.init(T, 4864, G, (int)blockIdx.x);
        pg8::EpiP1 E{ws};
        pg8::gemm_phase<pg8::EpiP1, pg8::StaticOrder, true, true>((PG8_LAS unsigned char*)lds, g, S, E);
    }
    xcd_barrier(xb);


    {
        PHASE_PTRS
        for (int t = gw; t < T; t += NGW) {
            float a6[8]; ld_bf8(QD + (size_t)t * 384 + 8 * (lane & 47), a6); float s = 0.f;
#pragma unroll
            for (int i = 0; i < 8; ++i) s += a6[i] * a6[i];
            if (lane >= 48) s = 0.f;
            float b4[4]; ld_bf4(KVD + (size_t)t * 256 + 4 * lane, b4); const float s2 = (b4[0] * b4[0] + b4[1] * b4[1]) + (b4[2] * b4[2] + b4[3] * b4[3]);
            const float sq = wave_sum(s), skv = wave_sum(s2);
            if (lane == 0) { ssq[t] = rsqrtf(sq * (1.f / 384.f) + EPS); sskv[t] = rsqrtf(skv * (1.f / 256.f) + EPS); }
        }
    }
    {
        PHASE_PTRS
        LAS bf16_t* MIX = (LAS bf16_t*)lds; LAS bf16_t* LOR = (LAS bf16_t*)((LAS unsigned char*)lds + 49152);
        for (int tt = blockIdx.x; tt < T / 16; tt += G) {
            int h = wave; asm volatile("" : "+s"(h));
            __syncthreads();
            {
                u32x4 pw[8], ppw[8];
#pragma unroll
                for (int u = 0; u < 8; ++u) {
                    const int ci = tid + u * NT < 16 * 228 ? tid + u * NT : 16 * 228 - 1; const int row = ci / 228, cc = (ci - row * 228) * 8; const int tk = tt * 16 + row;
                    pw[u] = *(const u32x4*)(Prw + (size_t)tk * 2048 + cc);
                    ppw[u] = *(const u32x4*)(Prw + (size_t)((tk & (SEQ - 1)) != 0 ? tk - 1 : tk) * 2048 + cc);
                }
                __builtin_amdgcn_sched_barrier(0);
#pragma unroll
                for (int u = 0; u < 8; ++u) {
                    const int ci = tid + u * NT; if (ci < 16 * 228) {
                        const int row = ci / 228, cc = (ci - row * 228) * 8; const bool hp_ = ((tt * 16 + row) & (SEQ - 1)) != 0;
                        const float pv[8] = {bflo(pw[u].x), bfhi(pw[u].x), bflo(pw[u].y), bfhi(pw[u].y), bflo(pw[u].z), bfhi(pw[u].z), bflo(pw[u].w), bfhi(pw[u].w)};
                        float ppv[8] = {bflo(ppw[u].x), bfhi(ppw[u].x), bflo(ppw[u].y), bfhi(ppw[u].y), bflo(ppw[u].z), bfhi(ppw[u].z), bflo(ppw[u].w), bfhi(ppw[u].w)};
                        if (!hp_) {
#pragma unroll
                            for (int j = 0; j < 8; ++j) ppv[j] = 0.f; }
                        const f32x4 mu0 = *(const f32x4*)(rw_mu + cc), mu1 = *(const f32x4*)(rw_mu + cc + 4); float xm[8];
#pragma unroll
                        for (int j = 0; j < 8; ++j) { const float mu = j < 4 ? mu0[j & 3] : mu1[j & 3]; const float v = pv[j] + mu * (ppv[j] - pv[j]);
                            xm[j] = cc < 1600 ? (cc < 1536 ? v : tanhf_(v)) : (cc < 1664 ? v : sigmoidf_(v)); }
                        if (cc < 1536) *(LAS bf16x8*)(MIX + row * 1536 + cc) = pack8(xm); else *(LAS bf16x8*)(LOR + row * 288 + (cc - 1536)) = pack8(xm);
                    }
                }
            }
            __syncthreads();
            const int tok = tt * 16 + fr;
            f32x4 accw[4], acca[4], accg[4];
#pragma unroll
            for (int n = 0; n < 4; ++n) { accw[n] = (f32x4){0.f, 0.f, 0.f, 0.f}; acca[n] = accw[n]; accg[n] = accw[n]; }
#define LORA_STEP(lcol_, Wt_, KS_, ks_, accv_) { \
                const bf16x8 a = *(const LAS bf16x8*)(LOR + fr * 288 + (lcol_) + 8 * fq); \
                _Pragma("unroll") for (int n = 0; n < 4; ++n) { const bf16x8 b = *(const bf16x8*)((Wt_) + ((size_t)(((h * (KS_) + (ks_)) * 4 + n) * 64 + lane)) * 8); accv_[n] = mfma16(b, a, accv_[n]); } }
#pragma unroll
            for (int ks = 0; ks < 2; ++ks) LORA_STEP(32 * ks, W2T, 2, ks, accw)
#pragma unroll
            for (int ks = 0; ks < 2; ++ks) LORA_STEP(64 + 32 * ks, A2T, 2, ks, acca)
#pragma unroll
            for (int ks = 0; ks < 5; ++ks) LORA_STEP(128 + 32 * ks, G2T, 5, ks, accg)
#undef LORA_STEP
            float kkv[4][4], av[4][4]; float ssq = 0.f, bon = 0.f;
            u32x2 Rp[4], Wp[4], Kp[4], Vp[4], Gp[4];
#pragma unroll
            for (int n = 0; n < 4; ++n) {
                const int ch = 64 * h + 16 * fq + 4 * n;
                float r4[4], k4[4], v4[4];
#pragma unroll
                for (int seg = 0; seg < 3; ++seg) {
                    const u32x2 w = *(const LAS u32x2*)(MIX + fr * 1536 + seg * 512 + ch);
                    const float m4[4] = {bflo(w.x), bfhi(w.x), bflo(w.y), bfhi(w.y)};
#pragma unroll
                    for (int i = 0; i < 4; ++i) { if (seg == 0) r4[i] = m4[i]; else if (seg == 1) k4[i] = m4[i]; else v4[i] = m4[i]; }
                }
                const f32x4 w0 = *(const f32x4*)(rw_w0 + ch), a0 = *(const f32x4*)(rw_a0 + ch), kkw = *(const f32x4*)(rw_k_k + ch), kaw = *(const f32x4*)(rw_k_a + ch), rkw = *(const f32x4*)(rw_r_k + ch);
                float dd[4], kf[4];
#pragma unroll
                for (int i = 0; i < 4; ++i) {
                    const float z = -(w0[i] + accw[n][i]);
                    const float sp = z > 20.f ? z : __logf(1.f + __expf(z));
                    const float wlog = -sp - 0.5f;
                    dd[i] = -__expf(wlog);
                    const float a = sigmoidf_(a0[i] + acca[n][i]); av[n][i] = a;
                    kkv[n][i] = k4[i] * kkw[i]; ssq += kkv[n][i] * kkv[n][i];
                    kf[i] = k4[i] * (1.f + (a - 1.f) * kaw[i]);
                    bon += r4[i] * kf[i] * rkw[i];
                }
                Rp[n] = (u32x2){pk2(r4[0], r4[1]), pk2(r4[2], r4[3])}; Wp[n] = (u32x2){pk2(dd[0], dd[1]), pk2(dd[2], dd[3])}; Kp[n] = (u32x2){pk2(kf[0], kf[1]), pk2(kf[2], kf[3])};
                Vp[n] = (u32x2){pk2(v4[0], v4[1]), pk2(v4[2], v4[3])}; Gp[n] = (u32x2){pk2(accg[n][0], accg[n][1]), pk2(accg[n][2], accg[n][3])};
            }
            const size_t o = (size_t)tok * 512 + 64 * h + 16 * fq;
#define ST16(P_, X_) { *(u32x4*)((P_) + o) = (u32x4){X_[0].x, X_[0].y, X_[1].x, X_[1].y}; *(u32x4*)((P_) + o + 8) = (u32x4){X_[2].x, X_[2].y, X_[3].x, X_[3].y}; }
            ST16(Rb, Rp) ST16(Wb, Wp) ST16(Kb, Kp) ST16(Vb, Vp) ST16(Gtb, Gp)
            ssq += __shfl_xor(ssq, 16); ssq += __shfl_xor(ssq, 32);
            bon += __shfl_xor(bon, 16); bon += __shfl_xor(bon, 32);
            const float inv = 1.f / fmaxf(sqrtf(ssq), 1e-12f);
            u32x2 KKp[4], Bp[4];
#pragma unroll
            for (int n = 0; n < 4; ++n) {
                float kk[4], bb[4];
#pragma unroll
                for (int i = 0; i < 4; ++i) { kk[i] = kkv[n][i] * inv; bb[i] = kk[i] * av[n][i]; }
                KKp[n] = (u32x2){pk2(kk[0], kk[1]), pk2(kk[2], kk[3])}; Bp[n] = (u32x2){pk2(bb[0], bb[1]), pk2(bb[2], bb[3])};
            }
            ST16(KKb, KKp) ST16(Bvb, Bp)
#undef ST16
            if (fq == 0) bonus[(size_t)tok * 8 + h] = bon;
        }
    }
    xcd_barrier(xb);

    {
        PHASE_PTRS
        { int Kq = 384; asm volatile("" : "+s"(Kq));
          pg8::Gemm g{QD, WuqT, T, 768, Kq}; pg8::StaticOrder S; S.init(T, 768, G, (int)blockIdx.x); pg8::EpiQraw E{Qb, ssq};
          pg8::gemm_phase<pg8::EpiQraw, pg8::StaticOrder, true, true>((PG8_LAS unsigned char*)lds, g, S, E); }
        { int Kkv = 256; asm volatile("" : "+s"(Kkv));
          pg8::Gemm g{KVD, WukvT, T, 1024, Kkv}; pg8::StaticOrder S; S.init(T, 1024, G, (int)blockIdx.x); pg8::EpiKVraw E{Kraw, Vt, sskv};
          pg8::gemm_phase<pg8::EpiKVraw, pg8::StaticOrder, true, true>((PG8_LAS unsigned char*)lds, g, S, E); }
    }
    xcd_barrier(xb);
    {
        PHASE_PTRS
        for (int t = gw; t < T; t += NGW) {
            const int hh = lane >> 3, l8 = lane & 7;
            const float pos = (float)positions[t];
            float cs[4], sn[4];
#pragma unroll
            for (int i = 0; i < 4; ++i) { const float invf = exp2f(-(float)(4 * (l8 & 3) + i) * (13.287712379549449f / 16.f)); float rev = pos * invf * 0.15915494309189535f; rev -= rintf(rev);
                sn[i] = __builtin_amdgcn_sinf(rev); cs[i] = __builtin_amdgcn_cosf(rev); }
            bf16_t* qrow = Qb + (size_t)t * 768;
            float qn[8], qp[4]; ld_bf8(qrow + 8 * lane, qn); ld_bf4(qrow + 512 + 4 * lane, qp);
            float kn[8], kp4[4]; ld_bf8(Kraw + (size_t)t * 512 + 8 * lane, kn); ld_bf4(KPE + (size_t)t * 32 + 4 * l8, kp4);
            float s1 = 0.f, s2 = 0.f, s3 = 0.f, s4 = 0.f;
#pragma unroll
            for (int i = 0; i < 8; ++i) { s1 += qn[i] * qn[i]; s3 += kn[i] * kn[i]; }
#pragma unroll
            for (int i = 0; i < 4; ++i) { s2 += qp[i] * qp[i]; s4 += kp4[i] * kp4[i]; }
            s1 = sum8(s1); s2 = sum8(s2); s3 = sum8(s3); s4 = sum8(s4);
            const float r1 = rsqrtf(s1 * (1.f / 64.f) + EPS) * QSCALE, r2 = rsqrtf(s2 * (1.f / 32.f) + EPS), r3 = rsqrtf(s3 * (1.f / 64.f) + EPS), r4 = rsqrtf(s4 * (1.f / 32.f) + EPS);
            const f32x4 wq0 = *(const f32x4*)(qn_nope_w + 8 * l8), wq1 = *(const f32x4*)(qn_nope_w + 8 * l8 + 4), wk0 = *(const f32x4*)(kn_nope_w + 8 * l8), wk1 = *(const f32x4*)(kn_nope_w + 8 * l8 + 4);
            const f32x4 wqp = *(const f32x4*)(qn_pe_w + 4 * l8), wkp = *(const f32x4*)(kn_pe_w + 4 * l8);
            float oq[8], ok[8], oqp[4], okp[4];
#pragma unroll
            for (int i = 0; i < 8; ++i) { oq[i] = qn[i] * r1 * (i < 4 ? wq0[i & 3] : wq1[i & 3]); ok[i] = kn[i] * r3 * (i < 4 ? wk0[i & 3] : wk1[i & 3]); }
#pragma unroll
            for (int i = 0; i < 4; ++i) {
                const float xq = qp[i] * r2 * wqp[i], xk = kp4[i] * r4 * wkp[i];
                const float pq = dpp_f<0x141>(xq), pk_ = dpp_f<0x141>(xk);
                (void)pq; (void)pk_;
                oqp[i] = xq; okp[i] = xk;
            }
#pragma unroll
            for (int i = 0; i < 4; ++i) {
                const float pq = __shfl_xor(oqp[i], 4), pk_ = __shfl_xor(okp[i], 4);
                const float xq = oqp[i], xk = okp[i];
                oqp[i] = l8 < 4 ? (xq * cs[i] - pq * sn[i]) : (xq * cs[i] + pq * sn[i]);
                okp[i] = l8 < 4 ? (xk * cs[i] - pk_ * sn[i]) : (xk * cs[i] + pk_ * sn[i]);
                oqp[i] *= QSCALE;
            }
            bf16_t* qo = Qb + ((size_t)t * 8 + hh) * 96;
            *(bf16x8*)(qo + 8 * l8) = pack8(oq); st_bf4(qo + 64 + 4 * l8, oqp[0], oqp[1], oqp[2], oqp[3]);
            { const int bb = t >> 12, pos = t & 4095; bf16_t* kfb = Kab + (((size_t)(bb * 8 + hh) * 128 + (pos >> 5)) * 6) * 512 + (pos & 31) * 8;
              *(bf16x8*)(kfb + (l8 >> 1) * 512 + 256 * (l8 & 1)) = pack8(ok);
              st_bf4(kfb + (4 + (l8 >> 2)) * 512 + 256 * ((l8 >> 1) & 1) + 4 * (l8 & 1), okp[0], okp[1], okp[2], okp[3]); }
        }
    }
    xcd_barrier(xb);

    {
        PHASE_PTRS
        float* GL = (float*)(dob + DO_GL);
        const int fr_o = fr, fq_o = fq, lane_o = lane;
        if (wave < 3) {
            LAS unsigned char* wb = (LAS unsigned char*)lds + wave * 49152;
            LAS bf16_t* At = (LAS bf16_t*)(wb + 0);      LAS bf16_t* Btm = (LAS bf16_t*)(wb + 4096);  LAS bf16_t* Ktm = (LAS bf16_t*)(wb + 8192); LAS bf16_t* Rtm = (LAS bf16_t*)(wb + 12288);
            LAS bf16_t* AtT = (LAS bf16_t*)(wb + 16384); LAS bf16_t* BtT = (LAS bf16_t*)(wb + 20480); LAS bf16_t* KtT = (LAS bf16_t*)(wb + 24576); LAS bf16_t* VmT = (LAS bf16_t*)(wb + 28672);
            LAS bf16_t* Nm = (LAS bf16_t*)(wb + 32768);  LAS bf16_t* NmT = (LAS bf16_t*)(wb + 34816); LAS bf16_t* Tm = (LAS bf16_t*)(wb + 36864);  LAS bf16_t* TmT = (LAS bf16_t*)(wb + 38912);
            LAS bf16_t* MmT = (LAS bf16_t*)(wb + 40960); LAS bf16_t* NBT = (LAS bf16_t*)(wb + 43008); LAS bf16_t* MKT = (LAS bf16_t*)(wb + 45056); LAS float* gLs = (LAS float*)(wb + 47104);
            LAS bf16_t* W1 = At; LAS bf16_t* W1T = Btm; LAS bf16_t* ATm = Ktm;
#pragma unroll 1
            for (int it = blockIdx.x * 3 + wave; it < 4096; it += G * 3) {
                const int bh = it >> 7, c = it & 127, b = bh >> 3, h = bh & 7;
                int fr = fr_o, fq = fq_o, lane = lane_o; asm volatile("" : "+v"(fr), "+v"(fq), "+v"(lane));
                const int lpA = (4 * (fr >> 3) + (fr & 3)) + 32 * (fq & 1) + ((fq >> 1) + 4 * ((fr >> 2) & 1)) * 512;
                const int lpB = ((fr >> 1) + 16 * (fq & 1)) * 512 + 16 * (fr & 1) + 4 * (fq >> 1);
                const int lpC = 4 * (fq >> 1) + 16 * (fr & 3) + ((fr >> 2) + 8 * (fq & 1)) * 512;
                const size_t sbase = ((size_t)b * SEQ + c * 32) * 512 + h * 64;
                {
                    float cs = 0.f; unsigned aT[16], bT[16], kT[16], vT[16];
#pragma unroll
                    for (int t = 0; t < 32; ++t) {
                        const size_t o = sbase + (size_t)t * 512 + lane;
                        const float ldv = bf1(Wb[o]), rr = bf1(Rb[o]), kv = bf1(Kb[o]), qv = bf1(KKb[o]), bv = bf1(Bvb[o]); const unsigned vraw = Vb[o];
                        const float ep = __expf(cs); cs += ldv; const float ec = __expf(cs), en = __expf(-cs);
                        const unsigned a_ = bf1of(-qv * ep), b_ = bf1of(bv * en), k_ = bf1of(kv * en), r_ = bf1of(rr * ec);
                        At[SW64(t, lane)] = (bf16_t)a_; Btm[SW64(t, lane)] = (bf16_t)b_; Ktm[SW64(t, lane)] = (bf16_t)k_; Rtm[SW64(t, lane)] = (bf16_t)r_;
                        if (t & 1) { aT[t >> 1] |= a_ << 16; bT[t >> 1] |= b_ << 16; kT[t >> 1] |= k_ << 16; vT[t >> 1] |= vraw << 16; }
                        else { aT[t >> 1] = a_; bT[t >> 1] = b_; kT[t >> 1] = k_; vT[t >> 1] = vraw; }
                    }
#pragma unroll
                    for (int q = 0; q < 4; ++q) {
                        *(LAS u32x4*)(AtT + lane * 32 + ((q ^ ((lane >> 2) & 3)) << 3)) = (u32x4){aT[4 * q], aT[4 * q + 1], aT[4 * q + 2], aT[4 * q + 3]};
                        *(LAS u32x4*)(BtT + lane * 32 + ((q ^ ((lane >> 2) & 3)) << 3)) = (u32x4){bT[4 * q], bT[4 * q + 1], bT[4 * q + 2], bT[4 * q + 3]};
                        *(LAS u32x4*)(KtT + lane * 32 + ((q ^ ((lane >> 2) & 3)) << 3)) = (u32x4){kT[4 * q], kT[4 * q + 1], kT[4 * q + 2], kT[4 * q + 3]};
                        *(LAS u32x4*)(VmT + lane * 32 + ((q ^ ((lane >> 2) & 3)) << 3)) = (u32x4){vT[4 * q], vT[4 * q + 1], vT[4 * q + 2], vT[4 * q + 3]};
                    }
                    const float gl = __expf(cs); gLs[lane] = gl;
                    { const int k5 = lane & 31; GL[(size_t)it * 64 + (lane >> 5) * 32 + ((k5 >> 2) & 1) * 16 + (k5 & 3) + 4 * (k5 >> 3)] = gl; }
                }
                {
                    f32x4 acc[2][2];
#define ZACC(MT_, NT_) _Pragma("unroll") for (int m = 0; m < MT_; ++m) _Pragma("unroll") for (int n = 0; n < NT_; ++n) acc[m][n] = (f32x4){0.f, 0.f, 0.f, 0.f};
                    ZACC(2, 2) gemm_lds<2, 2, 2>(Btm, 64, At, 64, acc, fr, fq);
#pragma unroll
                    for (int m = 0; m < 2; ++m)
#pragma unroll
                        for (int n = 0; n < 2; ++n)
#pragma unroll
                            for (int j = 0; j < 4; ++j) { const int i = 16 * m + fr, tt = 16 * n + 4 * fq + j; const float v = i < tt ? acc[m][n][j] : 0.f; const bf16_t w = bf1of(v), w1 = bf1of(v + (i == tt ? 1.f : 0.f));
                                Nm[SW32(i, tt)] = w; NmT[SW32(tt, i)] = w; Tm[SW32(i, tt)] = w1; TmT[SW32(tt, i)] = w1; }
                    ZACC(2, 2) gemm_lds<2, 2, 2>(Ktm, 64, At, 64, acc, fr, fq);
#pragma unroll
                    for (int m = 0; m < 2; ++m)
#pragma unroll
                        for (int n = 0; n < 2; ++n)
#pragma unroll
                            for (int j = 0; j < 4; ++j) { const int i = 16 * m + fr, tt = 16 * n + 4 * fq + j; MmT[SW32(tt, i)] = bf1of(i < tt ? acc[m][n][j] : 0.f); }
                    ZACC(2, 2) gemm_lds<2, 2, 2>(Btm, 64, Rtm, 64, acc, fr, fq);
#pragma unroll
                    for (int m = 0; m < 2; ++m)
#pragma unroll
                        for (int n = 0; n < 2; ++n)
#pragma unroll
                            for (int j = 0; j < 4; ++j) { const int i = 16 * m + fr, tt = 16 * n + 4 * fq + j; NBT[SW32(tt, i)] = bf1of(i <= tt ? acc[m][n][j] : 0.f); }
                    ZACC(2, 2) gemm_lds<2, 2, 2>(Ktm, 64, Rtm, 64, acc, fr, fq);
#pragma unroll
                    for (int m = 0; m < 2; ++m)
#pragma unroll
                        for (int n = 0; n < 2; ++n)
#pragma unroll
                            for (int j = 0; j < 4; ++j) { const int i = 16 * m + fr, tt = 16 * n + 4 * fq + j; MKT[SW32(tt, i)] = bf1of(i <= tt ? acc[m][n][j] : 0.f); }
#pragma unroll 1
                    for (int rd = 0; rd < 4; ++rd) {
                        ZACC(2, 2) gemm_lds<2, 2, 1>(Nm, 32, NmT, 32, acc, fr, fq);
#pragma unroll
                        for (int m = 0; m < 2; ++m)
#pragma unroll
                            for (int n = 0; n < 2; ++n)
#pragma unroll
                                for (int j = 0; j < 4; ++j) { const int i = 16 * m + fr, tt = 16 * n + 4 * fq + j; const bf16_t w = bf1of(acc[m][n][j]); Nm[SW32(i, tt)] = w; NmT[SW32(tt, i)] = w; }
                        ZACC(2, 2) gemm_lds<2, 2, 1>(Tm, 32, NmT, 32, acc, fr, fq);
#pragma unroll
                        for (int m = 0; m < 2; ++m)
#pragma unroll
                            for (int n = 0; n < 2; ++n)
#pragma unroll
                                for (int j = 0; j < 4; ++j) { const int i = 16 * m + fr, tt = 16 * n + 4 * fq + j; const bf16_t w = bf1of(acc[m][n][j] + bf1(Tm[SW32(i, tt)])); Tm[SW32(i, tt)] = w; TmT[SW32(tt, i)] = w; }
                    }
                }
                asm volatile("" : "+v"(fr), "+v"(fq));
                {
                    f32x4 acc[4][2];
                    ZACC(4, 2) gemm_lds<4, 2, 1>(AtT, 32, TmT, 32, acc, fr, fq);
#pragma unroll
                    for (int m = 0; m < 4; ++m)
#pragma unroll
                        for (int n = 0; n < 2; ++n)
#pragma unroll
                            for (int j = 0; j < 4; ++j) ATm[SW32(16 * m + fr, 16 * n + 4 * fq + j)] = bf1of(acc[m][n][j]);
                    ZACC(4, 2) gemm_lds<4, 2, 1>(VmT, 32, MmT, 32, acc, fr, fq);
#pragma unroll
                    for (int m = 0; m < 4; ++m)
#pragma unroll
                        for (int n = 0; n < 2; ++n)
#pragma unroll
                            for (int j = 0; j < 4; ++j) W1[SW32(16 * m + fr, 16 * n + 4 * fq + j)] = bf1of(acc[m][n][j]);
                    ZACC(4, 2) gemm_lds<4, 2, 1>(W1, 32, TmT, 32, acc, fr, fq);
#pragma unroll
                    for (int m = 0; m < 4; ++m)
#pragma unroll
                        for (int n = 0; n < 2; ++n)
#pragma unroll
                            for (int j = 0; j < 4; ++j) W1T[SW32(16 * m + fr, 16 * n + 4 * fq + j)] = bf1of(acc[m][n][j]);
                    ZACC(4, 2) gemm_lds<4, 2, 1>(ATm, 32, NBT, 32, acc, fr, fq);
#pragma unroll
                    for (int m = 0; m < 4; ++m)
#pragma unroll
                        for (int n = 0; n < 2; ++n)
#pragma unroll
                            for (int j = 0; j < 4; ++j) { const int k = 16 * m + fr, tp = 16 * n + 4 * fq + j; const float v = acc[m][n][j] + bf1(Rtm[SW64(tp, k)]);
                                Rb[sbase + lpA + (size_t)(j * 8 + (2 * n + 8 * m) * 512)] = bf1of(v); }
                    ZACC(4, 2) gemm_lds<4, 2, 1>(W1T, 32, NBT, 32, acc, fr, fq); gemm_lds<4, 2, 1>(VmT, 32, MKT, 32, acc, fr, fq);
#pragma unroll
                    for (int m = 0; m < 4; ++m)
#pragma unroll
                        for (int n = 0; n < 2; ++n)
#pragma unroll
                            for (int j = 0; j < 4; ++j) Yb[sbase + lpB + (size_t)((8 * (m & 1)) * 512 + 32 * (m >> 1) + j + 8 * n)] = bf1of(acc[m][n][j]);
                }
                asm volatile("" : "+v"(fr), "+v"(fq));
                {
                    f32x4 acc[4][4];
                    ZACC(4, 4) gemm_lds<4, 4, 1>(ATm, 32, BtT, 32, acc, fr, fq);
#pragma unroll
                    for (int m = 0; m < 4; ++m)
#pragma unroll
                        for (int n = 0; n < 4; ++n)
#pragma unroll
                            for (int j = 0; j < 4; ++j) { const float v = acc[m][n][j] * gLs[16 * n + 4 * fq + j];
                                (n < 2 ? Wb : Kb)[sbase + lpA + (size_t)(j * 8 + (2 * (n & 1) + 8 * m) * 512)] = bf1of(v); }
                    ZACC(4, 4) gemm_lds<4, 4, 1>(W1T, 32, BtT, 32, acc, fr, fq); gemm_lds<4, 4, 1>(VmT, 32, KtT, 32, acc, fr, fq);
#pragma unroll
                    for (int m = 0; m < 4; ++m)
#pragma unroll
                        for (int n = 0; n < 4; ++n)
#pragma unroll
                            for (int j = 0; j < 4; ++j) { const float v = acc[m][n][j] * gLs[16 * n + 4 * fq + j];
                                (m < 2 ? KKb : Bvb)[sbase + lpC + (size_t)(j + 8 * (n & 1) + (4 * (m & 1) + 16 * (n >> 1)) * 512)] = bf1of(v); }
                }
#undef ZACC
            }
        }
    }
    xcd_barrier(xb);

    {
        PHASE_PTRS
        if (wave < 5 && blockIdx.x < 64) {
            const int item = blockIdx.x, bh = item >> 1, wv = item & 1, b = bh >> 3, h = bh & 7;
            const int hi = lane >> 5, vcol = lane & 31;
            float* GL = (float*)(dob + DO_GL);
            volatile LAS unsigned* ctr = (volatile LAS unsigned*)((LAS unsigned char*)lds + LDS_BYTES - 64);
#define SLICE(arr, sb, li) ((arr) + (sb) + (size_t)((li) >> 6) * 512 + ((li) & 63))
#define DMA16(src_, dst_) __builtin_amdgcn_global_load_lds((const unsigned*)(src_), (LAS unsigned*)(dst_), 16, 0, 0)
            if (wave >= 1 && wave <= 3) {
                __builtin_amdgcn_s_setprio(2);
#pragma unroll 1
                for (int c = 0; c < 128; ++c) {
                    if (c >= 4) { while ((int)ctr[3] < c - 3) __builtin_amdgcn_s_sleep(1); }
                    asm volatile("" ::: "memory");
                    const size_t sb = ((size_t)b * SEQ + c * 32) * 512 + h * 64; LAS unsigned char* lb = (LAS unsigned char*)lds + (c & 3) * 19712;
                    if (wave == 1) {
#pragma unroll
                        for (int q = 0; q < 4; ++q) DMA16(SLICE(Wb, sb, (q * 64 + lane) * 8), lb + q * 1024);
#pragma unroll
                        for (int q = 0; q < 2; ++q) DMA16(SLICE(Kb, sb, (q * 64 + lane) * 8), lb + 4096 + q * 1024);
                        asm volatile("s_waitcnt vmcnt(12)" ::: "memory");
                    } else if (wave == 2) {
#pragma unroll
                        for (int q = 2; q < 4; ++q) DMA16(SLICE(Kb, sb, (q * 64 + lane) * 8), lb + 4096 + q * 1024);
#pragma unroll
                        for (int q = 0; q < 4; ++q) DMA16(SLICE(Rb, sb, (q * 64 + lane) * 8), lb + 8192 + q * 1024);
                        asm volatile("s_waitcnt vmcnt(12)" ::: "memory");
                    } else {
#pragma unroll
                        for (int kb = 0; kb < 2; ++kb)
#pragma unroll
                            for (int hf = 0; hf < 2; ++hf) DMA16(SLICE(wv ? Bvb : KKb, sb, (kb * 64 + lane) * 16 + 8 * hf), lb + 12288 + kb * 2048 + hf * 1024);
#pragma unroll
                        for (int hf = 0; hf < 2; ++hf) DMA16(Yb + sb + (size_t)(lane >> 1) * 512 + 32 * wv + 16 * (lane & 1) + 8 * hf, lb + 16384 + hf * 1024);
                        __builtin_amdgcn_global_load_lds((const unsigned*)(GL + ((size_t)(bh * 128 + c)) * 64 + lane), (LAS unsigned*)(lb + 18432), 4, 0, 0);
                        asm volatile("s_waitcnt vmcnt(14)" ::: "memory");
                    }
                    if (c >= 2 && lane == 0) ctr[wave - 1] = (unsigned)(c - 1);
                }
                asm volatile("s_waitcnt vmcnt(0)" ::: "memory");
                if (lane == 0) ctr[wave - 1] = 128u;
                __builtin_amdgcn_s_setprio(0);
            } else if (wave == 4) {
#pragma unroll 1
                for (int c = 0; c < 128; ++c) {
                    while ((int)ctr[4] <= c) __builtin_amdgcn_s_sleep(2);
                    asm volatile("" ::: "memory");
                    const LAS u32x4* ys = (const LAS u32x4*)((LAS unsigned char*)lds + 81920 + (c & 7) * 2048 + lane * 32);
                    const u32x4 ya = ys[0], yb = ys[1];
                    u32x4* yo = (u32x4*)(Yb + ((size_t)b * SEQ + c * 32 + (lane >> 1)) * 512 + h * 64 + 32 * wv + 16 * (lane & 1));
                    yo[0] = ya; yo[1] = yb;
                    asm volatile("s_waitcnt lgkmcnt(0)" ::: "memory");
                    if (lane == 0) ctr[5] = (unsigned)(c + 1);
                }
            } else {
                __builtin_amdgcn_s_setprio(3);
                f32x16 S0t, S1t;
#pragma unroll
                for (int r = 0; r < 16; ++r) { S0t[r] = 0.f; S1t[r] = 0.f; }
#pragma unroll 1
                for (int c = 0; c < 128; ++c) {
                    while ((int)ctr[0] <= c || (int)ctr[1] <= c || (int)ctr[2] <= c) __builtin_amdgcn_s_sleep(1);
                    asm volatile("" ::: "memory");
                    const LAS unsigned char* lb = (const LAS unsigned char*)lds + (c & 3) * 19712;
                    bf16x8 sf[4];
#pragma unroll
                    for (int s = 0; s < 4; ++s) { float t8[8];
#pragma unroll
                        for (int j = 0; j < 8; ++j) t8[j] = (s < 2 ? S0t : S1t)[8 * (s & 1) + j];
                        sf[s] = pack8(t8); }
                    f32x16 yt;
                    { const u32x4 c0 = *(const LAS u32x4*)(lb + 16384 + lane * 16), c1 = *(const LAS u32x4*)(lb + 16384 + 1024 + lane * 16);
                      yt[0] = bflo(c0.x); yt[1] = bfhi(c0.x); yt[2] = bflo(c0.y); yt[3] = bfhi(c0.y); yt[4] = bflo(c0.z); yt[5] = bfhi(c0.z); yt[6] = bflo(c0.w); yt[7] = bfhi(c0.w);
                      yt[8] = bflo(c1.x); yt[9] = bfhi(c1.x); yt[10] = bflo(c1.y); yt[11] = bfhi(c1.y); yt[12] = bflo(c1.z); yt[13] = bfhi(c1.z); yt[14] = bflo(c1.w); yt[15] = bfhi(c1.w); }
                    f32x16 n0, n1;
#pragma unroll
                    for (int kb = 0; kb < 2; ++kb) {
                        const u32x4 c0 = *(const LAS u32x4*)(lb + 12288 + kb * 2048 + lane * 16), c1 = *(const LAS u32x4*)(lb + 12288 + kb * 2048 + 1024 + lane * 16);
                        const LAS float* gp = (const LAS float*)(lb + 18432) + kb * 32 + hi * 16;
                        f32x16 nn; const f32x16 so = kb ? S1t : S0t;
                        nn[0] = bflo(c0.x); nn[1] = bfhi(c0.x); nn[2] = bflo(c0.y); nn[3] = bfhi(c0.y); nn[4] = bflo(c0.z); nn[5] = bfhi(c0.z); nn[6] = bflo(c0.w); nn[7] = bfhi(c0.w);
                        nn[8] = bflo(c1.x); nn[9] = bfhi(c1.x); nn[10] = bflo(c1.y); nn[11] = bfhi(c1.y); nn[12] = bflo(c1.z); nn[13] = bfhi(c1.z); nn[14] = bflo(c1.w); nn[15] = bfhi(c1.w);
#pragma unroll
                        for (int r = 0; r < 16; ++r) nn[r] += gp[r] * so[r];
                        if (kb) n1 = nn; else n0 = nn;
                    }
#pragma unroll
                    for (int s = 0; s < 4; ++s) {
                        const bf16x8 ra = *(const LAS bf16x8*)(lb + 8192 + s * 1024 + lane * 16);
                        const bf16x8 p0 = *(const LAS bf16x8*)(lb + s * 1024 + lane * 16), p1 = *(const LAS bf16x8*)(lb + 4096 + s * 1024 + lane * 16);
                        yt = mfma32(ra, sf[s], yt); n0 = mfma32(p0, sf[s], n0); n1 = mfma32(p1, sf[s], n1);
                    }
                    S0t = n0; S1t = n1;
                    asm volatile("s_waitcnt lgkmcnt(0)" ::: "memory");
                    if (lane == 0) ctr[3] = (unsigned)(c + 1);
                    if (c >= 8) { while ((int)ctr[5] < c - 7) __builtin_amdgcn_s_sleep(1); }
                    asm volatile("" ::: "memory");
                    { LAS bf16_t* ys = (LAS bf16_t*)((LAS unsigned char*)lds + 81920 + (c & 7) * 2048) + vcol;
#pragma unroll
                      for (int r = 0; r < 16; ++r) ys[crow(r, hi) * 32] = bf1of(yt[r]);
                      asm volatile("s_waitcnt lgkmcnt(0)" ::: "memory");
                      if (lane == 0) ctr[4] = (unsigned)(c + 1); }
                }
                __builtin_amdgcn_s_setprio(0);
            }
#undef DMA16
#undef SLICE
        }
        for (;;) {
            unsigned item = 0;
            const int xg = blockIdx.x & 7;
            if (lane == 0) item = atomicAdd(&cnt[xg], 1u);
            item = __builtin_amdgcn_readfirstlane(item);
            if (item >= 256u) break;
            const int qt = 63 - (int)(item >> 2), bh = 8 * (int)(item & 3) + xg, b = bh >> 3, h = bh & 7;
            const int qi = lane & 31, hi = lane >> 5;
            const size_t tokq = (size_t)b * SEQ + qt * 64 + qi;
            bf16x8 qfa[6], qfb[6];
#pragma unroll
            for (int s = 0; s < 6; ++s) { qfa[s] = *(const bf16x8*)(Qb + (tokq * 8 + h) * 96 + 16 * s + 8 * hi); qfb[s] = *(const bf16x8*)(Qb + ((tokq + 32) * 8 + h) * 96 + 16 * s + 8 * hi); }
            float ma = -1e30f, la = 0.f, mb = -1e30f, lb = 0.f;
            f32x16 oa0, oa1, ob0, ob1;
#pragma unroll
            for (int r = 0; r < 16; ++r) { oa0[r] = 0.f; oa1[r] = 0.f; ob0[r] = 0.f; ob1[r] = 0.f; }
            const bf16_t* kfb = Kab + ((size_t)(b * 8 + h) * 128) * 6 * 512 + lane * 8;
            const bf16_t* vfb = Vt + ((size_t)(b * 8 + h) * 128) * 4 * 512 + lane * 8;
            const int nt = 2 * qt + 2;
#define ATT_GROUP(QF, M_, L_, O0, O1, DIAG) { \
                f32x16 xs; _Pragma("unroll") for (int r = 0; r < 16; ++r) xs[r] = 0.f; \
                _Pragma("unroll") for (int s = 0; s < 6; ++s) xs = mfma32(kf[s], QF[s], xs); \
                if (DIAG) { _Pragma("unroll") for (int r = 0; r < 16; ++r) if (crow(r, hi) > qi) xs[r] = -1e30f; } \
                float mx = xs[0]; _Pragma("unroll") for (int r = 1; r < 16; ++r) mx = fmaxf(mx, xs[r]); \
                mx = fmaxf(mx, __shfl_xor(mx, 32)); \
                if (__any(mx > M_)) { const float mn = fmaxf(M_, mx), alpha = __builtin_amdgcn_exp2f(M_ - mn); L_ *= alpha; M_ = mn; \
                    _Pragma("unroll") for (int r = 0; r < 16; ++r) { O0[r] *= alpha; O1[r] *= alpha; } } \
                float ps = 0.f; _Pragma("unroll") for (int r = 0; r < 16; ++r) { xs[r] = __builtin_amdgcn_exp2f(xs[r] - M_); ps += xs[r]; } \
                L_ += ps; \
                _Pragma("unroll") for (int s = 0; s < 2; ++s) { float t8[8]; _Pragma("unroll") for (int j = 0; j < 8; ++j) t8[j] = xs[8 * s + j]; const bf16x8 pbs = pack8(t8); \
                    O0 = mfma32(vf[0][s], pbs, O0); O1 = mfma32(vf[1][s], pbs, O1); } }
#pragma unroll 1
            for (int kt = 0; kt < nt; ++kt) {
                bf16x8 kf[6], vf[2][2];
#pragma unroll
                for (int s = 0; s < 6; ++s) kf[s] = *(const bf16x8*)(kfb + (size_t)(kt * 6 + s) * 512);
#pragma unroll
                for (int d0 = 0; d0 < 2; ++d0)
#pragma unroll
                    for (int s = 0; s < 2; ++s) vf[d0][s] = *(const bf16x8*)(vfb + (size_t)((kt * 2 + d0) * 2 + s) * 512);
                if (kt < nt - 1) ATT_GROUP(qfa, ma, la, oa0, oa1, kt == nt - 2)
                ATT_GROUP(qfb, mb, lb, ob0, ob1, kt == nt - 1)
            }
#undef ATT_GROUP
            la += __shfl_xor(la, 32); lb += __shfl_xor(lb, 32);
            const float ila = 1.f / la, ilb = 1.f / lb;
            bf16_t* orow = Ob + tokq * 512 + h * 64;
#pragma unroll
            for (int g = 0; g < 4; ++g) {
                st_bf4(orow + 8 * g + 4 * hi, oa0[4 * g] * ila, oa0[4 * g + 1] * ila, oa0[4 * g + 2] * ila, oa0[4 * g + 3] * ila);
                st_bf4(orow + 32 + 8 * g + 4 * hi, oa1[4 * g] * ila, oa1[4 * g + 1] * ila, oa1[4 * g + 2] * ila, oa1[4 * g + 3] * ila);
                st_bf4(orow + (size_t)32 * 512 + 8 * g + 4 * hi, ob0[4 * g] * ilb, ob0[4 * g + 1] * ilb, ob0[4 * g + 2] * ilb, ob0[4 * g + 3] * ilb);
                st_bf4(orow + (size_t)32 * 512 + 32 + 8 * g + 4 * hi, ob1[4 * g] * ilb, ob1[4 * g + 1] * ilb, ob1[4 * g + 2] * ilb, ob1[4 * g + 3] * ilb);
            }
        }
    }
    xcd_barrier(xb);

    {
        PHASE_PTRS
        for (int t = gw; t < T; t += NGW) {
            const int ch = 8 * lane, h = lane >> 3;
            float y[8], v[8], g[8]; ld_bf8(Yb + (size_t)t * 512 + ch, y); ld_bf8(Vb + (size_t)t * 512 + ch, v); ld_bf8(Gtb + (size_t)t * 512 + ch, g);
            float s = 0.f;
#pragma unroll
            for (int i = 0; i < 8; ++i) s += y[i];
            s += __shfl_xor(s, 1); s += __shfl_xor(s, 2); s += __shfl_xor(s, 4);
            const float mu = s * (1.f / 64.f); float q = 0.f;
#pragma unroll
            for (int i = 0; i < 8; ++i) { y[i] -= mu; q += y[i] * y[i]; }
            q += __shfl_xor(q, 1); q += __shfl_xor(q, 2); q += __shfl_xor(q, 4);
            const float rstd = rsqrtf(q * (1.f / 64.f) + 64e-5f);
            const float bo = bonus[(size_t)t * 8 + h];
            const f32x4 lw0 = *(const f32x4*)(rw_ln_w + ch), lw1 = *(const f32x4*)(rw_ln_w + ch + 4), lb0 = *(const f32x4*)(rw_ln_b + ch), lb1 = *(const f32x4*)(rw_ln_b + ch + 4);
            float o[8];
#pragma unroll
            for (int i = 0; i < 8; ++i) { const float lw = i < 4 ? lw0[i & 3] : lw1[i & 3], lb = i < 4 ? lb0[i & 3] : lb1[i & 3]; o[i] = (y[i] * rstd * lw + lb + bo * v[i]) * g[i]; }
            *(bf16x8*)(YA + (size_t)t * 512 + ch) = pack8(o);
        }
    }
    xcd_barrier(xb);

    {
        PHASE_PTRS
        pg8::StaticOrder S; S.init(T, 1024, G, (int)blockIdx.x);
        { pg8::Gemm g{YA, RwoT, T, 1024, 512}; pg8::EpiGate E{MIXED, Gg, 0, 0};
          pg8::gemm_phase<pg8::EpiGate, pg8::StaticOrder, true, true>((PG8_LAS unsigned char*)lds, g, S, E); }
        { pg8::Gemm g{Ob, MwoT, T, 1024, 512}; pg8::EpiGate E{MIXED, Gg, 1024, 1};
          pg8::gemm_phase<pg8::EpiGate, pg8::StaticOrder, true, true>((PG8_LAS unsigned char*)lds, g, S, E); }
    }
    xcd_barrier(xb);

    {
        PHASE_PTRS
        { pg8::Gemm g{MIXED, WoutT, T, 1024, 1024}; pg8::StaticOrder S; S.init(T, 1024, G, (int)blockIdx.x);
          pg8::EpiRes E{x, HB, ss2};
          pg8::gemm_phase<pg8::EpiRes, pg8::StaticOrder, true, true>((PG8_LAS unsigned char*)lds, g, S, E); }
        { const float* pu = kp->in[29]; const float* pv = kp->in[30];
          for (size_t i = (size_t)blockIdx.x * NT + tid; i < (size_t)16384 * 1024 / 16; i += (size_t)G * NT) {
              u32x4 uo, vo;
#pragma unroll
              for (int q = 0; q < 4; ++q) {
                  const f32x4 u = ((const f32x4*)pu)[i * 4 + q]; const f32x4 w = ((const f32x4*)norm2_w)[(i & 63) * 4 + q];
                  uo[q] = pk4_fp8(u.x * w.x * U8_SCALE, u.y * w.y * U8_SCALE, u.z * w.z * U8_SCALE, u.w * w.w * U8_SCALE);
                  const f32x4 v = ((const f32x4*)pv)[i * 4 + q]; vo[q] = pk4_fp8(v.x * V8_SCALE, v.y * V8_SCALE, v.z * V8_SCALE, v.w * V8_SCALE);
              }
              ((u32x4*)UB)[i] = uo;
              { const size_t e = i >> 6; const int d0 = (int)(i & 63) * 16; *(u32x4*)((unsigned char*)VBp + ((size_t)(d0 >> 7) * 16384 + e) * 128 + (d0 & 127)) = vo; } } }
    }
    xcd_barrier(xb);

    {
        PHASE_PTRS
        pg8::Gemm g{HB, PwqT, T, 2048, 1024}; pg8::StaticOrder S; S.init(T, 2048, G, (int)blockIdx.x);
        pg8::EpiScale E{SC, ss2};
        pg8::gemm_phase<pg8::EpiScale, pg8::StaticOrder, true, true>((PG8_LAS unsigned char*)lds, g, S, E);
    }
    xcd_barrier(xb);

    {
        PHASE_PTRS
        const int wp = wave & 3; const bool producer = wave < 4;
        volatile LAS unsigned* pc = (volatile LAS unsigned*)((LAS unsigned char*)lds + LDS_BYTES - 128) + 2 * wp;
        int kq = 0;
        for (int t = blockIdx.x * 4 + wp; t < T; t += G * 4, ++kq) {
            LAS unsigned char* wl = (LAS unsigned char*)lds + wp * 4096 + (kq & 1) * 2048;
            LAS u32x2* tab = (LAS u32x2*)wl;
            const float rs = rsqrtf(ss2[t] * (1.f / DM) + EPS);
            if (producer) {
            if (kq >= 2) { while ((int)pc[1] < kq - 1) __builtin_amdgcn_s_sleep(2); }
            asm volatile("" ::: "memory");
            { float xa[8], xb[8]; ld_bf8(HB + (size_t)t * DM + 16 * lane, xa); ld_bf8(HB + (size_t)t * DM + 16 * lane + 8, xb);
              u32x4 w; w.x = pk4_fp8(xa[0], xa[1], xa[2], xa[3]); w.y = pk4_fp8(xa[4], xa[5], xa[6], xa[7]); w.z = pk4_fp8(xb[0], xb[1], xb[2], xb[3]); w.w = pk4_fp8(xb[4], xb[5], xb[6], xb[7]);
              *(LAS u32x4*)(wl + 1024 + lane * 16) = w; }
#define SORT4(k) { unsigned hi_, lo_; \
                    hi_ = umax2(k[0], k[1]); lo_ = k[0] < k[1] ? k[0] : k[1]; k[0] = hi_; k[1] = lo_; hi_ = umax2(k[2], k[3]); lo_ = k[2] < k[3] ? k[2] : k[3]; k[2] = hi_; k[3] = lo_; \
                    hi_ = umax2(k[0], k[2]); lo_ = k[0] < k[2] ? k[0] : k[2]; k[0] = hi_; k[2] = lo_; hi_ = umax2(k[1], k[3]); lo_ = k[1] < k[3] ? k[1] : k[3]; k[1] = hi_; k[3] = lo_; \
                    hi_ = umax2(k[1], k[2]); lo_ = k[1] < k[2] ? k[1] : k[2]; k[1] = hi_; k[2] = lo_; }
#pragma unroll 1
            for (int hg = 0; hg < 8; hg += 4) {
                unsigned key[4][4], top[4];
#pragma unroll
                for (int q = 0; q < 4; ++q) {
                    const u32x2 w = *(const u32x2*)(SC + (size_t)t * 2048 + (hg + q) * 256 + 4 * lane);
                    const float f[4] = {bflo(w.x), bfhi(w.x), bflo(w.y), bfhi(w.y)};
#pragma unroll
                    for (int c = 0; c < 4; ++c) { unsigned u = __float_as_uint(f[c]); u = (u & 0x80000000u) ? ~u : (u | 0x80000000u); key[q][c] = (u & ~127u) | (unsigned)(127 - (4 * (lane & 31) + c)); }
                    SORT4(key[q])
                    top[q] = 0u;
                }
#pragma unroll 1
                for (int r = 0; r < 16; ++r) {
                    const bool isr = (lane & 31) == r;
#pragma unroll
                    for (int q = 0; q < 4; ++q) {
                        unsigned m = umax16(key[q][0]);
                        { const auto rr = __builtin_amdgcn_permlane16_swap(m, m, false, false); m = umax2(rr[0], rr[1]); }
                        const bool win = key[q][0] == m;
                        key[q][0] = win ? key[q][1] : key[q][0]; key[q][1] = win ? key[q][2] : key[q][1]; key[q][2] = win ? key[q][3] : key[q][2]; key[q][3] = win ? 0u : key[q][3];
                        top[q] = isr ? m : top[q];
                    }
                }
                unsigned ck[4][4], best[4];
#pragma unroll
                for (int q = 0; q < 4; ++q) {
                    float sval; { unsigned u = top[q] & ~127u; u = (u & 0x80000000u) ? (u & 0x7fffffffu) : ~u; sval = __uint_as_float(u); }
                    const float a = __shfl(sval, lane >> 2);
#pragma unroll
                    for (int c = 0; c < 4; ++c) { const float bsc = __shfl(sval, 32 + 4 * (lane & 3) + c); unsigned u = __float_as_uint(a + bsc); u = (u & 0x80000000u) ? ~u : (u | 0x80000000u);
                        ck[q][c] = (u & ~255u) | (unsigned)(255 - ((lane >> 2) * 16 + 4 * (lane & 3) + c)); }
                    SORT4(ck[q])
                    best[q] = 0u;
                }
#pragma unroll 1
                for (int r = 0; r < 16; ++r) {
                    const bool isr = lane == r;
#pragma unroll
                    for (int q = 0; q < 4; ++q) {
                        unsigned m = umax16(ck[q][0]);
                        { const auto rr = __builtin_amdgcn_permlane16_swap(m, m, false, false); m = umax2(rr[0], rr[1]); }
                        { const auto rr = __builtin_amdgcn_permlane32_swap(m, m, false, false); m = umax2(rr[0], rr[1]); }
                        const bool win = ck[q][0] == m;
                        ck[q][0] = win ? ck[q][1] : ck[q][0]; ck[q][1] = win ? ck[q][2] : ck[q][1]; ck[q][2] = win ? ck[q][3] : ck[q][2]; ck[q][3] = win ? 0u : ck[q][3];
                        best[q] = isr ? m : best[q];
                    }
                }
#pragma unroll
                for (int q = 0; q < 4; ++q) {
                    float bs; { unsigned u = best[q] & ~255u; u = (u & 0x80000000u) ? (u & 0x7fffffffu) : ~u; bs = __uint_as_float(u); }
                    const int pos = 255 - (int)(best[q] & 255u);
                    const float bmax = __uint_as_float(rdlane(__float_as_uint(bs), 0));
                    const float e = lane < 16 ? __expf(bs - bmax) : 0.f;
                    const float gate = e / sum16(e);
                    const unsigned t1 = (unsigned)__shfl((int)top[q], (pos >> 4) & 15), t2 = (unsigned)__shfl((int)top[q], 32 + (pos & 15));
                    const unsigned eid = (127u - (t1 & 127u)) * 128u + (127u - (t2 & 127u));
                    if (lane < 16) tab[16 * (hg + q) + lane] = (u32x2){eid, __float_as_uint(gate)};
                }
            }
#undef SORT4
            asm volatile("s_waitcnt lgkmcnt(0)" ::: "memory");
            if (lane == 0) pc[0] = (unsigned)(kq + 1);
            } else {
            while ((int)pc[0] <= kq) __builtin_amdgcn_s_sleep(2);
            asm volatile("" ::: "memory");
            const unsigned char* UB8 = (const unsigned char*)UB; const unsigned char* VB8 = (const unsigned char*)VBp;
            u32x4 ua[16];
            { const unsigned char* up = UB8 + (size_t)tab[fr].x * DM + 16 * fq;
#pragma unroll
              for (int s = 0; s < 16; ++s) ua[s] = *(const u32x4*)(up + 64 * s); }
#pragma unroll 1
            for (int h = 0; h < 8; ++h) {
                u32x4 uc[16];
#pragma unroll
                for (int s = 0; s < 16; ++s) uc[s] = ua[s];
                { const int hn = h + 1 < 8 ? h + 1 : 7; const unsigned char* up = UB8 + (size_t)tab[16 * hn + fr].x * DM + 16 * fq;
#pragma unroll
                  for (int s = 0; s < 16; ++s) ua[s] = *(const u32x4*)(up + 64 * s); }
                f32x4 ac0 = (f32x4){0.f, 0.f, 0.f, 0.f}, ac1 = ac0, ac2 = ac0, ac3 = ac0;
#pragma unroll
                for (int s = 0; s < 16; s += 2) {
                    const u32x4 b0 = *(const LAS u32x4*)(wl + 1024 + 64 * s + 16 * fq), b1 = *(const LAS u32x4*)(wl + 1024 + 64 * (s + 1) + 16 * fq);
                    ac0 = mfma16_fp8((u32x2){uc[s].x, uc[s].y}, (u32x2){b0.x, b0.y}, ac0);
                    ac1 = mfma16_fp8((u32x2){uc[s].z, uc[s].w}, (u32x2){b0.z, b0.w}, ac1);
                    ac2 = mfma16_fp8((u32x2){uc[s + 1].x, uc[s + 1].y}, (u32x2){b1.x, b1.y}, ac2);
                    ac3 = mfma16_fp8((u32x2){uc[s + 1].z, uc[s + 1].w}, (u32x2){b1.z, b1.w}, ac3);
                }
                const f32x4 acc = (ac0 + ac1) + (ac2 + ac3);
                const int j = fr & 3;
                const float d = (j == 0 ? acc[0] : (j == 1 ? acc[1] : (j == 2 ? acc[2] : acc[3]))) * (rs * (1.f / U8_SCALE));
                const float act = 0.5f * d * (1.f + erff(d * 0.7071067811865476f));
                if (fr < 4) { const int i = 16 * h + 4 * fq + fr; const float g = __uint_as_float(tab[i].y); tab[i].y = __float_as_uint(g * act * (1.f / V8_SCALE)); }
            }
            asm volatile("s_waitcnt lgkmcnt(0)" ::: "memory");
            {
                const u32x4 tv = *(const LAS u32x4*)(wl + lane * 16);
                LAS unsigned char* tq = wl + 1024; const int r0 = 2 * (lane & 3), l0 = lane >> 2;
                *(LAS unsigned short*)(tq + (r0 * 16 + l0) * 2) = (unsigned short)tv.x; *(LAS unsigned short*)(tq + ((r0 + 1) * 16 + l0) * 2) = (unsigned short)tv.z;
                const float c0 = fminf(fmaxf(__uint_as_float(tv.y) * C8_SCALE, -440.f), 440.f), c1 = fminf(fmaxf(__uint_as_float(tv.w) * C8_SCALE, -440.f), 440.f);
                const unsigned c8 = (unsigned)__builtin_amdgcn_cvt_pk_fp8_f32(c0, c1, 0, false);
                *(tq + 256 + r0 * 16 + l0) = (unsigned char)(c8 & 0xffu); *(tq + 256 + (r0 + 1) * 16 + l0) = (unsigned char)((c8 >> 8) & 0xffu);
                asm volatile("s_waitcnt lgkmcnt(0)" ::: "memory");
                if (lane < 24) { const u32x4 o = *(const LAS u32x4*)(tq + lane * 16); *(u32x4*)(ws + WS_TAB + (size_t)t * 384 + lane * 16) = o; }
            }
            asm volatile("s_waitcnt lgkmcnt(0)" ::: "memory");
            if (lane == 0) pc[1] = (unsigned)(kq + 1);
            }
        }
    }
    xcd_barrier(xb);

    {
        PHASE_PTRS
        const unsigned sl = blockIdx.x & 7;
        const unsigned char* VS = (const unsigned char*)VBp + (size_t)sl * 16384 * 128;
        const int rho = lane >> 3, chi = lane & 7;
        constexpr float CSCALE = C8_SCALE;
        unsigned selLo[4], selHi[4];
#pragma unroll
        for (int k = 0; k < 4; ++k) { const unsigned sh = 8u * (unsigned)(chi & 3); const unsigned v = (0x0c0c0c0cu & ~(0xffu << sh)) | ((unsigned)k << sh);
            selLo[k] = chi < 4 ? v : 0x0c0c0c0cu; selHi[k] = chi < 4 ? 0x0c0c0c0cu : v; }
        const bool olane = (lane & 0x28) == 0;
        const unsigned voff0 = 16u * (unsigned)chi;
        LAS unsigned char* wl8 = (LAS unsigned char*)lds + wave * 6144;
        const int wstride = (G >> 3) * NWAVES, tg0 = (blockIdx.x >> 3) * NWAVES + wave;
        const int nb = tg0 < T / 8 ? (T / 8 - tg0 + wstride - 1) / wstride : 0, ntok = nb * 8;
#define P6C_TOK(i_) ((tg0 + ((i_) >> 3) * wstride) * 8 + ((i_) & 7))
#define P6C_DMA(b_) { _Pragma("unroll") for (int k = 0; k < 3; ++k) __builtin_amdgcn_global_load_lds((const unsigned*)(ws + WS_TAB + (size_t)((tg0 + (b_) * wstride) * 8) * 384 + k * 1024 + lane * 16), (LAS unsigned*)(wl8 + ((b_) & 1) * 3072 + k * 1024), 16, 0, 0); }
#define P6C_TAB(EL, EH, CW, i_) { const int ii_ = (i_) < ntok ? (i_) : ntok - 1; const LAS unsigned char* tq_ = wl8 + ((ii_ >> 3) & 1) * 3072 + (ii_ & 7) * 384; \
            EL = *(const LAS u32x4*)(tq_ + rho * 32); EH = *(const LAS u32x4*)(tq_ + rho * 32 + 16); CW = *(const LAS u32x4*)(tq_ + 256 + rho * 16); }
#define P6C_EID(ER, j_) (((j_) & 1) ? (ER[(j_) >> 1] >> 16) : (ER[(j_) >> 1] & 0xffffu))
#define P6C_LOAD(VV, ER) { _Pragma("unroll") for (int j = 0; j < 8; ++j) VV[j] = *(const u32x4*)(VS + (size_t)((P6C_EID(ER, j) << 7) | voff0)); }
#define P6C_USE(VV, CWA, CWB) { _Pragma("unroll") for (int j = 0; j < 8; ++j) { const unsigned cwd = (j < 4) ? CWA : CWB; \
            u32x2 xo; xo.x = __builtin_amdgcn_perm(cwd, cwd, selLo[j & 3]); xo.y = __builtin_amdgcn_perm(cwd, cwd, selHi[j & 3]); \
            acc0 = mfma16_fp8(xo, (u32x2){VV[j].x, VV[j].y}, acc0); acc1 = mfma16_fp8(xo, (u32x2){VV[j].z, VV[j].w}, acc1); } }
#define P6C_BODY(i_, VA, VB, EL, EH, CW, VBo, EHo) { \
            const size_t oo_ = (size_t)P6C_TOK(i_) * DM + 128 * sl + 16 * chi + 4 * ((lane >> 4) & 1); float* orow = kp->out + oo_; \
            u32x2 hw0 = (u32x2){0u, 0u}, hw1 = hw0; \
            if (olane) { hw0 = *(const u32x2*)(HB + oo_); hw1 = *(const u32x2*)(HB + oo_ + 8); }        \
            P6C_LOAD(VBo, EHo)                                     \
            const u32x4 cwq = CW; \
            __builtin_amdgcn_sched_barrier(0); \
            f32x4 acc0 = (f32x4){0.f, 0.f, 0.f, 0.f}, acc1 = acc0; \
            P6C_USE(VA, cwq.x, cwq.y) \
            __builtin_amdgcn_sched_barrier(0); \
            P6C_TAB(EL, EH, CW, (i_) + 2) \
            P6C_LOAD(VA, EL)                                       \
            __builtin_amdgcn_sched_barrier(0); \
            P6C_USE(VB, cwq.z, cwq.w) \
            float s[8]; \
            _Pragma("unroll") for (int r = 0; r < 4; ++r) {        \
                { const auto rr = __builtin_amdgcn_permlane32_swap(__float_as_uint(acc0[r]), __float_as_uint(acc0[r]), false, false); s[r] = acc0[r] + dpp_f<0x128>(__uint_as_float(rr[1])); } \
                { const auto rr = __builtin_amdgcn_permlane32_swap(__float_as_uint(acc1[r]), __float_as_uint(acc1[r]), false, false); s[4 + r] = acc1[r] + dpp_f<0x128>(__uint_as_float(rr[1])); } } \
            if (olane) { const f32x4 h0 = (f32x4){bflo(hw0.x), bfhi(hw0.x), bflo(hw0.y), bfhi(hw0.y)}, h1 = (f32x4){bflo(hw1.x), bfhi(hw1.x), bflo(hw1.y), bfhi(hw1.y)}; \
                *(f32x4*)orow = h0 + (f32x4){s[0], s[1], s[2], s[3]} * (1.f / CSCALE); *(f32x4*)(orow + 8) = h1 + (f32x4){s[4], s[5], s[6], s[7]} * (1.f / CSCALE); } \
            __builtin_amdgcn_sched_barrier(0); }
        if (nb > 0) {
            u32x4 vA0[8], vB0[8], vA1[8], vB1[8];
            u32x4 eL0, eH0, cw0, eL1, eH1, cw1;
            P6C_DMA(0)
            if (nb > 1) P6C_DMA(1)
            asm volatile("s_waitcnt vmcnt(0)" ::: "memory");
            P6C_TAB(eL0, eH0, cw0, 0)
            P6C_LOAD(vA0, eL0)
            P6C_LOAD(vB0, eH0)
            P6C_TAB(eL1, eH1, cw1, 1)
            P6C_LOAD(vA1, eL1)
#pragma unroll 1
            for (int i = 0; i < ntok; i += 2) {
                if ((i & 7) == 0 && i > 0 && (i >> 3) + 1 < nb) P6C_DMA((i >> 3) + 1)
                if ((i & 7) == 4) asm volatile("s_waitcnt vmcnt(40)" ::: "memory");
                P6C_BODY(i, vA0, vB0, eL0, eH0, cw0, vB1, eH1)
                P6C_BODY(i + 1, vA1, vB1, eL1, eH1, cw1, vB0, eH0)
            }
            asm volatile("s_waitcnt vmcnt(0) lgkmcnt(0)" ::: "memory");
        }
#undef P6C_BODY
#undef P6C_USE
#undef P6C_LOAD
#undef P6C_EID
#undef P6C_TAB
#undef P6C_DMA
#undef P6C_TOK
    }
}

extern "C" void kernel_launch(void* const* d_in, const int* in_sizes, int n_in, void* d_out, int out_size,
                              void* d_ws, size_t ws_size, hipStream_t stream) {
    static int grid_blocks = 0;
    if (!grid_blocks) {
        int dev = 0, cus = 0, per_cu = 0;
        (void)hipGetDevice(&dev);
        (void)hipDeviceGetAttribute(&cus, hipDeviceAttributeMultiprocessorCount, dev);
        (void)hipFuncSetAttribute((const void*)mega, hipFuncAttributeMaxDynamicSharedMemorySize, LDS_BYTES);
        (void)hipOccupancyMaxActiveBlocksPerMultiprocessor(&per_cu, (const void*)mega, NT, LDS_BYTES);
        if (per_cu < 1) per_cu = 1;
        if (per_cu > 1) per_cu = 1;
        grid_blocks = cus * per_cu;
        if (ws_size < 256 * MiB) fprintf(stderr, "kernel_launch: workspace too small: %zu\n", ws_size);
    }
    Params p{};
    for (int i = 0; i < 31; ++i) p.in[i] = (const float*)d_in[i];
    p.out = (float*)d_out;
    p.ws = (unsigned char*)d_ws;
    void* args[] = {&p};
    (void)hipMemsetAsync((unsigned char*)d_ws + WS_CNT, 0, 65536, stream);
    hipError_t e = hipLaunchCooperativeKernel((const void*)mega, dim3(grid_blocks), dim3(NT), args, LDS_BYTES, stream);
    if (e != hipSuccess) fprintf(stderr, "cooperative launch failed: %s (grid %d)\n", hipGetErrorString(e), grid_blocks);
}
```

```cpp
#include <hip/hip_runtime.h>
#include <hip/hip_cooperative_groups.h>
#include <cstdio>
#include <cstdint>
namespace cg = cooperative_groups;

#define DEVI __device__ __forceinline__
typedef unsigned short bf16_t;
typedef short bf16x8 __attribute__((ext_vector_type(8)));
typedef float f32x4 __attribute__((ext_vector_type(4)));
typedef float f32x16 __attribute__((ext_vector_type(16)));
typedef unsigned u32x2 __attribute__((ext_vector_type(2)));
typedef unsigned u32x4 __attribute__((ext_vector_type(4)));

constexpr int T = 16384, SEQ = 4096, DM = 1024;
constexpr int NWAVES = 8, NT = 512;
constexpr int LDS_BYTES = 147456;
constexpr float EPS = 1e-6f;
constexpr float LOG2E = 1.4426950408889634f;
constexpr float QSCALE = 0.10206207261596575f * 1.4426950408889634f;

constexpr size_t MiB = 1u << 20;
constexpr size_t WS_SS2 = 0;
constexpr size_t WS_CNT = 512 * 1024;
constexpr size_t WS_SSQ = 64 * 1024, WS_SSKV = 128 * 1024;
constexpr size_t WS_WIN = 1 * MiB;
constexpr size_t WS_WUQ = 10 * MiB + 512 * 1024;
constexpr size_t WS_WUKV = 11 * MiB + 256 * 1024;
constexpr size_t WS_RWO = 12 * MiB;
constexpr size_t WS_MWO = 13 * MiB;
constexpr size_t WS_WOUT = 14 * MiB;
constexpr size_t WS_PWQ = 16 * MiB;
constexpr size_t WS_SUBK = 20 * MiB;
constexpr size_t WS_W2T = 20 * MiB + 512 * 1024;
constexpr size_t WS_A2T = WS_W2T + 64 * 1024;
constexpr size_t WS_G2T = WS_A2T + 64 * 1024;
constexpr size_t WS_G = 24 * MiB;
constexpr size_t WS_UB = 56 * MiB, WS_VB = 72 * MiB;
constexpr size_t WS_SC = 176 * MiB;
constexpr size_t WS_PRW = 88 * MiB;
constexpr size_t WS_Q = 88 * MiB, WS_K = 112 * MiB, WS_VT = 136 * MiB;
constexpr size_t WS_HB = 88 * MiB;
constexpr size_t WS_QD = 152 * MiB, WS_KVD = 164 * MiB, WS_KPE = 172 * MiB;
constexpr size_t WS_O = 152 * MiB;
constexpr size_t WS_R = 176 * MiB, WS_W = 192 * MiB, WS_KS = 208 * MiB, WS_V = 224 * MiB, WS_KK = 240 * MiB;
constexpr size_t WS_YA = 176 * MiB;
constexpr size_t WS_MIXED = 192 * MiB;
constexpr size_t WS_PQ = 184 * MiB;
constexpr size_t WS_TAB = 240 * MiB;
constexpr size_t DO_XN = 0;
constexpr size_t DO_BV = 0, DO_GT = 16 * MiB, DO_BONUS = 32 * MiB, DO_Y = 33 * MiB, DO_KRAW = 33 * MiB, DO_GL = 50 * MiB;

struct Params {
    const float* in[31];
    float* out;
    unsigned char* ws;
};

DEVI unsigned f2bf(float f) { unsigned u = __float_as_uint(f); return (u + 0x7fffu + ((u >> 16) & 1u)) >> 16; }
typedef float f32x2_t __attribute__((ext_vector_type(2)));
typedef __bf16 bf16x2_t __attribute__((ext_vector_type(2)));
DEVI unsigned pk2(float lo, float hi) { f32x2_t v = {lo, hi}; bf16x2_t b = __builtin_convertvector(v, bf16x2_t); return __builtin_bit_cast(unsigned, b); }
DEVI float bflo(unsigned u) { return __uint_as_float(u << 16); }
DEVI float bfhi(unsigned u) { return __uint_as_float(u & 0xffff0000u); }
DEVI float bf1(bf16_t u) { return __uint_as_float(((unsigned)u) << 16); }
DEVI float wave_sum(float v) {
#pragma unroll
    for (int o = 32; o >= 1; o >>= 1) v += __shfl_xor(v, o);
    return v;
}
DEVI float sigmoidf_(float x) { return __builtin_amdgcn_rcpf(1.f + __builtin_amdgcn_exp2f(-1.4426950408889634f * x)); }
DEVI float tanhf_(float x) { return 1.f - 2.f * __builtin_amdgcn_rcpf(__builtin_amdgcn_exp2f(2.885390081777927f * x) + 1.f); }
DEVI void st_bf4(bf16_t* p, float a, float b, float c, float d) { u32x2 w; w.x = pk2(a, b); w.y = pk2(c, d); *(u32x2*)p = w; }
DEVI void ld_bf4(const bf16_t* p, float (&o)[4]) { u32x2 w = *(const u32x2*)p; o[0] = bflo(w.x); o[1] = bfhi(w.x); o[2] = bflo(w.y); o[3] = bfhi(w.y); }
DEVI void ld_bf8(const bf16_t* p, float (&o)[8]) { u32x4 w = *(const u32x4*)p; o[0] = bflo(w.x); o[1] = bfhi(w.x); o[2] = bflo(w.y); o[3] = bfhi(w.y); o[4] = bflo(w.z); o[5] = bfhi(w.z); o[6] = bflo(w.w); o[7] = bfhi(w.w); }
DEVI bf16x8 pack8(const float (&v)[8]) { u32x4 w; w.x = pk2(v[0], v[1]); w.y = pk2(v[2], v[3]); w.z = pk2(v[4], v[5]); w.w = pk2(v[6], v[7]); return __builtin_bit_cast(bf16x8, w); }
DEVI f32x4 mfma16(bf16x8 a, bf16x8 b, f32x4 c) { return __builtin_amdgcn_mfma_f32_16x16x32_bf16(a, b, c, 0, 0, 0); }
DEVI f32x16 mfma32(bf16x8 a, bf16x8 b, f32x16 c) { return __builtin_amdgcn_mfma_f32_32x32x16_bf16(a, b, c, 0, 0, 0); }
DEVI int crow(int r, int hi) { return (r & 3) + 8 * (r >> 2) + 4 * hi; }


template <int CTRL> DEVI float dpp_f(float v) { return __builtin_bit_cast(float, __builtin_amdgcn_update_dpp(0, __builtin_bit_cast(int, v), CTRL, 0xf, 0xf, true)); }
template <int CTRL> DEVI unsigned dpp_u(unsigned v) { return (unsigned)__builtin_amdgcn_update_dpp(0, (int)v, CTRL, 0xf, 0xf, true); }
DEVI float sum8(float v) { v += dpp_f<0xB1>(v); v += dpp_f<0x4E>(v); v += dpp_f<0x141>(v); return v; }
DEVI float sum16(float v) { v = sum8(v); v += dpp_f<0x140>(v); return v; }
DEVI unsigned umax2(unsigned a, unsigned b) { return a > b ? a : b; }
DEVI unsigned umax16(unsigned v) { v = umax2(v, dpp_u<0xB1>(v)); v = umax2(v, dpp_u<0x4E>(v)); v = umax2(v, dpp_u<0x141>(v)); v = umax2(v, dpp_u<0x140>(v)); return v; }
DEVI unsigned rdlane(unsigned v, int l) { return (unsigned)__builtin_amdgcn_readlane((int)v, l); }
#define LAS __attribute__((address_space(3)))

DEVI unsigned pk4_fp8(float a, float b, float c, float d) { int w = 0; w = __builtin_amdgcn_cvt_pk_fp8_f32(a, b, w, false); w = __builtin_amdgcn_cvt_pk_fp8_f32(c, d, w, true); return (unsigned)w; }
DEVI f32x4 mfma16_fp8(u32x2 a, u32x2 b, f32x4 c) { return __builtin_amdgcn_mfma_f32_16x16x32_fp8_fp8(__builtin_bit_cast(long, a), __builtin_bit_cast(long, b), c, 0, 0, 0); }
DEVI unsigned pk4_u8(float a, float b, float c, float d) { unsigned w = 0; w = __builtin_amdgcn_cvt_pk_u8_f32(a, 0, w); w = __builtin_amdgcn_cvt_pk_u8_f32(b, 1, w); w = __builtin_amdgcn_cvt_pk_u8_f32(c, 2, w); w = __builtin_amdgcn_cvt_pk_u8_f32(d, 3, w); return w; }
constexpr float U8_SCALE = 32.f, V8_SCALE = 4.f;
constexpr float C8_SCALE = 256.f;

template <int OFF> DEVI f32x4 lds_rd128(unsigned a) { f32x4 r; asm volatile("ds_read_b128 %0, %1 offset:%2" : "=v"(r) : "v"(a), "i"(OFF)); return r; }
template <int OFF> DEVI float lds_rd32(unsigned a) { float r; asm volatile("ds_read_b32 %0, %1 offset:%2" : "=v"(r) : "v"(a), "i"(OFF)); return r; }
DEVI void lds_wr32(unsigned a, float v) { asm volatile("ds_write_b32 %0, %1" ::"v"(a), "v"(v) : "memory"); }

#define SW64(r, k) ((r) * 64 + (((((k) >> 3) ^ ((r) & 7))) << 3) + ((k) & 7))
#define SW32(r, c) ((r) * 32 + (((((c) >> 3) ^ (((r) >> 2) & 3))) << 3) + ((c) & 7))
DEVI int swz_off(int r, int chunk, int ld) { return ld == 64 ? r * 64 + ((chunk ^ (r & 7)) << 3) : r * 32 + ((chunk ^ ((r >> 2) & 3)) << 3); }
template <int MT, int NTL, int KS>
DEVI void gemm_lds(const LAS bf16_t* A, int lda, const LAS bf16_t* B, int ldb, f32x4 (&acc)[MT][NTL], int fr, int fq) {
#pragma unroll
    for (int ks = 0; ks < KS; ++ks) {
        bf16x8 a[MT], b[NTL];
#pragma unroll
        for (int m = 0; m < MT; ++m) a[m] = *(const LAS bf16x8*)(A + swz_off(16 * m + fr, 4 * ks + fq, lda));
#pragma unroll
        for (int n = 0; n < NTL; ++n) b[n] = *(const LAS bf16x8*)(B + swz_off(16 * n + fr, 4 * ks + fq, ldb));
#pragma unroll
        for (int m = 0; m < MT; ++m)
#pragma unroll
            for (int n = 0; n < NTL; ++n) acc[m][n] = mfma16(b[n], a[m], acc[m][n]);
    }
}
DEVI bf16_t bf1of(float x) { return (bf16_t)(pk2(x, x) & 0xffffu); }
DEVI void gemm_tile_acc(const bf16_t* __restrict__ A, int lda, const bf16_t* __restrict__ Bt, int ldb, int K, int m0, int n0, int lane, f32x4 (&acc)[4][4]) {
    const int fr = lane & 15, fq = lane >> 4;
    const bf16_t* ap = A + (size_t)(m0 + fr) * lda + fq * 8;
    const bf16_t* bp = Bt + (size_t)(n0 + fr) * ldb + fq * 8;
#pragma unroll 2
    for (int k0 = 0; k0 < K; k0 += 32) {
        bf16x8 a[4], b[4];
#pragma unroll
        for (int m = 0; m < 4; ++m) a[m] = *(const bf16x8*)(ap + (size_t)m * 16 * lda + k0);
#pragma unroll
        for (int n = 0; n < 4; ++n) b[n] = *(const bf16x8*)(bp + (size_t)n * 16 * ldb + k0);
#pragma unroll
        for (int m = 0; m < 4; ++m)
#pragma unroll
            for (int n = 0; n < 4; ++n) acc[m][n] = mfma16(b[n], a[m], acc[m][n]);
    }
}
DEVI void zero_acc(f32x4 (&acc)[4][4]) {
#pragma unroll
    for (int m = 0; m < 4; ++m)
#pragma unroll
        for (int n = 0; n < 4; ++n) acc[m][n] = (f32x4){0.f, 0.f, 0.f, 0.f};
}


namespace pg8 {
#define PG8_LAS __attribute__((address_space(3)))
typedef unsigned short bf16_t;
typedef short bf16x8 __attribute__((ext_vector_type(8)));
typedef float f32x4 __attribute__((ext_vector_type(4)));
typedef unsigned u32x4 __attribute__((ext_vector_type(4)));
constexpr int BM = 256, BK = 64, HALF = 128, HTB = HALF * BK * 2  , STAGE_BYTES = 8 * HTB, NXCD = 8, WGM = 8;

__host__ __device__ __forceinline__ int lds_byte(int r, int c) { const int st = (r >> 4) * 2 + (c >> 5), rr = r & 15, cc = c & 31, ob = rr * 64 + cc * 2; return st * 1024 + (ob ^ (((ob >> 9) & 1) << 5)); }
__host__ __device__ __forceinline__ void stage_rc(int b, int& R, int& C) { const int st = b / 1024, sb = b % 1024, swz = sb ^ (((sb >> 9) & 1) << 5); R = (st >> 1) * 16 + swz / 64; C = (st & 1) * 32 + (swz % 64) / 2; }
__host__ __device__ __forceinline__ int perm32(int rho) { const int n = rho >> 4, i = rho & 15; return 8 * (i >> 2) + 4 * n + (i & 3); }

struct Unit { int pm, pn; };
struct Gemm { const bf16_t* A; const bf16_t* Bt; int M, N, K; };

struct StaticOrder {
    int nM, nN, nwg, G, c;
    __host__ __device__ void init(int M, int N, int G_, int c_) { nM = M / BM; nN = N / BM; nwg = nM * nN; G = G_; c = c_; }
    __host__ __device__ bool next(int i, Unit& u) const {
        const long L = (long)i * G + c; if (L >= nwg) return false;
        int wgid = (int)L; { const int q = nwg / NXCD, r = nwg % NXCD, xcd = wgid % NXCD, off = wgid / NXCD; wgid = (xcd < r ? xcd * (q + 1) : r * (q + 1) + (xcd - r) * q) + off; }
        const int nig = WGM * nN, gid = wgid / nig, fm = gid * WGM, gsz = (nM - fm) < WGM ? (nM - fm) : WGM;
        u.pm = fm + ((wgid % nig) % gsz); u.pn = (wgid % nig) / gsz; return true;
    }
    __device__ __forceinline__ void a_ready(const Unit&) const {}
    __device__ __forceinline__ void done(const Unit&) const {}
};


DEVI float sigm(float x) { return __builtin_amdgcn_rcpf(1.f + __builtin_amdgcn_exp2f(-1.4426950408889634f * x)); }
DEVI u32x4 pack8v(f32x4 a, f32x4 b) { u32x4 w; w.x = pk2(a[0], a[1]); w.y = pk2(a[2], a[3]); w.z = pk2(b[0], b[1]); w.w = pk2(b[2], b[3]); return w; }
struct EpiP1 {
    static constexpr bool PERM = true, AFTER_DRAIN = false;
    unsigned char* ws;
    __device__ __forceinline__ void operator()(const f32x4 (&acc)[2][2][4][2], const Unit& u, int wr, int wc, int fr_in, int fq_in) const {
        int fr = fr_in, fq = fq_in; asm volatile("" : "+v"(fr), "+v"(fq));
        const int row0 = u.pm * BM + wr * 64 + fr;
        if (u.pn >= 8 && u.pn < 11) {
#pragma unroll
            for (int bj = 0; bj < 2; ++bj) {
                const int c = (u.pn - 8) * 256 + bj * HALF + wc * 32 + 8 * fq;
                const size_t off = c < 384 ? WS_QD : (c < 640 ? WS_KVD : WS_KPE);
                const int ld = c < 384 ? 384 : (c < 640 ? 256 : 32), cc = c < 384 ? c : (c < 640 ? c - 384 : c - 640);
                if (c < 672) {
#pragma unroll
                    for (int ai = 0; ai < 2; ++ai)
#pragma unroll
                        for (int m = 0; m < 4; ++m) { const size_t row = (size_t)(row0 + ai * HALF + m * 16);
                            *(u32x4*)(ws + off + (row * ld + cc) * 2) = pack8v(acc[ai][bj][m][0], acc[ai][bj][m][1]); }
                }
            }
            return;
        }
        if (u.pn >= 11) {
            const int col0 = (u.pn - 11) * 256 + wc * 32 + 8 * fq;
#pragma unroll
            for (int ai = 0; ai < 2; ++ai)
#pragma unroll
                for (int m = 0; m < 4; ++m) { unsigned char* rowp = ws + WS_G + ((size_t)(row0 + ai * HALF + m * 16) * 2048 + col0);
#pragma unroll
                    for (int bj = 0; bj < 2; ++bj) { const f32x4 v0 = acc[ai][bj][m][0], v1 = acc[ai][bj][m][1];
                        u32x2 w; w.x = pk4_u8(sigm(v0[0]) * 255.f, sigm(v0[1]) * 255.f, sigm(v0[2]) * 255.f, sigm(v0[3]) * 255.f);
                        w.y = pk4_u8(sigm(v1[0]) * 255.f, sigm(v1[1]) * 255.f, sigm(v1[2]) * 255.f, sigm(v1[3]) * 255.f);
                        *(u32x2*)(rowp + bj * HALF) = w; } }
            return;
        }
        const int col0 = u.pn * 256 + wc * 32 + 8 * fq;
#pragma unroll
        for (int ai = 0; ai < 2; ++ai)
#pragma unroll
            for (int m = 0; m < 4; ++m) { unsigned char* rowp = ws + WS_PRW + ((size_t)(row0 + ai * HALF + m * 16) * 2048 + col0) * 2;
#pragma unroll
                for (int bj = 0; bj < 2; ++bj) *(u32x4*)(rowp + bj * HALF * 2) = pack8v(acc[ai][bj][m][0], acc[ai][bj][m][1]); }
    }
};
struct EpiQraw {
    static constexpr bool PERM = true, AFTER_DRAIN = false;
    bf16_t* q; const float* ssq;
    __device__ __forceinline__ void operator()(const f32x4 (&acc)[2][2][4][2], const Unit& u, int wr, int wc, int fr_in, int fq_in) const {
        int fr = fr_in, fq = fq_in; asm volatile("" : "+v"(fr), "+v"(fq));
        const int row0 = u.pm * BM + wr * 64 + fr, col0 = u.pn * BM + wc * 32 + 8 * fq;
#pragma unroll
        for (int ai = 0; ai < 2; ++ai)
#pragma unroll
            for (int m = 0; m < 4; ++m) { const size_t row = (size_t)(row0 + ai * HALF + m * 16); const float rs = ssq[row];
#pragma unroll
                for (int bj = 0; bj < 2; ++bj) *(u32x4*)(q + row * 768 + col0 + bj * HALF) = pack8v(acc[ai][bj][m][0] * rs, acc[ai][bj][m][1] * rs); }
    }
};
struct EpiKVraw {
    static constexpr bool PERM = true, AFTER_DRAIN = false;
    bf16_t* kraw; bf16_t* vt; const float* sskv;
    __device__ __forceinline__ void operator()(const f32x4 (&acc)[2][2][4][2], const Unit& u, int wr, int wc, int fr_in, int fq_in) const {
        int fr = fr_in, fq = fq_in; asm volatile("" : "+v"(fr), "+v"(fq));
        const int row0 = u.pm * BM + wr * 64 + fr;
#pragma unroll
        for (int ai = 0; ai < 2; ++ai)
#pragma unroll
            for (int m = 0; m < 4; ++m) { const int row = row0 + ai * HALF + m * 16; const float rs = sskv[row];
#pragma unroll
                for (int bj = 0; bj < 2; ++bj) { const f32x4 v0 = acc[ai][bj][m][0] * rs, v1 = acc[ai][bj][m][1] * rs;
                    if (u.pn < 2) *(u32x4*)(kraw + (size_t)row * 512 + u.pn * BM + bj * HALF + wc * 32 + 8 * fq) = pack8v(v0, v1);
                    else { const int c = (u.pn - 2) * BM + bj * HALF + wc * 32 + 8 * fq, h = c >> 6, d = c & 63; const int bb = row >> 12, s = row & 4095;
                        const int kt = s >> 5, k4 = s & 15, jj = 4 * (k4 >> 3) + (k4 & 3), hv = (k4 >> 2) & 1;
                        bf16_t* vp = vt + ((((size_t)(bb * 8 + h) * 128 + kt) * 2 + (d >> 5)) * 2 + ((s >> 4) & 1)) * 512 + ((d & 31) + 32 * hv) * 8 + jj; const u32x4 w = pack8v(v0, v1);
                        vp[0] = (bf16_t)(w.x & 0xffffu); vp[8] = (bf16_t)(w.x >> 16); vp[16] = (bf16_t)(w.y & 0xffffu); vp[24] = (bf16_t)(w.y >> 16);
                        vp[32] = (bf16_t)(w.z & 0xffffu); vp[40] = (bf16_t)(w.z >> 16); vp[48] = (bf16_t)(w.w & 0xffffu); vp[56] = (bf16_t)(w.w >> 16); } } }
    }
};
struct EpiGate {
    static constexpr bool PERM = true, AFTER_DRAIN = false;
    bf16_t* mixed; const unsigned char* gg; int goff; int add;
    __device__ __forceinline__ void operator()(const f32x4 (&acc)[2][2][4][2], const Unit& u, int wr, int wc, int fr_in, int fq_in) const {
        int fr = fr_in, fq = fq_in; asm volatile("" : "+v"(fr), "+v"(fq));
        const int row0 = u.pm * BM + wr * 64 + fr, col0 = u.pn * BM + wc * 32 + 8 * fq;
#pragma unroll
        for (int ai = 0; ai < 2; ++ai)
#pragma unroll
            for (int m = 0; m < 4; ++m) { const size_t row = (size_t)(row0 + ai * HALF + m * 16);
#pragma unroll
                for (int bj = 0; bj < 2; ++bj) { const int col = col0 + bj * HALF;
                    const u32x2 gw = *(const u32x2*)(gg + row * 2048 + goff + col);
                    const f32x4 g0 = (f32x4){(float)(gw.x & 0xffu), (float)((gw.x >> 8) & 0xffu), (float)((gw.x >> 16) & 0xffu), (float)(gw.x >> 24)};
                    const f32x4 g1 = (f32x4){(float)(gw.y & 0xffu), (float)((gw.y >> 8) & 0xffu), (float)((gw.y >> 16) & 0xffu), (float)(gw.y >> 24)};
                    f32x4 v0 = g0 * (acc[ai][bj][m][0] * (1.f / 255.f)), v1 = g1 * (acc[ai][bj][m][1] * (1.f / 255.f));
                    if (add) { const u32x4 pw = *(const u32x4*)(mixed + row * 1024 + col);
                        v0 += (f32x4){__uint_as_float(pw.x << 16), __uint_as_float(pw.x & 0xffff0000u), __uint_as_float(pw.y << 16), __uint_as_float(pw.y & 0xffff0000u)};
                        v1 += (f32x4){__uint_as_float(pw.z << 16), __uint_as_float(pw.z & 0xffff0000u), __uint_as_float(pw.w << 16), __uint_as_float(pw.w & 0xffff0000u)}; }
                    *(u32x4*)(mixed + row * 1024 + col) = pack8v(v0, v1); } }
    }
};
struct EpiRes {
    static constexpr bool PERM = true, AFTER_DRAIN = false;
    const float* x; bf16_t* hb; float* ss2;
    __device__ __forceinline__ void operator()(const f32x4 (&acc)[2][2][4][2], const Unit& u, int wr, int wc, int fr_in, int fq_in) const {
        int fr = fr_in, fq = fq_in; asm volatile("" : "+v"(fr), "+v"(fq));
        const int row0 = u.pm * BM + wr * 64 + fr, col0 = u.pn * BM + wc * 32 + 8 * fq;
#pragma unroll
        for (int ai = 0; ai < 2; ++ai)
#pragma unroll
            for (int m = 0; m < 4; ++m) { const size_t row = (size_t)(row0 + ai * HALF + m * 16); float sq = 0.f;
#pragma unroll
                for (int bj = 0; bj < 2; ++bj) { const size_t o = row * 1024 + col0 + bj * HALF;
                    const f32x4 h0 = *(const f32x4*)(x + o) + acc[ai][bj][m][0], h1 = *(const f32x4*)(x + o + 4) + acc[ai][bj][m][1];
                    *(u32x4*)(hb + o) = pack8v(h0, h1);
                    sq += (h0[0] * h0[0] + h0[1] * h0[1]) + (h0[2] * h0[2] + h0[3] * h0[3]) + (h1[0] * h1[0] + h1[1] * h1[1]) + (h1[2] * h1[2] + h1[3] * h1[3]); }
                sq += __shfl_xor(sq, 16); sq += __shfl_xor(sq, 32);
                if (fq == 0) atomicAdd(ss2 + row, sq); }
    }
};
struct EpiScale {
    static constexpr bool PERM = true, AFTER_DRAIN = false;
    bf16_t* pq; const float* ss2;
    __device__ __forceinline__ void operator()(const f32x4 (&acc)[2][2][4][2], const Unit& u, int wr, int wc, int fr_in, int fq_in) const {
        int fr = fr_in, fq = fq_in; asm volatile("" : "+v"(fr), "+v"(fq));
        const int row0 = u.pm * BM + wr * 64 + fr, col0 = u.pn * BM + wc * 32 + 8 * fq;
#pragma unroll
        for (int ai = 0; ai < 2; ++ai)
#pragma unroll
            for (int m = 0; m < 4; ++m) { const size_t row = (size_t)(row0 + ai * HALF + m * 16); const float rs = rsqrtf(ss2[row] * (1.f / 1024.f) + 1e-6f);
#pragma unroll
                for (int bj = 0; bj < 2; ++bj) *(u32x4*)(pq + row * 2048 + col0 + bj * HALF) = pack8v(acc[ai][bj][m][0] * rs, acc[ai][bj][m][1] * rs); }
    }
};
template <class Epi, class Sched, bool ALIGN_EPI = false, bool SP2 = false>
__device__ __forceinline__ void gemm_phase(PG8_LAS unsigned char* lds, const Gemm g, const Sched& S, const Epi& E) {
    int tid_l = threadIdx.x; asm volatile("" : "+v"(tid_l));
    const int tid = tid_l, wid = __builtin_amdgcn_readfirstlane(tid >> 6), lane = tid & 63, wr = wid >> 2, wc = wid & 3, fr = lane & 15, fq = lane >> 4;
    const int K = g.K, nt = K / BK;
    unsigned voffA[2], voffB[2];
#pragma unroll
    for (int i = 0; i < 2; ++i) { int R, C; stage_rc(tid * 16 + i * 8192, R, C); const int Rb = Epi::PERM ? ((R & ~31) + perm32(R & 31)) : R;
        voffA[i] = (unsigned)(R * K + C) * 2u; voffB[i] = (unsigned)(Rb * K + C) * 2u; }
    const size_t kstep = (size_t)(BK * 2);
    const size_t hstep = (size_t)HALF * K * 2;
    const size_t tstep = 2 * hstep;
    const unsigned ldsw = (unsigned)wid * 1024u;
    const int aoff = lds_byte(wr * 64 + fr, fq * 8), boff = lds_byte(wc * 32 + fr, fq * 8);
#define PG8_SA(b, h) (((b) * 2 + (h)) * HTB)
#define PG8_SB(b, h) ((4 + (b) * 2 + (h)) * HTB)
#define PG8_STAGE(bufoff, gbase, voff) do { _Pragma("unroll") for (int _i = 0; _i < 2; ++_i) \
        __builtin_amdgcn_global_load_lds((const unsigned*)((const char*)(gbase) + (voff)[_i]), (PG8_LAS unsigned*)(lds + (bufoff) + ldsw + _i * 8192), 16, 0, 0); } while (0)
#define PG8_LDA(dst, b, h) do { _Pragma("unroll") for (int m = 0; m < 4; ++m) _Pragma("unroll") for (int k = 0; k < 2; ++k) dst[m][k] = *(const PG8_LAS bf16x8*)(lds + PG8_SA(b, h) + aoff + m * 2048 + k * 1024); } while (0)
#define PG8_LDB(dst, b, h) do { _Pragma("unroll") for (int n = 0; n < 2; ++n) _Pragma("unroll") for (int k = 0; k < 2; ++k) dst[n][k] = *(const PG8_LAS bf16x8*)(lds + PG8_SB(b, h) + boff + n * 2048 + k * 1024); } while (0)
#define PG8_MMA(ai, bj, At, Bt) do { __builtin_amdgcn_s_setprio(1); _Pragma("unroll") for (int m = 0; m < 4; ++m) _Pragma("unroll") for (int n = 0; n < 2; ++n) _Pragma("unroll") for (int k = 0; k < 2; ++k) \
        acc[ai][bj][m][n] = __builtin_amdgcn_mfma_f32_16x16x32_bf16(Bt[n][k], At[m][k], acc[ai][bj][m][n], 0, 0, 0); __builtin_amdgcn_s_setprio(0); } while (0)
#define PG8_WAIT_V(n) asm volatile("s_waitcnt vmcnt(" #n ")" ::: "memory")
#define PG8_WAIT_L(n) asm volatile("s_waitcnt lgkmcnt(" #n ")" ::: "memory")
#define PG8_BAR __builtin_amdgcn_s_barrier()
#define PG8_SCHED __builtin_amdgcn_sched_barrier(0)
    Unit cur, nxt; int ui = 0;
    if (!S.next(0, cur)) return;
    f32x4 acc[2][2][4][2];
#pragma unroll
    for (int a = 0; a < 2; ++a)
#pragma unroll
        for (int b = 0; b < 2; ++b)
#pragma unroll
            for (int m = 0; m < 4; ++m)
#pragma unroll
                for (int n = 0; n < 2; ++n) acc[a][b][m][n] = (f32x4){0.f, 0.f, 0.f, 0.f};
    bf16x8 At[4][2], B0[2][2], B1[2][2];
    const char* cA = (const char*)g.A + (size_t)cur.pm * tstep; const char* cB = (const char*)g.Bt + (size_t)cur.pn * tstep;
    S.a_ready(cur);
    if constexpr (SP2) {
        PG8_STAGE(PG8_SB(0, 0), cB, voffB); PG8_STAGE(PG8_SB(0, 1), cB + hstep, voffB); PG8_STAGE(PG8_SA(0, 0), cA, voffA); PG8_STAGE(PG8_SA(0, 1), cA + hstep, voffA);
        if (wr == 1) PG8_BAR;
        PG8_WAIT_V(2); PG8_BAR;
        PG8_STAGE(PG8_SB(1, 0), cB + kstep, voffB); PG8_STAGE(PG8_SA(1, 0), cA + kstep, voffA); PG8_STAGE(PG8_SB(1, 1), cB + hstep + kstep, voffB);
        PG8_WAIT_V(6); PG8_BAR;
    } else {
        PG8_STAGE(PG8_SB(0, 0), cB, voffB); PG8_STAGE(PG8_SA(0, 0), cA, voffA); PG8_STAGE(PG8_SB(0, 1), cB + hstep, voffB); PG8_STAGE(PG8_SA(0, 1), cA + hstep, voffA);
        if (wr == 1) PG8_BAR;
        PG8_WAIT_V(4); PG8_BAR;
        PG8_STAGE(PG8_SB(1, 0), cB + kstep, voffB); PG8_STAGE(PG8_SA(1, 0), cA + kstep, voffA); PG8_STAGE(PG8_SB(1, 1), cB + hstep + kstep, voffB);
        PG8_WAIT_V(6); PG8_BAR;
    }
    for (;;) {
        const bool has_next = S.next(ui + 1, nxt);
        const char* nA = has_next ? (const char*)g.A + (size_t)nxt.pm * tstep : cA; const char* nB = has_next ? (const char*)g.Bt + (size_t)nxt.pn * tstep : cB;
        for (int t = 0; t < nt; t += 2) {
            const bool last = (t == nt - 2);
            const char* a1 = cA + (size_t)(t + 1) * kstep;
            const char* a2 = last ? nA : cA + (size_t)(t + 2) * kstep; const char* b2 = last ? nB : cB + (size_t)(t + 2) * kstep;
            const char* a3 = a2 + kstep; const char* b3 = b2 + kstep;
            if (last && has_next) S.a_ready(nxt);
            if constexpr (SP2) {
            PG8_LDB(B0, 0, 0); PG8_LDB(B1, 0, 1); PG8_SCHED; PG8_LDA(At, 0, 0); PG8_STAGE(PG8_SA(1, 1), a1 + hstep, voffA);
            PG8_WAIT_V(8); PG8_WAIT_L(0); PG8_BAR; PG8_MMA(0, 0, At, B0); PG8_MMA(0, 1, At, B1); PG8_BAR; PG8_SCHED;
            PG8_LDA(At, 0, 1); PG8_STAGE(PG8_SB(0, 0), b2, voffB); PG8_STAGE(PG8_SB(0, 1), b2 + hstep, voffB); PG8_STAGE(PG8_SA(0, 0), a2, voffA);
            PG8_WAIT_V(8); PG8_WAIT_L(0); PG8_BAR; PG8_MMA(1, 0, At, B0); PG8_MMA(1, 1, At, B1); PG8_BAR; PG8_SCHED;
            PG8_LDB(B0, 1, 0); PG8_LDB(B1, 1, 1); PG8_SCHED; PG8_LDA(At, 1, 0); PG8_STAGE(PG8_SA(0, 1), a2 + hstep, voffA);
            PG8_WAIT_V(8); PG8_WAIT_L(0); PG8_BAR; PG8_MMA(0, 0, At, B0); PG8_MMA(0, 1, At, B1); PG8_BAR; PG8_SCHED;
            PG8_LDA(At, 1, 1); PG8_STAGE(PG8_SB(1, 0), b3, voffB); PG8_STAGE(PG8_SB(1, 1), b3 + hstep, voffB); PG8_STAGE(PG8_SA(1, 0), a3, voffA);
            PG8_WAIT_V(8); PG8_WAIT_L(0); PG8_BAR; PG8_MMA(1, 0, At, B0); PG8_MMA(1, 1, At, B1); PG8_BAR; PG8_SCHED;
            } else {
            PG8_LDB(B0, 0, 0); PG8_SCHED; PG8_LDA(At, 0, 0); PG8_STAGE(PG8_SA(1, 1), a1 + hstep, voffA);
            PG8_WAIT_L(8); PG8_BAR; PG8_WAIT_L(0); PG8_MMA(0, 0, At, B0); PG8_BAR; PG8_SCHED;
            PG8_LDB(B1, 0, 1); PG8_STAGE(PG8_SB(0, 0), b2, voffB);
            PG8_BAR; PG8_WAIT_L(0); PG8_MMA(0, 1, At, B1); PG8_BAR;
            PG8_LDA(At, 0, 1); PG8_STAGE(PG8_SA(0, 0), a2, voffA);
            PG8_BAR; PG8_WAIT_L(0); PG8_MMA(1, 0, At, B0); PG8_BAR; PG8_SCHED;
            PG8_STAGE(PG8_SB(0, 1), b2 + hstep, voffB);
            PG8_WAIT_V(6); PG8_BAR; PG8_MMA(1, 1, At, B1); PG8_BAR;
            PG8_LDB(B0, 1, 0); PG8_SCHED; PG8_LDA(At, 1, 0); PG8_STAGE(PG8_SA(0, 1), a2 + hstep, voffA);
            PG8_WAIT_L(8); PG8_BAR; PG8_WAIT_L(0); PG8_MMA(0, 0, At, B0); PG8_BAR; PG8_SCHED;
            PG8_LDB(B1, 1, 1); PG8_STAGE(PG8_SB(1, 0), b3, voffB);
            PG8_BAR; PG8_WAIT_L(0); PG8_MMA(0, 1, At, B1); PG8_BAR;
            PG8_LDA(At, 1, 1); PG8_STAGE(PG8_SA(1, 0), a3, voffA);
            PG8_BAR; PG8_WAIT_L(0); PG8_MMA(1, 0, At, B0); PG8_BAR; PG8_SCHED;
            PG8_STAGE(PG8_SB(1, 1), b3 + hstep, voffB);
            PG8_WAIT_V(6); PG8_BAR; PG8_MMA(1, 1, At, B1); PG8_BAR;
            }
        }
        if constexpr (ALIGN_EPI) { if (wr == 0) PG8_BAR; }
        if constexpr (!Epi::AFTER_DRAIN) { E(acc, cur, wr, wc, fr, fq); S.done(cur); }
        if (!has_next) break;
#pragma unroll
        for (int a = 0; a < 2; ++a)
#pragma unroll
            for (int b = 0; b < 2; ++b)
#pragma unroll
                for (int m = 0; m < 4; ++m)
#pragma unroll
                    for (int n = 0; n < 2; ++n) acc[a][b][m][n] = (f32x4){0.f, 0.f, 0.f, 0.f};
        cur = nxt; cA = nA; cB = nB; ++ui;
        if constexpr (ALIGN_EPI) { if (wr == 1) PG8_BAR; }
    }
    PG8_WAIT_V(0);
    if constexpr (!ALIGN_EPI) { if (wr == 0) PG8_BAR; }
    PG8_BAR;
    if constexpr (Epi::AFTER_DRAIN) { E.fused(acc, cur, wr, wc, fr, fq, lds, wid, lane); S.done(cur); }
#undef PG8_SA
#undef PG8_SB
#undef PG8_STAGE
#undef PG8_LDA
#undef PG8_LDB
#undef PG8_MMA
#undef PG8_WAIT_V
#undef PG8_WAIT_L
#undef PG8_BAR
#undef PG8_SCHED
}
}


#define RLX_AGENT __ATOMIC_RELAXED, __HIP_MEMORY_SCOPE_AGENT
#define XB_TMO      128
#define XB_XCNT(j)  (256  + 64 * (j))
#define XB_XSUB(j)  (1280 + 64 * (j))
#define XB_XGEN(j)  (2304 + 64 * (j))
#define XB_TOP      3328
#define XB_TOPGEN   3392
#define XCD_BAR_WORDS 3456
#define XB_SPIN_CAP (1u << 18)

__device__ __forceinline__ unsigned xb_ld(unsigned* p)              { return __hip_atomic_load(p, __ATOMIC_RELAXED, __HIP_MEMORY_SCOPE_AGENT); }
__device__ __forceinline__ unsigned xb_add(unsigned* p, unsigned v) { return __hip_atomic_fetch_add(p, v, __ATOMIC_RELAXED, __HIP_MEMORY_SCOPE_AGENT); }
__device__ __forceinline__ unsigned xb_xcc_id() { return (unsigned)__builtin_amdgcn_s_getreg((3 << 11) | 20) & 0xFu; }
#define XB_SPIN(cond, bar) do { unsigned _sp = 0; while (cond) { __builtin_amdgcn_s_sleep(1); \
    if ((++_sp & 255u) == 0u) { if (xb_ld(&(bar)[XB_TMO])) break; if (_sp > XB_SPIN_CAP) { atomicAdd(&(bar)[XB_TMO], 1u); break; } } } } while (0)

struct XcdBarrier {
    unsigned* bar; unsigned x;
    volatile LAS unsigned* st;
};

__device__ __forceinline__ XcdBarrier xcd_barrier_post(unsigned* bar, volatile LAS unsigned* st) {
    XcdBarrier b; b.bar = bar; b.x = xb_xcc_id(); b.st = st;
    if (threadIdx.x == 0) (void)xb_add(&bar[XB_XCNT(b.x)], 1u);
    return b;
}
__device__ __forceinline__ void xcd_barrier_complete(unsigned* bar, unsigned x, unsigned& nloc, unsigned& nx) {
    const unsigned G = gridDim.x * gridDim.y * gridDim.z;
    unsigned sum, cnt, mine, sp = 0u;
    for (;;) {
        sum = 0u; cnt = 0u; mine = 0u;
#pragma unroll
        for (unsigned j = 0; j < 16; ++j) { const unsigned c = xb_ld(&bar[XB_XCNT(j)]); sum += c; cnt += (c > 0u) ? 1u : 0u; mine = (j == x) ? c : mine; }
        if (sum == G) break;
        __builtin_amdgcn_s_sleep(1);
        if ((++sp & 255u) == 0u) { if (xb_ld(&bar[XB_TMO])) break; if (sp > XB_SPIN_CAP) { atomicAdd(&bar[XB_TMO], 1u); break; } }
    }
    nloc = mine > 0u ? mine : 1u; nx = cnt > 0u ? cnt : 1u;
}

__device__ __forceinline__ void xcd_barrier(const XcdBarrier& b) {
    asm volatile("s_waitcnt vmcnt(0)" ::: "memory");
    __syncthreads();
    if (threadIdx.x == 0) {
        unsigned* bar = b.bar;
        __builtin_amdgcn_s_waitcnt(0);
        unsigned nloc = b.st[0], nx = b.st[1];
        if (nloc == 0u) { xcd_barrier_complete(bar, b.x, nloc, nx); b.st[0] = nloc; b.st[1] = nx; }
        const unsigned old = xb_add(&bar[XB_XSUB(b.x)], 1u);
        const unsigned gen = old / nloc;
        if (old + 1u == (gen + 1u) * nloc) {
            __builtin_amdgcn_fence(__ATOMIC_RELEASE, "agent");
            asm volatile("s_waitcnt vmcnt(0)" ::: "memory");
            const unsigned og = xb_add(&bar[XB_TOP], 1u);
            const unsigned tg = og / nx;
            if (og + 1u == (tg + 1u) * nx) xb_add(&bar[XB_TOPGEN], 1u);
            else XB_SPIN(xb_ld(&bar[XB_TOPGEN]) == tg, bar);
            __builtin_amdgcn_fence(__ATOMIC_ACQUIRE, "agent");
            xb_add(&bar[XB_XGEN(b.x)], 1u);
            asm volatile("s_waitcnt vmcnt(0)" ::: "memory");
        } else {
            XB_SPIN(xb_ld(&bar[XB_XGEN(b.x)]) == gen, bar);
            __builtin_amdgcn_fence(__ATOMIC_ACQUIRE, "agent");
            asm volatile("s_waitcnt vmcnt(0)" ::: "memory");
        }
    }
    __syncthreads();
}

DEVI void transpose_item(const float* __restrict__ W, int ldw, int c0, bf16_t* WT, int ldk, int r0, int Kmax, int kb, int nb, const float* kscale, float* scr, int lane, int fragKS = 0) {
    const int k0 = 64 * kb, n0 = 32 * nb;
#pragma unroll 8
    for (int i = 0; i < 32; ++i) {
        const int kk = 2 * i + (lane >> 5);
        float v = 0.f;
        if (k0 + kk < Kmax) { v = W[(size_t)(k0 + kk) * ldw + c0 + n0 + (lane & 31)]; if (kscale) v *= kscale[k0 + kk]; }
        scr[kk * 33 + (lane & 31)] = v;
    }
    asm volatile("s_waitcnt lgkmcnt(0)" ::: "memory");
    asm volatile("" ::: "memory");
    const int c = lane & 7;
    if (k0 + 8 * c < Kmax) {
#pragma unroll
        for (int j = 0; j < 4; ++j) {
            const int n = (lane >> 3) + 8 * j;
            const float* s = scr + (8 * c) * 33 + n;
            u32x4 o; o.x = pk2(s[0], s[33]); o.y = pk2(s[66], s[99]); o.z = pk2(s[132], s[165]); o.w = pk2(s[198], s[231]);
            if (fragKS > 0) { const int row = r0 + n0 + n, k = k0 + 8 * c, hd = row >> 6, rr = row & 63;
                *(u32x4*)(WT + ((size_t)(((hd * fragKS + (k >> 5)) * 4 + ((rr >> 2) & 3)) * 64 + ((k >> 3) & 3) * 16 + 4 * (rr >> 4) + (rr & 3))) * 8) = o; }
            else *(u32x4*)(WT + (size_t)(r0 + n0 + n) * ldk + k0 + 8 * c) = o;
        }
    }
    asm volatile("s_waitcnt lgkmcnt(0)" ::: "memory");
    asm volatile("" ::: "memory");
}


DEVI void wcomb_item(const float* __restrict__ Wq, const float* __restrict__ Sk, const float* __restrict__ n2w, bf16_t* WcT, int it, int lane) {
    const int fr = lane & 15, fq = lane >> 4;
    const int hp = it >> 6, nt = (it >> 4) & 3, kt = it & 15;
    const float* ap = Sk + ((size_t)hp * 128 + nt * 32 + fr) * 128 + fq * 8;
    const float* bp = Wq + (size_t)(kt * 64 + fr) * 2048 + hp * 128 + fq * 8;
    f32x4 acc[2][4];
#pragma unroll
    for (int m = 0; m < 2; ++m)
#pragma unroll
        for (int n = 0; n < 4; ++n) acc[m][n] = (f32x4){0.f, 0.f, 0.f, 0.f};
#pragma unroll
    for (int k0 = 0; k0 < 128; k0 += 32) {
        bf16x8 a[2], b[4];
#pragma unroll
        for (int m = 0; m < 2; ++m) { const f32x4 lo = *(const f32x4*)(ap + (size_t)m * 16 * 128 + k0), hi = *(const f32x4*)(ap + (size_t)m * 16 * 128 + k0 + 4);
            u32x4 w; w.x = pk2(lo.x, lo.y); w.y = pk2(lo.z, lo.w); w.z = pk2(hi.x, hi.y); w.w = pk2(hi.z, hi.w); a[m] = __builtin_bit_cast(bf16x8, w); }
#pragma unroll
        for (int n = 0; n < 4; ++n) { const f32x4 lo = *(const f32x4*)(bp + (size_t)n * 16 * 2048 + k0), hi = *(const f32x4*)(bp + (size_t)n * 16 * 2048 + k0 + 4);
            u32x4 w; w.x = pk2(lo.x, lo.y); w.y = pk2(lo.z, lo.w); w.z = pk2(hi.x, hi.y); w.w = pk2(hi.z, hi.w); b[n] = __builtin_bit_cast(bf16x8, w); }
#pragma unroll
        for (int m = 0; m < 2; ++m)
#pragma unroll
            for (int n = 0; n < 4; ++n) acc[m][n] = mfma16(b[n], a[m], acc[m][n]);
    }
#pragma unroll
    for (int n = 0; n < 4; ++n) {
        const int col = kt * 64 + 16 * n + 4 * fq; const f32x4 w = *(const f32x4*)(n2w + col);
#pragma unroll
        for (int m = 0; m < 2; ++m) { const int row = hp * 128 + nt * 32 + 16 * m + fr; st_bf4(WcT + (size_t)row * 1024 + col, acc[m][n][0] * w.x, acc[m][n][1] * w.y, acc[m][n][2] * w.z, acc[m][n][3] * w.w); }
    }
}

#define KARG __attribute__((address_space(4)))
DEVI const KARG Params* kargs() { unsigned long long k = (unsigned long long)__builtin_amdgcn_kernarg_segment_ptr(); asm volatile("" : "+s"(k)); return (const KARG Params*)k; }
#define PHASE_PTRS \
    int tid_l_ = threadIdx.x; asm volatile("" : "+v"(tid_l_)); \
    [[maybe_unused]] const int tid = tid_l_, lane = tid & 63, wave = __builtin_amdgcn_readfirstlane(tid >> 6), gw = blockIdx.x * NWAVES + wave, fr = lane & 15, fq = lane >> 4; \
    const KARG Params* kp = kargs(); unsigned char* ws = kp->ws; unsigned char* dob = (unsigned char*)kp->out; (void)ws; (void)dob; \
    [[maybe_unused]] const float* x = kp->in[0]; [[maybe_unused]] const int* positions = (const int*)kp->in[1]; [[maybe_unused]] const float* norm1_w = kp->in[2]; [[maybe_unused]] const float* w_in = kp->in[3]; \
    [[maybe_unused]] const float* rw_mu = kp->in[4]; [[maybe_unused]] const float* rw_w0 = kp->in[5]; [[maybe_unused]] const float* rw_a0 = kp->in[7]; [[maybe_unused]] const float* rw_k_k = kp->in[10]; \
    [[maybe_unused]] const float* rw_k_a = kp->in[11]; [[maybe_unused]] const float* rw_r_k = kp->in[12]; [[maybe_unused]] const float* rw_ln_w = kp->in[13]; [[maybe_unused]] const float* rw_ln_b = kp->in[14]; \
    [[maybe_unused]] const float* q_norm_w = kp->in[16]; [[maybe_unused]] const float* kv_norm_w = kp->in[18]; [[maybe_unused]] const float* qn_nope_w = kp->in[20]; [[maybe_unused]] const float* qn_pe_w = kp->in[21]; \
    [[maybe_unused]] const float* kn_nope_w = kp->in[22]; [[maybe_unused]] const float* kn_pe_w = kp->in[23]; [[maybe_unused]] const float* norm2_w = kp->in[26]; \
    [[maybe_unused]] float* ss2 = (float*)(ws + WS_SS2); [[maybe_unused]] unsigned* cnt = (unsigned*)(ws + WS_CNT); [[maybe_unused]] unsigned* xbar_words = (unsigned*)(ws + WS_CNT + 4096); \
    [[maybe_unused]] bf16_t* WinT = (bf16_t*)(ws + WS_WIN); [[maybe_unused]] bf16_t* WuqT = (bf16_t*)(ws + WS_WUQ); [[maybe_unused]] bf16_t* WukvT = (bf16_t*)(ws + WS_WUKV); [[maybe_unused]] bf16_t* RwoT = (bf16_t*)(ws + WS_RWO); \
    [[maybe_unused]] bf16_t* MwoT = (bf16_t*)(ws + WS_MWO); [[maybe_unused]] bf16_t* WoutT = (bf16_t*)(ws + WS_WOUT); [[maybe_unused]] bf16_t* PwqT = (bf16_t*)(ws + WS_PWQ); [[maybe_unused]] bf16_t* SubK = (bf16_t*)(ws + WS_SUBK); \
    [[maybe_unused]] bf16_t* W2T = (bf16_t*)(ws + WS_W2T); [[maybe_unused]] bf16_t* A2T = (bf16_t*)(ws + WS_A2T); [[maybe_unused]] bf16_t* G2T = (bf16_t*)(ws + WS_G2T); [[maybe_unused]] const unsigned char* Gg = ws + WS_G; \
    [[maybe_unused]] bf16_t* Prw = (bf16_t*)(ws + WS_PRW); [[maybe_unused]] bf16_t* QD = (bf16_t*)(ws + WS_QD); [[maybe_unused]] bf16_t* KVD = (bf16_t*)(ws + WS_KVD); [[maybe_unused]] bf16_t* KPE = (bf16_t*)(ws + WS_KPE); \
    [[maybe_unused]] float* ssq = (float*)(ws + WS_SSQ); [[maybe_unused]] float* sskv = (float*)(ws + WS_SSKV); [[maybe_unused]] bf16_t* XN = (bf16_t*)(dob + DO_XN); \
    [[maybe_unused]] bf16_t* Rb = (bf16_t*)(ws + WS_R); [[maybe_unused]] bf16_t* Wb = (bf16_t*)(ws + WS_W); [[maybe_unused]] bf16_t* Kb = (bf16_t*)(ws + WS_KS); [[maybe_unused]] bf16_t* Vb = (bf16_t*)(ws + WS_V); [[maybe_unused]] bf16_t* KKb = (bf16_t*)(ws + WS_KK); \
    [[maybe_unused]] bf16_t* Bvb = (bf16_t*)(dob + DO_BV); [[maybe_unused]] bf16_t* Gtb = (bf16_t*)(dob + DO_GT); [[maybe_unused]] float* bonus = (float*)(dob + DO_BONUS); [[maybe_unused]] bf16_t* Yb = (bf16_t*)(dob + DO_Y); \
    [[maybe_unused]] bf16_t* Qb = (bf16_t*)(ws + WS_Q); [[maybe_unused]] bf16_t* Kab = (bf16_t*)(ws + WS_K); [[maybe_unused]] bf16_t* Vt = (bf16_t*)(ws + WS_VT); [[maybe_unused]] bf16_t* Kraw = (bf16_t*)(dob + DO_KRAW); \
    [[maybe_unused]] bf16_t* Ob = (bf16_t*)(ws + WS_O); [[maybe_unused]] bf16_t* YA = (bf16_t*)(ws + WS_YA); [[maybe_unused]] bf16_t* MIXED = (bf16_t*)(ws + WS_MIXED); [[maybe_unused]] bf16_t* HB = (bf16_t*)(ws + WS_HB); \
    [[maybe_unused]] bf16_t* UB = (bf16_t*)(ws + WS_UB); [[maybe_unused]] bf16_t* VBp = (bf16_t*)(ws + WS_VB); [[maybe_unused]] bf16_t* PQ = (bf16_t*)(ws + WS_PQ); [[maybe_unused]] bf16_t* SC = (bf16_t*)(ws + WS_SC);

__global__ void __launch_bounds__(NT, 2) mega(Params p) {
    extern __shared__ __attribute__((aligned(16))) unsigned char lds[];
    cg::grid_group grid = cg::this_grid();
    const int G = gridDim.x, NGW = G * NWAVES;
    volatile LAS unsigned* bst = (volatile LAS unsigned*)((LAS unsigned char*)lds + LDS_BYTES - 16);
    if (threadIdx.x < 2) bst[threadIdx.x] = 0u;
    if (threadIdx.x >= 8 && threadIdx.x < 16) ((volatile LAS unsigned*)((LAS unsigned char*)lds + LDS_BYTES - 64))[threadIdx.x - 8] = 0u;
    if (threadIdx.x >= 16 && threadIdx.x < 32) ((volatile LAS unsigned*)((LAS unsigned char*)lds + LDS_BYTES - 128))[threadIdx.x - 16] = 0u;
    __syncthreads();
    if (kargs()->ws == nullptr) grid.sync();
    const XcdBarrier xb = xcd_barrier_post((unsigned*)(kargs()->ws + WS_CNT + 4096), bst);

    {
        PHASE_PTRS
        for (int i = blockIdx.x * NT + tid; i < T; i += G * NT) ss2[i] = 0.f;
        for (int t = gw; t < T; t += NGW) {
            const f32x4* xr = (const f32x4*)(x + (size_t)t * DM) + lane;
            f32x4 v[4]; float s = 0.f;
#pragma unroll
            for (int j = 0; j < 4; ++j) { v[j] = xr[64 * j]; s += v[j].x * v[j].x + v[j].y * v[j].y + v[j].z * v[j].z + v[j].w * v[j].w; }
            const float rstd = rsqrtf(wave_sum(s) * (1.f / DM) + EPS);
            const f32x4* wr = (const f32x4*)norm1_w + lane;
#pragma unroll
            for (int j = 0; j < 4; ++j) { const f32x4 w = wr[64 * j]; st_bf4(XN + (size_t)t * DM + (lane + 64 * j) * 4, v[j].x * rstd * w.x, v[j].y * rstd * w.y, v[j].z * rstd * w.z, v[j].w * rstd * w.w); }
        }
        float* scr = (float*)lds + wave * (64 * 33);
        int it = gw;
#define TR_SEG(W_, ldw_, c0_, WT_, ldk_, r0_, Kmax_, nkb_, nnb_, ksc_) \
        { const int cntI = (nkb_) * (nnb_); for (; it < cntI; it += NGW) transpose_item(W_, ldw_, c0_, WT_, ldk_, r0_, Kmax_, it / (nnb_), it % (nnb_), ksc_, scr, lane); it -= cntI; }
        TR_SEG(w_in, 4544, 0, WinT, 1024, 0, 1024, 16, 57, nullptr)
        TR_SEG(w_in, 4544, 1824, WinT, 1024, 2048, 1024, 16, 21, nullptr)
        TR_SEG(w_in, 4544, 2496, WinT, 1024, 2816, 1024, 16, 64, nullptr)
#define TR_SEGF(W_, ldw_, WT_, Kmax_, nkb_, nnb_, fks_) \
        { const int cntI = (nkb_) * (nnb_); for (; it < cntI; it += NGW) transpose_item(W_, ldw_, 0, WT_, 0, 0, Kmax_, it / (nnb_), it % (nnb_), nullptr, scr, lane, fks_); it -= cntI; }
        TR_SEGF(kp->in[6], 512, W2T, 64, 1, 16, 2)
        TR_SEGF(kp->in[8], 512, A2T, 64, 1, 16, 2)
        TR_SEGF(kp->in[9], 512, G2T, 160, 3, 16, 5)
#undef TR_SEGF
#pragma unroll 1
        for (int hh = 0; hh < 8; ++hh) {
            TR_SEG(kp->in[17], 768, hh * 96, WuqT, 384, hh * 64, 384, 6, 2, q_norm_w)
            TR_SEG(kp->in[17], 768, hh * 96 + 64, WuqT, 384, 512 + hh * 32, 384, 6, 1, q_norm_w)
            TR_SEG(kp->in[19], 1024, hh * 128, WukvT, 256, hh * 64, 256, 4, 2, kv_norm_w)
            TR_SEG(kp->in[19], 1024, hh * 128 + 64, WukvT, 256, 512 + hh * 64, 256, 4, 2, kv_norm_w)
        }
        TR_SEG(kp->in[15], 1024, 0, RwoT, 512, 0, 512, 8, 32, nullptr)
        TR_SEG(kp->in[24], 1024, 0, MwoT, 512, 0, 512, 8, 32, nullptr)
        TR_SEG(kp->in[25], 1024, 0, WoutT, 1024, 0, 1024, 16, 32, nullptr)
#undef TR_SEG
        for (; it < 1024; it += NGW) wcomb_item(kp->in[27], kp->in[28], norm2_w, PwqT, it, lane);
        for (int i = blockIdx.x * NT + tid; i < (224 + 96) * 128; i += G * NT) {
            const int r = i >> 7, c = i & 127; const int row = r < 224 ? 1824 + r : 2720 + (r - 224);
            *(u32x4*)(WinT + (size_t)row * 1024 + c * 8) = (u32x4){0u, 0u, 0u, 0u};
        }
    }
    xcd_barrier(xb);

    {
        PHASE_PTRS
        pg8::Gemm g{XN, WinT, T, 4864, DM}; pg8::StaticOrder S; S.init(T, 4864, G, (int)blockIdx.x);
        pg8::EpiP1 E{ws};
        pg8::gemm_phase<pg8::EpiP1, pg8::StaticOrder, true, true>((PG8_LAS unsigned char*)lds, g, S, E);
    }
    xcd_barrier(xb);


    {
        PHASE_PTRS
        for (int t = gw; t < T; t += NGW) {
            float a6[8]; ld_bf8(QD + (size_t)t * 384 + 8 * (lane & 47), a6); float s = 0.f;
#pragma unroll
            for (int i = 0; i < 8; ++i) s += a6[i] * a6[i];
            if (lane >= 48) s = 0.f;
            float b4[4]; ld_bf4(KVD + (size_t)t * 256 + 4 * lane, b4); const float s2 = (b4[0] * b4[0] + b4[1] * b4[1]) + (b4[2] * b4[2] + b4[3] * b4[3]);
            const float sq = wave_sum(s), skv = wave_sum(s2);
            if (lane == 0) { ssq[t] = rsqrtf(sq * (1.f / 384.f) + EPS); sskv[t] = rsqrtf(skv * (1.f / 256.f) + EPS); }
        }
    }
    {
        PHASE_PTRS
        LAS bf16_t* MIX = (LAS bf16_t*)lds; LAS bf16_t* LOR = (LAS bf16_t*)((LAS unsigned char*)lds + 49152);
        for (int tt = blockIdx.x; tt < T / 16; tt += G) {
            int h = wave; asm volatile("" : "+s"(h));
            __syncthreads();
            {
                u32x4 pw[8], ppw[8];
#pragma unroll
                for (int u = 0; u < 8; ++u) {
                    const int ci = tid + u * NT < 16 * 228 ? tid + u * NT : 16 * 228 - 1; const int row = ci / 228, cc = (ci - row * 228) * 8; const int tk = tt * 16 + row;
                    pw[u] = *(const u32x4*)(Prw + (size_t)tk * 2048 + cc);
                    ppw[u] = *(const u32x4*)(Prw + (size_t)((tk & (SEQ - 1)) != 0 ? tk - 1 : tk) * 2048 + cc);
                }
                __builtin_amdgcn_sched_barrier(0);
#pragma unroll
                for (int u = 0; u < 8; ++u) {
                    const int ci = tid + u * NT; if (ci < 16 * 228) {
                        const int row = ci / 228, cc = (ci - row * 228) * 8; const bool hp_ = ((tt * 16 + row) & (SEQ - 1)) != 0;
                        const float pv[8] = {bflo(pw[u].x), bfhi(pw[u].x), bflo(pw[u].y), bfhi(pw[u].y), bflo(pw[u].z), bfhi(pw[u].z), bflo(pw[u].w), bfhi(pw[u].w)};
                        float ppv[8] = {bflo(ppw[u].x), bfhi(ppw[u].x), bflo(ppw[u].y), bfhi(ppw[u].y), bflo(ppw[u].z), bfhi(ppw[u].z), bflo(ppw[u].w), bfhi(ppw[u].w)};
                        if (!hp_) {
#pragma unroll
                            for (int j = 0; j < 8; ++j) ppv[j] = 0.f; }
                        const f32x4 mu0 = *(const f32x4*)(rw_mu + cc), mu1 = *(const f32x4*)(rw_mu + cc + 4); float xm[8];
#pragma unroll
                        for (int j = 0; j < 8; ++j) { const float mu = j < 4 ? mu0[j & 3] : mu1[j & 3]; const float v = pv[j] + mu * (ppv[j] - pv[j]);
                            xm[j] = cc < 1600 ? (cc < 1536 ? v : tanhf_(v)) : (cc < 1664 ? v : sigmoidf_(v)); }
                        if (cc < 1536) *(LAS bf16x8*)(MIX + row * 1536 + cc) = pack8(xm); else *(LAS bf16x8*)(LOR + row * 288 + (cc - 1536)) = pack8(xm);
                    }
                }
            }
            __syncthreads();
            const int tok = tt * 16 + fr;
            f32x4 accw[4], acca[4], accg[4];
#pragma unroll
            for (int n = 0; n < 4; ++n) { accw[n] = (f32x4){0.f, 0.f, 0.f, 0.f}; acca[n] = accw[n]; accg[n] = accw[n]; }
#define LORA_STEP(lcol_, Wt_, KS_, ks_, accv_) { \
                const bf16x8 a = *(const LAS bf16x8*)(LOR + fr * 288 + (lcol_) + 8 * fq); \
                _Pragma("unroll") for (int n = 0; n < 4; ++n) { const bf16x8 b = *(const bf16x8*)((Wt_) + ((size_t)(((h * (KS_) + (ks_)) * 4 + n) * 64 + lane)) * 8); accv_[n] = mfma16(b, a, accv_[n]); } }
#pragma unroll
            for (int ks = 0; ks < 2; ++ks) LORA_STEP(32 * ks, W2T, 2, ks, accw)
#pragma unroll
            for (int ks = 0; ks < 2; ++ks) LORA_STEP(64 + 32 * ks, A2T, 2, ks, acca)
#pragma unroll
            for (int ks = 0; ks < 5; ++ks) LORA_STEP(128 + 32 * ks, G2T, 5, ks, accg)
#undef LORA_STEP
            float kkv[4][4], av[4][4]; float ssq = 0.f, bon = 0.f;
            u32x2 Rp[4], Wp[4], Kp[4], Vp[4], Gp[4];
#pragma unroll
            for (int n = 0; n < 4; ++n) {
                const int ch = 64 * h + 16 * fq + 4 * n;
                float r4[4], k4[4], v4[4];
#pragma unroll
                for (int seg = 0; seg < 3; ++seg) {
                    const u32x2 w = *(const LAS u32x2*)(MIX + fr * 1536 + seg * 512 + ch);
                    const float m4[4] = {bflo(w.x), bfhi(w.x), bflo(w.y), bfhi(w.y)};
#pragma unroll
                    for (int i = 0; i < 4; ++i) { if (seg == 0) r4[i] = m4[i]; else if (seg == 1) k4[i] = m4[i]; else v4[i] = m4[i]; }
                }
                const f32x4 w0 = *(const f32x4*)(rw_w0 + ch), a0 = *(const f32x4*)(rw_a0 + ch), kkw = *(const f32x4*)(rw_k_k + ch), kaw = *(const f32x4*)(rw_k_a + ch), rkw = *(const f32x4*)(rw_r_k + ch);
                float dd[4], kf[4];
#pragma unroll
                for (int i = 0; i < 4; ++i) {
                    const float z = -(w0[i] + accw[n][i]);
                    const float sp = z > 20.f ? z : __logf(1.f + __expf(z));
                    const float wlog = -sp - 0.5f;
                    dd[i] = -__expf(wlog);
                    const float a = sigmoidf_(a0[i] + acca[n][i]); av[n][i] = a;
                    kkv[n][i] = k4[i] * kkw[i]; ssq += kkv[n][i] * kkv[n][i];
                    kf[i] = k4[i] * (1.f + (a - 1.f) * kaw[i]);
                    bon += r4[i] * kf[i] * rkw[i];
                }
                Rp[n] = (u32x2){pk2(r4[0], r4[1]), pk2(r4[2], r4[3])}; Wp[n] = (u32x2){pk2(dd[0], dd[1]), pk2(dd[2], dd[3])}; Kp[n] = (u32x2){pk2(kf[0], kf[1]), pk2(kf[2], kf[3])};
                Vp[n] = (u32x2){pk2(v4[0], v4[1]), pk2(v4[2], v4[3])}; Gp[n] = (u32x2){pk2(accg[n][0], accg[n][1]), pk2(accg[n][2], accg[n][3])};
            }
            const size_t o = (size_t)tok * 512 + 64 * h + 16 * fq;
#define ST16(P_, X_) { *(u32x4*)((P_) + o) = (u32x4){X_[0].x, X_[0].y, X_[1].x, X_[1].y}; *(u32x4*)((P_) + o + 8) = (u32x4){X_[2].x, X_[2].y, X_[3].x, X_[3].y}; }
            ST16(Rb, Rp) ST16(Wb, Wp) ST16(Kb, Kp) ST16(Vb, Vp) ST16(Gtb, Gp)
            ssq += __shfl_xor(ssq, 16); ssq += __shfl_xor(ssq, 32);
            bon += __shfl_xor(bon, 16); bon += __shfl_xor(bon, 32);
            const float inv = 1.f / fmaxf(sqrtf(ssq), 1e-12f);
            u32x2 KKp[4], Bp[4];
#pragma unroll
            for (int n = 0; n < 4; ++n) {
                float kk[4], bb[4];
#pragma unroll
                for (int i = 0; i < 4; ++i) { kk[i] = kkv[n][i] * inv; bb[i] = kk[i] * av[n][i]; }
                KKp[n] = (u32x2){pk2(kk[0], kk[1]), pk2(kk[2], kk[3])}; Bp[n] = (u32x2){pk2(bb[0], bb[1]), pk2(bb[2], bb[3])};
            }
            ST16(KKb, KKp) ST16(Bvb, Bp)
#undef ST16
            if (fq == 0) bonus[(size_t)tok * 8 + h] = bon;
        }
    }
    xcd_barrier(xb);

    {
        PHASE_PTRS
        { int Kq = 384; asm volatile("" : "+s"(Kq));
          pg8::Gemm g{QD, WuqT, T, 768, Kq}; pg8::StaticOrder S; S.init(T, 768, G, (int)blockIdx.x); pg8::EpiQraw E{Qb, ssq};
          pg8::gemm_phase<pg8::EpiQraw, pg8::StaticOrder, true, true>((PG8_LAS unsigned char*)lds, g, S, E); }
        { int Kkv = 256; asm volatile("" : "+s"(Kkv));
          pg8::Gemm g{KVD, WukvT, T, 1024, Kkv}; pg8::StaticOrder S; S.init(T, 1024, G, (int)blockIdx.x); pg8::EpiKVraw E{Kraw, Vt, sskv};
          pg8::gemm_phase<pg8::EpiKVraw, pg8::StaticOrder, true, true>((PG8_LAS unsigned char*)lds, g, S, E); }
    }
    xcd_barrier(xb);
    {
        PHASE_PTRS
        for (int t = gw; t < T; t += NGW) {
            const int hh = lane >> 3, l8 = lane & 7;
            const float pos = (float)positions[t];
            float cs[4], sn[4];
#pragma unroll
            for (int i = 0; i < 4; ++i) { const float invf = exp2f(-(float)(4 * (l8 & 3) + i) * (13.287712379549449f / 16.f)); float rev = pos * invf * 0.15915494309189535f; rev -= rintf(rev);
                sn[i] = __builtin_amdgcn_sinf(rev); cs[i] = __builtin_amdgcn_cosf(rev); }
            bf16_t* qrow = Qb + (size_t)t * 768;
            float qn[8], qp[4]; ld_bf8(qrow + 8 * lane, qn); ld_bf4(qrow + 512 + 4 * lane, qp);
            float kn[8], kp4[4]; ld_bf8(Kraw + (size_t)t * 512 + 8 * lane, kn); ld_bf4(KPE + (size_t)t * 32 + 4 * l8, kp4);
            float s1 = 0.f, s2 = 0.f, s3 = 0.f, s4 = 0.f;
#pragma unroll
            for (int i = 0; i < 8; ++i) { s1 += qn[i] * qn[i]; s3 += kn[i] * kn[i]; }
#pragma unroll
            for (int i = 0; i < 4; ++i) { s2 += qp[i] * qp[i]; s4 += kp4[i] * kp4[i]; }
            s1 = sum8(s1); s2 = sum8(s2); s3 = sum8(s3); s4 = sum8(s4);
            const float r1 = rsqrtf(s1 * (1.f / 64.f) + EPS) * QSCALE, r2 = rsqrtf(s2 * (1.f / 32.f) + EPS), r3 = rsqrtf(s3 * (1.f / 64.f) + EPS), r4 = rsqrtf(s4 * (1.f / 32.f) + EPS);
            const f32x4 wq0 = *(const f32x4*)(qn_nope_w + 8 * l8), wq1 = *(const f32x4*)(qn_nope_w + 8 * l8 + 4), wk0 = *(const f32x4*)(kn_nope_w + 8 * l8), wk1 = *(const f32x4*)(kn_nope_w + 8 * l8 + 4);
            const f32x4 wqp = *(const f32x4*)(qn_pe_w + 4 * l8), wkp = *(const f32x4*)(kn_pe_w + 4 * l8);
            float oq[8], ok[8], oqp[4], okp[4];
#pragma unroll
            for (int i = 0; i < 8; ++i) { oq[i] = qn[i] * r1 * (i < 4 ? wq0[i & 3] : wq1[i & 3]); ok[i] = kn[i] * r3 * (i < 4 ? wk0[i & 3] : wk1[i & 3]); }
#pragma unroll
            for (int i = 0; i < 4; ++i) {
                const float xq = qp[i] * r2 * wqp[i], xk = kp4[i] * r4 * wkp[i];
                const float pq = dpp_f<0x141>(xq), pk_ = dpp_f<0x141>(xk);
                (void)pq; (void)pk_;
                oqp[i] = xq; okp[i] = xk;
            }
#pragma unroll
            for (int i = 0; i < 4; ++i) {
                const float pq = __shfl_xor(oqp[i], 4), pk_ = __shfl_xor(okp[i], 4);
                const float xq = oqp[i], xk = okp[i];
                oqp[i] = l8 < 4 ? (xq * cs[i] - pq * sn[i]) : (xq * cs[i] + pq * sn[i]);
                okp[i] = l8 < 4 ? (xk * cs[i] - pk_ * sn[i]) : (xk * cs[i] + pk_ * sn[i]);
                oqp[i] *= QSCALE;
            }
            bf16_t* qo = Qb + ((size_t)t * 8 + hh) * 96;
            *(bf16x8*)(qo + 8 * l8) = pack8(oq); st_bf4(qo + 64 + 4 * l8, oqp[0], oqp[1], oqp[2], oqp[3]);
            { const int bb = t >> 12, pos = t & 4095; bf16_t* kfb = Kab + (((size_t)(bb * 8 + hh) * 128 + (pos >> 5)) * 6) * 512 + (pos & 31) * 8;
              *(bf16x8*)(kfb + (l8 >> 1) * 512 + 256 * (l8 & 1)) = pack8(ok);
              st_bf4(kfb + (4 + (l8 >> 2)) * 512 + 256 * ((l8 >> 1) & 1) + 4 * (l8 & 1), okp[0], okp[1], okp[2], okp[3]); }
        }
    }
    xcd_barrier(xb);

    {
        PHASE_PTRS
        float* GL = (float*)(dob + DO_GL);
        const int fr_o = fr, fq_o = fq, lane_o = lane;
        if (wave < 3) {
            LAS unsigned char* wb = (LAS unsigned char*)lds + wave * 49152;
            LAS bf16_t* At = (LAS bf16_t*)(wb + 0);      LAS bf16_t* Btm = (LAS bf16_t*)(wb + 4096);  LAS bf16_t* Ktm = (LAS bf16_t*)(wb + 8192); LAS bf16_t* Rtm = (LAS bf16_t*)(wb + 12288);
            LAS bf16_t* AtT = (LAS bf16_t*)(wb + 16384); LAS bf16_t* BtT = (LAS bf16_t*)(wb + 20480); LAS bf16_t* KtT = (LAS bf16_t*)(wb + 24576); LAS bf16_t* VmT = (LAS bf16_t*)(wb + 28672);
            LAS bf16_t* Nm = (LAS bf16_t*)(wb + 32768);  LAS bf16_t* NmT = (LAS bf16_t*)(wb + 34816); LAS bf16_t* Tm = (LAS bf16_t*)(wb + 36864);  LAS bf16_t* TmT = (LAS bf16_t*)(wb + 38912);
            LAS bf16_t* MmT = (LAS bf16_t*)(wb + 40960); LAS bf16_t* NBT = (LAS bf16_t*)(wb + 43008); LAS bf16_t* MKT = (LAS bf16_t*)(wb + 45056); LAS float* gLs = (LAS float*)(wb + 47104);
            LAS bf16_t* W1 = At; LAS bf16_t* W1T = Btm; LAS bf16_t* ATm = Ktm;
#pragma unroll 1
            for (int it = blockIdx.x * 3 + wave; it < 4096; it += G * 3) {
                const int bh = it >> 7, c = it & 127, b = bh >> 3, h = bh & 7;
                int fr = fr_o, fq = fq_o, lane = lane_o; asm volatile("" : "+v"(fr), "+v"(fq), "+v"(lane));
                const int lpA = (4 * (fr >> 3) + (fr & 3)) + 32 * (fq & 1) + ((fq >> 1) + 4 * ((fr >> 2) & 1)) * 512;
                const int lpB = ((fr >> 1) + 16 * (fq & 1)) * 512 + 16 * (fr & 1) + 4 * (fq >> 1);
                const int lpC = 4 * (fq >> 1) + 16 * (fr & 3) + ((fr >> 2) + 8 * (fq & 1)) * 512;
                const size_t sbase = ((size_t)b * SEQ + c * 32) * 512 + h * 64;
                {
                    float cs = 0.f; unsigned aT[16], bT[16], kT[16], vT[16];
#pragma unroll
                    for (int t = 0; t < 32; ++t) {
                        const size_t o = sbase + (size_t)t * 512 + lane;
                        const float ldv = bf1(Wb[o]), rr = bf1(Rb[o]), kv = bf1(Kb[o]), qv = bf1(KKb[o]), bv = bf1(Bvb[o]); const unsigned vraw = Vb[o];
                        const float ep = __expf(cs); cs += ldv; const float ec = __expf(cs), en = __expf(-cs);
                        const unsigned a_ = bf1of(-qv * ep), b_ = bf1of(bv * en), k_ = bf1of(kv * en), r_ = bf1of(rr * ec);
                        At[SW64(t, lane)] = (bf16_t)a_; Btm[SW64(t, lane)] = (bf16_t)b_; Ktm[SW64(t, lane)] = (bf16_t)k_; Rtm[SW64(t, lane)] = (bf16_t)r_;
                        if (t & 1) { aT[t >> 1] |= a_ << 16; bT[t >> 1] |= b_ << 16; kT[t >> 1] |= k_ << 16; vT[t >> 1] |= vraw << 16; }
                        else { aT[t >> 1] = a_; bT[t >> 1] = b_; kT[t >> 1] = k_; vT[t >> 1] = vraw; }
                    }
#pragma unroll
                    for (int q = 0; q < 4; ++q) {
                        *(LAS u32x4*)(AtT + lane * 32 + ((q ^ ((lane >> 2) & 3)) << 3)) = (u32x4){aT[4 * q], aT[4 * q + 1], aT[4 * q + 2], aT[4 * q + 3]};
                        *(LAS u32x4*)(BtT + lane * 32 + ((q ^ ((lane >> 2) & 3)) << 3)) = (u32x4){bT[4 * q], bT[4 * q + 1], bT[4 * q + 2], bT[4 * q + 3]};
                        *(LAS u32x4*)(KtT + lane * 32 + ((q ^ ((lane >> 2) & 3)) << 3)) = (u32x4){kT[4 * q], kT[4 * q + 1], kT[4 * q + 2], kT[4 * q + 3]};
                        *(LAS u32x4*)(VmT + lane * 32 + ((q ^ ((lane >> 2) & 3)) << 3)) = (u32x4){vT[4 * q], vT[4 * q + 1], vT[4 * q + 2], vT[4 * q + 3]};
                    }
                    const float gl = __expf(cs); gLs[lane] = gl;
                    { const int k5 = lane & 31; GL[(size_t)it * 64 + (lane >> 5) * 32 + ((k5 >> 2) & 1) * 16 + (k5 & 3) + 4 * (k5 >> 3)] = gl; }
                }
                {
                    f32x4 acc[2][2];
#define ZACC(MT_, NT_) _Pragma("unroll") for (int m = 0; m < MT_; ++m) _Pragma("unroll") for (int n = 0; n < NT_; ++n) acc[m][n] = (f32x4){0.f, 0.f, 0.f, 0.f};
                    ZACC(2, 2) gemm_lds<2, 2, 2>(Btm, 64, At, 64, acc, fr, fq);
#pragma unroll
                    for (int m = 0; m < 2; ++m)
#pragma unroll
                        for (int n = 0; n < 2; ++n)
#pragma unroll
                            for (int j = 0; j < 4; ++j) { const int i = 16 * m + fr, tt = 16 * n + 4 * fq + j; const float v = i < tt ? acc[m][n][j] : 0.f; const bf16_t w = bf1of(v), w1 = bf1of(v + (i == tt ? 1.f : 0.f));
                                Nm[SW32(i, tt)] = w; NmT[SW32(tt, i)] = w; Tm[SW32(i, tt)] = w1; TmT[SW32(tt, i)] = w1; }
                    ZACC(2, 2) gemm_lds<2, 2, 2>(Ktm, 64, At, 64, acc, fr, fq);
#pragma unroll
                    for (int m = 0; m < 2; ++m)
#pragma unroll
                        for (int n = 0; n < 2; ++n)
#pragma unroll
                            for (int j = 0; j < 4; ++j) { const int i = 16 * m + fr, tt = 16 * n + 4 * fq + j; MmT[SW32(tt, i)] = bf1of(i < tt ? acc[m][n][j] : 0.f); }
                    ZACC(2, 2) gemm_lds<2, 2, 2>(Btm, 64, Rtm, 64, acc, fr, fq);
#pragma unroll
                    for (int m = 0; m < 2; ++m)
#pragma unroll
                        for (int n = 0; n < 2; ++n)
#pragma unroll
                            for (int j = 0; j < 4; ++j) { const int i = 16 * m + fr, tt = 16 * n + 4 * fq + j; NBT[SW32(tt, i)] = bf1of(i <= tt ? acc[m][n][j] : 0.f); }
                    ZACC(2, 2) gemm_lds<2, 2, 2>(Ktm, 64, Rtm, 64, acc, fr, fq);
#pragma unroll
                    for (int m = 0; m < 2; ++m)
#pragma unroll
                        for (int n = 0; n < 2; ++n)
#pragma unroll
                            for (int j = 0; j < 4; ++j) { const int i = 16 * m + fr, tt = 16 * n + 4 * fq + j; MKT[SW32(tt, i)] = bf1of(i <= tt ? acc[m][n][j] : 0.f); }
#pragma unroll 1
                    for (int rd = 0; rd < 4; ++rd) {
                        ZACC(2, 2) gemm_lds<2, 2, 1>(Nm, 32, NmT, 32, acc, fr, fq);
#pragma unroll
                        for (int m = 0; m < 2; ++m)
#pragma unroll
                            for (int n = 0; n < 2; ++n)
#pragma unroll
                                for (int j = 0; j < 4; ++j) { const int i = 16 * m + fr, tt = 16 * n + 4 * fq + j; const bf16_t w = bf1of(acc[m][n][j]); Nm[SW32(i, tt)] = w; NmT[SW32(tt, i)] = w; }
                        ZACC(2, 2) gemm_lds<2, 2, 1>(Tm, 32, NmT, 32, acc, fr, fq);
#pragma unroll
                        for (int m = 0; m < 2; ++m)
#pragma unroll
                            for (int n = 0; n < 2; ++n)
#pragma unroll
                                for (int j = 0; j < 4; ++j) { const int i = 16 * m + fr, tt = 16 * n + 4 * fq + j; const bf16_t w = bf1of(acc[m][n][j] + bf1(Tm[SW32(i, tt)])); Tm[SW32(i, tt)] = w; TmT[SW32(tt, i)] = w; }
                    }
                }
                asm volatile("" : "+v"(fr), "+v"(fq));
                {
                    f32x4 acc[4][2];
                    ZACC(4, 2) gemm_lds<4, 2, 1>(AtT, 32, TmT, 32, acc, fr, fq);
#pragma unroll
                    for (int m = 0; m < 4; ++m)
#pragma unroll
                        for (int n = 0; n < 2; ++n)
#pragma unroll
                            for (int j = 0; j < 4; ++j) ATm[SW32(16 * m + fr, 16 * n + 4 * fq + j)] = bf1of(acc[m][n][j]);
                    ZACC(4, 2) gemm_lds<4, 2, 1>(VmT, 32, MmT, 32, acc, fr, fq);
#pragma unroll
                    for (int m = 0; m < 4; ++m)
#pragma unroll
                        for (int n = 0; n < 2; ++n)
#pragma unroll
                            for (int j = 0; j < 4; ++j) W1[SW32(16 * m + fr, 16 * n + 4 * fq + j)] = bf1of(acc[m][n][j]);
                    ZACC(4, 2) gemm_lds<4, 2, 1>(W1, 32, TmT, 32, acc, fr, fq);
#pragma unroll
                    for (int m = 0; m < 4; ++m)
#pragma unroll
                        for (int n = 0; n < 2; ++n)
#pragma unroll
                            for (int j = 0; j < 4; ++j) W1T[SW32(16 * m + fr, 16 * n + 4 * fq + j)] = bf1of(acc[m][n][j]);
                    ZACC(4, 2) gemm_lds<4, 2, 1>(ATm, 32, NBT, 32, acc, fr, fq);
#pragma unroll
                    for (int m = 0; m < 4; ++m)
#pragma unroll
                        for (int n = 0; n < 2; ++n)
#pragma unroll
                            for (int j = 0; j < 4; ++j) { const int k = 16 * m + fr, tp = 16 * n + 4 * fq + j; const float v = acc[m][n][j] + bf1(Rtm[SW64(tp, k)]);
                                Rb[sbase + lpA + (size_t)(j * 8 + (2 * n + 8 * m) * 512)] = bf1of(v); }
                    ZACC(4, 2) gemm_lds<4, 2, 1>(W1T, 32, NBT, 32, acc, fr, fq); gemm_lds<4, 2, 1>(VmT, 32, MKT, 32, acc, fr, fq);
#pragma unroll
                    for (int m = 0; m < 4; ++m)
#pragma unroll
                        for (int n = 0; n < 2; ++n)
#pragma unroll
                            for (int j = 0; j < 4; ++j) Yb[sbase + lpB + (size_t)((8 * (m & 1)) * 512 + 32 * (m >> 1) + j + 8 * n)] = bf1of(acc[m][n][j]);
                }
                asm volatile("" : "+v"(fr), "+v"(fq));
                {
                    f32x4 acc[4][4];
                    ZACC(4, 4) gemm_lds<4, 4, 1>(ATm, 32, BtT, 32, acc, fr, fq);
#pragma unroll
                    for (int m = 0; m < 4; ++m)
#pragma unroll
                        for (int n = 0; n < 4; ++n)
#pragma unroll
                            for (int j = 0; j < 4; ++j) { const float v = acc[m][n][j] * gLs[16 * n + 4 * fq + j];
                                (n < 2 ? Wb : Kb)[sbase + lpA + (size_t)(j * 8 + (2 * (n & 1) + 8 * m) * 512)] = bf1of(v); }
                    ZACC(4, 4) gemm_lds<4, 4, 1>(W1T, 32, BtT, 32, acc, fr, fq); gemm_lds<4, 4, 1>(VmT, 32, KtT, 32, acc, fr, fq);
#pragma unroll
                    for (int m = 0; m < 4; ++m)
#pragma unroll
                        for (int n = 0; n < 4; ++n)
#pragma unroll
                            for (int j = 0; j < 4; ++j) { const float v = acc[m][n][j] * gLs[16 * n + 4 * fq + j];
                                (m < 2 ? KKb : Bvb)[sbase + lpC + (size_t)(j + 8 * (n & 1) + (4 * (m & 1) + 16 * (n >> 1)) * 512)] = bf1of(v); }
                }
#undef ZACC
            }
        }
    }
    xcd_barrier(xb);

    {
        PHASE_PTRS
        if (wave < 5 && blockIdx.x < 64) {
            const int item = blockIdx.x, bh = item >> 1, wv = item & 1, b = bh >> 3, h = bh & 7;
            const int hi = lane >> 5, vcol = lane & 31;
            float* GL = (float*)(dob + DO_GL);
            volatile LAS unsigned* ctr = (volatile LAS unsigned*)((LAS unsigned char*)lds + LDS_BYTES - 64);
#define SLICE(arr, sb, li) ((arr) + (sb) + (size_t)((li) >> 6) * 512 + ((li) & 63))
#define DMA16(src_, dst_) __builtin_amdgcn_global_load_lds((const unsigned*)(src_), (LAS unsigned*)(dst_), 16, 0, 0)
            if (wave >= 1 && wave <= 3) {
                __builtin_amdgcn_s_setprio(2);
#pragma unroll 1
                for (int c = 0; c < 128; ++c) {
                    if (c >= 4) { while ((int)ctr[3] < c - 3) __builtin_amdgcn_s_sleep(1); }
                    asm volatile("" ::: "memory");
                    const size_t sb = ((size_t)b * SEQ + c * 32) * 512 + h * 64; LAS unsigned char* lb = (LAS unsigned char*)lds + (c & 3) * 19712;
                    if (wave == 1) {
#pragma unroll
                        for (int q = 0; q < 4; ++q) DMA16(SLICE(Wb, sb, (q * 64 + lane) * 8), lb + q * 1024);
#pragma unroll
                        for (int q = 0; q < 2; ++q) DMA16(SLICE(Kb, sb, (q * 64 + lane) * 8), lb + 4096 + q * 1024);
                        asm volatile("s_waitcnt vmcnt(12)" ::: "memory");
                    } else if (wave == 2) {
#pragma unroll
                        for (int q = 2; q < 4; ++q) DMA16(SLICE(Kb, sb, (q * 64 + lane) * 8), lb + 4096 + q * 1024);
#pragma unroll
                        for (int q = 0; q < 4; ++q) DMA16(SLICE(Rb, sb, (q * 64 + lane) * 8), lb + 8192 + q * 1024);
                        asm volatile("s_waitcnt vmcnt(12)" ::: "memory");
                    } else {
#pragma unroll
                        for (int kb = 0; kb < 2; ++kb)
#pragma unroll
                            for (int hf = 0; hf < 2; ++hf) DMA16(SLICE(wv ? Bvb : KKb, sb, (kb * 64 + lane) * 16 + 8 * hf), lb + 12288 + kb * 2048 + hf * 1024);
#pragma unroll
                        for (int hf = 0; hf < 2; ++hf) DMA16(Yb + sb + (size_t)(lane >> 1) * 512 + 32 * wv + 16 * (lane & 1) + 8 * hf, lb + 16384 + hf * 1024);
                        __builtin_amdgcn_global_load_lds((const unsigned*)(GL + ((size_t)(bh * 128 + c)) * 64 + lane), (LAS unsigned*)(lb + 18432), 4, 0, 0);
                        asm volatile("s_waitcnt vmcnt(14)" ::: "memory");
                    }
                    if (c >= 2 && lane == 0) ctr[wave - 1] = (unsigned)(c - 1);
                }
                asm volatile("s_waitcnt vmcnt(0)" ::: "memory");
                if (lane == 0) ctr[wave - 1] = 128u;
                __builtin_amdgcn_s_setprio(0);
            } else if (wave == 4) {
#pragma unroll 1
                for (int c = 0; c < 128; ++c) {
                    while ((int)ctr[4] <= c) __builtin_amdgcn_s_sleep(2);
                    asm volatile("" ::: "memory");
                    const LAS u32x4* ys = (const LAS u32x4*)((LAS unsigned char*)lds + 81920 + (c & 7) * 2048 + lane * 32);
                    const u32x4 ya = ys[0], yb = ys[1];
                    u32x4* yo = (u32x4*)(Yb + ((size_t)b * SEQ + c * 32 + (lane >> 1)) * 512 + h * 64 + 32 * wv + 16 * (lane & 1));
                    yo[0] = ya; yo[1] = yb;
                    asm volatile("s_waitcnt lgkmcnt(0)" ::: "memory");
                    if (lane == 0) ctr[5] = (unsigned)(c + 1);
                }
            } else {
                __builtin_amdgcn_s_setprio(3);
                f32x16 S0t, S1t;
#pragma unroll
                for (int r = 0; r < 16; ++r) { S0t[r] = 0.f; S1t[r] = 0.f; }
#pragma unroll 1
                for (int c = 0; c < 128; ++c) {
                    while ((int)ctr[0] <= c || (int)ctr[1] <= c || (int)ctr[2] <= c) __builtin_amdgcn_s_sleep(1);
                    asm volatile("" ::: "memory");
                    const LAS unsigned char* lb = (const LAS unsigned char*)lds + (c & 3) * 19712;
                    bf16x8 sf[4];
#pragma unroll
                    for (int s = 0; s < 4; ++s) { float t8[8];
#pragma unroll
                        for (int j = 0; j < 8; ++j) t8[j] = (s < 2 ? S0t : S1t)[8 * (s & 1) + j];
                        sf[s] = pack8(t8); }
                    f32x16 yt;
                    { const u32x4 c0 = *(const LAS u32x4*)(lb + 16384 + lane * 16), c1 = *(const LAS u32x4*)(lb + 16384 + 1024 + lane * 16);
                      yt[0] = bflo(c0.x); yt[1] = bfhi(c0.x); yt[2] = bflo(c0.y); yt[3] = bfhi(c0.y); yt[4] = bflo(c0.z); yt[5] = bfhi(c0.z); yt[6] = bflo(c0.w); yt[7] = bfhi(c0.w);
                      yt[8] = bflo(c1.x); yt[9] = bfhi(c1.x); yt[10] = bflo(c1.y); yt[11] = bfhi(c1.y); yt[12] = bflo(c1.z); yt[13] = bfhi(c1.z); yt[14] = bflo(c1.w); yt[15] = bfhi(c1.w); }
                    f32x16 n0, n1;
#pragma unroll
                    for (int kb = 0; kb < 2; ++kb) {
                        const u32x4 c0 = *(const LAS u32x4*)(lb + 12288 + kb * 2048 + lane * 16), c1 = *(const LAS u32x4*)(lb + 12288 + kb * 2048 + 1024 + lane * 16);
                        const LAS float* gp = (const LAS float*)(lb + 18432) + kb * 32 + hi * 16;
                        f32x16 nn; const f32x16 so = kb ? S1t : S0t;
                        nn[0] = bflo(c0.x); nn[1] = bfhi(c0.x); nn[2] = bflo(c0.y); nn[3] = bfhi(c0.y); nn[4] = bflo(c0.z); nn[5] = bfhi(c0.z); nn[6] = bflo(c0.w); nn[7] = bfhi(c0.w);
                        nn[8] = bflo(c1.x); nn[9] = bfhi(c1.x); nn[10] = bflo(c1.y); nn[11] = bfhi(c1.y); nn[12] = bflo(c1.z); nn[13] = bfhi(c1.z); nn[14] = bflo(c1.w); nn[15] = bfhi(c1.w);
#pragma unroll
                        for (int r = 0; r < 16; ++r) nn[r] += gp[r] * so[r];
                        if (kb) n1 = nn; else n0 = nn;
                    }
#pragma unroll
                    for (int s = 0; s < 4; ++s) {
                        const bf16x8 ra = *(const LAS bf16x8*)(lb + 8192 + s * 1024 + lane * 16);
                        const bf16x8 p0 = *(const LAS bf16x8*)(lb + s * 1024 + lane * 16), p1 = *(const LAS bf16x8*)(lb + 4096 + s * 1024 + lane * 16);
                        yt = mfma32(ra, sf[s], yt); n0 = mfma32(p0, sf[s], n0); n1 = mfma32(p1, sf[s], n1);
                    }
                    S0t = n0; S1t = n1;
                    asm volatile("s_waitcnt lgkmcnt(0)" ::: "memory");
                    if (lane == 0) ctr[3] = (unsigned)(c + 1);
                    if (c >= 8) { while ((int)ctr[5] < c - 7) __builtin_amdgcn_s_sleep(1); }
                    asm volatile("" ::: "memory");
                    { LAS bf16_t* ys = (LAS bf16_t*)((LAS unsigned char*)lds + 81920 + (c & 7) * 2048) + vcol;
#pragma unroll
                      for (int r = 0; r < 16; ++r) ys[crow(r, hi) * 32] = bf1of(yt[r]);
                      asm volatile("s_waitcnt lgkmcnt(0)" ::: "memory");
                      if (lane == 0) ctr[4] = (unsigned)(c + 1); }
                }
                __builtin_amdgcn_s_setprio(0);
            }
#undef DMA16
#undef SLICE
        }
        for (;;) {
            unsigned item = 0;
            const int xg = blockIdx.x & 7;
            if (lane == 0) item = atomicAdd(&cnt[xg], 1u);
            item = __builtin_amdgcn_readfirstlane(item);
            if (item >= 256u) break;
            const int qt = 63 - (int)(item >> 2), bh = 8 * (int)(item & 3) + xg, b = bh >> 3, h = bh & 7;
            const int qi = lane & 31, hi = lane >> 5;
            const size_t tokq = (size_t)b * SEQ + qt * 64 + qi;
            bf16x8 qfa[6], qfb[6];
#pragma unroll
            for (int s = 0; s < 6; ++s) { qfa[s] = *(const bf16x8*)(Qb + (tokq * 8 + h) * 96 + 16 * s + 8 * hi); qfb[s] = *(const bf16x8*)(Qb + ((tokq + 32) * 8 + h) * 96 + 16 * s + 8 * hi); }
            float ma = -1e30f, la = 0.f, mb = -1e30f, lb = 0.f;
            f32x16 oa0, oa1, ob0, ob1;
#pragma unroll
            for (int r = 0; r < 16; ++r) { oa0[r] = 0.f; oa1[r] = 0.f; ob0[r] = 0.f; ob1[r] = 0.f; }
            const bf16_t* kfb = Kab + ((size_t)(b * 8 + h) * 128) * 6 * 512 + lane * 8;
            const bf16_t* vfb = Vt + ((size_t)(b * 8 + h) * 128) * 4 * 512 + lane * 8;
            const int nt = 2 * qt + 2;
#define ATT_GROUP(QF, M_, L_, O0, O1, DIAG) { \
                f32x16 xs; _Pragma("unroll") for (int r = 0; r < 16; ++r) xs[r] = 0.f; \
                _Pragma("unroll") for (int s = 0; s < 6; ++s) xs = mfma32(kf[s], QF[s], xs); \
                if (DIAG) { _Pragma("unroll") for (int r = 0; r < 16; ++r) if (crow(r, hi) > qi) xs[r] = -1e30f; } \
                float mx = xs[0]; _Pragma("unroll") for (int r = 1; r < 16; ++r) mx = fmaxf(mx, xs[r]); \
                mx = fmaxf(mx, __shfl_xor(mx, 32)); \
                if (__any(mx > M_)) { const float mn = fmaxf(M_, mx), alpha = __builtin_amdgcn_exp2f(M_ - mn); L_ *= alpha; M_ = mn; \
                    _Pragma("unroll") for (int r = 0; r < 16; ++r) { O0[r] *= alpha; O1[r] *= alpha; } } \
                float ps = 0.f; _Pragma("unroll") for (int r = 0; r < 16; ++r) { xs[r] = __builtin_amdgcn_exp2f(xs[r] - M_); ps += xs[r]; } \
                L_ += ps; \
                _Pragma("unroll") for (int s = 0; s < 2; ++s) { float t8[8]; _Pragma("unroll") for (int j = 0; j < 8; ++j) t8[j] = xs[8 * s + j]; const bf16x8 pbs = pack8(t8); \
                    O0 = mfma32(vf[0][s], pbs, O0); O1 = mfma32(vf[1][s], pbs, O1); } }
#pragma unroll 1
            for (int kt = 0; kt < nt; ++kt) {
                bf16x8 kf[6], vf[2][2];
#pragma unroll
                for (int s = 0; s < 6; ++s) kf[s] = *(const bf16x8*)(kfb + (size_t)(kt * 6 + s) * 512);
#pragma unroll
                for (int d0 = 0; d0 < 2; ++d0)
#pragma unroll
                    for (int s = 0; s < 2; ++s) vf[d0][s] = *(const bf16x8*)(vfb + (size_t)((kt * 2 + d0) * 2 + s) * 512);
                if (kt < nt - 1) ATT_GROUP(qfa, ma, la, oa0, oa1, kt == nt - 2)
                ATT_GROUP(qfb, mb, lb, ob0, ob1, kt == nt - 1)
            }
#undef ATT_GROUP
            la += __shfl_xor(la, 32); lb += __shfl_xor(lb, 32);
            const float ila = 1.f / la, ilb = 1.f / lb;
            bf16_t* orow = Ob + tokq * 512 + h * 64;
#pragma unroll
            for (int g = 0; g < 4; ++g) {
                st_bf4(orow + 8 * g + 4 * hi, oa0[4 * g] * ila, oa0[4 * g + 1] * ila, oa0[4 * g + 2] * ila, oa0[4 * g + 3] * ila);
                st_bf4(orow + 32 + 8 * g + 4 * hi, oa1[4 * g] * ila, oa1[4 * g + 1] * ila, oa1[4 * g + 2] * ila, oa1[4 * g + 3] * ila);
                st_bf4(orow + (size_t)32 * 512 + 8 * g + 4 * hi, ob0[4 * g] * ilb, ob0[4 * g + 1] * ilb, ob0[4 * g + 2] * ilb, ob0[4 * g + 3] * ilb);
                st_bf4(orow + (size_t)32 * 512 + 32 + 8 * g + 4 * hi, ob1[4 * g] * ilb, ob1[4 * g + 1] * ilb, ob1[4 * g + 2] * ilb, ob1[4 * g + 3] * ilb);
            }
        }
    }
    xcd_barrier(xb);

    {
        PHASE_PTRS
        for (int t = gw; t < T; t += NGW) {
            const int ch = 8 * lane, h = lane >> 3;
            float y[8], v[8], g[8]; ld_bf8(Yb + (size_t)t * 512 + ch, y); ld_bf8(Vb + (size_t)t * 512 + ch, v); ld_bf8(Gtb + (size_t)t * 512 + ch, g);
            float s = 0.f;
#pragma unroll
            for (int i = 0; i < 8; ++i) s += y[i];
            s += __shfl_xor(s, 1); s += __shfl_xor(s, 2); s += __shfl_xor(s, 4);
            const float mu = s * (1.f / 64.f); float q = 0.f;
#pragma unroll
            for (int i = 0; i < 8; ++i) { y[i] -= mu; q += y[i] * y[i]; }
            q += __shfl_xor(q, 1); q += __shfl_xor(q, 2); q += __shfl_xor(q, 4);
            const float rstd = rsqrtf(q * (1.f / 64.f) + 64e-5f);
            const float bo = bonus[(size_t)t * 8 + h];
            const f32x4 lw0 = *(const f32x4*)(rw_ln_w + ch), lw1 = *(const f32x4*)(rw_ln_w + ch + 4), lb0 = *(const f32x4*)(rw_ln_b + ch), lb1 = *(const f32x4*)(rw_ln_b + ch + 4);
            float o[8];
#pragma unroll
            for (int i = 0; i < 8; ++i) { const float lw = i < 4 ? lw0[i & 3] : lw1[i & 3], lb = i < 4 ? lb0[i & 3] : lb1[i & 3]; o[i] = (y[i] * rstd * lw + lb + bo * v[i]) * g[i]; }
            *(bf16x8*)(YA + (size_t)t * 512 + ch) = pack8(o);
        }
    }
    xcd_barrier(xb);

    {
        PHASE_PTRS
        pg8::StaticOrder S; S.init(T, 1024, G, (int)blockIdx.x);
        { pg8::Gemm g{YA, RwoT, T, 1024, 512}; pg8::EpiGate E{MIXED, Gg, 0, 0};
          pg8::gemm_phase<pg8::EpiGate, pg8::StaticOrder, true, true>((PG8_LAS unsigned char*)lds, g, S, E); }
        { pg8::Gemm g{Ob, MwoT, T, 1024, 512}; pg8::EpiGate E{MIXED, Gg, 1024, 1};
          pg8::gemm_phase<pg8::EpiGate, pg8::StaticOrder, true, true>((PG8_LAS unsigned char*)lds, g, S, E); }
    }
    xcd_barrier(xb);

    {
        PHASE_PTRS
        const bool conv_first = ((blockIdx.x >> 3) & 1) != 0;
#define P4B_CONV         { const float* pu = kp->in[29]; const float* pv = kp->in[30]; \
          for (size_t i = (size_t)blockIdx.x * NT + tid; i < (size_t)16384 * 1024 / 16; i += (size_t)G * NT) { \
              u32x4 uo, vo; \
              _Pragma("unroll") for (int q = 0; q < 4; ++q) { \
                  const f32x4 u = ((const f32x4*)pu)[i * 4 + q]; const f32x4 w = ((const f32x4*)norm2_w)[(i & 63) * 4 + q]; \
                  uo[q] = pk4_fp8(u.x * w.x * U8_SCALE, u.y * w.y * U8_SCALE, u.z * w.z * U8_SCALE, u.w * w.w * U8_SCALE); \
                  const f32x4 v = ((const f32x4*)pv)[i * 4 + q]; vo[q] = pk4_fp8(v.x * V8_SCALE, v.y * V8_SCALE, v.z * V8_SCALE, v.w * V8_SCALE); \
              } \
              ((u32x4*)UB)[i] = uo; \
              { const size_t e = i >> 6; const int d0 = (int)(i & 63) * 16; *(u32x4*)((unsigned char*)VBp + ((size_t)(d0 >> 7) * 16384 + e) * 128 + (d0 & 127)) = vo; } } }
        if (conv_first) P4B_CONV
        { pg8::Gemm g{MIXED, WoutT, T, 1024, 1024}; pg8::StaticOrder S; S.init(T, 1024, G, (int)blockIdx.x);
          pg8::EpiRes E{x, HB, ss2};
          pg8::gemm_phase<pg8::EpiRes, pg8::StaticOrder, true, true>((PG8_LAS unsigned char*)lds, g, S, E); }
        if (!conv_first) P4B_CONV
#undef P4B_CONV
    }
    xcd_barrier(xb);

    {
        PHASE_PTRS
        pg8::Gemm g{HB, PwqT, T, 2048, 1024}; pg8::StaticOrder S; S.init(T, 2048, G, (int)blockIdx.x);
        pg8::EpiScale E{SC, ss2};
        pg8::gemm_phase<pg8::EpiScale, pg8::StaticOrder, true, true>((PG8_LAS unsigned char*)lds, g, S, E);
    }
    xcd_barrier(xb);

    {
        PHASE_PTRS
        const int wp = wave & 3; const bool producer = wave < 4;
        volatile LAS unsigned* pc = (volatile LAS unsigned*)((LAS unsigned char*)lds + LDS_BYTES - 128) + 2 * wp;
        int kq = 0;
        for (int t = blockIdx.x * 4 + wp; t < T; t += G * 4, ++kq) {
            LAS unsigned char* wl = (LAS unsigned char*)lds + wp * 4096 + (kq & 1) * 2048;
            LAS u32x2* tab = (LAS u32x2*)wl;
            const float rs = rsqrtf(ss2[t] * (1.f / DM) + EPS);
            if (producer) {
            if (kq >= 2) { while ((int)pc[1] < kq - 1) __builtin_amdgcn_s_sleep(2); }
            asm volatile("" ::: "memory");
            { float xa[8], xb[8]; ld_bf8(HB + (size_t)t * DM + 16 * lane, xa); ld_bf8(HB + (size_t)t * DM + 16 * lane + 8, xb);
              u32x4 w; w.x = pk4_fp8(xa[0], xa[1], xa[2], xa[3]); w.y = pk4_fp8(xa[4], xa[5], xa[6], xa[7]); w.z = pk4_fp8(xb[0], xb[1], xb[2], xb[3]); w.w = pk4_fp8(xb[4], xb[5], xb[6], xb[7]);
              *(LAS u32x4*)(wl + 1024 + lane * 16) = w; }
#define SORT4(k) { unsigned hi_, lo_; \
                    hi_ = umax2(k[0], k[1]); lo_ = k[0] < k[1] ? k[0] : k[1]; k[0] = hi_; k[1] = lo_; hi_ = umax2(k[2], k[3]); lo_ = k[2] < k[3] ? k[2] : k[3]; k[2] = hi_; k[3] = lo_; \
                    hi_ = umax2(k[0], k[2]); lo_ = k[0] < k[2] ? k[0] : k[2]; k[0] = hi_; k[2] = lo_; hi_ = umax2(k[1], k[3]); lo_ = k[1] < k[3] ? k[1] : k[3]; k[1] = hi_; k[3] = lo_; \
                    hi_ = umax2(k[1], k[2]); lo_ = k[1] < k[2] ? k[1] : k[2]; k[1] = hi_; k[2] = lo_; }
#pragma unroll 1
            for (int hg = 0; hg < 8; hg += 4) {
                unsigned key[4][4], top[4];
#pragma unroll
                for (int q = 0; q < 4; ++q) {
                    const u32x2 w = *(const u32x2*)(SC + (size_t)t * 2048 + (hg + q) * 256 + 4 * lane);
                    const float f[4] = {bflo(w.x), bfhi(w.x), bflo(w.y), bfhi(w.y)};
#pragma unroll
                    for (int c = 0; c < 4; ++c) { unsigned u = __float_as_uint(f[c]); u = (u & 0x80000000u) ? ~u : (u | 0x80000000u); key[q][c] = (u & ~127u) | (unsigned)(127 - (4 * (lane & 31) + c)); }
                    SORT4(key[q])
                    top[q] = 0u;
                }
#pragma unroll 1
                for (int r = 0; r < 16; ++r) {
                    const bool isr = (lane & 31) == r;
#pragma unroll
                    for (int q = 0; q < 4; ++q) {
                        unsigned m = umax16(key[q][0]);
                        { const auto rr = __builtin_amdgcn_permlane16_swap(m, m, false, false); m = umax2(rr[0], rr[1]); }
                        const bool win = key[q][0] == m;
                        key[q][0] = win ? key[q][1] : key[q][0]; key[q][1] = win ? key[q][2] : key[q][1]; key[q][2] = win ? key[q][3] : key[q][2]; key[q][3] = win ? 0u : key[q][3];
                        top[q] = isr ? m : top[q];
                    }
                }
                unsigned ck[4][4], best[4];
#pragma unroll
                for (int q = 0; q < 4; ++q) {
                    float sval; { unsigned u = top[q] & ~127u; u = (u & 0x80000000u) ? (u & 0x7fffffffu) : ~u; sval = __uint_as_float(u); }
                    const float a = __shfl(sval, lane >> 2);
#pragma unroll
                    for (int c = 0; c < 4; ++c) { const float bsc = __shfl(sval, 32 + 4 * (lane & 3) + c); unsigned u = __float_as_uint(a + bsc); u = (u & 0x80000000u) ? ~u : (u | 0x80000000u);
                        ck[q][c] = (u & ~255u) | (unsigned)(255 - ((lane >> 2) * 16 + 4 * (lane & 3) + c)); }
                    SORT4(ck[q])
                    best[q] = 0u;
                }
#pragma unroll 1
                for (int r = 0; r < 16; ++r) {
                    const bool isr = lane == r;
#pragma unroll
                    for (int q = 0; q < 4; ++q) {
                        unsigned m = umax16(ck[q][0]);
                        { const auto rr = __builtin_amdgcn_permlane16_swap(m, m, false, false); m = umax2(rr[0], rr[1]); }
                        { const auto rr = __builtin_amdgcn_permlane32_swap(m, m, false, false); m = umax2(rr[0], rr[1]); }
                        const bool win = ck[q][0] == m;
                        ck[q][0] = win ? ck[q][1] : ck[q][0]; ck[q][1] = win ? ck[q][2] : ck[q][1]; ck[q][2] = win ? ck[q][3] : ck[q][2]; ck[q][3] = win ? 0u : ck[q][3];
                        best[q] = isr ? m : best[q];
                    }
                }
#pragma unroll
                for (int q = 0; q < 4; ++q) {
                    float bs; { unsigned u = best[q] & ~255u; u = (u & 0x80000000u) ? (u & 0x7fffffffu) : ~u; bs = __uint_as_float(u); }
                    const int pos = 255 - (int)(best[q] & 255u);
                    const float bmax = __uint_as_float(rdlane(__float_as_uint(bs), 0));
                    const float e = lane < 16 ? __expf(bs - bmax) : 0.f;
                    const float gate = e / sum16(e);
                    const unsigned t1 = (unsigned)__shfl((int)top[q], (pos >> 4) & 15), t2 = (unsigned)__shfl((int)top[q], 32 + (pos & 15));
                    const unsigned eid = (127u - (t1 & 127u)) * 128u + (127u - (t2 & 127u));
                    if (lane < 16) tab[16 * (hg + q) + lane] = (u32x2){eid, __float_as_uint(gate)};
                }
            }
#undef SORT4
            asm volatile("s_waitcnt lgkmcnt(0)" ::: "memory");
            if (lane == 0) pc[0] = (unsigned)(kq + 1);
            } else {
            while ((int)pc[0] <= kq) __builtin_amdgcn_s_sleep(2);
            asm volatile("" ::: "memory");
            const unsigned char* UB8 = (const unsigned char*)UB; const unsigned char* VB8 = (const unsigned char*)VBp;
            u32x4 ua[16];
            { const unsigned char* up = UB8 + (size_t)tab[fr].x * DM + 16 * fq;
#pragma unroll
              for (int s = 0; s < 16; ++s) ua[s] = *(const u32x4*)(up + 64 * s); }
#pragma unroll 1
            for (int h = 0; h < 8; ++h) {
                u32x4 uc[16];
#pragma unroll
                for (int s = 0; s < 16; ++s) uc[s] = ua[s];
                { const int hn = h + 1 < 8 ? h + 1 : 7; const unsigned char* up = UB8 + (size_t)tab[16 * hn + fr].x * DM + 16 * fq;
#pragma unroll
                  for (int s = 0; s < 16; ++s) ua[s] = *(const u32x4*)(up + 64 * s); }
                f32x4 ac0 = (f32x4){0.f, 0.f, 0.f, 0.f}, ac1 = ac0, ac2 = ac0, ac3 = ac0;
#pragma unroll
                for (int s = 0; s < 16; s += 2) {
                    const u32x4 b0 = *(const LAS u32x4*)(wl + 1024 + 64 * s + 16 * fq), b1 = *(const LAS u32x4*)(wl + 1024 + 64 * (s + 1) + 16 * fq);
                    ac0 = mfma16_fp8((u32x2){uc[s].x, uc[s].y}, (u32x2){b0.x, b0.y}, ac0);
                    ac1 = mfma16_fp8((u32x2){uc[s].z, uc[s].w}, (u32x2){b0.z, b0.w}, ac1);
                    ac2 = mfma16_fp8((u32x2){uc[s + 1].x, uc[s + 1].y}, (u32x2){b1.x, b1.y}, ac2);
                    ac3 = mfma16_fp8((u32x2){uc[s + 1].z, uc[s + 1].w}, (u32x2){b1.z, b1.w}, ac3);
                }
                const f32x4 acc = (ac0 + ac1) + (ac2 + ac3);
                const int j = fr & 3;
                const float d = (j == 0 ? acc[0] : (j == 1 ? acc[1] : (j == 2 ? acc[2] : acc[3]))) * (rs * (1.f / U8_SCALE));
                const float act = 0.5f * d * (1.f + erff(d * 0.7071067811865476f));
                if (fr < 4) { const int i = 16 * h + 4 * fq + fr; const float g = __uint_as_float(tab[i].y); tab[i].y = __float_as_uint(g * act * (1.f / V8_SCALE)); }
            }
            asm volatile("s_waitcnt lgkmcnt(0)" ::: "memory");
            {
                const u32x4 tv = *(const LAS u32x4*)(wl + lane * 16);
                LAS unsigned char* tq = wl + 1024; const int r0 = 2 * (lane & 3), l0 = lane >> 2;
                *(LAS unsigned short*)(tq + (r0 * 16 + l0) * 2) = (unsigned short)tv.x; *(LAS unsigned short*)(tq + ((r0 + 1) * 16 + l0) * 2) = (unsigned short)tv.z;
                const float c0 = fminf(fmaxf(__uint_as_float(tv.y) * C8_SCALE, -440.f), 440.f), c1 = fminf(fmaxf(__uint_as_float(tv.w) * C8_SCALE, -440.f), 440.f);
                const unsigned c8 = (unsigned)__builtin_amdgcn_cvt_pk_fp8_f32(c0, c1, 0, false);
                *(tq + 256 + r0 * 16 + l0) = (unsigned char)(c8 & 0xffu); *(tq + 256 + (r0 + 1) * 16 + l0) = (unsigned char)((c8 >> 8) & 0xffu);
                asm volatile("s_waitcnt lgkmcnt(0)" ::: "memory");
                if (lane < 24) { const u32x4 o = *(const LAS u32x4*)(tq + lane * 16); *(u32x4*)(ws + WS_TAB + (size_t)t * 384 + lane * 16) = o; }
            }
            asm volatile("s_waitcnt lgkmcnt(0)" ::: "memory");
            if (lane == 0) pc[1] = (unsigned)(kq + 1);
            }
        }
    }
    xcd_barrier(xb);

    {
        PHASE_PTRS
        const unsigned sl = blockIdx.x & 7;
        const unsigned char* VS = (const unsigned char*)VBp + (size_t)sl * 16384 * 128;
        const int rho = lane >> 3, chi = lane & 7;
        constexpr float CSCALE = C8_SCALE;
        unsigned selLo[4], selHi[4];
#pragma unroll
        for (int k = 0; k < 4; ++k) { const unsigned sh = 8u * (unsigned)(chi & 3); const unsigned v = (0x0c0c0c0cu & ~(0xffu << sh)) | ((unsigned)k << sh);
            selLo[k] = chi < 4 ? v : 0x0c0c0c0cu; selHi[k] = chi < 4 ? 0x0c0c0c0cu : v; }
        const bool olane = (lane & 0x28) == 0;
        const unsigned voff0 = 16u * (unsigned)chi;
        LAS unsigned char* wl8 = (LAS unsigned char*)lds + wave * 6144;
        const int wstride = (G >> 3) * NWAVES, tg0 = (blockIdx.x >> 3) * NWAVES + wave;
        const int nb = tg0 < T / 8 ? (T / 8 - tg0 + wstride - 1) / wstride : 0, ntok = nb * 8;
#define P6C_TOK(i_) ((tg0 + ((i_) >> 3) * wstride) * 8 + ((i_) & 7))
#define P6C_DMA(b_) { _Pragma("unroll") for (int k = 0; k < 3; ++k) __builtin_amdgcn_global_load_lds((const unsigned*)(ws + WS_TAB + (size_t)((tg0 + (b_) * wstride) * 8) * 384 + k * 1024 + lane * 16), (LAS unsigned*)(wl8 + ((b_) & 1) * 3072 + k * 1024), 16, 0, 0); }
#define P6C_TAB(EL, EH, CW, i_) { const int ii_ = (i_) < ntok ? (i_) : ntok - 1; const LAS unsigned char* tq_ = wl8 + ((ii_ >> 3) & 1) * 3072 + (ii_ & 7) * 384; \
            EL = *(const LAS u32x4*)(tq_ + rho * 32); EH = *(const LAS u32x4*)(tq_ + rho * 32 + 16); CW = *(const LAS u32x4*)(tq_ + 256 + rho * 16); }
#define P6C_EID(ER, j_) (((j_) & 1) ? (ER[(j_) >> 1] >> 16) : (ER[(j_) >> 1] & 0xffffu))
#define P6C_LOAD(VV, ER) { _Pragma("unroll") for (int j = 0; j < 8; ++j) VV[j] = *(const u32x4*)(VS + (size_t)((P6C_EID(ER, j) << 7) | voff0)); }
#define P6C_USE(VV, CWA, CWB) { _Pragma("unroll") for (int j = 0; j < 8; ++j) { const unsigned cwd = (j < 4) ? CWA : CWB; \
            u32x2 xo; xo.x = __builtin_amdgcn_perm(cwd, cwd, selLo[j & 3]); xo.y = __builtin_amdgcn_perm(cwd, cwd, selHi[j & 3]); \
            acc0 = mfma16_fp8(xo, (u32x2){VV[j].x, VV[j].y}, acc0); acc1 = mfma16_fp8(xo, (u32x2){VV[j].z, VV[j].w}, acc1); } }
#define P6C_BODY(i_, VA, VB, EL, EH, CW, VBo, EHo) { \
            const size_t oo_ = (size_t)P6C_TOK(i_) * DM + 128 * sl + 16 * chi + 4 * ((lane >> 4) & 1); float* orow = kp->out + oo_; \
            u32x2 hw0 = (u32x2){0u, 0u}, hw1 = hw0; \
            if (olane) { hw0 = *(const u32x2*)(HB + oo_); hw1 = *(const u32x2*)(HB + oo_ + 8); }        \
            P6C_LOAD(VBo, EHo)                                     \
            const u32x4 cwq = CW; \
            __builtin_amdgcn_sched_barrier(0); \
            f32x4 acc0 = (f32x4){0.f, 0.f, 0.f, 0.f}, acc1 = acc0; \
            P6C_USE(VA, cwq.x, cwq.y) \
            __builtin_amdgcn_sched_barrier(0); \
            P6C_TAB(EL, EH, CW, (i_) + 2) \
            P6C_LOAD(VA, EL)                                       \
            __builtin_amdgcn_sched_barrier(0); \
            P6C_USE(VB, cwq.z, cwq.w) \
            float s[8]; \
            _Pragma("unroll") for (int r = 0; r < 4; ++r) {        \
                { const auto rr = __builtin_amdgcn_permlane32_swap(__float_as_uint(acc0[r]), __float_as_uint(acc0[r]), false, false); s[r] = acc0[r] + dpp_f<0x128>(__uint_as_float(rr[1])); } \
                { const auto rr = __builtin_amdgcn_permlane32_swap(__float_as_uint(acc1[r]), __float_as_uint(acc1[r]), false, false); s[4 + r] = acc1[r] + dpp_f<0x128>(__uint_as_float(rr[1])); } } \
            if (olane) { const f32x4 h0 = (f32x4){bflo(hw0.x), bfhi(hw0.x), bflo(hw0.y), bfhi(hw0.y)}, h1 = (f32x4){bflo(hw1.x), bfhi(hw1.x), bflo(hw1.y), bfhi(hw1.y)}; \
                *(f32x4*)orow = h0 + (f32x4){s[0], s[1], s[2], s[3]} * (1.f / CSCALE); *(f32x4*)(orow + 8) = h1 + (f32x4){s[4], s[5], s[6], s[7]} * (1.f / CSCALE); } \
            __builtin_amdgcn_sched_barrier(0); }
        if (nb > 0) {
            u32x4 vA0[8], vB0[8], vA1[8], vB1[8];
            u32x4 eL0, eH0, cw0, eL1, eH1, cw1;
            P6C_DMA(0)
            if (nb > 1) P6C_DMA(1)
            asm volatile("s_waitcnt vmcnt(0)" ::: "memory");
            P6C_TAB(eL0, eH0, cw0, 0)
            P6C_LOAD(vA0, eL0)
            P6C_LOAD(vB0, eH0)
            P6C_TAB(eL1, eH1, cw1, 1)
            P6C_LOAD(vA1, eL1)
#pragma unroll 1
            for (int i = 0; i < ntok; i += 2) {
                if ((i & 7) == 0 && i > 0 && (i >> 3) + 1 < nb) P6C_DMA((i >> 3) + 1)
                if ((i & 7) == 4) asm volatile("s_waitcnt vmcnt(40)" ::: "memory");
                P6C_BODY(i, vA0, vB0, eL0, eH0, cw0, vB1, eH1)
                P6C_BODY(i + 1, vA1, vB1, eL1, eH1, cw1, vB0, eH0)
            }
            asm volatile("s_waitcnt vmcnt(0) lgkmcnt(0)" ::: "memory");
        }
#undef P6C_BODY
#undef P6C_USE
#undef P6C_LOAD
#undef P6C_EID
#undef P6C_TAB
#undef P6C_DMA
#undef P6C_TOK
    }
}

extern "C" void kernel_launch(void* const* d_in, const int* in_sizes, int n_in, void* d_out, int out_size,
                              void* d_ws, size_t ws_size, hipStream_t stream) {
    static int grid_blocks = 0;
    if (!grid_blocks) {
        int dev = 0, cus = 0, per_cu = 0;
        (void)hipGetDevice(&dev);
        (void)hipDeviceGetAttribute(&cus, hipDeviceAttributeMultiprocessorCount, dev);
        (void)hipFuncSetAttribute((const void*)mega, hipFuncAttributeMaxDynamicSharedMemorySize, LDS_BYTES);
        (void)hipOccupancyMaxActiveBlocksPerMultiprocessor(&per_cu, (const void*)mega, NT, LDS_BYTES);
        if (per_cu < 1) per_cu = 1;
        if (per_cu > 1) per_cu = 1;
        grid_blocks = cus * per_cu;
        if (ws_size < 256 * MiB) fprintf(stderr, "kernel_launch: workspace too small: %zu\n", ws_size);
    }
    Params p{};
    for (int i = 0; i < 31; ++i) p.in[i] = (const float*)d_in[i];
    p.out = (float*)d_out;
    p.ws = (unsigned char*)d_ws;
    void* args[] = {&p};
    (void)hipMemsetAsync((unsigned char*)d_ws + WS_CNT, 0, 65536, stream);
    hipError_t e = hipLaunchCooperativeKernel((const void*)mega, dim3(grid_blocks), dim3(NT), args, LDS_BYTES, stream);
    if (e != hipSuccess) fprintf(stderr, "cooperative launch failed: %s (grid %d)\n", hipGetErrorString(e), grid_blocks);
}
```

```cpp
#include <hip/hip_runtime.h>
#include <hip/hip_cooperative_groups.h>
#include <cstdio>
#include <cstdint>
namespace cg = cooperative_groups;

#define DEVI __device__ __forceinline__
typedef unsigned short bf16_t;
typedef short bf16x8 __attribute__((ext_vector_type(8)));
typedef float f32x4 __attribute__((ext_vector_type(4)));
typedef float f32x16 __attribute__((ext_vector_type(16)));
typedef unsigned u32x2 __attribute__((ext_vector_type(2)));
typedef unsigned u32x4 __attribute__((ext_vector_type(4)));

constexpr int T = 16384, SEQ = 4096, DM = 1024;
constexpr int NWAVES = 8, NT = 512;
constexpr int LDS_BYTES = 147456;
constexpr float EPS = 1e-6f;
constexpr float LOG2E = 1.4426950408889634f;
constexpr float QSCALE = 0.10206207261596575f * 1.4426950408889634f;

constexpr size_t MiB = 1u << 20;
constexpr size_t WS_SS2 = 0;
constexpr size_t WS_CNT = 512 * 1024;
constexpr size_t WS_SSQ = 64 * 1024, WS_SSKV = 128 * 1024;
constexpr size_t WS_WIN = 1 * MiB;
constexpr size_t WS_WUQ = 10 * MiB + 512 * 1024;
constexpr size_t WS_WUKV = 11 * MiB + 256 * 1024;
constexpr size_t WS_RWO = 12 * MiB;
constexpr size_t WS_MWO = 13 * MiB;
constexpr size_t WS_WOUT = 14 * MiB;
constexpr size_t WS_PWQ = 16 * MiB;
constexpr size_t WS_SUBK = 20 * MiB;
constexpr size_t WS_W2T = 20 * MiB + 512 * 1024;
constexpr size_t WS_A2T = WS_W2T + 64 * 1024;
constexpr size_t WS_G2T = WS_A2T + 64 * 1024;
constexpr size_t WS_G = 24 * MiB;
constexpr size_t WS_UB = 56 * MiB, WS_VB = 72 * MiB;
constexpr size_t WS_SC = 176 * MiB;
constexpr size_t WS_PRW = 88 * MiB;
constexpr size_t WS_Q = 88 * MiB, WS_K = 112 * MiB, WS_VT = 136 * MiB;
constexpr size_t WS_HB = 88 * MiB;
constexpr size_t WS_QD = 152 * MiB, WS_KVD = 164 * MiB, WS_KPE = 172 * MiB;
constexpr size_t WS_O = 152 * MiB;
constexpr size_t WS_R = 176 * MiB, WS_W = 192 * MiB, WS_KS = 208 * MiB, WS_V = 224 * MiB, WS_KK = 240 * MiB;
constexpr size_t WS_YA = 176 * MiB;
constexpr size_t WS_MIXED = 192 * MiB;
constexpr size_t WS_PQ = 184 * MiB;
constexpr size_t WS_TAB = 240 * MiB;
constexpr size_t DO_XN = 0;
constexpr size_t DO_BV = 0, DO_GT = 16 * MiB, DO_BONUS = 32 * MiB, DO_Y = 33 * MiB, DO_KRAW = 33 * MiB, DO_GL = 50 * MiB;

struct Params {
    const float* in[31];
    float* out;
    unsigned char* ws;
};

DEVI unsigned f2bf(float f) { unsigned u = __float_as_uint(f); return (u + 0x7fffu + ((u >> 16) & 1u)) >> 16; }
typedef float f32x2_t __attribute__((ext_vector_type(2)));
typedef __bf16 bf16x2_t __attribute__((ext_vector_type(2)));
DEVI unsigned pk2(float lo, float hi) { f32x2_t v = {lo, hi}; bf16x2_t b = __builtin_convertvector(v, bf16x2_t); return __builtin_bit_cast(unsigned, b); }
DEVI float bflo(unsigned u) { return __uint_as_float(u << 16); }
DEVI float bfhi(unsigned u) { return __uint_as_float(u & 0xffff0000u); }
DEVI float bf1(bf16_t u) { return __uint_as_float(((unsigned)u) << 16); }
DEVI float wave_sum(float v) {
#pragma unroll
    for (int o = 32; o >= 1; o >>= 1) v += __shfl_xor(v, o);
    return v;
}
DEVI float sigmoidf_(float x) { return __builtin_amdgcn_rcpf(1.f + __builtin_amdgcn_exp2f(-1.4426950408889634f * x)); }
DEVI float tanhf_(float x) { return 1.f - 2.f * __builtin_amdgcn_rcpf(__builtin_amdgcn_exp2f(2.885390081777927f * x) + 1.f); }
DEVI void st_bf4(bf16_t* p, float a, float b, float c, float d) { u32x2 w; w.x = pk2(a, b); w.y = pk2(c, d); *(u32x2*)p = w; }
DEVI void ld_bf4(const bf16_t* p, float (&o)[4]) { u32x2 w = *(const u32x2*)p; o[0] = bflo(w.x); o[1] = bfhi(w.x); o[2] = bflo(w.y); o[3] = bfhi(w.y); }
DEVI void ld_bf8(const bf16_t* p, float (&o)[8]) { u32x4 w = *(const u32x4*)p; o[0] = bflo(w.x); o[1] = bfhi(w.x); o[2] = bflo(w.y); o[3] = bfhi(w.y); o[4] = bflo(w.z); o[5] = bfhi(w.z); o[6] = bflo(w.w); o[7] = bfhi(w.w); }
DEVI bf16x8 pack8(const float (&v)[8]) { u32x4 w; w.x = pk2(v[0], v[1]); w.y = pk2(v[2], v[3]); w.z = pk2(v[4], v[5]); w.w = pk2(v[6], v[7]); return __builtin_bit_cast(bf16x8, w); }
DEVI f32x4 mfma16(bf16x8 a, bf16x8 b, f32x4 c) { return __builtin_amdgcn_mfma_f32_16x16x32_bf16(a, b, c, 0, 0, 0); }
DEVI f32x16 mfma32(bf16x8 a, bf16x8 b, f32x16 c) { return __builtin_amdgcn_mfma_f32_32x32x16_bf16(a, b, c, 0, 0, 0); }
DEVI int crow(int r, int hi) { return (r & 3) + 8 * (r >> 2) + 4 * hi; }


template <int CTRL> DEVI float dpp_f(float v) { return __builtin_bit_cast(float, __builtin_amdgcn_update_dpp(0, __builtin_bit_cast(int, v), CTRL, 0xf, 0xf, true)); }
template <int CTRL> DEVI unsigned dpp_u(unsigned v) { return (unsigned)__builtin_amdgcn_update_dpp(0, (int)v, CTRL, 0xf, 0xf, true); }
DEVI float sum8(float v) { v += dpp_f<0xB1>(v); v += dpp_f<0x4E>(v); v += dpp_f<0x141>(v); return v; }
DEVI float sum16(float v) { v = sum8(v); v += dpp_f<0x140>(v); return v; }
DEVI unsigned umax2(unsigned a, unsigned b) { return a > b ? a : b; }
DEVI unsigned umax16(unsigned v) { v = umax2(v, dpp_u<0xB1>(v)); v = umax2(v, dpp_u<0x4E>(v)); v = umax2(v, dpp_u<0x141>(v)); v = umax2(v, dpp_u<0x140>(v)); return v; }
DEVI unsigned rdlane(unsigned v, int l) { return (unsigned)__builtin_amdgcn_readlane((int)v, l); }
#define LAS __attribute__((address_space(3)))

DEVI unsigned pk4_fp8(float a, float b, float c, float d) { int w = 0; w = __builtin_amdgcn_cvt_pk_fp8_f32(a, b, w, false); w = __builtin_amdgcn_cvt_pk_fp8_f32(c, d, w, true); return (unsigned)w; }
DEVI f32x4 mfma16_fp8(u32x2 a, u32x2 b, f32x4 c) { return __builtin_amdgcn_mfma_f32_16x16x32_fp8_fp8(__builtin_bit_cast(long, a), __builtin_bit_cast(long, b), c, 0, 0, 0); }
DEVI unsigned pk4_u8(float a, float b, float c, float d) { unsigned w = 0; w = __builtin_amdgcn_cvt_pk_u8_f32(a, 0, w); w = __builtin_amdgcn_cvt_pk_u8_f32(b, 1, w); w = __builtin_amdgcn_cvt_pk_u8_f32(c, 2, w); w = __builtin_amdgcn_cvt_pk_u8_f32(d, 3, w); return w; }
constexpr float U8_SCALE = 32.f, V8_SCALE = 4.f;
constexpr float C8_SCALE = 256.f;

template <int OFF> DEVI f32x4 lds_rd128(unsigned a) { f32x4 r; asm volatile("ds_read_b128 %0, %1 offset:%2" : "=v"(r) : "v"(a), "i"(OFF)); return r; }
template <int OFF> DEVI float lds_rd32(unsigned a) { float r; asm volatile("ds_read_b32 %0, %1 offset:%2" : "=v"(r) : "v"(a), "i"(OFF)); return r; }
DEVI void lds_wr32(unsigned a, float v) { asm volatile("ds_write_b32 %0, %1" ::"v"(a), "v"(v) : "memory"); }

#define SW64(r, k) ((r) * 64 + (((((k) >> 3) ^ ((r) & 7))) << 3) + ((k) & 7))
#define SW32(r, c) ((r) * 32 + (((((c) >> 3) ^ (((r) >> 2) & 3))) << 3) + ((c) & 7))
DEVI int swz_off(int r, int chunk, int ld) { return ld == 64 ? r * 64 + ((chunk ^ (r & 7)) << 3) : r * 32 + ((chunk ^ ((r >> 2) & 3)) << 3); }
template <int MT, int NTL, int KS>
DEVI void gemm_lds(const LAS bf16_t* A, int lda, const LAS bf16_t* B, int ldb, f32x4 (&acc)[MT][NTL], int fr, int fq) {
#pragma unroll
    for (int ks = 0; ks < KS; ++ks) {
        bf16x8 a[MT], b[NTL];
#pragma unroll
        for (int m = 0; m < MT; ++m) a[m] = *(const LAS bf16x8*)(A + swz_off(16 * m + fr, 4 * ks + fq, lda));
#pragma unroll
        for (int n = 0; n < NTL; ++n) b[n] = *(const LAS bf16x8*)(B + swz_off(16 * n + fr, 4 * ks + fq, ldb));
#pragma unroll
        for (int m = 0; m < MT; ++m)
#pragma unroll
            for (int n = 0; n < NTL; ++n) acc[m][n] = mfma16(b[n], a[m], acc[m][n]);
    }
}
DEVI bf16_t bf1of(float x) { return (bf16_t)(pk2(x, x) & 0xffffu); }
DEVI void gemm_tile_acc(const bf16_t* __restrict__ A, int lda, const bf16_t* __restrict__ Bt, int ldb, int K, int m0, int n0, int lane, f32x4 (&acc)[4][4]) {
    const int fr = lane & 15, fq = lane >> 4;
    const bf16_t* ap = A + (size_t)(m0 + fr) * lda + fq * 8;
    const bf16_t* bp = Bt + (size_t)(n0 + fr) * ldb + fq * 8;
#pragma unroll 2
    for (int k0 = 0; k0 < K; k0 += 32) {
        bf16x8 a[4], b[4];
#pragma unroll
        for (int m = 0; m < 4; ++m) a[m] = *(const bf16x8*)(ap + (size_t)m * 16 * lda + k0);
#pragma unroll
        for (int n = 0; n < 4; ++n) b[n] = *(const bf16x8*)(bp + (size_t)n * 16 * ldb + k0);
#pragma unroll
        for (int m = 0; m < 4; ++m)
#pragma unroll
            for (int n = 0; n < 4; ++n) acc[m][n] = mfma16(b[n], a[m], acc[m][n]);
    }
}
DEVI void zero_acc(f32x4 (&acc)[4][4]) {
#pragma unroll
    for (int m = 0; m < 4; ++m)
#pragma unroll
        for (int n = 0; n < 4; ++n) acc[m][n] = (f32x4){0.f, 0.f, 0.f, 0.f};
}


namespace pg8 {
#define PG8_LAS __attribute__((address_space(3)))
typedef unsigned short bf16_t;
typedef short bf16x8 __attribute__((ext_vector_type(8)));
typedef float f32x4 __attribute__((ext_vector_type(4)));
typedef unsigned u32x4 __attribute__((ext_vector_type(4)));
constexpr int BM = 256, BK = 64, HALF = 128, HTB = HALF * BK * 2  , STAGE_BYTES = 8 * HTB, NXCD = 8, WGM = 8;

__host__ __device__ __forceinline__ int lds_byte(int r, int c) { const int st = (r >> 4) * 2 + (c >> 5), rr = r & 15, cc = c & 31, ob = rr * 64 + cc * 2; return st * 1024 + (ob ^ (((ob >> 9) & 1) << 5)); }
__host__ __device__ __forceinline__ void stage_rc(int b, int& R, int& C) { const int st = b / 1024, sb = b % 1024, swz = sb ^ (((sb >> 9) & 1) << 5); R = (st >> 1) * 16 + swz / 64; C = (st & 1) * 32 + (swz % 64) / 2; }
__host__ __device__ __forceinline__ int perm32(int rho) { const int n = rho >> 4, i = rho & 15; return 8 * (i >> 2) + 4 * n + (i & 3); }

struct Unit { int pm, pn; };
struct Gemm { const bf16_t* A; const bf16_t* Bt; int M, N, K; };

struct StaticOrder {
    int nM, nN, nwg, G, c;
    __host__ __device__ void init(int M, int N, int G_, int c_) { nM = M / BM; nN = N / BM; nwg = nM * nN; G = G_; c = c_; }
    __host__ __device__ bool next(int i, Unit& u) const {
        const long L = (long)i * G + c; if (L >= nwg) return false;
        int wgid = (int)L; { const int q = nwg / NXCD, r = nwg % NXCD, xcd = wgid % NXCD, off = wgid / NXCD; wgid = (xcd < r ? xcd * (q + 1) : r * (q + 1) + (xcd - r) * q) + off; }
        const int nig = WGM * nN, gid = wgid / nig, fm = gid * WGM, gsz = (nM - fm) < WGM ? (nM - fm) : WGM;
        u.pm = fm + ((wgid % nig) % gsz); u.pn = (wgid % nig) / gsz; return true;
    }
    __device__ __forceinline__ void a_ready(const Unit&) const {}
    __device__ __forceinline__ void done(const Unit&) const {}
};


DEVI float sigm(float x) { return __builtin_amdgcn_rcpf(1.f + __builtin_amdgcn_exp2f(-1.4426950408889634f * x)); }
DEVI u32x4 pack8v(f32x4 a, f32x4 b) { u32x4 w; w.x = pk2(a[0], a[1]); w.y = pk2(a[2], a[3]); w.z = pk2(b[0], b[1]); w.w = pk2(b[2], b[3]); return w; }
struct EpiP1 {
    static constexpr bool PERM = true, AFTER_DRAIN = false;
    unsigned char* ws;
    __device__ __forceinline__ void operator()(const f32x4 (&acc)[2][2][4][2], const Unit& u, int wr, int wc, int fr_in, int fq_in) const {
        int fr = fr_in, fq = fq_in; asm volatile("" : "+v"(fr), "+v"(fq));
        const int row0 = u.pm * BM + wr * 64 + fr;
        if (u.pn >= 8 && u.pn < 11) {
#pragma unroll
            for (int bj = 0; bj < 2; ++bj) {
                const int c = (u.pn - 8) * 256 + bj * HALF + wc * 32 + 8 * fq;
                const size_t off = c < 384 ? WS_QD : (c < 640 ? WS_KVD : WS_KPE);
                const int ld = c < 384 ? 384 : (c < 640 ? 256 : 32), cc = c < 384 ? c : (c < 640 ? c - 384 : c - 640);
                if (c < 672) {
#pragma unroll
                    for (int ai = 0; ai < 2; ++ai)
#pragma unroll
                        for (int m = 0; m < 4; ++m) { const size_t row = (size_t)(row0 + ai * HALF + m * 16);
                            *(u32x4*)(ws + off + (row * ld + cc) * 2) = pack8v(acc[ai][bj][m][0], acc[ai][bj][m][1]); }
                }
            }
            return;
        }
        if (u.pn >= 11) {
            const int col0 = (u.pn - 11) * 256 + wc * 32 + 8 * fq;
#pragma unroll
            for (int ai = 0; ai < 2; ++ai)
#pragma unroll
                for (int m = 0; m < 4; ++m) { unsigned char* rowp = ws + WS_G + ((size_t)(row0 + ai * HALF + m * 16) * 2048 + col0);
#pragma unroll
                    for (int bj = 0; bj < 2; ++bj) { const f32x4 v0 = acc[ai][bj][m][0], v1 = acc[ai][bj][m][1];
                        u32x2 w; w.x = pk4_u8(sigm(v0[0]) * 255.f, sigm(v0[1]) * 255.f, sigm(v0[2]) * 255.f, sigm(v0[3]) * 255.f);
                        w.y = pk4_u8(sigm(v1[0]) * 255.f, sigm(v1[1]) * 255.f, sigm(v1[2]) * 255.f, sigm(v1[3]) * 255.f);
                        *(u32x2*)(rowp + bj * HALF) = w; } }
            return;
        }
        const int col0 = u.pn * 256 + wc * 32 + 8 * fq;
#pragma unroll
        for (int ai = 0; ai < 2; ++ai)
#pragma unroll
            for (int m = 0; m < 4; ++m) { unsigned char* rowp = ws + WS_PRW + ((size_t)(row0 + ai * HALF + m * 16) * 2048 + col0) * 2;
#pragma unroll
                for (int bj = 0; bj < 2; ++bj) *(u32x4*)(rowp + bj * HALF * 2) = pack8v(acc[ai][bj][m][0], acc[ai][bj][m][1]); }
    }
};
struct EpiQraw {
    static constexpr bool PERM = true, AFTER_DRAIN = false;
    bf16_t* q; const float* ssq;
    __device__ __forceinline__ void operator()(const f32x4 (&acc)[2][2][4][2], const Unit& u, int wr, int wc, int fr_in, int fq_in) const {
        int fr = fr_in, fq = fq_in; asm volatile("" : "+v"(fr), "+v"(fq));
        const int row0 = u.pm * BM + wr * 64 + fr, col0 = u.pn * BM + wc * 32 + 8 * fq;
#pragma unroll
        for (int ai = 0; ai < 2; ++ai)
#pragma unroll
            for (int m = 0; m < 4; ++m) { const size_t row = (size_t)(row0 + ai * HALF + m * 16); const float rs = ssq[row];
#pragma unroll
                for (int bj = 0; bj < 2; ++bj) *(u32x4*)(q + row * 768 + col0 + bj * HALF) = pack8v(acc[ai][bj][m][0] * rs, acc[ai][bj][m][1] * rs); }
    }
};
struct EpiKVraw {
    static constexpr bool PERM = true, AFTER_DRAIN = false;
    bf16_t* kraw; bf16_t* vt; const float* sskv;
    __device__ __forceinline__ void operator()(const f32x4 (&acc)[2][2][4][2], const Unit& u, int wr, int wc, int fr_in, int fq_in) const {
        int fr = fr_in, fq = fq_in; asm volatile("" : "+v"(fr), "+v"(fq));
        const int row0 = u.pm * BM + wr * 64 + fr;
#pragma unroll
        for (int ai = 0; ai < 2; ++ai)
#pragma unroll
            for (int m = 0; m < 4; ++m) { const int row = row0 + ai * HALF + m * 16; const float rs = sskv[row];
#pragma unroll
                for (int bj = 0; bj < 2; ++bj) { const f32x4 v0 = acc[ai][bj][m][0] * rs, v1 = acc[ai][bj][m][1] * rs;
                    if (u.pn < 2) *(u32x4*)(kraw + (size_t)row * 512 + u.pn * BM + bj * HALF + wc * 32 + 8 * fq) = pack8v(v0, v1);
                    else { const int c = (u.pn - 2) * BM + bj * HALF + wc * 32 + 8 * fq, h = c >> 6, d = c & 63; const int bb = row >> 12, s = row & 4095;
                        const int kt = s >> 5, k4 = s & 15, jj = 4 * (k4 >> 3) + (k4 & 3), hv = (k4 >> 2) & 1;
                        bf16_t* vp = vt + ((((size_t)(bb * 8 + h) * 128 + kt) * 2 + (d >> 5)) * 2 + ((s >> 4) & 1)) * 512 + ((d & 31) + 32 * hv) * 8 + jj; const u32x4 w = pack8v(v0, v1);
                        vp[0] = (bf16_t)(w.x & 0xffffu); vp[8] = (bf16_t)(w.x >> 16); vp[16] = (bf16_t)(w.y & 0xffffu); vp[24] = (bf16_t)(w.y >> 16);
                        vp[32] = (bf16_t)(w.z & 0xffffu); vp[40] = (bf16_t)(w.z >> 16); vp[48] = (bf16_t)(w.w & 0xffffu); vp[56] = (bf16_t)(w.w >> 16); } } }
    }
};
struct EpiGate {
    static constexpr bool PERM = true, AFTER_DRAIN = false;
    bf16_t* mixed; const unsigned char* gg; int goff; int add;
    __device__ __forceinline__ void operator()(const f32x4 (&acc)[2][2][4][2], const Unit& u, int wr, int wc, int fr_in, int fq_in) const {
        int fr = fr_in, fq = fq_in; asm volatile("" : "+v"(fr), "+v"(fq));
        const int row0 = u.pm * BM + wr * 64 + fr, col0 = u.pn * BM + wc * 32 + 8 * fq;
#pragma unroll
        for (int ai = 0; ai < 2; ++ai)
#pragma unroll
            for (int m = 0; m < 4; ++m) { const size_t row = (size_t)(row0 + ai * HALF + m * 16);
#pragma unroll
                for (int bj = 0; bj < 2; ++bj) { const int col = col0 + bj * HALF;
                    const u32x2 gw = *(const u32x2*)(gg + row * 2048 + goff + col);
                    const f32x4 g0 = (f32x4){(float)(gw.x & 0xffu), (float)((gw.x >> 8) & 0xffu), (float)((gw.x >> 16) & 0xffu), (float)(gw.x >> 24)};
                    const f32x4 g1 = (f32x4){(float)(gw.y & 0xffu), (float)((gw.y >> 8) & 0xffu), (float)((gw.y >> 16) & 0xffu), (float)(gw.y >> 24)};
                    f32x4 v0 = g0 * (acc[ai][bj][m][0] * (1.f / 255.f)), v1 = g1 * (acc[ai][bj][m][1] * (1.f / 255.f));
                    if (add) { const u32x4 pw = *(const u32x4*)(mixed + row * 1024 + col);
                        v0 += (f32x4){__uint_as_float(pw.x << 16), __uint_as_float(pw.x & 0xffff0000u), __uint_as_float(pw.y << 16), __uint_as_float(pw.y & 0xffff0000u)};
                        v1 += (f32x4){__uint_as_float(pw.z << 16), __uint_as_float(pw.z & 0xffff0000u), __uint_as_float(pw.w << 16), __uint_as_float(pw.w & 0xffff0000u)}; }
                    *(u32x4*)(mixed + row * 1024 + col) = pack8v(v0, v1); } }
    }
};
struct EpiRes {
    static constexpr bool PERM = true, AFTER_DRAIN = false;
    const float* x; bf16_t* hb; float* ss2;
    __device__ __forceinline__ void operator()(const f32x4 (&acc)[2][2][4][2], const Unit& u, int wr, int wc, int fr_in, int fq_in) const {
        int fr = fr_in, fq = fq_in; asm volatile("" : "+v"(fr), "+v"(fq));
        const int row0 = u.pm * BM + wr * 64 + fr, col0 = u.pn * BM + wc * 32 + 8 * fq;
#pragma unroll
        for (int ai = 0; ai < 2; ++ai)
#pragma unroll
            for (int m = 0; m < 4; ++m) { const size_t row = (size_t)(row0 + ai * HALF + m * 16); float sq = 0.f;
#pragma unroll
                for (int bj = 0; bj < 2; ++bj) { const size_t o = row * 1024 + col0 + bj * HALF;
                    const f32x4 h0 = *(const f32x4*)(x + o) + acc[ai][bj][m][0], h1 = *(const f32x4*)(x + o + 4) + acc[ai][bj][m][1];
                    *(u32x4*)(hb + o) = pack8v(h0, h1);
                    sq += (h0[0] * h0[0] + h0[1] * h0[1]) + (h0[2] * h0[2] + h0[3] * h0[3]) + (h1[0] * h1[0] + h1[1] * h1[1]) + (h1[2] * h1[2] + h1[3] * h1[3]); }
                sq += __shfl_xor(sq, 16); sq += __shfl_xor(sq, 32);
                if (fq == 0) atomicAdd(ss2 + row, sq); }
    }
};
struct EpiScale {
    static constexpr bool PERM = true, AFTER_DRAIN = false;
    bf16_t* pq; const float* ss2;
    __device__ __forceinline__ void operator()(const f32x4 (&acc)[2][2][4][2], const Unit& u, int wr, int wc, int fr_in, int fq_in) const {
        int fr = fr_in, fq = fq_in; asm volatile("" : "+v"(fr), "+v"(fq));
        const int row0 = u.pm * BM + wr * 64 + fr, col0 = u.pn * BM + wc * 32 + 8 * fq;
#pragma unroll
        for (int ai = 0; ai < 2; ++ai)
#pragma unroll
            for (int m = 0; m < 4; ++m) { const size_t row = (size_t)(row0 + ai * HALF + m * 16); const float rs = rsqrtf(ss2[row] * (1.f / 1024.f) + 1e-6f);
#pragma unroll
                for (int bj = 0; bj < 2; ++bj) *(u32x4*)(pq + row * 2048 + col0 + bj * HALF) = pack8v(acc[ai][bj][m][0] * rs, acc[ai][bj][m][1] * rs); }
    }
};
template <class Epi, class Sched, bool ALIGN_EPI = false, bool SP2 = false>
__device__ __forceinline__ void gemm_phase(PG8_LAS unsigned char* lds, const Gemm g, const Sched& S, const Epi& E) {
    int tid_l = threadIdx.x; asm volatile("" : "+v"(tid_l));
    const int tid = tid_l, wid = __builtin_amdgcn_readfirstlane(tid >> 6), lane = tid & 63, wr = wid >> 2, wc = wid & 3, fr = lane & 15, fq = lane >> 4;
    const int K = g.K, nt = K / BK;
    unsigned voffA[2], voffB[2];
#pragma unroll
    for (int i = 0; i < 2; ++i) { int R, C; stage_rc(tid * 16 + i * 8192, R, C); const int Rb = Epi::PERM ? ((R & ~31) + perm32(R & 31)) : R;
        voffA[i] = (unsigned)(R * K + C) * 2u; voffB[i] = (unsigned)(Rb * K + C) * 2u; }
    const size_t kstep = (size_t)(BK * 2);
    const size_t hstep = (size_t)HALF * K * 2;
    const size_t tstep = 2 * hstep;
    const unsigned ldsw = (unsigned)wid * 1024u;
    const int aoff = lds_byte(wr * 64 + fr, fq * 8), boff = lds_byte(wc * 32 + fr, fq * 8);
#define PG8_SA(b, h) (((b) * 2 + (h)) * HTB)
#define PG8_SB(b, h) ((4 + (b) * 2 + (h)) * HTB)
#define PG8_STAGE(bufoff, gbase, voff) do { _Pragma("unroll") for (int _i = 0; _i < 2; ++_i) \
        __builtin_amdgcn_global_load_lds((const unsigned*)((const char*)(gbase) + (voff)[_i]), (PG8_LAS unsigned*)(lds + (bufoff) + ldsw + _i * 8192), 16, 0, 0); } while (0)
#define PG8_LDA(dst, b, h) do { _Pragma("unroll") for (int m = 0; m < 4; ++m) _Pragma("unroll") for (int k = 0; k < 2; ++k) dst[m][k] = *(const PG8_LAS bf16x8*)(lds + PG8_SA(b, h) + aoff + m * 2048 + k * 1024); } while (0)
#define PG8_LDB(dst, b, h) do { _Pragma("unroll") for (int n = 0; n < 2; ++n) _Pragma("unroll") for (int k = 0; k < 2; ++k) dst[n][k] = *(const PG8_LAS bf16x8*)(lds + PG8_SB(b, h) + boff + n * 2048 + k * 1024); } while (0)
#define PG8_MMA(ai, bj, At, Bt) do { __builtin_amdgcn_s_setprio(1); _Pragma("unroll") for (int m = 0; m < 4; ++m) _Pragma("unroll") for (int n = 0; n < 2; ++n) _Pragma("unroll") for (int k = 0; k < 2; ++k) \
        acc[ai][bj][m][n] = __builtin_amdgcn_mfma_f32_16x16x32_bf16(Bt[n][k], At[m][k], acc[ai][bj][m][n], 0, 0, 0); __builtin_amdgcn_s_setprio(0); } while (0)
#define PG8_WAIT_V(n) asm volatile("s_waitcnt vmcnt(" #n ")" ::: "memory")
#define PG8_WAIT_L(n) asm volatile("s_waitcnt lgkmcnt(" #n ")" ::: "memory")
#define PG8_BAR __builtin_amdgcn_s_barrier()
#define PG8_SCHED __builtin_amdgcn_sched_barrier(0)
    Unit cur, nxt; int ui = 0;
    if (!S.next(0, cur)) return;
    f32x4 acc[2][2][4][2];
#pragma unroll
    for (int a = 0; a < 2; ++a)
#pragma unroll
        for (int b = 0; b < 2; ++b)
#pragma unroll
            for (int m = 0; m < 4; ++m)
#pragma unroll
                for (int n = 0; n < 2; ++n) acc[a][b][m][n] = (f32x4){0.f, 0.f, 0.f, 0.f};
    bf16x8 At[4][2], B0[2][2], B1[2][2];
    const char* cA = (const char*)g.A + (size_t)cur.pm * tstep; const char* cB = (const char*)g.Bt + (size_t)cur.pn * tstep;
    S.a_ready(cur);
    if constexpr (SP2) {
        PG8_STAGE(PG8_SB(0, 0), cB, voffB); PG8_STAGE(PG8_SB(0, 1), cB + hstep, voffB); PG8_STAGE(PG8_SA(0, 0), cA, voffA); PG8_STAGE(PG8_SA(0, 1), cA + hstep, voffA);
        if (wr == 1) PG8_BAR;
        PG8_WAIT_V(2); PG8_BAR;
        PG8_STAGE(PG8_SB(1, 0), cB + kstep, voffB); PG8_STAGE(PG8_SA(1, 0), cA + kstep, voffA); PG8_STAGE(PG8_SB(1, 1), cB + hstep + kstep, voffB);
        PG8_WAIT_V(6); PG8_BAR;
    } else {
        PG8_STAGE(PG8_SB(0, 0), cB, voffB); PG8_STAGE(PG8_SA(0, 0), cA, voffA); PG8_STAGE(PG8_SB(0, 1), cB + hstep, voffB); PG8_STAGE(PG8_SA(0, 1), cA + hstep, voffA);
        if (wr == 1) PG8_BAR;
        PG8_WAIT_V(4); PG8_BAR;
        PG8_STAGE(PG8_SB(1, 0), cB + kstep, voffB); PG8_STAGE(PG8_SA(1, 0), cA + kstep, voffA); PG8_STAGE(PG8_SB(1, 1), cB + hstep + kstep, voffB);
        PG8_WAIT_V(6); PG8_BAR;
    }
    for (;;) {
        const bool has_next = S.next(ui + 1, nxt);
        const char* nA = has_next ? (const char*)g.A + (size_t)nxt.pm * tstep : cA; const char* nB = has_next ? (const char*)g.Bt + (size_t)nxt.pn * tstep : cB;
        for (int t = 0; t < nt; t += 2) {
            const bool last = (t == nt - 2);
            const char* a1 = cA + (size_t)(t + 1) * kstep;
            const char* a2 = last ? nA : cA + (size_t)(t + 2) * kstep; const char* b2 = last ? nB : cB + (size_t)(t + 2) * kstep;
            const char* a3 = a2 + kstep; const char* b3 = b2 + kstep;
            if (last && has_next) S.a_ready(nxt);
            if constexpr (SP2) {
            PG8_LDB(B0, 0, 0); PG8_LDB(B1, 0, 1); PG8_SCHED; PG8_LDA(At, 0, 0); PG8_STAGE(PG8_SA(1, 1), a1 + hstep, voffA);
            PG8_WAIT_V(8); PG8_WAIT_L(0); PG8_BAR; PG8_MMA(0, 0, At, B0); PG8_MMA(0, 1, At, B1); PG8_BAR; PG8_SCHED;
            PG8_LDA(At, 0, 1); PG8_STAGE(PG8_SB(0, 0), b2, voffB); PG8_STAGE(PG8_SB(0, 1), b2 + hstep, voffB); PG8_STAGE(PG8_SA(0, 0), a2, voffA);
            PG8_WAIT_V(8); PG8_WAIT_L(0); PG8_BAR; PG8_MMA(1, 0, At, B0); PG8_MMA(1, 1, At, B1); PG8_BAR; PG8_SCHED;
            PG8_LDB(B0, 1, 0); PG8_LDB(B1, 1, 1); PG8_SCHED; PG8_LDA(At, 1, 0); PG8_STAGE(PG8_SA(0, 1), a2 + hstep, voffA);
            PG8_WAIT_V(8); PG8_WAIT_L(0); PG8_BAR; PG8_MMA(0, 0, At, B0); PG8_MMA(0, 1, At, B1); PG8_BAR; PG8_SCHED;
            PG8_LDA(At, 1, 1); PG8_STAGE(PG8_SB(1, 0), b3, voffB); PG8_STAGE(PG8_SB(1, 1), b3 + hstep, voffB); PG8_STAGE(PG8_SA(1, 0), a3, voffA);
            PG8_WAIT_V(8); PG8_WAIT_L(0); PG8_BAR; PG8_MMA(1, 0, At, B0); PG8_MMA(1, 1, At, B1); PG8_BAR; PG8_SCHED;
            } else {
            PG8_LDB(B0, 0, 0); PG8_SCHED; PG8_LDA(At, 0, 0); PG8_STAGE(PG8_SA(1, 1), a1 + hstep, voffA);
            PG8_WAIT_L(8); PG8_BAR; PG8_WAIT_L(0); PG8_MMA(0, 0, At, B0); PG8_BAR; PG8_SCHED;
            PG8_LDB(B1, 0, 1); PG8_STAGE(PG8_SB(0, 0), b2, voffB);
            PG8_BAR; PG8_WAIT_L(0); PG8_MMA(0, 1, At, B1); PG8_BAR;
            PG8_LDA(At, 0, 1); PG8_STAGE(PG8_SA(0, 0), a2, voffA);
            PG8_BAR; PG8_WAIT_L(0); PG8_MMA(1, 0, At, B0); PG8_BAR; PG8_SCHED;
            PG8_STAGE(PG8_SB(0, 1), b2 + hstep, voffB);
            PG8_WAIT_V(6); PG8_BAR; PG8_MMA(1, 1, At, B1); PG8_BAR;
            PG8_LDB(B0, 1, 0); PG8_SCHED; PG8_LDA(At, 1, 0); PG8_STAGE(PG8_SA(0, 1), a2 + hstep, voffA);
            PG8_WAIT_L(8); PG8_BAR; PG8_WAIT_L(0); PG8_MMA(0, 0, At, B0); PG8_BAR; PG8_SCHED;
            PG8_LDB(B1, 1, 1); PG8_STAGE(PG8_SB(1, 0), b3, voffB);
            PG8_BAR; PG8_WAIT_L(0); PG8_MMA(0, 1, At, B1); PG8_BAR;
            PG8_LDA(At, 1, 1); PG8_STAGE(PG8_SA(1, 0), a3, voffA);
            PG8_BAR; PG8_WAIT_L(0); PG8_MMA(1, 0, At, B0); PG8_BAR; PG8_SCHED;
            PG8_STAGE(PG8_SB(1, 1), b3 + hstep, voffB);
            PG8_WAIT_V(6); PG8_BAR; PG8_MMA(1, 1, At, B1); PG8_BAR;
            }
        }
        if constexpr (ALIGN_EPI) { if (wr == 0) PG8_BAR; }
        if constexpr (!Epi::AFTER_DRAIN) { E(acc, cur, wr, wc, fr, fq); S.done(cur); }
        if (!has_next) break;
#pragma unroll
        for (int a = 0; a < 2; ++a)
#pragma unroll
            for (int b = 0; b < 2; ++b)
#pragma unroll
                for (int m = 0; m < 4; ++m)
#pragma unroll
                    for (int n = 0; n < 2; ++n) acc[a][b][m][n] = (f32x4){0.f, 0.f, 0.f, 0.f};
        cur = nxt; cA = nA; cB = nB; ++ui;
        if constexpr (ALIGN_EPI) { if (wr == 1) PG8_BAR; }
    }
    PG8_WAIT_V(0);
    if constexpr (!ALIGN_EPI) { if (wr == 0) PG8_BAR; }
    PG8_BAR;
    if constexpr (Epi::AFTER_DRAIN) { E.fused(acc, cur, wr, wc, fr, fq, lds, wid, lane); S.done(cur); }
#undef PG8_SA
#undef PG8_SB
#undef PG8_STAGE
#undef PG8_LDA
#undef PG8_LDB
#undef PG8_MMA
#undef PG8_WAIT_V
#undef PG8_WAIT_L
#undef PG8_BAR
#undef PG8_SCHED
}
}


#define RLX_AGENT __ATOMIC_RELAXED, __HIP_MEMORY_SCOPE_AGENT
#define XB_TMO      128
#define XB_XCNT(j)  (256  + 64 * (j))
#define XB_XSUB(j)  (1280 + 64 * (j))
#define XB_XGEN(j)  (2304 + 64 * (j))
#define XB_TOP      3328
#define XB_TOPGEN   3392
#define XCD_BAR_WORDS 3456
#define XB_SPIN_CAP (1u << 18)

__device__ __forceinline__ unsigned xb_ld(unsigned* p)              { return __hip_atomic_load(p, __ATOMIC_RELAXED, __HIP_MEMORY_SCOPE_AGENT); }
__device__ __forceinline__ unsigned xb_add(unsigned* p, unsigned v) { return __hip_atomic_fetch_add(p, v, __ATOMIC_RELAXED, __HIP_MEMORY_SCOPE_AGENT); }
__device__ __forceinline__ unsigned xb_xcc_id() { return (unsigned)__builtin_amdgcn_s_getreg((3 << 11) | 20) & 0xFu; }
#define XB_SPIN(cond, bar) do { unsigned _sp = 0; while (cond) { __builtin_amdgcn_s_sleep(1); \
    if ((++_sp & 255u) == 0u) { if (xb_ld(&(bar)[XB_TMO])) break; if (_sp > XB_SPIN_CAP) { atomicAdd(&(bar)[XB_TMO], 1u); break; } } } } while (0)

struct XcdBarrier {
    unsigned* bar; unsigned x;
    volatile LAS unsigned* st;
};

__device__ __forceinline__ XcdBarrier xcd_barrier_post(unsigned* bar, volatile LAS unsigned* st) {
    XcdBarrier b; b.bar = bar; b.x = xb_xcc_id(); b.st = st;
    if (threadIdx.x == 0) (void)xb_add(&bar[XB_XCNT(b.x)], 1u);
    return b;
}
__device__ __forceinline__ void xcd_barrier_complete(unsigned* bar, unsigned x, unsigned& nloc, unsigned& nx) {
    const unsigned G = gridDim.x * gridDim.y * gridDim.z;
    unsigned sum, cnt, mine, sp = 0u;
    for (;;) {
        sum = 0u; cnt = 0u; mine = 0u;
#pragma unroll
        for (unsigned j = 0; j < 16; ++j) { const unsigned c = xb_ld(&bar[XB_XCNT(j)]); sum += c; cnt += (c > 0u) ? 1u : 0u; mine = (j == x) ? c : mine; }
        if (sum == G) break;
        __builtin_amdgcn_s_sleep(1);
        if ((++sp & 255u) == 0u) { if (xb_ld(&bar[XB_TMO])) break; if (sp > XB_SPIN_CAP) { atomicAdd(&bar[XB_TMO], 1u); break; } }
    }
    nloc = mine > 0u ? mine : 1u; nx = cnt > 0u ? cnt : 1u;
}

__device__ __forceinline__ void xcd_barrier(const XcdBarrier& b) {
    asm volatile("s_waitcnt vmcnt(0)" ::: "memory");
    __syncthreads();
    if (threadIdx.x == 0) {
        unsigned* bar = b.bar;
        __builtin_amdgcn_s_waitcnt(0);
        unsigned nloc = b.st[0], nx = b.st[1];
        if (nloc == 0u) { xcd_barrier_complete(bar, b.x, nloc, nx); b.st[0] = nloc; b.st[1] = nx; }
        const unsigned old = xb_add(&bar[XB_XSUB(b.x)], 1u);
        const unsigned gen = old / nloc;
        if (old + 1u == (gen + 1u) * nloc) {
            __builtin_amdgcn_fence(__ATOMIC_RELEASE, "agent");
            asm volatile("s_waitcnt vmcnt(0)" ::: "memory");
            const unsigned og = xb_add(&bar[XB_TOP], 1u);
            const unsigned tg = og / nx;
            if (og + 1u == (tg + 1u) * nx) xb_add(&bar[XB_TOPGEN], 1u);
            else XB_SPIN(xb_ld(&bar[XB_TOPGEN]) == tg, bar);
            __builtin_amdgcn_fence(__ATOMIC_ACQUIRE, "agent");
            xb_add(&bar[XB_XGEN(b.x)], 1u);
            asm volatile("s_waitcnt vmcnt(0)" ::: "memory");
        } else {
            XB_SPIN(xb_ld(&bar[XB_XGEN(b.x)]) == gen, bar);
            __builtin_amdgcn_fence(__ATOMIC_ACQUIRE, "agent");
            asm volatile("s_waitcnt vmcnt(0)" ::: "memory");
        }
    }
    __syncthreads();
}

DEVI void transpose_item(const float* __restrict__ W, int ldw, int c0, bf16_t* WT, int ldk, int r0, int Kmax, int kb, int nb, const float* kscale, float* scr, int lane, int fragKS = 0) {
    const int k0 = 64 * kb, n0 = 32 * nb;
#pragma unroll 8
    for (int i = 0; i < 32; ++i) {
        const int kk = 2 * i + (lane >> 5);
        float v = 0.f;
        if (k0 + kk < Kmax) { v = W[(size_t)(k0 + kk) * ldw + c0 + n0 + (lane & 31)]; if (kscale) v *= kscale[k0 + kk]; }
        scr[kk * 33 + (lane & 31)] = v;
    }
    asm volatile("s_waitcnt lgkmcnt(0)" ::: "memory");
    asm volatile("" ::: "memory");
    const int c = lane & 7;
    if (k0 + 8 * c < Kmax) {
#pragma unroll
        for (int j = 0; j < 4; ++j) {
            const int n = (lane >> 3) + 8 * j;
            const float* s = scr + (8 * c) * 33 + n;
            u32x4 o; o.x = pk2(s[0], s[33]); o.y = pk2(s[66], s[99]); o.z = pk2(s[132], s[165]); o.w = pk2(s[198], s[231]);
            if (fragKS > 0) { const int row = r0 + n0 + n, k = k0 + 8 * c, hd = row >> 6, rr = row & 63;
                *(u32x4*)(WT + ((size_t)(((hd * fragKS + (k >> 5)) * 4 + ((rr >> 2) & 3)) * 64 + ((k >> 3) & 3) * 16 + 4 * (rr >> 4) + (rr & 3))) * 8) = o; }
            else *(u32x4*)(WT + (size_t)(r0 + n0 + n) * ldk + k0 + 8 * c) = o;
        }
    }
    asm volatile("s_waitcnt lgkmcnt(0)" ::: "memory");
    asm volatile("" ::: "memory");
}


DEVI void wcomb_item(const float* __restrict__ Wq, const float* __restrict__ Sk, const float* __restrict__ n2w, bf16_t* WcT, int it, int lane) {
    const int fr = lane & 15, fq = lane >> 4;
    const int hp = it >> 6, nt = (it >> 4) & 3, kt = it & 15;
    const float* ap = Sk + ((size_t)hp * 128 + nt * 32 + fr) * 128 + fq * 8;
    const float* bp = Wq + (size_t)(kt * 64 + fr) * 2048 + hp * 128 + fq * 8;
    f32x4 acc[2][4];
#pragma unroll
    for (int m = 0; m < 2; ++m)
#pragma unroll
        for (int n = 0; n < 4; ++n) acc[m][n] = (f32x4){0.f, 0.f, 0.f, 0.f};
#pragma unroll
    for (int k0 = 0; k0 < 128; k0 += 32) {
        bf16x8 a[2], b[4];
#pragma unroll
        for (int m = 0; m < 2; ++m) { const f32x4 lo = *(const f32x4*)(ap + (size_t)m * 16 * 128 + k0), hi = *(const f32x4*)(ap + (size_t)m * 16 * 128 + k0 + 4);
            u32x4 w; w.x = pk2(lo.x, lo.y); w.y = pk2(lo.z, lo.w); w.z = pk2(hi.x, hi.y); w.w = pk2(hi.z, hi.w); a[m] = __builtin_bit_cast(bf16x8, w); }
#pragma unroll
        for (int n = 0; n < 4; ++n) { const f32x4 lo = *(const f32x4*)(bp + (size_t)n * 16 * 2048 + k0), hi = *(const f32x4*)(bp + (size_t)n * 16 * 2048 + k0 + 4);
            u32x4 w; w.x = pk2(lo.x, lo.y); w.y = pk2(lo.z, lo.w); w.z = pk2(hi.x, hi.y); w.w = pk2(hi.z, hi.w); b[n] = __builtin_bit_cast(bf16x8, w); }
#pragma unroll
        for (int m = 0; m < 2; ++m)
#pragma unroll
            for (int n = 0; n < 4; ++n) acc[m][n] = mfma16(b[n], a[m], acc[m][n]);
    }
#pragma unroll
    for (int n = 0; n < 4; ++n) {
        const int col = kt * 64 + 16 * n + 4 * fq; const f32x4 w = *(const f32x4*)(n2w + col);
#pragma unroll
        for (int m = 0; m < 2; ++m) { const int row = hp * 128 + nt * 32 + 16 * m + fr; st_bf4(WcT + (size_t)row * 1024 + col, acc[m][n][0] * w.x, acc[m][n][1] * w.y, acc[m][n][2] * w.z, acc[m][n][3] * w.w); }
    }
}

DEVI int peer_pair(int s) {
    if (s < 16) return s;
    if (s < 24) return 16 + (s - 16);
    if (s < 29) return 32 + (s - 24);
    if (s < 33) return 48 + (s - 29);
    if (s < 36) return 64 + (s - 33);
    if (s < 42) return 80 + 16 * ((s - 36) >> 1) + ((s - 36) & 1);
    if (s < 50) return 128 + 16 * (s - 42);
    return -1;
}

#define KARG __attribute__((address_space(4)))
DEVI const KARG Params* kargs() { unsigned long long k = (unsigned long long)__builtin_amdgcn_kernarg_segment_ptr(); asm volatile("" : "+s"(k)); return (const KARG Params*)k; }
#define PHASE_PTRS \
    int tid_l_ = threadIdx.x; asm volatile("" : "+v"(tid_l_)); \
    [[maybe_unused]] const int tid = tid_l_, lane = tid & 63, wave = __builtin_amdgcn_readfirstlane(tid >> 6), gw = blockIdx.x * NWAVES + wave, fr = lane & 15, fq = lane >> 4; \
    const KARG Params* kp = kargs(); unsigned char* ws = kp->ws; unsigned char* dob = (unsigned char*)kp->out; (void)ws; (void)dob; \
    [[maybe_unused]] const float* x = kp->in[0]; [[maybe_unused]] const int* positions = (const int*)kp->in[1]; [[maybe_unused]] const float* norm1_w = kp->in[2]; [[maybe_unused]] const float* w_in = kp->in[3]; \
    [[maybe_unused]] const float* rw_mu = kp->in[4]; [[maybe_unused]] const float* rw_w0 = kp->in[5]; [[maybe_unused]] const float* rw_a0 = kp->in[7]; [[maybe_unused]] const float* rw_k_k = kp->in[10]; \
    [[maybe_unused]] const float* rw_k_a = kp->in[11]; [[maybe_unused]] const float* rw_r_k = kp->in[12]; [[maybe_unused]] const float* rw_ln_w = kp->in[13]; [[maybe_unused]] const float* rw_ln_b = kp->in[14]; \
    [[maybe_unused]] const float* q_norm_w = kp->in[16]; [[maybe_unused]] const float* kv_norm_w = kp->in[18]; [[maybe_unused]] const float* qn_nope_w = kp->in[20]; [[maybe_unused]] const float* qn_pe_w = kp->in[21]; \
    [[maybe_unused]] const float* kn_nope_w = kp->in[22]; [[maybe_unused]] const float* kn_pe_w = kp->in[23]; [[maybe_unused]] const float* norm2_w = kp->in[26]; \
    [[maybe_unused]] float* ss2 = (float*)(ws + WS_SS2); [[maybe_unused]] unsigned* cnt = (unsigned*)(ws + WS_CNT); [[maybe_unused]] unsigned* xbar_words = (unsigned*)(ws + WS_CNT + 4096); \
    [[maybe_unused]] bf16_t* WinT = (bf16_t*)(ws + WS_WIN); [[maybe_unused]] bf16_t* WuqT = (bf16_t*)(ws + WS_WUQ); [[maybe_unused]] bf16_t* WukvT = (bf16_t*)(ws + WS_WUKV); [[maybe_unused]] bf16_t* RwoT = (bf16_t*)(ws + WS_RWO); \
    [[maybe_unused]] bf16_t* MwoT = (bf16_t*)(ws + WS_MWO); [[maybe_unused]] bf16_t* WoutT = (bf16_t*)(ws + WS_WOUT); [[maybe_unused]] bf16_t* PwqT = (bf16_t*)(ws + WS_PWQ); [[maybe_unused]] bf16_t* SubK = (bf16_t*)(ws + WS_SUBK); \
    [[maybe_unused]] bf16_t* W2T = (bf16_t*)(ws + WS_W2T); [[maybe_unused]] bf16_t* A2T = (bf16_t*)(ws + WS_A2T); [[maybe_unused]] bf16_t* G2T = (bf16_t*)(ws + WS_G2T); [[maybe_unused]] const unsigned char* Gg = ws + WS_G; \
    [[maybe_unused]] bf16_t* Prw = (bf16_t*)(ws + WS_PRW); [[maybe_unused]] bf16_t* QD = (bf16_t*)(ws + WS_QD); [[maybe_unused]] bf16_t* KVD = (bf16_t*)(ws + WS_KVD); [[maybe_unused]] bf16_t* KPE = (bf16_t*)(ws + WS_KPE); \
    [[maybe_unused]] float* ssq = (float*)(ws + WS_SSQ); [[maybe_unused]] float* sskv = (float*)(ws + WS_SSKV); [[maybe_unused]] bf16_t* XN = (bf16_t*)(dob + DO_XN); \
    [[maybe_unused]] bf16_t* Rb = (bf16_t*)(ws + WS_R); [[maybe_unused]] bf16_t* Wb = (bf16_t*)(ws + WS_W); [[maybe_unused]] bf16_t* Kb = (bf16_t*)(ws + WS_KS); [[maybe_unused]] bf16_t* Vb = (bf16_t*)(ws + WS_V); [[maybe_unused]] bf16_t* KKb = (bf16_t*)(ws + WS_KK); \
    [[maybe_unused]] bf16_t* Bvb = (bf16_t*)(dob + DO_BV); [[maybe_unused]] bf16_t* Gtb = (bf16_t*)(dob + DO_GT); [[maybe_unused]] float* bonus = (float*)(dob + DO_BONUS); [[maybe_unused]] bf16_t* Yb = (bf16_t*)(dob + DO_Y); \
    [[maybe_unused]] bf16_t* Qb = (bf16_t*)(ws + WS_Q); [[maybe_unused]] bf16_t* Kab = (bf16_t*)(ws + WS_K); [[maybe_unused]] bf16_t* Vt = (bf16_t*)(ws + WS_VT); [[maybe_unused]] bf16_t* Kraw = (bf16_t*)(dob + DO_KRAW); \
    [[maybe_unused]] bf16_t* Ob = (bf16_t*)(ws + WS_O); [[maybe_unused]] bf16_t* YA = (bf16_t*)(ws + WS_YA); [[maybe_unused]] bf16_t* MIXED = (bf16_t*)(ws + WS_MIXED); [[maybe_unused]] bf16_t* HB = (bf16_t*)(ws + WS_HB); \
    [[maybe_unused]] bf16_t* UB = (bf16_t*)(ws + WS_UB); [[maybe_unused]] bf16_t* VBp = (bf16_t*)(ws + WS_VB); [[maybe_unused]] bf16_t* PQ = (bf16_t*)(ws + WS_PQ); [[maybe_unused]] bf16_t* SC = (bf16_t*)(ws + WS_SC);

__global__ void __launch_bounds__(NT, 2) mega(Params p) {
    extern __shared__ __attribute__((aligned(16))) unsigned char lds[];
    cg::grid_group grid = cg::this_grid();
    const int G = gridDim.x, NGW = G * NWAVES;
    volatile LAS unsigned* bst = (volatile LAS unsigned*)((LAS unsigned char*)lds + LDS_BYTES - 16);
    if (threadIdx.x < 2) bst[threadIdx.x] = 0u;
    if (threadIdx.x >= 8 && threadIdx.x < 16) ((volatile LAS unsigned*)((LAS unsigned char*)lds + LDS_BYTES - 64))[threadIdx.x - 8] = 0u;
    if (threadIdx.x >= 16 && threadIdx.x < 32) ((volatile LAS unsigned*)((LAS unsigned char*)lds + LDS_BYTES - 128))[threadIdx.x - 16] = 0u;
    __syncthreads();
    if (kargs()->ws == nullptr) grid.sync();
    const XcdBarrier xb = xcd_barrier_post((unsigned*)(kargs()->ws + WS_CNT + 4096), bst);

    {
        PHASE_PTRS
        for (int i = blockIdx.x * NT + tid; i < T; i += G * NT) ss2[i] = 0.f;
        for (int t = gw; t < T; t += NGW) {
            const f32x4* xr = (const f32x4*)(x + (size_t)t * DM) + lane;
            f32x4 v[4]; float s = 0.f;
#pragma unroll
            for (int j = 0; j < 4; ++j) { v[j] = xr[64 * j]; s += v[j].x * v[j].x + v[j].y * v[j].y + v[j].z * v[j].z + v[j].w * v[j].w; }
            const float rstd = rsqrtf(wave_sum(s) * (1.f / DM) + EPS);
            const f32x4* wr = (const f32x4*)norm1_w + lane;
#pragma unroll
            for (int j = 0; j < 4; ++j) { const f32x4 w = wr[64 * j]; st_bf4(XN + (size_t)t * DM + (lane + 64 * j) * 4, v[j].x * rstd * w.x, v[j].y * rstd * w.y, v[j].z * rstd * w.z, v[j].w * rstd * w.w); }
        }
        float* scr = (float*)lds + wave * (64 * 33);
        int it = gw;
#define TR_SEG(W_, ldw_, c0_, WT_, ldk_, r0_, Kmax_, nkb_, nnb_, ksc_) \
        { const int cntI = (nkb_) * (nnb_); for (; it < cntI; it += NGW) transpose_item(W_, ldw_, c0_, WT_, ldk_, r0_, Kmax_, it / (nnb_), it % (nnb_), ksc_, scr, lane); it -= cntI; }
        TR_SEG(w_in, 4544, 0, WinT, 1024, 0, 1024, 16, 57, nullptr)
        TR_SEG(w_in, 4544, 1824, WinT, 1024, 2048, 1024, 16, 21, nullptr)
        TR_SEG(w_in, 4544, 2496, WinT, 1024, 2816, 1024, 16, 64, nullptr)
#define TR_SEGF(W_, ldw_, WT_, Kmax_, nkb_, nnb_, fks_) \
        { const int cntI = (nkb_) * (nnb_); for (; it < cntI; it += NGW) transpose_item(W_, ldw_, 0, WT_, 0, 0, Kmax_, it / (nnb_), it % (nnb_), nullptr, scr, lane, fks_); it -= cntI; }
        TR_SEGF(kp->in[6], 512, W2T, 64, 1, 16, 2)
        TR_SEGF(kp->in[8], 512, A2T, 64, 1, 16, 2)
        TR_SEGF(kp->in[9], 512, G2T, 160, 3, 16, 5)
#undef TR_SEGF
#pragma unroll 1
        for (int hh = 0; hh < 8; ++hh) {
            TR_SEG(kp->in[17], 768, hh * 96, WuqT, 384, hh * 64, 384, 6, 2, q_norm_w)
            TR_SEG(kp->in[17], 768, hh * 96 + 64, WuqT, 384, 512 + hh * 32, 384, 6, 1, q_norm_w)
            TR_SEG(kp->in[19], 1024, hh * 128, WukvT, 256, hh * 64, 256, 4, 2, kv_norm_w)
            TR_SEG(kp->in[19], 1024, hh * 128 + 64, WukvT, 256, 512 + hh * 64, 256, 4, 2, kv_norm_w)
        }
        TR_SEG(kp->in[15], 1024, 0, RwoT, 512, 0, 512, 8, 32, nullptr)
        TR_SEG(kp->in[24], 1024, 0, MwoT, 512, 0, 512, 8, 32, nullptr)
        TR_SEG(kp->in[25], 1024, 0, WoutT, 1024, 0, 1024, 16, 32, nullptr)
#undef TR_SEG
        for (; it < 1024; it += NGW) wcomb_item(kp->in[27], kp->in[28], norm2_w, PwqT, it, lane);
        for (int i = blockIdx.x * NT + tid; i < (224 + 96) * 128; i += G * NT) {
            const int r = i >> 7, c = i & 127; const int row = r < 224 ? 1824 + r : 2720 + (r - 224);
            *(u32x4*)(WinT + (size_t)row * 1024 + c * 8) = (u32x4){0u, 0u, 0u, 0u};
        }
    }
    xcd_barrier(xb);

    {
        PHASE_PTRS
        pg8::Gemm g{XN, WinT, T, 4864, DM}; pg8::StaticOrder S; S.init(T, 4864, G, (int)blockIdx.x);
        pg8::EpiP1 E{ws};
        pg8::gemm_phase<pg8::EpiP1, pg8::StaticOrder, true, true>((PG8_LAS unsigned char*)lds, g, S, E);
    }
    xcd_barrier(xb);


    {
        PHASE_PTRS
        for (int t = gw; t < T; t += NGW) {
            float a6[8]; ld_bf8(QD + (size_t)t * 384 + 8 * (lane & 47), a6); float s = 0.f;
#pragma unroll
            for (int i = 0; i < 8; ++i) s += a6[i] * a6[i];
            if (lane >= 48) s = 0.f;
            float b4[4]; ld_bf4(KVD + (size_t)t * 256 + 4 * lane, b4); const float s2 = (b4[0] * b4[0] + b4[1] * b4[1]) + (b4[2] * b4[2] + b4[3] * b4[3]);
            const float sq = wave_sum(s), skv = wave_sum(s2);
            if (lane == 0) { ssq[t] = rsqrtf(sq * (1.f / 384.f) + EPS); sskv[t] = rsqrtf(skv * (1.f / 256.f) + EPS); }
        }
    }
    {
        PHASE_PTRS
        LAS bf16_t* MIX = (LAS bf16_t*)lds; LAS bf16_t* LOR = (LAS bf16_t*)((LAS unsigned char*)lds + 49152);
        for (int tt = blockIdx.x; tt < T / 16; tt += G) {
            int h = wave; asm volatile("" : "+s"(h));
            __syncthreads();
            {
                u32x4 pw[8], ppw[8];
#pragma unroll
                for (int u = 0; u < 8; ++u) {
                    const int ci = tid + u * NT < 16 * 228 ? tid + u * NT : 16 * 228 - 1; const int row = ci / 228, cc = (ci - row * 228) * 8; const int tk = tt * 16 + row;
                    pw[u] = *(const u32x4*)(Prw + (size_t)tk * 2048 + cc);
                    ppw[u] = *(const u32x4*)(Prw + (size_t)((tk & (SEQ - 1)) != 0 ? tk - 1 : tk) * 2048 + cc);
                }
                __builtin_amdgcn_sched_barrier(0);
#pragma unroll
                for (int u = 0; u < 8; ++u) {
                    const int ci = tid + u * NT; if (ci < 16 * 228) {
                        const int row = ci / 228, cc = (ci - row * 228) * 8; const bool hp_ = ((tt * 16 + row) & (SEQ - 1)) != 0;
                        const float pv[8] = {bflo(pw[u].x), bfhi(pw[u].x), bflo(pw[u].y), bfhi(pw[u].y), bflo(pw[u].z), bfhi(pw[u].z), bflo(pw[u].w), bfhi(pw[u].w)};
                        float ppv[8] = {bflo(ppw[u].x), bfhi(ppw[u].x), bflo(ppw[u].y), bfhi(ppw[u].y), bflo(ppw[u].z), bfhi(ppw[u].z), bflo(ppw[u].w), bfhi(ppw[u].w)};
                        if (!hp_) {
#pragma unroll
                            for (int j = 0; j < 8; ++j) ppv[j] = 0.f; }
                        const f32x4 mu0 = *(const f32x4*)(rw_mu + cc), mu1 = *(const f32x4*)(rw_mu + cc + 4); float xm[8];
#pragma unroll
                        for (int j = 0; j < 8; ++j) { const float mu = j < 4 ? mu0[j & 3] : mu1[j & 3]; const float v = pv[j] + mu * (ppv[j] - pv[j]);
                            xm[j] = cc < 1600 ? (cc < 1536 ? v : tanhf_(v)) : (cc < 1664 ? v : sigmoidf_(v)); }
                        if (cc < 1536) *(LAS bf16x8*)(MIX + row * 1536 + cc) = pack8(xm); else *(LAS bf16x8*)(LOR + row * 288 + (cc - 1536)) = pack8(xm);
                    }
                }
            }
            __syncthreads();
            const int tok = tt * 16 + fr;
            f32x4 accw[4], acca[4], accg[4];
#pragma unroll
            for (int n = 0; n < 4; ++n) { accw[n] = (f32x4){0.f, 0.f, 0.f, 0.f}; acca[n] = accw[n]; accg[n] = accw[n]; }
#define LORA_STEP(lcol_, Wt_, KS_, ks_, accv_) { \
                const bf16x8 a = *(const LAS bf16x8*)(LOR + fr * 288 + (lcol_) + 8 * fq); \
                _Pragma("unroll") for (int n = 0; n < 4; ++n) { const bf16x8 b = *(const bf16x8*)((Wt_) + ((size_t)(((h * (KS_) + (ks_)) * 4 + n) * 64 + lane)) * 8); accv_[n] = mfma16(b, a, accv_[n]); } }
#pragma unroll
            for (int ks = 0; ks < 2; ++ks) LORA_STEP(32 * ks, W2T, 2, ks, accw)
#pragma unroll
            for (int ks = 0; ks < 2; ++ks) LORA_STEP(64 + 32 * ks, A2T, 2, ks, acca)
#pragma unroll
            for (int ks = 0; ks < 5; ++ks) LORA_STEP(128 + 32 * ks, G2T, 5, ks, accg)
#undef LORA_STEP
            float kkv[4][4], av[4][4]; float ssq = 0.f, bon = 0.f;
            u32x2 Rp[4], Wp[4], Kp[4], Vp[4], Gp[4];
#pragma unroll
            for (int n = 0; n < 4; ++n) {
                const int ch = 64 * h + 16 * fq + 4 * n;
                float r4[4], k4[4], v4[4];
#pragma unroll
                for (int seg = 0; seg < 3; ++seg) {
                    const u32x2 w = *(const LAS u32x2*)(MIX + fr * 1536 + seg * 512 + ch);
                    const float m4[4] = {bflo(w.x), bfhi(w.x), bflo(w.y), bfhi(w.y)};
#pragma unroll
                    for (int i = 0; i < 4; ++i) { if (seg == 0) r4[i] = m4[i]; else if (seg == 1) k4[i] = m4[i]; else v4[i] = m4[i]; }
                }
                const f32x4 w0 = *(const f32x4*)(rw_w0 + ch), a0 = *(const f32x4*)(rw_a0 + ch), kkw = *(const f32x4*)(rw_k_k + ch), kaw = *(const f32x4*)(rw_k_a + ch), rkw = *(const f32x4*)(rw_r_k + ch);
                float dd[4], kf[4];
#pragma unroll
                for (int i = 0; i < 4; ++i) {
                    const float z = -(w0[i] + accw[n][i]);
                    const float sp = z > 20.f ? z : __logf(1.f + __expf(z));
                    const float wlog = -sp - 0.5f;
                    dd[i] = -__expf(wlog);
                    const float a = sigmoidf_(a0[i] + acca[n][i]); av[n][i] = a;
                    kkv[n][i] = k4[i] * kkw[i]; ssq += kkv[n][i] * kkv[n][i];
                    kf[i] = k4[i] * (1.f + (a - 1.f) * kaw[i]);
                    bon += r4[i] * kf[i] * rkw[i];
                }
                Rp[n] = (u32x2){pk2(r4[0], r4[1]), pk2(r4[2], r4[3])}; Wp[n] = (u32x2){pk2(dd[0], dd[1]), pk2(dd[2], dd[3])}; Kp[n] = (u32x2){pk2(kf[0], kf[1]), pk2(kf[2], kf[3])};
                Vp[n] = (u32x2){pk2(v4[0], v4[1]), pk2(v4[2], v4[3])}; Gp[n] = (u32x2){pk2(accg[n][0], accg[n][1]), pk2(accg[n][2], accg[n][3])};
            }
            const size_t o = (size_t)tok * 512 + 64 * h + 16 * fq;
#define ST16(P_, X_) { *(u32x4*)((P_) + o) = (u32x4){X_[0].x, X_[0].y, X_[1].x, X_[1].y}; *(u32x4*)((P_) + o + 8) = (u32x4){X_[2].x, X_[2].y, X_[3].x, X_[3].y}; }
            ST16(Rb, Rp) ST16(Wb, Wp) ST16(Kb, Kp) ST16(Vb, Vp) ST16(Gtb, Gp)
            ssq += __shfl_xor(ssq, 16); ssq += __shfl_xor(ssq, 32);
            bon += __shfl_xor(bon, 16); bon += __shfl_xor(bon, 32);
            const float inv = 1.f / fmaxf(sqrtf(ssq), 1e-12f);
            u32x2 KKp[4], Bp[4];
#pragma unroll
            for (int n = 0; n < 4; ++n) {
                float kk[4], bb[4];
#pragma unroll
                for (int i = 0; i < 4; ++i) { kk[i] = kkv[n][i] * inv; bb[i] = kk[i] * av[n][i]; }
                KKp[n] = (u32x2){pk2(kk[0], kk[1]), pk2(kk[2], kk[3])}; Bp[n] = (u32x2){pk2(bb[0], bb[1]), pk2(bb[2], bb[3])};
            }
            ST16(KKb, KKp) ST16(Bvb, Bp)
#undef ST16
            if (fq == 0) bonus[(size_t)tok * 8 + h] = bon;
        }
    }
    xcd_barrier(xb);

    {
        PHASE_PTRS
        { int Kq = 384; asm volatile("" : "+s"(Kq));
          pg8::Gemm g{QD, WuqT, T, 768, Kq}; pg8::StaticOrder S; S.init(T, 768, G, (int)blockIdx.x); pg8::EpiQraw E{Qb, ssq};
          pg8::gemm_phase<pg8::EpiQraw, pg8::StaticOrder, true, true>((PG8_LAS unsigned char*)lds, g, S, E); }
        { int Kkv = 256; asm volatile("" : "+s"(Kkv));
          pg8::Gemm g{KVD, WukvT, T, 1024, Kkv}; pg8::StaticOrder S; S.init(T, 1024, G, (int)blockIdx.x); pg8::EpiKVraw E{Kraw, Vt, sskv};
          pg8::gemm_phase<pg8::EpiKVraw, pg8::StaticOrder, true, true>((PG8_LAS unsigned char*)lds, g, S, E); }
    }
    xcd_barrier(xb);
    {
        PHASE_PTRS
        for (int t = gw; t < T; t += NGW) {
            const int hh = lane >> 3, l8 = lane & 7;
            const float pos = (float)positions[t];
            float cs[4], sn[4];
#pragma unroll
            for (int i = 0; i < 4; ++i) { const float invf = exp2f(-(float)(4 * (l8 & 3) + i) * (13.287712379549449f / 16.f)); float rev = pos * invf * 0.15915494309189535f; rev -= rintf(rev);
                sn[i] = __builtin_amdgcn_sinf(rev); cs[i] = __builtin_amdgcn_cosf(rev); }
            bf16_t* qrow = Qb + (size_t)t * 768;
            float qn[8], qp[4]; ld_bf8(qrow + 8 * lane, qn); ld_bf4(qrow + 512 + 4 * lane, qp);
            float kn[8], kp4[4]; ld_bf8(Kraw + (size_t)t * 512 + 8 * lane, kn); ld_bf4(KPE + (size_t)t * 32 + 4 * l8, kp4);
            float s1 = 0.f, s2 = 0.f, s3 = 0.f, s4 = 0.f;
#pragma unroll
            for (int i = 0; i < 8; ++i) { s1 += qn[i] * qn[i]; s3 += kn[i] * kn[i]; }
#pragma unroll
            for (int i = 0; i < 4; ++i) { s2 += qp[i] * qp[i]; s4 += kp4[i] * kp4[i]; }
            s1 = sum8(s1); s2 = sum8(s2); s3 = sum8(s3); s4 = sum8(s4);
            const float r1 = rsqrtf(s1 * (1.f / 64.f) + EPS) * QSCALE, r2 = rsqrtf(s2 * (1.f / 32.f) + EPS), r3 = rsqrtf(s3 * (1.f / 64.f) + EPS), r4 = rsqrtf(s4 * (1.f / 32.f) + EPS);
            const f32x4 wq0 = *(const f32x4*)(qn_nope_w + 8 * l8), wq1 = *(const f32x4*)(qn_nope_w + 8 * l8 + 4), wk0 = *(const f32x4*)(kn_nope_w + 8 * l8), wk1 = *(const f32x4*)(kn_nope_w + 8 * l8 + 4);
            const f32x4 wqp = *(const f32x4*)(qn_pe_w + 4 * l8), wkp = *(const f32x4*)(kn_pe_w + 4 * l8);
            float oq[8], ok[8], oqp[4], okp[4];
#pragma unroll
            for (int i = 0; i < 8; ++i) { oq[i] = qn[i] * r1 * (i < 4 ? wq0[i & 3] : wq1[i & 3]); ok[i] = kn[i] * r3 * (i < 4 ? wk0[i & 3] : wk1[i & 3]); }
#pragma unroll
            for (int i = 0; i < 4; ++i) {
                const float xq = qp[i] * r2 * wqp[i], xk = kp4[i] * r4 * wkp[i];
                const float pq = dpp_f<0x141>(xq), pk_ = dpp_f<0x141>(xk);
                (void)pq; (void)pk_;
                oqp[i] = xq; okp[i] = xk;
            }
#pragma unroll
            for (int i = 0; i < 4; ++i) {
                const float pq = __shfl_xor(oqp[i], 4), pk_ = __shfl_xor(okp[i], 4);
                const float xq = oqp[i], xk = okp[i];
                oqp[i] = l8 < 4 ? (xq * cs[i] - pq * sn[i]) : (xq * cs[i] + pq * sn[i]);
                okp[i] = l8 < 4 ? (xk * cs[i] - pk_ * sn[i]) : (xk * cs[i] + pk_ * sn[i]);
                oqp[i] *= QSCALE;
            }
            bf16_t* qo = Qb + ((size_t)t * 8 + hh) * 96;
            *(bf16x8*)(qo + 8 * l8) = pack8(oq); st_bf4(qo + 64 + 4 * l8, oqp[0], oqp[1], oqp[2], oqp[3]);
            { const int bb = t >> 12, pos = t & 4095; bf16_t* kfb = Kab + (((size_t)(bb * 8 + hh) * 128 + (pos >> 5)) * 6) * 512 + (pos & 31) * 8;
              *(bf16x8*)(kfb + (l8 >> 1) * 512 + 256 * (l8 & 1)) = pack8(ok);
              st_bf4(kfb + (4 + (l8 >> 2)) * 512 + 256 * ((l8 >> 1) & 1) + 4 * (l8 & 1), okp[0], okp[1], okp[2], okp[3]); }
        }
    }
    xcd_barrier(xb);

    {
        PHASE_PTRS
        float* GL = (float*)(dob + DO_GL);
        const int fr_o = fr, fq_o = fq, lane_o = lane;
        if (wave < 3) {
            LAS unsigned char* wb = (LAS unsigned char*)lds + wave * 49152;
            LAS bf16_t* At = (LAS bf16_t*)(wb + 0);      LAS bf16_t* Btm = (LAS bf16_t*)(wb + 4096);  LAS bf16_t* Ktm = (LAS bf16_t*)(wb + 8192); LAS bf16_t* Rtm = (LAS bf16_t*)(wb + 12288);
            LAS bf16_t* AtT = (LAS bf16_t*)(wb + 16384); LAS bf16_t* BtT = (LAS bf16_t*)(wb + 20480); LAS bf16_t* KtT = (LAS bf16_t*)(wb + 24576); LAS bf16_t* VmT = (LAS bf16_t*)(wb + 28672);
            LAS bf16_t* Nm = (LAS bf16_t*)(wb + 32768);  LAS bf16_t* NmT = (LAS bf16_t*)(wb + 34816); LAS bf16_t* Tm = (LAS bf16_t*)(wb + 36864);  LAS bf16_t* TmT = (LAS bf16_t*)(wb + 38912);
            LAS bf16_t* MmT = (LAS bf16_t*)(wb + 40960); LAS bf16_t* NBT = (LAS bf16_t*)(wb + 43008); LAS bf16_t* MKT = (LAS bf16_t*)(wb + 45056); LAS float* gLs = (LAS float*)(wb + 47104);
            LAS bf16_t* W1 = At; LAS bf16_t* W1T = Btm; LAS bf16_t* ATm = Ktm;
#pragma unroll 1
            for (int it = blockIdx.x * 3 + wave; it < 4096; it += G * 3) {
                const int bh = it >> 7, c = it & 127, b = bh >> 3, h = bh & 7;
                int fr = fr_o, fq = fq_o, lane = lane_o; asm volatile("" : "+v"(fr), "+v"(fq), "+v"(lane));
                const int lpA = (4 * (fr >> 3) + (fr & 3)) + 32 * (fq & 1) + ((fq >> 1) + 4 * ((fr >> 2) & 1)) * 512;
                const int lpB = ((fr >> 1) + 16 * (fq & 1)) * 512 + 16 * (fr & 1) + 4 * (fq >> 1);
                const int lpC = 4 * (fq >> 1) + 16 * (fr & 3) + ((fr >> 2) + 8 * (fq & 1)) * 512;
                const size_t sbase = ((size_t)b * SEQ + c * 32) * 512 + h * 64;
                {
                    float cs = 0.f; unsigned aT[16], bT[16], kT[16], vT[16];
#pragma unroll
                    for (int t = 0; t < 32; ++t) {
                        const size_t o = sbase + (size_t)t * 512 + lane;
                        const float ldv = bf1(Wb[o]), rr = bf1(Rb[o]), kv = bf1(Kb[o]), qv = bf1(KKb[o]), bv = bf1(Bvb[o]); const unsigned vraw = Vb[o];
                        const float ep = __expf(cs); cs += ldv; const float ec = __expf(cs), en = __expf(-cs);
                        const unsigned a_ = bf1of(-qv * ep), b_ = bf1of(bv * en), k_ = bf1of(kv * en), r_ = bf1of(rr * ec);
                        At[SW64(t, lane)] = (bf16_t)a_; Btm[SW64(t, lane)] = (bf16_t)b_; Ktm[SW64(t, lane)] = (bf16_t)k_; Rtm[SW64(t, lane)] = (bf16_t)r_;
                        if (t & 1) { aT[t >> 1] |= a_ << 16; bT[t >> 1] |= b_ << 16; kT[t >> 1] |= k_ << 16; vT[t >> 1] |= vraw << 16; }
                        else { aT[t >> 1] = a_; bT[t >> 1] = b_; kT[t >> 1] = k_; vT[t >> 1] = vraw; }
                    }
#pragma unroll
                    for (int q = 0; q < 4; ++q) {
                        *(LAS u32x4*)(AtT + lane * 32 + ((q ^ ((lane >> 2) & 3)) << 3)) = (u32x4){aT[4 * q], aT[4 * q + 1], aT[4 * q + 2], aT[4 * q + 3]};
                        *(LAS u32x4*)(BtT + lane * 32 + ((q ^ ((lane >> 2) & 3)) << 3)) = (u32x4){bT[4 * q], bT[4 * q + 1], bT[4 * q + 2], bT[4 * q + 3]};
                        *(LAS u32x4*)(KtT + lane * 32 + ((q ^ ((lane >> 2) & 3)) << 3)) = (u32x4){kT[4 * q], kT[4 * q + 1], kT[4 * q + 2], kT[4 * q + 3]};
                        *(LAS u32x4*)(VmT + lane * 32 + ((q ^ ((lane >> 2) & 3)) << 3)) = (u32x4){vT[4 * q], vT[4 * q + 1], vT[4 * q + 2], vT[4 * q + 3]};
                    }
                    const float gl = __expf(cs); gLs[lane] = gl;
                    { const int k5 = lane & 31; GL[(size_t)it * 64 + (lane >> 5) * 32 + ((k5 >> 2) & 1) * 16 + (k5 & 3) + 4 * (k5 >> 3)] = gl; }
                }
                {
                    f32x4 acc[2][2];
#define ZACC(MT_, NT_) _Pragma("unroll") for (int m = 0; m < MT_; ++m) _Pragma("unroll") for (int n = 0; n < NT_; ++n) acc[m][n] = (f32x4){0.f, 0.f, 0.f, 0.f};
                    ZACC(2, 2) gemm_lds<2, 2, 2>(Btm, 64, At, 64, acc, fr, fq);
#pragma unroll
                    for (int m = 0; m < 2; ++m)
#pragma unroll
                        for (int n = 0; n < 2; ++n)
#pragma unroll
                            for (int j = 0; j < 4; ++j) { const int i = 16 * m + fr, tt = 16 * n + 4 * fq + j; const float v = i < tt ? acc[m][n][j] : 0.f; const bf16_t w = bf1of(v), w1 = bf1of(v + (i == tt ? 1.f : 0.f));
                                Nm[SW32(i, tt)] = w; NmT[SW32(tt, i)] = w; Tm[SW32(i, tt)] = w1; TmT[SW32(tt, i)] = w1; }
                    ZACC(2, 2) gemm_lds<2, 2, 2>(Ktm, 64, At, 64, acc, fr, fq);
#pragma unroll
                    for (int m = 0; m < 2; ++m)
#pragma unroll
                        for (int n = 0; n < 2; ++n)
#pragma unroll
                            for (int j = 0; j < 4; ++j) { const int i = 16 * m + fr, tt = 16 * n + 4 * fq + j; MmT[SW32(tt, i)] = bf1of(i < tt ? acc[m][n][j] : 0.f); }
                    ZACC(2, 2) gemm_lds<2, 2, 2>(Btm, 64, Rtm, 64, acc, fr, fq);
#pragma unroll
                    for (int m = 0; m < 2; ++m)
#pragma unroll
                        for (int n = 0; n < 2; ++n)
#pragma unroll
                            for (int j = 0; j < 4; ++j) { const int i = 16 * m + fr, tt = 16 * n + 4 * fq + j; NBT[SW32(tt, i)] = bf1of(i <= tt ? acc[m][n][j] : 0.f); }
                    ZACC(2, 2) gemm_lds<2, 2, 2>(Ktm, 64, Rtm, 64, acc, fr, fq);
#pragma unroll
                    for (int m = 0; m < 2; ++m)
#pragma unroll
                        for (int n = 0; n < 2; ++n)
#pragma unroll
                            for (int j = 0; j < 4; ++j) { const int i = 16 * m + fr, tt = 16 * n + 4 * fq + j; MKT[SW32(tt, i)] = bf1of(i <= tt ? acc[m][n][j] : 0.f); }
#pragma unroll 1
                    for (int rd = 0; rd < 4; ++rd) {
                        ZACC(2, 2) gemm_lds<2, 2, 1>(Nm, 32, NmT, 32, acc, fr, fq);
#pragma unroll
                        for (int m = 0; m < 2; ++m)
#pragma unroll
                            for (int n = 0; n < 2; ++n)
#pragma unroll
                                for (int j = 0; j < 4; ++j) { const int i = 16 * m + fr, tt = 16 * n + 4 * fq + j; const bf16_t w = bf1of(acc[m][n][j]); Nm[SW32(i, tt)] = w; NmT[SW32(tt, i)] = w; }
                        ZACC(2, 2) gemm_lds<2, 2, 1>(Tm, 32, NmT, 32, acc, fr, fq);
#pragma unroll
                        for (int m = 0; m < 2; ++m)
#pragma unroll
                            for (int n = 0; n < 2; ++n)
#pragma unroll
                                for (int j = 0; j < 4; ++j) { const int i = 16 * m + fr, tt = 16 * n + 4 * fq + j; const bf16_t w = bf1of(acc[m][n][j] + bf1(Tm[SW32(i, tt)])); Tm[SW32(i, tt)] = w; TmT[SW32(tt, i)] = w; }
                    }
                }
                asm volatile("" : "+v"(fr), "+v"(fq));
                {
                    f32x4 acc[4][2];
                    ZACC(4, 2) gemm_lds<4, 2, 1>(AtT, 32, TmT, 32, acc, fr, fq);
#pragma unroll
                    for (int m = 0; m < 4; ++m)
#pragma unroll
                        for (int n = 0; n < 2; ++n)
#pragma unroll
                            for (int j = 0; j < 4; ++j) ATm[SW32(16 * m + fr, 16 * n + 4 * fq + j)] = bf1of(acc[m][n][j]);
                    ZACC(4, 2) gemm_lds<4, 2, 1>(VmT, 32, MmT, 32, acc, fr, fq);
#pragma unroll
                    for (int m = 0; m < 4; ++m)
#pragma unroll
                        for (int n = 0; n < 2; ++n)
#pragma unroll
                            for (int j = 0; j < 4; ++j) W1[SW32(16 * m + fr, 16 * n + 4 * fq + j)] = bf1of(acc[m][n][j]);
                    ZACC(4, 2) gemm_lds<4, 2, 1>(W1, 32, TmT, 32, acc, fr, fq);
#pragma unroll
                    for (int m = 0; m < 4; ++m)
#pragma unroll
                        for (int n = 0; n < 2; ++n)
#pragma unroll
                            for (int j = 0; j < 4; ++j) W1T[SW32(16 * m + fr, 16 * n + 4 * fq + j)] = bf1of(acc[m][n][j]);
                    ZACC(4, 2) gemm_lds<4, 2, 1>(ATm, 32, NBT, 32, acc, fr, fq);
#pragma unroll
                    for (int m = 0; m < 4; ++m)
#pragma unroll
                        for (int n = 0; n < 2; ++n)
#pragma unroll
                            for (int j = 0; j < 4; ++j) { const int k = 16 * m + fr, tp = 16 * n + 4 * fq + j; const float v = acc[m][n][j] + bf1(Rtm[SW64(tp, k)]);
                                Rb[sbase + lpA + (size_t)(j * 8 + (2 * n + 8 * m) * 512)] = bf1of(v); }
                    ZACC(4, 2) gemm_lds<4, 2, 1>(W1T, 32, NBT, 32, acc, fr, fq); gemm_lds<4, 2, 1>(VmT, 32, MKT, 32, acc, fr, fq);
#pragma unroll
                    for (int m = 0; m < 4; ++m)
#pragma unroll
                        for (int n = 0; n < 2; ++n)
#pragma unroll
                            for (int j = 0; j < 4; ++j) Yb[sbase + lpB + (size_t)((8 * (m & 1)) * 512 + 32 * (m >> 1) + j + 8 * n)] = bf1of(acc[m][n][j]);
                }
                asm volatile("" : "+v"(fr), "+v"(fq));
                {
                    f32x4 acc[4][4];
                    ZACC(4, 4) gemm_lds<4, 4, 1>(ATm, 32, BtT, 32, acc, fr, fq);
#pragma unroll
                    for (int m = 0; m < 4; ++m)
#pragma unroll
                        for (int n = 0; n < 4; ++n)
#pragma unroll
                            for (int j = 0; j < 4; ++j) { const float v = acc[m][n][j] * gLs[16 * n + 4 * fq + j];
                                (n < 2 ? Wb : Kb)[sbase + lpA + (size_t)(j * 8 + (2 * (n & 1) + 8 * m) * 512)] = bf1of(v); }
                    ZACC(4, 4) gemm_lds<4, 4, 1>(W1T, 32, BtT, 32, acc, fr, fq); gemm_lds<4, 4, 1>(VmT, 32, KtT, 32, acc, fr, fq);
#pragma unroll
                    for (int m = 0; m < 4; ++m)
#pragma unroll
                        for (int n = 0; n < 4; ++n)
#pragma unroll
                            for (int j = 0; j < 4; ++j) { const float v = acc[m][n][j] * gLs[16 * n + 4 * fq + j];
                                (m < 2 ? KKb : Bvb)[sbase + lpC + (size_t)(j + 8 * (n & 1) + (4 * (m & 1) + 16 * (n >> 1)) * 512)] = bf1of(v); }
                }
#undef ZACC
            }
        }
    }
    xcd_barrier(xb);

    {
        PHASE_PTRS
        if (wave < 5 && blockIdx.x < 64) {
            const int item = blockIdx.x, bh = item >> 1, wv = item & 1, b = bh >> 3, h = bh & 7;
            const int hi = lane >> 5, vcol = lane & 31;
            float* GL = (float*)(dob + DO_GL);
            volatile LAS unsigned* ctr = (volatile LAS unsigned*)((LAS unsigned char*)lds + LDS_BYTES - 64);
#define SLICE(arr, sb, li) ((arr) + (sb) + (size_t)((li) >> 6) * 512 + ((li) & 63))
#define DMA16(src_, dst_) __builtin_amdgcn_global_load_lds((const unsigned*)(src_), (LAS unsigned*)(dst_), 16, 0, 0)
            if (wave >= 1 && wave <= 3) {
                __builtin_amdgcn_s_setprio(2);
#pragma unroll 1
                for (int c = 0; c < 128; ++c) {
                    if (c >= 4) { while ((int)ctr[3] < c - 3) __builtin_amdgcn_s_sleep(1); }
                    asm volatile("" ::: "memory");
                    const size_t sb = ((size_t)b * SEQ + c * 32) * 512 + h * 64; LAS unsigned char* lb = (LAS unsigned char*)lds + (c & 3) * 19712;
                    if (wave == 1) {
#pragma unroll
                        for (int q = 0; q < 4; ++q) DMA16(SLICE(Wb, sb, (q * 64 + lane) * 8), lb + q * 1024);
#pragma unroll
                        for (int q = 0; q < 2; ++q) DMA16(SLICE(Kb, sb, (q * 64 + lane) * 8), lb + 4096 + q * 1024);
                        asm volatile("s_waitcnt vmcnt(12)" ::: "memory");
                    } else if (wave == 2) {
#pragma unroll
                        for (int q = 2; q < 4; ++q) DMA16(SLICE(Kb, sb, (q * 64 + lane) * 8), lb + 4096 + q * 1024);
#pragma unroll
                        for (int q = 0; q < 4; ++q) DMA16(SLICE(Rb, sb, (q * 64 + lane) * 8), lb + 8192 + q * 1024);
                        asm volatile("s_waitcnt vmcnt(12)" ::: "memory");
                    } else {
#pragma unroll
                        for (int kb = 0; kb < 2; ++kb)
#pragma unroll
                            for (int hf = 0; hf < 2; ++hf) DMA16(SLICE(wv ? Bvb : KKb, sb, (kb * 64 + lane) * 16 + 8 * hf), lb + 12288 + kb * 2048 + hf * 1024);
#pragma unroll
                        for (int hf = 0; hf < 2; ++hf) DMA16(Yb + sb + (size_t)(lane >> 1) * 512 + 32 * wv + 16 * (lane & 1) + 8 * hf, lb + 16384 + hf * 1024);
                        __builtin_amdgcn_global_load_lds((const unsigned*)(GL + ((size_t)(bh * 128 + c)) * 64 + lane), (LAS unsigned*)(lb + 18432), 4, 0, 0);
                        asm volatile("s_waitcnt vmcnt(14)" ::: "memory");
                    }
                    if (c >= 2 && lane == 0) ctr[wave - 1] = (unsigned)(c - 1);
                }
                asm volatile("s_waitcnt vmcnt(0)" ::: "memory");
                if (lane == 0) ctr[wave - 1] = 128u;
                __builtin_amdgcn_s_setprio(0);
            } else if (wave == 4) {
#pragma unroll 1
                for (int c = 0; c < 128; ++c) {
                    while ((int)ctr[4] <= c) __builtin_amdgcn_s_sleep(2);
                    asm volatile("" ::: "memory");
                    const LAS u32x4* ys = (const LAS u32x4*)((LAS unsigned char*)lds + 81920 + (c & 7) * 2048 + lane * 32);
                    const u32x4 ya = ys[0], yb = ys[1];
                    u32x4* yo = (u32x4*)(Yb + ((size_t)b * SEQ + c * 32 + (lane >> 1)) * 512 + h * 64 + 32 * wv + 16 * (lane & 1));
                    yo[0] = ya; yo[1] = yb;
                    asm volatile("s_waitcnt lgkmcnt(0)" ::: "memory");
                    if (lane == 0) ctr[5] = (unsigned)(c + 1);
                }
            } else {
                __builtin_amdgcn_s_setprio(3);
                f32x16 S0t, S1t;
#pragma unroll
                for (int r = 0; r < 16; ++r) { S0t[r] = 0.f; S1t[r] = 0.f; }
#pragma unroll 1
                for (int c = 0; c < 128; ++c) {
                    while ((int)ctr[0] <= c || (int)ctr[1] <= c || (int)ctr[2] <= c) __builtin_amdgcn_s_sleep(1);
                    asm volatile("" ::: "memory");
                    const LAS unsigned char* lb = (const LAS unsigned char*)lds + (c & 3) * 19712;
                    bf16x8 sf[4];
#pragma unroll
                    for (int s = 0; s < 4; ++s) { float t8[8];
#pragma unroll
                        for (int j = 0; j < 8; ++j) t8[j] = (s < 2 ? S0t : S1t)[8 * (s & 1) + j];
                        sf[s] = pack8(t8); }
                    f32x16 yt;
                    { const u32x4 c0 = *(const LAS u32x4*)(lb + 16384 + lane * 16), c1 = *(const LAS u32x4*)(lb + 16384 + 1024 + lane * 16);
                      yt[0] = bflo(c0.x); yt[1] = bfhi(c0.x); yt[2] = bflo(c0.y); yt[3] = bfhi(c0.y); yt[4] = bflo(c0.z); yt[5] = bfhi(c0.z); yt[6] = bflo(c0.w); yt[7] = bfhi(c0.w);
                      yt[8] = bflo(c1.x); yt[9] = bfhi(c1.x); yt[10] = bflo(c1.y); yt[11] = bfhi(c1.y); yt[12] = bflo(c1.z); yt[13] = bfhi(c1.z); yt[14] = bflo(c1.w); yt[15] = bfhi(c1.w); }
                    f32x16 n0, n1;
#pragma unroll
                    for (int kb = 0; kb < 2; ++kb) {
                        const u32x4 c0 = *(const LAS u32x4*)(lb + 12288 + kb * 2048 + lane * 16), c1 = *(const LAS u32x4*)(lb + 12288 + kb * 2048 + 1024 + lane * 16);
                        const LAS float* gp = (const LAS float*)(lb + 18432) + kb * 32 + hi * 16;
                        f32x16 nn; const f32x16 so = kb ? S1t : S0t;
                        nn[0] = bflo(c0.x); nn[1] = bfhi(c0.x); nn[2] = bflo(c0.y); nn[3] = bfhi(c0.y); nn[4] = bflo(c0.z); nn[5] = bfhi(c0.z); nn[6] = bflo(c0.w); nn[7] = bfhi(c0.w);
                        nn[8] = bflo(c1.x); nn[9] = bfhi(c1.x); nn[10] = bflo(c1.y); nn[11] = bfhi(c1.y); nn[12] = bflo(c1.z); nn[13] = bfhi(c1.z); nn[14] = bflo(c1.w); nn[15] = bfhi(c1.w);
#pragma unroll
                        for (int r = 0; r < 16; ++r) nn[r] += gp[r] * so[r];
                        if (kb) n1 = nn; else n0 = nn;
                    }
#pragma unroll
                    for (int s = 0; s < 4; ++s) {
                        const bf16x8 ra = *(const LAS bf16x8*)(lb + 8192 + s * 1024 + lane * 16);
                        const bf16x8 p0 = *(const LAS bf16x8*)(lb + s * 1024 + lane * 16), p1 = *(const LAS bf16x8*)(lb + 4096 + s * 1024 + lane * 16);
                        yt = mfma32(ra, sf[s], yt); n0 = mfma32(p0, sf[s], n0); n1 = mfma32(p1, sf[s], n1);
                    }
                    S0t = n0; S1t = n1;
                    asm volatile("s_waitcnt lgkmcnt(0)" ::: "memory");
                    if (lane == 0) ctr[3] = (unsigned)(c + 1);
                    if (c >= 8) { while ((int)ctr[5] < c - 7) __builtin_amdgcn_s_sleep(1); }
                    asm volatile("" ::: "memory");
                    { LAS bf16_t* ys = (LAS bf16_t*)((LAS unsigned char*)lds + 81920 + (c & 7) * 2048) + vcol;
#pragma unroll
                      for (int r = 0; r < 16; ++r) ys[crow(r, hi) * 32] = bf1of(yt[r]);
                      asm volatile("s_waitcnt lgkmcnt(0)" ::: "memory");
                      if (lane == 0) ctr[4] = (unsigned)(c + 1); }
                }
                __builtin_amdgcn_s_setprio(0);
            }
#undef DMA16
#undef SLICE
        }
        for (;;) {
            unsigned item = 0;
            const int xg = blockIdx.x & 7;
            if (lane == 0) item = atomicAdd(&cnt[xg], 1u);
            item = __builtin_amdgcn_readfirstlane(item);
            if (item >= 256u) break;
            const int qt = 63 - (int)(item >> 2), bh = 8 * (int)(item & 3) + xg, b = bh >> 3, h = bh & 7;
            const int qi = lane & 31, hi = lane >> 5;
            const size_t tokq = (size_t)b * SEQ + qt * 64 + qi;
            bf16x8 qfa[6], qfb[6];
#pragma unroll
            for (int s = 0; s < 6; ++s) { qfa[s] = *(const bf16x8*)(Qb + (tokq * 8 + h) * 96 + 16 * s + 8 * hi); qfb[s] = *(const bf16x8*)(Qb + ((tokq + 32) * 8 + h) * 96 + 16 * s + 8 * hi); }
            float ma = -1e30f, la = 0.f, mb = -1e30f, lb = 0.f;
            f32x16 oa0, oa1, ob0, ob1;
#pragma unroll
            for (int r = 0; r < 16; ++r) { oa0[r] = 0.f; oa1[r] = 0.f; ob0[r] = 0.f; ob1[r] = 0.f; }
            const bf16_t* kfb = Kab + ((size_t)(b * 8 + h) * 128) * 6 * 512 + lane * 8;
            const bf16_t* vfb = Vt + ((size_t)(b * 8 + h) * 128) * 4 * 512 + lane * 8;
            const int nt = 2 * qt + 2;
#define ATT_GROUP(QF, M_, L_, O0, O1, DIAG) { \
                f32x16 xs; _Pragma("unroll") for (int r = 0; r < 16; ++r) xs[r] = 0.f; \
                _Pragma("unroll") for (int s = 0; s < 6; ++s) xs = mfma32(kf[s], QF[s], xs); \
                if (DIAG) { _Pragma("unroll") for (int r = 0; r < 16; ++r) if (crow(r, hi) > qi) xs[r] = -1e30f; } \
                float mx = xs[0]; _Pragma("unroll") for (int r = 1; r < 16; ++r) mx = fmaxf(mx, xs[r]); \
                mx = fmaxf(mx, __shfl_xor(mx, 32)); \
                if (__any(mx > M_)) { const float mn = fmaxf(M_, mx), alpha = __builtin_amdgcn_exp2f(M_ - mn); L_ *= alpha; M_ = mn; \
                    _Pragma("unroll") for (int r = 0; r < 16; ++r) { O0[r] *= alpha; O1[r] *= alpha; } } \
                float ps = 0.f; _Pragma("unroll") for (int r = 0; r < 16; ++r) { xs[r] = __builtin_amdgcn_exp2f(xs[r] - M_); ps += xs[r]; } \
                L_ += ps; \
                _Pragma("unroll") for (int s = 0; s < 2; ++s) { float t8[8]; _Pragma("unroll") for (int j = 0; j < 8; ++j) t8[j] = xs[8 * s + j]; const bf16x8 pbs = pack8(t8); \
                    O0 = mfma32(vf[0][s], pbs, O0); O1 = mfma32(vf[1][s], pbs, O1); } }
#pragma unroll 1
            for (int kt = 0; kt < nt; ++kt) {
                bf16x8 kf[6], vf[2][2];
#pragma unroll
                for (int s = 0; s < 6; ++s) kf[s] = *(const bf16x8*)(kfb + (size_t)(kt * 6 + s) * 512);
#pragma unroll
                for (int d0 = 0; d0 < 2; ++d0)
#pragma unroll
                    for (int s = 0; s < 2; ++s) vf[d0][s] = *(const bf16x8*)(vfb + (size_t)((kt * 2 + d0) * 2 + s) * 512);
                if (kt < nt - 1) ATT_GROUP(qfa, ma, la, oa0, oa1, kt == nt - 2)
                ATT_GROUP(qfb, mb, lb, ob0, ob1, kt == nt - 1)
            }
#undef ATT_GROUP
            la += __shfl_xor(la, 32); lb += __shfl_xor(lb, 32);
            const float ila = 1.f / la, ilb = 1.f / lb;
            bf16_t* orow = Ob + tokq * 512 + h * 64;
#pragma unroll
            for (int g = 0; g < 4; ++g) {
                st_bf4(orow + 8 * g + 4 * hi, oa0[4 * g] * ila, oa0[4 * g + 1] * ila, oa0[4 * g + 2] * ila, oa0[4 * g + 3] * ila);
                st_bf4(orow + 32 + 8 * g + 4 * hi, oa1[4 * g] * ila, oa1[4 * g + 1] * ila, oa1[4 * g + 2] * ila, oa1[4 * g + 3] * ila);
                st_bf4(orow + (size_t)32 * 512 + 8 * g + 4 * hi, ob0[4 * g] * ilb, ob0[4 * g + 1] * ilb, ob0[4 * g + 2] * ilb, ob0[4 * g + 3] * ilb);
                st_bf4(orow + (size_t)32 * 512 + 32 + 8 * g + 4 * hi, ob1[4 * g] * ilb, ob1[4 * g + 1] * ilb, ob1[4 * g + 2] * ilb, ob1[4 * g + 3] * ilb);
            }
        }
    }
    xcd_barrier(xb);

    {
        PHASE_PTRS
        for (int t = gw; t < T; t += NGW) {
            const int ch = 8 * lane, h = lane >> 3;
            float y[8], v[8], g[8]; ld_bf8(Yb + (size_t)t * 512 + ch, y); ld_bf8(Vb + (size_t)t * 512 + ch, v); ld_bf8(Gtb + (size_t)t * 512 + ch, g);
            float s = 0.f;
#pragma unroll
            for (int i = 0; i < 8; ++i) s += y[i];
            s += __shfl_xor(s, 1); s += __shfl_xor(s, 2); s += __shfl_xor(s, 4);
            const float mu = s * (1.f / 64.f); float q = 0.f;
#pragma unroll
            for (int i = 0; i < 8; ++i) { y[i] -= mu; q += y[i] * y[i]; }
            q += __shfl_xor(q, 1); q += __shfl_xor(q, 2); q += __shfl_xor(q, 4);
            const float rstd = rsqrtf(q * (1.f / 64.f) + 64e-5f);
            const float bo = bonus[(size_t)t * 8 + h];
            const f32x4 lw0 = *(const f32x4*)(rw_ln_w + ch), lw1 = *(const f32x4*)(rw_ln_w + ch + 4), lb0 = *(const f32x4*)(rw_ln_b + ch), lb1 = *(const f32x4*)(rw_ln_b + ch + 4);
            float o[8];
#pragma unroll
            for (int i = 0; i < 8; ++i) { const float lw = i < 4 ? lw0[i & 3] : lw1[i & 3], lb = i < 4 ? lb0[i & 3] : lb1[i & 3]; o[i] = (y[i] * rstd * lw + lb + bo * v[i]) * g[i]; }
            *(bf16x8*)(YA + (size_t)t * 512 + ch) = pack8(o);
        }
    }
    xcd_barrier(xb);

    {
        PHASE_PTRS
        pg8::StaticOrder S; S.init(T, 1024, G, (int)blockIdx.x);
        { pg8::Gemm g{YA, RwoT, T, 1024, 512}; pg8::EpiGate E{MIXED, Gg, 0, 0};
          pg8::gemm_phase<pg8::EpiGate, pg8::StaticOrder, true, true>((PG8_LAS unsigned char*)lds, g, S, E); }
        { pg8::Gemm g{Ob, MwoT, T, 1024, 512}; pg8::EpiGate E{MIXED, Gg, 1024, 1};
          pg8::gemm_phase<pg8::EpiGate, pg8::StaticOrder, true, true>((PG8_LAS unsigned char*)lds, g, S, E); }
    }
    xcd_barrier(xb);

    {
        PHASE_PTRS
        const bool conv_first = ((blockIdx.x >> 3) & 1) != 0;
#define P4B_CONV         { const float* pu = kp->in[29]; const float* pv = kp->in[30]; \
          for (size_t i = (size_t)blockIdx.x * NT + tid; i < (size_t)16384 * 1024 / 16; i += (size_t)G * NT) { \
              u32x4 uo, vo; \
              _Pragma("unroll") for (int q = 0; q < 4; ++q) { \
                  const f32x4 u = ((const f32x4*)pu)[i * 4 + q]; const f32x4 w = ((const f32x4*)norm2_w)[(i & 63) * 4 + q]; \
                  uo[q] = pk4_fp8(u.x * w.x * U8_SCALE, u.y * w.y * U8_SCALE, u.z * w.z * U8_SCALE, u.w * w.w * U8_SCALE); \
                  const f32x4 v = ((const f32x4*)pv)[i * 4 + q]; vo[q] = pk4_fp8(v.x * V8_SCALE, v.y * V8_SCALE, v.z * V8_SCALE, v.w * V8_SCALE); \
              } \
              ((u32x4*)UB)[i] = uo; \
              { const size_t e = i >> 6; const int d0 = (int)(i & 63) * 16; *(u32x4*)((unsigned char*)VBp + ((size_t)(d0 >> 7) * 16384 + e) * 128 + (d0 & 127)) = vo; } } }
        if (conv_first) P4B_CONV
        { pg8::Gemm g{MIXED, WoutT, T, 1024, 1024}; pg8::StaticOrder S; S.init(T, 1024, G, (int)blockIdx.x);
          pg8::EpiRes E{x, HB, ss2};
          pg8::gemm_phase<pg8::EpiRes, pg8::StaticOrder, true, true>((PG8_LAS unsigned char*)lds, g, S, E); }
        if (!conv_first) P4B_CONV
#undef P4B_CONV
    }
    xcd_barrier(xb);

    {
        PHASE_PTRS
        pg8::Gemm g{HB, PwqT, T, 2048, 1024}; pg8::StaticOrder S; S.init(T, 2048, G, (int)blockIdx.x);
        pg8::EpiScale E{SC, ss2};
        pg8::gemm_phase<pg8::EpiScale, pg8::StaticOrder, true, true>((PG8_LAS unsigned char*)lds, g, S, E);
    }
    xcd_barrier(xb);

    {
        PHASE_PTRS
        const int wp = wave & 3; const bool producer = wave < 4;
        volatile LAS unsigned* pc = (volatile LAS unsigned*)((LAS unsigned char*)lds + LDS_BYTES - 128) + 2 * wp;
        int ppair[4];
#pragma unroll
        for (int c = 0; c < 4; ++c) ppair[c] = peer_pair(16 * c + (lane & 15));
        int kq = 0;
        for (int t = blockIdx.x * 4 + wp; t < T; t += G * 4, ++kq) {
            LAS unsigned char* wl = (LAS unsigned char*)lds + wp * 4096 + (kq & 1) * 2048;
            LAS u32x2* tab = (LAS u32x2*)wl;
            const float rs = rsqrtf(ss2[t] * (1.f / DM) + EPS);
            if (producer) {
            if (kq >= 2) { while ((int)pc[1] < kq - 1) __builtin_amdgcn_s_sleep(2); }
            asm volatile("" ::: "memory");
            { float xa[8], xb[8]; ld_bf8(HB + (size_t)t * DM + 16 * lane, xa); ld_bf8(HB + (size_t)t * DM + 16 * lane + 8, xb);
              u32x4 w; w.x = pk4_fp8(xa[0], xa[1], xa[2], xa[3]); w.y = pk4_fp8(xa[4], xa[5], xa[6], xa[7]); w.z = pk4_fp8(xb[0], xb[1], xb[2], xb[3]); w.w = pk4_fp8(xb[4], xb[5], xb[6], xb[7]);
              *(LAS u32x4*)(wl + 1024 + lane * 16) = w; }
            {
                const int l16 = lane & 15, rho = lane >> 4;
                LAS unsigned* rkK = (LAS unsigned*)((LAS unsigned char*)lds + 16384 + wp * 2048);
                LAS float* rkS = (LAS float*)(rkK + 256);
#define CE_(a_, b_) { const unsigned hi_ = umax2(a_, b_), lo_ = a_ < b_ ? a_ : b_; a_ = hi_; b_ = lo_; }
#define SORT8(k) { CE_(k[0], k[1]) CE_(k[2], k[3]) CE_(k[4], k[5]) CE_(k[6], k[7]) CE_(k[0], k[2]) CE_(k[1], k[3]) CE_(k[4], k[6]) CE_(k[5], k[7]) CE_(k[1], k[2]) CE_(k[5], k[6]) \
                    CE_(k[0], k[4]) CE_(k[3], k[7]) CE_(k[1], k[5]) CE_(k[2], k[6]) CE_(k[1], k[4]) CE_(k[3], k[6]) CE_(k[2], k[4]) CE_(k[3], k[5]) CE_(k[3], k[4]) }
#define SORT4(k) { CE_(k[0], k[1]) CE_(k[2], k[3]) CE_(k[0], k[2]) CE_(k[1], k[3]) CE_(k[1], k[2]) }
                {
                    unsigned key[4][8], top[4];
#pragma unroll
                    for (int q = 0; q < 4; ++q) {
                        const u32x4 w = *(const u32x4*)(SC + (size_t)t * 2048 + (4 * q + rho) * 128 + 8 * l16);
#pragma unroll
                        for (int c = 0; c < 8; ++c) { unsigned u = (c & 1) ? (w[c >> 1] & 0xffff0000u) : (w[c >> 1] << 16); u = (u & 0x80000000u) ? ~u : (u | 0x80000000u); key[q][c] = (u & ~127u) | (unsigned)(127 - (8 * l16 + c)); }
                        SORT8(key[q])
                        top[q] = 0u;
                    }
#pragma unroll 1
                    for (int r = 0; r < 16; ++r) {
                        const bool isr = l16 == r;
#pragma unroll
                        for (int q = 0; q < 4; ++q) {
                            const unsigned m = umax16(key[q][0]);
                            const bool win = key[q][0] == m;
#pragma unroll
                            for (int c = 0; c < 7; ++c) key[q][c] = win ? key[q][c + 1] : key[q][c];
                            key[q][7] = win ? 0u : key[q][7];
                            top[q] = isr ? m : top[q];
                        }
                    }
#pragma unroll
                    for (int q = 0; q < 4; ++q) { unsigned u = top[q] & ~127u; u = (u & 0x80000000u) ? (u & 0x7fffffffu) : ~u; rkK[(4 * q + rho) * 16 + l16] = top[q]; rkS[(4 * q + rho) * 16 + l16] = __uint_as_float(u); }
                }
                asm volatile("s_waitcnt lgkmcnt(0)" ::: "memory");
                {
                    unsigned ck[2][4], best[2];
#pragma unroll
                    for (int q = 0; q < 2; ++q) {
                        const int hd = 4 * q + rho;
#pragma unroll
                        for (int c = 0; c < 4; ++c) { const int pr = ppair[c], pi = pr < 0 ? 0 : pr;
                            const float sm = rkS[32 * hd + (pi >> 4)] + rkS[32 * hd + 16 + (pi & 15)]; unsigned u = __float_as_uint(sm); u = (u & 0x80000000u) ? ~u : (u | 0x80000000u);
                            ck[q][c] = pr < 0 ? 0u : ((u & ~255u) | (unsigned)(255 - pr)); }
                        SORT4(ck[q])
                        best[q] = 0u;
                    }
#pragma unroll 1
                    for (int r = 0; r < 16; ++r) {
                        const bool isr = l16 == r;
#pragma unroll
                        for (int q = 0; q < 2; ++q) {
                            const unsigned m = umax16(ck[q][0]);
                            const bool win = ck[q][0] == m;
                            ck[q][0] = win ? ck[q][1] : ck[q][0]; ck[q][1] = win ? ck[q][2] : ck[q][1]; ck[q][2] = win ? ck[q][3] : ck[q][2]; ck[q][3] = win ? 0u : ck[q][3];
                            best[q] = isr ? m : best[q];
                        }
                    }
#pragma unroll
                    for (int q = 0; q < 2; ++q) {
                        const int hd = 4 * q + rho;
                        float bs; { unsigned u = best[q] & ~255u; u = (u & 0x80000000u) ? (u & 0x7fffffffu) : ~u; bs = __uint_as_float(u); }
                        float bmax; { unsigned u = umax16(best[q]) & ~255u; u = (u & 0x80000000u) ? (u & 0x7fffffffu) : ~u; bmax = __uint_as_float(u); }
                        const int pos = 255 - (int)(best[q] & 255u);
                        const float e = __expf(bs - bmax);
                        const float gate = e / sum16(e);
                        const unsigned t1 = rkK[32 * hd + (pos >> 4)], t2 = rkK[32 * hd + 16 + (pos & 15)];
                        const unsigned eid = (127u - (t1 & 127u)) * 128u + (127u - (t2 & 127u));
                        tab[16 * hd + l16] = (u32x2){eid, __float_as_uint(gate)};
                    }
                }
#undef SORT4
#undef SORT8
#undef CE_
            }
            asm volatile("s_waitcnt lgkmcnt(0)" ::: "memory");
            if (lane == 0) pc[0] = (unsigned)(kq + 1);
            } else {
            while ((int)pc[0] <= kq) __builtin_amdgcn_s_sleep(2);
            asm volatile("" ::: "memory");
            const unsigned char* UB8 = (const unsigned char*)UB; const unsigned char* VB8 = (const unsigned char*)VBp;
            u32x4 ua[16];
            { const unsigned char* up = UB8 + (size_t)tab[fr].x * DM + 16 * fq;
#pragma unroll
              for (int s = 0; s < 16; ++s) ua[s] = *(const u32x4*)(up + 64 * s); }
#pragma unroll 1
            for (int h = 0; h < 8; ++h) {
                u32x4 uc[16];
#pragma unroll
                for (int s = 0; s < 16; ++s) uc[s] = ua[s];
                { const int hn = h + 1 < 8 ? h + 1 : 7; const unsigned char* up = UB8 + (size_t)tab[16 * hn + fr].x * DM + 16 * fq;
#pragma unroll
                  for (int s = 0; s < 16; ++s) ua[s] = *(const u32x4*)(up + 64 * s); }
                f32x4 ac0 = (f32x4){0.f, 0.f, 0.f, 0.f}, ac1 = ac0, ac2 = ac0, ac3 = ac0;
#pragma unroll
                for (int s = 0; s < 16; s += 2) {
                    const u32x4 b0 = *(const LAS u32x4*)(wl + 1024 + 64 * s + 16 * fq), b1 = *(const LAS u32x4*)(wl + 1024 + 64 * (s + 1) + 16 * fq);
                    ac0 = mfma16_fp8((u32x2){uc[s].x, uc[s].y}, (u32x2){b0.x, b0.y}, ac0);
                    ac1 = mfma16_fp8((u32x2){uc[s].z, uc[s].w}, (u32x2){b0.z, b0.w}, ac1);
                    ac2 = mfma16_fp8((u32x2){uc[s + 1].x, uc[s + 1].y}, (u32x2){b1.x, b1.y}, ac2);
                    ac3 = mfma16_fp8((u32x2){uc[s + 1].z, uc[s + 1].w}, (u32x2){b1.z, b1.w}, ac3);
                }
                const f32x4 acc = (ac0 + ac1) + (ac2 + ac3);
                const int j = fr & 3;
                const float d = (j == 0 ? acc[0] : (j == 1 ? acc[1] : (j == 2 ? acc[2] : acc[3]))) * (rs * (1.f / U8_SCALE));
                const float act = 0.5f * d * (1.f + erff(d * 0.7071067811865476f));
                if (fr < 4) { const int i = 16 * h + 4 * fq + fr; const float g = __uint_as_float(tab[i].y); tab[i].y = __float_as_uint(g * act * (1.f / V8_SCALE)); }
            }
            asm volatile("s_waitcnt lgkmcnt(0)" ::: "memory");
            {
                const u32x4 tv = *(const LAS u32x4*)(wl + lane * 16);
                LAS unsigned char* tq = wl + 1024; const int r0 = 2 * (lane & 3), l0 = lane >> 2;
                *(LAS unsigned short*)(tq + (r0 * 16 + l0) * 2) = (unsigned short)tv.x; *(LAS unsigned short*)(tq + ((r0 + 1) * 16 + l0) * 2) = (unsigned short)tv.z;
                const float c0 = fminf(fmaxf(__uint_as_float(tv.y) * C8_SCALE, -440.f), 440.f), c1 = fminf(fmaxf(__uint_as_float(tv.w) * C8_SCALE, -440.f), 440.f);
                const unsigned c8 = (unsigned)__builtin_amdgcn_cvt_pk_fp8_f32(c0, c1, 0, false);
                *(tq + 256 + r0 * 16 + l0) = (unsigned char)(c8 & 0xffu); *(tq + 256 + (r0 + 1) * 16 + l0) = (unsigned char)((c8 >> 8) & 0xffu);
                asm volatile("s_waitcnt lgkmcnt(0)" ::: "memory");
                if (lane < 24) { const u32x4 o = *(const LAS u32x4*)(tq + lane * 16); *(u32x4*)(ws + WS_TAB + (size_t)t * 384 + lane * 16) = o; }
            }
            asm volatile("s_waitcnt lgkmcnt(0)" ::: "memory");
            if (lane == 0) pc[1] = (unsigned)(kq + 1);
            }
        }
    }
    xcd_barrier(xb);

    {
        PHASE_PTRS
        const unsigned sl = blockIdx.x & 7;
        const unsigned char* VS = (const unsigned char*)VBp + (size_t)sl * 16384 * 128;
        const int rho = lane >> 3, chi = lane & 7;
        constexpr float CSCALE = C8_SCALE;
        unsigned selLo[4], selHi[4];
#pragma unroll
        for (int k = 0; k < 4; ++k) { const unsigned sh = 8u * (unsigned)(chi & 3); const unsigned v = (0x0c0c0c0cu & ~(0xffu << sh)) | ((unsigned)k << sh);
            selLo[k] = chi < 4 ? v : 0x0c0c0c0cu; selHi[k] = chi < 4 ? 0x0c0c0c0cu : v; }
        const bool olane = (lane & 0x28) == 0;
        const unsigned voff0 = 16u * (unsigned)chi;
        LAS unsigned char* wl8 = (LAS unsigned char*)lds + wave * 6144;
        const int wstride = (G >> 3) * NWAVES, tg0 = (blockIdx.x >> 3) * NWAVES + wave;
        const int nb = tg0 < T / 8 ? (T / 8 - tg0 + wstride - 1) / wstride : 0, ntok = nb * 8;
#define P6C_TOK(i_) ((tg0 + ((i_) >> 3) * wstride) * 8 + ((i_) & 7))
#define P6C_DMA(b_) { _Pragma("unroll") for (int k = 0; k < 3; ++k) __builtin_amdgcn_global_load_lds((const unsigned*)(ws + WS_TAB + (size_t)((tg0 + (b_) * wstride) * 8) * 384 + k * 1024 + lane * 16), (LAS unsigned*)(wl8 + ((b_) & 1) * 3072 + k * 1024), 16, 0, 0); }
#define P6C_TAB(EL, EH, CW, i_) { const int ii_ = (i_) < ntok ? (i_) : ntok - 1; const LAS unsigned char* tq_ = wl8 + ((ii_ >> 3) & 1) * 3072 + (ii_ & 7) * 384; \
            EL = *(const LAS u32x4*)(tq_ + rho * 32); EH = *(const LAS u32x4*)(tq_ + rho * 32 + 16); CW = *(const LAS u32x4*)(tq_ + 256 + rho * 16); }
#define P6C_EID(ER, j_) (((j_) & 1) ? (ER[(j_) >> 1] >> 16) : (ER[(j_) >> 1] & 0xffffu))
#define P6C_LOAD(VV, ER) { _Pragma("unroll") for (int j = 0; j < 8; ++j) VV[j] = *(const u32x4*)(VS + (size_t)((P6C_EID(ER, j) << 7) | voff0)); }
#define P6C_USE(VV, CWA, CWB) { _Pragma("unroll") for (int j = 0; j < 8; ++j) { const unsigned cwd = (j < 4) ? CWA : CWB; \
            u32x2 xo; xo.x = __builtin_amdgcn_perm(cwd, cwd, selLo[j & 3]); xo.y = __builtin_amdgcn_perm(cwd, cwd, selHi[j & 3]); \
            acc0 = mfma16_fp8(xo, (u32x2){VV[j].x, VV[j].y}, acc0); acc1 = mfma16_fp8(xo, (u32x2){VV[j].z, VV[j].w}, acc1); } }
#define P6C_BODY(i_, VA, VB, EL, EH, CW, VBo, EHo) { \
            const size_t oo_ = (size_t)P6C_TOK(i_) * DM + 128 * sl + 16 * chi + 4 * ((lane >> 4) & 1); float* orow = kp->out + oo_; \
            u32x2 hw0 = (u32x2){0u, 0u}, hw1 = hw0; \
            if (olane) { hw0 = *(const u32x2*)(HB + oo_); hw1 = *(const u32x2*)(HB + oo_ + 8); }        \
            P6C_LOAD(VBo, EHo)                                     \
            const u32x4 cwq = CW; \
            __builtin_amdgcn_sched_barrier(0); \
            f32x4 acc0 = (f32x4){0.f, 0.f, 0.f, 0.f}, acc1 = acc0; \
            P6C_USE(VA, cwq.x, cwq.y) \
            __builtin_amdgcn_sched_barrier(0); \
            P6C_TAB(EL, EH, CW, (i_) + 2) \
            P6C_LOAD(VA, EL)                                       \
            __builtin_amdgcn_sched_barrier(0); \
            P6C_USE(VB, cwq.z, cwq.w) \
            float s[8]; \
            _Pragma("unroll") for (int r = 0; r < 4; ++r) {        \
                { const auto rr = __builtin_amdgcn_permlane32_swap(__float_as_uint(acc0[r]), __float_as_uint(acc0[r]), false, false); s[r] = acc0[r] + dpp_f<0x128>(__uint_as_float(rr[1])); } \
                { const auto rr = __builtin_amdgcn_permlane32_swap(__float_as_uint(acc1[r]), __float_as_uint(acc1[r]), false, false); s[4 + r] = acc1[r] + dpp_f<0x128>(__uint_as_float(rr[1])); } } \
            if (olane) { const f32x4 h0 = (f32x4){bflo(hw0.x), bfhi(hw0.x), bflo(hw0.y), bfhi(hw0.y)}, h1 = (f32x4){bflo(hw1.x), bfhi(hw1.x), bflo(hw1.y), bfhi(hw1.y)}; \
                *(f32x4*)orow = h0 + (f32x4){s[0], s[1], s[2], s[3]} * (1.f / CSCALE); *(f32x4*)(orow + 8) = h1 + (f32x4){s[4], s[5], s[6], s[7]} * (1.f / CSCALE); } \
            __builtin_amdgcn_sched_barrier(0); }
        if (nb > 0) {
            u32x4 vA0[8], vB0[8], vA1[8], vB1[8];
            u32x4 eL0, eH0, cw0, eL1, eH1, cw1;
            P6C_DMA(0)
            if (nb > 1) P6C_DMA(1)
            asm volatile("s_waitcnt vmcnt(0)" ::: "memory");
            P6C_TAB(eL0, eH0, cw0, 0)
            P6C_LOAD(vA0, eL0)
            P6C_LOAD(vB0, eH0)
            P6C_TAB(eL1, eH1, cw1, 1)
            P6C_LOAD(vA1, eL1)
#pragma unroll 1
            for (int i = 0; i < ntok; i += 2) {
                if ((i & 7) == 0 && i > 0 && (i >> 3) + 1 < nb) P6C_DMA((i >> 3) + 1)
                if ((i & 7) == 4) asm volatile("s_waitcnt vmcnt(40)" ::: "memory");
                P6C_BODY(i, vA0, vB0, eL0, eH0, cw0, vB1, eH1)
                P6C_BODY(i + 1, vA1, vB1, eL1, eH1, cw1, vB0, eH0)
            }
            asm volatile("s_waitcnt vmcnt(0) lgkmcnt(0)" ::: "memory");
        }
#undef P6C_BODY
#undef P6C_USE
#undef P6C_LOAD
#undef P6C_EID
#undef P6C_TAB
#undef P6C_DMA
#undef P6C_TOK
    }
}

extern "C" void kernel_launch(void* const* d_in, const int* in_sizes, int n_in, void* d_out, int out_size,
                              void* d_ws, size_t ws_size, hipStream_t stream) {
    static int grid_blocks = 0;
    if (!grid_blocks) {
        int dev = 0, cus = 0, per_cu = 0;
        (void)hipGetDevice(&dev);
        (void)hipDeviceGetAttribute(&cus, hipDeviceAttributeMultiprocessorCount, dev);
        (void)hipFuncSetAttribute((const void*)mega, hipFuncAttributeMaxDynamicSharedMemorySize, LDS_BYTES);
        (void)hipOccupancyMaxActiveBlocksPerMultiprocessor(&per_cu, (const void*)mega, NT, LDS_BYTES);
        if (per_cu < 1) per_cu = 1;
        if (per_cu > 1) per_cu = 1;
        grid_blocks = cus * per_cu;
        if (ws_size < 256 * MiB) fprintf(stderr, "kernel_launch: workspace too small: %zu\n", ws_size);
    }
    Params p{};
    for (int i = 0; i < 31; ++i) p.in[i] = (const float*)d_in[i];
    p.out = (float*)d_out;
    p.ws = (unsigned char*)d_ws;
    void* args[] = {&p};
    (void)hipMemsetAsync((unsigned char*)d_ws + WS_CNT, 0, 65536, stream);
    hipError_t e = hipLaunchCooperativeKernel((const void*)mega, dim3(grid_blocks), dim3(NT), args, LDS_BYTES, stream);
    if (e != hipSuccess) fprintf(stderr, "cooperative launch failed: %s (grid %d)\n", hipGetErrorString(e), grid_blocks);
}
```

```cpp
#include <hip/hip_runtime.h>
#include <hip/hip_cooperative_groups.h>
#include <cstdio>
#include <cstdint>
namespace cg = cooperative_groups;

#define DEVI __device__ __forceinline__
typedef unsigned short bf16_t;
typedef short bf16x8 __attribute__((ext_vector_type(8)));
typedef float f32x4 __attribute__((ext_vector_type(4)));
typedef float f32x16 __attribute__((ext_vector_type(16)));
typedef unsigned u32x2 __attribute__((ext_vector_type(2)));
typedef unsigned u32x4 __attribute__((ext_vector_type(4)));

constexpr int T = 16384, SEQ = 4096, DM = 1024;
constexpr int NWAVES = 8, NT = 512;
constexpr int LDS_BYTES = 147456;
constexpr float EPS = 1e-6f;
constexpr float LOG2E = 1.4426950408889634f;
constexpr float QSCALE = 0.10206207261596575f * 1.4426950408889634f;

constexpr size_t MiB = 1u << 20;
constexpr size_t WS_SS2 = 0;
constexpr size_t WS_CNT = 512 * 1024;
constexpr size_t WS_SSQ = 64 * 1024, WS_SSKV = 128 * 1024;
constexpr size_t WS_WIN = 1 * MiB;
constexpr size_t WS_WUQ = 10 * MiB + 512 * 1024;
constexpr size_t WS_WUKV = 11 * MiB + 256 * 1024;
constexpr size_t WS_RWO = 12 * MiB;
constexpr size_t WS_MWO = 13 * MiB;
constexpr size_t WS_WOUT = 14 * MiB;
constexpr size_t WS_PWQ = 16 * MiB;
constexpr size_t WS_SUBK = 20 * MiB;
constexpr size_t WS_W2T = 20 * MiB + 512 * 1024;
constexpr size_t WS_A2T = WS_W2T + 64 * 1024;
constexpr size_t WS_G2T = WS_A2T + 64 * 1024;
constexpr size_t WS_G = 24 * MiB;
constexpr size_t WS_UB = 56 * MiB, WS_VB = 72 * MiB;
constexpr size_t WS_SC = 176 * MiB;
constexpr size_t WS_PRW = 88 * MiB;
constexpr size_t WS_Q = 88 * MiB, WS_K = 112 * MiB, WS_VT = 136 * MiB;
constexpr size_t WS_HB = 88 * MiB;
constexpr size_t WS_QD = 152 * MiB, WS_KVD = 164 * MiB, WS_KPE = 172 * MiB;
constexpr size_t WS_O = 152 * MiB;
constexpr size_t WS_R = 176 * MiB, WS_W = 192 * MiB, WS_KS = 208 * MiB, WS_V = 224 * MiB, WS_KK = 240 * MiB;
constexpr size_t WS_YA = 176 * MiB;
constexpr size_t WS_MIXED = 192 * MiB;
constexpr size_t WS_PQ = 184 * MiB;
constexpr size_t WS_TAB = 240 * MiB;
constexpr size_t DO_XN = 0;
constexpr size_t DO_BV = 0, DO_GT = 16 * MiB, DO_BONUS = 32 * MiB, DO_Y = 33 * MiB, DO_KRAW = 33 * MiB, DO_GL = 50 * MiB;

struct Params {
    const float* in[31];
    float* out;
    unsigned char* ws;
};

DEVI unsigned f2bf(float f) { unsigned u = __float_as_uint(f); return (u + 0x7fffu + ((u >> 16) & 1u)) >> 16; }
typedef float f32x2_t __attribute__((ext_vector_type(2)));
typedef __bf16 bf16x2_t __attribute__((ext_vector_type(2)));
DEVI unsigned pk2(float lo, float hi) { f32x2_t v = {lo, hi}; bf16x2_t b = __builtin_convertvector(v, bf16x2_t); return __builtin_bit_cast(unsigned, b); }
DEVI float bflo(unsigned u) { return __uint_as_float(u << 16); }
DEVI float bfhi(unsigned u) { return __uint_as_float(u & 0xffff0000u); }
DEVI float bf1(bf16_t u) { return __uint_as_float(((unsigned)u) << 16); }
DEVI float wave_sum(float v) {
#pragma unroll
    for (int o = 32; o >= 1; o >>= 1) v += __shfl_xor(v, o);
    return v;
}
DEVI float sigmoidf_(float x) { return __builtin_amdgcn_rcpf(1.f + __builtin_amdgcn_exp2f(-1.4426950408889634f * x)); }
DEVI float tanhf_(float x) { return 1.f - 2.f * __builtin_amdgcn_rcpf(__builtin_amdgcn_exp2f(2.885390081777927f * x) + 1.f); }
DEVI void st_bf4(bf16_t* p, float a, float b, float c, float d) { u32x2 w; w.x = pk2(a, b); w.y = pk2(c, d); *(u32x2*)p = w; }
DEVI void ld_bf4(const bf16_t* p, float (&o)[4]) { u32x2 w = *(const u32x2*)p; o[0] = bflo(w.x); o[1] = bfhi(w.x); o[2] = bflo(w.y); o[3] = bfhi(w.y); }
DEVI void ld_bf8(const bf16_t* p, float (&o)[8]) { u32x4 w = *(const u32x4*)p; o[0] = bflo(w.x); o[1] = bfhi(w.x); o[2] = bflo(w.y); o[3] = bfhi(w.y); o[4] = bflo(w.z); o[5] = bfhi(w.z); o[6] = bflo(w.w); o[7] = bfhi(w.w); }
DEVI bf16x8 pack8(const float (&v)[8]) { u32x4 w; w.x = pk2(v[0], v[1]); w.y = pk2(v[2], v[3]); w.z = pk2(v[4], v[5]); w.w = pk2(v[6], v[7]); return __builtin_bit_cast(bf16x8, w); }
DEVI f32x4 mfma16(bf16x8 a, bf16x8 b, f32x4 c) { return __builtin_amdgcn_mfma_f32_16x16x32_bf16(a, b, c, 0, 0, 0); }
DEVI f32x16 mfma32(bf16x8 a, bf16x8 b, f32x16 c) { return __builtin_amdgcn_mfma_f32_32x32x16_bf16(a, b, c, 0, 0, 0); }
DEVI int crow(int r, int hi) { return (r & 3) + 8 * (r >> 2) + 4 * hi; }


template <int CTRL> DEVI float dpp_f(float v) { return __builtin_bit_cast(float, __builtin_amdgcn_update_dpp(0, __builtin_bit_cast(int, v), CTRL, 0xf, 0xf, true)); }
template <int CTRL> DEVI unsigned dpp_u(unsigned v) { return (unsigned)__builtin_amdgcn_update_dpp(0, (int)v, CTRL, 0xf, 0xf, true); }
DEVI float sum8(float v) { v += dpp_f<0xB1>(v); v += dpp_f<0x4E>(v); v += dpp_f<0x141>(v); return v; }
DEVI float sum16(float v) { v = sum8(v); v += dpp_f<0x140>(v); return v; }
DEVI unsigned umax2(unsigned a, unsigned b) { return a > b ? a : b; }
DEVI unsigned umax16(unsigned v) { v = umax2(v, dpp_u<0xB1>(v)); v = umax2(v, dpp_u<0x4E>(v)); v = umax2(v, dpp_u<0x141>(v)); v = umax2(v, dpp_u<0x140>(v)); return v; }
DEVI unsigned rdlane(unsigned v, int l) { return (unsigned)__builtin_amdgcn_readlane((int)v, l); }
#define LAS __attribute__((address_space(3)))

DEVI unsigned pk4_fp8(float a, float b, float c, float d) { int w = 0; w = __builtin_amdgcn_cvt_pk_fp8_f32(a, b, w, false); w = __builtin_amdgcn_cvt_pk_fp8_f32(c, d, w, true); return (unsigned)w; }
DEVI f32x4 mfma16_fp8(u32x2 a, u32x2 b, f32x4 c) { return __builtin_amdgcn_mfma_f32_16x16x32_fp8_fp8(__builtin_bit_cast(long, a), __builtin_bit_cast(long, b), c, 0, 0, 0); }
DEVI unsigned pk4_u8(float a, float b, float c, float d) { unsigned w = 0; w = __builtin_amdgcn_cvt_pk_u8_f32(a, 0, w); w = __builtin_amdgcn_cvt_pk_u8_f32(b, 1, w); w = __builtin_amdgcn_cvt_pk_u8_f32(c, 2, w); w = __builtin_amdgcn_cvt_pk_u8_f32(d, 3, w); return w; }
constexpr float U8_SCALE = 32.f, V8_SCALE = 4.f;
constexpr float C8_SCALE = 256.f;

template <int OFF> DEVI f32x4 lds_rd128(unsigned a) { f32x4 r; asm volatile("ds_read_b128 %0, %1 offset:%2" : "=v"(r) : "v"(a), "i"(OFF)); return r; }
template <int OFF> DEVI float lds_rd32(unsigned a) { float r; asm volatile("ds_read_b32 %0, %1 offset:%2" : "=v"(r) : "v"(a), "i"(OFF)); return r; }
DEVI void lds_wr32(unsigned a, float v) { asm volatile("ds_write_b32 %0, %1" ::"v"(a), "v"(v) : "memory"); }

#define SW64(r, k) ((r) * 64 + (((((k) >> 3) ^ ((r) & 7))) << 3) + ((k) & 7))
#define SW32(r, c) ((r) * 32 + (((((c) >> 3) ^ (((r) >> 2) & 3))) << 3) + ((c) & 7))
DEVI int swz_off(int r, int chunk, int ld) { return ld == 64 ? r * 64 + ((chunk ^ (r & 7)) << 3) : r * 32 + ((chunk ^ ((r >> 2) & 3)) << 3); }
template <int MT, int NTL, int KS>
DEVI void gemm_lds(const LAS bf16_t* A, int lda, const LAS bf16_t* B, int ldb, f32x4 (&acc)[MT][NTL], int fr, int fq) {
#pragma unroll
    for (int ks = 0; ks < KS; ++ks) {
        bf16x8 a[MT], b[NTL];
#pragma unroll
        for (int m = 0; m < MT; ++m) a[m] = *(const LAS bf16x8*)(A + swz_off(16 * m + fr, 4 * ks + fq, lda));
#pragma unroll
        for (int n = 0; n < NTL; ++n) b[n] = *(const LAS bf16x8*)(B + swz_off(16 * n + fr, 4 * ks + fq, ldb));
#pragma unroll
        for (int m = 0; m < MT; ++m)
#pragma unroll
            for (int n = 0; n < NTL; ++n) acc[m][n] = mfma16(b[n], a[m], acc[m][n]);
    }
}
DEVI bf16_t bf1of(float x) { return (bf16_t)(pk2(x, x) & 0xffffu); }
DEVI void gemm_tile_acc(const bf16_t* __restrict__ A, int lda, const bf16_t* __restrict__ Bt, int ldb, int K, int m0, int n0, int lane, f32x4 (&acc)[4][4]) {
    const int fr = lane & 15, fq = lane >> 4;
    const bf16_t* ap = A + (size_t)(m0 + fr) * lda + fq * 8;
    const bf16_t* bp = Bt + (size_t)(n0 + fr) * ldb + fq * 8;
#pragma unroll 2
    for (int k0 = 0; k0 < K; k0 += 32) {
        bf16x8 a[4], b[4];
#pragma unroll
        for (int m = 0; m < 4; ++m) a[m] = *(const bf16x8*)(ap + (size_t)m * 16 * lda + k0);
#pragma unroll
        for (int n = 0; n < 4; ++n) b[n] = *(const bf16x8*)(bp + (size_t)n * 16 * ldb + k0);
#pragma unroll
        for (int m = 0; m < 4; ++m)
#pragma unroll
            for (int n = 0; n < 4; ++n) acc[m][n] = mfma16(b[n], a[m], acc[m][n]);
    }
}
DEVI void zero_acc(f32x4 (&acc)[4][4]) {
#pragma unroll
    for (int m = 0; m < 4; ++m)
#pragma unroll
        for (int n = 0; n < 4; ++n) acc[m][n] = (f32x4){0.f, 0.f, 0.f, 0.f};
}


namespace pg8 {
#define PG8_LAS __attribute__((address_space(3)))
typedef unsigned short bf16_t;
typedef short bf16x8 __attribute__((ext_vector_type(8)));
typedef float f32x4 __attribute__((ext_vector_type(4)));
typedef unsigned u32x4 __attribute__((ext_vector_type(4)));
constexpr int BM = 256, BK = 64, HALF = 128, HTB = HALF * BK * 2  , STAGE_BYTES = 8 * HTB, NXCD = 8, WGM = 8;

__host__ __device__ __forceinline__ int lds_byte(int r, int c) { const int st = (r >> 4) * 2 + (c >> 5), rr = r & 15, cc = c & 31, ob = rr * 64 + cc * 2; return st * 1024 + (ob ^ (((ob >> 9) & 1) << 5)); }
__host__ __device__ __forceinline__ void stage_rc(int b, int& R, int& C) { const int st = b / 1024, sb = b % 1024, swz = sb ^ (((sb >> 9) & 1) << 5); R = (st >> 1) * 16 + swz / 64; C = (st & 1) * 32 + (swz % 64) / 2; }
__host__ __device__ __forceinline__ int perm32(int rho) { const int n = rho >> 4, i = rho & 15; return 8 * (i >> 2) + 4 * n + (i & 3); }

struct Unit { int pm, pn; };
struct Gemm { const bf16_t* A; const bf16_t* Bt; int M, N, K; };

struct StaticOrder {
    int nM, nN, nwg, G, c;
    __host__ __device__ void init(int M, int N, int G_, int c_) { nM = M / BM; nN = N / BM; nwg = nM * nN; G = G_; c = c_; }
    __host__ __device__ bool next(int i, Unit& u) const {
        const long L = (long)i * G + c; if (L >= nwg) return false;
        int wgid = (int)L; { const int q = nwg / NXCD, r = nwg % NXCD, xcd = wgid % NXCD, off = wgid / NXCD; wgid = (xcd < r ? xcd * (q + 1) : r * (q + 1) + (xcd - r) * q) + off; }
        const int nig = WGM * nN, gid = wgid / nig, fm = gid * WGM, gsz = (nM - fm) < WGM ? (nM - fm) : WGM;
        u.pm = fm + ((wgid % nig) % gsz); u.pn = (wgid % nig) / gsz; return true;
    }
    __device__ __forceinline__ void a_ready(const Unit&) const {}
    __device__ __forceinline__ void done(const Unit&) const {}
};


DEVI float sigm(float x) { return __builtin_amdgcn_rcpf(1.f + __builtin_amdgcn_exp2f(-1.4426950408889634f * x)); }
DEVI u32x4 pack8v(f32x4 a, f32x4 b) { u32x4 w; w.x = pk2(a[0], a[1]); w.y = pk2(a[2], a[3]); w.z = pk2(b[0], b[1]); w.w = pk2(b[2], b[3]); return w; }
struct EpiP1 {
    static constexpr bool PERM = true, AFTER_DRAIN = false;
    unsigned char* ws;
    __device__ __forceinline__ void operator()(const f32x4 (&acc)[2][2][4][2], const Unit& u, int wr, int wc, int fr_in, int fq_in) const {
        int fr = fr_in, fq = fq_in; asm volatile("" : "+v"(fr), "+v"(fq));
        const int row0 = u.pm * BM + wr * 64 + fr;
        if (u.pn >= 8 && u.pn < 11) {
#pragma unroll
            for (int bj = 0; bj < 2; ++bj) {
                const int c = (u.pn - 8) * 256 + bj * HALF + wc * 32 + 8 * fq;
                const size_t off = c < 384 ? WS_QD : (c < 640 ? WS_KVD : WS_KPE);
                const int ld = c < 384 ? 384 : (c < 640 ? 256 : 32), cc = c < 384 ? c : (c < 640 ? c - 384 : c - 640);
                if (c < 672) {
#pragma unroll
                    for (int ai = 0; ai < 2; ++ai)
#pragma unroll
                        for (int m = 0; m < 4; ++m) { const size_t row = (size_t)(row0 + ai * HALF + m * 16);
                            *(u32x4*)(ws + off + (row * ld + cc) * 2) = pack8v(acc[ai][bj][m][0], acc[ai][bj][m][1]); }
                }
            }
            return;
        }
        if (u.pn >= 11) {
            const int col0 = (u.pn - 11) * 256 + wc * 32 + 8 * fq;
#pragma unroll
            for (int ai = 0; ai < 2; ++ai)
#pragma unroll
                for (int m = 0; m < 4; ++m) { unsigned char* rowp = ws + WS_G + ((size_t)(row0 + ai * HALF + m * 16) * 2048 + col0);
#pragma unroll
                    for (int bj = 0; bj < 2; ++bj) { const f32x4 v0 = acc[ai][bj][m][0], v1 = acc[ai][bj][m][1];
                        u32x2 w; w.x = pk4_u8(sigm(v0[0]) * 255.f, sigm(v0[1]) * 255.f, sigm(v0[2]) * 255.f, sigm(v0[3]) * 255.f);
                        w.y = pk4_u8(sigm(v1[0]) * 255.f, sigm(v1[1]) * 255.f, sigm(v1[2]) * 255.f, sigm(v1[3]) * 255.f);
                        *(u32x2*)(rowp + bj * HALF) = w; } }
            return;
        }
        const int col0 = u.pn * 256 + wc * 32 + 8 * fq;
#pragma unroll
        for (int ai = 0; ai < 2; ++ai)
#pragma unroll
            for (int m = 0; m < 4; ++m) { unsigned char* rowp = ws + WS_PRW + ((size_t)(row0 + ai * HALF + m * 16) * 2048 + col0) * 2;
#pragma unroll
                for (int bj = 0; bj < 2; ++bj) *(u32x4*)(rowp + bj * HALF * 2) = pack8v(acc[ai][bj][m][0], acc[ai][bj][m][1]); }
    }
};
struct EpiQraw {
    static constexpr bool PERM = true, AFTER_DRAIN = false;
    bf16_t* q; const float* ssq;
    __device__ __forceinline__ void operator()(const f32x4 (&acc)[2][2][4][2], const Unit& u, int wr, int wc, int fr_in, int fq_in) const {
        int fr = fr_in, fq = fq_in; asm volatile("" : "+v"(fr), "+v"(fq));
        const int row0 = u.pm * BM + wr * 64 + fr, col0 = u.pn * BM + wc * 32 + 8 * fq;
#pragma unroll
        for (int ai = 0; ai < 2; ++ai)
#pragma unroll
            for (int m = 0; m < 4; ++m) { const size_t row = (size_t)(row0 + ai * HALF + m * 16); const float rs = ssq[row];
#pragma unroll
                for (int bj = 0; bj < 2; ++bj) *(u32x4*)(q + row * 768 + col0 + bj * HALF) = pack8v(acc[ai][bj][m][0] * rs, acc[ai][bj][m][1] * rs); }
    }
};
struct EpiKVraw {
    static constexpr bool PERM = true, AFTER_DRAIN = false;
    bf16_t* kraw; bf16_t* vt; const float* sskv;
    __device__ __forceinline__ void operator()(const f32x4 (&acc)[2][2][4][2], const Unit& u, int wr, int wc, int fr_in, int fq_in) const {
        int fr = fr_in, fq = fq_in; asm volatile("" : "+v"(fr), "+v"(fq));
        const int row0 = u.pm * BM + wr * 64 + fr;
#pragma unroll
        for (int ai = 0; ai < 2; ++ai)
#pragma unroll
            for (int m = 0; m < 4; ++m) { const int row = row0 + ai * HALF + m * 16; const float rs = sskv[row];
#pragma unroll
                for (int bj = 0; bj < 2; ++bj) { const f32x4 v0 = acc[ai][bj][m][0] * rs, v1 = acc[ai][bj][m][1] * rs;
                    if (u.pn < 2) *(u32x4*)(kraw + (size_t)row * 512 + u.pn * BM + bj * HALF + wc * 32 + 8 * fq) = pack8v(v0, v1);
                    else { const int c = (u.pn - 2) * BM + bj * HALF + wc * 32 + 8 * fq, h = c >> 6, d = c & 63; const int bb = row >> 12, s = row & 4095;
                        const int kt = s >> 5, k4 = s & 15, jj = 4 * (k4 >> 3) + (k4 & 3), hv = (k4 >> 2) & 1;
                        bf16_t* vp = vt + ((((size_t)(bb * 8 + h) * 128 + kt) * 2 + (d >> 5)) * 2 + ((s >> 4) & 1)) * 512 + ((d & 31) + 32 * hv) * 8 + jj; const u32x4 w = pack8v(v0, v1);
                        vp[0] = (bf16_t)(w.x & 0xffffu); vp[8] = (bf16_t)(w.x >> 16); vp[16] = (bf16_t)(w.y & 0xffffu); vp[24] = (bf16_t)(w.y >> 16);
                        vp[32] = (bf16_t)(w.z & 0xffffu); vp[40] = (bf16_t)(w.z >> 16); vp[48] = (bf16_t)(w.w & 0xffffu); vp[56] = (bf16_t)(w.w >> 16); } } }
    }
};
struct EpiGate {
    static constexpr bool PERM = true, AFTER_DRAIN = false;
    bf16_t* mixed; const unsigned char* gg; int goff; int add;
    __device__ __forceinline__ void operator()(const f32x4 (&acc)[2][2][4][2], const Unit& u, int wr, int wc, int fr_in, int fq_in) const {
        int fr = fr_in, fq = fq_in; asm volatile("" : "+v"(fr), "+v"(fq));
        const int row0 = u.pm * BM + wr * 64 + fr, col0 = u.pn * BM + wc * 32 + 8 * fq;
#pragma unroll
        for (int ai = 0; ai < 2; ++ai)
#pragma unroll
            for (int m = 0; m < 4; ++m) { const size_t row = (size_t)(row0 + ai * HALF + m * 16);
#pragma unroll
                for (int bj = 0; bj < 2; ++bj) { const int col = col0 + bj * HALF;
                    const u32x2 gw = *(const u32x2*)(gg + row * 2048 + goff + col);
                    const f32x4 g0 = (f32x4){(float)(gw.x & 0xffu), (float)((gw.x >> 8) & 0xffu), (float)((gw.x >> 16) & 0xffu), (float)(gw.x >> 24)};
                    const f32x4 g1 = (f32x4){(float)(gw.y & 0xffu), (float)((gw.y >> 8) & 0xffu), (float)((gw.y >> 16) & 0xffu), (float)(gw.y >> 24)};
                    f32x4 v0 = g0 * (acc[ai][bj][m][0] * (1.f / 255.f)), v1 = g1 * (acc[ai][bj][m][1] * (1.f / 255.f));
                    if (add) { const u32x4 pw = *(const u32x4*)(mixed + row * 1024 + col);
                        v0 += (f32x4){__uint_as_float(pw.x << 16), __uint_as_float(pw.x & 0xffff0000u), __uint_as_float(pw.y << 16), __uint_as_float(pw.y & 0xffff0000u)};
                        v1 += (f32x4){__uint_as_float(pw.z << 16), __uint_as_float(pw.z & 0xffff0000u), __uint_as_float(pw.w << 16), __uint_as_float(pw.w & 0xffff0000u)}; }
                    *(u32x4*)(mixed + row * 1024 + col) = pack8v(v0, v1); } }
    }
};
struct EpiRes {
    static constexpr bool PERM = true, AFTER_DRAIN = false;
    const float* x; bf16_t* hb; float* ss2;
    __device__ __forceinline__ void operator()(const f32x4 (&acc)[2][2][4][2], const Unit& u, int wr, int wc, int fr_in, int fq_in) const {
        int fr = fr_in, fq = fq_in; asm volatile("" : "+v"(fr), "+v"(fq));
        const int row0 = u.pm * BM + wr * 64 + fr, col0 = u.pn * BM + wc * 32 + 8 * fq;
#pragma unroll
        for (int ai = 0; ai < 2; ++ai)
#pragma unroll
            for (int m = 0; m < 4; ++m) { const size_t row = (size_t)(row0 + ai * HALF + m * 16); float sq = 0.f;
#pragma unroll
                for (int bj = 0; bj < 2; ++bj) { const size_t o = row * 1024 + col0 + bj * HALF;
                    const f32x4 h0 = *(const f32x4*)(x + o) + acc[ai][bj][m][0], h1 = *(const f32x4*)(x + o + 4) + acc[ai][bj][m][1];
                    *(u32x4*)(hb + o) = pack8v(h0, h1);
                    sq += (h0[0] * h0[0] + h0[1] * h0[1]) + (h0[2] * h0[2] + h0[3] * h0[3]) + (h1[0] * h1[0] + h1[1] * h1[1]) + (h1[2] * h1[2] + h1[3] * h1[3]); }
                sq += __shfl_xor(sq, 16); sq += __shfl_xor(sq, 32);
                if (fq == 0) atomicAdd(ss2 + row, sq); }
    }
};
struct EpiScale {
    static constexpr bool PERM = true, AFTER_DRAIN = false;
    bf16_t* pq; const float* ss2;
    __device__ __forceinline__ void operator()(const f32x4 (&acc)[2][2][4][2], const Unit& u, int wr, int wc, int fr_in, int fq_in) const {
        int fr = fr_in, fq = fq_in; asm volatile("" : "+v"(fr), "+v"(fq));
        const int row0 = u.pm * BM + wr * 64 + fr, col0 = u.pn * BM + wc * 32 + 8 * fq;
#pragma unroll
        for (int ai = 0; ai < 2; ++ai)
#pragma unroll
            for (int m = 0; m < 4; ++m) { const size_t row = (size_t)(row0 + ai * HALF + m * 16); const float rs = rsqrtf(ss2[row] * (1.f / 1024.f) + 1e-6f);
#pragma unroll
                for (int bj = 0; bj < 2; ++bj) *(u32x4*)(pq + row * 2048 + col0 + bj * HALF) = pack8v(acc[ai][bj][m][0] * rs, acc[ai][bj][m][1] * rs); }
    }
};
template <class Epi, class Sched, bool ALIGN_EPI = false, bool SP2 = false>
__device__ __forceinline__ void gemm_phase(PG8_LAS unsigned char* lds, const Gemm g, const Sched& S, const Epi& E) {
    int tid_l = threadIdx.x; asm volatile("" : "+v"(tid_l));
    const int tid = tid_l, wid = __builtin_amdgcn_readfirstlane(tid >> 6), lane = tid & 63, wr = wid >> 2, wc = wid & 3, fr = lane & 15, fq = lane >> 4;
    const int K = g.K, nt = K / BK;
    unsigned voffA[2], voffB[2];
#pragma unroll
    for (int i = 0; i < 2; ++i) { int R, C; stage_rc(tid * 16 + i * 8192, R, C); const int Rb = Epi::PERM ? ((R & ~31) + perm32(R & 31)) : R;
        voffA[i] = (unsigned)(R * K + C) * 2u; voffB[i] = (unsigned)(Rb * K + C) * 2u; }
    const size_t kstep = (size_t)(BK * 2);
    const size_t hstep = (size_t)HALF * K * 2;
    const size_t tstep = 2 * hstep;
    const unsigned ldsw = (unsigned)wid * 1024u;
    const int aoff = lds_byte(wr * 64 + fr, fq * 8), boff = lds_byte(wc * 32 + fr, fq * 8);
#define PG8_SA(b, h) (((b) * 2 + (h)) * HTB)
#define PG8_SB(b, h) ((4 + (b) * 2 + (h)) * HTB)
#define PG8_STAGE(bufoff, gbase, voff) do { _Pragma("unroll") for (int _i = 0; _i < 2; ++_i) \
        __builtin_amdgcn_global_load_lds((const unsigned*)((const char*)(gbase) + (voff)[_i]), (PG8_LAS unsigned*)(lds + (bufoff) + ldsw + _i * 8192), 16, 0, 0); } while (0)
#define PG8_LDA(dst, b, h) do { _Pragma("unroll") for (int m = 0; m < 4; ++m) _Pragma("unroll") for (int k = 0; k < 2; ++k) dst[m][k] = *(const PG8_LAS bf16x8*)(lds + PG8_SA(b, h) + aoff + m * 2048 + k * 1024); } while (0)
#define PG8_LDB(dst, b, h) do { _Pragma("unroll") for (int n = 0; n < 2; ++n) _Pragma("unroll") for (int k = 0; k < 2; ++k) dst[n][k] = *(const PG8_LAS bf16x8*)(lds + PG8_SB(b, h) + boff + n * 2048 + k * 1024); } while (0)
#define PG8_MMA(ai, bj, At, Bt) do { __builtin_amdgcn_s_setprio(1); _Pragma("unroll") for (int m = 0; m < 4; ++m) _Pragma("unroll") for (int n = 0; n < 2; ++n) _Pragma("unroll") for (int k = 0; k < 2; ++k) \
        acc[ai][bj][m][n] = __builtin_amdgcn_mfma_f32_16x16x32_bf16(Bt[n][k], At[m][k], acc[ai][bj][m][n], 0, 0, 0); __builtin_amdgcn_s_setprio(0); } while (0)
#define PG8_WAIT_V(n) asm volatile("s_waitcnt vmcnt(" #n ")" ::: "memory")
#define PG8_WAIT_L(n) asm volatile("s_waitcnt lgkmcnt(" #n ")" ::: "memory")
#define PG8_BAR __builtin_amdgcn_s_barrier()
#define PG8_SCHED __builtin_amdgcn_sched_barrier(0)
    Unit cur, nxt; int ui = 0;
    if (!S.next(0, cur)) return;
    f32x4 acc[2][2][4][2];
#pragma unroll
    for (int a = 0; a < 2; ++a)
#pragma unroll
        for (int b = 0; b < 2; ++b)
#pragma unroll
            for (int m = 0; m < 4; ++m)
#pragma unroll
                for (int n = 0; n < 2; ++n) acc[a][b][m][n] = (f32x4){0.f, 0.f, 0.f, 0.f};
    bf16x8 At[4][2], B0[2][2], B1[2][2];
    const char* cA = (const char*)g.A + (size_t)cur.pm * tstep; const char* cB = (const char*)g.Bt + (size_t)cur.pn * tstep;
    S.a_ready(cur);
    if constexpr (SP2) {
        PG8_STAGE(PG8_SB(0, 0), cB, voffB); PG8_STAGE(PG8_SB(0, 1), cB + hstep, voffB); PG8_STAGE(PG8_SA(0, 0), cA, voffA); PG8_STAGE(PG8_SA(0, 1), cA + hstep, voffA);
        if (wr == 1) PG8_BAR;
        PG8_WAIT_V(2); PG8_BAR;
        PG8_STAGE(PG8_SB(1, 0), cB + kstep, voffB); PG8_STAGE(PG8_SA(1, 0), cA + kstep, voffA); PG8_STAGE(PG8_SB(1, 1), cB + hstep + kstep, voffB);
        PG8_WAIT_V(6); PG8_BAR;
    } else {
        PG8_STAGE(PG8_SB(0, 0), cB, voffB); PG8_STAGE(PG8_SA(0, 0), cA, voffA); PG8_STAGE(PG8_SB(0, 1), cB + hstep, voffB); PG8_STAGE(PG8_SA(0, 1), cA + hstep, voffA);
        if (wr == 1) PG8_BAR;
        PG8_WAIT_V(4); PG8_BAR;
        PG8_STAGE(PG8_SB(1, 0), cB + kstep, voffB); PG8_STAGE(PG8_SA(1, 0), cA + kstep, voffA); PG8_STAGE(PG8_SB(1, 1), cB + hstep + kstep, voffB);
        PG8_WAIT_V(6); PG8_BAR;
    }
    for (;;) {
        const bool has_next = S.next(ui + 1, nxt);
        const char* nA = has_next ? (const char*)g.A + (size_t)nxt.pm * tstep : cA; const char* nB = has_next ? (const char*)g.Bt + (size_t)nxt.pn * tstep : cB;
        for (int t = 0; t < nt; t += 2) {
            const bool last = (t == nt - 2);
            const char* a1 = cA + (size_t)(t + 1) * kstep;
            const char* a2 = last ? nA : cA + (size_t)(t + 2) * kstep; const char* b2 = last ? nB : cB + (size_t)(t + 2) * kstep;
            const char* a3 = a2 + kstep; const char* b3 = b2 + kstep;
            if (last && has_next) S.a_ready(nxt);
            if constexpr (SP2) {
            PG8_LDB(B0, 0, 0); PG8_LDB(B1, 0, 1); PG8_SCHED; PG8_LDA(At, 0, 0); PG8_STAGE(PG8_SA(1, 1), a1 + hstep, voffA);
            PG8_WAIT_V(8); PG8_WAIT_L(0); PG8_BAR; PG8_MMA(0, 0, At, B0); PG8_MMA(0, 1, At, B1); PG8_BAR; PG8_SCHED;
            PG8_LDA(At, 0, 1); PG8_STAGE(PG8_SB(0, 0), b2, voffB); PG8_STAGE(PG8_SB(0, 1), b2 + hstep, voffB); PG8_STAGE(PG8_SA(0, 0), a2, voffA);
            PG8_WAIT_V(8); PG8_WAIT_L(0); PG8_BAR; PG8_MMA(1, 0, At, B0); PG8_MMA(1, 1, At, B1); PG8_BAR; PG8_SCHED;
            PG8_LDB(B0, 1, 0); PG8_LDB(B1, 1, 1); PG8_SCHED; PG8_LDA(At, 1, 0); PG8_STAGE(PG8_SA(0, 1), a2 + hstep, voffA);
            PG8_WAIT_V(8); PG8_WAIT_L(0); PG8_BAR; PG8_MMA(0, 0, At, B0); PG8_MMA(0, 1, At, B1); PG8_BAR; PG8_SCHED;
            PG8_LDA(At, 1, 1); PG8_STAGE(PG8_SB(1, 0), b3, voffB); PG8_STAGE(PG8_SB(1, 1), b3 + hstep, voffB); PG8_STAGE(PG8_SA(1, 0), a3, voffA);
            PG8_WAIT_V(8); PG8_WAIT_L(0); PG8_BAR; PG8_MMA(1, 0, At, B0); PG8_MMA(1, 1, At, B1); PG8_BAR; PG8_SCHED;
            } else {
            PG8_LDB(B0, 0, 0); PG8_SCHED; PG8_LDA(At, 0, 0); PG8_STAGE(PG8_SA(1, 1), a1 + hstep, voffA);
            PG8_WAIT_L(8); PG8_BAR; PG8_WAIT_L(0); PG8_MMA(0, 0, At, B0); PG8_BAR; PG8_SCHED;
            PG8_LDB(B1, 0, 1); PG8_STAGE(PG8_SB(0, 0), b2, voffB);
            PG8_BAR; PG8_WAIT_L(0); PG8_MMA(0, 1, At, B1); PG8_BAR;
            PG8_LDA(At, 0, 1); PG8_STAGE(PG8_SA(0, 0), a2, voffA);
            PG8_BAR; PG8_WAIT_L(0); PG8_MMA(1, 0, At, B0); PG8_BAR; PG8_SCHED;
            PG8_STAGE(PG8_SB(0, 1), b2 + hstep, voffB);
            PG8_WAIT_V(6); PG8_BAR; PG8_MMA(1, 1, At, B1); PG8_BAR;
            PG8_LDB(B0, 1, 0); PG8_SCHED; PG8_LDA(At, 1, 0); PG8_STAGE(PG8_SA(0, 1), a2 + hstep, voffA);
            PG8_WAIT_L(8); PG8_BAR; PG8_WAIT_L(0); PG8_MMA(0, 0, At, B0); PG8_BAR; PG8_SCHED;
            PG8_LDB(B1, 1, 1); PG8_STAGE(PG8_SB(1, 0), b3, voffB);
            PG8_BAR; PG8_WAIT_L(0); PG8_MMA(0, 1, At, B1); PG8_BAR;
            PG8_LDA(At, 1, 1); PG8_STAGE(PG8_SA(1, 0), a3, voffA);
            PG8_BAR; PG8_WAIT_L(0); PG8_MMA(1, 0, At, B0); PG8_BAR; PG8_SCHED;
            PG8_STAGE(PG8_SB(1, 1), b3 + hstep, voffB);
            PG8_WAIT_V(6); PG8_BAR; PG8_MMA(1, 1, At, B1); PG8_BAR;
            }
        }
        if constexpr (ALIGN_EPI) { if (wr == 0) PG8_BAR; }
        if constexpr (!Epi::AFTER_DRAIN) { E(acc, cur, wr, wc, fr, fq); S.done(cur); }
        if (!has_next) break;
#pragma unroll
        for (int a = 0; a < 2; ++a)
#pragma unroll
            for (int b = 0; b < 2; ++b)
#pragma unroll
                for (int m = 0; m < 4; ++m)
#pragma unroll
                    for (int n = 0; n < 2; ++n) acc[a][b][m][n] = (f32x4){0.f, 0.f, 0.f, 0.f};
        cur = nxt; cA = nA; cB = nB; ++ui;
        if constexpr (ALIGN_EPI) { if (wr == 1) PG8_BAR; }
    }
    PG8_WAIT_V(0);
    if constexpr (!ALIGN_EPI) { if (wr == 0) PG8_BAR; }
    PG8_BAR;
    if constexpr (Epi::AFTER_DRAIN) { E.fused(acc, cur, wr, wc, fr, fq, lds, wid, lane); S.done(cur); }
#undef PG8_SA
#undef PG8_SB
#undef PG8_STAGE
#undef PG8_LDA
#undef PG8_LDB
#undef PG8_MMA
#undef PG8_WAIT_V
#undef PG8_WAIT_L
#undef PG8_BAR
#undef PG8_SCHED
}
}


#define RLX_AGENT __ATOMIC_RELAXED, __HIP_MEMORY_SCOPE_AGENT
#define XB_TMO      128
#define XB_XCNT(j)  (256  + 64 * (j))
#define XB_XSUB(j)  (1280 + 64 * (j))
#define XB_XGEN(j)  (2304 + 64 * (j))
#define XB_TOP      3328
#define XB_TOPGEN   3392
#define XCD_BAR_WORDS 3456
#define XB_SPIN_CAP (1u << 18)

__device__ __forceinline__ unsigned xb_ld(unsigned* p)              { return __hip_atomic_load(p, __ATOMIC_RELAXED, __HIP_MEMORY_SCOPE_AGENT); }
__device__ __forceinline__ unsigned xb_add(unsigned* p, unsigned v) { return __hip_atomic_fetch_add(p, v, __ATOMIC_RELAXED, __HIP_MEMORY_SCOPE_AGENT); }
__device__ __forceinline__ unsigned xb_xcc_id() { return (unsigned)__builtin_amdgcn_s_getreg((3 << 11) | 20) & 0xFu; }
#define XB_SPIN(cond, bar) do { unsigned _sp = 0; while (cond) { __builtin_amdgcn_s_sleep(1); \
    if ((++_sp & 255u) == 0u) { if (xb_ld(&(bar)[XB_TMO])) break; if (_sp > XB_SPIN_CAP) { atomicAdd(&(bar)[XB_TMO], 1u); break; } } } } while (0)

struct XcdBarrier {
    unsigned* bar; unsigned x;
    volatile LAS unsigned* st;
};

__device__ __forceinline__ XcdBarrier xcd_barrier_post(unsigned* bar, volatile LAS unsigned* st) {
    XcdBarrier b; b.bar = bar; b.x = xb_xcc_id(); b.st = st;
    if (threadIdx.x == 0) (void)xb_add(&bar[XB_XCNT(b.x)], 1u);
    return b;
}
__device__ __forceinline__ void xcd_barrier_complete(unsigned* bar, unsigned x, unsigned& nloc, unsigned& nx) {
    const unsigned G = gridDim.x * gridDim.y * gridDim.z;
    unsigned sum, cnt, mine, sp = 0u;
    for (;;) {
        sum = 0u; cnt = 0u; mine = 0u;
#pragma unroll
        for (unsigned j = 0; j < 16; ++j) { const unsigned c = xb_ld(&bar[XB_XCNT(j)]); sum += c; cnt += (c > 0u) ? 1u : 0u; mine = (j == x) ? c : mine; }
        if (sum == G) break;
        __builtin_amdgcn_s_sleep(1);
        if ((++sp & 255u) == 0u) { if (xb_ld(&bar[XB_TMO])) break; if (sp > XB_SPIN_CAP) { atomicAdd(&bar[XB_TMO], 1u); break; } }
    }
    nloc = mine > 0u ? mine : 1u; nx = cnt > 0u ? cnt : 1u;
}

__device__ __forceinline__ void xcd_barrier(const XcdBarrier& b) {
    asm volatile("s_waitcnt vmcnt(0)" ::: "memory");
    __syncthreads();
    if (threadIdx.x == 0) {
        unsigned* bar = b.bar;
        __builtin_amdgcn_s_waitcnt(0);
        unsigned nloc = b.st[0], nx = b.st[1];
        if (nloc == 0u) { xcd_barrier_complete(bar, b.x, nloc, nx); b.st[0] = nloc; b.st[1] = nx; }
        const unsigned old = xb_add(&bar[XB_XSUB(b.x)], 1u);
        const unsigned gen = old / nloc;
        if (old + 1u == (gen + 1u) * nloc) {
            __builtin_amdgcn_fence(__ATOMIC_RELEASE, "agent");
            asm volatile("s_waitcnt vmcnt(0)" ::: "memory");
            const unsigned og = xb_add(&bar[XB_TOP], 1u);
            const unsigned tg = og / nx;
            if (og + 1u == (tg + 1u) * nx) xb_add(&bar[XB_TOPGEN], 1u);
            else XB_SPIN(xb_ld(&bar[XB_TOPGEN]) == tg, bar);
            __builtin_amdgcn_fence(__ATOMIC_ACQUIRE, "agent");
            xb_add(&bar[XB_XGEN(b.x)], 1u);
            asm volatile("s_waitcnt vmcnt(0)" ::: "memory");
        } else {
            XB_SPIN(xb_ld(&bar[XB_XGEN(b.x)]) == gen, bar);
            __builtin_amdgcn_fence(__ATOMIC_ACQUIRE, "agent");
            asm volatile("s_waitcnt vmcnt(0)" ::: "memory");
        }
    }
    __syncthreads();
}

DEVI void transpose_item(const float* __restrict__ W, int ldw, int c0, bf16_t* WT, int ldk, int r0, int Kmax, int kb, int nb, const float* kscale, float* scr, int lane, int fragKS = 0) {
    const int k0 = 64 * kb, n0 = 32 * nb;
#pragma unroll 8
    for (int i = 0; i < 32; ++i) {
        const int kk = 2 * i + (lane >> 5);
        float v = 0.f;
        if (k0 + kk < Kmax) { v = W[(size_t)(k0 + kk) * ldw + c0 + n0 + (lane & 31)]; if (kscale) v *= kscale[k0 + kk]; }
        scr[kk * 33 + (lane & 31)] = v;
    }
    asm volatile("s_waitcnt lgkmcnt(0)" ::: "memory");
    asm volatile("" ::: "memory");
    const int c = lane & 7;
    if (k0 + 8 * c < Kmax) {
#pragma unroll
        for (int j = 0; j < 4; ++j) {
            const int n = (lane >> 3) + 8 * j;
            const float* s = scr + (8 * c) * 33 + n;
            u32x4 o; o.x = pk2(s[0], s[33]); o.y = pk2(s[66], s[99]); o.z = pk2(s[132], s[165]); o.w = pk2(s[198], s[231]);
            if (fragKS > 0) { const int row = r0 + n0 + n, k = k0 + 8 * c, hd = row >> 6, rr = row & 63;
                *(u32x4*)(WT + ((size_t)(((hd * fragKS + (k >> 5)) * 4 + ((rr >> 2) & 3)) * 64 + ((k >> 3) & 3) * 16 + 4 * (rr >> 4) + (rr & 3))) * 8) = o; }
            else *(u32x4*)(WT + (size_t)(r0 + n0 + n) * ldk + k0 + 8 * c) = o;
        }
    }
    asm volatile("s_waitcnt lgkmcnt(0)" ::: "memory");
    asm volatile("" ::: "memory");
}


DEVI void wcomb_item(const float* __restrict__ Wq, const float* __restrict__ Sk, const float* __restrict__ n2w, bf16_t* WcT, int it, int lane) {
    const int fr = lane & 15, fq = lane >> 4;
    const int hp = it >> 6, nt = (it >> 4) & 3, kt = it & 15;
    const float* ap = Sk + ((size_t)hp * 128 + nt * 32 + fr) * 128 + fq * 8;
    const float* bp = Wq + (size_t)(kt * 64 + fr) * 2048 + hp * 128 + fq * 8;
    f32x4 acc[2][4];
#pragma unroll
    for (int m = 0; m < 2; ++m)
#pragma unroll
        for (int n = 0; n < 4; ++n) acc[m][n] = (f32x4){0.f, 0.f, 0.f, 0.f};
#pragma unroll
    for (int k0 = 0; k0 < 128; k0 += 32) {
        bf16x8 a[2], b[4];
#pragma unroll
        for (int m = 0; m < 2; ++m) { const f32x4 lo = *(const f32x4*)(ap + (size_t)m * 16 * 128 + k0), hi = *(const f32x4*)(ap + (size_t)m * 16 * 128 + k0 + 4);
            u32x4 w; w.x = pk2(lo.x, lo.y); w.y = pk2(lo.z, lo.w); w.z = pk2(hi.x, hi.y); w.w = pk2(hi.z, hi.w); a[m] = __builtin_bit_cast(bf16x8, w); }
#pragma unroll
        for (int n = 0; n < 4; ++n) { const f32x4 lo = *(const f32x4*)(bp + (size_t)n * 16 * 2048 + k0), hi = *(const f32x4*)(bp + (size_t)n * 16 * 2048 + k0 + 4);
            u32x4 w; w.x = pk2(lo.x, lo.y); w.y = pk2(lo.z, lo.w); w.z = pk2(hi.x, hi.y); w.w = pk2(hi.z, hi.w); b[n] = __builtin_bit_cast(bf16x8, w); }
#pragma unroll
        for (int m = 0; m < 2; ++m)
#pragma unroll
            for (int n = 0; n < 4; ++n) acc[m][n] = mfma16(b[n], a[m], acc[m][n]);
    }
#pragma unroll
    for (int n = 0; n < 4; ++n) {
        const int col = kt * 64 + 16 * n + 4 * fq; const f32x4 w = *(const f32x4*)(n2w + col);
#pragma unroll
        for (int m = 0; m < 2; ++m) { const int row = hp * 128 + nt * 32 + 16 * m + fr; st_bf4(WcT + (size_t)row * 1024 + col, acc[m][n][0] * w.x, acc[m][n][1] * w.y, acc[m][n][2] * w.z, acc[m][n][3] * w.w); }
    }
}

DEVI int peer_pair(int s) {
    if (s < 16) return s;
    if (s < 24) return 16 + (s - 16);
    if (s < 29) return 32 + (s - 24);
    if (s < 33) return 48 + (s - 29);
    if (s < 36) return 64 + (s - 33);
    if (s < 42) return 80 + 16 * ((s - 36) >> 1) + ((s - 36) & 1);
    if (s < 50) return 128 + 16 * (s - 42);
    return -1;
}

#define KARG __attribute__((address_space(4)))
DEVI const KARG Params* kargs() { unsigned long long k = (unsigned long long)__builtin_amdgcn_kernarg_segment_ptr(); asm volatile("" : "+s"(k)); return (const KARG Params*)k; }
#define PHASE_PTRS \
    int tid_l_ = threadIdx.x; asm volatile("" : "+v"(tid_l_)); \
    [[maybe_unused]] const int tid = tid_l_, lane = tid & 63, wave = __builtin_amdgcn_readfirstlane(tid >> 6), gw = blockIdx.x * NWAVES + wave, fr = lane & 15, fq = lane >> 4; \
    const KARG Params* kp = kargs(); unsigned char* ws = kp->ws; unsigned char* dob = (unsigned char*)kp->out; (void)ws; (void)dob; \
    [[maybe_unused]] const float* x = kp->in[0]; [[maybe_unused]] const int* positions = (const int*)kp->in[1]; [[maybe_unused]] const float* norm1_w = kp->in[2]; [[maybe_unused]] const float* w_in = kp->in[3]; \
    [[maybe_unused]] const float* rw_mu = kp->in[4]; [[maybe_unused]] const float* rw_w0 = kp->in[5]; [[maybe_unused]] const float* rw_a0 = kp->in[7]; [[maybe_unused]] const float* rw_k_k = kp->in[10]; \
    [[maybe_unused]] const float* rw_k_a = kp->in[11]; [[maybe_unused]] const float* rw_r_k = kp->in[12]; [[maybe_unused]] const float* rw_ln_w = kp->in[13]; [[maybe_unused]] const float* rw_ln_b = kp->in[14]; \
    [[maybe_unused]] const float* q_norm_w = kp->in[16]; [[maybe_unused]] const float* kv_norm_w = kp->in[18]; [[maybe_unused]] const float* qn_nope_w = kp->in[20]; [[maybe_unused]] const float* qn_pe_w = kp->in[21]; \
    [[maybe_unused]] const float* kn_nope_w = kp->in[22]; [[maybe_unused]] const float* kn_pe_w = kp->in[23]; [[maybe_unused]] const float* norm2_w = kp->in[26]; \
    [[maybe_unused]] float* ss2 = (float*)(ws + WS_SS2); [[maybe_unused]] unsigned* cnt = (unsigned*)(ws + WS_CNT); [[maybe_unused]] unsigned* xbar_words = (unsigned*)(ws + WS_CNT + 4096); \
    [[maybe_unused]] bf16_t* WinT = (bf16_t*)(ws + WS_WIN); [[maybe_unused]] bf16_t* WuqT = (bf16_t*)(ws + WS_WUQ); [[maybe_unused]] bf16_t* WukvT = (bf16_t*)(ws + WS_WUKV); [[maybe_unused]] bf16_t* RwoT = (bf16_t*)(ws + WS_RWO); \
    [[maybe_unused]] bf16_t* MwoT = (bf16_t*)(ws + WS_MWO); [[maybe_unused]] bf16_t* WoutT = (bf16_t*)(ws + WS_WOUT); [[maybe_unused]] bf16_t* PwqT = (bf16_t*)(ws + WS_PWQ); [[maybe_unused]] bf16_t* SubK = (bf16_t*)(ws + WS_SUBK); \
    [[maybe_unused]] bf16_t* W2T = (bf16_t*)(ws + WS_W2T); [[maybe_unused]] bf16_t* A2T = (bf16_t*)(ws + WS_A2T); [[maybe_unused]] bf16_t* G2T = (bf16_t*)(ws + WS_G2T); [[maybe_unused]] const unsigned char* Gg = ws + WS_G; \
    [[maybe_unused]] bf16_t* Prw = (bf16_t*)(ws + WS_PRW); [[maybe_unused]] bf16_t* QD = (bf16_t*)(ws + WS_QD); [[maybe_unused]] bf16_t* KVD = (bf16_t*)(ws + WS_KVD); [[maybe_unused]] bf16_t* KPE = (bf16_t*)(ws + WS_KPE); \
    [[maybe_unused]] float* ssq = (float*)(ws + WS_SSQ); [[maybe_unused]] float* sskv = (float*)(ws + WS_SSKV); [[maybe_unused]] bf16_t* XN = (bf16_t*)(dob + DO_XN); \
    [[maybe_unused]] bf16_t* Rb = (bf16_t*)(ws + WS_R); [[maybe_unused]] bf16_t* Wb = (bf16_t*)(ws + WS_W); [[maybe_unused]] bf16_t* Kb = (bf16_t*)(ws + WS_KS); [[maybe_unused]] bf16_t* Vb = (bf16_t*)(ws + WS_V); [[maybe_unused]] bf16_t* KKb = (bf16_t*)(ws + WS_KK); \
    [[maybe_unused]] bf16_t* Bvb = (bf16_t*)(dob + DO_BV); [[maybe_unused]] bf16_t* Gtb = (bf16_t*)(dob + DO_GT); [[maybe_unused]] float* bonus = (float*)(dob + DO_BONUS); [[maybe_unused]] bf16_t* Yb = (bf16_t*)(dob + DO_Y); \
    [[maybe_unused]] bf16_t* Qb = (bf16_t*)(ws + WS_Q); [[maybe_unused]] bf16_t* Kab = (bf16_t*)(ws + WS_K); [[maybe_unused]] bf16_t* Vt = (bf16_t*)(ws + WS_VT); [[maybe_unused]] bf16_t* Kraw = (bf16_t*)(dob + DO_KRAW); \
    [[maybe_unused]] bf16_t* Ob = (bf16_t*)(ws + WS_O); [[maybe_unused]] bf16_t* YA = (bf16_t*)(ws + WS_YA); [[maybe_unused]] bf16_t* MIXED = (bf16_t*)(ws + WS_MIXED); [[maybe_unused]] bf16_t* HB = (bf16_t*)(ws + WS_HB); \
    [[maybe_unused]] bf16_t* UB = (bf16_t*)(ws + WS_UB); [[maybe_unused]] bf16_t* VBp = (bf16_t*)(ws + WS_VB); [[maybe_unused]] bf16_t* PQ = (bf16_t*)(ws + WS_PQ); [[maybe_unused]] bf16_t* SC = (bf16_t*)(ws + WS_SC);

__global__ void __launch_bounds__(NT, 2) mega(Params p) {
    extern __shared__ __attribute__((aligned(16))) unsigned char lds[];
    cg::grid_group grid = cg::this_grid();
    const int G = gridDim.x, NGW = G * NWAVES;
    volatile LAS unsigned* bst = (volatile LAS unsigned*)((LAS unsigned char*)lds + LDS_BYTES - 16);
    if (threadIdx.x < 2) bst[threadIdx.x] = 0u;
    if (threadIdx.x >= 8 && threadIdx.x < 16) ((volatile LAS unsigned*)((LAS unsigned char*)lds + LDS_BYTES - 64))[threadIdx.x - 8] = 0u;
    if (threadIdx.x >= 16 && threadIdx.x < 32) ((volatile LAS unsigned*)((LAS unsigned char*)lds + LDS_BYTES - 128))[threadIdx.x - 16] = 0u;
    __syncthreads();
    if (kargs()->ws == nullptr) grid.sync();
    const XcdBarrier xb = xcd_barrier_post((unsigned*)(kargs()->ws + WS_CNT + 4096), bst);

    {
        PHASE_PTRS
        for (int i = blockIdx.x * NT + tid; i < T; i += G * NT) ss2[i] = 0.f;
        for (int t = gw; t < T; t += NGW) {
            const f32x4* xr = (const f32x4*)(x + (size_t)t * DM) + lane;
            f32x4 v[4]; float s = 0.f;
#pragma unroll
            for (int j = 0; j < 4; ++j) { v[j] = xr[64 * j]; s += v[j].x * v[j].x + v[j].y * v[j].y + v[j].z * v[j].z + v[j].w * v[j].w; }
            const float rstd = rsqrtf(wave_sum(s) * (1.f / DM) + EPS);
            const f32x4* wr = (const f32x4*)norm1_w + lane;
#pragma unroll
            for (int j = 0; j < 4; ++j) { const f32x4 w = wr[64 * j]; st_bf4(XN + (size_t)t * DM + (lane + 64 * j) * 4, v[j].x * rstd * w.x, v[j].y * rstd * w.y, v[j].z * rstd * w.z, v[j].w * rstd * w.w); }
        }
        float* scr = (float*)lds + wave * (64 * 33);
        int it = gw;
#define TR_SEG(W_, ldw_, c0_, WT_, ldk_, r0_, Kmax_, nkb_, nnb_, ksc_) \
        { const int cntI = (nkb_) * (nnb_); for (; it < cntI; it += NGW) transpose_item(W_, ldw_, c0_, WT_, ldk_, r0_, Kmax_, it / (nnb_), it % (nnb_), ksc_, scr, lane); it -= cntI; }
        TR_SEG(w_in, 4544, 0, WinT, 1024, 0, 1024, 16, 57, nullptr)
        TR_SEG(w_in, 4544, 1824, WinT, 1024, 2048, 1024, 16, 21, nullptr)
        TR_SEG(w_in, 4544, 2496, WinT, 1024, 2816, 1024, 16, 64, nullptr)
#define TR_SEGF(W_, ldw_, WT_, Kmax_, nkb_, nnb_, fks_) \
        { const int cntI = (nkb_) * (nnb_); for (; it < cntI; it += NGW) transpose_item(W_, ldw_, 0, WT_, 0, 0, Kmax_, it / (nnb_), it % (nnb_), nullptr, scr, lane, fks_); it -= cntI; }
        TR_SEGF(kp->in[6], 512, W2T, 64, 1, 16, 2)
        TR_SEGF(kp->in[8], 512, A2T, 64, 1, 16, 2)
        TR_SEGF(kp->in[9], 512, G2T, 160, 3, 16, 5)
#undef TR_SEGF
#pragma unroll 1
        for (int hh = 0; hh < 8; ++hh) {
            TR_SEG(kp->in[17], 768, hh * 96, WuqT, 384, hh * 64, 384, 6, 2, q_norm_w)
            TR_SEG(kp->in[17], 768, hh * 96 + 64, WuqT, 384, 512 + hh * 32, 384, 6, 1, q_norm_w)
            TR_SEG(kp->in[19], 1024, hh * 128, WukvT, 256, hh * 64, 256, 4, 2, kv_norm_w)
            TR_SEG(kp->in[19], 1024, hh * 128 + 64, WukvT, 256, 512 + hh * 64, 256, 4, 2, kv_norm_w)
        }
        TR_SEG(kp->in[15], 1024, 0, RwoT, 512, 0, 512, 8, 32, nullptr)
        TR_SEG(kp->in[24], 1024, 0, MwoT, 512, 0, 512, 8, 32, nullptr)
        TR_SEG(kp->in[25], 1024, 0, WoutT, 1024, 0, 1024, 16, 32, nullptr)
#undef TR_SEG
        for (; it < 1024; it += NGW) wcomb_item(kp->in[27], kp->in[28], norm2_w, PwqT, it, lane);
        for (int i = blockIdx.x * NT + tid; i < (224 + 96) * 128; i += G * NT) {
            const int r = i >> 7, c = i & 127; const int row = r < 224 ? 1824 + r : 2720 + (r - 224);
            *(u32x4*)(WinT + (size_t)row * 1024 + c * 8) = (u32x4){0u, 0u, 0u, 0u};
        }
    }
    xcd_barrier(xb);

    {
        PHASE_PTRS
        pg8::Gemm g{XN, WinT, T, 4864, DM}; pg8::StaticOrder S; S.init(T, 4864, G, (int)blockIdx.x);
        pg8::EpiP1 E{ws};
        pg8::gemm_phase<pg8::EpiP1, pg8::StaticOrder, true, true>((PG8_LAS unsigned char*)lds, g, S, E);
    }
    xcd_barrier(xb);


    {
        PHASE_PTRS
        for (int t = gw; t < T; t += NGW) {
            float a6[8]; ld_bf8(QD + (size_t)t * 384 + 8 * (lane & 47), a6); float s = 0.f;
#pragma unroll
            for (int i = 0; i < 8; ++i) s += a6[i] * a6[i];
            if (lane >= 48) s = 0.f;
            float b4[4]; ld_bf4(KVD + (size_t)t * 256 + 4 * lane, b4); const float s2 = (b4[0] * b4[0] + b4[1] * b4[1]) + (b4[2] * b4[2] + b4[3] * b4[3]);
            const float sq = wave_sum(s), skv = wave_sum(s2);
            if (lane == 0) { ssq[t] = rsqrtf(sq * (1.f / 384.f) + EPS); sskv[t] = rsqrtf(skv * (1.f / 256.f) + EPS); }
        }
    }
    {
        PHASE_PTRS
        LAS bf16_t* MIX = (LAS bf16_t*)lds; LAS bf16_t* LOR = (LAS bf16_t*)((LAS unsigned char*)lds + 49152);
        for (int tt = blockIdx.x; tt < T / 16; tt += G) {
            int h = wave; asm volatile("" : "+s"(h));
            __syncthreads();
            {
                u32x4 pw[8], ppw[8];
#pragma unroll
                for (int u = 0; u < 8; ++u) {
                    const int ci = tid + u * NT < 16 * 228 ? tid + u * NT : 16 * 228 - 1; const int row = ci / 228, cc = (ci - row * 228) * 8; const int tk = tt * 16 + row;
                    pw[u] = *(const u32x4*)(Prw + (size_t)tk * 2048 + cc);
                    ppw[u] = *(const u32x4*)(Prw + (size_t)((tk & (SEQ - 1)) != 0 ? tk - 1 : tk) * 2048 + cc);
                }
                __builtin_amdgcn_sched_barrier(0);
#pragma unroll
                for (int u = 0; u < 8; ++u) {
                    const int ci = tid + u * NT; if (ci < 16 * 228) {
                        const int row = ci / 228, cc = (ci - row * 228) * 8; const bool hp_ = ((tt * 16 + row) & (SEQ - 1)) != 0;
                        const float pv[8] = {bflo(pw[u].x), bfhi(pw[u].x), bflo(pw[u].y), bfhi(pw[u].y), bflo(pw[u].z), bfhi(pw[u].z), bflo(pw[u].w), bfhi(pw[u].w)};
                        float ppv[8] = {bflo(ppw[u].x), bfhi(ppw[u].x), bflo(ppw[u].y), bfhi(ppw[u].y), bflo(ppw[u].z), bfhi(ppw[u].z), bflo(ppw[u].w), bfhi(ppw[u].w)};
                        if (!hp_) {
#pragma unroll
                            for (int j = 0; j < 8; ++j) ppv[j] = 0.f; }
                        const f32x4 mu0 = *(const f32x4*)(rw_mu + cc), mu1 = *(const f32x4*)(rw_mu + cc + 4); float xm[8];
#pragma unroll
                        for (int j = 0; j < 8; ++j) { const float mu = j < 4 ? mu0[j & 3] : mu1[j & 3]; const float v = pv[j] + mu * (ppv[j] - pv[j]);
                            xm[j] = cc < 1600 ? (cc < 1536 ? v : tanhf_(v)) : (cc < 1664 ? v : sigmoidf_(v)); }
                        if (cc < 1536) *(LAS bf16x8*)(MIX + row * 1536 + cc) = pack8(xm); else *(LAS bf16x8*)(LOR + row * 288 + (cc - 1536)) = pack8(xm);
                    }
                }
            }
            __syncthreads();
            const int tok = tt * 16 + fr;
            f32x4 accw[4], acca[4], accg[4];
#pragma unroll
            for (int n = 0; n < 4; ++n) { accw[n] = (f32x4){0.f, 0.f, 0.f, 0.f}; acca[n] = accw[n]; accg[n] = accw[n]; }
#define LORA_STEP(lcol_, Wt_, KS_, ks_, accv_) { \
                const bf16x8 a = *(const LAS bf16x8*)(LOR + fr * 288 + (lcol_) + 8 * fq); \
                _Pragma("unroll") for (int n = 0; n < 4; ++n) { const bf16x8 b = *(const bf16x8*)((Wt_) + ((size_t)(((h * (KS_) + (ks_)) * 4 + n) * 64 + lane)) * 8); accv_[n] = mfma16(b, a, accv_[n]); } }
#pragma unroll
            for (int ks = 0; ks < 2; ++ks) LORA_STEP(32 * ks, W2T, 2, ks, accw)
#pragma unroll
            for (int ks = 0; ks < 2; ++ks) LORA_STEP(64 + 32 * ks, A2T, 2, ks, acca)
#pragma unroll
            for (int ks = 0; ks < 5; ++ks) LORA_STEP(128 + 32 * ks, G2T, 5, ks, accg)
#undef LORA_STEP
            float kkv[4][4], av[4][4]; float ssq = 0.f, bon = 0.f;
            u32x2 Rp[4], Wp[4], Kp[4], Vp[4], Gp[4];
#pragma unroll
            for (int n = 0; n < 4; ++n) {
                const int ch = 64 * h + 16 * fq + 4 * n;
                float r4[4], k4[4], v4[4];
#pragma unroll
                for (int seg = 0; seg < 3; ++seg) {
                    const u32x2 w = *(const LAS u32x2*)(MIX + fr * 1536 + seg * 512 + ch);
                    const float m4[4] = {bflo(w.x), bfhi(w.x), bflo(w.y), bfhi(w.y)};
#pragma unroll
                    for (int i = 0; i < 4; ++i) { if (seg == 0) r4[i] = m4[i]; else if (seg == 1) k4[i] = m4[i]; else v4[i] = m4[i]; }
                }
                const f32x4 w0 = *(const f32x4*)(rw_w0 + ch), a0 = *(const f32x4*)(rw_a0 + ch), kkw = *(const f32x4*)(rw_k_k + ch), kaw = *(const f32x4*)(rw_k_a + ch), rkw = *(const f32x4*)(rw_r_k + ch);
                float dd[4], kf[4];
#pragma unroll
                for (int i = 0; i < 4; ++i) {
                    const float z = -(w0[i] + accw[n][i]);
                    const float sp = z > 20.f ? z : __logf(1.f + __expf(z));
                    const float wlog = -sp - 0.5f;
                    dd[i] = -__expf(wlog);
                    const float a = sigmoidf_(a0[i] + acca[n][i]); av[n][i] = a;
                    kkv[n][i] = k4[i] * kkw[i]; ssq += kkv[n][i] * kkv[n][i];
                    kf[i] = k4[i] * (1.f + (a - 1.f) * kaw[i]);
                    bon += r4[i] * kf[i] * rkw[i];
                }
                Rp[n] = (u32x2){pk2(r4[0], r4[1]), pk2(r4[2], r4[3])}; Wp[n] = (u32x2){pk2(dd[0], dd[1]), pk2(dd[2], dd[3])}; Kp[n] = (u32x2){pk2(kf[0], kf[1]), pk2(kf[2], kf[3])};
                Vp[n] = (u32x2){pk2(v4[0], v4[1]), pk2(v4[2], v4[3])}; Gp[n] = (u32x2){pk2(accg[n][0], accg[n][1]), pk2(accg[n][2], accg[n][3])};
            }
            const size_t o = (size_t)tok * 512 + 64 * h + 16 * fq;
#define ST16(P_, X_) { *(u32x4*)((P_) + o) = (u32x4){X_[0].x, X_[0].y, X_[1].x, X_[1].y}; *(u32x4*)((P_) + o + 8) = (u32x4){X_[2].x, X_[2].y, X_[3].x, X_[3].y}; }
            ST16(Rb, Rp) ST16(Wb, Wp) ST16(Kb, Kp) ST16(Vb, Vp) ST16(Gtb, Gp)
            ssq += __shfl_xor(ssq, 16); ssq += __shfl_xor(ssq, 32);
            bon += __shfl_xor(bon, 16); bon += __shfl_xor(bon, 32);
            const float inv = 1.f / fmaxf(sqrtf(ssq), 1e-12f);
            u32x2 KKp[4], Bp[4];
#pragma unroll
            for (int n = 0; n < 4; ++n) {
                float kk[4], bb[4];
#pragma unroll
                for (int i = 0; i < 4; ++i) { kk[i] = kkv[n][i] * inv; bb[i] = kk[i] * av[n][i]; }
                KKp[n] = (u32x2){pk2(kk[0], kk[1]), pk2(kk[2], kk[3])}; Bp[n] = (u32x2){pk2(bb[0], bb[1]), pk2(bb[2], bb[3])};
            }
            ST16(KKb, KKp) ST16(Bvb, Bp)
#undef ST16
            if (fq == 0) bonus[(size_t)tok * 8 + h] = bon;
        }
    }
    xcd_barrier(xb);

    {
        PHASE_PTRS
        { int Kq = 384; asm volatile("" : "+s"(Kq));
          pg8::Gemm g{QD, WuqT, T, 768, Kq}; pg8::StaticOrder S; S.init(T, 768, G, (int)blockIdx.x); pg8::EpiQraw E{Qb, ssq};
          pg8::gemm_phase<pg8::EpiQraw, pg8::StaticOrder, true, true>((PG8_LAS unsigned char*)lds, g, S, E); }
        { int Kkv = 256; asm volatile("" : "+s"(Kkv));
          pg8::Gemm g{KVD, WukvT, T, 1024, Kkv}; pg8::StaticOrder S; S.init(T, 1024, G, (int)blockIdx.x); pg8::EpiKVraw E{Kraw, Vt, sskv};
          pg8::gemm_phase<pg8::EpiKVraw, pg8::StaticOrder, true, true>((PG8_LAS unsigned char*)lds, g, S, E); }
    }
    xcd_barrier(xb);
    {
        PHASE_PTRS
        for (int t = gw; t < T; t += NGW) {
            const int hh = lane >> 3, l8 = lane & 7;
            const float pos = (float)positions[t];
            float cs[4], sn[4];
#pragma unroll
            for (int i = 0; i < 4; ++i) { const float invf = exp2f(-(float)(4 * (l8 & 3) + i) * (13.287712379549449f / 16.f)); float rev = pos * invf * 0.15915494309189535f; rev -= rintf(rev);
                sn[i] = __builtin_amdgcn_sinf(rev); cs[i] = __builtin_amdgcn_cosf(rev); }
            bf16_t* qrow = Qb + (size_t)t * 768;
            float qn[8], qp[4]; ld_bf8(qrow + 8 * lane, qn); ld_bf4(qrow + 512 + 4 * lane, qp);
            float kn[8], kp4[4]; ld_bf8(Kraw + (size_t)t * 512 + 8 * lane, kn); ld_bf4(KPE + (size_t)t * 32 + 4 * l8, kp4);
            float s1 = 0.f, s2 = 0.f, s3 = 0.f, s4 = 0.f;
#pragma unroll
            for (int i = 0; i < 8; ++i) { s1 += qn[i] * qn[i]; s3 += kn[i] * kn[i]; }
#pragma unroll
            for (int i = 0; i < 4; ++i) { s2 += qp[i] * qp[i]; s4 += kp4[i] * kp4[i]; }
            s1 = sum8(s1); s2 = sum8(s2); s3 = sum8(s3); s4 = sum8(s4);
            const float r1 = rsqrtf(s1 * (1.f / 64.f) + EPS) * QSCALE, r2 = rsqrtf(s2 * (1.f / 32.f) + EPS), r3 = rsqrtf(s3 * (1.f / 64.f) + EPS), r4 = rsqrtf(s4 * (1.f / 32.f) + EPS);
            const f32x4 wq0 = *(const f32x4*)(qn_nope_w + 8 * l8), wq1 = *(const f32x4*)(qn_nope_w + 8 * l8 + 4), wk0 = *(const f32x4*)(kn_nope_w + 8 * l8), wk1 = *(const f32x4*)(kn_nope_w + 8 * l8 + 4);
            const f32x4 wqp = *(const f32x4*)(qn_pe_w + 4 * l8), wkp = *(const f32x4*)(kn_pe_w + 4 * l8);
            float oq[8], ok[8], oqp[4], okp[4];
#pragma unroll
            for (int i = 0; i < 8; ++i) { oq[i] = qn[i] * r1 * (i < 4 ? wq0[i & 3] : wq1[i & 3]); ok[i] = kn[i] * r3 * (i < 4 ? wk0[i & 3] : wk1[i & 3]); }
#pragma unroll
            for (int i = 0; i < 4; ++i) {
                const float xq = qp[i] * r2 * wqp[i], xk = kp4[i] * r4 * wkp[i];
                const float pq = dpp_f<0x141>(xq), pk_ = dpp_f<0x141>(xk);
                (void)pq; (void)pk_;
                oqp[i] = xq; okp[i] = xk;
            }
#pragma unroll
            for (int i = 0; i < 4; ++i) {
                const float pq = __shfl_xor(oqp[i], 4), pk_ = __shfl_xor(okp[i], 4);
                const float xq = oqp[i], xk = okp[i];
                oqp[i] = l8 < 4 ? (xq * cs[i] - pq * sn[i]) : (xq * cs[i] + pq * sn[i]);
                okp[i] = l8 < 4 ? (xk * cs[i] - pk_ * sn[i]) : (xk * cs[i] + pk_ * sn[i]);
                oqp[i] *= QSCALE;
            }
            bf16_t* qo = Qb + ((size_t)t * 8 + hh) * 96;
            *(bf16x8*)(qo + 8 * l8) = pack8(oq); st_bf4(qo + 64 + 4 * l8, oqp[0], oqp[1], oqp[2], oqp[3]);
            { const int bb = t >> 12, pos = t & 4095; bf16_t* kfb = Kab + (((size_t)(bb * 8 + hh) * 128 + (pos >> 5)) * 6) * 512 + (pos & 31) * 8;
              *(bf16x8*)(kfb + (l8 >> 1) * 512 + 256 * (l8 & 1)) = pack8(ok);
              st_bf4(kfb + (4 + (l8 >> 2)) * 512 + 256 * ((l8 >> 1) & 1) + 4 * (l8 & 1), okp[0], okp[1], okp[2], okp[3]); }
        }
    }
    xcd_barrier(xb);

    {
        PHASE_PTRS
        float* GL = (float*)(dob + DO_GL);
        const int fr_o = fr, fq_o = fq, lane_o = lane;
        if (wave < 3) {
            LAS unsigned char* wb = (LAS unsigned char*)lds + wave * 49152;
            LAS bf16_t* At = (LAS bf16_t*)(wb + 0);      LAS bf16_t* Btm = (LAS bf16_t*)(wb + 4096);  LAS bf16_t* Ktm = (LAS bf16_t*)(wb + 8192); LAS bf16_t* Rtm = (LAS bf16_t*)(wb + 12288);
            LAS bf16_t* AtT = (LAS bf16_t*)(wb + 16384); LAS bf16_t* BtT = (LAS bf16_t*)(wb + 20480); LAS bf16_t* KtT = (LAS bf16_t*)(wb + 24576); LAS bf16_t* VmT = (LAS bf16_t*)(wb + 28672);
            LAS bf16_t* Nm = (LAS bf16_t*)(wb + 32768);  LAS bf16_t* NmT = (LAS bf16_t*)(wb + 34816); LAS bf16_t* Tm = (LAS bf16_t*)(wb + 36864);  LAS bf16_t* TmT = (LAS bf16_t*)(wb + 38912);
            LAS bf16_t* MmT = (LAS bf16_t*)(wb + 40960); LAS bf16_t* NBT = (LAS bf16_t*)(wb + 43008); LAS bf16_t* MKT = (LAS bf16_t*)(wb + 45056); LAS float* gLs = (LAS float*)(wb + 47104);
            LAS bf16_t* W1 = At; LAS bf16_t* W1T = Btm; LAS bf16_t* ATm = Ktm;
#pragma unroll 1
            for (int it = blockIdx.x * 3 + wave; it < 4096; it += G * 3) {
                const int bh = it >> 7, c = it & 127, b = bh >> 3, h = bh & 7;
                int fr = fr_o, fq = fq_o, lane = lane_o; asm volatile("" : "+v"(fr), "+v"(fq), "+v"(lane));
                const int lpA = (4 * (fr >> 3) + (fr & 3)) + 32 * (fq & 1) + ((fq >> 1) + 4 * ((fr >> 2) & 1)) * 512;
                const int lpB = ((fr >> 1) + 16 * (fq & 1)) * 512 + 16 * (fr & 1) + 4 * (fq >> 1);
                const int lpC = 4 * (fq >> 1) + 16 * (fr & 3) + ((fr >> 2) + 8 * (fq & 1)) * 512;
                const size_t sbase = ((size_t)b * SEQ + c * 32) * 512 + h * 64;
                {
                    float cs = 0.f; unsigned aT[16], bT[16], kT[16], vT[16];
#pragma unroll
                    for (int t = 0; t < 32; ++t) {
                        const size_t o = sbase + (size_t)t * 512 + lane;
                        const float ldv = bf1(Wb[o]), rr = bf1(Rb[o]), kv = bf1(Kb[o]), qv = bf1(KKb[o]), bv = bf1(Bvb[o]); const unsigned vraw = Vb[o];
                        const float ep = __expf(cs); cs += ldv; const float ec = __expf(cs), en = __expf(-cs);
                        const unsigned a_ = bf1of(-qv * ep), b_ = bf1of(bv * en), k_ = bf1of(kv * en), r_ = bf1of(rr * ec);
                        At[SW64(t, lane)] = (bf16_t)a_; Btm[SW64(t, lane)] = (bf16_t)b_; Ktm[SW64(t, lane)] = (bf16_t)k_; Rtm[SW64(t, lane)] = (bf16_t)r_;
                        if (t & 1) { aT[t >> 1] |= a_ << 16; bT[t >> 1] |= b_ << 16; kT[t >> 1] |= k_ << 16; vT[t >> 1] |= vraw << 16; }
                        else { aT[t >> 1] = a_; bT[t >> 1] = b_; kT[t >> 1] = k_; vT[t >> 1] = vraw; }
                    }
#pragma unroll
                    for (int q = 0; q < 4; ++q) {
                        *(LAS u32x4*)(AtT + lane * 32 + ((q ^ ((lane >> 2) & 3)) << 3)) = (u32x4){aT[4 * q], aT[4 * q + 1], aT[4 * q + 2], aT[4 * q + 3]};
                        *(LAS u32x4*)(BtT + lane * 32 + ((q ^ ((lane >> 2) & 3)) << 3)) = (u32x4){bT[4 * q], bT[4 * q + 1], bT[4 * q + 2], bT[4 * q + 3]};
                        *(LAS u32x4*)(KtT + lane * 32 + ((q ^ ((lane >> 2) & 3)) << 3)) = (u32x4){kT[4 * q], kT[4 * q + 1], kT[4 * q + 2], kT[4 * q + 3]};
                        *(LAS u32x4*)(VmT + lane * 32 + ((q ^ ((lane >> 2) & 3)) << 3)) = (u32x4){vT[4 * q], vT[4 * q + 1], vT[4 * q + 2], vT[4 * q + 3]};
                    }
                    const float gl = __expf(cs); gLs[lane] = gl;
                    { const int k5 = lane & 31; GL[(size_t)it * 64 + (lane >> 5) * 32 + ((k5 >> 2) & 1) * 16 + (k5 & 3) + 4 * (k5 >> 3)] = gl; }
                }
                {
                    f32x4 acc[2][2];
#define ZACC(MT_, NT_) _Pragma("unroll") for (int m = 0; m < MT_; ++m) _Pragma("unroll") for (int n = 0; n < NT_; ++n) acc[m][n] = (f32x4){0.f, 0.f, 0.f, 0.f};
                    ZACC(2, 2) gemm_lds<2, 2, 2>(Btm, 64, At, 64, acc, fr, fq);
#pragma unroll
                    for (int m = 0; m < 2; ++m)
#pragma unroll
                        for (int n = 0; n < 2; ++n)
#pragma unroll
                            for (int j = 0; j < 4; ++j) { const int i = 16 * m + fr, tt = 16 * n + 4 * fq + j; const float v = i < tt ? acc[m][n][j] : 0.f; const bf16_t w = bf1of(v), w1 = bf1of(v + (i == tt ? 1.f : 0.f));
                                Nm[SW32(i, tt)] = w; NmT[SW32(tt, i)] = w; Tm[SW32(i, tt)] = w1; TmT[SW32(tt, i)] = w1; }
                    ZACC(2, 2) gemm_lds<2, 2, 2>(Ktm, 64, At, 64, acc, fr, fq);
#pragma unroll
                    for (int m = 0; m < 2; ++m)
#pragma unroll
                        for (int n = 0; n < 2; ++n)
#pragma unroll
                            for (int j = 0; j < 4; ++j) { const int i = 16 * m + fr, tt = 16 * n + 4 * fq + j; MmT[SW32(tt, i)] = bf1of(i < tt ? acc[m][n][j] : 0.f); }
                    ZACC(2, 2) gemm_lds<2, 2, 2>(Btm, 64, Rtm, 64, acc, fr, fq);
#pragma unroll
                    for (int m = 0; m < 2; ++m)
#pragma unroll
                        for (int n = 0; n < 2; ++n)
#pragma unroll
                            for (int j = 0; j < 4; ++j) { const int i = 16 * m + fr, tt = 16 * n + 4 * fq + j; NBT[SW32(tt, i)] = bf1of(i <= tt ? acc[m][n][j] : 0.f); }
                    ZACC(2, 2) gemm_lds<2, 2, 2>(Ktm, 64, Rtm, 64, acc, fr, fq);
#pragma unroll
                    for (int m = 0; m < 2; ++m)
#pragma unroll
                        for (int n = 0; n < 2; ++n)
#pragma unroll
                            for (int j = 0; j < 4; ++j) { const int i = 16 * m + fr, tt = 16 * n + 4 * fq + j; MKT[SW32(tt, i)] = bf1of(i <= tt ? acc[m][n][j] : 0.f); }
#pragma unroll 1
                    for (int rd = 0; rd < 4; ++rd) {
                        ZACC(2, 2) gemm_lds<2, 2, 1>(Nm, 32, NmT, 32, acc, fr, fq);
#pragma unroll
                        for (int m = 0; m < 2; ++m)
#pragma unroll
                            for (int n = 0; n < 2; ++n)
#pragma unroll
                                for (int j = 0; j < 4; ++j) { const int i = 16 * m + fr, tt = 16 * n + 4 * fq + j; const bf16_t w = bf1of(acc[m][n][j]); Nm[SW32(i, tt)] = w; NmT[SW32(tt, i)] = w; }
                        ZACC(2, 2) gemm_lds<2, 2, 1>(Tm, 32, NmT, 32, acc, fr, fq);
#pragma unroll
                        for (int m = 0; m < 2; ++m)
#pragma unroll
                            for (int n = 0; n < 2; ++n)
#pragma unroll
                                for (int j = 0; j < 4; ++j) { const int i = 16 * m + fr, tt = 16 * n + 4 * fq + j; const bf16_t w = bf1of(acc[m][n][j] + bf1(Tm[SW32(i, tt)])); Tm[SW32(i, tt)] = w; TmT[SW32(tt, i)] = w; }
                    }
                }
                asm volatile("" : "+v"(fr), "+v"(fq));
                {
                    f32x4 acc[4][2];
                    ZACC(4, 2) gemm_lds<4, 2, 1>(AtT, 32, TmT, 32, acc, fr, fq);
#pragma unroll
                    for (int m = 0; m < 4; ++m)
#pragma unroll
                        for (int n = 0; n < 2; ++n)
#pragma unroll
                            for (int j = 0; j < 4; ++j) ATm[SW32(16 * m + fr, 16 * n + 4 * fq + j)] = bf1of(acc[m][n][j]);
                    ZACC(4, 2) gemm_lds<4, 2, 1>(VmT, 32, MmT, 32, acc, fr, fq);
#pragma unroll
                    for (int m = 0; m < 4; ++m)
#pragma unroll
                        for (int n = 0; n < 2; ++n)
#pragma unroll
                            for (int j = 0; j < 4; ++j) W1[SW32(16 * m + fr, 16 * n + 4 * fq + j)] = bf1of(acc[m][n][j]);
                    ZACC(4, 2) gemm_lds<4, 2, 1>(W1, 32, TmT, 32, acc, fr, fq);
#pragma unroll
                    for (int m = 0; m < 4; ++m)
#pragma unroll
                        for (int n = 0; n < 2; ++n)
#pragma unroll
                            for (int j = 0; j < 4; ++j) W1T[SW32(16 * m + fr, 16 * n + 4 * fq + j)] = bf1of(acc[m][n][j]);
                    ZACC(4, 2) gemm_lds<4, 2, 1>(ATm, 32, NBT, 32, acc, fr, fq);
#pragma unroll
                    for (int m = 0; m < 4; ++m)
#pragma unroll
                        for (int n = 0; n < 2; ++n)
#pragma unroll
                            for (int j = 0; j < 4; ++j) { const int k = 16 * m + fr, tp = 16 * n + 4 * fq + j; const float v = acc[m][n][j] + bf1(Rtm[SW64(tp, k)]);
                                Rb[sbase + lpA + (size_t)(j * 8 + (2 * n + 8 * m) * 512)] = bf1of(v); }
                    ZACC(4, 2) gemm_lds<4, 2, 1>(W1T, 32, NBT, 32, acc, fr, fq); gemm_lds<4, 2, 1>(VmT, 32, MKT, 32, acc, fr, fq);
#pragma unroll
                    for (int m = 0; m < 4; ++m)
#pragma unroll
                        for (int n = 0; n < 2; ++n)
#pragma unroll
                            for (int j = 0; j < 4; ++j) Yb[sbase + lpB + (size_t)((8 * (m & 1)) * 512 + 32 * (m >> 1) + j + 8 * n)] = bf1of(acc[m][n][j]);
                }
                asm volatile("" : "+v"(fr), "+v"(fq));
                {
                    f32x4 acc[4][4];
                    ZACC(4, 4) gemm_lds<4, 4, 1>(ATm, 32, BtT, 32, acc, fr, fq);
#pragma unroll
                    for (int m = 0; m < 4; ++m)
#pragma unroll
                        for (int n = 0; n < 4; ++n)
#pragma unroll
                            for (int j = 0; j < 4; ++j) { const float v = acc[m][n][j] * gLs[16 * n + 4 * fq + j];
                                (n < 2 ? Wb : Kb)[sbase + lpA + (size_t)(j * 8 + (2 * (n & 1) + 8 * m) * 512)] = bf1of(v); }
                    ZACC(4, 4) gemm_lds<4, 4, 1>(W1T, 32, BtT, 32, acc, fr, fq); gemm_lds<4, 4, 1>(VmT, 32, KtT, 32, acc, fr, fq);
#pragma unroll
                    for (int m = 0; m < 4; ++m)
#pragma unroll
                        for (int n = 0; n < 4; ++n)
#pragma unroll
                            for (int j = 0; j < 4; ++j) { const float v = acc[m][n][j] * gLs[16 * n + 4 * fq + j];
                                (m < 2 ? KKb : Bvb)[sbase + lpC + (size_t)(j + 8 * (n & 1) + (4 * (m & 1) + 16 * (n >> 1)) * 512)] = bf1of(v); }
                }
#undef ZACC
            }
        }
    }
    xcd_barrier(xb);

    {
        PHASE_PTRS
        if (wave < 5 && blockIdx.x < 64) {
            const int item = blockIdx.x, bh = item >> 1, wv = item & 1, b = bh >> 3, h = bh & 7;
            const int hi = lane >> 5, vcol = lane & 31;
            float* GL = (float*)(dob + DO_GL);
            volatile LAS unsigned* ctr = (volatile LAS unsigned*)((LAS unsigned char*)lds + LDS_BYTES - 64);
#define SLICE(arr, sb, li) ((arr) + (sb) + (size_t)((li) >> 6) * 512 + ((li) & 63))
#define DMA16(src_, dst_) __builtin_amdgcn_global_load_lds((const unsigned*)(src_), (LAS unsigned*)(dst_), 16, 0, 0)
            if (wave >= 1 && wave <= 3) {
                __builtin_amdgcn_s_setprio(2);
#pragma unroll 1
                for (int c = 0; c < 128; ++c) {
                    if (c >= 4) { while ((int)ctr[3] < c - 3) __builtin_amdgcn_s_sleep(1); }
                    asm volatile("" ::: "memory");
                    const size_t sb = ((size_t)b * SEQ + c * 32) * 512 + h * 64; LAS unsigned char* lb = (LAS unsigned char*)lds + (c & 3) * 19712;
                    if (wave == 1) {
#pragma unroll
                        for (int q = 0; q < 4; ++q) DMA16(SLICE(Wb, sb, (q * 64 + lane) * 8), lb + q * 1024);
#pragma unroll
                        for (int q = 0; q < 2; ++q) DMA16(SLICE(Kb, sb, (q * 64 + lane) * 8), lb + 4096 + q * 1024);
                        asm volatile("s_waitcnt vmcnt(12)" ::: "memory");
                    } else if (wave == 2) {
#pragma unroll
                        for (int q = 2; q < 4; ++q) DMA16(SLICE(Kb, sb, (q * 64 + lane) * 8), lb + 4096 + q * 1024);
#pragma unroll
                        for (int q = 0; q < 4; ++q) DMA16(SLICE(Rb, sb, (q * 64 + lane) * 8), lb + 8192 + q * 1024);
                        asm volatile("s_waitcnt vmcnt(12)" ::: "memory");
                    } else {
#pragma unroll
                        for (int kb = 0; kb < 2; ++kb)
#pragma unroll
                            for (int hf = 0; hf < 2; ++hf) DMA16(SLICE(wv ? Bvb : KKb, sb, (kb * 64 + lane) * 16 + 8 * hf), lb + 12288 + kb * 2048 + hf * 1024);
#pragma unroll
                        for (int hf = 0; hf < 2; ++hf) DMA16(Yb + sb + (size_t)(lane >> 1) * 512 + 32 * wv + 16 * (lane & 1) + 8 * hf, lb + 16384 + hf * 1024);
                        __builtin_amdgcn_global_load_lds((const unsigned*)(GL + ((size_t)(bh * 128 + c)) * 64 + lane), (LAS unsigned*)(lb + 18432), 4, 0, 0);
                        asm volatile("s_waitcnt vmcnt(14)" ::: "memory");
                    }
                    if (c >= 2 && lane == 0) ctr[wave - 1] = (unsigned)(c - 1);
                }
                asm volatile("s_waitcnt vmcnt(0)" ::: "memory");
                if (lane == 0) ctr[wave - 1] = 128u;
                __builtin_amdgcn_s_setprio(0);
            } else if (wave == 4) {
#pragma unroll 1
                for (int c = 0; c < 128; ++c) {
                    while ((int)ctr[4] <= c) __builtin_amdgcn_s_sleep(2);
                    asm volatile("" ::: "memory");
                    const LAS u32x4* ys = (const LAS u32x4*)((LAS unsigned char*)lds + 81920 + (c & 7) * 2048 + lane * 32);
                    const u32x4 ya = ys[0], yb = ys[1];
                    u32x4* yo = (u32x4*)(Yb + ((size_t)b * SEQ + c * 32 + (lane >> 1)) * 512 + h * 64 + 32 * wv + 16 * (lane & 1));
                    yo[0] = ya; yo[1] = yb;
                    asm volatile("s_waitcnt lgkmcnt(0)" ::: "memory");
                    if (lane == 0) ctr[5] = (unsigned)(c + 1);
                }
            } else {
                __builtin_amdgcn_s_setprio(3);
                f32x16 S0t, S1t;
#pragma unroll
                for (int r = 0; r < 16; ++r) { S0t[r] = 0.f; S1t[r] = 0.f; }
#pragma unroll 1
                for (int c = 0; c < 128; ++c) {
                    while ((int)ctr[0] <= c || (int)ctr[1] <= c || (int)ctr[2] <= c) __builtin_amdgcn_s_sleep(1);
                    asm volatile("" ::: "memory");
                    const LAS unsigned char* lb = (const LAS unsigned char*)lds + (c & 3) * 19712;
                    bf16x8 sf[4];
#pragma unroll
                    for (int s = 0; s < 4; ++s) { float t8[8];
#pragma unroll
                        for (int j = 0; j < 8; ++j) t8[j] = (s < 2 ? S0t : S1t)[8 * (s & 1) + j];
                        sf[s] = pack8(t8); }
                    f32x16 yt;
                    { const u32x4 c0 = *(const LAS u32x4*)(lb + 16384 + lane * 16), c1 = *(const LAS u32x4*)(lb + 16384 + 1024 + lane * 16);
                      yt[0] = bflo(c0.x); yt[1] = bfhi(c0.x); yt[2] = bflo(c0.y); yt[3] = bfhi(c0.y); yt[4] = bflo(c0.z); yt[5] = bfhi(c0.z); yt[6] = bflo(c0.w); yt[7] = bfhi(c0.w);
                      yt[8] = bflo(c1.x); yt[9] = bfhi(c1.x); yt[10] = bflo(c1.y); yt[11] = bfhi(c1.y); yt[12] = bflo(c1.z); yt[13] = bfhi(c1.z); yt[14] = bflo(c1.w); yt[15] = bfhi(c1.w); }
                    f32x16 n0, n1;
#pragma unroll
                    for (int kb = 0; kb < 2; ++kb) {
                        const u32x4 c0 = *(const LAS u32x4*)(lb + 12288 + kb * 2048 + lane * 16), c1 = *(const LAS u32x4*)(lb + 12288 + kb * 2048 + 1024 + lane * 16);
                        const LAS float* gp = (const LAS float*)(lb + 18432) + kb * 32 + hi * 16;
                        f32x16 nn; const f32x16 so = kb ? S1t : S0t;
                        nn[0] = bflo(c0.x); nn[1] = bfhi(c0.x); nn[2] = bflo(c0.y); nn[3] = bfhi(c0.y); nn[4] = bflo(c0.z); nn[5] = bfhi(c0.z); nn[6] = bflo(c0.w); nn[7] = bfhi(c0.w);
                        nn[8] = bflo(c1.x); nn[9] = bfhi(c1.x); nn[10] = bflo(c1.y); nn[11] = bfhi(c1.y); nn[12] = bflo(c1.z); nn[13] = bfhi(c1.z); nn[14] = bflo(c1.w); nn[15] = bfhi(c1.w);
#pragma unroll
                        for (int r = 0; r < 16; ++r) nn[r] += gp[r] * so[r];
                        if (kb) n1 = nn; else n0 = nn;
                    }
#pragma unroll
                    for (int s = 0; s < 4; ++s) {
                        const bf16x8 ra = *(const LAS bf16x8*)(lb + 8192 + s * 1024 + lane * 16);
                        const bf16x8 p0 = *(const LAS bf16x8*)(lb + s * 1024 + lane * 16), p1 = *(const LAS bf16x8*)(lb + 4096 + s * 1024 + lane * 16);
                        yt = mfma32(ra, sf[s], yt); n0 = mfma32(p0, sf[s], n0); n1 = mfma32(p1, sf[s], n1);
                    }
                    S0t = n0; S1t = n1;
                    asm volatile("s_waitcnt lgkmcnt(0)" ::: "memory");
                    if (lane == 0) ctr[3] = (unsigned)(c + 1);
                    if (c >= 8) { while ((int)ctr[5] < c - 7) __builtin_amdgcn_s_sleep(1); }
                    asm volatile("" ::: "memory");
                    { LAS bf16_t* ys = (LAS bf16_t*)((LAS unsigned char*)lds + 81920 + (c & 7) * 2048) + vcol;
#pragma unroll
                      for (int r = 0; r < 16; ++r) ys[crow(r, hi) * 32] = bf1of(yt[r]);
                      asm volatile("s_waitcnt lgkmcnt(0)" ::: "memory");
                      if (lane == 0) ctr[4] = (unsigned)(c + 1); }
                }
                __builtin_amdgcn_s_setprio(0);
            }
#undef DMA16
#undef SLICE
        }
        for (;;) {
            unsigned item = 0;
            const int xg = blockIdx.x & 7;
            if (lane == 0) item = atomicAdd(&cnt[xg], 1u);
            item = __builtin_amdgcn_readfirstlane(item);
            if (item >= 256u) break;
            const int qt = 63 - (int)(item >> 2), bh = 8 * (int)(item & 3) + xg, b = bh >> 3, h = bh & 7;
            const int qi = lane & 31, hi = lane >> 5;
            const size_t tokq = (size_t)b * SEQ + qt * 64 + qi;
            bf16x8 qfa[6], qfb[6];
#pragma unroll
            for (int s = 0; s < 6; ++s) { qfa[s] = *(const bf16x8*)(Qb + (tokq * 8 + h) * 96 + 16 * s + 8 * hi); qfb[s] = *(const bf16x8*)(Qb + ((tokq + 32) * 8 + h) * 96 + 16 * s + 8 * hi); }
            float ma = -1e30f, la = 0.f, mb = -1e30f, lb = 0.f;
            f32x16 oa0, oa1, ob0, ob1;
#pragma unroll
            for (int r = 0; r < 16; ++r) { oa0[r] = 0.f; oa1[r] = 0.f; ob0[r] = 0.f; ob1[r] = 0.f; }
            const bf16_t* kfb = Kab + ((size_t)(b * 8 + h) * 128) * 6 * 512 + lane * 8;
            const bf16_t* vfb = Vt + ((size_t)(b * 8 + h) * 128) * 4 * 512 + lane * 8;
            const int nt = 2 * qt + 2;
#define ATT_GROUP(QF, M_, L_, O0, O1, DIAG) { \
                f32x16 xs; _Pragma("unroll") for (int r = 0; r < 16; ++r) xs[r] = 0.f; \
                _Pragma("unroll") for (int s = 0; s < 6; ++s) xs = mfma32(kf[s], QF[s], xs); \
                if (DIAG) { _Pragma("unroll") for (int r = 0; r < 16; ++r) if (crow(r, hi) > qi) xs[r] = -1e30f; } \
                float mx = xs[0]; _Pragma("unroll") for (int r = 1; r < 16; ++r) mx = fmaxf(mx, xs[r]); \
                mx = fmaxf(mx, __shfl_xor(mx, 32)); \
                if (__any(mx > M_)) { const float mn = fmaxf(M_, mx), alpha = __builtin_amdgcn_exp2f(M_ - mn); L_ *= alpha; M_ = mn; \
                    _Pragma("unroll") for (int r = 0; r < 16; ++r) { O0[r] *= alpha; O1[r] *= alpha; } } \
                float ps = 0.f; _Pragma("unroll") for (int r = 0; r < 16; ++r) { xs[r] = __builtin_amdgcn_exp2f(xs[r] - M_); ps += xs[r]; } \
                L_ += ps; \
                _Pragma("unroll") for (int s = 0; s < 2; ++s) { float t8[8]; _Pragma("unroll") for (int j = 0; j < 8; ++j) t8[j] = xs[8 * s + j]; const bf16x8 pbs = pack8(t8); \
                    O0 = mfma32(vf[0][s], pbs, O0); O1 = mfma32(vf[1][s], pbs, O1); } }
#pragma unroll 1
            for (int kt = 0; kt < nt; ++kt) {
                bf16x8 kf[6], vf[2][2];
#pragma unroll
                for (int s = 0; s < 6; ++s) kf[s] = *(const bf16x8*)(kfb + (size_t)(kt * 6 + s) * 512);
#pragma unroll
                for (int d0 = 0; d0 < 2; ++d0)
#pragma unroll
                    for (int s = 0; s < 2; ++s) vf[d0][s] = *(const bf16x8*)(vfb + (size_t)((kt * 2 + d0) * 2 + s) * 512);
                if (kt < nt - 1) ATT_GROUP(qfa, ma, la, oa0, oa1, kt == nt - 2)
                ATT_GROUP(qfb, mb, lb, ob0, ob1, kt == nt - 1)
            }
#undef ATT_GROUP
            la += __shfl_xor(la, 32); lb += __shfl_xor(lb, 32);
            const float ila = 1.f / la, ilb = 1.f / lb;
            bf16_t* orow = Ob + tokq * 512 + h * 64;
#pragma unroll
            for (int g = 0; g < 4; ++g) {
                st_bf4(orow + 8 * g + 4 * hi, oa0[4 * g] * ila, oa0[4 * g + 1] * ila, oa0[4 * g + 2] * ila, oa0[4 * g + 3] * ila);
                st_bf4(orow + 32 + 8 * g + 4 * hi, oa1[4 * g] * ila, oa1[4 * g + 1] * ila, oa1[4 * g + 2] * ila, oa1[4 * g + 3] * ila);
                st_bf4(orow + (size_t)32 * 512 + 8 * g + 4 * hi, ob0[4 * g] * ilb, ob0[4 * g + 1] * ilb, ob0[4 * g + 2] * ilb, ob0[4 * g + 3] * ilb);
                st_bf4(orow + (size_t)32 * 512 + 32 + 8 * g + 4 * hi, ob1[4 * g] * ilb, ob1[4 * g + 1] * ilb, ob1[4 * g + 2] * ilb, ob1[4 * g + 3] * ilb);
            }
        }
    }
    xcd_barrier(xb);

    {
        PHASE_PTRS
        for (int t = gw; t < T; t += NGW) {
            const int ch = 8 * lane, h = lane >> 3;
            float y[8], v[8], g[8]; ld_bf8(Yb + (size_t)t * 512 + ch, y); ld_bf8(Vb + (size_t)t * 512 + ch, v); ld_bf8(Gtb + (size_t)t * 512 + ch, g);
            float s = 0.f;
#pragma unroll
            for (int i = 0; i < 8; ++i) s += y[i];
            s += __shfl_xor(s, 1); s += __shfl_xor(s, 2); s += __shfl_xor(s, 4);
            const float mu = s * (1.f / 64.f); float q = 0.f;
#pragma unroll
            for (int i = 0; i < 8; ++i) { y[i] -= mu; q += y[i] * y[i]; }
            q += __shfl_xor(q, 1); q += __shfl_xor(q, 2); q += __shfl_xor(q, 4);
            const float rstd = rsqrtf(q * (1.f / 64.f) + 64e-5f);
            const float bo = bonus[(size_t)t * 8 + h];
            const f32x4 lw0 = *(const f32x4*)(rw_ln_w + ch), lw1 = *(const f32x4*)(rw_ln_w + ch + 4), lb0 = *(const f32x4*)(rw_ln_b + ch), lb1 = *(const f32x4*)(rw_ln_b + ch + 4);
            float o[8];
#pragma unroll
            for (int i = 0; i < 8; ++i) { const float lw = i < 4 ? lw0[i & 3] : lw1[i & 3], lb = i < 4 ? lb0[i & 3] : lb1[i & 3]; o[i] = (y[i] * rstd * lw + lb + bo * v[i]) * g[i]; }
            *(bf16x8*)(YA + (size_t)t * 512 + ch) = pack8(o);
        }
    }
    xcd_barrier(xb);

    {
        PHASE_PTRS
        pg8::StaticOrder S; S.init(T, 1024, G, (int)blockIdx.x);
        { pg8::Gemm g{YA, RwoT, T, 1024, 512}; pg8::EpiGate E{MIXED, Gg, 0, 0};
          pg8::gemm_phase<pg8::EpiGate, pg8::StaticOrder, true, true>((PG8_LAS unsigned char*)lds, g, S, E); }
        { pg8::Gemm g{Ob, MwoT, T, 1024, 512}; pg8::EpiGate E{MIXED, Gg, 1024, 1};
          pg8::gemm_phase<pg8::EpiGate, pg8::StaticOrder, true, true>((PG8_LAS unsigned char*)lds, g, S, E); }
    }
    xcd_barrier(xb);

    {
        PHASE_PTRS
        const bool conv_first = ((blockIdx.x >> 3) & 1) != 0;
#define P4B_CONV         { const float* pu = kp->in[29]; const float* pv = kp->in[30]; \
          for (size_t i = (size_t)blockIdx.x * NT + tid; i < (size_t)16384 * 1024 / 16; i += (size_t)G * NT) { \
              u32x4 uo, vo; \
              _Pragma("unroll") for (int q = 0; q < 4; ++q) { \
                  const f32x4 u = ((const f32x4*)pu)[i * 4 + q]; const f32x4 w = ((const f32x4*)norm2_w)[(i & 63) * 4 + q]; \
                  uo[q] = pk4_fp8(u.x * w.x * U8_SCALE, u.y * w.y * U8_SCALE, u.z * w.z * U8_SCALE, u.w * w.w * U8_SCALE); \
                  const f32x4 v = ((const f32x4*)pv)[i * 4 + q]; vo[q] = pk4_fp8(v.x * V8_SCALE, v.y * V8_SCALE, v.z * V8_SCALE, v.w * V8_SCALE); \
              } \
              ((u32x4*)UB)[i] = uo; \
              { const size_t e = i >> 6; const int d0 = (int)(i & 63) * 16; *(u32x4*)((unsigned char*)VBp + ((size_t)(d0 >> 7) * 16384 + e) * 128 + (d0 & 127)) = vo; } } }
        if (conv_first) P4B_CONV
        { pg8::Gemm g{MIXED, WoutT, T, 1024, 1024}; pg8::StaticOrder S; S.init(T, 1024, G, (int)blockIdx.x);
          pg8::EpiRes E{x, HB, ss2};
          pg8::gemm_phase<pg8::EpiRes, pg8::StaticOrder, true, true>((PG8_LAS unsigned char*)lds, g, S, E); }
        if (!conv_first) P4B_CONV
#undef P4B_CONV
    }
    xcd_barrier(xb);

    {
        PHASE_PTRS
        pg8::Gemm g{HB, PwqT, T, 2048, 1024}; pg8::StaticOrder S; S.init(T, 2048, G, (int)blockIdx.x);
        pg8::EpiScale E{SC, ss2};
        pg8::gemm_phase<pg8::EpiScale, pg8::StaticOrder, true, true>((PG8_LAS unsigned char*)lds, g, S, E);
    }
    xcd_barrier(xb);

    {
        PHASE_PTRS
        const int wp = wave & 3; const bool producer = wave < 4;
        volatile LAS unsigned* pc = (volatile LAS unsigned*)((LAS unsigned char*)lds + LDS_BYTES - 128) + 2 * wp;
        int ppair[4];
#pragma unroll
        for (int c = 0; c < 4; ++c) ppair[c] = peer_pair(16 * c + (lane & 15));
        if (tid < 64) *(LAS u32x4*)((LAS unsigned char*)lds + 24576 + tid * 16) = (u32x4){0u, 0u, 0u, 0u};
        __syncthreads();
        if (producer) {
        int kq = 0;
        for (int t = blockIdx.x * 4 + wp; t < T; t += G * 4, ++kq) {
            LAS unsigned char* wl = (LAS unsigned char*)lds + wp * 4096 + (kq & 1) * 2048;
            LAS u32x2* tab = (LAS u32x2*)wl;
            if (kq >= 2) { while ((int)pc[1] < kq - 1) __builtin_amdgcn_s_sleep(2); }
            asm volatile("" ::: "memory");
            { float xa[8], xb[8]; ld_bf8(HB + (size_t)t * DM + 16 * lane, xa); ld_bf8(HB + (size_t)t * DM + 16 * lane + 8, xb);
              u32x4 w; w.x = pk4_fp8(xa[0], xa[1], xa[2], xa[3]); w.y = pk4_fp8(xa[4], xa[5], xa[6], xa[7]); w.z = pk4_fp8(xb[0], xb[1], xb[2], xb[3]); w.w = pk4_fp8(xb[4], xb[5], xb[6], xb[7]);
              *(LAS u32x4*)(wl + 1024 + lane * 16) = w; }
            {
                const int l16 = lane & 15, rho = lane >> 4;
                LAS unsigned* rkK = (LAS unsigned*)((LAS unsigned char*)lds + 16384 + wp * 2048);
                LAS float* rkS = (LAS float*)(rkK + 256);
#define CE_(a_, b_) { const unsigned hi_ = umax2(a_, b_), lo_ = a_ < b_ ? a_ : b_; a_ = hi_; b_ = lo_; }
#define SORT8(k) { CE_(k[0], k[1]) CE_(k[2], k[3]) CE_(k[4], k[5]) CE_(k[6], k[7]) CE_(k[0], k[2]) CE_(k[1], k[3]) CE_(k[4], k[6]) CE_(k[5], k[7]) CE_(k[1], k[2]) CE_(k[5], k[6]) \
                    CE_(k[0], k[4]) CE_(k[3], k[7]) CE_(k[1], k[5]) CE_(k[2], k[6]) CE_(k[1], k[4]) CE_(k[3], k[6]) CE_(k[2], k[4]) CE_(k[3], k[5]) CE_(k[3], k[4]) }
#define SORT4(k) { CE_(k[0], k[1]) CE_(k[2], k[3]) CE_(k[0], k[2]) CE_(k[1], k[3]) CE_(k[1], k[2]) }
                {
                    unsigned key[4][8], top[4];
#pragma unroll
                    for (int q = 0; q < 4; ++q) {
                        const u32x4 w = *(const u32x4*)(SC + (size_t)t * 2048 + (4 * q + rho) * 128 + 8 * l16);
#pragma unroll
                        for (int c = 0; c < 8; ++c) { unsigned u = (c & 1) ? (w[c >> 1] & 0xffff0000u) : (w[c >> 1] << 16); u = (u & 0x80000000u) ? ~u : (u | 0x80000000u); key[q][c] = (u & ~127u) | (unsigned)(127 - (8 * l16 + c)); }
                        SORT8(key[q])
                        top[q] = 0u;
                    }
#pragma unroll 1
                    for (int r = 0; r < 16; ++r) {
                        const bool isr = l16 == r;
#pragma unroll
                        for (int q = 0; q < 4; ++q) {
                            const unsigned m = umax16(key[q][0]);
                            const bool win = key[q][0] == m;
#pragma unroll
                            for (int c = 0; c < 7; ++c) key[q][c] = win ? key[q][c + 1] : key[q][c];
                            key[q][7] = win ? 0u : key[q][7];
                            top[q] = isr ? m : top[q];
                        }
                    }
#pragma unroll
                    for (int q = 0; q < 4; ++q) { unsigned u = top[q] & ~127u; u = (u & 0x80000000u) ? (u & 0x7fffffffu) : ~u; rkK[(4 * q + rho) * 16 + l16] = top[q]; rkS[(4 * q + rho) * 16 + l16] = __uint_as_float(u); }
                }
                asm volatile("s_waitcnt lgkmcnt(0)" ::: "memory");
                {
                    unsigned ck[2][4], best[2];
#pragma unroll
                    for (int q = 0; q < 2; ++q) {
                        const int hd = 4 * q + rho;
#pragma unroll
                        for (int c = 0; c < 4; ++c) { const int pr = ppair[c], pi = pr < 0 ? 0 : pr;
                            const float sm = rkS[32 * hd + (pi >> 4)] + rkS[32 * hd + 16 + (pi & 15)]; unsigned u = __float_as_uint(sm); u = (u & 0x80000000u) ? ~u : (u | 0x80000000u);
                            ck[q][c] = pr < 0 ? 0u : ((u & ~255u) | (unsigned)(255 - pr)); }
                        SORT4(ck[q])
                        best[q] = 0u;
                    }
#pragma unroll 1
                    for (int r = 0; r < 16; ++r) {
                        const bool isr = l16 == r;
#pragma unroll
                        for (int q = 0; q < 2; ++q) {
                            const unsigned m = umax16(ck[q][0]);
                            const bool win = ck[q][0] == m;
                            ck[q][0] = win ? ck[q][1] : ck[q][0]; ck[q][1] = win ? ck[q][2] : ck[q][1]; ck[q][2] = win ? ck[q][3] : ck[q][2]; ck[q][3] = win ? 0u : ck[q][3];
                            best[q] = isr ? m : best[q];
                        }
                    }
#pragma unroll
                    for (int q = 0; q < 2; ++q) {
                        const int hd = 4 * q + rho;
                        float bs; { unsigned u = best[q] & ~255u; u = (u & 0x80000000u) ? (u & 0x7fffffffu) : ~u; bs = __uint_as_float(u); }
                        float bmax; { unsigned u = umax16(best[q]) & ~255u; u = (u & 0x80000000u) ? (u & 0x7fffffffu) : ~u; bmax = __uint_as_float(u); }
                        const int pos = 255 - (int)(best[q] & 255u);
                        const float e = __expf(bs - bmax);
                        const float gate = e / sum16(e);
                        const unsigned t1 = rkK[32 * hd + (pos >> 4)], t2 = rkK[32 * hd + 16 + (pos & 15)];
                        const unsigned eid = (127u - (t1 & 127u)) * 128u + (127u - (t2 & 127u));
                        tab[16 * hd + l16] = (u32x2){eid, __float_as_uint(gate)};
                    }
                }
#undef SORT4
#undef SORT8
#undef CE_
            }
            asm volatile("s_waitcnt lgkmcnt(0)" ::: "memory");
            if (lane == 0) pc[0] = (unsigned)(kq + 1);
        }
        } else {
            const unsigned char* UB8 = (const unsigned char*)UB;
            const int tfirst = blockIdx.x * 4 + wp; const int nt = tfirst < T ? (T - tfirst + G * 4 - 1) / (G * 4) : 0;
            const int rho = lane >> 3, chi = lane & 7, jj = lane & 15, qq = lane >> 4;
            const bool useful = (qq & 1) == ((jj >> 2) & 1);
            const bool wr_lane = (jj & 7) == 0 && (qq & 1) == 0;
            LAS float* dotb = (LAS float*)((LAS unsigned char*)lds + 25600 + wp * 512);
            const unsigned zbase = 24576u;
            u32x4 R0[8], R1[8], R2[8], R3[8];
#define P6U_LOAD(R, kq_, G_) { const LAS u32x2* tb_ = (const LAS u32x2*)((LAS unsigned char*)lds + wp * 4096 + ((kq_) & 1) * 2048); \
                const unsigned char* up_ = UB8 + (size_t)tb_[8 * (G_) + rho].x * DM + 16 * chi; \
                _Pragma("unroll") for (int cb = 0; cb < 8; ++cb) R[cb] = *(const u32x4*)(up_ + 128 * cb); }
#define P6U_USE(R, G_) { f32x4 d0 = (f32x4){0.f, 0.f, 0.f, 0.f}, d1 = d0; \
                _Pragma("unroll") for (int cb = 0; cb < 8; ++cb) { \
                    const u32x2 ba0 = *(const LAS u32x2*)((LAS unsigned char*)lds + xa0 + 128 * cb), ba1 = *(const LAS u32x2*)((LAS unsigned char*)lds + xa1 + 128 * cb); \
                    const u32x2 bb0 = *(const LAS u32x2*)((LAS unsigned char*)lds + xa0 + 128 * cb + 8), bb1 = *(const LAS u32x2*)((LAS unsigned char*)lds + xa1 + 128 * cb + 8); \
                    d0 = mfma16_fp8((u32x2){R[cb].x, R[cb].y}, ba0, d0); d1 = mfma16_fp8((u32x2){R[cb].x, R[cb].y}, ba1, d1); \
                    d0 = mfma16_fp8((u32x2){R[cb].z, R[cb].w}, bb0, d0); d1 = mfma16_fp8((u32x2){R[cb].z, R[cb].w}, bb1, d1); } \
                const int r_ = jj & 3; \
                float v0 = r_ == 0 ? d0[0] : (r_ == 1 ? d0[1] : (r_ == 2 ? d0[2] : d0[3])), v1 = r_ == 0 ? d1[0] : (r_ == 1 ? d1[1] : (r_ == 2 ? d1[2] : d1[3])); \
                v0 = useful ? v0 : 0.f; v1 = useful ? v1 : 0.f; v0 = sum8(v0); v1 = sum8(v1); \
                { const auto rr = __builtin_amdgcn_permlane16_swap(__float_as_uint(v0), __float_as_uint(v0), false, false); v0 = __uint_as_float(rr[0]) + __uint_as_float(rr[1]); } \
                { const auto rr = __builtin_amdgcn_permlane16_swap(__float_as_uint(v1), __float_as_uint(v1), false, false); v1 = __uint_as_float(rr[0]) + __uint_as_float(rr[1]); } \
                if (wr_lane) { const int e_ = 8 * (G_) + 2 * (jj >> 3) + (qq >> 1); dotb[e_] = v0; dotb[e_ + 4] = v1; } }
            if (nt > 0) {
                while ((int)pc[0] <= 0) __builtin_amdgcn_s_sleep(2);
                asm volatile("" ::: "memory");
                P6U_LOAD(R0, 0, 0) P6U_LOAD(R1, 0, 1) P6U_LOAD(R2, 0, 2)
            }
            for (int kq = 0; kq < nt; ++kq) {
                const int t = tfirst + kq * (G * 4);
                LAS unsigned char* wl = (LAS unsigned char*)lds + wp * 4096 + (kq & 1) * 2048;
                const float rs = rsqrtf(ss2[t] * (1.f / DM) + EPS);
                const unsigned xb_ = (unsigned)(wp * 4096 + (kq & 1) * 2048 + 1024 + 16 * (jj & 7));
                const unsigned xa0 = qq == (jj >> 3) ? xb_ : zbase, xa1 = qq == 2 + (jj >> 3) ? xb_ : zbase;
#pragma unroll 1
                for (int GG = 0; GG < 16; GG += 4) {
                    int kn = kq, gn = GG + 4;
                    if (GG == 12) {
                        if (kq + 1 < nt) { while ((int)pc[0] < kq + 2) __builtin_amdgcn_s_sleep(2); asm volatile("" ::: "memory"); kn = kq + 1; gn = 0; }
                        else gn = 12;
                    }
                    P6U_LOAD(R3, kq, GG + 3)
                    __builtin_amdgcn_sched_barrier(0);
                    P6U_USE(R0, GG)
                    __builtin_amdgcn_sched_barrier(0);
                    P6U_LOAD(R0, kn, gn)
                    __builtin_amdgcn_sched_barrier(0);
                    P6U_USE(R1, GG + 1)
                    __builtin_amdgcn_sched_barrier(0);
                    P6U_LOAD(R1, kn, gn + 1)
                    __builtin_amdgcn_sched_barrier(0);
                    P6U_USE(R2, GG + 2)
                    __builtin_amdgcn_sched_barrier(0);
                    P6U_LOAD(R2, kn, gn + 2)
                    __builtin_amdgcn_sched_barrier(0);
                    P6U_USE(R3, GG + 3)
                    __builtin_amdgcn_sched_barrier(0);
                }
                asm volatile("s_waitcnt lgkmcnt(0)" ::: "memory");
                {
                    const u32x4 tv = *(const LAS u32x4*)(wl + lane * 16);
                    const f32x2_t dd = *(const LAS f32x2_t*)(dotb + 2 * lane);
                    const float da = dd.x * (rs * (1.f / U8_SCALE)), db = dd.y * (rs * (1.f / U8_SCALE));
                    const float acta = 0.5f * da * (1.f + erff(da * 0.7071067811865476f)), actb = 0.5f * db * (1.f + erff(db * 0.7071067811865476f));
                    const float cfa = __uint_as_float(tv.y) * acta * (1.f / V8_SCALE), cfb = __uint_as_float(tv.w) * actb * (1.f / V8_SCALE);
                    asm volatile("s_waitcnt lgkmcnt(0)" ::: "memory");
                    LAS unsigned char* tq = wl + 1024; const int r0 = 2 * (lane & 3), l0 = lane >> 2;
                    *(LAS unsigned short*)(tq + (r0 * 16 + l0) * 2) = (unsigned short)tv.x; *(LAS unsigned short*)(tq + ((r0 + 1) * 16 + l0) * 2) = (unsigned short)tv.z;
                    const float c0 = fminf(fmaxf(cfa * C8_SCALE, -440.f), 440.f), c1 = fminf(fmaxf(cfb * C8_SCALE, -440.f), 440.f);
                    const unsigned c8 = (unsigned)__builtin_amdgcn_cvt_pk_fp8_f32(c0, c1, 0, false);
                    *(tq + 256 + r0 * 16 + l0) = (unsigned char)(c8 & 0xffu); *(tq + 256 + (r0 + 1) * 16 + l0) = (unsigned char)((c8 >> 8) & 0xffu);
                    asm volatile("s_waitcnt lgkmcnt(0)" ::: "memory");
                    if (lane < 24) { const u32x4 o = *(const LAS u32x4*)(tq + lane * 16); *(u32x4*)(ws + WS_TAB + (size_t)t * 384 + lane * 16) = o; }
                }
                asm volatile("s_waitcnt lgkmcnt(0)" ::: "memory");
                if (lane == 0) pc[1] = (unsigned)(kq + 1);
            }
#undef P6U_USE
#undef P6U_LOAD
        }
    }
    xcd_barrier(xb);

    {
        PHASE_PTRS
        const unsigned sl = blockIdx.x & 7;
        const unsigned char* VS = (const unsigned char*)VBp + (size_t)sl * 16384 * 128;
        const int rho = lane >> 3, chi = lane & 7;
        constexpr float CSCALE = C8_SCALE;
        unsigned selLo[4], selHi[4];
#pragma unroll
        for (int k = 0; k < 4; ++k) { const unsigned sh = 8u * (unsigned)(chi & 3); const unsigned v = (0x0c0c0c0cu & ~(0xffu << sh)) | ((unsigned)k << sh);
            selLo[k] = chi < 4 ? v : 0x0c0c0c0cu; selHi[k] = chi < 4 ? 0x0c0c0c0cu : v; }
        const bool olane = (lane & 0x28) == 0;
        const unsigned voff0 = 16u * (unsigned)chi;
        LAS unsigned char* wl8 = (LAS unsigned char*)lds + wave * 6144;
        const int wstride = (G >> 3) * NWAVES, tg0 = (blockIdx.x >> 3) * NWAVES + wave;
        const int nb = tg0 < T / 8 ? (T / 8 - tg0 + wstride - 1) / wstride : 0, ntok = nb * 8;
#define P6C_TOK(i_) ((tg0 + ((i_) >> 3) * wstride) * 8 + ((i_) & 7))
#define P6C_DMA(b_) { _Pragma("unroll") for (int k = 0; k < 3; ++k) __builtin_amdgcn_global_load_lds((const unsigned*)(ws + WS_TAB + (size_t)((tg0 + (b_) * wstride) * 8) * 384 + k * 1024 + lane * 16), (LAS unsigned*)(wl8 + ((b_) & 1) * 3072 + k * 1024), 16, 0, 0); }
#define P6C_TAB(EL, EH, CW, i_) { const int ii_ = (i_) < ntok ? (i_) : ntok - 1; const LAS unsigned char* tq_ = wl8 + ((ii_ >> 3) & 1) * 3072 + (ii_ & 7) * 384; \
            EL = *(const LAS u32x4*)(tq_ + rho * 32); EH = *(const LAS u32x4*)(tq_ + rho * 32 + 16); CW = *(const LAS u32x4*)(tq_ + 256 + rho * 16); }
#define P6C_EID(ER, j_) (((j_) & 1) ? (ER[(j_) >> 1] >> 16) : (ER[(j_) >> 1] & 0xffffu))
#define P6C_LOAD(VV, ER) { _Pragma("unroll") for (int j = 0; j < 8; ++j) VV[j] = *(const u32x4*)(VS + (size_t)((P6C_EID(ER, j) << 7) | voff0)); }
#define P6C_USE(VV, CWA, CWB) { _Pragma("unroll") for (int j = 0; j < 8; ++j) { const unsigned cwd = (j < 4) ? CWA : CWB; \
            u32x2 xo; xo.x = __builtin_amdgcn_perm(cwd, cwd, selLo[j & 3]); xo.y = __builtin_amdgcn_perm(cwd, cwd, selHi[j & 3]); \
            acc0 = mfma16_fp8(xo, (u32x2){VV[j].x, VV[j].y}, acc0); acc1 = mfma16_fp8(xo, (u32x2){VV[j].z, VV[j].w}, acc1); } }
#define P6C_BODY(i_, VA, VB, EL, EH, CW, VBo, EHo) { \
            const size_t oo_ = (size_t)P6C_TOK(i_) * DM + 128 * sl + 16 * chi + 4 * ((lane >> 4) & 1); float* orow = kp->out + oo_; \
            u32x2 hw0 = (u32x2){0u, 0u}, hw1 = hw0; \
            if (olane) { hw0 = *(const u32x2*)(HB + oo_); hw1 = *(const u32x2*)(HB + oo_ + 8); }        \
            P6C_LOAD(VBo, EHo)                                     \
            const u32x4 cwq = CW; \
            __builtin_amdgcn_sched_barrier(0); \
            f32x4 acc0 = (f32x4){0.f, 0.f, 0.f, 0.f}, acc1 = acc0; \
            P6C_USE(VA, cwq.x, cwq.y) \
            __builtin_amdgcn_sched_barrier(0); \
            P6C_TAB(EL, EH, CW, (i_) + 2) \
            P6C_LOAD(VA, EL)                                       \
            __builtin_amdgcn_sched_barrier(0); \
            P6C_USE(VB, cwq.z, cwq.w) \
            float s[8]; \
            _Pragma("unroll") for (int r = 0; r < 4; ++r) {        \
                { const auto rr = __builtin_amdgcn_permlane32_swap(__float_as_uint(acc0[r]), __float_as_uint(acc0[r]), false, false); s[r] = acc0[r] + dpp_f<0x128>(__uint_as_float(rr[1])); } \
                { const auto rr = __builtin_amdgcn_permlane32_swap(__float_as_uint(acc1[r]), __float_as_uint(acc1[r]), false, false); s[4 + r] = acc1[r] + dpp_f<0x128>(__uint_as_float(rr[1])); } } \
            if (olane) { const f32x4 h0 = (f32x4){bflo(hw0.x), bfhi(hw0.x), bflo(hw0.y), bfhi(hw0.y)}, h1 = (f32x4){bflo(hw1.x), bfhi(hw1.x), bflo(hw1.y), bfhi(hw1.y)}; \
                *(f32x4*)orow = h0 + (f32x4){s[0], s[1], s[2], s[3]} * (1.f / CSCALE); *(f32x4*)(orow + 8) = h1 + (f32x4){s[4], s[5], s[6], s[7]} * (1.f / CSCALE); } \
            __builtin_amdgcn_sched_barrier(0); }
        if (nb > 0) {
            u32x4 vA0[8], vB0[8], vA1[8], vB1[8];
            u32x4 eL0, eH0, cw0, eL1, eH1, cw1;
            P6C_DMA(0)
            if (nb > 1) P6C_DMA(1)
            asm volatile("s_waitcnt vmcnt(0)" ::: "memory");
            P6C_TAB(eL0, eH0, cw0, 0)
            P6C_LOAD(vA0, eL0)
            P6C_LOAD(vB0, eH0)
            P6C_TAB(eL1, eH1, cw1, 1)
            P6C_LOAD(vA1, eL1)
#pragma unroll 1
            for (int i = 0; i < ntok; i += 2) {
                if ((i & 7) == 0 && i > 0 && (i >> 3) + 1 < nb) P6C_DMA((i >> 3) + 1)
                if ((i & 7) == 4) asm volatile("s_waitcnt vmcnt(40)" ::: "memory");
                P6C_BODY(i, vA0, vB0, eL0, eH0, cw0, vB1, eH1)
                P6C_BODY(i + 1, vA1, vB1, eL1, eH1, cw1, vB0, eH0)
            }
            asm volatile("s_waitcnt vmcnt(0) lgkmcnt(0)" ::: "memory");
        }
#undef P6C_BODY
#undef P6C_USE
#undef P6C_LOAD
#undef P6C_EID
#undef P6C_TAB
#undef P6C_DMA
#undef P6C_TOK
    }
}

extern "C" void kernel_launch(void* const* d_in, const int* in_sizes, int n_in, void* d_out, int out_size,
                              void* d_ws, size_t ws_size, hipStream_t stream) {
    static int grid_blocks = 0;
    if (!grid_blocks) {
        int dev = 0, cus = 0, per_cu = 0;
        (void)hipGetDevice(&dev);
        (void)hipDeviceGetAttribute(&cus, hipDeviceAttributeMultiprocessorCount, dev);
        (void)hipFuncSetAttribute((const void*)mega, hipFuncAttributeMaxDynamicSharedMemorySize, LDS_BYTES);
        (void)hipOccupancyMaxActiveBlocksPerMultiprocessor(&per_cu, (const void*)mega, NT, LDS_BYTES);
        if (per_cu < 1) per_cu = 1;
        if (per_cu > 1) per_cu = 1;
        grid_blocks = cus * per_cu;
        if (ws_size < 256 * MiB) fprintf(stderr, "kernel_launch: workspace too small: %zu\n", ws_size);
    }
    Params p{};
    for (int i = 0; i < 31; ++i) p.in[i] = (const float*)d_in[i];
    p.out = (float*)d_out;
    p.ws = (unsigned char*)d_ws;
    void* args[] = {&p};
    (void)hipMemsetAsync((unsigned char*)d_ws + WS_CNT, 0, 65536, stream);
    hipError_t e = hipLaunchCooperativeKernel((const void*)mega, dim3(grid_blocks), dim3(NT), args, LDS_BYTES, stream);
    if (e != hipSuccess) fprintf(stderr, "cooperative launch failed: %s (grid %d)\n", hipGetErrorString(e), grid_blocks);
}
```

```cpp
#include <hip/hip_runtime.h>
#include <hip/hip_cooperative_groups.h>
#include <cstdio>
#include <cstdint>
namespace cg = cooperative_groups;

#define DEVI __device__ __forceinline__
typedef unsigned short bf16_t;
typedef short bf16x8 __attribute__((ext_vector_type(8)));
typedef float f32x4 __attribute__((ext_vector_type(4)));
typedef float f32x16 __attribute__((ext_vector_type(16)));
typedef unsigned u32x2 __attribute__((ext_vector_type(2)));
typedef unsigned u32x4 __attribute__((ext_vector_type(4)));

constexpr int T = 16384, SEQ = 4096, DM = 1024;
constexpr int NWAVES = 8, NT = 512;
constexpr int LDS_BYTES = 147456;
constexpr float EPS = 1e-6f;
constexpr float LOG2E = 1.4426950408889634f;
constexpr float QSCALE = 0.10206207261596575f * 1.4426950408889634f;

constexpr size_t MiB = 1u << 20;
constexpr size_t WS_SS2 = 0;
constexpr size_t WS_CNT = 512 * 1024;
constexpr size_t WS_SSQ = 64 * 1024, WS_SSKV = 128 * 1024;
constexpr size_t WS_WIN = 1 * MiB;
constexpr size_t WS_WUQ = 10 * MiB + 512 * 1024;
constexpr size_t WS_WUKV = 11 * MiB + 256 * 1024;
constexpr size_t WS_RWO = 12 * MiB;
constexpr size_t WS_MWO = 13 * MiB;
constexpr size_t WS_WOUT = 14 * MiB;
constexpr size_t WS_PWQ = 16 * MiB;
constexpr size_t WS_SUBK = 20 * MiB;
constexpr size_t WS_W2T = 20 * MiB + 512 * 1024;
constexpr size_t WS_A2T = WS_W2T + 64 * 1024;
constexpr size_t WS_G2T = WS_A2T + 64 * 1024;
constexpr size_t WS_G = 24 * MiB;
constexpr size_t WS_UB = 56 * MiB, WS_VB = 72 * MiB;
constexpr size_t WS_SC = 176 * MiB;
constexpr size_t WS_PRW = 88 * MiB;
constexpr size_t WS_Q = 88 * MiB, WS_K = 112 * MiB, WS_VT = 136 * MiB;
constexpr size_t WS_HB = 88 * MiB;
constexpr size_t WS_QD = 152 * MiB, WS_KVD = 164 * MiB, WS_KPE = 172 * MiB;
constexpr size_t WS_O = 152 * MiB;
constexpr size_t WS_R = 176 * MiB, WS_W = 192 * MiB, WS_KS = 208 * MiB, WS_V = 224 * MiB, WS_KK = 240 * MiB;
constexpr size_t WS_YA = 176 * MiB;
constexpr size_t WS_MIXED = 192 * MiB;
constexpr size_t WS_PQ = 184 * MiB;
constexpr size_t WS_TAB = 240 * MiB;
constexpr size_t DO_XN = 0;
constexpr size_t DO_BV = 0, DO_GT = 16 * MiB, DO_BONUS = 32 * MiB, DO_Y = 33 * MiB, DO_KRAW = 33 * MiB, DO_GL = 50 * MiB;

struct Params {
    const float* in[31];
    float* out;
    unsigned char* ws;
};

DEVI unsigned f2bf(float f) { unsigned u = __float_as_uint(f); return (u + 0x7fffu + ((u >> 16) & 1u)) >> 16; }
typedef float f32x2_t __attribute__((ext_vector_type(2)));
typedef __bf16 bf16x2_t __attribute__((ext_vector_type(2)));
DEVI unsigned pk2(float lo, float hi) { f32x2_t v = {lo, hi}; bf16x2_t b = __builtin_convertvector(v, bf16x2_t); return __builtin_bit_cast(unsigned, b); }
DEVI float bflo(unsigned u) { return __uint_as_float(u << 16); }
DEVI float bfhi(unsigned u) { return __uint_as_float(u & 0xffff0000u); }
DEVI float bf1(bf16_t u) { return __uint_as_float(((unsigned)u) << 16); }
DEVI float wave_sum(float v) {
#pragma unroll
    for (int o = 32; o >= 1; o >>= 1) v += __shfl_xor(v, o);
    return v;
}
DEVI float sigmoidf_(float x) { return __builtin_amdgcn_rcpf(1.f + __builtin_amdgcn_exp2f(-1.4426950408889634f * x)); }
DEVI float tanhf_(float x) { return 1.f - 2.f * __builtin_amdgcn_rcpf(__builtin_amdgcn_exp2f(2.885390081777927f * x) + 1.f); }
DEVI void st_bf4(bf16_t* p, float a, float b, float c, float d) { u32x2 w; w.x = pk2(a, b); w.y = pk2(c, d); *(u32x2*)p = w; }
DEVI void ld_bf4(const bf16_t* p, float (&o)[4]) { u32x2 w = *(const u32x2*)p; o[0] = bflo(w.x); o[1] = bfhi(w.x); o[2] = bflo(w.y); o[3] = bfhi(w.y); }
DEVI void ld_bf8(const bf16_t* p, float (&o)[8]) { u32x4 w = *(const u32x4*)p; o[0] = bflo(w.x); o[1] = bfhi(w.x); o[2] = bflo(w.y); o[3] = bfhi(w.y); o[4] = bflo(w.z); o[5] = bfhi(w.z); o[6] = bflo(w.w); o[7] = bfhi(w.w); }
DEVI bf16x8 pack8(const float (&v)[8]) { u32x4 w; w.x = pk2(v[0], v[1]); w.y = pk2(v[2], v[3]); w.z = pk2(v[4], v[5]); w.w = pk2(v[6], v[7]); return __builtin_bit_cast(bf16x8, w); }
DEVI f32x4 mfma16(bf16x8 a, bf16x8 b, f32x4 c) { return __builtin_amdgcn_mfma_f32_16x16x32_bf16(a, b, c, 0, 0, 0); }
DEVI f32x16 mfma32(bf16x8 a, bf16x8 b, f32x16 c) { return __builtin_amdgcn_mfma_f32_32x32x16_bf16(a, b, c, 0, 0, 0); }
DEVI int crow(int r, int hi) { return (r & 3) + 8 * (r >> 2) + 4 * hi; }


template <int CTRL> DEVI float dpp_f(float v) { return __builtin_bit_cast(float, __builtin_amdgcn_update_dpp(0, __builtin_bit_cast(int, v), CTRL, 0xf, 0xf, true)); }
template <int CTRL> DEVI unsigned dpp_u(unsigned v) { return (unsigned)__builtin_amdgcn_update_dpp(0, (int)v, CTRL, 0xf, 0xf, true); }
DEVI float sum8(float v) { v += dpp_f<0xB1>(v); v += dpp_f<0x4E>(v); v += dpp_f<0x141>(v); return v; }
DEVI float sum16(float v) { v = sum8(v); v += dpp_f<0x140>(v); return v; }
DEVI unsigned umax2(unsigned a, unsigned b) { return a > b ? a : b; }
DEVI unsigned umax16(unsigned v) { v = umax2(v, dpp_u<0xB1>(v)); v = umax2(v, dpp_u<0x4E>(v)); v = umax2(v, dpp_u<0x141>(v)); v = umax2(v, dpp_u<0x140>(v)); return v; }
DEVI unsigned rdlane(unsigned v, int l) { return (unsigned)__builtin_amdgcn_readlane((int)v, l); }
#define LAS __attribute__((address_space(3)))

DEVI unsigned pk4_fp8(float a, float b, float c, float d) { int w = 0; w = __builtin_amdgcn_cvt_pk_fp8_f32(a, b, w, false); w = __builtin_amdgcn_cvt_pk_fp8_f32(c, d, w, true); return (unsigned)w; }
DEVI f32x4 mfma16_fp8(u32x2 a, u32x2 b, f32x4 c) { return __builtin_amdgcn_mfma_f32_16x16x32_fp8_fp8(__builtin_bit_cast(long, a), __builtin_bit_cast(long, b), c, 0, 0, 0); }
DEVI unsigned pk4_u8(float a, float b, float c, float d) { unsigned w = 0; w = __builtin_amdgcn_cvt_pk_u8_f32(a, 0, w); w = __builtin_amdgcn_cvt_pk_u8_f32(b, 1, w); w = __builtin_amdgcn_cvt_pk_u8_f32(c, 2, w); w = __builtin_amdgcn_cvt_pk_u8_f32(d, 3, w); return w; }
constexpr float U8_SCALE = 32.f, V8_SCALE = 4.f;
constexpr float C8_SCALE = 256.f;

template <int OFF> DEVI f32x4 lds_rd128(unsigned a) { f32x4 r; asm volatile("ds_read_b128 %0, %1 offset:%2" : "=v"(r) : "v"(a), "i"(OFF)); return r; }
template <int OFF> DEVI float lds_rd32(unsigned a) { float r; asm volatile("ds_read_b32 %0, %1 offset:%2" : "=v"(r) : "v"(a), "i"(OFF)); return r; }
DEVI void lds_wr32(unsigned a, float v) { asm volatile("ds_write_b32 %0, %1" ::"v"(a), "v"(v) : "memory"); }

#define SW64(r, k) ((r) * 64 + (((((k) >> 3) ^ ((r) & 7))) << 3) + ((k) & 7))
#define SW32(r, c) ((r) * 32 + (((((c) >> 3) ^ (((r) >> 2) & 3))) << 3) + ((c) & 7))
DEVI int swz_off(int r, int chunk, int ld) { return ld == 64 ? r * 64 + ((chunk ^ (r & 7)) << 3) : r * 32 + ((chunk ^ ((r >> 2) & 3)) << 3); }
template <int MT, int NTL, int KS>
DEVI void gemm_lds(const LAS bf16_t* A, int lda, const LAS bf16_t* B, int ldb, f32x4 (&acc)[MT][NTL], int fr, int fq) {
#pragma unroll
    for (int ks = 0; ks < KS; ++ks) {
        bf16x8 a[MT], b[NTL];
#pragma unroll
        for (int m = 0; m < MT; ++m) a[m] = *(const LAS bf16x8*)(A + swz_off(16 * m + fr, 4 * ks + fq, lda));
#pragma unroll
        for (int n = 0; n < NTL; ++n) b[n] = *(const LAS bf16x8*)(B + swz_off(16 * n + fr, 4 * ks + fq, ldb));
#pragma unroll
        for (int m = 0; m < MT; ++m)
#pragma unroll
            for (int n = 0; n < NTL; ++n) acc[m][n] = mfma16(b[n], a[m], acc[m][n]);
    }
}
DEVI bf16_t bf1of(float x) { return (bf16_t)(pk2(x, x) & 0xffffu); }
DEVI void gemm_tile_acc(const bf16_t* __restrict__ A, int lda, const bf16_t* __restrict__ Bt, int ldb, int K, int m0, int n0, int lane, f32x4 (&acc)[4][4]) {
    const int fr = lane & 15, fq = lane >> 4;
    const bf16_t* ap = A + (size_t)(m0 + fr) * lda + fq * 8;
    const bf16_t* bp = Bt + (size_t)(n0 + fr) * ldb + fq * 8;
#pragma unroll 2
    for (int k0 = 0; k0 < K; k0 += 32) {
        bf16x8 a[4], b[4];
#pragma unroll
        for (int m = 0; m < 4; ++m) a[m] = *(const bf16x8*)(ap + (size_t)m * 16 * lda + k0);
#pragma unroll
        for (int n = 0; n < 4; ++n) b[n] = *(const bf16x8*)(bp + (size_t)n * 16 * ldb + k0);
#pragma unroll
        for (int m = 0; m < 4; ++m)
#pragma unroll
            for (int n = 0; n < 4; ++n) acc[m][n] = mfma16(b[n], a[m], acc[m][n]);
    }
}
DEVI void zero_acc(f32x4 (&acc)[4][4]) {
#pragma unroll
    for (int m = 0; m < 4; ++m)
#pragma unroll
        for (int n = 0; n < 4; ++n) acc[m][n] = (f32x4){0.f, 0.f, 0.f, 0.f};
}


namespace pg8 {
#define PG8_LAS __attribute__((address_space(3)))
typedef unsigned short bf16_t;
typedef short bf16x8 __attribute__((ext_vector_type(8)));
typedef float f32x4 __attribute__((ext_vector_type(4)));
typedef unsigned u32x4 __attribute__((ext_vector_type(4)));
constexpr int BM = 256, BK = 64, HALF = 128, HTB = HALF * BK * 2  , STAGE_BYTES = 8 * HTB, NXCD = 8, WGM = 8;

__host__ __device__ __forceinline__ int lds_byte(int r, int c) { const int st = (r >> 4) * 2 + (c >> 5), rr = r & 15, cc = c & 31, ob = rr * 64 + cc * 2; return st * 1024 + (ob ^ (((ob >> 9) & 1) << 5)); }
__host__ __device__ __forceinline__ void stage_rc(int b, int& R, int& C) { const int st = b / 1024, sb = b % 1024, swz = sb ^ (((sb >> 9) & 1) << 5); R = (st >> 1) * 16 + swz / 64; C = (st & 1) * 32 + (swz % 64) / 2; }
__host__ __device__ __forceinline__ int perm32(int rho) { const int n = rho >> 4, i = rho & 15; return 8 * (i >> 2) + 4 * n + (i & 3); }

struct Unit { int pm, pn; };
struct Gemm { const bf16_t* A; const bf16_t* Bt; int M, N, K; };

struct StaticOrder {
    int nM, nN, nwg, G, c;
    __host__ __device__ void init(int M, int N, int G_, int c_) { nM = M / BM; nN = N / BM; nwg = nM * nN; G = G_; c = c_; }
    __host__ __device__ bool next(int i, Unit& u) const {
        const long L = (long)i * G + c; if (L >= nwg) return false;
        int wgid = (int)L; { const int q = nwg / NXCD, r = nwg % NXCD, xcd = wgid % NXCD, off = wgid / NXCD; wgid = (xcd < r ? xcd * (q + 1) : r * (q + 1) + (xcd - r) * q) + off; }
        const int nig = WGM * nN, gid = wgid / nig, fm = gid * WGM, gsz = (nM - fm) < WGM ? (nM - fm) : WGM;
        u.pm = fm + ((wgid % nig) % gsz); u.pn = (wgid % nig) / gsz; return true;
    }
    __device__ __forceinline__ void a_ready(const Unit&) const {}
    __device__ __forceinline__ void done(const Unit&) const {}
};


DEVI float sigm(float x) { return __builtin_amdgcn_rcpf(1.f + __builtin_amdgcn_exp2f(-1.4426950408889634f * x)); }
DEVI u32x4 pack8v(f32x4 a, f32x4 b) { u32x4 w; w.x = pk2(a[0], a[1]); w.y = pk2(a[2], a[3]); w.z = pk2(b[0], b[1]); w.w = pk2(b[2], b[3]); return w; }
struct EpiP1 {
    static constexpr bool PERM = true, AFTER_DRAIN = false;
    unsigned char* ws;
    __device__ __forceinline__ void operator()(const f32x4 (&acc)[2][2][4][2], const Unit& u, int wr, int wc, int fr_in, int fq_in) const {
        int fr = fr_in, fq = fq_in; asm volatile("" : "+v"(fr), "+v"(fq));
        const int row0 = u.pm * BM + wr * 64 + fr;
        if (u.pn >= 8 && u.pn < 11) {
#pragma unroll
            for (int bj = 0; bj < 2; ++bj) {
                const int c = (u.pn - 8) * 256 + bj * HALF + wc * 32 + 8 * fq;
                const size_t off = c < 384 ? WS_QD : (c < 640 ? WS_KVD : WS_KPE);
                const int ld = c < 384 ? 384 : (c < 640 ? 256 : 32), cc = c < 384 ? c : (c < 640 ? c - 384 : c - 640);
                if (c < 672) {
#pragma unroll
                    for (int ai = 0; ai < 2; ++ai)
#pragma unroll
                        for (int m = 0; m < 4; ++m) { const size_t row = (size_t)(row0 + ai * HALF + m * 16);
                            *(u32x4*)(ws + off + (row * ld + cc) * 2) = pack8v(acc[ai][bj][m][0], acc[ai][bj][m][1]); }
                }
            }
            return;
        }
        if (u.pn >= 11) {
            const int col0 = (u.pn - 11) * 256 + wc * 32 + 8 * fq;
#pragma unroll
            for (int ai = 0; ai < 2; ++ai)
#pragma unroll
                for (int m = 0; m < 4; ++m) { unsigned char* rowp = ws + WS_G + ((size_t)(row0 + ai * HALF + m * 16) * 2048 + col0);
#pragma unroll
                    for (int bj = 0; bj < 2; ++bj) { const f32x4 v0 = acc[ai][bj][m][0], v1 = acc[ai][bj][m][1];
                        u32x2 w; w.x = pk4_u8(sigm(v0[0]) * 255.f, sigm(v0[1]) * 255.f, sigm(v0[2]) * 255.f, sigm(v0[3]) * 255.f);
                        w.y = pk4_u8(sigm(v1[0]) * 255.f, sigm(v1[1]) * 255.f, sigm(v1[2]) * 255.f, sigm(v1[3]) * 255.f);
                        *(u32x2*)(rowp + bj * HALF) = w; } }
            return;
        }
        const int col0 = u.pn * 256 + wc * 32 + 8 * fq;
#pragma unroll
        for (int ai = 0; ai < 2; ++ai)
#pragma unroll
            for (int m = 0; m < 4; ++m) { unsigned char* rowp = ws + WS_PRW + ((size_t)(row0 + ai * HALF + m * 16) * 2048 + col0) * 2;
#pragma unroll
                for (int bj = 0; bj < 2; ++bj) *(u32x4*)(rowp + bj * HALF * 2) = pack8v(acc[ai][bj][m][0], acc[ai][bj][m][1]); }
    }
};
struct EpiQraw {
    static constexpr bool PERM = true, AFTER_DRAIN = false;
    bf16_t* q; const float* ssq;
    __device__ __forceinline__ void operator()(const f32x4 (&acc)[2][2][4][2], const Unit& u, int wr, int wc, int fr_in, int fq_in) const {
        int fr = fr_in, fq = fq_in; asm volatile("" : "+v"(fr), "+v"(fq));
        const int row0 = u.pm * BM + wr * 64 + fr, col0 = u.pn * BM + wc * 32 + 8 * fq;
#pragma unroll
        for (int ai = 0; ai < 2; ++ai)
#pragma unroll
            for (int m = 0; m < 4; ++m) { const size_t row = (size_t)(row0 + ai * HALF + m * 16); const float rs = ssq[row];
#pragma unroll
                for (int bj = 0; bj < 2; ++bj) *(u32x4*)(q + row * 768 + col0 + bj * HALF) = pack8v(acc[ai][bj][m][0] * rs, acc[ai][bj][m][1] * rs); }
    }
};
struct EpiKVraw {
    static constexpr bool PERM = true, AFTER_DRAIN = false;
    bf16_t* kraw; bf16_t* vt; const float* sskv;
    __device__ __forceinline__ void operator()(const f32x4 (&acc)[2][2][4][2], const Unit& u, int wr, int wc, int fr_in, int fq_in) const {
        int fr = fr_in, fq = fq_in; asm volatile("" : "+v"(fr), "+v"(fq));
        const int row0 = u.pm * BM + wr * 64 + fr;
#pragma unroll
        for (int ai = 0; ai < 2; ++ai)
#pragma unroll
            for (int m = 0; m < 4; ++m) { const int row = row0 + ai * HALF + m * 16; const float rs = sskv[row];
#pragma unroll
                for (int bj = 0; bj < 2; ++bj) { const f32x4 v0 = acc[ai][bj][m][0] * rs, v1 = acc[ai][bj][m][1] * rs;
                    if (u.pn < 2) *(u32x4*)(kraw + (size_t)row * 512 + u.pn * BM + bj * HALF + wc * 32 + 8 * fq) = pack8v(v0, v1);
                    else { const int c = (u.pn - 2) * BM + bj * HALF + wc * 32 + 8 * fq, h = c >> 6, d = c & 63; const int bb = row >> 12, s = row & 4095;
                        const int kt = s >> 5, k4 = s & 15, jj = 4 * (k4 >> 3) + (k4 & 3), hv = (k4 >> 2) & 1;
                        bf16_t* vp = vt + ((((size_t)(bb * 8 + h) * 128 + kt) * 2 + (d >> 5)) * 2 + ((s >> 4) & 1)) * 512 + ((d & 31) + 32 * hv) * 8 + jj; const u32x4 w = pack8v(v0, v1);
                        vp[0] = (bf16_t)(w.x & 0xffffu); vp[8] = (bf16_t)(w.x >> 16); vp[16] = (bf16_t)(w.y & 0xffffu); vp[24] = (bf16_t)(w.y >> 16);
                        vp[32] = (bf16_t)(w.z & 0xffffu); vp[40] = (bf16_t)(w.z >> 16); vp[48] = (bf16_t)(w.w & 0xffffu); vp[56] = (bf16_t)(w.w >> 16); } } }
    }
};
struct EpiGate {
    static constexpr bool PERM = true, AFTER_DRAIN = false;
    bf16_t* mixed; const unsigned char* gg; int goff; int add;
    __device__ __forceinline__ void operator()(const f32x4 (&acc)[2][2][4][2], const Unit& u, int wr, int wc, int fr_in, int fq_in) const {
        int fr = fr_in, fq = fq_in; asm volatile("" : "+v"(fr), "+v"(fq));
        const int row0 = u.pm * BM + wr * 64 + fr, col0 = u.pn * BM + wc * 32 + 8 * fq;
#pragma unroll
        for (int ai = 0; ai < 2; ++ai)
#pragma unroll
            for (int m = 0; m < 4; ++m) { const size_t row = (size_t)(row0 + ai * HALF + m * 16);
#pragma unroll
                for (int bj = 0; bj < 2; ++bj) { const int col = col0 + bj * HALF;
                    const u32x2 gw = *(const u32x2*)(gg + row * 2048 + goff + col);
                    const f32x4 g0 = (f32x4){(float)(gw.x & 0xffu), (float)((gw.x >> 8) & 0xffu), (float)((gw.x >> 16) & 0xffu), (float)(gw.x >> 24)};
                    const f32x4 g1 = (f32x4){(float)(gw.y & 0xffu), (float)((gw.y >> 8) & 0xffu), (float)((gw.y >> 16) & 0xffu), (float)(gw.y >> 24)};
                    f32x4 v0 = g0 * (acc[ai][bj][m][0] * (1.f / 255.f)), v1 = g1 * (acc[ai][bj][m][1] * (1.f / 255.f));
                    if (add) { const u32x4 pw = *(const u32x4*)(mixed + row * 1024 + col);
                        v0 += (f32x4){__uint_as_float(pw.x << 16), __uint_as_float(pw.x & 0xffff0000u), __uint_as_float(pw.y << 16), __uint_as_float(pw.y & 0xffff0000u)};
                        v1 += (f32x4){__uint_as_float(pw.z << 16), __uint_as_float(pw.z & 0xffff0000u), __uint_as_float(pw.w << 16), __uint_as_float(pw.w & 0xffff0000u)}; }
                    *(u32x4*)(mixed + row * 1024 + col) = pack8v(v0, v1); } }
    }
};
struct EpiRes {
    static constexpr bool PERM = true, AFTER_DRAIN = false;
    const float* x; bf16_t* hb; float* ss2;
    __device__ __forceinline__ void operator()(const f32x4 (&acc)[2][2][4][2], const Unit& u, int wr, int wc, int fr_in, int fq_in) const {
        int fr = fr_in, fq = fq_in; asm volatile("" : "+v"(fr), "+v"(fq));
        const int row0 = u.pm * BM + wr * 64 + fr, col0 = u.pn * BM + wc * 32 + 8 * fq;
#pragma unroll
        for (int ai = 0; ai < 2; ++ai)
#pragma unroll
            for (int m = 0; m < 4; ++m) { const size_t row = (size_t)(row0 + ai * HALF + m * 16); float sq = 0.f;
#pragma unroll
                for (int bj = 0; bj < 2; ++bj) { const size_t o = row * 1024 + col0 + bj * HALF;
                    const f32x4 h0 = *(const f32x4*)(x + o) + acc[ai][bj][m][0], h1 = *(const f32x4*)(x + o + 4) + acc[ai][bj][m][1];
                    *(u32x4*)(hb + o) = pack8v(h0, h1);
                    sq += (h0[0] * h0[0] + h0[1] * h0[1]) + (h0[2] * h0[2] + h0[3] * h0[3]) + (h1[0] * h1[0] + h1[1] * h1[1]) + (h1[2] * h1[2] + h1[3] * h1[3]); }
                sq += __shfl_xor(sq, 16); sq += __shfl_xor(sq, 32);
                if (fq == 0) atomicAdd(ss2 + row, sq); }
    }
};
struct EpiScale {
    static constexpr bool PERM = true, AFTER_DRAIN = false;
    bf16_t* pq; const float* ss2;
    __device__ __forceinline__ void operator()(const f32x4 (&acc)[2][2][4][2], const Unit& u, int wr, int wc, int fr_in, int fq_in) const {
        int fr = fr_in, fq = fq_in; asm volatile("" : "+v"(fr), "+v"(fq));
        const int row0 = u.pm * BM + wr * 64 + fr, col0 = u.pn * BM + wc * 32 + 8 * fq;
#pragma unroll
        for (int ai = 0; ai < 2; ++ai)
#pragma unroll
            for (int m = 0; m < 4; ++m) { const size_t row = (size_t)(row0 + ai * HALF + m * 16); const float rs = rsqrtf(ss2[row] * (1.f / 1024.f) + 1e-6f);
#pragma unroll
                for (int bj = 0; bj < 2; ++bj) *(u32x4*)(pq + row * 2048 + col0 + bj * HALF) = pack8v(acc[ai][bj][m][0] * rs, acc[ai][bj][m][1] * rs); }
    }
};
template <class Epi, class Sched, bool ALIGN_EPI = false, bool SP2 = false>
__device__ __forceinline__ void gemm_phase(PG8_LAS unsigned char* lds, const Gemm g, const Sched& S, const Epi& E) {
    int tid_l = threadIdx.x; asm volatile("" : "+v"(tid_l));
    const int tid = tid_l, wid = __builtin_amdgcn_readfirstlane(tid >> 6), lane = tid & 63, wr = wid >> 2, wc = wid & 3, fr = lane & 15, fq = lane >> 4;
    const int K = g.K, nt = K / BK;
    unsigned voffA[2], voffB[2];
#pragma unroll
    for (int i = 0; i < 2; ++i) { int R, C; stage_rc(tid * 16 + i * 8192, R, C); const int Rb = Epi::PERM ? ((R & ~31) + perm32(R & 31)) : R;
        voffA[i] = (unsigned)(R * K + C) * 2u; voffB[i] = (unsigned)(Rb * K + C) * 2u; }
    const size_t kstep = (size_t)(BK * 2);
    const size_t hstep = (size_t)HALF * K * 2;
    const size_t tstep = 2 * hstep;
    const unsigned ldsw = (unsigned)wid * 1024u;
    const int aoff = lds_byte(wr * 64 + fr, fq * 8), boff = lds_byte(wc * 32 + fr, fq * 8);
#define PG8_SA(b, h) (((b) * 2 + (h)) * HTB)
#define PG8_SB(b, h) ((4 + (b) * 2 + (h)) * HTB)
#define PG8_STAGE(bufoff, gbase, voff) do { _Pragma("unroll") for (int _i = 0; _i < 2; ++_i) \
        __builtin_amdgcn_global_load_lds((const unsigned*)((const char*)(gbase) + (voff)[_i]), (PG8_LAS unsigned*)(lds + (bufoff) + ldsw + _i * 8192), 16, 0, 0); } while (0)
#define PG8_LDA(dst, b, h) do { _Pragma("unroll") for (int m = 0; m < 4; ++m) _Pragma("unroll") for (int k = 0; k < 2; ++k) dst[m][k] = *(const PG8_LAS bf16x8*)(lds + PG8_SA(b, h) + aoff + m * 2048 + k * 1024); } while (0)
#define PG8_LDB(dst, b, h) do { _Pragma("unroll") for (int n = 0; n < 2; ++n) _Pragma("unroll") for (int k = 0; k < 2; ++k) dst[n][k] = *(const PG8_LAS bf16x8*)(lds + PG8_SB(b, h) + boff + n * 2048 + k * 1024); } while (0)
#define PG8_MMA(ai, bj, At, Bt) do { __builtin_amdgcn_s_setprio(1); _Pragma("unroll") for (int m = 0; m < 4; ++m) _Pragma("unroll") for (int n = 0; n < 2; ++n) _Pragma("unroll") for (int k = 0; k < 2; ++k) \
        acc[ai][bj][m][n] = __builtin_amdgcn_mfma_f32_16x16x32_bf16(Bt[n][k], At[m][k], acc[ai][bj][m][n], 0, 0, 0); __builtin_amdgcn_s_setprio(0); } while (0)
#define PG8_WAIT_V(n) asm volatile("s_waitcnt vmcnt(" #n ")" ::: "memory")
#define PG8_WAIT_L(n) asm volatile("s_waitcnt lgkmcnt(" #n ")" ::: "memory")
#define PG8_BAR __builtin_amdgcn_s_barrier()
#define PG8_SCHED __builtin_amdgcn_sched_barrier(0)
    Unit cur, nxt; int ui = 0;
    if (!S.next(0, cur)) return;
    f32x4 acc[2][2][4][2];
#pragma unroll
    for (int a = 0; a < 2; ++a)
#pragma unroll
        for (int b = 0; b < 2; ++b)
#pragma unroll
            for (int m = 0; m < 4; ++m)
#pragma unroll
                for (int n = 0; n < 2; ++n) acc[a][b][m][n] = (f32x4){0.f, 0.f, 0.f, 0.f};
    bf16x8 At[4][2], B0[2][2], B1[2][2];
    const char* cA = (const char*)g.A + (size_t)cur.pm * tstep; const char* cB = (const char*)g.Bt + (size_t)cur.pn * tstep;
    S.a_ready(cur);
    if constexpr (SP2) {
        PG8_STAGE(PG8_SB(0, 0), cB, voffB); PG8_STAGE(PG8_SB(0, 1), cB + hstep, voffB); PG8_STAGE(PG8_SA(0, 0), cA, voffA); PG8_STAGE(PG8_SA(0, 1), cA + hstep, voffA);
        if (wr == 1) PG8_BAR;
        PG8_WAIT_V(2); PG8_BAR;
        PG8_STAGE(PG8_SB(1, 0), cB + kstep, voffB); PG8_STAGE(PG8_SA(1, 0), cA + kstep, voffA); PG8_STAGE(PG8_SB(1, 1), cB + hstep + kstep, voffB);
        PG8_WAIT_V(6); PG8_BAR;
    } else {
        PG8_STAGE(PG8_SB(0, 0), cB, voffB); PG8_STAGE(PG8_SA(0, 0), cA, voffA); PG8_STAGE(PG8_SB(0, 1), cB + hstep, voffB); PG8_STAGE(PG8_SA(0, 1), cA + hstep, voffA);
        if (wr == 1) PG8_BAR;
        PG8_WAIT_V(4); PG8_BAR;
        PG8_STAGE(PG8_SB(1, 0), cB + kstep, voffB); PG8_STAGE(PG8_SA(1, 0), cA + kstep, voffA); PG8_STAGE(PG8_SB(1, 1), cB + hstep + kstep, voffB);
        PG8_WAIT_V(6); PG8_BAR;
    }
    for (;;) {
        const bool has_next = S.next(ui + 1, nxt);
        const char* nA = has_next ? (const char*)g.A + (size_t)nxt.pm * tstep : cA; const char* nB = has_next ? (const char*)g.Bt + (size_t)nxt.pn * tstep : cB;
        for (int t = 0; t < nt; t += 2) {
            const bool last = (t == nt - 2);
            const char* a1 = cA + (size_t)(t + 1) * kstep;
            const char* a2 = last ? nA : cA + (size_t)(t + 2) * kstep; const char* b2 = last ? nB : cB + (size_t)(t + 2) * kstep;
            const char* a3 = a2 + kstep; const char* b3 = b2 + kstep;
            if (last && has_next) S.a_ready(nxt);
            if constexpr (SP2) {
            PG8_LDB(B0, 0, 0); PG8_LDB(B1, 0, 1); PG8_SCHED; PG8_LDA(At, 0, 0); PG8_STAGE(PG8_SA(1, 1), a1 + hstep, voffA);
            PG8_WAIT_V(8); PG8_WAIT_L(0); PG8_BAR; PG8_MMA(0, 0, At, B0); PG8_MMA(0, 1, At, B1); PG8_BAR; PG8_SCHED;
            PG8_LDA(At, 0, 1); PG8_STAGE(PG8_SB(0, 0), b2, voffB); PG8_STAGE(PG8_SB(0, 1), b2 + hstep, voffB); PG8_STAGE(PG8_SA(0, 0), a2, voffA);
            PG8_WAIT_V(8); PG8_WAIT_L(0); PG8_BAR; PG8_MMA(1, 0, At, B0); PG8_MMA(1, 1, At, B1); PG8_BAR; PG8_SCHED;
            PG8_LDB(B0, 1, 0); PG8_LDB(B1, 1, 1); PG8_SCHED; PG8_LDA(At, 1, 0); PG8_STAGE(PG8_SA(0, 1), a2 + hstep, voffA);
            PG8_WAIT_V(8); PG8_WAIT_L(0); PG8_BAR; PG8_MMA(0, 0, At, B0); PG8_MMA(0, 1, At, B1); PG8_BAR; PG8_SCHED;
            PG8_LDA(At, 1, 1); PG8_STAGE(PG8_SB(1, 0), b3, voffB); PG8_STAGE(PG8_SB(1, 1), b3 + hstep, voffB); PG8_STAGE(PG8_SA(1, 0), a3, voffA);
            PG8_WAIT_V(8); PG8_WAIT_L(0); PG8_BAR; PG8_MMA(1, 0, At, B0); PG8_MMA(1, 1, At, B1); PG8_BAR; PG8_SCHED;
            } else {
            PG8_LDB(B0, 0, 0); PG8_SCHED; PG8_LDA(At, 0, 0); PG8_STAGE(PG8_SA(1, 1), a1 + hstep, voffA);
            PG8_WAIT_L(8); PG8_BAR; PG8_WAIT_L(0); PG8_MMA(0, 0, At, B0); PG8_BAR; PG8_SCHED;
            PG8_LDB(B1, 0, 1); PG8_STAGE(PG8_SB(0, 0), b2, voffB);
            PG8_BAR; PG8_WAIT_L(0); PG8_MMA(0, 1, At, B1); PG8_BAR;
            PG8_LDA(At, 0, 1); PG8_STAGE(PG8_SA(0, 0), a2, voffA);
            PG8_BAR; PG8_WAIT_L(0); PG8_MMA(1, 0, At, B0); PG8_BAR; PG8_SCHED;
            PG8_STAGE(PG8_SB(0, 1), b2 + hstep, voffB);
            PG8_WAIT_V(6); PG8_BAR; PG8_MMA(1, 1, At, B1); PG8_BAR;
            PG8_LDB(B0, 1, 0); PG8_SCHED; PG8_LDA(At, 1, 0); PG8_STAGE(PG8_SA(0, 1), a2 + hstep, voffA);
            PG8_WAIT_L(8); PG8_BAR; PG8_WAIT_L(0); PG8_MMA(0, 0, At, B0); PG8_BAR; PG8_SCHED;
            PG8_LDB(B1, 1, 1); PG8_STAGE(PG8_SB(1, 0), b3, voffB);
            PG8_BAR; PG8_WAIT_L(0); PG8_MMA(0, 1, At, B1); PG8_BAR;
            PG8_LDA(At, 1, 1); PG8_STAGE(PG8_SA(1, 0), a3, voffA);
            PG8_BAR; PG8_WAIT_L(0); PG8_MMA(1, 0, At, B0); PG8_BAR; PG8_SCHED;
            PG8_STAGE(PG8_SB(1, 1), b3 + hstep, voffB);
            PG8_WAIT_V(6); PG8_BAR; PG8_MMA(1, 1, At, B1); PG8_BAR;
            }
        }
        if constexpr (ALIGN_EPI) { if (wr == 0) PG8_BAR; }
        if constexpr (!Epi::AFTER_DRAIN) { E(acc, cur, wr, wc, fr, fq); S.done(cur); }
        if (!has_next) break;
#pragma unroll
        for (int a = 0; a < 2; ++a)
#pragma unroll
            for (int b = 0; b < 2; ++b)
#pragma unroll
                for (int m = 0; m < 4; ++m)
#pragma unroll
                    for (int n = 0; n < 2; ++n) acc[a][b][m][n] = (f32x4){0.f, 0.f, 0.f, 0.f};
        cur = nxt; cA = nA; cB = nB; ++ui;
        if constexpr (ALIGN_EPI) { if (wr == 1) PG8_BAR; }
    }
    PG8_WAIT_V(0);
    if constexpr (!ALIGN_EPI) { if (wr == 0) PG8_BAR; }
    PG8_BAR;
    if constexpr (Epi::AFTER_DRAIN) { E.fused(acc, cur, wr, wc, fr, fq, lds, wid, lane); S.done(cur); }
#undef PG8_SA
#undef PG8_SB
#undef PG8_STAGE
#undef PG8_LDA
#undef PG8_LDB
#undef PG8_MMA
#undef PG8_WAIT_V
#undef PG8_WAIT_L
#undef PG8_BAR
#undef PG8_SCHED
}
}


#define RLX_AGENT __ATOMIC_RELAXED, __HIP_MEMORY_SCOPE_AGENT
#define XB_TMO      128
#define XB_XCNT(j)  (256  + 64 * (j))
#define XB_XSUB(j)  (1280 + 64 * (j))
#define XB_XGEN(j)  (2304 + 64 * (j))
#define XB_TOP      3328
#define XB_TOPGEN   3392
#define XCD_BAR_WORDS 3456
#define XB_SPIN_CAP (1u << 18)

__device__ __forceinline__ unsigned xb_ld(unsigned* p)              { return __hip_atomic_load(p, __ATOMIC_RELAXED, __HIP_MEMORY_SCOPE_AGENT); }
__device__ __forceinline__ unsigned xb_add(unsigned* p, unsigned v) { return __hip_atomic_fetch_add(p, v, __ATOMIC_RELAXED, __HIP_MEMORY_SCOPE_AGENT); }
__device__ __forceinline__ unsigned xb_xcc_id() { return (unsigned)__builtin_amdgcn_s_getreg((3 << 11) | 20) & 0xFu; }
#define XB_SPIN(cond, bar) do { unsigned _sp = 0; while (cond) { __builtin_amdgcn_s_sleep(1); \
    if ((++_sp & 255u) == 0u) { if (xb_ld(&(bar)[XB_TMO])) break; if (_sp > XB_SPIN_CAP) { atomicAdd(&(bar)[XB_TMO], 1u); break; } } } } while (0)

struct XcdBarrier {
    unsigned* bar; unsigned x;
    volatile LAS unsigned* st;
};

__device__ __forceinline__ XcdBarrier xcd_barrier_post(unsigned* bar, volatile LAS unsigned* st) {
    XcdBarrier b; b.bar = bar; b.x = xb_xcc_id(); b.st = st;
    if (threadIdx.x == 0) (void)xb_add(&bar[XB_XCNT(b.x)], 1u);
    return b;
}
__device__ __forceinline__ void xcd_barrier_complete(unsigned* bar, unsigned x, unsigned& nloc, unsigned& nx) {
    const unsigned G = gridDim.x * gridDim.y * gridDim.z;
    unsigned sum, cnt, mine, sp = 0u;
    for (;;) {
        sum = 0u; cnt = 0u; mine = 0u;
#pragma unroll
        for (unsigned j = 0; j < 16; ++j) { const unsigned c = xb_ld(&bar[XB_XCNT(j)]); sum += c; cnt += (c > 0u) ? 1u : 0u; mine = (j == x) ? c : mine; }
        if (sum == G) break;
        __builtin_amdgcn_s_sleep(1);
        if ((++sp & 255u) == 0u) { if (xb_ld(&bar[XB_TMO])) break; if (sp > XB_SPIN_CAP) { atomicAdd(&bar[XB_TMO], 1u); break; } }
    }
    nloc = mine > 0u ? mine : 1u; nx = cnt > 0u ? cnt : 1u;
}

__device__ __forceinline__ void xcd_barrier(const XcdBarrier& b) {
    asm volatile("s_waitcnt vmcnt(0)" ::: "memory");
    __syncthreads();
    if (threadIdx.x == 0) {
        unsigned* bar = b.bar;
        __builtin_amdgcn_s_waitcnt(0);
        unsigned nloc = b.st[0], nx = b.st[1];
        if (nloc == 0u) { xcd_barrier_complete(bar, b.x, nloc, nx); b.st[0] = nloc; b.st[1] = nx; }
        const unsigned old = xb_add(&bar[XB_XSUB(b.x)], 1u);
        const unsigned gen = old / nloc;
        if (old + 1u == (gen + 1u) * nloc) {
            __builtin_amdgcn_fence(__ATOMIC_RELEASE, "agent");
            asm volatile("s_waitcnt vmcnt(0)" ::: "memory");
            const unsigned og = xb_add(&bar[XB_TOP], 1u);
            const unsigned tg = og / nx;
            if (og + 1u == (tg + 1u) * nx) xb_add(&bar[XB_TOPGEN], 1u);
            else XB_SPIN(xb_ld(&bar[XB_TOPGEN]) == tg, bar);
            __builtin_amdgcn_fence(__ATOMIC_ACQUIRE, "agent");
            xb_add(&bar[XB_XGEN(b.x)], 1u);
            asm volatile("s_waitcnt vmcnt(0)" ::: "memory");
        } else {
            XB_SPIN(xb_ld(&bar[XB_XGEN(b.x)]) == gen, bar);
            __builtin_amdgcn_fence(__ATOMIC_ACQUIRE, "agent");
            asm volatile("s_waitcnt vmcnt(0)" ::: "memory");
        }
    }
    __syncthreads();
}

DEVI void transpose_item(const float* __restrict__ W, int ldw, int c0, bf16_t* WT, int ldk, int r0, int Kmax, int kb, int nb, const float* kscale, float* scr, int lane, int fragKS = 0) {
    const int k0 = 64 * kb, n0 = 32 * nb;
#pragma unroll 8
    for (int i = 0; i < 32; ++i) {
        const int kk = 2 * i + (lane >> 5);
        float v = 0.f;
        if (k0 + kk < Kmax) { v = W[(size_t)(k0 + kk) * ldw + c0 + n0 + (lane & 31)]; if (kscale) v *= kscale[k0 + kk]; }
        scr[kk * 33 + (lane & 31)] = v;
    }
    asm volatile("s_waitcnt lgkmcnt(0)" ::: "memory");
    asm volatile("" ::: "memory");
    const int c = lane & 7;
    if (k0 + 8 * c < Kmax) {
#pragma unroll
        for (int j = 0; j < 4; ++j) {
            const int n = (lane >> 3) + 8 * j;
            const float* s = scr + (8 * c) * 33 + n;
            u32x4 o; o.x = pk2(s[0], s[33]); o.y = pk2(s[66], s[99]); o.z = pk2(s[132], s[165]); o.w = pk2(s[198], s[231]);
            if (fragKS > 0) { const int row = r0 + n0 + n, k = k0 + 8 * c, hd = row >> 6, rr = row & 63;
                *(u32x4*)(WT + ((size_t)(((hd * fragKS + (k >> 5)) * 4 + ((rr >> 2) & 3)) * 64 + ((k >> 3) & 3) * 16 + 4 * (rr >> 4) + (rr & 3))) * 8) = o; }
            else *(u32x4*)(WT + (size_t)(r0 + n0 + n) * ldk + k0 + 8 * c) = o;
        }
    }
    asm volatile("s_waitcnt lgkmcnt(0)" ::: "memory");
    asm volatile("" ::: "memory");
}


DEVI void wcomb_item(const float* __restrict__ Wq, const float* __restrict__ Sk, const float* __restrict__ n2w, bf16_t* WcT, int it, int lane) {
    const int fr = lane & 15, fq = lane >> 4;
    const int hp = it >> 6, nt = (it >> 4) & 3, kt = it & 15;
    const float* ap = Sk + ((size_t)hp * 128 + nt * 32 + fr) * 128 + fq * 8;
    const float* bp = Wq + (size_t)(kt * 64 + fr) * 2048 + hp * 128 + fq * 8;
    f32x4 acc[2][4];
#pragma unroll
    for (int m = 0; m < 2; ++m)
#pragma unroll
        for (int n = 0; n < 4; ++n) acc[m][n] = (f32x4){0.f, 0.f, 0.f, 0.f};
#pragma unroll
    for (int k0 = 0; k0 < 128; k0 += 32) {
        bf16x8 a[2], b[4];
#pragma unroll
        for (int m = 0; m < 2; ++m) { const f32x4 lo = *(const f32x4*)(ap + (size_t)m * 16 * 128 + k0), hi = *(const f32x4*)(ap + (size_t)m * 16 * 128 + k0 + 4);
            u32x4 w; w.x = pk2(lo.x, lo.y); w.y = pk2(lo.z, lo.w); w.z = pk2(hi.x, hi.y); w.w = pk2(hi.z, hi.w); a[m] = __builtin_bit_cast(bf16x8, w); }
#pragma unroll
        for (int n = 0; n < 4; ++n) { const f32x4 lo = *(const f32x4*)(bp + (size_t)n * 16 * 2048 + k0), hi = *(const f32x4*)(bp + (size_t)n * 16 * 2048 + k0 + 4);
            u32x4 w; w.x = pk2(lo.x, lo.y); w.y = pk2(lo.z, lo.w); w.z = pk2(hi.x, hi.y); w.w = pk2(hi.z, hi.w); b[n] = __builtin_bit_cast(bf16x8, w); }
#pragma unroll
        for (int m = 0; m < 2; ++m)
#pragma unroll
            for (int n = 0; n < 4; ++n) acc[m][n] = mfma16(b[n], a[m], acc[m][n]);
    }
#pragma unroll
    for (int n = 0; n < 4; ++n) {
        const int col = kt * 64 + 16 * n + 4 * fq; const f32x4 w = *(const f32x4*)(n2w + col);
#pragma unroll
        for (int m = 0; m < 2; ++m) { const int row = hp * 128 + nt * 32 + 16 * m + fr; st_bf4(WcT + (size_t)row * 1024 + col, acc[m][n][0] * w.x, acc[m][n][1] * w.y, acc[m][n][2] * w.z, acc[m][n][3] * w.w); }
    }
}

DEVI int peer_pair(int s) {
    if (s < 16) return s;
    if (s < 24) return 16 + (s - 16);
    if (s < 29) return 32 + (s - 24);
    if (s < 33) return 48 + (s - 29);
    if (s < 36) return 64 + (s - 33);
    if (s < 42) return 80 + 16 * ((s - 36) >> 1) + ((s - 36) & 1);
    if (s < 50) return 128 + 16 * (s - 42);
    return -1;
}

#define KARG __attribute__((address_space(4)))
DEVI const KARG Params* kargs() { unsigned long long k = (unsigned long long)__builtin_amdgcn_kernarg_segment_ptr(); asm volatile("" : "+s"(k)); return (const KARG Params*)k; }
#define PHASE_PTRS \
    int tid_l_ = threadIdx.x; asm volatile("" : "+v"(tid_l_)); \
    [[maybe_unused]] const int tid = tid_l_, lane = tid & 63, wave = __builtin_amdgcn_readfirstlane(tid >> 6), gw = blockIdx.x * NWAVES + wave, fr = lane & 15, fq = lane >> 4; \
    const KARG Params* kp = kargs(); unsigned char* ws = kp->ws; unsigned char* dob = (unsigned char*)kp->out; (void)ws; (void)dob; \
    [[maybe_unused]] const float* x = kp->in[0]; [[maybe_unused]] const int* positions = (const int*)kp->in[1]; [[maybe_unused]] const float* norm1_w = kp->in[2]; [[maybe_unused]] const float* w_in = kp->in[3]; \
    [[maybe_unused]] const float* rw_mu = kp->in[4]; [[maybe_unused]] const float* rw_w0 = kp->in[5]; [[maybe_unused]] const float* rw_a0 = kp->in[7]; [[maybe_unused]] const float* rw_k_k = kp->in[10]; \
    [[maybe_unused]] const float* rw_k_a = kp->in[11]; [[maybe_unused]] const float* rw_r_k = kp->in[12]; [[maybe_unused]] const float* rw_ln_w = kp->in[13]; [[maybe_unused]] const float* rw_ln_b = kp->in[14]; \
    [[maybe_unused]] const float* q_norm_w = kp->in[16]; [[maybe_unused]] const float* kv_norm_w = kp->in[18]; [[maybe_unused]] const float* qn_nope_w = kp->in[20]; [[maybe_unused]] const float* qn_pe_w = kp->in[21]; \
    [[maybe_unused]] const float* kn_nope_w = kp->in[22]; [[maybe_unused]] const float* kn_pe_w = kp->in[23]; [[maybe_unused]] const float* norm2_w = kp->in[26]; \
    [[maybe_unused]] float* ss2 = (float*)(ws + WS_SS2); [[maybe_unused]] unsigned* cnt = (unsigned*)(ws + WS_CNT); [[maybe_unused]] unsigned* xbar_words = (unsigned*)(ws + WS_CNT + 4096); \
    [[maybe_unused]] bf16_t* WinT = (bf16_t*)(ws + WS_WIN); [[maybe_unused]] bf16_t* WuqT = (bf16_t*)(ws + WS_WUQ); [[maybe_unused]] bf16_t* WukvT = (bf16_t*)(ws + WS_WUKV); [[maybe_unused]] bf16_t* RwoT = (bf16_t*)(ws + WS_RWO); \
    [[maybe_unused]] bf16_t* MwoT = (bf16_t*)(ws + WS_MWO); [[maybe_unused]] bf16_t* WoutT = (bf16_t*)(ws + WS_WOUT); [[maybe_unused]] bf16_t* PwqT = (bf16_t*)(ws + WS_PWQ); [[maybe_unused]] bf16_t* SubK = (bf16_t*)(ws + WS_SUBK); \
    [[maybe_unused]] bf16_t* W2T = (bf16_t*)(ws + WS_W2T); [[maybe_unused]] bf16_t* A2T = (bf16_t*)(ws + WS_A2T); [[maybe_unused]] bf16_t* G2T = (bf16_t*)(ws + WS_G2T); [[maybe_unused]] const unsigned char* Gg = ws + WS_G; \
    [[maybe_unused]] bf16_t* Prw = (bf16_t*)(ws + WS_PRW); [[maybe_unused]] bf16_t* QD = (bf16_t*)(ws + WS_QD); [[maybe_unused]] bf16_t* KVD = (bf16_t*)(ws + WS_KVD); [[maybe_unused]] bf16_t* KPE = (bf16_t*)(ws + WS_KPE); \
    [[maybe_unused]] float* ssq = (float*)(ws + WS_SSQ); [[maybe_unused]] float* sskv = (float*)(ws + WS_SSKV); [[maybe_unused]] bf16_t* XN = (bf16_t*)(dob + DO_XN); \
    [[maybe_unused]] bf16_t* Rb = (bf16_t*)(ws + WS_R); [[maybe_unused]] bf16_t* Wb = (bf16_t*)(ws + WS_W); [[maybe_unused]] bf16_t* Kb = (bf16_t*)(ws + WS_KS); [[maybe_unused]] bf16_t* Vb = (bf16_t*)(ws + WS_V); [[maybe_unused]] bf16_t* KKb = (bf16_t*)(ws + WS_KK); \
    [[maybe_unused]] bf16_t* Bvb = (bf16_t*)(dob + DO_BV); [[maybe_unused]] bf16_t* Gtb = (bf16_t*)(dob + DO_GT); [[maybe_unused]] float* bonus = (float*)(dob + DO_BONUS); [[maybe_unused]] bf16_t* Yb = (bf16_t*)(dob + DO_Y); \
    [[maybe_unused]] bf16_t* Qb = (bf16_t*)(ws + WS_Q); [[maybe_unused]] bf16_t* Kab = (bf16_t*)(ws + WS_K); [[maybe_unused]] bf16_t* Vt = (bf16_t*)(ws + WS_VT); [[maybe_unused]] bf16_t* Kraw = (bf16_t*)(dob + DO_KRAW); \
    [[maybe_unused]] bf16_t* Ob = (bf16_t*)(ws + WS_O); [[maybe_unused]] bf16_t* YA = (bf16_t*)(ws + WS_YA); [[maybe_unused]] bf16_t* MIXED = (bf16_t*)(ws + WS_MIXED); [[maybe_unused]] bf16_t* HB = (bf16_t*)(ws + WS_HB); \
    [[maybe_unused]] bf16_t* UB = (bf16_t*)(ws + WS_UB); [[maybe_unused]] bf16_t* VBp = (bf16_t*)(ws + WS_VB); [[maybe_unused]] bf16_t* PQ = (bf16_t*)(ws + WS_PQ); [[maybe_unused]] bf16_t* SC = (bf16_t*)(ws + WS_SC);

__global__ void __launch_bounds__(NT, 2) mega(Params p) {
    extern __shared__ __attribute__((aligned(16))) unsigned char lds[];
    cg::grid_group grid = cg::this_grid();
    const int G = gridDim.x, NGW = G * NWAVES;
    volatile LAS unsigned* bst = (volatile LAS unsigned*)((LAS unsigned char*)lds + LDS_BYTES - 16);
    if (threadIdx.x < 2) bst[threadIdx.x] = 0u;
    if (threadIdx.x >= 8 && threadIdx.x < 16) ((volatile LAS unsigned*)((LAS unsigned char*)lds + LDS_BYTES - 64))[threadIdx.x - 8] = 0u;
    if (threadIdx.x >= 16 && threadIdx.x < 32) ((volatile LAS unsigned*)((LAS unsigned char*)lds + LDS_BYTES - 128))[threadIdx.x - 16] = 0u;
    __syncthreads();
    if (kargs()->ws == nullptr) grid.sync();
    const XcdBarrier xb = xcd_barrier_post((unsigned*)(kargs()->ws + WS_CNT + 4096), bst);

    {
        PHASE_PTRS
        for (int i = blockIdx.x * NT + tid; i < T; i += G * NT) ss2[i] = 0.f;
        for (int t = gw; t < T; t += NGW) {
            const f32x4* xr = (const f32x4*)(x + (size_t)t * DM) + lane;
            f32x4 v[4]; float s = 0.f;
#pragma unroll
            for (int j = 0; j < 4; ++j) { v[j] = xr[64 * j]; s += v[j].x * v[j].x + v[j].y * v[j].y + v[j].z * v[j].z + v[j].w * v[j].w; }
            const float rstd = rsqrtf(wave_sum(s) * (1.f / DM) + EPS);
            const f32x4* wr = (const f32x4*)norm1_w + lane;
#pragma unroll
            for (int j = 0; j < 4; ++j) { const f32x4 w = wr[64 * j]; st_bf4(XN + (size_t)t * DM + (lane + 64 * j) * 4, v[j].x * rstd * w.x, v[j].y * rstd * w.y, v[j].z * rstd * w.z, v[j].w * rstd * w.w); }
        }
        float* scr = (float*)lds + wave * (64 * 33);
        int it = gw;
#define TR_SEG(W_, ldw_, c0_, WT_, ldk_, r0_, Kmax_, nkb_, nnb_, ksc_) \
        { const int cntI = (nkb_) * (nnb_); for (; it < cntI; it += NGW) transpose_item(W_, ldw_, c0_, WT_, ldk_, r0_, Kmax_, it / (nnb_), it % (nnb_), ksc_, scr, lane); it -= cntI; }
        TR_SEG(w_in, 4544, 0, WinT, 1024, 0, 1024, 16, 57, nullptr)
        TR_SEG(w_in, 4544, 1824, WinT, 1024, 2048, 1024, 16, 21, nullptr)
        TR_SEG(w_in, 4544, 2496, WinT, 1024, 2816, 1024, 16, 64, nullptr)
#define TR_SEGF(W_, ldw_, WT_, Kmax_, nkb_, nnb_, fks_) \
        { const int cntI = (nkb_) * (nnb_); for (; it < cntI; it += NGW) transpose_item(W_, ldw_, 0, WT_, 0, 0, Kmax_, it / (nnb_), it % (nnb_), nullptr, scr, lane, fks_); it -= cntI; }
        TR_SEGF(kp->in[6], 512, W2T, 64, 1, 16, 2)
        TR_SEGF(kp->in[8], 512, A2T, 64, 1, 16, 2)
        TR_SEGF(kp->in[9], 512, G2T, 160, 3, 16, 5)
#undef TR_SEGF
#pragma unroll 1
        for (int hh = 0; hh < 8; ++hh) {
            TR_SEG(kp->in[17], 768, hh * 96, WuqT, 384, hh * 64, 384, 6, 2, q_norm_w)
            TR_SEG(kp->in[17], 768, hh * 96 + 64, WuqT, 384, 512 + hh * 32, 384, 6, 1, q_norm_w)
            TR_SEG(kp->in[19], 1024, hh * 128, WukvT, 256, hh * 64, 256, 4, 2, kv_norm_w)
            TR_SEG(kp->in[19], 1024, hh * 128 + 64, WukvT, 256, 512 + hh * 64, 256, 4, 2, kv_norm_w)
        }
        TR_SEG(kp->in[15], 1024, 0, RwoT, 512, 0, 512, 8, 32, nullptr)
        TR_SEG(kp->in[24], 1024, 0, MwoT, 512, 0, 512, 8, 32, nullptr)
        TR_SEG(kp->in[25], 1024, 0, WoutT, 1024, 0, 1024, 16, 32, nullptr)
#undef TR_SEG
        for (; it < 1024; it += NGW) wcomb_item(kp->in[27], kp->in[28], norm2_w, PwqT, it, lane);
        for (int i = blockIdx.x * NT + tid; i < (224 + 96) * 128; i += G * NT) {
            const int r = i >> 7, c = i & 127; const int row = r < 224 ? 1824 + r : 2720 + (r - 224);
            *(u32x4*)(WinT + (size_t)row * 1024 + c * 8) = (u32x4){0u, 0u, 0u, 0u};
        }
    }
    xcd_barrier(xb);

    {
        PHASE_PTRS
        pg8::Gemm g{XN, WinT, T, 4864, DM}; pg8::StaticOrder S; S.init(T, 4864, G, (int)blockIdx.x);
        pg8::EpiP1 E{ws};
        pg8::gemm_phase<pg8::EpiP1, pg8::StaticOrder, true, true>((PG8_LAS unsigned char*)lds, g, S, E);
    }
    xcd_barrier(xb);


    {
        PHASE_PTRS
        for (int t = gw; t < T; t += NGW) {
            float a6[8]; ld_bf8(QD + (size_t)t * 384 + 8 * (lane & 47), a6); float s = 0.f;
#pragma unroll
            for (int i = 0; i < 8; ++i) s += a6[i] * a6[i];
            if (lane >= 48) s = 0.f;
            float b4[4]; ld_bf4(KVD + (size_t)t * 256 + 4 * lane, b4); const float s2 = (b4[0] * b4[0] + b4[1] * b4[1]) + (b4[2] * b4[2] + b4[3] * b4[3]);
            const float sq = wave_sum(s), skv = wave_sum(s2);
            if (lane == 0) { ssq[t] = rsqrtf(sq * (1.f / 384.f) + EPS); sskv[t] = rsqrtf(skv * (1.f / 256.f) + EPS); }
        }
    }
    {
        PHASE_PTRS
        LAS bf16_t* MIX = (LAS bf16_t*)lds; LAS bf16_t* LOR = (LAS bf16_t*)((LAS unsigned char*)lds + 49152);
        for (int tt = blockIdx.x; tt < T / 16; tt += G) {
            int h = wave; asm volatile("" : "+s"(h));
            __syncthreads();
            {
                u32x4 pw[8], ppw[8];
#pragma unroll
                for (int u = 0; u < 8; ++u) {
                    const int ci = tid + u * NT < 16 * 228 ? tid + u * NT : 16 * 228 - 1; const int row = ci / 228, cc = (ci - row * 228) * 8; const int tk = tt * 16 + row;
                    pw[u] = *(const u32x4*)(Prw + (size_t)tk * 2048 + cc);
                    ppw[u] = *(const u32x4*)(Prw + (size_t)((tk & (SEQ - 1)) != 0 ? tk - 1 : tk) * 2048 + cc);
                }
                __builtin_amdgcn_sched_barrier(0);
#pragma unroll
                for (int u = 0; u < 8; ++u) {
                    const int ci = tid + u * NT; if (ci < 16 * 228) {
                        const int row = ci / 228, cc = (ci - row * 228) * 8; const bool hp_ = ((tt * 16 + row) & (SEQ - 1)) != 0;
                        const float pv[8] = {bflo(pw[u].x), bfhi(pw[u].x), bflo(pw[u].y), bfhi(pw[u].y), bflo(pw[u].z), bfhi(pw[u].z), bflo(pw[u].w), bfhi(pw[u].w)};
                        float ppv[8] = {bflo(ppw[u].x), bfhi(ppw[u].x), bflo(ppw[u].y), bfhi(ppw[u].y), bflo(ppw[u].z), bfhi(ppw[u].z), bflo(ppw[u].w), bfhi(ppw[u].w)};
                        if (!hp_) {
#pragma unroll
                            for (int j = 0; j < 8; ++j) ppv[j] = 0.f; }
                        const f32x4 mu0 = *(const f32x4*)(rw_mu + cc), mu1 = *(const f32x4*)(rw_mu + cc + 4); float xm[8];
#pragma unroll
                        for (int j = 0; j < 8; ++j) { const float mu = j < 4 ? mu0[j & 3] : mu1[j & 3]; const float v = pv[j] + mu * (ppv[j] - pv[j]);
                            xm[j] = cc < 1600 ? (cc < 1536 ? v : tanhf_(v)) : (cc < 1664 ? v : sigmoidf_(v)); }
                        if (cc < 1536) *(LAS bf16x8*)(MIX + row * 1536 + cc) = pack8(xm); else *(LAS bf16x8*)(LOR + row * 288 + (cc - 1536)) = pack8(xm);
                    }
                }
            }
            __syncthreads();
            const int tok = tt * 16 + fr;
            f32x4 accw[4], acca[4], accg[4];
#pragma unroll
            for (int n = 0; n < 4; ++n) { accw[n] = (f32x4){0.f, 0.f, 0.f, 0.f}; acca[n] = accw[n]; accg[n] = accw[n]; }
#define LORA_STEP(lcol_, Wt_, KS_, ks_, accv_) { \
                const bf16x8 a = *(const LAS bf16x8*)(LOR + fr * 288 + (lcol_) + 8 * fq); \
                _Pragma("unroll") for (int n = 0; n < 4; ++n) { const bf16x8 b = *(const bf16x8*)((Wt_) + ((size_t)(((h * (KS_) + (ks_)) * 4 + n) * 64 + lane)) * 8); accv_[n] = mfma16(b, a, accv_[n]); } }
#pragma unroll
            for (int ks = 0; ks < 2; ++ks) LORA_STEP(32 * ks, W2T, 2, ks, accw)
#pragma unroll
            for (int ks = 0; ks < 2; ++ks) LORA_STEP(64 + 32 * ks, A2T, 2, ks, acca)
#pragma unroll
            for (int ks = 0; ks < 5; ++ks) LORA_STEP(128 + 32 * ks, G2T, 5, ks, accg)
#undef LORA_STEP
            float kkv[4][4], av[4][4]; float ssq = 0.f, bon = 0.f;
            u32x2 Rp[4], Wp[4], Kp[4], Vp[4], Gp[4];
#pragma unroll
            for (int n = 0; n < 4; ++n) {
                const int ch = 64 * h + 16 * fq + 4 * n;
                float r4[4], k4[4], v4[4];
#pragma unroll
                for (int seg = 0; seg < 3; ++seg) {
                    const u32x2 w = *(const LAS u32x2*)(MIX + fr * 1536 + seg * 512 + ch);
                    const float m4[4] = {bflo(w.x), bfhi(w.x), bflo(w.y), bfhi(w.y)};
#pragma unroll
                    for (int i = 0; i < 4; ++i) { if (seg == 0) r4[i] = m4[i]; else if (seg == 1) k4[i] = m4[i]; else v4[i] = m4[i]; }
                }
                const f32x4 w0 = *(const f32x4*)(rw_w0 + ch), a0 = *(const f32x4*)(rw_a0 + ch), kkw = *(const f32x4*)(rw_k_k + ch), kaw = *(const f32x4*)(rw_k_a + ch), rkw = *(const f32x4*)(rw_r_k + ch);
                float dd[4], kf[4];
#pragma unroll
                for (int i = 0; i < 4; ++i) {
                    const float z = -(w0[i] + accw[n][i]);
                    const float sp = z > 20.f ? z : __logf(1.f + __expf(z));
                    const float wlog = -sp - 0.5f;
                    dd[i] = -__expf(wlog);
                    const float a = sigmoidf_(a0[i] + acca[n][i]); av[n][i] = a;
                    kkv[n][i] = k4[i] * kkw[i]; ssq += kkv[n][i] * kkv[n][i];
                    kf[i] = k4[i] * (1.f + (a - 1.f) * kaw[i]);
                    bon += r4[i] * kf[i] * rkw[i];
                }
                Rp[n] = (u32x2){pk2(r4[0], r4[1]), pk2(r4[2], r4[3])}; Wp[n] = (u32x2){pk2(dd[0], dd[1]), pk2(dd[2], dd[3])}; Kp[n] = (u32x2){pk2(kf[0], kf[1]), pk2(kf[2], kf[3])};
                Vp[n] = (u32x2){pk2(v4[0], v4[1]), pk2(v4[2], v4[3])}; Gp[n] = (u32x2){pk2(accg[n][0], accg[n][1]), pk2(accg[n][2], accg[n][3])};
            }
            const size_t o = (size_t)tok * 512 + 64 * h + 16 * fq;
#define ST16(P_, X_) { *(u32x4*)((P_) + o) = (u32x4){X_[0].x, X_[0].y, X_[1].x, X_[1].y}; *(u32x4*)((P_) + o + 8) = (u32x4){X_[2].x, X_[2].y, X_[3].x, X_[3].y}; }
            ST16(Rb, Rp) ST16(Wb, Wp) ST16(Kb, Kp) ST16(Vb, Vp) ST16(Gtb, Gp)
            ssq += __shfl_xor(ssq, 16); ssq += __shfl_xor(ssq, 32);
            bon += __shfl_xor(bon, 16); bon += __shfl_xor(bon, 32);
            const float inv = 1.f / fmaxf(sqrtf(ssq), 1e-12f);
            u32x2 KKp[4], Bp[4];
#pragma unroll
            for (int n = 0; n < 4; ++n) {
                float kk[4], bb[4];
#pragma unroll
                for (int i = 0; i < 4; ++i) { kk[i] = kkv[n][i] * inv; bb[i] = kk[i] * av[n][i]; }
                KKp[n] = (u32x2){pk2(kk[0], kk[1]), pk2(kk[2], kk[3])}; Bp[n] = (u32x2){pk2(bb[0], bb[1]), pk2(bb[2], bb[3])};
            }
            ST16(KKb, KKp) ST16(Bvb, Bp)
#undef ST16
            if (fq == 0) bonus[(size_t)tok * 8 + h] = bon;
        }
    }
    xcd_barrier(xb);

    {
        PHASE_PTRS
        { int Kq = 384; asm volatile("" : "+s"(Kq));
          pg8::Gemm g{QD, WuqT, T, 768, Kq}; pg8::StaticOrder S; S.init(T, 768, G, (int)blockIdx.x); pg8::EpiQraw E{Qb, ssq};
          pg8::gemm_phase<pg8::EpiQraw, pg8::StaticOrder, true, true>((PG8_LAS unsigned char*)lds, g, S, E); }
        { int Kkv = 256; asm volatile("" : "+s"(Kkv));
          pg8::Gemm g{KVD, WukvT, T, 1024, Kkv}; pg8::StaticOrder S; S.init(T, 1024, G, (int)blockIdx.x); pg8::EpiKVraw E{Kraw, Vt, sskv};
          pg8::gemm_phase<pg8::EpiKVraw, pg8::StaticOrder, true, true>((PG8_LAS unsigned char*)lds, g, S, E); }
    }
    xcd_barrier(xb);
    {
        PHASE_PTRS
        for (int t = gw; t < T; t += NGW) {
            const int hh = lane >> 3, l8 = lane & 7;
            const float pos = (float)positions[t];
            float cs[4], sn[4];
#pragma unroll
            for (int i = 0; i < 4; ++i) { const float invf = exp2f(-(float)(4 * (l8 & 3) + i) * (13.287712379549449f / 16.f)); float rev = pos * invf * 0.15915494309189535f; rev -= rintf(rev);
                sn[i] = __builtin_amdgcn_sinf(rev); cs[i] = __builtin_amdgcn_cosf(rev); }
            bf16_t* qrow = Qb + (size_t)t * 768;
            float qn[8], qp[4]; ld_bf8(qrow + 8 * lane, qn); ld_bf4(qrow + 512 + 4 * lane, qp);
            float kn[8], kp4[4]; ld_bf8(Kraw + (size_t)t * 512 + 8 * lane, kn); ld_bf4(KPE + (size_t)t * 32 + 4 * l8, kp4);
            float s1 = 0.f, s2 = 0.f, s3 = 0.f, s4 = 0.f;
#pragma unroll
            for (int i = 0; i < 8; ++i) { s1 += qn[i] * qn[i]; s3 += kn[i] * kn[i]; }
#pragma unroll
            for (int i = 0; i < 4; ++i) { s2 += qp[i] * qp[i]; s4 += kp4[i] * kp4[i]; }
            s1 = sum8(s1); s2 = sum8(s2); s3 = sum8(s3); s4 = sum8(s4);
            const float r1 = rsqrtf(s1 * (1.f / 64.f) + EPS) * QSCALE, r2 = rsqrtf(s2 * (1.f / 32.f) + EPS), r3 = rsqrtf(s3 * (1.f / 64.f) + EPS), r4 = rsqrtf(s4 * (1.f / 32.f) + EPS);
            const f32x4 wq0 = *(const f32x4*)(qn_nope_w + 8 * l8), wq1 = *(const f32x4*)(qn_nope_w + 8 * l8 + 4), wk0 = *(const f32x4*)(kn_nope_w + 8 * l8), wk1 = *(const f32x4*)(kn_nope_w + 8 * l8 + 4);
            const f32x4 wqp = *(const f32x4*)(qn_pe_w + 4 * l8), wkp = *(const f32x4*)(kn_pe_w + 4 * l8);
            float oq[8], ok[8], oqp[4], okp[4];
#pragma unroll
            for (int i = 0; i < 8; ++i) { oq[i] = qn[i] * r1 * (i < 4 ? wq0[i & 3] : wq1[i & 3]); ok[i] = kn[i] * r3 * (i < 4 ? wk0[i & 3] : wk1[i & 3]); }
#pragma unroll
            for (int i = 0; i < 4; ++i) {
                const float xq = qp[i] * r2 * wqp[i], xk = kp4[i] * r4 * wkp[i];
                const float pq = dpp_f<0x141>(xq), pk_ = dpp_f<0x141>(xk);
                (void)pq; (void)pk_;
                oqp[i] = xq; okp[i] = xk;
            }
#pragma unroll
            for (int i = 0; i < 4; ++i) {
                const float pq = __shfl_xor(oqp[i], 4), pk_ = __shfl_xor(okp[i], 4);
                const float xq = oqp[i], xk = okp[i];
                oqp[i] = l8 < 4 ? (xq * cs[i] - pq * sn[i]) : (xq * cs[i] + pq * sn[i]);
                okp[i] = l8 < 4 ? (xk * cs[i] - pk_ * sn[i]) : (xk * cs[i] + pk_ * sn[i]);
                oqp[i] *= QSCALE;
            }
            bf16_t* qo = Qb + ((size_t)t * 8 + hh) * 96;
            *(bf16x8*)(qo + 8 * l8) = pack8(oq); st_bf4(qo + 64 + 4 * l8, oqp[0], oqp[1], oqp[2], oqp[3]);
            { const int bb = t >> 12, pos = t & 4095; bf16_t* kfb = Kab + (((size_t)(bb * 8 + hh) * 128 + (pos >> 5)) * 6) * 512 + (pos & 31) * 8;
              *(bf16x8*)(kfb + (l8 >> 1) * 512 + 256 * (l8 & 1)) = pack8(ok);
              st_bf4(kfb + (4 + (l8 >> 2)) * 512 + 256 * ((l8 >> 1) & 1) + 4 * (l8 & 1), okp[0], okp[1], okp[2], okp[3]); }
        }
    }
    xcd_barrier(xb);

    {
        PHASE_PTRS
        float* GL = (float*)(dob + DO_GL);
        const int fr_o = fr, fq_o = fq, lane_o = lane;
        if (wave < 4) {
            LAS unsigned char* wb = (LAS unsigned char*)lds + wave * 36864;
            LAS bf16_t* At = (LAS bf16_t*)(wb + 0);      LAS bf16_t* Btm = (LAS bf16_t*)(wb + 4096);  LAS bf16_t* Ktm = (LAS bf16_t*)(wb + 8192); LAS bf16_t* Rtm = (LAS bf16_t*)(wb + 12288);
            LAS bf16_t* VmT = (LAS bf16_t*)(wb + 16384);
            LAS bf16_t* Nm = (LAS bf16_t*)(wb + 20480);  LAS bf16_t* NmT = (LAS bf16_t*)(wb + 22528); LAS bf16_t* Tm = (LAS bf16_t*)(wb + 24576);  LAS bf16_t* TmT = (LAS bf16_t*)(wb + 26624);
            LAS bf16_t* MmT = (LAS bf16_t*)(wb + 28672); LAS bf16_t* NBT = (LAS bf16_t*)(wb + 30720); LAS bf16_t* MKT = (LAS bf16_t*)(wb + 32768); LAS float* gLs = (LAS float*)(wb + 34816);
            LAS bf16_t* AtT = At; LAS bf16_t* BtT = Nm; LAS bf16_t* KtT = Tm;
            LAS bf16_t* W1 = At; LAS bf16_t* W1T = Btm; LAS bf16_t* ATm = Ktm;
#pragma unroll 1
            for (int it = blockIdx.x * 4 + wave; it < 4096; it += G * 4) {
                const int bh = it >> 7, c = it & 127, b = bh >> 3, h = bh & 7;
                int fr = fr_o, fq = fq_o, lane = lane_o; asm volatile("" : "+v"(fr), "+v"(fq), "+v"(lane));
                const int lpA = (4 * (fr >> 3) + (fr & 3)) + 32 * (fq & 1) + ((fq >> 1) + 4 * ((fr >> 2) & 1)) * 512;
                const int lpB = ((fr >> 1) + 16 * (fq & 1)) * 512 + 16 * (fr & 1) + 4 * (fq >> 1);
                const int lpC = 4 * (fq >> 1) + 16 * (fr & 3) + ((fr >> 2) + 8 * (fq & 1)) * 512;
                const size_t sbase = ((size_t)b * SEQ + c * 32) * 512 + h * 64;
                unsigned aT[16], bT[16], kT[16];
                {
                    float cs = 0.f; unsigned vT[16];
#pragma unroll
                    for (int t = 0; t < 32; ++t) {
                        const size_t o = sbase + (size_t)t * 512 + lane;
                        const float ldv = bf1(Wb[o]), rr = bf1(Rb[o]), kv = bf1(Kb[o]), qv = bf1(KKb[o]), bv = bf1(Bvb[o]); const unsigned vraw = Vb[o];
                        const float ep = __expf(cs); cs += ldv; const float ec = __expf(cs), en = __expf(-cs);
                        const unsigned a_ = bf1of(-qv * ep), b_ = bf1of(bv * en), k_ = bf1of(kv * en), r_ = bf1of(rr * ec);
                        At[SW64(t, lane)] = (bf16_t)a_; Btm[SW64(t, lane)] = (bf16_t)b_; Ktm[SW64(t, lane)] = (bf16_t)k_; Rtm[SW64(t, lane)] = (bf16_t)r_;
                        if (t & 1) { aT[t >> 1] |= a_ << 16; bT[t >> 1] |= b_ << 16; kT[t >> 1] |= k_ << 16; vT[t >> 1] |= vraw << 16; }
                        else { aT[t >> 1] = a_; bT[t >> 1] = b_; kT[t >> 1] = k_; vT[t >> 1] = vraw; }
                    }
#pragma unroll
                    for (int q = 0; q < 4; ++q)
                        *(LAS u32x4*)(VmT + lane * 32 + ((q ^ ((lane >> 2) & 3)) << 3)) = (u32x4){vT[4 * q], vT[4 * q + 1], vT[4 * q + 2], vT[4 * q + 3]};
                    const float gl = __expf(cs); gLs[lane] = gl;
                    { const int k5 = lane & 31; GL[(size_t)it * 64 + (lane >> 5) * 32 + ((k5 >> 2) & 1) * 16 + (k5 & 3) + 4 * (k5 >> 3)] = gl; }
                }
                {
                    f32x4 acc[2][2];
#define ZACC(MT_, NT_) _Pragma("unroll") for (int m = 0; m < MT_; ++m) _Pragma("unroll") for (int n = 0; n < NT_; ++n) acc[m][n] = (f32x4){0.f, 0.f, 0.f, 0.f};
                    ZACC(2, 2) gemm_lds<2, 2, 2>(Btm, 64, At, 64, acc, fr, fq);
#pragma unroll
                    for (int m = 0; m < 2; ++m)
#pragma unroll
                        for (int n = 0; n < 2; ++n)
#pragma unroll
                            for (int j = 0; j < 4; ++j) { const int i = 16 * m + fr, tt = 16 * n + 4 * fq + j; const float v = i < tt ? acc[m][n][j] : 0.f; const bf16_t w = bf1of(v), w1 = bf1of(v + (i == tt ? 1.f : 0.f));
                                Nm[SW32(i, tt)] = w; NmT[SW32(tt, i)] = w; Tm[SW32(i, tt)] = w1; TmT[SW32(tt, i)] = w1; }
                    ZACC(2, 2) gemm_lds<2, 2, 2>(Ktm, 64, At, 64, acc, fr, fq);
#pragma unroll
                    for (int m = 0; m < 2; ++m)
#pragma unroll
                        for (int n = 0; n < 2; ++n)
#pragma unroll
                            for (int j = 0; j < 4; ++j) { const int i = 16 * m + fr, tt = 16 * n + 4 * fq + j; MmT[SW32(tt, i)] = bf1of(i < tt ? acc[m][n][j] : 0.f); }
                    ZACC(2, 2) gemm_lds<2, 2, 2>(Btm, 64, Rtm, 64, acc, fr, fq);
#pragma unroll
                    for (int m = 0; m < 2; ++m)
#pragma unroll
                        for (int n = 0; n < 2; ++n)
#pragma unroll
                            for (int j = 0; j < 4; ++j) { const int i = 16 * m + fr, tt = 16 * n + 4 * fq + j; NBT[SW32(tt, i)] = bf1of(i <= tt ? acc[m][n][j] : 0.f); }
                    ZACC(2, 2) gemm_lds<2, 2, 2>(Ktm, 64, Rtm, 64, acc, fr, fq);
#pragma unroll
                    for (int m = 0; m < 2; ++m)
#pragma unroll
                        for (int n = 0; n < 2; ++n)
#pragma unroll
                            for (int j = 0; j < 4; ++j) { const int i = 16 * m + fr, tt = 16 * n + 4 * fq + j; MKT[SW32(tt, i)] = bf1of(i <= tt ? acc[m][n][j] : 0.f); }
#pragma unroll
                    for (int q = 0; q < 4; ++q)
                        *(LAS u32x4*)(AtT + lane * 32 + ((q ^ ((lane >> 2) & 3)) << 3)) = (u32x4){aT[4 * q], aT[4 * q + 1], aT[4 * q + 2], aT[4 * q + 3]};
#pragma unroll 1
                    for (int rd = 0; rd < 4; ++rd) {
                        ZACC(2, 2) gemm_lds<2, 2, 1>(Nm, 32, NmT, 32, acc, fr, fq);
#pragma unroll
                        for (int m = 0; m < 2; ++m)
#pragma unroll
                            for (int n = 0; n < 2; ++n)
#pragma unroll
                                for (int j = 0; j < 4; ++j) { const int i = 16 * m + fr, tt = 16 * n + 4 * fq + j; const bf16_t w = bf1of(acc[m][n][j]); Nm[SW32(i, tt)] = w; NmT[SW32(tt, i)] = w; }
                        ZACC(2, 2) gemm_lds<2, 2, 1>(Tm, 32, NmT, 32, acc, fr, fq);
#pragma unroll
                        for (int m = 0; m < 2; ++m)
#pragma unroll
                            for (int n = 0; n < 2; ++n)
#pragma unroll
                                for (int j = 0; j < 4; ++j) { const int i = 16 * m + fr, tt = 16 * n + 4 * fq + j; const bf16_t w = bf1of(acc[m][n][j] + bf1(Tm[SW32(i, tt)])); Tm[SW32(i, tt)] = w; TmT[SW32(tt, i)] = w; }
                    }
                }
                asm volatile("" : "+v"(fr), "+v"(fq));
                {
                    f32x4 acc[4][2];
                    ZACC(4, 2) gemm_lds<4, 2, 1>(AtT, 32, TmT, 32, acc, fr, fq);
#pragma unroll
                    for (int m = 0; m < 4; ++m)
#pragma unroll
                        for (int n = 0; n < 2; ++n)
#pragma unroll
                            for (int j = 0; j < 4; ++j) ATm[SW32(16 * m + fr, 16 * n + 4 * fq + j)] = bf1of(acc[m][n][j]);
                    ZACC(4, 2) gemm_lds<4, 2, 1>(VmT, 32, MmT, 32, acc, fr, fq);
#pragma unroll
                    for (int m = 0; m < 4; ++m)
#pragma unroll
                        for (int n = 0; n < 2; ++n)
#pragma unroll
                            for (int j = 0; j < 4; ++j) W1[SW32(16 * m + fr, 16 * n + 4 * fq + j)] = bf1of(acc[m][n][j]);
                    ZACC(4, 2) gemm_lds<4, 2, 1>(W1, 32, TmT, 32, acc, fr, fq);
#pragma unroll
                    for (int m = 0; m < 4; ++m)
#pragma unroll
                        for (int n = 0; n < 2; ++n)
#pragma unroll
                            for (int j = 0; j < 4; ++j) W1T[SW32(16 * m + fr, 16 * n + 4 * fq + j)] = bf1of(acc[m][n][j]);
#pragma unroll
                    for (int q = 0; q < 4; ++q) {
                        *(LAS u32x4*)(BtT + lane * 32 + ((q ^ ((lane >> 2) & 3)) << 3)) = (u32x4){bT[4 * q], bT[4 * q + 1], bT[4 * q + 2], bT[4 * q + 3]};
                        *(LAS u32x4*)(KtT + lane * 32 + ((q ^ ((lane >> 2) & 3)) << 3)) = (u32x4){kT[4 * q], kT[4 * q + 1], kT[4 * q + 2], kT[4 * q + 3]};
                    }
                    ZACC(4, 2) gemm_lds<4, 2, 1>(ATm, 32, NBT, 32, acc, fr, fq);
#pragma unroll
                    for (int m = 0; m < 4; ++m)
#pragma unroll
                        for (int n = 0; n < 2; ++n)
#pragma unroll
                            for (int j = 0; j < 4; ++j) { const int k = 16 * m + fr, tp = 16 * n + 4 * fq + j; const float v = acc[m][n][j] + bf1(Rtm[SW64(tp, k)]);
                                Rb[sbase + lpA + (size_t)(j * 8 + (2 * n + 8 * m) * 512)] = bf1of(v); }
                    ZACC(4, 2) gemm_lds<4, 2, 1>(W1T, 32, NBT, 32, acc, fr, fq); gemm_lds<4, 2, 1>(VmT, 32, MKT, 32, acc, fr, fq);
#pragma unroll
                    for (int m = 0; m < 4; ++m)
#pragma unroll
                        for (int n = 0; n < 2; ++n)
#pragma unroll
                            for (int j = 0; j < 4; ++j) Yb[sbase + lpB + (size_t)((8 * (m & 1)) * 512 + 32 * (m >> 1) + j + 8 * n)] = bf1of(acc[m][n][j]);
                }
                asm volatile("" : "+v"(fr), "+v"(fq));
                {
                    f32x4 acc[4][4];
                    ZACC(4, 4) gemm_lds<4, 4, 1>(ATm, 32, BtT, 32, acc, fr, fq);
#pragma unroll
                    for (int m = 0; m < 4; ++m)
#pragma unroll
                        for (int n = 0; n < 4; ++n)
#pragma unroll
                            for (int j = 0; j < 4; ++j) { const float v = acc[m][n][j] * gLs[16 * n + 4 * fq + j];
                                (n < 2 ? Wb : Kb)[sbase + lpA + (size_t)(j * 8 + (2 * (n & 1) + 8 * m) * 512)] = bf1of(v); }
                    ZACC(4, 4) gemm_lds<4, 4, 1>(W1T, 32, BtT, 32, acc, fr, fq); gemm_lds<4, 4, 1>(VmT, 32, KtT, 32, acc, fr, fq);
#pragma unroll
                    for (int m = 0; m < 4; ++m)
#pragma unroll
                        for (int n = 0; n < 4; ++n)
#pragma unroll
                            for (int j = 0; j < 4; ++j) { const float v = acc[m][n][j] * gLs[16 * n + 4 * fq + j];
                                (m < 2 ? KKb : Bvb)[sbase + lpC + (size_t)(j + 8 * (n & 1) + (4 * (m & 1) + 16 * (n >> 1)) * 512)] = bf1of(v); }
                }
#undef ZACC
            }
        }
    }
    xcd_barrier(xb);

    {
        PHASE_PTRS
        if (wave < 5 && blockIdx.x < 64) {
            const int item = blockIdx.x, bh = item >> 1, wv = item & 1, b = bh >> 3, h = bh & 7;
            const int hi = lane >> 5, vcol = lane & 31;
            float* GL = (float*)(dob + DO_GL);
            volatile LAS unsigned* ctr = (volatile LAS unsigned*)((LAS unsigned char*)lds + LDS_BYTES - 64);
#define SLICE(arr, sb, li) ((arr) + (sb) + (size_t)((li) >> 6) * 512 + ((li) & 63))
#define DMA16(src_, dst_) __builtin_amdgcn_global_load_lds((const unsigned*)(src_), (LAS unsigned*)(dst_), 16, 0, 0)
            if (wave >= 1 && wave <= 3) {
                __builtin_amdgcn_s_setprio(2);
#pragma unroll 1
                for (int c = 0; c < 128; ++c) {
                    if (c >= 4) { while ((int)ctr[3] < c - 3) __builtin_amdgcn_s_sleep(1); }
                    asm volatile("" ::: "memory");
                    const size_t sb = ((size_t)b * SEQ + c * 32) * 512 + h * 64; LAS unsigned char* lb = (LAS unsigned char*)lds + (c & 3) * 19712;
                    if (wave == 1) {
#pragma unroll
                        for (int q = 0; q < 4; ++q) DMA16(SLICE(Wb, sb, (q * 64 + lane) * 8), lb + q * 1024);
#pragma unroll
                        for (int q = 0; q < 2; ++q) DMA16(SLICE(Kb, sb, (q * 64 + lane) * 8), lb + 4096 + q * 1024);
                        asm volatile("s_waitcnt vmcnt(12)" ::: "memory");
                    } else if (wave == 2) {
#pragma unroll
                        for (int q = 2; q < 4; ++q) DMA16(SLICE(Kb, sb, (q * 64 + lane) * 8), lb + 4096 + q * 1024);
#pragma unroll
                        for (int q = 0; q < 4; ++q) DMA16(SLICE(Rb, sb, (q * 64 + lane) * 8), lb + 8192 + q * 1024);
                        asm volatile("s_waitcnt vmcnt(12)" ::: "memory");
                    } else {
#pragma unroll
                        for (int kb = 0; kb < 2; ++kb)
#pragma unroll
                            for (int hf = 0; hf < 2; ++hf) DMA16(SLICE(wv ? Bvb : KKb, sb, (kb * 64 + lane) * 16 + 8 * hf), lb + 12288 + kb * 2048 + hf * 1024);
#pragma unroll
                        for (int hf = 0; hf < 2; ++hf) DMA16(Yb + sb + (size_t)(lane >> 1) * 512 + 32 * wv + 16 * (lane & 1) + 8 * hf, lb + 16384 + hf * 1024);
                        __builtin_amdgcn_global_load_lds((const unsigned*)(GL + ((size_t)(bh * 128 + c)) * 64 + lane), (LAS unsigned*)(lb + 18432), 4, 0, 0);
                        asm volatile("s_waitcnt vmcnt(14)" ::: "memory");
                    }
                    if (c >= 2 && lane == 0) ctr[wave - 1] = (unsigned)(c - 1);
                }
                asm volatile("s_waitcnt vmcnt(0)" ::: "memory");
                if (lane == 0) ctr[wave - 1] = 128u;
                __builtin_amdgcn_s_setprio(0);
            } else if (wave == 4) {
#pragma unroll 1
                for (int c = 0; c < 128; ++c) {
                    while ((int)ctr[4] <= c) __builtin_amdgcn_s_sleep(2);
                    asm volatile("" ::: "memory");
                    const LAS u32x4* ys = (const LAS u32x4*)((LAS unsigned char*)lds + 81920 + (c & 7) * 2048 + lane * 32);
                    const u32x4 ya = ys[0], yb = ys[1];
                    u32x4* yo = (u32x4*)(Yb + ((size_t)b * SEQ + c * 32 + (lane >> 1)) * 512 + h * 64 + 32 * wv + 16 * (lane & 1));
                    yo[0] = ya; yo[1] = yb;
                    asm volatile("s_waitcnt lgkmcnt(0)" ::: "memory");
                    if (lane == 0) ctr[5] = (unsigned)(c + 1);
                }
            } else {
                __builtin_amdgcn_s_setprio(3);
                f32x16 S0t, S1t;
#pragma unroll
                for (int r = 0; r < 16; ++r) { S0t[r] = 0.f; S1t[r] = 0.f; }
#pragma unroll 1
                for (int c = 0; c < 128; ++c) {
                    while ((int)ctr[0] <= c || (int)ctr[1] <= c || (int)ctr[2] <= c) __builtin_amdgcn_s_sleep(1);
                    asm volatile("" ::: "memory");
                    const LAS unsigned char* lb = (const LAS unsigned char*)lds + (c & 3) * 19712;
                    bf16x8 sf[4];
#pragma unroll
                    for (int s = 0; s < 4; ++s) { float t8[8];
#pragma unroll
                        for (int j = 0; j < 8; ++j) t8[j] = (s < 2 ? S0t : S1t)[8 * (s & 1) + j];
                        sf[s] = pack8(t8); }
                    f32x16 yt;
                    { const u32x4 c0 = *(const LAS u32x4*)(lb + 16384 + lane * 16), c1 = *(const LAS u32x4*)(lb + 16384 + 1024 + lane * 16);
                      yt[0] = bflo(c0.x); yt[1] = bfhi(c0.x); yt[2] = bflo(c0.y); yt[3] = bfhi(c0.y); yt[4] = bflo(c0.z); yt[5] = bfhi(c0.z); yt[6] = bflo(c0.w); yt[7] = bfhi(c0.w);
                      yt[8] = bflo(c1.x); yt[9] = bfhi(c1.x); yt[10] = bflo(c1.y); yt[11] = bfhi(c1.y); yt[12] = bflo(c1.z); yt[13] = bfhi(c1.z); yt[14] = bflo(c1.w); yt[15] = bfhi(c1.w); }
                    f32x16 n0, n1;
#pragma unroll
                    for (int kb = 0; kb < 2; ++kb) {
                        const u32x4 c0 = *(const LAS u32x4*)(lb + 12288 + kb * 2048 + lane * 16), c1 = *(const LAS u32x4*)(lb + 12288 + kb * 2048 + 1024 + lane * 16);
                        const LAS float* gp = (const LAS float*)(lb + 18432) + kb * 32 + hi * 16;
                        f32x16 nn; const f32x16 so = kb ? S1t : S0t;
                        nn[0] = bflo(c0.x); nn[1] = bfhi(c0.x); nn[2] = bflo(c0.y); nn[3] = bfhi(c0.y); nn[4] = bflo(c0.z); nn[5] = bfhi(c0.z); nn[6] = bflo(c0.w); nn[7] = bfhi(c0.w);
                        nn[8] = bflo(c1.x); nn[9] = bfhi(c1.x); nn[10] = bflo(c1.y); nn[11] = bfhi(c1.y); nn[12] = bflo(c1.z); nn[13] = bfhi(c1.z); nn[14] = bflo(c1.w); nn[15] = bfhi(c1.w);
#pragma unroll
                        for (int r = 0; r < 16; ++r) nn[r] += gp[r] * so[r];
                        if (kb) n1 = nn; else n0 = nn;
                    }
#pragma unroll
                    for (int s = 0; s < 4; ++s) {
                        const bf16x8 ra = *(const LAS bf16x8*)(lb + 8192 + s * 1024 + lane * 16);
                        const bf16x8 p0 = *(const LAS bf16x8*)(lb + s * 1024 + lane * 16), p1 = *(const LAS bf16x8*)(lb + 4096 + s * 1024 + lane * 16);
                        yt = mfma32(ra, sf[s], yt); n0 = mfma32(p0, sf[s], n0); n1 = mfma32(p1, sf[s], n1);
                    }
                    S0t = n0; S1t = n1;
                    asm volatile("s_waitcnt lgkmcnt(0)" ::: "memory");
                    if (lane == 0) ctr[3] = (unsigned)(c + 1);
                    if (c >= 8) { while ((int)ctr[5] < c - 7) __builtin_amdgcn_s_sleep(1); }
                    asm volatile("" ::: "memory");
                    { LAS bf16_t* ys = (LAS bf16_t*)((LAS unsigned char*)lds + 81920 + (c & 7) * 2048) + vcol;
#pragma unroll
                      for (int r = 0; r < 16; ++r) ys[crow(r, hi) * 32] = bf1of(yt[r]);
                      asm volatile("s_waitcnt lgkmcnt(0)" ::: "memory");
                      if (lane == 0) ctr[4] = (unsigned)(c + 1); }
                }
                __builtin_amdgcn_s_setprio(0);
            }
#undef DMA16
#undef SLICE
        }
        for (;;) {
            unsigned item = 0;
            const int xg = blockIdx.x & 7;
            if (lane == 0) item = atomicAdd(&cnt[xg], 1u);
            item = __builtin_amdgcn_readfirstlane(item);
            if (item >= 256u) break;
            const int qt = 63 - (int)(item >> 2), bh = 8 * (int)(item & 3) + xg, b = bh >> 3, h = bh & 7;
            const int qi = lane & 31, hi = lane >> 5;
            const size_t tokq = (size_t)b * SEQ + qt * 64 + qi;
            bf16x8 qfa[6], qfb[6];
#pragma unroll
            for (int s = 0; s < 6; ++s) { qfa[s] = *(const bf16x8*)(Qb + (tokq * 8 + h) * 96 + 16 * s + 8 * hi); qfb[s] = *(const bf16x8*)(Qb + ((tokq + 32) * 8 + h) * 96 + 16 * s + 8 * hi); }
            float ma = -1e30f, la = 0.f, mb = -1e30f, lb = 0.f;
            f32x16 oa0, oa1, ob0, ob1;
#pragma unroll
            for (int r = 0; r < 16; ++r) { oa0[r] = 0.f; oa1[r] = 0.f; ob0[r] = 0.f; ob1[r] = 0.f; }
            const bf16_t* kfb = Kab + ((size_t)(b * 8 + h) * 128) * 6 * 512 + lane * 8;
            const bf16_t* vfb = Vt + ((size_t)(b * 8 + h) * 128) * 4 * 512 + lane * 8;
            const int nt = 2 * qt + 2;
#define ATT_GROUP(QF, M_, L_, O0, O1, DIAG) { \
                f32x16 xs; _Pragma("unroll") for (int r = 0; r < 16; ++r) xs[r] = 0.f; \
                _Pragma("unroll") for (int s = 0; s < 6; ++s) xs = mfma32(kf[s], QF[s], xs); \
                if (DIAG) { _Pragma("unroll") for (int r = 0; r < 16; ++r) if (crow(r, hi) > qi) xs[r] = -1e30f; } \
                float mx = xs[0]; _Pragma("unroll") for (int r = 1; r < 16; ++r) mx = fmaxf(mx, xs[r]); \
                mx = fmaxf(mx, __shfl_xor(mx, 32)); \
                if (__any(mx > M_)) { const float mn = fmaxf(M_, mx), alpha = __builtin_amdgcn_exp2f(M_ - mn); L_ *= alpha; M_ = mn; \
                    _Pragma("unroll") for (int r = 0; r < 16; ++r) { O0[r] *= alpha; O1[r] *= alpha; } } \
                float ps = 0.f; _Pragma("unroll") for (int r = 0; r < 16; ++r) { xs[r] = __builtin_amdgcn_exp2f(xs[r] - M_); ps += xs[r]; } \
                L_ += ps; \
                _Pragma("unroll") for (int s = 0; s < 2; ++s) { float t8[8]; _Pragma("unroll") for (int j = 0; j < 8; ++j) t8[j] = xs[8 * s + j]; const bf16x8 pbs = pack8(t8); \
                    O0 = mfma32(vf[0][s], pbs, O0); O1 = mfma32(vf[1][s], pbs, O1); } }
#pragma unroll 1
            for (int kt = 0; kt < nt; ++kt) {
                bf16x8 kf[6], vf[2][2];
#pragma unroll
                for (int s = 0; s < 6; ++s) kf[s] = *(const bf16x8*)(kfb + (size_t)(kt * 6 + s) * 512);
#pragma unroll
                for (int d0 = 0; d0 < 2; ++d0)
#pragma unroll
                    for (int s = 0; s < 2; ++s) vf[d0][s] = *(const bf16x8*)(vfb + (size_t)((kt * 2 + d0) * 2 + s) * 512);
                if (kt < nt - 1) ATT_GROUP(qfa, ma, la, oa0, oa1, kt == nt - 2)
                ATT_GROUP(qfb, mb, lb, ob0, ob1, kt == nt - 1)
            }
#undef ATT_GROUP
            la += __shfl_xor(la, 32); lb += __shfl_xor(lb, 32);
            const float ila = 1.f / la, ilb = 1.f / lb;
            bf16_t* orow = Ob + tokq * 512 + h * 64;
#pragma unroll
            for (int g = 0; g < 4; ++g) {
                st_bf4(orow + 8 * g + 4 * hi, oa0[4 * g] * ila, oa0[4 * g + 1] * ila, oa0[4 * g + 2] * ila, oa0[4 * g + 3] * ila);
                st_bf4(orow + 32 + 8 * g + 4 * hi, oa1[4 * g] * ila, oa1[4 * g + 1] * ila, oa1[4 * g + 2] * ila, oa1[4 * g + 3] * ila);
                st_bf4(orow + (size_t)32 * 512 + 8 * g + 4 * hi, ob0[4 * g] * ilb, ob0[4 * g + 1] * ilb, ob0[4 * g + 2] * ilb, ob0[4 * g + 3] * ilb);
                st_bf4(orow + (size_t)32 * 512 + 32 + 8 * g + 4 * hi, ob1[4 * g] * ilb, ob1[4 * g + 1] * ilb, ob1[4 * g + 2] * ilb, ob1[4 * g + 3] * ilb);
            }
        }
    }
    xcd_barrier(xb);

    {
        PHASE_PTRS
        for (int t = gw; t < T; t += NGW) {
            const int ch = 8 * lane, h = lane >> 3;
            float y[8], v[8], g[8]; ld_bf8(Yb + (size_t)t * 512 + ch, y); ld_bf8(Vb + (size_t)t * 512 + ch, v); ld_bf8(Gtb + (size_t)t * 512 + ch, g);
            float s = 0.f;
#pragma unroll
            for (int i = 0; i < 8; ++i) s += y[i];
            s += __shfl_xor(s, 1); s += __shfl_xor(s, 2); s += __shfl_xor(s, 4);
            const float mu = s * (1.f / 64.f); float q = 0.f;
#pragma unroll
            for (int i = 0; i < 8; ++i) { y[i] -= mu; q += y[i] * y[i]; }
            q += __shfl_xor(q, 1); q += __shfl_xor(q, 2); q += __shfl_xor(q, 4);
            const float rstd = rsqrtf(q * (1.f / 64.f) + 64e-5f);
            const float bo = bonus[(size_t)t * 8 + h];
            const f32x4 lw0 = *(const f32x4*)(rw_ln_w + ch), lw1 = *(const f32x4*)(rw_ln_w + ch + 4), lb0 = *(const f32x4*)(rw_ln_b + ch), lb1 = *(const f32x4*)(rw_ln_b + ch + 4);
            float o[8];
#pragma unroll
            for (int i = 0; i < 8; ++i) { const float lw = i < 4 ? lw0[i & 3] : lw1[i & 3], lb = i < 4 ? lb0[i & 3] : lb1[i & 3]; o[i] = (y[i] * rstd * lw + lb + bo * v[i]) * g[i]; }
            *(bf16x8*)(YA + (size_t)t * 512 + ch) = pack8(o);
        }
    }
    xcd_barrier(xb);

    {
        PHASE_PTRS
        pg8::StaticOrder S; S.init(T, 1024, G, (int)blockIdx.x);
        { pg8::Gemm g{YA, RwoT, T, 1024, 512}; pg8::EpiGate E{MIXED, Gg, 0, 0};
          pg8::gemm_phase<pg8::EpiGate, pg8::StaticOrder, true, true>((PG8_LAS unsigned char*)lds, g, S, E); }
        { pg8::Gemm g{Ob, MwoT, T, 1024, 512}; pg8::EpiGate E{MIXED, Gg, 1024, 1};
          pg8::gemm_phase<pg8::EpiGate, pg8::StaticOrder, true, true>((PG8_LAS unsigned char*)lds, g, S, E); }
    }
    xcd_barrier(xb);

    {
        PHASE_PTRS
        const bool conv_first = ((blockIdx.x >> 3) & 1) != 0;
#define P4B_CONV         { const float* pu = kp->in[29]; const float* pv = kp->in[30]; \
          for (size_t i = (size_t)blockIdx.x * NT + tid; i < (size_t)16384 * 1024 / 16; i += (size_t)G * NT) { \
              u32x4 uo, vo; \
              _Pragma("unroll") for (int q = 0; q < 4; ++q) { \
                  const f32x4 u = ((const f32x4*)pu)[i * 4 + q]; const f32x4 w = ((const f32x4*)norm2_w)[(i & 63) * 4 + q]; \
                  uo[q] = pk4_fp8(u.x * w.x * U8_SCALE, u.y * w.y * U8_SCALE, u.z * w.z * U8_SCALE, u.w * w.w * U8_SCALE); \
                  const f32x4 v = ((const f32x4*)pv)[i * 4 + q]; vo[q] = pk4_fp8(v.x * V8_SCALE, v.y * V8_SCALE, v.z * V8_SCALE, v.w * V8_SCALE); \
              } \
              ((u32x4*)UB)[i] = uo; \
              { const size_t e = i >> 6; const int d0 = (int)(i & 63) * 16; *(u32x4*)((unsigned char*)VBp + ((size_t)(d0 >> 7) * 16384 + e) * 128 + (d0 & 127)) = vo; } } }
        if (conv_first) P4B_CONV
        { pg8::Gemm g{MIXED, WoutT, T, 1024, 1024}; pg8::StaticOrder S; S.init(T, 1024, G, (int)blockIdx.x);
          pg8::EpiRes E{x, HB, ss2};
          pg8::gemm_phase<pg8::EpiRes, pg8::StaticOrder, true, true>((PG8_LAS unsigned char*)lds, g, S, E); }
        if (!conv_first) P4B_CONV
#undef P4B_CONV
    }
    xcd_barrier(xb);

    {
        PHASE_PTRS
        pg8::Gemm g{HB, PwqT, T, 2048, 1024}; pg8::StaticOrder S; S.init(T, 2048, G, (int)blockIdx.x);
        pg8::EpiScale E{SC, ss2};
        pg8::gemm_phase<pg8::EpiScale, pg8::StaticOrder, true, true>((PG8_LAS unsigned char*)lds, g, S, E);
    }
    xcd_barrier(xb);

    {
        PHASE_PTRS
        const int wp = wave & 3; const bool producer = wave < 4;
        volatile LAS unsigned* pc = (volatile LAS unsigned*)((LAS unsigned char*)lds + LDS_BYTES - 128) + 2 * wp;
        int ppair[4];
#pragma unroll
        for (int c = 0; c < 4; ++c) ppair[c] = peer_pair(16 * c + (lane & 15));
        if (tid < 64) *(LAS u32x4*)((LAS unsigned char*)lds + 24576 + tid * 16) = (u32x4){0u, 0u, 0u, 0u};
        __syncthreads();
        if (producer) {
        int kq = 0;
        for (int t = blockIdx.x * 4 + wp; t < T; t += G * 4, ++kq) {
            LAS unsigned char* wl = (LAS unsigned char*)lds + wp * 4096 + (kq & 1) * 2048;
            LAS u32x2* tab = (LAS u32x2*)wl;
            if (kq >= 2) { while ((int)pc[1] < kq - 1) __builtin_amdgcn_s_sleep(2); }
            asm volatile("" ::: "memory");
            { float xa[8], xb[8]; ld_bf8(HB + (size_t)t * DM + 16 * lane, xa); ld_bf8(HB + (size_t)t * DM + 16 * lane + 8, xb);
              u32x4 w; w.x = pk4_fp8(xa[0], xa[1], xa[2], xa[3]); w.y = pk4_fp8(xa[4], xa[5], xa[6], xa[7]); w.z = pk4_fp8(xb[0], xb[1], xb[2], xb[3]); w.w = pk4_fp8(xb[4], xb[5], xb[6], xb[7]);
              *(LAS u32x4*)(wl + 1024 + lane * 16) = w; }
            {
                const int l16 = lane & 15, rho = lane >> 4;
                LAS unsigned* rkK = (LAS unsigned*)((LAS unsigned char*)lds + 16384 + wp * 2048);
                LAS float* rkS = (LAS float*)(rkK + 256);
#define CE_(a_, b_) { const unsigned hi_ = umax2(a_, b_), lo_ = a_ < b_ ? a_ : b_; a_ = hi_; b_ = lo_; }
#define SORT8(k) { CE_(k[0], k[1]) CE_(k[2], k[3]) CE_(k[4], k[5]) CE_(k[6], k[7]) CE_(k[0], k[2]) CE_(k[1], k[3]) CE_(k[4], k[6]) CE_(k[5], k[7]) CE_(k[1], k[2]) CE_(k[5], k[6]) \
                    CE_(k[0], k[4]) CE_(k[3], k[7]) CE_(k[1], k[5]) CE_(k[2], k[6]) CE_(k[1], k[4]) CE_(k[3], k[6]) CE_(k[2], k[4]) CE_(k[3], k[5]) CE_(k[3], k[4]) }
#define SORT4(k) { CE_(k[0], k[1]) CE_(k[2], k[3]) CE_(k[0], k[2]) CE_(k[1], k[3]) CE_(k[1], k[2]) }
                {
                    unsigned key[4][8], top[4];
#pragma unroll
                    for (int q = 0; q < 4; ++q) {
                        const u32x4 w = *(const u32x4*)(SC + (size_t)t * 2048 + (4 * q + rho) * 128 + 8 * l16);
#pragma unroll
                        for (int c = 0; c < 8; ++c) { unsigned u = (c & 1) ? (w[c >> 1] & 0xffff0000u) : (w[c >> 1] << 16); u = (u & 0x80000000u) ? ~u : (u | 0x80000000u); key[q][c] = (u & ~127u) | (unsigned)(127 - (8 * l16 + c)); }
                        SORT8(key[q])
                        top[q] = 0u;
                    }
#pragma unroll 1
                    for (int r = 0; r < 16; ++r) {
                        const bool isr = l16 == r;
#pragma unroll
                        for (int q = 0; q < 4; ++q) {
                            const unsigned m = umax16(key[q][0]);
                            const bool win = key[q][0] == m;
#pragma unroll
                            for (int c = 0; c < 7; ++c) key[q][c] = win ? key[q][c + 1] : key[q][c];
                            key[q][7] = win ? 0u : key[q][7];
                            top[q] = isr ? m : top[q];
                        }
                    }
#pragma unroll
                    for (int q = 0; q < 4; ++q) { unsigned u = top[q] & ~127u; u = (u & 0x80000000u) ? (u & 0x7fffffffu) : ~u; rkK[(4 * q + rho) * 16 + l16] = top[q]; rkS[(4 * q + rho) * 16 + l16] = __uint_as_float(u); }
                }
                asm volatile("s_waitcnt lgkmcnt(0)" ::: "memory");
                {
                    unsigned ck[2][4], best[2];
#pragma unroll
                    for (int q = 0; q < 2; ++q) {
                        const int hd = 4 * q + rho;
#pragma unroll
                        for (int c = 0; c < 4; ++c) { const int pr = ppair[c], pi = pr < 0 ? 0 : pr;
                            const float sm = rkS[32 * hd + (pi >> 4)] + rkS[32 * hd + 16 + (pi & 15)]; unsigned u = __float_as_uint(sm); u = (u & 0x80000000u) ? ~u : (u | 0x80000000u);
                            ck[q][c] = pr < 0 ? 0u : ((u & ~255u) | (unsigned)(255 - pr)); }
                        SORT4(ck[q])
                        best[q] = 0u;
                    }
#pragma unroll 1
                    for (int r = 0; r < 16; ++r) {
                        const bool isr = l16 == r;
#pragma unroll
                        for (int q = 0; q < 2; ++q) {
                            const unsigned m = umax16(ck[q][0]);
                            const bool win = ck[q][0] == m;
                            ck[q][0] = win ? ck[q][1] : ck[q][0]; ck[q][1] = win ? ck[q][2] : ck[q][1]; ck[q][2] = win ? ck[q][3] : ck[q][2]; ck[q][3] = win ? 0u : ck[q][3];
                            best[q] = isr ? m : best[q];
                        }
                    }
#pragma unroll
                    for (int q = 0; q < 2; ++q) {
                        const int hd = 4 * q + rho;
                        float bs; { unsigned u = best[q] & ~255u; u = (u & 0x80000000u) ? (u & 0x7fffffffu) : ~u; bs = __uint_as_float(u); }
                        float bmax; { unsigned u = umax16(best[q]) & ~255u; u = (u & 0x80000000u) ? (u & 0x7fffffffu) : ~u; bmax = __uint_as_float(u); }
                        const int pos = 255 - (int)(best[q] & 255u);
                        const float e = __expf(bs - bmax);
                        const float gate = e / sum16(e);
                        const unsigned t1 = rkK[32 * hd + (pos >> 4)], t2 = rkK[32 * hd + 16 + (pos & 15)];
                        const unsigned eid = (127u - (t1 & 127u)) * 128u + (127u - (t2 & 127u));
                        tab[16 * hd + l16] = (u32x2){eid, __float_as_uint(gate)};
                    }
                }
#undef SORT4
#undef SORT8
#undef CE_
            }
            asm volatile("s_waitcnt lgkmcnt(0)" ::: "memory");
            if (lane == 0) pc[0] = (unsigned)(kq + 1);
        }
        } else {
            const unsigned char* UB8 = (const unsigned char*)UB;
            const int tfirst = blockIdx.x * 4 + wp; const int nt = tfirst < T ? (T - tfirst + G * 4 - 1) / (G * 4) : 0;
            const int rho = lane >> 3, chi = lane & 7, jj = lane & 15, qq = lane >> 4;
            const bool useful = (qq & 1) == ((jj >> 2) & 1);
            const bool wr_lane = (jj & 7) == 0 && (qq & 1) == 0;
            LAS float* dotb = (LAS float*)((LAS unsigned char*)lds + 25600 + wp * 512);
            const unsigned zbase = 24576u;
            u32x4 R0[8], R1[8], R2[8], R3[8];
#define P6U_LOAD(R, kq_, G_) { const LAS u32x2* tb_ = (const LAS u32x2*)((LAS unsigned char*)lds + wp * 4096 + ((kq_) & 1) * 2048); \
                const unsigned char* up_ = UB8 + (size_t)tb_[8 * (G_) + rho].x * DM + 16 * chi; \
                _Pragma("unroll") for (int cb = 0; cb < 8; ++cb) R[cb] = *(const u32x4*)(up_ + 128 * cb); }
#define P6U_USE(R, G_) { f32x4 d0 = (f32x4){0.f, 0.f, 0.f, 0.f}, d1 = d0; \
                _Pragma("unroll") for (int cb = 0; cb < 8; ++cb) { \
                    const u32x2 ba0 = *(const LAS u32x2*)((LAS unsigned char*)lds + xa0 + 128 * cb), ba1 = *(const LAS u32x2*)((LAS unsigned char*)lds + xa1 + 128 * cb); \
                    const u32x2 bb0 = *(const LAS u32x2*)((LAS unsigned char*)lds + xa0 + 128 * cb + 8), bb1 = *(const LAS u32x2*)((LAS unsigned char*)lds + xa1 + 128 * cb + 8); \
                    d0 = mfma16_fp8((u32x2){R[cb].x, R[cb].y}, ba0, d0); d1 = mfma16_fp8((u32x2){R[cb].x, R[cb].y}, ba1, d1); \
                    d0 = mfma16_fp8((u32x2){R[cb].z, R[cb].w}, bb0, d0); d1 = mfma16_fp8((u32x2){R[cb].z, R[cb].w}, bb1, d1); } \
                const int r_ = jj & 3; \
                float v0 = r_ == 0 ? d0[0] : (r_ == 1 ? d0[1] : (r_ == 2 ? d0[2] : d0[3])), v1 = r_ == 0 ? d1[0] : (r_ == 1 ? d1[1] : (r_ == 2 ? d1[2] : d1[3])); \
                v0 = useful ? v0 : 0.f; v1 = useful ? v1 : 0.f; v0 = sum8(v0); v1 = sum8(v1); \
                { const auto rr = __builtin_amdgcn_permlane16_swap(__float_as_uint(v0), __float_as_uint(v0), false, false); v0 = __uint_as_float(rr[0]) + __uint_as_float(rr[1]); } \
                { const auto rr = __builtin_amdgcn_permlane16_swap(__float_as_uint(v1), __float_as_uint(v1), false, false); v1 = __uint_as_float(rr[0]) + __uint_as_float(rr[1]); } \
                if (wr_lane) { const int e_ = 8 * (G_) + 2 * (jj >> 3) + (qq >> 1); dotb[e_] = v0; dotb[e_ + 4] = v1; } }
            if (nt > 0) {
                while ((int)pc[0] <= 0) __builtin_amdgcn_s_sleep(2);
                asm volatile("" ::: "memory");
                P6U_LOAD(R0, 0, 0) P6U_LOAD(R1, 0, 1) P6U_LOAD(R2, 0, 2)
            }
            for (int kq = 0; kq < nt; ++kq) {
                const int t = tfirst + kq * (G * 4);
                LAS unsigned char* wl = (LAS unsigned char*)lds + wp * 4096 + (kq & 1) * 2048;
                const float rs = rsqrtf(ss2[t] * (1.f / DM) + EPS);
                const unsigned xb_ = (unsigned)(wp * 4096 + (kq & 1) * 2048 + 1024 + 16 * (jj & 7));
                const unsigned xa0 = qq == (jj >> 3) ? xb_ : zbase, xa1 = qq == 2 + (jj >> 3) ? xb_ : zbase;
#pragma unroll 1
                for (int GG = 0; GG < 16; GG += 4) {
                    int kn = kq, gn = GG + 4;
                    if (GG == 12) {
                        if (kq + 1 < nt) { while ((int)pc[0] < kq + 2) __builtin_amdgcn_s_sleep(2); asm volatile("" ::: "memory"); kn = kq + 1; gn = 0; }
                        else gn = 12;
                    }
                    P6U_LOAD(R3, kq, GG + 3)
                    __builtin_amdgcn_sched_barrier(0);
                    P6U_USE(R0, GG)
                    __builtin_amdgcn_sched_barrier(0);
                    P6U_LOAD(R0, kn, gn)
                    __builtin_amdgcn_sched_barrier(0);
                    P6U_USE(R1, GG + 1)
                    __builtin_amdgcn_sched_barrier(0);
                    P6U_LOAD(R1, kn, gn + 1)
                    __builtin_amdgcn_sched_barrier(0);
                    P6U_USE(R2, GG + 2)
                    __builtin_amdgcn_sched_barrier(0);
                    P6U_LOAD(R2, kn, gn + 2)
                    __builtin_amdgcn_sched_barrier(0);
                    P6U_USE(R3, GG + 3)
                    __builtin_amdgcn_sched_barrier(0);
                }
                asm volatile("s_waitcnt lgkmcnt(0)" ::: "memory");
                {
                    const u32x4 tv = *(const LAS u32x4*)(wl + lane * 16);
                    const f32x2_t dd = *(const LAS f32x2_t*)(dotb + 2 * lane);
                    const float da = dd.x * (rs * (1.f / U8_SCALE)), db = dd.y * (rs * (1.f / U8_SCALE));
                    const float acta = 0.5f * da * (1.f + erff(da * 0.7071067811865476f)), actb = 0.5f * db * (1.f + erff(db * 0.7071067811865476f));
                    const float cfa = __uint_as_float(tv.y) * acta * (1.f / V8_SCALE), cfb = __uint_as_float(tv.w) * actb * (1.f / V8_SCALE);
                    asm volatile("s_waitcnt lgkmcnt(0)" ::: "memory");
                    LAS unsigned char* tq = wl + 1024; const int r0 = 2 * (lane & 3), l0 = lane >> 2;
                    *(LAS unsigned short*)(tq + (r0 * 16 + l0) * 2) = (unsigned short)tv.x; *(LAS unsigned short*)(tq + ((r0 + 1) * 16 + l0) * 2) = (unsigned short)tv.z;
                    const float c0 = fminf(fmaxf(cfa * C8_SCALE, -440.f), 440.f), c1 = fminf(fmaxf(cfb * C8_SCALE, -440.f), 440.f);
                    const unsigned c8 = (unsigned)__builtin_amdgcn_cvt_pk_fp8_f32(c0, c1, 0, false);
                    *(tq + 256 + r0 * 16 + l0) = (unsigned char)(c8 & 0xffu); *(tq + 256 + (r0 + 1) * 16 + l0) = (unsigned char)((c8 >> 8) & 0xffu);
                    asm volatile("s_waitcnt lgkmcnt(0)" ::: "memory");
                    if (lane < 24) { const u32x4 o = *(const LAS u32x4*)(tq + lane * 16); *(u32x4*)(ws + WS_TAB + (size_t)t * 384 + lane * 16) = o; }
                }
                asm volatile("s_waitcnt lgkmcnt(0)" ::: "memory");
                if (lane == 0) pc[1] = (unsigned)(kq + 1);
            }
#undef P6U_USE
#undef P6U_LOAD
        }
    }
    xcd_barrier(xb);

    {
        PHASE_PTRS
        const unsigned sl = blockIdx.x & 7;
        const unsigned char* VS = (const unsigned char*)VBp + (size_t)sl * 16384 * 128;
        const int rho = lane >> 3, chi = lane & 7;
        constexpr float CSCALE = C8_SCALE;
        unsigned selLo[4], selHi[4];
#pragma unroll
        for (int k = 0; k < 4; ++k) { const unsigned sh = 8u * (unsigned)(chi & 3); const unsigned v = (0x0c0c0c0cu & ~(0xffu << sh)) | ((unsigned)k << sh);
            selLo[k] = chi < 4 ? v : 0x0c0c0c0cu; selHi[k] = chi < 4 ? 0x0c0c0c0cu : v; }
        const bool olane = (lane & 0x28) == 0;
        const unsigned voff0 = 16u * (unsigned)chi;
        LAS unsigned char* wl8 = (LAS unsigned char*)lds + wave * 6144;
        const int wstride = (G >> 3) * NWAVES, tg0 = (blockIdx.x >> 3) * NWAVES + wave;
        const int nb = tg0 < T / 8 ? (T / 8 - tg0 + wstride - 1) / wstride : 0, ntok = nb * 8;
#define P6C_TOK(i_) ((tg0 + ((i_) >> 3) * wstride) * 8 + ((i_) & 7))
#define P6C_DMA(b_) { _Pragma("unroll") for (int k = 0; k < 3; ++k) __builtin_amdgcn_global_load_lds((const unsigned*)(ws + WS_TAB + (size_t)((tg0 + (b_) * wstride) * 8) * 384 + k * 1024 + lane * 16), (LAS unsigned*)(wl8 + ((b_) & 1) * 3072 + k * 1024), 16, 0, 0); }
#define P6C_TAB(EL, EH, CW, i_) { const int ii_ = (i_) < ntok ? (i_) : ntok - 1; const LAS unsigned char* tq_ = wl8 + ((ii_ >> 3) & 1) * 3072 + (ii_ & 7) * 384; \
            EL = *(const LAS u32x4*)(tq_ + rho * 32); EH = *(const LAS u32x4*)(tq_ + rho * 32 + 16); CW = *(const LAS u32x4*)(tq_ + 256 + rho * 16); }
#define P6C_EID(ER, j_) (((j_) & 1) ? (ER[(j_) >> 1] >> 16) : (ER[(j_) >> 1] & 0xffffu))
#define P6C_LOAD(VV, ER) { _Pragma("unroll") for (int j = 0; j < 8; ++j) VV[j] = *(const u32x4*)(VS + (size_t)((P6C_EID(ER, j) << 7) | voff0)); }
#define P6C_USE(VV, CWA, CWB) { _Pragma("unroll") for (int j = 0; j < 8; ++j) { const unsigned cwd = (j < 4) ? CWA : CWB; \
            u32x2 xo; xo.x = __builtin_amdgcn_perm(cwd, cwd, selLo[j & 3]); xo.y = __builtin_amdgcn_perm(cwd, cwd, selHi[j & 3]); \
            acc0 = mfma16_fp8(xo, (u32x2){VV[j].x, VV[j].y}, acc0); acc1 = mfma16_fp8(xo, (u32x2){VV[j].z, VV[j].w}, acc1); } }
#define P6C_BODY(i_, VA, VB, EL, EH, CW, VBo, EHo) { \
            const size_t oo_ = (size_t)P6C_TOK(i_) * DM + 128 * sl + 16 * chi + 4 * ((lane >> 4) & 1); float* orow = kp->out + oo_; \
            u32x2 hw0 = (u32x2){0u, 0u}, hw1 = hw0; \
            if (olane) { hw0 = *(const u32x2*)(HB + oo_); hw1 = *(const u32x2*)(HB + oo_ + 8); }        \
            P6C_LOAD(VBo, EHo)                                     \
            const u32x4 cwq = CW; \
            __builtin_amdgcn_sched_barrier(0); \
            f32x4 acc0 = (f32x4){0.f, 0.f, 0.f, 0.f}, acc1 = acc0; \
            P6C_USE(VA, cwq.x, cwq.y) \
            __builtin_amdgcn_sched_barrier(0); \
            P6C_TAB(EL, EH, CW, (i_) + 2) \
            P6C_LOAD(VA, EL)                                       \
            __builtin_amdgcn_sched_barrier(0); \
            P6C_USE(VB, cwq.z, cwq.w) \
            float s[8]; \
            _Pragma("unroll") for (int r = 0; r < 4; ++r) {        \
                { const auto rr = __builtin_amdgcn_permlane32_swap(__float_as_uint(acc0[r]), __float_as_uint(acc0[r]), false, false); s[r] = acc0[r] + dpp_f<0x128>(__uint_as_float(rr[1])); } \
                { const auto rr = __builtin_amdgcn_permlane32_swap(__float_as_uint(acc1[r]), __float_as_uint(acc1[r]), false, false); s[4 + r] = acc1[r] + dpp_f<0x128>(__uint_as_float(rr[1])); } } \
            if (olane) { const f32x4 h0 = (f32x4){bflo(hw0.x), bfhi(hw0.x), bflo(hw0.y), bfhi(hw0.y)}, h1 = (f32x4){bflo(hw1.x), bfhi(hw1.x), bflo(hw1.y), bfhi(hw1.y)}; \
                *(f32x4*)orow = h0 + (f32x4){s[0], s[1], s[2], s[3]} * (1.f / CSCALE); *(f32x4*)(orow + 8) = h1 + (f32x4){s[4], s[5], s[6], s[7]} * (1.f / CSCALE); } \
            __builtin_amdgcn_sched_barrier(0); }
        if (nb > 0) {
            u32x4 vA0[8], vB0[8], vA1[8], vB1[8];
            u32x4 eL0, eH0, cw0, eL1, eH1, cw1;
            P6C_DMA(0)
            if (nb > 1) P6C_DMA(1)
            asm volatile("s_waitcnt vmcnt(0)" ::: "memory");
            P6C_TAB(eL0, eH0, cw0, 0)
            P6C_LOAD(vA0, eL0)
            P6C_LOAD(vB0, eH0)
            P6C_TAB(eL1, eH1, cw1, 1)
            P6C_LOAD(vA1, eL1)
#pragma unroll 1
            for (int i = 0; i < ntok; i += 2) {
                if ((i & 7) == 0 && i > 0 && (i >> 3) + 1 < nb) P6C_DMA((i >> 3) + 1)
                if ((i & 7) == 4) asm volatile("s_waitcnt vmcnt(40)" ::: "memory");
                P6C_BODY(i, vA0, vB0, eL0, eH0, cw0, vB1, eH1)
                P6C_BODY(i + 1, vA1, vB1, eL1, eH1, cw1, vB0, eH0)
            }
            asm volatile("s_waitcnt vmcnt(0) lgkmcnt(0)" ::: "memory");
        }
#undef P6C_BODY
#undef P6C_USE
#undef P6C_LOAD
#undef P6C_EID
#undef P6C_TAB
#undef P6C_DMA
#undef P6C_TOK
    }
}

extern "C" void kernel_launch(void* const* d_in, const int* in_sizes, int n_in, void* d_out, int out_size,
                              void* d_ws, size_t ws_size, hipStream_t stream) {
    static int grid_blocks = 0;
    if (!grid_blocks) {
        int dev = 0, cus = 0, per_cu = 0;
        (void)hipGetDevice(&dev);
        (void)hipDeviceGetAttribute(&cus, hipDeviceAttributeMultiprocessorCount, dev);
        (void)hipFuncSetAttribute((const void*)mega, hipFuncAttributeMaxDynamicSharedMemorySize, LDS_BYTES);
        (void)hipOccupancyMaxActiveBlocksPerMultiprocessor(&per_cu, (const void*)mega, NT, LDS_BYTES);
        if (per_cu < 1) per_cu = 1;
        if (per_cu > 1) per_cu = 1;
        grid_blocks = cus * per_cu;
        if (ws_size < 256 * MiB) fprintf(stderr, "kernel_launch: workspace too small: %zu\n", ws_size);
    }
    Params p{};
    for (int i = 0; i < 31; ++i) p.in[i] = (const float*)d_in[i];
    p.out = (float*)d_out;
    p.ws = (unsigned char*)d_ws;
    void* args[] = {&p};
    (void)hipMemsetAsync((unsigned char*)d_ws + WS_CNT, 0, 65536, stream);
    hipError_t e = hipLaunchCooperativeKernel((const void*)mega, dim3(grid_blocks), dim3(NT), args, LDS_BYTES, stream);
    if (e != hipSuccess) fprintf(stderr, "cooperative launch failed: %s (grid %d)\n", hipGetErrorString(e), grid_blocks);
}
```

```cpp
#include <hip/hip_runtime.h>
#include <hip/hip_cooperative_groups.h>
#include <cstdio>
#include <cstdint>
namespace cg = cooperative_groups;

#define DEVI __device__ __forceinline__
typedef unsigned short bf16_t;
typedef short bf16x8 __attribute__((ext_vector_type(8)));
typedef float f32x4 __attribute__((ext_vector_type(4)));
typedef float f32x16 __attribute__((ext_vector_type(16)));
typedef unsigned u32x2 __attribute__((ext_vector_type(2)));
typedef unsigned u32x4 __attribute__((ext_vector_type(4)));
typedef int i32x8 __attribute__((ext_vector_type(8)));

constexpr int T = 16384, SEQ = 4096, DM = 1024;
constexpr int NWAVES = 8, NT = 512;
constexpr int LDS_BYTES = 147456;
constexpr float EPS = 1e-6f;
constexpr float LOG2E = 1.4426950408889634f;
constexpr float QSCALE = 0.10206207261596575f * 1.4426950408889634f;

constexpr size_t MiB = 1u << 20;
constexpr size_t WS_SS2 = 0;
constexpr size_t WS_CNT = 512 * 1024;
constexpr size_t WS_SSQ = 64 * 1024, WS_SSKV = 128 * 1024;
constexpr size_t WS_WIN = 1 * MiB;
constexpr size_t WS_WUQ = 10 * MiB + 512 * 1024;
constexpr size_t WS_WUKV = 11 * MiB + 256 * 1024;
constexpr size_t WS_RWO = 12 * MiB;
constexpr size_t WS_MWO = 13 * MiB;
constexpr size_t WS_WOUT = 14 * MiB;
constexpr size_t WS_PWQ = 16 * MiB;
constexpr size_t WS_SUBK = 20 * MiB;
constexpr size_t WS_W2T = 20 * MiB + 512 * 1024;
constexpr size_t WS_A2T = WS_W2T + 64 * 1024;
constexpr size_t WS_G2T = WS_A2T + 64 * 1024;
constexpr size_t WS_G = 24 * MiB;
constexpr size_t WS_KRAW = 56 * MiB;
constexpr size_t WS_UB = 56 * MiB, WS_VB = 72 * MiB;
constexpr size_t WS_USC = 64 * MiB;
constexpr size_t WS_SC = 176 * MiB;
constexpr size_t WS_PRW = 88 * MiB;
constexpr size_t WS_Q = 88 * MiB, WS_K = 112 * MiB, WS_VT = 136 * MiB;
constexpr size_t WS_HB = 88 * MiB;
constexpr size_t WS_QD = 152 * MiB, WS_KVD = 164 * MiB, WS_KPE = 172 * MiB;
constexpr size_t WS_O = 152 * MiB;
constexpr size_t WS_R = 176 * MiB, WS_W = 192 * MiB, WS_KS = 208 * MiB, WS_V = 224 * MiB, WS_KK = 240 * MiB;
constexpr size_t WS_YA = 176 * MiB;
constexpr size_t WS_MIXED = 192 * MiB;
constexpr size_t WS_PQ = 184 * MiB;
constexpr size_t WS_TAB = 240 * MiB;
constexpr size_t DO_XN = 0;
constexpr size_t DO_BV = 0, DO_GT = 16 * MiB, DO_BONUS = 32 * MiB, DO_Y = 33 * MiB, DO_KRAW = 33 * MiB, DO_GL = 50 * MiB;

struct Params {
    const float* in[31];
    float* out;
    unsigned char* ws;
};

DEVI unsigned f2bf(float f) { unsigned u = __float_as_uint(f); return (u + 0x7fffu + ((u >> 16) & 1u)) >> 16; }
typedef float f32x2_t __attribute__((ext_vector_type(2)));
typedef __bf16 bf16x2_t __attribute__((ext_vector_type(2)));
DEVI unsigned pk2(float lo, float hi) { f32x2_t v = {lo, hi}; bf16x2_t b = __builtin_convertvector(v, bf16x2_t); return __builtin_bit_cast(unsigned, b); }
DEVI float bflo(unsigned u) { return __uint_as_float(u << 16); }
DEVI float bfhi(unsigned u) { return __uint_as_float(u & 0xffff0000u); }
DEVI float bf1(bf16_t u) { return __uint_as_float(((unsigned)u) << 16); }
DEVI float wave_sum(float v) {
#pragma unroll
    for (int o = 32; o >= 1; o >>= 1) v += __shfl_xor(v, o);
    return v;
}
DEVI float sigmoidf_(float x) { return __builtin_amdgcn_rcpf(1.f + __builtin_amdgcn_exp2f(-1.4426950408889634f * x)); }
DEVI float tanhf_(float x) { return 1.f - 2.f * __builtin_amdgcn_rcpf(__builtin_amdgcn_exp2f(2.885390081777927f * x) + 1.f); }
DEVI void st_bf4(bf16_t* p, float a, float b, float c, float d) { u32x2 w; w.x = pk2(a, b); w.y = pk2(c, d); *(u32x2*)p = w; }
DEVI void ld_bf4(const bf16_t* p, float (&o)[4]) { u32x2 w = *(const u32x2*)p; o[0] = bflo(w.x); o[1] = bfhi(w.x); o[2] = bflo(w.y); o[3] = bfhi(w.y); }
DEVI void ld_bf8(const bf16_t* p, float (&o)[8]) { u32x4 w = *(const u32x4*)p; o[0] = bflo(w.x); o[1] = bfhi(w.x); o[2] = bflo(w.y); o[3] = bfhi(w.y); o[4] = bflo(w.z); o[5] = bfhi(w.z); o[6] = bflo(w.w); o[7] = bfhi(w.w); }
DEVI bf16x8 pack8(const float (&v)[8]) { u32x4 w; w.x = pk2(v[0], v[1]); w.y = pk2(v[2], v[3]); w.z = pk2(v[4], v[5]); w.w = pk2(v[6], v[7]); return __builtin_bit_cast(bf16x8, w); }
DEVI f32x4 mfma16(bf16x8 a, bf16x8 b, f32x4 c) { return __builtin_amdgcn_mfma_f32_16x16x32_bf16(a, b, c, 0, 0, 0); }
DEVI f32x16 mfma32(bf16x8 a, bf16x8 b, f32x16 c) { return __builtin_amdgcn_mfma_f32_32x32x16_bf16(a, b, c, 0, 0, 0); }
DEVI int crow(int r, int hi) { return (r & 3) + 8 * (r >> 2) + 4 * hi; }


template <int CTRL> DEVI float dpp_f(float v) { return __builtin_bit_cast(float, __builtin_amdgcn_update_dpp(0, __builtin_bit_cast(int, v), CTRL, 0xf, 0xf, true)); }
template <int CTRL> DEVI unsigned dpp_u(unsigned v) { return (unsigned)__builtin_amdgcn_update_dpp(0, (int)v, CTRL, 0xf, 0xf, true); }
DEVI float sum8(float v) { v += dpp_f<0xB1>(v); v += dpp_f<0x4E>(v); v += dpp_f<0x141>(v); return v; }
DEVI float sum16(float v) { v = sum8(v); v += dpp_f<0x140>(v); return v; }
DEVI unsigned umax2(unsigned a, unsigned b) { return a > b ? a : b; }
DEVI unsigned umax16(unsigned v) { v = umax2(v, dpp_u<0xB1>(v)); v = umax2(v, dpp_u<0x4E>(v)); v = umax2(v, dpp_u<0x141>(v)); v = umax2(v, dpp_u<0x140>(v)); return v; }
DEVI unsigned rdlane(unsigned v, int l) { return (unsigned)__builtin_amdgcn_readlane((int)v, l); }
#define LAS __attribute__((address_space(3)))

DEVI unsigned pk4_fp8(float a, float b, float c, float d) { int w = 0; w = __builtin_amdgcn_cvt_pk_fp8_f32(a, b, w, false); w = __builtin_amdgcn_cvt_pk_fp8_f32(c, d, w, true); return (unsigned)w; }
DEVI f32x16 mfma32_fp8(u32x2 a, u32x2 b, f32x16 c) { return __builtin_amdgcn_mfma_f32_32x32x16_fp8_fp8(__builtin_bit_cast(long, a), __builtin_bit_cast(long, b), c, 0, 0, 0); }
DEVI f32x4 mfma16_fp8(u32x2 a, u32x2 b, f32x4 c) { return __builtin_amdgcn_mfma_f32_16x16x32_fp8_fp8(__builtin_bit_cast(long, a), __builtin_bit_cast(long, b), c, 0, 0, 0); }
DEVI unsigned pk4_u8(float a, float b, float c, float d) { unsigned w = 0; w = __builtin_amdgcn_cvt_pk_u8_f32(a, 0, w); w = __builtin_amdgcn_cvt_pk_u8_f32(b, 1, w); w = __builtin_amdgcn_cvt_pk_u8_f32(c, 2, w); w = __builtin_amdgcn_cvt_pk_u8_f32(d, 3, w); return w; }
constexpr float U8_SCALE = 32.f, V8_SCALE = 4.f;
constexpr float C8_SCALE = 256.f;

template <int OFF> DEVI f32x4 lds_rd128(unsigned a) { f32x4 r; asm volatile("ds_read_b128 %0, %1 offset:%2" : "=v"(r) : "v"(a), "i"(OFF)); return r; }
template <int OFF> DEVI float lds_rd32(unsigned a) { float r; asm volatile("ds_read_b32 %0, %1 offset:%2" : "=v"(r) : "v"(a), "i"(OFF)); return r; }
DEVI void lds_wr32(unsigned a, float v) { asm volatile("ds_write_b32 %0, %1" ::"v"(a), "v"(v) : "memory"); }

#define SW64(r, k) ((r) * 64 + (((((k) >> 3) ^ ((r) & 7))) << 3) + ((k) & 7))
#define SW32(r, c) ((r) * 32 + (((((c) >> 3) ^ (((r) >> 2) & 3))) << 3) + ((c) & 7))
DEVI int swz_off(int r, int chunk, int ld) { return ld == 64 ? r * 64 + ((chunk ^ (r & 7)) << 3) : r * 32 + ((chunk ^ ((r >> 2) & 3)) << 3); }
template <int MT, int NTL, int KS>
DEVI void gemm_lds(const LAS bf16_t* A, int lda, const LAS bf16_t* B, int ldb, f32x4 (&acc)[MT][NTL], int fr, int fq) {
#pragma unroll
    for (int ks = 0; ks < KS; ++ks) {
        bf16x8 a[MT], b[NTL];
#pragma unroll
        for (int m = 0; m < MT; ++m) a[m] = *(const LAS bf16x8*)(A + swz_off(16 * m + fr, 4 * ks + fq, lda));
#pragma unroll
        for (int n = 0; n < NTL; ++n) b[n] = *(const LAS bf16x8*)(B + swz_off(16 * n + fr, 4 * ks + fq, ldb));
#pragma unroll
        for (int m = 0; m < MT; ++m)
#pragma unroll
            for (int n = 0; n < NTL; ++n) acc[m][n] = mfma16(b[n], a[m], acc[m][n]);
    }
}
DEVI bf16_t bf1of(float x) { return (bf16_t)(pk2(x, x) & 0xffffu); }
DEVI void gemm_tile_acc(const bf16_t* __restrict__ A, int lda, const bf16_t* __restrict__ Bt, int ldb, int K, int m0, int n0, int lane, f32x4 (&acc)[4][4]) {
    const int fr = lane & 15, fq = lane >> 4;
    const bf16_t* ap = A + (size_t)(m0 + fr) * lda + fq * 8;
    const bf16_t* bp = Bt + (size_t)(n0 + fr) * ldb + fq * 8;
#pragma unroll 2
    for (int k0 = 0; k0 < K; k0 += 32) {
        bf16x8 a[4], b[4];
#pragma unroll
        for (int m = 0; m < 4; ++m) a[m] = *(const bf16x8*)(ap + (size_t)m * 16 * lda + k0);
#pragma unroll
        for (int n = 0; n < 4; ++n) b[n] = *(const bf16x8*)(bp + (size_t)n * 16 * ldb + k0);
#pragma unroll
        for (int m = 0; m < 4; ++m)
#pragma unroll
            for (int n = 0; n < 4; ++n) acc[m][n] = mfma16(b[n], a[m], acc[m][n]);
    }
}
DEVI void zero_acc(f32x4 (&acc)[4][4]) {
#pragma unroll
    for (int m = 0; m < 4; ++m)
#pragma unroll
        for (int n = 0; n < 4; ++n) acc[m][n] = (f32x4){0.f, 0.f, 0.f, 0.f};
}


namespace pg8 {
#define PG8_LAS __attribute__((address_space(3)))
typedef unsigned short bf16_t;
typedef short bf16x8 __attribute__((ext_vector_type(8)));
typedef float f32x4 __attribute__((ext_vector_type(4)));
typedef unsigned u32x4 __attribute__((ext_vector_type(4)));
constexpr int BM = 256, BK = 64, HALF = 128, HTB = HALF * BK * 2  , STAGE_BYTES = 8 * HTB, NXCD = 8, WGM = 8;

__host__ __device__ __forceinline__ int lds_byte(int r, int c) { const int st = (r >> 4) * 2 + (c >> 5), rr = r & 15, cc = c & 31, ob = rr * 64 + cc * 2; return st * 1024 + (ob ^ (((ob >> 9) & 1) << 5)); }
__host__ __device__ __forceinline__ void stage_rc(int b, int& R, int& C) { const int st = b / 1024, sb = b % 1024, swz = sb ^ (((sb >> 9) & 1) << 5); R = (st >> 1) * 16 + swz / 64; C = (st & 1) * 32 + (swz % 64) / 2; }
__host__ __device__ __forceinline__ int perm32(int rho) { const int n = rho >> 4, i = rho & 15; return 8 * (i >> 2) + 4 * n + (i & 3); }

struct Unit { int pm, pn; };
struct Gemm { const bf16_t* A; const bf16_t* Bt; int M, N, K; };

struct StaticOrder {
    int nM, nN, nwg, G, c;
    __host__ __device__ void init(int M, int N, int G_, int c_) { nM = M / BM; nN = N / BM; nwg = nM * nN; G = G_; c = c_; }
    __host__ __device__ bool next(int i, Unit& u) const {
        const long L = (long)i * G + c; if (L >= nwg) return false;
        int wgid = (int)L; { const int q = nwg / NXCD, r = nwg % NXCD, xcd = wgid % NXCD, off = wgid / NXCD; wgid = (xcd < r ? xcd * (q + 1) : r * (q + 1) + (xcd - r) * q) + off; }
        const int nig = WGM * nN, gid = wgid / nig, fm = gid * WGM, gsz = (nM - fm) < WGM ? (nM - fm) : WGM;
        u.pm = fm + ((wgid % nig) % gsz); u.pn = (wgid % nig) / gsz; return true;
    }
    __device__ __forceinline__ void a_ready(const Unit&) const {}
    __device__ __forceinline__ void done(const Unit&) const {}
};


DEVI float sigm(float x) { return __builtin_amdgcn_rcpf(1.f + __builtin_amdgcn_exp2f(-1.4426950408889634f * x)); }
DEVI u32x4 pack8v(f32x4 a, f32x4 b) { u32x4 w; w.x = pk2(a[0], a[1]); w.y = pk2(a[2], a[3]); w.z = pk2(b[0], b[1]); w.w = pk2(b[2], b[3]); return w; }
struct EpiP1 {
    static constexpr bool PERM = true, AFTER_DRAIN = false;
    unsigned char* ws;
    __device__ __forceinline__ void operator()(const f32x4 (&acc)[2][2][4][2], const Unit& u, int wr, int wc, int fr_in, int fq_in) const {
        int fr = fr_in, fq = fq_in; asm volatile("" : "+v"(fr), "+v"(fq));
        const int row0 = u.pm * BM + wr * 64 + fr;
        if (u.pn >= 8 && u.pn < 11) {
#pragma unroll
            for (int bj = 0; bj < 2; ++bj) {
                const int c = (u.pn - 8) * 256 + bj * HALF + wc * 32 + 8 * fq;
                const size_t off = c < 384 ? WS_QD : (c < 640 ? WS_KVD : WS_KPE);
                const int ld = c < 384 ? 384 : (c < 640 ? 256 : 32), cc = c < 384 ? c : (c < 640 ? c - 384 : c - 640);
                if (c < 672) {
#pragma unroll
                    for (int ai = 0; ai < 2; ++ai)
#pragma unroll
                        for (int m = 0; m < 4; ++m) { const size_t row = (size_t)(row0 + ai * HALF + m * 16);
                            *(u32x4*)(ws + off + (row * ld + cc) * 2) = pack8v(acc[ai][bj][m][0], acc[ai][bj][m][1]); }
                }
            }
            return;
        }
        if (u.pn >= 11) {
            const int col0 = (u.pn - 11) * 256 + wc * 32 + 8 * fq;
#pragma unroll
            for (int ai = 0; ai < 2; ++ai)
#pragma unroll
                for (int m = 0; m < 4; ++m) { unsigned char* rowp = ws + WS_G + ((size_t)(row0 + ai * HALF + m * 16) * 2048 + col0);
#pragma unroll
                    for (int bj = 0; bj < 2; ++bj) { const f32x4 v0 = acc[ai][bj][m][0], v1 = acc[ai][bj][m][1];
                        u32x2 w; w.x = pk4_u8(sigm(v0[0]) * 255.f, sigm(v0[1]) * 255.f, sigm(v0[2]) * 255.f, sigm(v0[3]) * 255.f);
                        w.y = pk4_u8(sigm(v1[0]) * 255.f, sigm(v1[1]) * 255.f, sigm(v1[2]) * 255.f, sigm(v1[3]) * 255.f);
                        *(u32x2*)(rowp + bj * HALF) = w; } }
            return;
        }
        const int col0 = u.pn * 256 + wc * 32 + 8 * fq;
#pragma unroll
        for (int ai = 0; ai < 2; ++ai)
#pragma unroll
            for (int m = 0; m < 4; ++m) { unsigned char* rowp = ws + WS_PRW + ((size_t)(row0 + ai * HALF + m * 16) * 2048 + col0) * 2;
#pragma unroll
                for (int bj = 0; bj < 2; ++bj) *(u32x4*)(rowp + bj * HALF * 2) = pack8v(acc[ai][bj][m][0], acc[ai][bj][m][1]); }
    }
};
struct EpiQraw {
    static constexpr bool PERM = true, AFTER_DRAIN = false;
    bf16_t* q; const float* ssq;
    __device__ __forceinline__ void operator()(const f32x4 (&acc)[2][2][4][2], const Unit& u, int wr, int wc, int fr_in, int fq_in) const {
        int fr = fr_in, fq = fq_in; asm volatile("" : "+v"(fr), "+v"(fq));
        const int row0 = u.pm * BM + wr * 64 + fr, col0 = u.pn * BM + wc * 32 + 8 * fq;
#pragma unroll
        for (int ai = 0; ai < 2; ++ai)
#pragma unroll
            for (int m = 0; m < 4; ++m) { const size_t row = (size_t)(row0 + ai * HALF + m * 16); const float rs = ssq[row];
#pragma unroll
                for (int bj = 0; bj < 2; ++bj) *(u32x4*)(q + row * 768 + col0 + bj * HALF) = pack8v(acc[ai][bj][m][0] * rs, acc[ai][bj][m][1] * rs); }
    }
};
struct EpiKVraw {
    static constexpr bool PERM = true, AFTER_DRAIN = false;
    bf16_t* kraw; bf16_t* vt; const float* sskv;
    __device__ __forceinline__ void operator()(const f32x4 (&acc)[2][2][4][2], const Unit& u, int wr, int wc, int fr_in, int fq_in) const {
        int fr = fr_in, fq = fq_in; asm volatile("" : "+v"(fr), "+v"(fq));
        const int row0 = u.pm * BM + wr * 64 + fr;
#pragma unroll
        for (int ai = 0; ai < 2; ++ai)
#pragma unroll
            for (int m = 0; m < 4; ++m) { const int row = row0 + ai * HALF + m * 16; const float rs = sskv[row];
#pragma unroll
                for (int bj = 0; bj < 2; ++bj) { const f32x4 v0 = acc[ai][bj][m][0] * rs, v1 = acc[ai][bj][m][1] * rs;
                    if (u.pn < 2) *(u32x4*)(kraw + (size_t)row * 512 + u.pn * BM + bj * HALF + wc * 32 + 8 * fq) = pack8v(v0, v1);
                    else { const int c = (u.pn - 2) * BM + bj * HALF + wc * 32 + 8 * fq, h = c >> 6, d = c & 63; const int bb = row >> 12, s = row & 4095;
                        const int kt = s >> 5, k4 = s & 15, jj = 4 * (k4 >> 3) + (k4 & 3), hv = (k4 >> 2) & 1;
                        unsigned char* vp = (unsigned char*)vt + (((size_t)(bb * 8 + h) * 128 + kt) * 2 + (d >> 5)) * 1024 + ((d & 31) + 32 * hv) * 16 + ((s >> 4) & 1) * 8 + jj;
                        const unsigned w0 = pk4_fp8(v0[0], v0[1], v0[2], v0[3]), w1 = pk4_fp8(v1[0], v1[1], v1[2], v1[3]);
                        vp[0] = (unsigned char)(w0 & 0xffu); vp[16] = (unsigned char)((w0 >> 8) & 0xffu); vp[32] = (unsigned char)((w0 >> 16) & 0xffu); vp[48] = (unsigned char)(w0 >> 24);
                        vp[64] = (unsigned char)(w1 & 0xffu); vp[80] = (unsigned char)((w1 >> 8) & 0xffu); vp[96] = (unsigned char)((w1 >> 16) & 0xffu); vp[112] = (unsigned char)(w1 >> 24); } } }
    }
};
struct EpiGate {
    static constexpr bool PERM = true, AFTER_DRAIN = false;
    bf16_t* mixed; const unsigned char* gg; int goff; int add;
    __device__ __forceinline__ void operator()(const f32x4 (&acc)[2][2][4][2], const Unit& u, int wr, int wc, int fr_in, int fq_in) const {
        int fr = fr_in, fq = fq_in; asm volatile("" : "+v"(fr), "+v"(fq));
        const int row0 = u.pm * BM + wr * 64 + fr, col0 = u.pn * BM + wc * 32 + 8 * fq;
#pragma unroll
        for (int ai = 0; ai < 2; ++ai)
#pragma unroll
            for (int m = 0; m < 4; ++m) { const size_t row = (size_t)(row0 + ai * HALF + m * 16);
#pragma unroll
                for (int bj = 0; bj < 2; ++bj) { const int col = col0 + bj * HALF;
                    const u32x2 gw = *(const u32x2*)(gg + row * 2048 + goff + col);
                    const f32x4 g0 = (f32x4){(float)(gw.x & 0xffu), (float)((gw.x >> 8) & 0xffu), (float)((gw.x >> 16) & 0xffu), (float)(gw.x >> 24)};
                    const f32x4 g1 = (f32x4){(float)(gw.y & 0xffu), (float)((gw.y >> 8) & 0xffu), (float)((gw.y >> 16) & 0xffu), (float)(gw.y >> 24)};
                    f32x4 v0 = g0 * (acc[ai][bj][m][0] * (1.f / 255.f)), v1 = g1 * (acc[ai][bj][m][1] * (1.f / 255.f));
                    if (add) { const u32x4 pw = *(const u32x4*)(mixed + row * 1024 + col);
                        v0 += (f32x4){__uint_as_float(pw.x << 16), __uint_as_float(pw.x & 0xffff0000u), __uint_as_float(pw.y << 16), __uint_as_float(pw.y & 0xffff0000u)};
                        v1 += (f32x4){__uint_as_float(pw.z << 16), __uint_as_float(pw.z & 0xffff0000u), __uint_as_float(pw.w << 16), __uint_as_float(pw.w & 0xffff0000u)}; }
                    *(u32x4*)(mixed + row * 1024 + col) = pack8v(v0, v1); } }
    }
};
struct EpiRes {
    static constexpr bool PERM = true, AFTER_DRAIN = false;
    const float* x; bf16_t* hb; float* ss2;
    __device__ __forceinline__ void operator()(const f32x4 (&acc)[2][2][4][2], const Unit& u, int wr, int wc, int fr_in, int fq_in) const {
        int fr = fr_in, fq = fq_in; asm volatile("" : "+v"(fr), "+v"(fq));
        const int row0 = u.pm * BM + wr * 64 + fr, col0 = u.pn * BM + wc * 32 + 8 * fq;
#pragma unroll
        for (int ai = 0; ai < 2; ++ai)
#pragma unroll
            for (int m = 0; m < 4; ++m) { const size_t row = (size_t)(row0 + ai * HALF + m * 16); float sq = 0.f;
#pragma unroll
                for (int bj = 0; bj < 2; ++bj) { const size_t o = row * 1024 + col0 + bj * HALF;
                    const f32x4 h0 = *(const f32x4*)(x + o) + acc[ai][bj][m][0], h1 = *(const f32x4*)(x + o + 4) + acc[ai][bj][m][1];
                    *(u32x4*)(hb + o) = pack8v(h0, h1);
                    sq += (h0[0] * h0[0] + h0[1] * h0[1]) + (h0[2] * h0[2] + h0[3] * h0[3]) + (h1[0] * h1[0] + h1[1] * h1[1]) + (h1[2] * h1[2] + h1[3] * h1[3]); }
                sq += __shfl_xor(sq, 16); sq += __shfl_xor(sq, 32);
                if (fq == 0) atomicAdd(ss2 + row, sq); }
    }
};
struct EpiScale {
    static constexpr bool PERM = true, AFTER_DRAIN = false;
    bf16_t* pq; const float* ss2;
    __device__ __forceinline__ void operator()(const f32x4 (&acc)[2][2][4][2], const Unit& u, int wr, int wc, int fr_in, int fq_in) const {
        int fr = fr_in, fq = fq_in; asm volatile("" : "+v"(fr), "+v"(fq));
        const int row0 = u.pm * BM + wr * 64 + fr, col0 = u.pn * BM + wc * 32 + 8 * fq;
#pragma unroll
        for (int ai = 0; ai < 2; ++ai)
#pragma unroll
            for (int m = 0; m < 4; ++m) { const size_t row = (size_t)(row0 + ai * HALF + m * 16); const float rs = rsqrtf(ss2[row] * (1.f / 1024.f) + 1e-6f);
#pragma unroll
                for (int bj = 0; bj < 2; ++bj) *(u32x4*)(pq + row * 2048 + col0 + bj * HALF) = pack8v(acc[ai][bj][m][0] * rs, acc[ai][bj][m][1] * rs); }
    }
};
template <class Epi, class Sched, bool ALIGN_EPI = false, bool SP2 = false>
__device__ __forceinline__ void gemm_phase(PG8_LAS unsigned char* lds, const Gemm g, const Sched& S, const Epi& E) {
    int tid_l = threadIdx.x; asm volatile("" : "+v"(tid_l));
    const int tid = tid_l, wid = __builtin_amdgcn_readfirstlane(tid >> 6), lane = tid & 63, wr = wid >> 2, wc = wid & 3, fr = lane & 15, fq = lane >> 4;
    const int K = g.K, nt = K / BK;
    unsigned voffA[2], voffB[2];
#pragma unroll
    for (int i = 0; i < 2; ++i) { int R, C; stage_rc(tid * 16 + i * 8192, R, C); const int Rb = Epi::PERM ? ((R & ~31) + perm32(R & 31)) : R;
        voffA[i] = (unsigned)(R * K + C) * 2u; voffB[i] = (unsigned)(Rb * K + C) * 2u; }
    const size_t kstep = (size_t)(BK * 2);
    const size_t hstep = (size_t)HALF * K * 2;
    const size_t tstep = 2 * hstep;
    const unsigned ldsw = (unsigned)wid * 1024u;
    const int aoff = lds_byte(wr * 64 + fr, fq * 8), boff = lds_byte(wc * 32 + fr, fq * 8);
#define PG8_SA(b, h) (((b) * 2 + (h)) * HTB)
#define PG8_SB(b, h) ((4 + (b) * 2 + (h)) * HTB)
#define PG8_STAGE(bufoff, gbase, voff) do { _Pragma("unroll") for (int _i = 0; _i < 2; ++_i) \
        __builtin_amdgcn_global_load_lds((const unsigned*)((const char*)(gbase) + (voff)[_i]), (PG8_LAS unsigned*)(lds + (bufoff) + ldsw + _i * 8192), 16, 0, 0); } while (0)
#define PG8_LDA(dst, b, h) do { _Pragma("unroll") for (int m = 0; m < 4; ++m) _Pragma("unroll") for (int k = 0; k < 2; ++k) dst[m][k] = *(const PG8_LAS bf16x8*)(lds + PG8_SA(b, h) + aoff + m * 2048 + k * 1024); } while (0)
#define PG8_LDB(dst, b, h) do { _Pragma("unroll") for (int n = 0; n < 2; ++n) _Pragma("unroll") for (int k = 0; k < 2; ++k) dst[n][k] = *(const PG8_LAS bf16x8*)(lds + PG8_SB(b, h) + boff + n * 2048 + k * 1024); } while (0)
#define PG8_MMA(ai, bj, At, Bt) do { __builtin_amdgcn_s_setprio(1); _Pragma("unroll") for (int m = 0; m < 4; ++m) _Pragma("unroll") for (int n = 0; n < 2; ++n) _Pragma("unroll") for (int k = 0; k < 2; ++k) \
        acc[ai][bj][m][n] = __builtin_amdgcn_mfma_f32_16x16x32_bf16(Bt[n][k], At[m][k], acc[ai][bj][m][n], 0, 0, 0); __builtin_amdgcn_s_setprio(0); } while (0)
#define PG8_WAIT_V(n) asm volatile("s_waitcnt vmcnt(" #n ")" ::: "memory")
#define PG8_WAIT_L(n) asm volatile("s_waitcnt lgkmcnt(" #n ")" ::: "memory")
#define PG8_BAR __builtin_amdgcn_s_barrier()
#define PG8_SCHED __builtin_amdgcn_sched_barrier(0)
    Unit cur, nxt; int ui = 0;
    if (!S.next(0, cur)) return;
    f32x4 acc[2][2][4][2];
#pragma unroll
    for (int a = 0; a < 2; ++a)
#pragma unroll
        for (int b = 0; b < 2; ++b)
#pragma unroll
            for (int m = 0; m < 4; ++m)
#pragma unroll
                for (int n = 0; n < 2; ++n) acc[a][b][m][n] = (f32x4){0.f, 0.f, 0.f, 0.f};
    bf16x8 At[4][2], B0[2][2], B1[2][2];
    const char* cA = (const char*)g.A + (size_t)cur.pm * tstep; const char* cB = (const char*)g.Bt + (size_t)cur.pn * tstep;
    S.a_ready(cur);
    if constexpr (SP2) {
        PG8_STAGE(PG8_SB(0, 0), cB, voffB); PG8_STAGE(PG8_SB(0, 1), cB + hstep, voffB); PG8_STAGE(PG8_SA(0, 0), cA, voffA); PG8_STAGE(PG8_SA(0, 1), cA + hstep, voffA);
        if (wr == 1) PG8_BAR;
        PG8_WAIT_V(2); PG8_BAR;
        PG8_STAGE(PG8_SB(1, 0), cB + kstep, voffB); PG8_STAGE(PG8_SA(1, 0), cA + kstep, voffA); PG8_STAGE(PG8_SB(1, 1), cB + hstep + kstep, voffB);
        PG8_WAIT_V(6); PG8_BAR;
    } else {
        PG8_STAGE(PG8_SB(0, 0), cB, voffB); PG8_STAGE(PG8_SA(0, 0), cA, voffA); PG8_STAGE(PG8_SB(0, 1), cB + hstep, voffB); PG8_STAGE(PG8_SA(0, 1), cA + hstep, voffA);
        if (wr == 1) PG8_BAR;
        PG8_WAIT_V(4); PG8_BAR;
        PG8_STAGE(PG8_SB(1, 0), cB + kstep, voffB); PG8_STAGE(PG8_SA(1, 0), cA + kstep, voffA); PG8_STAGE(PG8_SB(1, 1), cB + hstep + kstep, voffB);
        PG8_WAIT_V(6); PG8_BAR;
    }
    for (;;) {
        const bool has_next = S.next(ui + 1, nxt);
        const char* nA = has_next ? (const char*)g.A + (size_t)nxt.pm * tstep : cA; const char* nB = has_next ? (const char*)g.Bt + (size_t)nxt.pn * tstep : cB;
        for (int t = 0; t < nt; t += 2) {
            const bool last = (t == nt - 2);
            const char* a1 = cA + (size_t)(t + 1) * kstep;
            const char* a2 = last ? nA : cA + (size_t)(t + 2) * kstep; const char* b2 = last ? nB : cB + (size_t)(t + 2) * kstep;
            const char* a3 = a2 + kstep; const char* b3 = b2 + kstep;
            if (last && has_next) S.a_ready(nxt);
            if constexpr (SP2) {
            PG8_LDB(B0, 0, 0); PG8_LDB(B1, 0, 1); PG8_SCHED; PG8_LDA(At, 0, 0); PG8_STAGE(PG8_SA(1, 1), a1 + hstep, voffA);
            PG8_WAIT_V(8); PG8_WAIT_L(0); PG8_BAR; PG8_MMA(0, 0, At, B0); PG8_MMA(0, 1, At, B1); PG8_BAR; PG8_SCHED;
            PG8_LDA(At, 0, 1); PG8_STAGE(PG8_SB(0, 0), b2, voffB); PG8_STAGE(PG8_SB(0, 1), b2 + hstep, voffB); PG8_STAGE(PG8_SA(0, 0), a2, voffA);
            PG8_WAIT_V(8); PG8_WAIT_L(0); PG8_BAR; PG8_MMA(1, 0, At, B0); PG8_MMA(1, 1, At, B1); PG8_BAR; PG8_SCHED;
            PG8_LDB(B0, 1, 0); PG8_LDB(B1, 1, 1); PG8_SCHED; PG8_LDA(At, 1, 0); PG8_STAGE(PG8_SA(0, 1), a2 + hstep, voffA);
            PG8_WAIT_V(8); PG8_WAIT_L(0); PG8_BAR; PG8_MMA(0, 0, At, B0); PG8_MMA(0, 1, At, B1); PG8_BAR; PG8_SCHED;
            PG8_LDA(At, 1, 1); PG8_STAGE(PG8_SB(1, 0), b3, voffB); PG8_STAGE(PG8_SB(1, 1), b3 + hstep, voffB); PG8_STAGE(PG8_SA(1, 0), a3, voffA);
            PG8_WAIT_V(8); PG8_WAIT_L(0); PG8_BAR; PG8_MMA(1, 0, At, B0); PG8_MMA(1, 1, At, B1); PG8_BAR; PG8_SCHED;
            } else {
            PG8_LDB(B0, 0, 0); PG8_SCHED; PG8_LDA(At, 0, 0); PG8_STAGE(PG8_SA(1, 1), a1 + hstep, voffA);
            PG8_WAIT_L(8); PG8_BAR; PG8_WAIT_L(0); PG8_MMA(0, 0, At, B0); PG8_BAR; PG8_SCHED;
            PG8_LDB(B1, 0, 1); PG8_STAGE(PG8_SB(0, 0), b2, voffB);
            PG8_BAR; PG8_WAIT_L(0); PG8_MMA(0, 1, At, B1); PG8_BAR;
            PG8_LDA(At, 0, 1); PG8_STAGE(PG8_SA(0, 0), a2, voffA);
            PG8_BAR; PG8_WAIT_L(0); PG8_MMA(1, 0, At, B0); PG8_BAR; PG8_SCHED;
            PG8_STAGE(PG8_SB(0, 1), b2 + hstep, voffB);
            PG8_WAIT_V(6); PG8_BAR; PG8_MMA(1, 1, At, B1); PG8_BAR;
            PG8_LDB(B0, 1, 0); PG8_SCHED; PG8_LDA(At, 1, 0); PG8_STAGE(PG8_SA(0, 1), a2 + hstep, voffA);
            PG8_WAIT_L(8); PG8_BAR; PG8_WAIT_L(0); PG8_MMA(0, 0, At, B0); PG8_BAR; PG8_SCHED;
            PG8_LDB(B1, 1, 1); PG8_STAGE(PG8_SB(1, 0), b3, voffB);
            PG8_BAR; PG8_WAIT_L(0); PG8_MMA(0, 1, At, B1); PG8_BAR;
            PG8_LDA(At, 1, 1); PG8_STAGE(PG8_SA(1, 0), a3, voffA);
            PG8_BAR; PG8_WAIT_L(0); PG8_MMA(1, 0, At, B0); PG8_BAR; PG8_SCHED;
            PG8_STAGE(PG8_SB(1, 1), b3 + hstep, voffB);
            PG8_WAIT_V(6); PG8_BAR; PG8_MMA(1, 1, At, B1); PG8_BAR;
            }
        }
        if constexpr (ALIGN_EPI) { if (wr == 0) PG8_BAR; }
        if constexpr (!Epi::AFTER_DRAIN) { E(acc, cur, wr, wc, fr, fq); S.done(cur); }
        if (!has_next) break;
#pragma unroll
        for (int a = 0; a < 2; ++a)
#pragma unroll
            for (int b = 0; b < 2; ++b)
#pragma unroll
                for (int m = 0; m < 4; ++m)
#pragma unroll
                    for (int n = 0; n < 2; ++n) acc[a][b][m][n] = (f32x4){0.f, 0.f, 0.f, 0.f};
        cur = nxt; cA = nA; cB = nB; ++ui;
        if constexpr (ALIGN_EPI) { if (wr == 1) PG8_BAR; }
    }
    PG8_WAIT_V(0);
    if constexpr (!ALIGN_EPI) { if (wr == 0) PG8_BAR; }
    PG8_BAR;
    if constexpr (Epi::AFTER_DRAIN) { E.fused(acc, cur, wr, wc, fr, fq, lds, wid, lane); S.done(cur); }
#undef PG8_SA
#undef PG8_SB
#undef PG8_STAGE
#undef PG8_LDA
#undef PG8_LDB
#undef PG8_MMA
#undef PG8_WAIT_V
#undef PG8_WAIT_L
#undef PG8_BAR
#undef PG8_SCHED
}
}


#define RLX_AGENT __ATOMIC_RELAXED, __HIP_MEMORY_SCOPE_AGENT
#define XB_TMO      128
#define XB_XCNT(j)  (256  + 64 * (j))
#define XB_XSUB(j)  (1280 + 64 * (j))
#define XB_XGEN(j)  (2304 + 64 * (j))
#define XB_TOP      3328
#define XB_TOPGEN   3392
#define XCD_BAR_WORDS 3456
#define XB_SPIN_CAP (1u << 18)

__device__ __forceinline__ unsigned xb_ld(unsigned* p)              { return __hip_atomic_load(p, __ATOMIC_RELAXED, __HIP_MEMORY_SCOPE_AGENT); }
__device__ __forceinline__ unsigned xb_add(unsigned* p, unsigned v) { return __hip_atomic_fetch_add(p, v, __ATOMIC_RELAXED, __HIP_MEMORY_SCOPE_AGENT); }
__device__ __forceinline__ unsigned xb_xcc_id() { return (unsigned)__builtin_amdgcn_s_getreg((3 << 11) | 20) & 0xFu; }
#define XB_SPIN(cond, bar) do { unsigned _sp = 0; while (cond) { __builtin_amdgcn_s_sleep(1); \
    if ((++_sp & 255u) == 0u) { if (xb_ld(&(bar)[XB_TMO])) break; if (_sp > XB_SPIN_CAP) { atomicAdd(&(bar)[XB_TMO], 1u); break; } } } } while (0)

struct XcdBarrier {
    unsigned* bar; unsigned x;
    volatile LAS unsigned* st;
};

__device__ __forceinline__ XcdBarrier xcd_barrier_post(unsigned* bar, volatile LAS unsigned* st) {
    XcdBarrier b; b.bar = bar; b.x = xb_xcc_id(); b.st = st;
    if (threadIdx.x == 0) (void)xb_add(&bar[XB_XCNT(b.x)], 1u);
    return b;
}
__device__ __forceinline__ void xcd_barrier_complete(unsigned* bar, unsigned x, unsigned& nloc, unsigned& nx) {
    const unsigned G = gridDim.x * gridDim.y * gridDim.z;
    unsigned sum, cnt, mine, sp = 0u;
    for (;;) {
        sum = 0u; cnt = 0u; mine = 0u;
#pragma unroll
        for (unsigned j = 0; j < 16; ++j) { const unsigned c = xb_ld(&bar[XB_XCNT(j)]); sum += c; cnt += (c > 0u) ? 1u : 0u; mine = (j == x) ? c : mine; }
        if (sum == G) break;
        __builtin_amdgcn_s_sleep(1);
        if ((++sp & 255u) == 0u) { if (xb_ld(&bar[XB_TMO])) break; if (sp > XB_SPIN_CAP) { atomicAdd(&bar[XB_TMO], 1u); break; } }
    }
    nloc = mine > 0u ? mine : 1u; nx = cnt > 0u ? cnt : 1u;
}

__device__ __forceinline__ void xcd_barrier(const XcdBarrier& b) {
    asm volatile("s_waitcnt vmcnt(0)" ::: "memory");
    __syncthreads();
    if (threadIdx.x == 0) {
        unsigned* bar = b.bar;
        __builtin_amdgcn_s_waitcnt(0);
        unsigned nloc = b.st[0], nx = b.st[1];
        if (nloc == 0u) { xcd_barrier_complete(bar, b.x, nloc, nx); b.st[0] = nloc; b.st[1] = nx; }
        const unsigned old = xb_add(&bar[XB_XSUB(b.x)], 1u);
        const unsigned gen = old / nloc;
        if (old + 1u == (gen + 1u) * nloc) {
            __builtin_amdgcn_fence(__ATOMIC_RELEASE, "agent");
            asm volatile("s_waitcnt vmcnt(0)" ::: "memory");
            const unsigned og = xb_add(&bar[XB_TOP], 1u);
            const unsigned tg = og / nx;
            if (og + 1u == (tg + 1u) * nx) xb_add(&bar[XB_TOPGEN], 1u);
            else XB_SPIN(xb_ld(&bar[XB_TOPGEN]) == tg, bar);
            __builtin_amdgcn_fence(__ATOMIC_ACQUIRE, "agent");
            asm volatile("s_waitcnt vmcnt(0)" ::: "memory");
        } else {
            XB_SPIN(xb_ld(&bar[XB_TOPGEN]) == gen, bar);
            __builtin_amdgcn_fence(__ATOMIC_ACQUIRE, "agent");
            asm volatile("s_waitcnt vmcnt(0)" ::: "memory");
        }
    }
    __syncthreads();
}

DEVI void transpose_item(const float* __restrict__ W, int ldw, int c0, bf16_t* WT, int ldk, int r0, int Kmax, int kb, int nb, const float* kscale, float* scr, int lane, int fragKS = 0) {
    const int k0 = 64 * kb, n0 = 32 * nb;
    {
        float vv[32];
#pragma unroll
        for (int i = 0; i < 32; ++i) { const int kk = 2 * i + (lane >> 5); const int kc = k0 + kk < Kmax ? k0 + kk : Kmax - 1; vv[i] = W[(size_t)kc * ldw + c0 + n0 + (lane & 31)]; }
        __builtin_amdgcn_sched_barrier(0);
#pragma unroll
        for (int i = 0; i < 32; ++i) { const int kk = 2 * i + (lane >> 5);
            float v = k0 + kk < Kmax ? vv[i] : 0.f; if (kscale && k0 + kk < Kmax) v *= kscale[k0 + kk];
            scr[kk * 33 + (lane & 31)] = v; }
    }
    asm volatile("s_waitcnt lgkmcnt(0)" ::: "memory");
    asm volatile("" ::: "memory");
    const int c = lane & 7;
    if (k0 + 8 * c < Kmax) {
#pragma unroll
        for (int j = 0; j < 4; ++j) {
            const int n = (lane >> 3) + 8 * j;
            const float* s = scr + (8 * c) * 33 + n;
            u32x4 o; o.x = pk2(s[0], s[33]); o.y = pk2(s[66], s[99]); o.z = pk2(s[132], s[165]); o.w = pk2(s[198], s[231]);
            if (fragKS > 0) { const int row = r0 + n0 + n, k = k0 + 8 * c, hd = row >> 6, rr = row & 63;
                *(u32x4*)(WT + ((size_t)(((hd * fragKS + (k >> 5)) * 4 + ((rr >> 2) & 3)) * 64 + ((k >> 3) & 3) * 16 + 4 * (rr >> 4) + (rr & 3))) * 8) = o; }
            else *(u32x4*)(WT + (size_t)(r0 + n0 + n) * ldk + k0 + 8 * c) = o;
        }
    }
    asm volatile("s_waitcnt lgkmcnt(0)" ::: "memory");
    asm volatile("" ::: "memory");
}


DEVI void wcomb_item(const float* __restrict__ Wq, const float* __restrict__ Sk, const float* __restrict__ n2w, bf16_t* WcT, int it, int lane) {
    const int fr = lane & 15, fq = lane >> 4;
    const int hp = it >> 6, nt = (it >> 4) & 3, kt = it & 15;
    const float* ap = Sk + ((size_t)hp * 128 + nt * 32 + fr) * 128 + fq * 8;
    const float* bp = Wq + (size_t)(kt * 64 + fr) * 2048 + hp * 128 + fq * 8;
    f32x4 acc[2][4];
#pragma unroll
    for (int m = 0; m < 2; ++m)
#pragma unroll
        for (int n = 0; n < 4; ++n) acc[m][n] = (f32x4){0.f, 0.f, 0.f, 0.f};
#pragma unroll
    for (int k0 = 0; k0 < 128; k0 += 32) {
        bf16x8 a[2], b[4];
#pragma unroll
        for (int m = 0; m < 2; ++m) { const f32x4 lo = *(const f32x4*)(ap + (size_t)m * 16 * 128 + k0), hi = *(const f32x4*)(ap + (size_t)m * 16 * 128 + k0 + 4);
            u32x4 w; w.x = pk2(lo.x, lo.y); w.y = pk2(lo.z, lo.w); w.z = pk2(hi.x, hi.y); w.w = pk2(hi.z, hi.w); a[m] = __builtin_bit_cast(bf16x8, w); }
#pragma unroll
        for (int n = 0; n < 4; ++n) { const f32x4 lo = *(const f32x4*)(bp + (size_t)n * 16 * 2048 + k0), hi = *(const f32x4*)(bp + (size_t)n * 16 * 2048 + k0 + 4);
            u32x4 w; w.x = pk2(lo.x, lo.y); w.y = pk2(lo.z, lo.w); w.z = pk2(hi.x, hi.y); w.w = pk2(hi.z, hi.w); b[n] = __builtin_bit_cast(bf16x8, w); }
#pragma unroll
        for (int m = 0; m < 2; ++m)
#pragma unroll
            for (int n = 0; n < 4; ++n) acc[m][n] = mfma16(b[n], a[m], acc[m][n]);
    }
#pragma unroll
    for (int n = 0; n < 4; ++n) {
        const int col = kt * 64 + 16 * n + 4 * fq; const f32x4 w = *(const f32x4*)(n2w + col);
#pragma unroll
        for (int m = 0; m < 2; ++m) { const int row = hp * 128 + nt * 32 + 16 * m + fr; st_bf4(WcT + (size_t)row * 1024 + col, acc[m][n][0] * w.x, acc[m][n][1] * w.y, acc[m][n][2] * w.z, acc[m][n][3] * w.w); }
    }
}

DEVI unsigned q_e2m1(float x, float& val) {
    const float a = fabsf(x);
    const unsigned rb = (__float_as_uint(a) + 0x00200000u) & 0xffc00000u;
    const unsigned cn = (rb >> 22) - 252u;
    const unsigned cs = (a >= 0.25f ? 1u : 0u) + (a >= 0.75f ? 1u : 0u);
    const bool big = a >= 1.f;
    const unsigned c = big ? (cn > 7u ? 7u : cn) : cs;
    const float hv = big ? fminf(__uint_as_float(rb), 6.f) : 0.5f * (float)cs;
    val = x < 0.f ? -hv : hv;
    return c | (x < 0.f ? 8u : 0u);
}

DEVI int peer_pair(int s) {
    if (s < 16) return s;
    if (s < 24) return 16 + (s - 16);
    if (s < 29) return 32 + (s - 24);
    if (s < 33) return 48 + (s - 29);
    if (s < 36) return 64 + (s - 33);
    if (s < 42) return 80 + 16 * ((s - 36) >> 1) + ((s - 36) & 1);
    if (s < 50) return 128 + 16 * (s - 42);
    return -1;
}

#define KARG __attribute__((address_space(4)))
DEVI const KARG Params* kargs() { unsigned long long k = (unsigned long long)__builtin_amdgcn_kernarg_segment_ptr(); asm volatile("" : "+s"(k)); return (const KARG Params*)k; }
#define PHASE_PTRS \
    int tid_l_ = threadIdx.x; asm volatile("" : "+v"(tid_l_)); \
    [[maybe_unused]] const int tid = tid_l_, lane = tid & 63, wave = __builtin_amdgcn_readfirstlane(tid >> 6), gw = blockIdx.x * NWAVES + wave, fr = lane & 15, fq = lane >> 4; \
    const KARG Params* kp = kargs(); unsigned char* ws = kp->ws; unsigned char* dob = (unsigned char*)kp->out; (void)ws; (void)dob; \
    [[maybe_unused]] const float* x = kp->in[0]; [[maybe_unused]] const int* positions = (const int*)kp->in[1]; [[maybe_unused]] const float* norm1_w = kp->in[2]; [[maybe_unused]] const float* w_in = kp->in[3]; \
    [[maybe_unused]] const float* rw_mu = kp->in[4]; [[maybe_unused]] const float* rw_w0 = kp->in[5]; [[maybe_unused]] const float* rw_a0 = kp->in[7]; [[maybe_unused]] const float* rw_k_k = kp->in[10]; \
    [[maybe_unused]] const float* rw_k_a = kp->in[11]; [[maybe_unused]] const float* rw_r_k = kp->in[12]; [[maybe_unused]] const float* rw_ln_w = kp->in[13]; [[maybe_unused]] const float* rw_ln_b = kp->in[14]; \
    [[maybe_unused]] const float* q_norm_w = kp->in[16]; [[maybe_unused]] const float* kv_norm_w = kp->in[18]; [[maybe_unused]] const float* qn_nope_w = kp->in[20]; [[maybe_unused]] const float* qn_pe_w = kp->in[21]; \
    [[maybe_unused]] const float* kn_nope_w = kp->in[22]; [[maybe_unused]] const float* kn_pe_w = kp->in[23]; [[maybe_unused]] const float* norm2_w = kp->in[26]; \
    [[maybe_unused]] float* ss2 = (float*)(ws + WS_SS2); [[maybe_unused]] unsigned* cnt = (unsigned*)(ws + WS_CNT); [[maybe_unused]] unsigned* xbar_words = (unsigned*)(ws + WS_CNT + 4096); \
    [[maybe_unused]] bf16_t* WinT = (bf16_t*)(ws + WS_WIN); [[maybe_unused]] bf16_t* WuqT = (bf16_t*)(ws + WS_WUQ); [[maybe_unused]] bf16_t* WukvT = (bf16_t*)(ws + WS_WUKV); [[maybe_unused]] bf16_t* RwoT = (bf16_t*)(ws + WS_RWO); \
    [[maybe_unused]] bf16_t* MwoT = (bf16_t*)(ws + WS_MWO); [[maybe_unused]] bf16_t* WoutT = (bf16_t*)(ws + WS_WOUT); [[maybe_unused]] bf16_t* PwqT = (bf16_t*)(ws + WS_PWQ); [[maybe_unused]] bf16_t* SubK = (bf16_t*)(ws + WS_SUBK); \
    [[maybe_unused]] bf16_t* W2T = (bf16_t*)(ws + WS_W2T); [[maybe_unused]] bf16_t* A2T = (bf16_t*)(ws + WS_A2T); [[maybe_unused]] bf16_t* G2T = (bf16_t*)(ws + WS_G2T); [[maybe_unused]] const unsigned char* Gg = ws + WS_G; \
    [[maybe_unused]] bf16_t* Prw = (bf16_t*)(ws + WS_PRW); [[maybe_unused]] bf16_t* QD = (bf16_t*)(ws + WS_QD); [[maybe_unused]] bf16_t* KVD = (bf16_t*)(ws + WS_KVD); [[maybe_unused]] bf16_t* KPE = (bf16_t*)(ws + WS_KPE); \
    [[maybe_unused]] float* ssq = (float*)(ws + WS_SSQ); [[maybe_unused]] float* sskv = (float*)(ws + WS_SSKV); [[maybe_unused]] bf16_t* XN = (bf16_t*)(dob + DO_XN); \
    [[maybe_unused]] bf16_t* Rb = (bf16_t*)(ws + WS_R); [[maybe_unused]] bf16_t* Wb = (bf16_t*)(ws + WS_W); [[maybe_unused]] bf16_t* Kb = (bf16_t*)(ws + WS_KS); [[maybe_unused]] bf16_t* Vb = (bf16_t*)(ws + WS_V); [[maybe_unused]] bf16_t* KKb = (bf16_t*)(ws + WS_KK); \
    [[maybe_unused]] bf16_t* Bvb = (bf16_t*)(dob + DO_BV); [[maybe_unused]] bf16_t* Gtb = (bf16_t*)(dob + DO_GT); [[maybe_unused]] float* bonus = (float*)(dob + DO_BONUS); [[maybe_unused]] bf16_t* Yb = (bf16_t*)(dob + DO_Y); \
    [[maybe_unused]] bf16_t* Qb = (bf16_t*)(ws + WS_Q); [[maybe_unused]] bf16_t* Kab = (bf16_t*)(ws + WS_K); [[maybe_unused]] bf16_t* Vt = (bf16_t*)(ws + WS_VT); [[maybe_unused]] bf16_t* Kraw = (bf16_t*)(ws + WS_KRAW); \
    [[maybe_unused]] bf16_t* Ob = (bf16_t*)(ws + WS_O); [[maybe_unused]] bf16_t* YA = (bf16_t*)(ws + WS_YA); [[maybe_unused]] bf16_t* MIXED = (bf16_t*)(ws + WS_MIXED); [[maybe_unused]] bf16_t* HB = (bf16_t*)(ws + WS_HB); \
    [[maybe_unused]] bf16_t* UB = (bf16_t*)(ws + WS_UB); [[maybe_unused]] bf16_t* VBp = (bf16_t*)(ws + WS_VB); [[maybe_unused]] bf16_t* PQ = (bf16_t*)(ws + WS_PQ); [[maybe_unused]] bf16_t* SC = (bf16_t*)(ws + WS_SC);

constexpr size_t PEER_CONV_Q = (size_t)16384 * 32 / 4;
#define PEER_CONV(LO_, HI_) { const float* pu = kp->in[29]; const float* pv = kp->in[30]; unsigned char* UF4 = ws + WS_UB; unsigned char* USC = ws + WS_USC; \
          for (size_t i = (size_t)(LO_) + (size_t)blockIdx.x * NT + tid; i < (size_t)(HI_); i += (size_t)G * NT) {        \
              const size_t e = i >> 5; const int kblk = (int)(i & 31); \
              float uv[32]; float amax = 0.f; \
              _Pragma("unroll") for (int q = 0; q < 8; ++q) { const f32x4 u = ((const f32x4*)pu)[i * 8 + q]; const f32x4 w = ((const f32x4*)norm2_w)[kblk * 8 + q]; \
                  uv[4 * q] = u.x * w.x; uv[4 * q + 1] = u.y * w.y; uv[4 * q + 2] = u.z * w.z; uv[4 * q + 3] = u.w * w.w; \
                  amax = fmaxf(fmaxf(amax, fmaxf(fabsf(uv[4 * q]), fabsf(uv[4 * q + 1]))), fmaxf(fabsf(uv[4 * q + 2]), fabsf(uv[4 * q + 3]))); } \
              amax = fmaxf(amax, __shfl_xor(amax, 1)); amax = fmaxf(amax, __shfl_xor(amax, 2));        \
                \
              const unsigned tb_ = __float_as_uint(amax * (1.f / 6.f)); unsigned E_ = ((tb_ >> 23) & 0xffu) + ((tb_ & 0x7fffffu) ? 1u : 0u); E_ = E_ < 1u ? 1u : (E_ > 254u ? 254u : E_); \
              const float inv_ = __uint_as_float((254u - E_) << 23); \
              u32x4 pk_; \
              _Pragma("unroll") for (int d = 0; d < 4; ++d) { unsigned wd_ = 0u;        \
                  wd_ = __builtin_amdgcn_cvt_scalef32_pk_fp4_f32(wd_, uv[8 * d] * inv_, uv[8 * d + 1] * inv_, 1.0f, 0); wd_ = __builtin_amdgcn_cvt_scalef32_pk_fp4_f32(wd_, uv[8 * d + 2] * inv_, uv[8 * d + 3] * inv_, 1.0f, 1); \
                  wd_ = __builtin_amdgcn_cvt_scalef32_pk_fp4_f32(wd_, uv[8 * d + 4] * inv_, uv[8 * d + 5] * inv_, 1.0f, 2); wd_ = __builtin_amdgcn_cvt_scalef32_pk_fp4_f32(wd_, uv[8 * d + 6] * inv_, uv[8 * d + 7] * inv_, 1.0f, 3); \
                  pk_[d] = wd_; } \
              *(u32x4*)(UF4 + e * 512 + 16 * kblk) = pk_; \
              if ((kblk & 3) == 0) USC[e * 8 + (kblk >> 2)] = (unsigned char)E_; \
              _Pragma("unroll") for (int hh_ = 0; hh_ < 2; ++hh_) { const size_t i2 = 2 * i + hh_; u32x4 vo; \
                  _Pragma("unroll") for (int q = 0; q < 4; ++q) { const f32x4 v = ((const f32x4*)pv)[i2 * 4 + q]; vo[q] = pk4_fp8(v.x * V8_SCALE, v.y * V8_SCALE, v.z * V8_SCALE, v.w * V8_SCALE); } \
                  const size_t e2 = i2 >> 6; const int d0 = (int)(i2 & 63) * 16; *(u32x4*)((unsigned char*)VBp + ((size_t)(d0 >> 7) * 16384 + e2) * 128 + (d0 & 127)) = vo; } } }

__global__ void __launch_bounds__(NT, 2) mega(Params p) {
    extern __shared__ __attribute__((aligned(16))) unsigned char lds[];
    cg::grid_group grid = cg::this_grid();
    const int G = gridDim.x, NGW = G * NWAVES;
    volatile LAS unsigned* bst = (volatile LAS unsigned*)((LAS unsigned char*)lds + LDS_BYTES - 16);
    if (threadIdx.x < 2) bst[threadIdx.x] = 0u;
    if (threadIdx.x >= 8 && threadIdx.x < 16) ((volatile LAS unsigned*)((LAS unsigned char*)lds + LDS_BYTES - 64))[threadIdx.x - 8] = 0u;
    if (threadIdx.x >= 16 && threadIdx.x < 32) ((volatile LAS unsigned*)((LAS unsigned char*)lds + LDS_BYTES - 128))[threadIdx.x - 16] = 0u;
    __syncthreads();
    if (kargs()->ws == nullptr) grid.sync();
    const XcdBarrier xb = xcd_barrier_post((unsigned*)(kargs()->ws + WS_CNT + 4096), bst);

    {
        PHASE_PTRS
        for (int i = blockIdx.x * NT + tid; i < T; i += G * NT) ss2[i] = 0.f;
#pragma unroll 1
        for (int half_ = 0; half_ < 2; ++half_) {
        if ((half_ == 0) == (wave < 4)) {
        {
            const f32x4* wr = (const f32x4*)norm1_w + lane;
            const f32x4 w0 = wr[0], w1 = wr[64], w2 = wr[128], w3 = wr[192];
            for (int t = gw; t < T; t += 4 * NGW) {
                f32x4 v[4][4];
#pragma unroll
                for (int q = 0; q < 4; ++q) { const f32x4* xr = (const f32x4*)(x + (size_t)(t + q * NGW) * DM) + lane;
#pragma unroll
                    for (int j = 0; j < 4; ++j) v[q][j] = xr[64 * j]; }
                __builtin_amdgcn_sched_barrier(0);
#pragma unroll
                for (int q = 0; q < 4; ++q) {
                    float s = 0.f;
#pragma unroll
                    for (int j = 0; j < 4; ++j) s += v[q][j].x * v[q][j].x + v[q][j].y * v[q][j].y + v[q][j].z * v[q][j].z + v[q][j].w * v[q][j].w;
                    const float rstd = rsqrtf(wave_sum(s) * (1.f / DM) + EPS);
                    bf16_t* xo = XN + (size_t)(t + q * NGW) * DM + lane * 4;
                    st_bf4(xo, v[q][0].x * rstd * w0.x, v[q][0].y * rstd * w0.y, v[q][0].z * rstd * w0.z, v[q][0].w * rstd * w0.w);
                    st_bf4(xo + 256, v[q][1].x * rstd * w1.x, v[q][1].y * rstd * w1.y, v[q][1].z * rstd * w1.z, v[q][1].w * rstd * w1.w);
                    st_bf4(xo + 512, v[q][2].x * rstd * w2.x, v[q][2].y * rstd * w2.y, v[q][2].z * rstd * w2.z, v[q][2].w * rstd * w2.w);
                    st_bf4(xo + 768, v[q][3].x * rstd * w3.x, v[q][3].y * rstd * w3.y, v[q][3].z * rstd * w3.z, v[q][3].w * rstd * w3.w);
                }
            }
        }
        } else {
        float* scr = (float*)lds + wave * (64 * 33);
        int it = gw;
#define TR_SEG(W_, ldw_, c0_, WT_, ldk_, r0_, Kmax_, nkb_, nnb_, ksc_) \
        { const int cntI = (nkb_) * (nnb_); for (; it < cntI; it += NGW) transpose_item(W_, ldw_, c0_, WT_, ldk_, r0_, Kmax_, it / (nnb_), it % (nnb_), ksc_, scr, lane); it -= cntI; }
        TR_SEG(w_in, 4544, 0, WinT, 1024, 0, 1024, 16, 57, nullptr)
        TR_SEG(w_in, 4544, 1824, WinT, 1024, 2048, 1024, 16, 21, nullptr)
        TR_SEG(w_in, 4544, 2496, WinT, 1024, 2816, 1024, 16, 64, nullptr)
#define TR_SEGF(W_, ldw_, WT_, Kmax_, nkb_, nnb_, fks_) \
        { const int cntI = (nkb_) * (nnb_); for (; it < cntI; it += NGW) transpose_item(W_, ldw_, 0, WT_, 0, 0, Kmax_, it / (nnb_), it % (nnb_), nullptr, scr, lane, fks_); it -= cntI; }
        TR_SEGF(kp->in[6], 512, W2T, 64, 1, 16, 2)
        TR_SEGF(kp->in[8], 512, A2T, 64, 1, 16, 2)
        TR_SEGF(kp->in[9], 512, G2T, 160, 3, 16, 5)
#undef TR_SEGF
#pragma unroll 1
        for (int hh = 0; hh < 8; ++hh) {
            TR_SEG(kp->in[17], 768, hh * 96, WuqT, 384, hh * 64, 384, 6, 2, q_norm_w)
            TR_SEG(kp->in[17], 768, hh * 96 + 64, WuqT, 384, 512 + hh * 32, 384, 6, 1, q_norm_w)
            TR_SEG(kp->in[19], 1024, hh * 128, WukvT, 256, hh * 64, 256, 4, 2, kv_norm_w)
            TR_SEG(kp->in[19], 1024, hh * 128 + 64, WukvT, 256, 512 + hh * 64, 256, 4, 2, kv_norm_w)
        }
        TR_SEG(kp->in[15], 1024, 0, RwoT, 512, 0, 512, 8, 32, nullptr)
        TR_SEG(kp->in[24], 1024, 0, MwoT, 512, 0, 512, 8, 32, nullptr)
        TR_SEG(kp->in[25], 1024, 0, WoutT, 1024, 0, 1024, 16, 32, nullptr)
#undef TR_SEG
        for (; it < 1024; it += NGW) wcomb_item(kp->in[27], kp->in[28], norm2_w, PwqT, it, lane);
        }
        }
        for (int i = blockIdx.x * NT + tid; i < (224 + 96) * 128; i += G * NT) {
            const int r = i >> 7, c = i & 127; const int row = r < 224 ? 1824 + r : 2720 + (r - 224);
            *(u32x4*)(WinT + (size_t)row * 1024 + c * 8) = (u32x4){0u, 0u, 0u, 0u};
        }
    }
    xcd_barrier(xb);

    {
        PHASE_PTRS
        pg8::Gemm g{XN, WinT, T, 4864, DM}; pg8::StaticOrder S; S.init(T, 4864, G, (int)blockIdx.x);
        pg8::EpiP1 E{ws};
        pg8::gemm_phase<pg8::EpiP1, pg8::StaticOrder, true, true>((PG8_LAS unsigned char*)lds, g, S, E);
    }
    xcd_barrier(xb);


    {
        PHASE_PTRS
        for (int t0 = gw; t0 < T; t0 += 4 * NGW) {
            u32x4 aw[4]; u32x2 bw[4];
#pragma unroll
            for (int q = 0; q < 4; ++q) { aw[q] = *(const u32x4*)(QD + (size_t)(t0 + q * NGW) * 384 + 8 * (lane & 47)); bw[q] = *(const u32x2*)(KVD + (size_t)(t0 + q * NGW) * 256 + 4 * lane); }
            __builtin_amdgcn_sched_barrier(0);
#pragma unroll
            for (int q = 0; q < 4; ++q) {
                const float a6[8] = {bflo(aw[q].x), bfhi(aw[q].x), bflo(aw[q].y), bfhi(aw[q].y), bflo(aw[q].z), bfhi(aw[q].z), bflo(aw[q].w), bfhi(aw[q].w)}; float s = 0.f;
#pragma unroll
                for (int i = 0; i < 8; ++i) s += a6[i] * a6[i];
                if (lane >= 48) s = 0.f;
                const float b4[4] = {bflo(bw[q].x), bfhi(bw[q].x), bflo(bw[q].y), bfhi(bw[q].y)}; const float s2 = (b4[0] * b4[0] + b4[1] * b4[1]) + (b4[2] * b4[2] + b4[3] * b4[3]);
                const float sq = wave_sum(s), skv = wave_sum(s2);
                if (lane == 0) { ssq[t0 + q * NGW] = rsqrtf(sq * (1.f / 384.f) + EPS); sskv[t0 + q * NGW] = rsqrtf(skv * (1.f / 256.f) + EPS); }
            }
        }
    }
    {
        PHASE_PTRS
        LAS bf16_t* MIX0 = (LAS bf16_t*)lds; LAS bf16_t* LOR0 = (LAS bf16_t*)((LAS unsigned char*)lds + 49152);
        constexpr int SUBE = 58368 / 2;
        for (int tt2 = blockIdx.x; tt2 < T / 32; tt2 += G) {
            int h = wave; asm volatile("" : "+s"(h));
            __syncthreads();
#pragma unroll 1
            for (int sub = 0; sub < 2; ++sub) {
                const int tt = 2 * tt2 + sub; LAS bf16_t* MIX = MIX0 + sub * SUBE; LAS bf16_t* LOR = LOR0 + sub * SUBE;
                u32x4 pw[8], ppw[8];
#pragma unroll
                for (int u = 0; u < 8; ++u) {
                    const int ci = tid + u * NT < 16 * 228 ? tid + u * NT : 16 * 228 - 1; const int row = ci / 228, cc = (ci - row * 228) * 8; const int tk = tt * 16 + row;
                    pw[u] = *(const u32x4*)(Prw + (size_t)tk * 2048 + cc);
                    ppw[u] = *(const u32x4*)(Prw + (size_t)((tk & (SEQ - 1)) != 0 ? tk - 1 : tk) * 2048 + cc);
                }
                __builtin_amdgcn_sched_barrier(0);
#pragma unroll
                for (int u = 0; u < 8; ++u) {
                    const int ci = tid + u * NT; if (ci < 16 * 228) {
                        const int row = ci / 228, cc = (ci - row * 228) * 8; const bool hp_ = ((tt * 16 + row) & (SEQ - 1)) != 0;
                        const float pv[8] = {bflo(pw[u].x), bfhi(pw[u].x), bflo(pw[u].y), bfhi(pw[u].y), bflo(pw[u].z), bfhi(pw[u].z), bflo(pw[u].w), bfhi(pw[u].w)};
                        float ppv[8] = {bflo(ppw[u].x), bfhi(ppw[u].x), bflo(ppw[u].y), bfhi(ppw[u].y), bflo(ppw[u].z), bfhi(ppw[u].z), bflo(ppw[u].w), bfhi(ppw[u].w)};
                        if (!hp_) {
#pragma unroll
                            for (int j = 0; j < 8; ++j) ppv[j] = 0.f; }
                        const f32x4 mu0 = *(const f32x4*)(rw_mu + cc), mu1 = *(const f32x4*)(rw_mu + cc + 4); float xm[8];
#pragma unroll
                        for (int j = 0; j < 8; ++j) { const float mu = j < 4 ? mu0[j & 3] : mu1[j & 3]; const float v = pv[j] + mu * (ppv[j] - pv[j]);
                            xm[j] = cc < 1600 ? (cc < 1536 ? v : tanhf_(v)) : (cc < 1664 ? v : sigmoidf_(v)); }
                        if (cc < 1536) *(LAS bf16x8*)(MIX + row * 1536 + cc) = pack8(xm); else *(LAS bf16x8*)(LOR + row * 288 + (cc - 1536)) = pack8(xm);
                    }
                }
            }
            __syncthreads();
#pragma unroll 1
            for (int sb = 0; sb < 2; ++sb) {
            asm volatile("" : "+s"(h));
            const int tok = (2 * tt2 + sb) * 16 + fr; const LAS bf16_t* MIX = MIX0 + sb * SUBE; const LAS bf16_t* LOR = LOR0 + sb * SUBE;
            f32x4 accw[4], acca[4], accg[4];
#pragma unroll
            for (int n = 0; n < 4; ++n) { accw[n] = (f32x4){0.f, 0.f, 0.f, 0.f}; acca[n] = accw[n]; accg[n] = accw[n]; }
#define LORA_STEP(lcol_, Wt_, KS_, ks_, accv_) { \
                const bf16x8 a = *(const LAS bf16x8*)(LOR + fr * 288 + (lcol_) + 8 * fq); \
                _Pragma("unroll") for (int n = 0; n < 4; ++n) { const bf16x8 b = *(const bf16x8*)((Wt_) + ((size_t)(((h * (KS_) + (ks_)) * 4 + n) * 64 + lane)) * 8); accv_[n] = mfma16(b, a, accv_[n]); } }
#pragma unroll
            for (int ks = 0; ks < 2; ++ks) LORA_STEP(32 * ks, W2T, 2, ks, accw)
#pragma unroll
            for (int ks = 0; ks < 2; ++ks) LORA_STEP(64 + 32 * ks, A2T, 2, ks, acca)
#pragma unroll
            for (int ks = 0; ks < 5; ++ks) LORA_STEP(128 + 32 * ks, G2T, 5, ks, accg)
#undef LORA_STEP
            float kkv[4][4], av[4][4]; float ssq = 0.f, bon = 0.f;
            u32x2 Rp[4], Wp[4], Kp[4], Vp[4], Gp[4];
#pragma unroll
            for (int n = 0; n < 4; ++n) {
                const int ch = 64 * h + 16 * fq + 4 * n;
                float r4[4], k4[4], v4[4];
#pragma unroll
                for (int seg = 0; seg < 3; ++seg) {
                    const u32x2 w = *(const LAS u32x2*)(MIX + fr * 1536 + seg * 512 + ch);
                    const float m4[4] = {bflo(w.x), bfhi(w.x), bflo(w.y), bfhi(w.y)};
#pragma unroll
                    for (int i = 0; i < 4; ++i) { if (seg == 0) r4[i] = m4[i]; else if (seg == 1) k4[i] = m4[i]; else v4[i] = m4[i]; }
                }
                const f32x4 w0 = *(const f32x4*)(rw_w0 + ch), a0 = *(const f32x4*)(rw_a0 + ch), kkw = *(const f32x4*)(rw_k_k + ch), kaw = *(const f32x4*)(rw_k_a + ch), rkw = *(const f32x4*)(rw_r_k + ch);
                float dd[4], kf[4];
#pragma unroll
                for (int i = 0; i < 4; ++i) {
                    const float z = -(w0[i] + accw[n][i]);
                    const float sp = z > 20.f ? z : __logf(1.f + __expf(z));
                    const float wlog = -sp - 0.5f;
                    dd[i] = -__expf(wlog);
                    const float a = sigmoidf_(a0[i] + acca[n][i]); av[n][i] = a;
                    kkv[n][i] = k4[i] * kkw[i]; ssq += kkv[n][i] * kkv[n][i];
                    kf[i] = k4[i] * (1.f + (a - 1.f) * kaw[i]);
                    bon += r4[i] * kf[i] * rkw[i];
                }
                Rp[n] = (u32x2){pk2(r4[0], r4[1]), pk2(r4[2], r4[3])}; Wp[n] = (u32x2){pk2(dd[0], dd[1]), pk2(dd[2], dd[3])}; Kp[n] = (u32x2){pk2(kf[0], kf[1]), pk2(kf[2], kf[3])};
                Vp[n] = (u32x2){pk2(v4[0], v4[1]), pk2(v4[2], v4[3])}; Gp[n] = (u32x2){pk2(accg[n][0], accg[n][1]), pk2(accg[n][2], accg[n][3])};
            }
            const size_t o = (size_t)tok * 512 + 64 * h + 16 * fq;
#define ST16(P_, X_) { *(u32x4*)((P_) + o) = (u32x4){X_[0].x, X_[0].y, X_[1].x, X_[1].y}; *(u32x4*)((P_) + o + 8) = (u32x4){X_[2].x, X_[2].y, X_[3].x, X_[3].y}; }
            ST16(Rb, Rp) ST16(Wb, Wp) ST16(Kb, Kp) ST16(Vb, Vp) ST16(Gtb, Gp)
            ssq += __shfl_xor(ssq, 16); ssq += __shfl_xor(ssq, 32);
            bon += __shfl_xor(bon, 16); bon += __shfl_xor(bon, 32);
            const float inv = 1.f / fmaxf(sqrtf(ssq), 1e-12f);
            u32x2 KKp[4], Bp[4];
#pragma unroll
            for (int n = 0; n < 4; ++n) {
                float kk[4], bb[4];
#pragma unroll
                for (int i = 0; i < 4; ++i) { kk[i] = kkv[n][i] * inv; bb[i] = kk[i] * av[n][i]; }
                KKp[n] = (u32x2){pk2(kk[0], kk[1]), pk2(kk[2], kk[3])}; Bp[n] = (u32x2){pk2(bb[0], bb[1]), pk2(bb[2], bb[3])};
            }
            ST16(KKb, KKp) ST16(Bvb, Bp)
#undef ST16
            if (fq == 0) bonus[(size_t)tok * 8 + h] = bon;
            }
        }
    }
    xcd_barrier(xb);

    {
        PHASE_PTRS
        { int Kq = 384; asm volatile("" : "+s"(Kq));
          pg8::Gemm g{QD, WuqT, T, 768, Kq}; pg8::StaticOrder S; S.init(T, 768, G, (int)blockIdx.x); pg8::EpiQraw E{Qb, ssq};
          pg8::gemm_phase<pg8::EpiQraw, pg8::StaticOrder, true, true>((PG8_LAS unsigned char*)lds, g, S, E); }
        { int Kkv = 256; asm volatile("" : "+s"(Kkv));
          pg8::Gemm g{KVD, WukvT, T, 1024, Kkv}; pg8::StaticOrder S; S.init(T, 1024, G, (int)blockIdx.x); pg8::EpiKVraw E{Kraw, Vt, sskv};
          pg8::gemm_phase<pg8::EpiKVraw, pg8::StaticOrder, true, true>((PG8_LAS unsigned char*)lds, g, S, E); }
    }
    xcd_barrier(xb);
    {
        PHASE_PTRS
        if (wave >= 4)
        for (int t = blockIdx.x * 4 + (wave - 4); t < T; t += G * 4) {
            const int hh = lane >> 3, l8 = lane & 7;
            const float pos = (float)positions[t];
            float cs[4], sn[4];
#pragma unroll
            for (int i = 0; i < 4; ++i) { const float invf = exp2f(-(float)(4 * (l8 & 3) + i) * (13.287712379549449f / 16.f)); float rev = pos * invf * 0.15915494309189535f; rev -= rintf(rev);
                sn[i] = __builtin_amdgcn_sinf(rev); cs[i] = __builtin_amdgcn_cosf(rev); }
            bf16_t* qrow = Qb + (size_t)t * 768;
            float qn[8], qp[4]; ld_bf8(qrow + 8 * lane, qn); ld_bf4(qrow + 512 + 4 * lane, qp);
            float kn[8], kp4[4]; ld_bf8(Kraw + (size_t)t * 512 + 8 * lane, kn); ld_bf4(KPE + (size_t)t * 32 + 4 * l8, kp4);
            float s1 = 0.f, s2 = 0.f, s3 = 0.f, s4 = 0.f;
#pragma unroll
            for (int i = 0; i < 8; ++i) { s1 += qn[i] * qn[i]; s3 += kn[i] * kn[i]; }
#pragma unroll
            for (int i = 0; i < 4; ++i) { s2 += qp[i] * qp[i]; s4 += kp4[i] * kp4[i]; }
            s1 = sum8(s1); s2 = sum8(s2); s3 = sum8(s3); s4 = sum8(s4);
            const float r1 = rsqrtf(s1 * (1.f / 64.f) + EPS) * QSCALE, r2 = rsqrtf(s2 * (1.f / 32.f) + EPS), r3 = rsqrtf(s3 * (1.f / 64.f) + EPS), r4 = rsqrtf(s4 * (1.f / 32.f) + EPS);
            const f32x4 wq0 = *(const f32x4*)(qn_nope_w + 8 * l8), wq1 = *(const f32x4*)(qn_nope_w + 8 * l8 + 4), wk0 = *(const f32x4*)(kn_nope_w + 8 * l8), wk1 = *(const f32x4*)(kn_nope_w + 8 * l8 + 4);
            const f32x4 wqp = *(const f32x4*)(qn_pe_w + 4 * l8), wkp = *(const f32x4*)(kn_pe_w + 4 * l8);
            float oq[8], ok[8], oqp[4], okp[4];
#pragma unroll
            for (int i = 0; i < 8; ++i) { oq[i] = qn[i] * r1 * (i < 4 ? wq0[i & 3] : wq1[i & 3]); ok[i] = kn[i] * r3 * (i < 4 ? wk0[i & 3] : wk1[i & 3]); }
#pragma unroll
            for (int i = 0; i < 4; ++i) {
                const float xq = qp[i] * r2 * wqp[i], xk = kp4[i] * r4 * wkp[i];
                const float pq = dpp_f<0x141>(xq), pk_ = dpp_f<0x141>(xk);
                (void)pq; (void)pk_;
                oqp[i] = xq; okp[i] = xk;
            }
#pragma unroll
            for (int i = 0; i < 4; ++i) {
                const float pq = __shfl_xor(oqp[i], 4), pk_ = __shfl_xor(okp[i], 4);
                const float xq = oqp[i], xk = okp[i];
                oqp[i] = l8 < 4 ? (xq * cs[i] - pq * sn[i]) : (xq * cs[i] + pq * sn[i]);
                okp[i] = l8 < 4 ? (xk * cs[i] - pk_ * sn[i]) : (xk * cs[i] + pk_ * sn[i]);
                oqp[i] *= QSCALE;
            }
            bf16_t* qo = Qb + ((size_t)t * 8 + hh) * 96;
            *(bf16x8*)(qo + 8 * l8) = pack8(oq); st_bf4(qo + 64 + 4 * l8, oqp[0], oqp[1], oqp[2], oqp[3]);
            { const int bb = t >> 12, pos = t & 4095; unsigned char* kfb = (unsigned char*)Kab + (((size_t)(bb * 8 + hh) * 128 + (pos >> 5)) * 6) * 512 + (pos & 31) * 16;
              *(u32x2*)(kfb + (l8 >> 2) * 1024 + 512 * (l8 & 1) + 8 * ((l8 >> 1) & 1)) = (u32x2){pk4_fp8(ok[0], ok[1], ok[2], ok[3]), pk4_fp8(ok[4], ok[5], ok[6], ok[7])};
              *(unsigned*)(kfb + 2048 + 512 * ((l8 >> 1) & 1) + 8 * (l8 >> 2) + 4 * (l8 & 1)) = pk4_fp8(okp[0], okp[1], okp[2], okp[3]); }
        }
    }

    {
        PHASE_PTRS
        float* GL = (float*)(dob + DO_GL);
        const int fr_o = fr, fq_o = fq, lane_o = lane;
        if (wave < 4) {
            LAS unsigned char* wb = (LAS unsigned char*)lds + wave * 36864;
            LAS bf16_t* At = (LAS bf16_t*)(wb + 0);      LAS bf16_t* Btm = (LAS bf16_t*)(wb + 4096);  LAS bf16_t* Ktm = (LAS bf16_t*)(wb + 8192); LAS bf16_t* Rtm = (LAS bf16_t*)(wb + 12288);
            LAS bf16_t* VmT = (LAS bf16_t*)(wb + 16384);
            LAS bf16_t* Nm = (LAS bf16_t*)(wb + 20480);  LAS bf16_t* NmT = (LAS bf16_t*)(wb + 22528); LAS bf16_t* Tm = (LAS bf16_t*)(wb + 24576);  LAS bf16_t* TmT = (LAS bf16_t*)(wb + 26624);
            LAS bf16_t* MmT = (LAS bf16_t*)(wb + 28672); LAS bf16_t* NBT = (LAS bf16_t*)(wb + 30720); LAS bf16_t* MKT = (LAS bf16_t*)(wb + 32768); LAS float* gLs = (LAS float*)(wb + 34816);
            LAS bf16_t* AtT = At; LAS bf16_t* BtT = Nm; LAS bf16_t* KtT = Tm;
            LAS bf16_t* W1 = At; LAS bf16_t* W1T = Btm; LAS bf16_t* ATm = Ktm;
#pragma unroll 1
            for (int it = blockIdx.x * 4 + wave; it < 4096; it += G * 4) {
                const int bh = it >> 7, c = it & 127, b = bh >> 3, h = bh & 7;
                int fr = fr_o, fq = fq_o, lane = lane_o; asm volatile("" : "+v"(fr), "+v"(fq), "+v"(lane));
                const int lpA = (4 * (fr >> 3) + (fr & 3)) + 32 * (fq & 1) + ((fq >> 1) + 4 * ((fr >> 2) & 1)) * 512;
                const int lpB = ((fr >> 1) + 16 * (fq & 1)) * 512 + 16 * (fr & 1) + 4 * (fq >> 1);
                const int lpC = 4 * (fq >> 1) + 16 * (fr & 3) + ((fr >> 2) + 8 * (fq & 1)) * 512;
                const size_t sbase = ((size_t)b * SEQ + c * 32) * 512 + h * 64;
                unsigned aT[16], bT[16], kT[16];
                {
                    float cs = 0.f; unsigned vT[16];
#pragma unroll
                    for (int t = 0; t < 32; ++t) {
                        const size_t o = sbase + (size_t)t * 512 + lane;
                        const float ldv = bf1(Wb[o]), rr = bf1(Rb[o]), kv = bf1(Kb[o]), qv = bf1(KKb[o]), bv = bf1(Bvb[o]); const unsigned vraw = Vb[o];
                        const float ep = __expf(cs); cs += ldv; const float ec = __expf(cs), en = __expf(-cs);
                        const unsigned a_ = bf1of(-qv * ep), b_ = bf1of(bv * en), k_ = bf1of(kv * en), r_ = bf1of(rr * ec);
                        At[SW64(t, lane)] = (bf16_t)a_; Btm[SW64(t, lane)] = (bf16_t)b_; Ktm[SW64(t, lane)] = (bf16_t)k_; Rtm[SW64(t, lane)] = (bf16_t)r_;
                        if (t & 1) { aT[t >> 1] |= a_ << 16; bT[t >> 1] |= b_ << 16; kT[t >> 1] |= k_ << 16; vT[t >> 1] |= vraw << 16; }
                        else { aT[t >> 1] = a_; bT[t >> 1] = b_; kT[t >> 1] = k_; vT[t >> 1] = vraw; }
                    }
#pragma unroll
                    for (int q = 0; q < 4; ++q)
                        *(LAS u32x4*)(VmT + lane * 32 + ((q ^ ((lane >> 2) & 3)) << 3)) = (u32x4){vT[4 * q], vT[4 * q + 1], vT[4 * q + 2], vT[4 * q + 3]};
                    const float gl = __expf(cs); gLs[lane] = gl;
                    { const int k5 = lane & 31; GL[(size_t)it * 64 + (lane >> 5) * 32 + ((k5 >> 2) & 1) * 16 + (k5 & 3) + 4 * (k5 >> 3)] = gl; }
                }
                {
                    f32x4 acc[2][2];
#define ZACC(MT_, NT_) _Pragma("unroll") for (int m = 0; m < MT_; ++m) _Pragma("unroll") for (int n = 0; n < NT_; ++n) acc[m][n] = (f32x4){0.f, 0.f, 0.f, 0.f};
                    ZACC(2, 2) gemm_lds<2, 2, 2>(Btm, 64, At, 64, acc, fr, fq);
#pragma unroll
                    for (int m = 0; m < 2; ++m)
#pragma unroll
                        for (int n = 0; n < 2; ++n)
#pragma unroll
                            for (int j = 0; j < 4; ++j) { const int i = 16 * m + fr, tt = 16 * n + 4 * fq + j; const float v = i < tt ? acc[m][n][j] : 0.f; const bf16_t w = bf1of(v), w1 = bf1of(v + (i == tt ? 1.f : 0.f));
                                Nm[SW32(i, tt)] = w; NmT[SW32(tt, i)] = w; Tm[SW32(i, tt)] = w1; TmT[SW32(tt, i)] = w1; }
                    ZACC(2, 2) gemm_lds<2, 2, 2>(Ktm, 64, At, 64, acc, fr, fq);
#pragma unroll
                    for (int m = 0; m < 2; ++m)
#pragma unroll
                        for (int n = 0; n < 2; ++n)
#pragma unroll
                            for (int j = 0; j < 4; ++j) { const int i = 16 * m + fr, tt = 16 * n + 4 * fq + j; MmT[SW32(tt, i)] = bf1of(i < tt ? acc[m][n][j] : 0.f); }
                    ZACC(2, 2) gemm_lds<2, 2, 2>(Btm, 64, Rtm, 64, acc, fr, fq);
#pragma unroll
                    for (int m = 0; m < 2; ++m)
#pragma unroll
                        for (int n = 0; n < 2; ++n)
#pragma unroll
                            for (int j = 0; j < 4; ++j) { const int i = 16 * m + fr, tt = 16 * n + 4 * fq + j; NBT[SW32(tt, i)] = bf1of(i <= tt ? acc[m][n][j] : 0.f); }
                    ZACC(2, 2) gemm_lds<2, 2, 2>(Ktm, 64, Rtm, 64, acc, fr, fq);
#pragma unroll
                    for (int m = 0; m < 2; ++m)
#pragma unroll
                        for (int n = 0; n < 2; ++n)
#pragma unroll
                            for (int j = 0; j < 4; ++j) { const int i = 16 * m + fr, tt = 16 * n + 4 * fq + j; MKT[SW32(tt, i)] = bf1of(i <= tt ? acc[m][n][j] : 0.f); }
#pragma unroll
                    for (int q = 0; q < 4; ++q)
                        *(LAS u32x4*)(AtT + lane * 32 + ((q ^ ((lane >> 2) & 3)) << 3)) = (u32x4){aT[4 * q], aT[4 * q + 1], aT[4 * q + 2], aT[4 * q + 3]};
#pragma unroll 1
                    for (int rd = 0; rd < 4; ++rd) {
                        ZACC(2, 2) gemm_lds<2, 2, 1>(Nm, 32, NmT, 32, acc, fr, fq);
#pragma unroll
                        for (int m = 0; m < 2; ++m)
#pragma unroll
                            for (int n = 0; n < 2; ++n)
#pragma unroll
                                for (int j = 0; j < 4; ++j) { const int i = 16 * m + fr, tt = 16 * n + 4 * fq + j; const bf16_t w = bf1of(acc[m][n][j]); Nm[SW32(i, tt)] = w; NmT[SW32(tt, i)] = w; }
                        ZACC(2, 2) gemm_lds<2, 2, 1>(Tm, 32, NmT, 32, acc, fr, fq);
#pragma unroll
                        for (int m = 0; m < 2; ++m)
#pragma unroll
                            for (int n = 0; n < 2; ++n)
#pragma unroll
                                for (int j = 0; j < 4; ++j) { const int i = 16 * m + fr, tt = 16 * n + 4 * fq + j; const bf16_t w = bf1of(acc[m][n][j] + bf1(Tm[SW32(i, tt)])); Tm[SW32(i, tt)] = w; TmT[SW32(tt, i)] = w; }
                    }
                }
                asm volatile("" : "+v"(fr), "+v"(fq));
                {
                    f32x4 acc[4][2];
                    ZACC(4, 2) gemm_lds<4, 2, 1>(AtT, 32, TmT, 32, acc, fr, fq);
#pragma unroll
                    for (int m = 0; m < 4; ++m)
#pragma unroll
                        for (int n = 0; n < 2; ++n)
#pragma unroll
                            for (int j = 0; j < 4; ++j) ATm[SW32(16 * m + fr, 16 * n + 4 * fq + j)] = bf1of(acc[m][n][j]);
                    ZACC(4, 2) gemm_lds<4, 2, 1>(VmT, 32, MmT, 32, acc, fr, fq);
#pragma unroll
                    for (int m = 0; m < 4; ++m)
#pragma unroll
                        for (int n = 0; n < 2; ++n)
#pragma unroll
                            for (int j = 0; j < 4; ++j) W1[SW32(16 * m + fr, 16 * n + 4 * fq + j)] = bf1of(acc[m][n][j]);
                    ZACC(4, 2) gemm_lds<4, 2, 1>(W1, 32, TmT, 32, acc, fr, fq);
#pragma unroll
                    for (int m = 0; m < 4; ++m)
#pragma unroll
                        for (int n = 0; n < 2; ++n)
#pragma unroll
                            for (int j = 0; j < 4; ++j) W1T[SW32(16 * m + fr, 16 * n + 4 * fq + j)] = bf1of(acc[m][n][j]);
#pragma unroll
                    for (int q = 0; q < 4; ++q) {
                        *(LAS u32x4*)(BtT + lane * 32 + ((q ^ ((lane >> 2) & 3)) << 3)) = (u32x4){bT[4 * q], bT[4 * q + 1], bT[4 * q + 2], bT[4 * q + 3]};
                        *(LAS u32x4*)(KtT + lane * 32 + ((q ^ ((lane >> 2) & 3)) << 3)) = (u32x4){kT[4 * q], kT[4 * q + 1], kT[4 * q + 2], kT[4 * q + 3]};
                    }
                    ZACC(4, 2) gemm_lds<4, 2, 1>(ATm, 32, NBT, 32, acc, fr, fq);
#pragma unroll
                    for (int m = 0; m < 4; ++m)
#pragma unroll
                        for (int n = 0; n < 2; ++n)
#pragma unroll
                            for (int j = 0; j < 4; ++j) { const int k = 16 * m + fr, tp = 16 * n + 4 * fq + j; const float v = acc[m][n][j] + bf1(Rtm[SW64(tp, k)]);
                                Rb[sbase + lpA + (size_t)(j * 8 + (2 * n + 8 * m) * 512)] = bf1of(v); }
                    ZACC(4, 2) gemm_lds<4, 2, 1>(W1T, 32, NBT, 32, acc, fr, fq); gemm_lds<4, 2, 1>(VmT, 32, MKT, 32, acc, fr, fq);
#pragma unroll
                    for (int m = 0; m < 4; ++m)
#pragma unroll
                        for (int n = 0; n < 2; ++n)
#pragma unroll
                            for (int j = 0; j < 4; ++j) Yb[sbase + lpB + (size_t)((8 * (m & 1)) * 512 + 32 * (m >> 1) + j + 8 * n)] = bf1of(acc[m][n][j]);
                }
                asm volatile("" : "+v"(fr), "+v"(fq));
                {
                    f32x4 acc[4][4];
                    ZACC(4, 4) gemm_lds<4, 4, 1>(ATm, 32, BtT, 32, acc, fr, fq);
#pragma unroll
                    for (int m = 0; m < 4; ++m)
#pragma unroll
                        for (int n = 0; n < 4; ++n)
#pragma unroll
                            for (int j = 0; j < 4; ++j) { const float v = acc[m][n][j] * gLs[16 * n + 4 * fq + j];
                                (n < 2 ? Wb : Kb)[sbase + lpA + (size_t)(j * 8 + (2 * (n & 1) + 8 * m) * 512)] = bf1of(v); }
                    ZACC(4, 4) gemm_lds<4, 4, 1>(W1T, 32, BtT, 32, acc, fr, fq); gemm_lds<4, 4, 1>(VmT, 32, KtT, 32, acc, fr, fq);
#pragma unroll
                    for (int m = 0; m < 4; ++m)
#pragma unroll
                        for (int n = 0; n < 4; ++n)
#pragma unroll
                            for (int j = 0; j < 4; ++j) { const float v = acc[m][n][j] * gLs[16 * n + 4 * fq + j];
                                (m < 2 ? KKb : Bvb)[sbase + lpC + (size_t)(j + 8 * (n & 1) + (4 * (m & 1) + 16 * (n >> 1)) * 512)] = bf1of(v); }
                }
#undef ZACC
            }
        }
    }
    xcd_barrier(xb);

    {
        PHASE_PTRS
        if (wave < 6 && blockIdx.x < 64) {
            const int item = blockIdx.x, bh = item >> 1, wv = item & 1, b = bh >> 3, h = bh & 7;
            const int hi = lane >> 5, vcol = lane & 31;
            float* GL = (float*)(dob + DO_GL);
            volatile LAS unsigned* ctr = (volatile LAS unsigned*)((LAS unsigned char*)lds + LDS_BYTES - 64);
#define SLICE(arr, sb, li) ((arr) + (sb) + (size_t)((li) >> 6) * 512 + ((li) & 63))
#define DMA16(src_, dst_) __builtin_amdgcn_global_load_lds((const unsigned*)(src_), (LAS unsigned*)(dst_), 16, 0, 0)
            if (wave >= 1 && wave <= 4) {
                __builtin_amdgcn_s_setprio(2);
                const int fl = wave == 4 ? 4 : wave - 1;
#pragma unroll 1
                for (int c = 0; c < 128; ++c) {
                    if (c >= 4) { while ((int)ctr[3] < c - 3 || (int)ctr[7] < c - 3) __builtin_amdgcn_s_sleep(1); }
                    asm volatile("" ::: "memory");
                    const size_t sb = ((size_t)b * SEQ + c * 32) * 512 + h * 64; LAS unsigned char* lb = (LAS unsigned char*)lds + (c & 3) * 19712;
                    if (wave == 1) {
#pragma unroll
                        for (int q = 0; q < 4; ++q) DMA16(SLICE(Wb, sb, (q * 64 + lane) * 8), lb + q * 1024);
                        DMA16(SLICE(Kb, sb, (0 * 64 + lane) * 8), lb + 4096);
                        asm volatile("s_waitcnt vmcnt(10)" ::: "memory");
                    } else if (wave == 2) {
#pragma unroll
                        for (int q = 1; q < 4; ++q) DMA16(SLICE(Kb, sb, (q * 64 + lane) * 8), lb + 4096 + q * 1024);
#pragma unroll
                        for (int q = 0; q < 2; ++q) DMA16(SLICE(Rb, sb, (q * 64 + lane) * 8), lb + 8192 + q * 1024);
                        asm volatile("s_waitcnt vmcnt(10)" ::: "memory");
                    } else if (wave == 3) {
#pragma unroll
                        for (int q = 2; q < 4; ++q) DMA16(SLICE(Rb, sb, (q * 64 + lane) * 8), lb + 8192 + q * 1024);
#pragma unroll
                        for (int hf = 0; hf < 2; ++hf) DMA16(SLICE(wv ? Bvb : KKb, sb, (0 * 64 + lane) * 16 + 8 * hf), lb + 12288 + hf * 1024);
                        __builtin_amdgcn_global_load_lds((const unsigned*)(GL + ((size_t)(bh * 128 + c)) * 64 + lane), (LAS unsigned*)(lb + 18432), 4, 0, 0);
                        asm volatile("s_waitcnt vmcnt(10)" ::: "memory");
                    } else {
#pragma unroll
                        for (int hf = 0; hf < 2; ++hf) DMA16(SLICE(wv ? Bvb : KKb, sb, (1 * 64 + lane) * 16 + 8 * hf), lb + 12288 + 2048 + hf * 1024);
#pragma unroll
                        for (int hf = 0; hf < 2; ++hf) DMA16(Yb + sb + (size_t)(lane >> 1) * 512 + 32 * wv + 16 * (lane & 1) + 8 * hf, lb + 16384 + hf * 1024);
                        asm volatile("s_waitcnt vmcnt(8)" ::: "memory");
                    }
                    if (c >= 2 && lane == 0) ctr[fl] = (unsigned)(c - 1);
                }
                asm volatile("s_waitcnt vmcnt(0)" ::: "memory");
                if (lane == 0) ctr[fl] = 128u;
                __builtin_amdgcn_s_setprio(0);
            } else if (wave == 5) {
                __builtin_amdgcn_s_setprio(2);
#pragma unroll 1
                for (int c = 0; c < 128; ++c) {
                    while ((int)ctr[6] <= c) __builtin_amdgcn_s_sleep(1);
                    asm volatile("" ::: "memory");
                    const LAS unsigned char* lb = (const LAS unsigned char*)lds + (c & 3) * 19712; const LAS unsigned char* sfr = (const LAS unsigned char*)lds + 98304 + (c & 3) * 4096;
                    const u32x4 c0 = *(const LAS u32x4*)(lb + 16384 + lane * 16), c1 = *(const LAS u32x4*)(lb + 16384 + 1024 + lane * 16);
                    bf16x8 ra[4], sfv[4];
#pragma unroll
                    for (int s = 0; s < 4; ++s) { ra[s] = *(const LAS bf16x8*)(lb + 8192 + s * 1024 + lane * 16); sfv[s] = *(const LAS bf16x8*)(sfr + s * 1024 + lane * 16); }
                    asm volatile("s_waitcnt lgkmcnt(0)" ::: "memory");
                    if (lane == 0) ctr[7] = (unsigned)(c + 1);
                    f32x16 yt;
                    yt[0] = bflo(c0.x); yt[1] = bfhi(c0.x); yt[2] = bflo(c0.y); yt[3] = bfhi(c0.y); yt[4] = bflo(c0.z); yt[5] = bfhi(c0.z); yt[6] = bflo(c0.w); yt[7] = bfhi(c0.w);
                    yt[8] = bflo(c1.x); yt[9] = bfhi(c1.x); yt[10] = bflo(c1.y); yt[11] = bfhi(c1.y); yt[12] = bflo(c1.z); yt[13] = bfhi(c1.z); yt[14] = bflo(c1.w); yt[15] = bfhi(c1.w);
#pragma unroll
                    for (int s = 0; s < 4; ++s) yt = mfma32(ra[s], sfv[s], yt);
                    LAS unsigned char* yimg = (LAS unsigned char*)lds + 81920 + (c & 1) * 2048;
                    { LAS bf16_t* ys = (LAS bf16_t*)yimg + vcol;
#pragma unroll
                      for (int r = 0; r < 16; ++r) ys[crow(r, hi) * 32] = bf1of(yt[r]); }
                    asm volatile("s_waitcnt lgkmcnt(0)" ::: "memory");
                    const u32x4 ya = *(const LAS u32x4*)(yimg + lane * 32), yb = *(const LAS u32x4*)(yimg + lane * 32 + 16);
                    u32x4* yo = (u32x4*)(Yb + ((size_t)b * SEQ + c * 32 + (lane >> 1)) * 512 + h * 64 + 32 * wv + 16 * (lane & 1));
                    yo[0] = ya; yo[1] = yb;
                }
                __builtin_amdgcn_s_setprio(0);
            } else {
                __builtin_amdgcn_s_setprio(3);
                f32x16 S0t, S1t;
#pragma unroll
                for (int r = 0; r < 16; ++r) { S0t[r] = 0.f; S1t[r] = 0.f; }
                u32x4 c3[2][2]; f32x4 gq[2][4]; bf16x8 pf0[4], pf1[4]; f32x16 cu0, cu1;
#define PS2_LOAD(c_) { const LAS unsigned char* lb_ = (const LAS unsigned char*)lds + ((c_) & 3) * 19712; \
                    _Pragma("unroll") for (int kb = 0; kb < 2; ++kb) { c3[kb][0] = *(const LAS u32x4*)(lb_ + 12288 + kb * 2048 + lane * 16); c3[kb][1] = *(const LAS u32x4*)(lb_ + 12288 + kb * 2048 + 1024 + lane * 16); \
                        _Pragma("unroll") for (int q = 0; q < 4; ++q) gq[kb][q] = *(const LAS f32x4*)(lb_ + 18432 + (kb * 32 + hi * 16 + 4 * q) * 4); } \
                    _Pragma("unroll") for (int s = 0; s < 4; ++s) { pf0[s] = *(const LAS bf16x8*)(lb_ + s * 1024 + lane * 16); pf1[s] = *(const LAS bf16x8*)(lb_ + 4096 + s * 1024 + lane * 16); } \
                    _Pragma("unroll") for (int kb = 0; kb < 2; ++kb) { const u32x4 c0 = c3[kb][0], c1 = c3[kb][1]; f32x16 nn; \
                        nn[0] = bflo(c0.x); nn[1] = bfhi(c0.x); nn[2] = bflo(c0.y); nn[3] = bfhi(c0.y); nn[4] = bflo(c0.z); nn[5] = bfhi(c0.z); nn[6] = bflo(c0.w); nn[7] = bfhi(c0.w); \
                        nn[8] = bflo(c1.x); nn[9] = bfhi(c1.x); nn[10] = bflo(c1.y); nn[11] = bfhi(c1.y); nn[12] = bflo(c1.z); nn[13] = bfhi(c1.z); nn[14] = bflo(c1.w); nn[15] = bfhi(c1.w); \
                        if (kb) cu1 = nn; else cu0 = nn; } }
                while ((int)ctr[0] <= 0 || (int)ctr[1] <= 0 || (int)ctr[2] <= 0 || (int)ctr[4] <= 0) __builtin_amdgcn_s_sleep(1);
                asm volatile("" ::: "memory");
                PS2_LOAD(0)
#pragma unroll 1
                for (int c = 0; c < 128; ++c) {
                    bf16x8 sf[4];
#pragma unroll
                    for (int s = 0; s < 4; ++s) { float t8[8];
#pragma unroll
                        for (int j = 0; j < 8; ++j) t8[j] = (s < 2 ? S0t : S1t)[8 * (s & 1) + j];
                        sf[s] = pack8(t8); }
                    asm volatile("" ::: "memory");
                    { LAS unsigned char* sfr = (LAS unsigned char*)lds + 98304 + (c & 3) * 4096;
#pragma unroll
                      for (int s = 0; s < 4; ++s) *(LAS bf16x8*)(sfr + s * 1024 + lane * 16) = sf[s]; }
                    f32x16 n0, n1;
#pragma unroll
                    for (int kb = 0; kb < 2; ++kb) {
                        f32x16 nn = kb ? cu1 : cu0; const f32x16 so = kb ? S1t : S0t;
#pragma unroll
                        for (int r = 0; r < 16; ++r) nn[r] += gq[kb][r >> 2][r & 3] * so[r];
                        if (kb) n1 = nn; else n0 = nn;
                    }
                    asm volatile("s_waitcnt lgkmcnt(0)" ::: "memory");
                    if (lane == 0) { ctr[6] = (unsigned)(c + 1);
                                     ctr[3] = (unsigned)(c + 1); }
#pragma unroll
                    for (int s = 0; s < 4; ++s) { n0 = mfma32(pf0[s], sf[s], n0); n1 = mfma32(pf1[s], sf[s], n1); }
                    if (c + 1 < 128) {
                        for (;;) { const u32x4 da = *(volatile LAS u32x4*)ctr, db = *(volatile LAS u32x4*)(ctr + 4);
                            if ((int)da.x > c + 1 && (int)da.y > c + 1 && (int)da.z > c + 1 && (int)db.x > c + 1 && (int)db.w >= c - 2) break;
                            __builtin_amdgcn_s_sleep(1); }
                        asm volatile("" ::: "memory");
                        PS2_LOAD(c + 1)
                    }
                    S0t = n0; S1t = n1;
                }
#undef PS2_LOAD
                __builtin_amdgcn_s_setprio(0);
            }
#undef DMA16
#undef SLICE
        }
        for (;;) {
            unsigned item = 0;
            const int xg = blockIdx.x & 7;
            if (lane == 0) item = atomicAdd(&cnt[xg], 1u);
            item = __builtin_amdgcn_readfirstlane(item);
            if (item >= 512u) break;
            const int ig = (int)(item >> 3), qt = 127 - (((ig >> 2) << 3) + (int)(item & 7)), bh = 8 * (ig & 3) + xg, b = bh >> 3, h = bh & 7;
            const int qi = lane & 31, hi = lane >> 5;
            const size_t tokq = (size_t)b * SEQ + qt * 32 + qi;
            float mb = -1024.f;
            f32x16 nmb;
            f32x16 ob0, ob1, lb;
#pragma unroll
            for (int r = 0; r < 16; ++r) { ob0[r] = 0.f; ob1[r] = 0.f; lb[r] = 0.f; nmb[r] = 1024.f; }
            const u32x2 ones8 = (u32x2){0x38383838u, 0x38383838u};
            const unsigned char* kfb = (const unsigned char*)Kab + ((size_t)(b * 8 + h) * 128) * 6 * 512 + lane * 16;
            const unsigned char* vfb = (const unsigned char*)Vt + ((size_t)(b * 8 + h) * 128) * 4 * 512 + lane * 16;
            const int nt = qt + 1;
#define ATT_GROUP(kf, vf, QF, M_, NM_, L_, O0, O1, DIAG) { \
                f32x16 xs = mfma32_fp8(kf[0], QF[0], NM_); \
                _Pragma("unroll") for (int s = 1; s < 6; ++s) xs = mfma32_fp8(kf[s], QF[s], xs);        \
                if (DIAG) { _Pragma("unroll") for (int r = 0; r < 16; ++r) if (crow(r, hi) > qi) xs[r] = -1e30f; } \
                float mx = xs[0]; _Pragma("unroll") for (int r = 1; r < 16; ++r) mx = fmaxf(mx, xs[r]); \
                mx = fmaxf(mx, __shfl_xor(mx, 32)); \
                if (__any(mx > 0.f)) { const float dm = fmaxf(mx, 0.f), alpha = __builtin_amdgcn_exp2f(-dm); L_[0] *= alpha; M_ += dm;        \
                    _Pragma("unroll") for (int r = 0; r < 16; ++r) { O0[r] *= alpha; O1[r] *= alpha; NM_[r] = -M_; xs[r] -= dm; } } \
                _Pragma("unroll") for (int r = 0; r < 16; ++r) xs[r] = __builtin_amdgcn_exp2f(xs[r]); \
                _Pragma("unroll") for (int s = 0; s < 2; ++s) { const u32x2 pbs = (u32x2){pk4_fp8(xs[8 * s], xs[8 * s + 1], xs[8 * s + 2], xs[8 * s + 3]), pk4_fp8(xs[8 * s + 4], xs[8 * s + 5], xs[8 * s + 6], xs[8 * s + 7])}; \
                    O0 = mfma32_fp8(vf[0][s], pbs, O0); O1 = mfma32_fp8(vf[1][s], pbs, O1); L_ = mfma32_fp8(ones8, pbs, L_); } }
            u32x2 k0_[6], v0_[2][2], k1_[6], v1_[2][2], k2_[6], v2_[2][2];
            const unsigned char* kp = kfb; const unsigned char* vp = vfb;
#define ATT_LOADKV(KN, VN) { _Pragma("unroll") for (int p = 0; p < 3; ++p) { const u32x4 kk = *(const u32x4*)(kp + p * 1024); KN[2 * p] = (u32x2){kk.x, kk.y}; KN[2 * p + 1] = (u32x2){kk.z, kk.w}; } \
                _Pragma("unroll") for (int d0 = 0; d0 < 2; ++d0) { const u32x4 vv = *(const u32x4*)(vp + d0 * 1024); VN[d0][0] = (u32x2){vv.x, vv.y}; VN[d0][1] = (u32x2){vv.z, vv.w}; } }
#define ATT_STEP(KF, VF, KL, VL, kt_) { { const int adv = (kt_) + 2 < nt ? 1 : 0; kp += adv * 3072; vp += adv * 2048; ATT_LOADKV(KL, VL) } \
                __builtin_amdgcn_sched_barrier(0); \
                ATT_GROUP(KF, VF, qfb, mb, nmb, lb, ob0, ob1, (kt_) == nt - 1) }
            ATT_LOADKV(k0_, v0_)
            { const int adv = 1 < nt ? 1 : 0; kp += adv * 3072; vp += adv * 2048; ATT_LOADKV(k1_, v1_) }
            __builtin_amdgcn_sched_barrier(0);
            u32x2 qfb[6];
#pragma unroll
            for (int s = 0; s < 6; ++s) { float qb_[8]; ld_bf8(Qb + (tokq * 8 + h) * 96 + 16 * s + 8 * hi, qb_);
                qfb[s] = (u32x2){pk4_fp8(qb_[0], qb_[1], qb_[2], qb_[3]), pk4_fp8(qb_[4], qb_[5], qb_[6], qb_[7])}; }
#pragma unroll 1
            for (int kt = 0; kt < nt; kt += 3) {
                ATT_STEP(k0_, v0_, k2_, v2_, kt)
                if (kt + 1 >= nt) break;
                ATT_STEP(k1_, v1_, k0_, v0_, kt + 1)
                if (kt + 2 >= nt) break;
                ATT_STEP(k2_, v2_, k1_, v1_, kt + 2)
            }
#undef ATT_STEP
#undef ATT_LOADKV
#undef ATT_GROUP
            const float ilb = 1.f / lb[0];
            bf16_t* orow = Ob + tokq * 512 + h * 64;
#pragma unroll
            for (int g = 0; g < 4; ++g) {
                st_bf4(orow + 8 * g + 4 * hi, ob0[4 * g] * ilb, ob0[4 * g + 1] * ilb, ob0[4 * g + 2] * ilb, ob0[4 * g + 3] * ilb);
                st_bf4(orow + 32 + 8 * g + 4 * hi, ob1[4 * g] * ilb, ob1[4 * g + 1] * ilb, ob1[4 * g + 2] * ilb, ob1[4 * g + 3] * ilb);
            }
        }
    }
    xcd_barrier(xb);

    {
        PHASE_PTRS
        {
            const int ch = 8 * lane, h = lane >> 3;
            const f32x4 lw0 = *(const f32x4*)(rw_ln_w + ch), lw1 = *(const f32x4*)(rw_ln_w + ch + 4), lb0 = *(const f32x4*)(rw_ln_b + ch), lb1 = *(const f32x4*)(rw_ln_b + ch + 4);
            for (int t0 = gw; t0 < T; t0 += 4 * NGW) {
                u32x4 yw[4], vw[4], gw_[4]; float bo[4];
#pragma unroll
                for (int q = 0; q < 4; ++q) { const size_t o_ = (size_t)(t0 + q * NGW) * 512 + ch; yw[q] = *(const u32x4*)(Yb + o_); vw[q] = *(const u32x4*)(Vb + o_); gw_[q] = *(const u32x4*)(Gtb + o_); bo[q] = bonus[(size_t)(t0 + q * NGW) * 8 + h]; }
                __builtin_amdgcn_sched_barrier(0);
#pragma unroll
                for (int q = 0; q < 4; ++q) {
                    float y[8] = {bflo(yw[q].x), bfhi(yw[q].x), bflo(yw[q].y), bfhi(yw[q].y), bflo(yw[q].z), bfhi(yw[q].z), bflo(yw[q].w), bfhi(yw[q].w)};
                    const float v[8] = {bflo(vw[q].x), bfhi(vw[q].x), bflo(vw[q].y), bfhi(vw[q].y), bflo(vw[q].z), bfhi(vw[q].z), bflo(vw[q].w), bfhi(vw[q].w)};
                    const float g[8] = {bflo(gw_[q].x), bfhi(gw_[q].x), bflo(gw_[q].y), bfhi(gw_[q].y), bflo(gw_[q].z), bfhi(gw_[q].z), bflo(gw_[q].w), bfhi(gw_[q].w)};
                    float s = 0.f;
#pragma unroll
                    for (int i = 0; i < 8; ++i) s += y[i];
                    s += __shfl_xor(s, 1); s += __shfl_xor(s, 2); s += __shfl_xor(s, 4);
                    const float mu = s * (1.f / 64.f); float qq = 0.f;
#pragma unroll
                    for (int i = 0; i < 8; ++i) { y[i] -= mu; qq += y[i] * y[i]; }
                    qq += __shfl_xor(qq, 1); qq += __shfl_xor(qq, 2); qq += __shfl_xor(qq, 4);
                    const float rstd = rsqrtf(qq * (1.f / 64.f) + 64e-5f);
                    float o[8];
#pragma unroll
                    for (int i = 0; i < 8; ++i) { const float lw = i < 4 ? lw0[i & 3] : lw1[i & 3], lb = i < 4 ? lb0[i & 3] : lb1[i & 3]; o[i] = (y[i] * rstd * lw + lb + bo[q] * v[i]) * g[i]; }
                    *(bf16x8*)(YA + (size_t)(t0 + q * NGW) * 512 + ch) = pack8(o);
                }
            }
        }
    }
    xcd_barrier(xb);

    {
        PHASE_PTRS
        const bool conv_first = ((blockIdx.x >> 3) & 1) != 0;
        if (conv_first) PEER_CONV(0, PEER_CONV_Q)
        pg8::StaticOrder S; S.init(T, 1024, G, (int)blockIdx.x);
        { pg8::Gemm g{YA, RwoT, T, 1024, 512}; pg8::EpiGate E{MIXED, Gg, 0, 0};
          pg8::gemm_phase<pg8::EpiGate, pg8::StaticOrder, true, true>((PG8_LAS unsigned char*)lds, g, S, E); }
        { pg8::Gemm g{Ob, MwoT, T, 1024, 512}; pg8::EpiGate E{MIXED, Gg, 1024, 1};
          pg8::gemm_phase<pg8::EpiGate, pg8::StaticOrder, true, true>((PG8_LAS unsigned char*)lds, g, S, E); }
        if (!conv_first) PEER_CONV(0, PEER_CONV_Q)
    }
    xcd_barrier(xb);

    {
        PHASE_PTRS
        const bool conv_first = ((blockIdx.x >> 3) & 1) != 0;
        if (conv_first) PEER_CONV(PEER_CONV_Q, 3 * PEER_CONV_Q)
        { pg8::Gemm g{MIXED, WoutT, T, 1024, 1024}; pg8::StaticOrder S; S.init(T, 1024, G, (int)blockIdx.x);
          pg8::EpiRes E{x, HB, ss2};
          pg8::gemm_phase<pg8::EpiRes, pg8::StaticOrder, true, true>((PG8_LAS unsigned char*)lds, g, S, E); }
        if (!conv_first) PEER_CONV(PEER_CONV_Q, 3 * PEER_CONV_Q)
    }
    xcd_barrier(xb);

    {
        PHASE_PTRS
        const bool conv_first = ((blockIdx.x >> 3) & 1) != 0;
        if (conv_first) PEER_CONV(3 * PEER_CONV_Q, 4 * PEER_CONV_Q)
        { pg8::Gemm g{HB, PwqT, T, 2048, 1024}; pg8::StaticOrder S; S.init(T, 2048, G, (int)blockIdx.x);
          pg8::EpiScale E{SC, ss2};
          pg8::gemm_phase<pg8::EpiScale, pg8::StaticOrder, true, true>((PG8_LAS unsigned char*)lds, g, S, E); }
        if (!conv_first) PEER_CONV(3 * PEER_CONV_Q, 4 * PEER_CONV_Q)
    }
    xcd_barrier(xb);

    {
        PHASE_PTRS
        const int wp = wave & 3; const bool producer = wave < 4;
        volatile LAS unsigned* pc = (volatile LAS unsigned*)((LAS unsigned char*)lds + LDS_BYTES - 128) + 2 * wp;
        int ppair[4];
#pragma unroll
        for (int c = 0; c < 4; ++c) ppair[c] = peer_pair(16 * c + (lane & 15));
        if (producer) {
        int kq = 0;
        u32x4 scn[4] = {{0u, 0u, 0u, 0u}, {0u, 0u, 0u, 0u}, {0u, 0u, 0u, 0u}, {0u, 0u, 0u, 0u}};
        if (blockIdx.x * 4 + wp < T) {
#pragma unroll
            for (int q = 0; q < 4; ++q) scn[q] = *(const u32x4*)(SC + (size_t)(blockIdx.x * 4 + wp) * 2048 + (4 * q + (lane >> 4)) * 128 + 8 * (lane & 15)); }
        for (int t = blockIdx.x * 4 + wp; t < T; t += G * 4, ++kq) {
            LAS unsigned char* wl = (LAS unsigned char*)lds + wp * 4096 + (kq & 1) * 2048;
            LAS u32x2* tab = (LAS u32x2*)wl;
            if (kq >= 2) { while ((int)pc[1] < kq - 1) __builtin_amdgcn_s_sleep(2); }
            asm volatile("" ::: "memory");
            {
                const int l16 = lane & 15, rho = lane >> 4;
                LAS unsigned* rkK = (LAS unsigned*)((LAS unsigned char*)lds + 16384 + wp * 2048);
                LAS float* rkS = (LAS float*)(rkK + 256);
#define CE_(a_, b_) { const unsigned hi_ = umax2(a_, b_), lo_ = a_ < b_ ? a_ : b_; a_ = hi_; b_ = lo_; }
#define SORT8(k) { CE_(k[0], k[1]) CE_(k[2], k[3]) CE_(k[4], k[5]) CE_(k[6], k[7]) CE_(k[0], k[2]) CE_(k[1], k[3]) CE_(k[4], k[6]) CE_(k[5], k[7]) CE_(k[1], k[2]) CE_(k[5], k[6]) \
                    CE_(k[0], k[4]) CE_(k[3], k[7]) CE_(k[1], k[5]) CE_(k[2], k[6]) CE_(k[1], k[4]) CE_(k[3], k[6]) CE_(k[2], k[4]) CE_(k[3], k[5]) CE_(k[3], k[4]) }
#define SORT4(k) { CE_(k[0], k[1]) CE_(k[2], k[3]) CE_(k[0], k[2]) CE_(k[1], k[3]) CE_(k[1], k[2]) }
                {
                    unsigned key[4][8], top[4];
#pragma unroll
                    for (int q = 0; q < 4; ++q) {
                        const u32x4 w = scn[q];
#pragma unroll
                        for (int c = 0; c < 8; ++c) { unsigned u = (c & 1) ? (w[c >> 1] & 0xffff0000u) : (w[c >> 1] << 16); u = (u & 0x80000000u) ? ~u : (u | 0x80000000u); key[q][c] = (u & ~127u) | (unsigned)(127 - (8 * l16 + c)); }
                        SORT8(key[q])
                        top[q] = 0u;
                    }
                    if (t + G * 4 < T) {
#pragma unroll
                        for (int q = 0; q < 4; ++q) scn[q] = *(const u32x4*)(SC + (size_t)(t + G * 4) * 2048 + (4 * q + rho) * 128 + 8 * l16); }
#pragma unroll 1
                    for (int r = 0; r < 16; ++r) {
                        const bool isr = l16 == r;
#pragma unroll
                        for (int q = 0; q < 4; ++q) {
                            const unsigned m = umax16(key[q][0]);
                            const bool win = key[q][0] == m;
#pragma unroll
                            for (int c = 0; c < 7; ++c) key[q][c] = win ? key[q][c + 1] : key[q][c];
                            key[q][7] = win ? 0u : key[q][7];
                            top[q] = isr ? m : top[q];
                        }
                    }
#pragma unroll
                    for (int q = 0; q < 4; ++q) { unsigned u = top[q] & ~127u; u = (u & 0x80000000u) ? (u & 0x7fffffffu) : ~u; rkK[(4 * q + rho) * 16 + l16] = top[q]; rkS[(4 * q + rho) * 16 + l16] = __uint_as_float(u); }
                }
                asm volatile("s_waitcnt lgkmcnt(0)" ::: "memory");
                {
                    unsigned ck[2][4], best[2];
#pragma unroll
                    for (int q = 0; q < 2; ++q) {
                        const int hd = 4 * q + rho;
#pragma unroll
                        for (int c = 0; c < 4; ++c) { const int pr = ppair[c], pi = pr < 0 ? 0 : pr;
                            const float sm = rkS[32 * hd + (pi >> 4)] + rkS[32 * hd + 16 + (pi & 15)]; unsigned u = __float_as_uint(sm); u = (u & 0x80000000u) ? ~u : (u | 0x80000000u);
                            ck[q][c] = pr < 0 ? 0u : ((u & ~255u) | (unsigned)(255 - pr)); }
                        SORT4(ck[q])
                        best[q] = 0u;
                    }
#pragma unroll 1
                    for (int r = 0; r < 16; ++r) {
                        const bool isr = l16 == r;
#pragma unroll
                        for (int q = 0; q < 2; ++q) {
                            const unsigned m = umax16(ck[q][0]);
                            const bool win = ck[q][0] == m;
                            ck[q][0] = win ? ck[q][1] : ck[q][0]; ck[q][1] = win ? ck[q][2] : ck[q][1]; ck[q][2] = win ? ck[q][3] : ck[q][2]; ck[q][3] = win ? 0u : ck[q][3];
                            best[q] = isr ? m : best[q];
                        }
                    }
#pragma unroll
                    for (int q = 0; q < 2; ++q) {
                        const int hd = 4 * q + rho;
                        float bs; { unsigned u = best[q] & ~255u; u = (u & 0x80000000u) ? (u & 0x7fffffffu) : ~u; bs = __uint_as_float(u); }
                        float bmax; { unsigned u = umax16(best[q]) & ~255u; u = (u & 0x80000000u) ? (u & 0x7fffffffu) : ~u; bmax = __uint_as_float(u); }
                        const int pos = 255 - (int)(best[q] & 255u);
                        const float e = __expf(bs - bmax);
                        const float gate = e / sum16(e);
                        const unsigned t1 = rkK[32 * hd + (pos >> 4)], t2 = rkK[32 * hd + 16 + (pos & 15)];
                        const unsigned eid = (127u - (t1 & 127u)) * 128u + (127u - (t2 & 127u));
                        tab[16 * hd + l16] = (u32x2){eid, __float_as_uint(gate)};
                    }
                }
#undef SORT4
#undef SORT8
#undef CE_
            }
            asm volatile("s_waitcnt lgkmcnt(0)" ::: "memory");
            if (lane == 0) pc[0] = (unsigned)(kq + 1);
        }
        } else {
            const int tfirst = blockIdx.x * 4 + wp; const int nt = tfirst < T ? (T - tfirst + G * 4 - 1) / (G * 4) : 0;
            LAS float* dotb = (LAS float*)((LAS unsigned char*)lds + 25600 + wp * 512);
            const unsigned char* UF4 = ws + WS_UB; const unsigned char* USC = ws + WS_USC;
            u32x4 R0[8], R1[8], R2[8], R3[8]; u32x2 S0, S1, S2, S3;
#define P6U_LOAD(R, S, kq_, h_) { const LAS u32x2* tb_ = (const LAS u32x2*)((LAS unsigned char*)lds + wp * 4096 + ((kq_) & 1) * 2048); \
                const unsigned e_ = tb_[16 * (h_) + fr].x; const unsigned char* up_ = UF4 + (size_t)e_ * 512 + 16 * fq; \
                _Pragma("unroll") for (int c = 0; c < 8; ++c) R[c] = *(const u32x4*)(up_ + 64 * c); \
                S = *(const u32x2*)(USC + (size_t)e_ * 8); }
#define P6U_USE(R, S, h_) { f32x4 d0 = (f32x4){0.f, 0.f, 0.f, 0.f}, d1 = d0; \
                _Pragma("unroll") for (int c = 0; c < 8; ++c) { \
                    const u32x4 ba = *(const LAS u32x4*)(wl + 1024 + 64 * c + 16 * fq), bl = *(const LAS u32x4*)(wl + 1536 + 64 * c + 16 * fq); \
                    const u32x4 ra_ = R[c]; const i32x8 av_ = (i32x8){(int)ra_.x, (int)ra_.y, (int)ra_.z, (int)ra_.w, 0, 0, 0, 0}; \
                    const i32x8 bv_ = (i32x8){(int)ba.x, (int)ba.y, (int)ba.z, (int)ba.w, 0, 0, 0, 0}, bw_ = (i32x8){(int)bl.x, (int)bl.y, (int)bl.z, (int)bl.w, 0, 0, 0, 0}; \
                    const unsigned sw_ = c < 4 ? S.x : S.y; const int sa_ = (int)__builtin_amdgcn_perm(sw_, sw_, 0x01010101u * (unsigned)(c & 3)); \
                    if (c & 1) { d1 = __builtin_amdgcn_mfma_scale_f32_16x16x128_f8f6f4(av_, bv_, d1, 4, 4, 0, sa_, 0, 0x7f7f7f7f); d1 = __builtin_amdgcn_mfma_scale_f32_16x16x128_f8f6f4(av_, bw_, d1, 4, 4, 0, sa_, 0, 0x7d7d7d7d); } \
                    else { d0 = __builtin_amdgcn_mfma_scale_f32_16x16x128_f8f6f4(av_, bv_, d0, 4, 4, 0, sa_, 0, 0x7f7f7f7f); d0 = __builtin_amdgcn_mfma_scale_f32_16x16x128_f8f6f4(av_, bw_, d0, 4, 4, 0, sa_, 0, 0x7d7d7d7d); } } \
                const f32x4 acc_ = d0 + d1; const int j_ = fr & 3; \
                const float dv_ = j_ == 0 ? acc_[0] : (j_ == 1 ? acc_[1] : (j_ == 2 ? acc_[2] : acc_[3])); \
                if (fr < 4) dotb[16 * (h_) + 4 * fq + fr] = dv_; }
            u32x4 hx0 = {0u, 0u, 0u, 0u}, hx1 = hx0;
            if (nt > 0) { hx0 = *(const u32x4*)(HB + (size_t)tfirst * DM + 16 * lane); hx1 = *(const u32x4*)(HB + (size_t)tfirst * DM + 16 * lane + 8); }
            if (nt > 0) {
                while ((int)pc[0] <= 0) __builtin_amdgcn_s_sleep(2);
                asm volatile("" ::: "memory");
                P6U_LOAD(R0, S0, 0, 0) P6U_LOAD(R1, S1, 0, 1) P6U_LOAD(R2, S2, 0, 2)
            }
            for (int kq = 0; kq < nt; ++kq) {
                const int t = tfirst + kq * (G * 4);
                LAS unsigned char* wl = (LAS unsigned char*)lds + wp * 4096 + (kq & 1) * 2048;
                const float rs = rsqrtf(ss2[t] * (1.f / DM) + EPS);
                {
                    const float xa[8] = {bflo(hx0.x), bfhi(hx0.x), bflo(hx0.y), bfhi(hx0.y), bflo(hx0.z), bfhi(hx0.z), bflo(hx0.w), bfhi(hx0.w)};
                    const float xb[8] = {bflo(hx1.x), bfhi(hx1.x), bflo(hx1.y), bfhi(hx1.y), bflo(hx1.z), bfhi(hx1.z), bflo(hx1.w), bfhi(hx1.w)};
                    if (kq + 1 < nt) { const size_t tn_ = (size_t)(t + G * 4) * DM + 16 * lane; hx0 = *(const u32x4*)(HB + tn_); hx1 = *(const u32x4*)(HB + tn_ + 8); }
                    unsigned h0_ = 0u, h1_ = 0u, l0_ = 0u, l1_ = 0u;
#define XQ4(bq) { h0_ = __builtin_amdgcn_cvt_scalef32_pk_fp4_f32(h0_, xa[2 * bq], xa[2 * bq + 1], 1.0f, bq); h1_ = __builtin_amdgcn_cvt_scalef32_pk_fp4_f32(h1_, xb[2 * bq], xb[2 * bq + 1], 1.0f, bq); \
                        const f32x2_t da_ = __builtin_amdgcn_cvt_scalef32_pk_f32_fp4(h0_, 1.0f, bq), db_ = __builtin_amdgcn_cvt_scalef32_pk_f32_fp4(h1_, 1.0f, bq); \
                        l0_ = __builtin_amdgcn_cvt_scalef32_pk_fp4_f32(l0_, 4.f * (xa[2 * bq] - da_.x), 4.f * (xa[2 * bq + 1] - da_.y), 1.0f, bq); \
                        l1_ = __builtin_amdgcn_cvt_scalef32_pk_fp4_f32(l1_, 4.f * (xb[2 * bq] - db_.x), 4.f * (xb[2 * bq + 1] - db_.y), 1.0f, bq); }
                    XQ4(0) XQ4(1) XQ4(2) XQ4(3)
#undef XQ4
                    *(LAS u32x2*)(wl + 1024 + lane * 8) = (u32x2){h0_, h1_}; *(LAS u32x2*)(wl + 1536 + lane * 8) = (u32x2){l0_, l1_};
                    asm volatile("s_waitcnt lgkmcnt(0)" ::: "memory");
                }
#pragma unroll 1
                for (int GG = 0; GG < 8; GG += 4) {
                    int kn = kq, gn = GG + 4;
                    if (GG == 4) {
                        if (kq + 1 < nt) { while ((int)pc[0] < kq + 2) __builtin_amdgcn_s_sleep(2); asm volatile("" ::: "memory"); kn = kq + 1; gn = 0; }
                        else gn = 4;
                    }
                    P6U_LOAD(R3, S3, kq, GG + 3)
                    __builtin_amdgcn_sched_barrier(0);
                    P6U_USE(R0, S0, GG)
                    __builtin_amdgcn_sched_barrier(0);
                    P6U_LOAD(R0, S0, kn, gn)
                    __builtin_amdgcn_sched_barrier(0);
                    P6U_USE(R1, S1, GG + 1)
                    __builtin_amdgcn_sched_barrier(0);
                    P6U_LOAD(R1, S1, kn, gn + 1)
                    __builtin_amdgcn_sched_barrier(0);
                    P6U_USE(R2, S2, GG + 2)
                    __builtin_amdgcn_sched_barrier(0);
                    P6U_LOAD(R2, S2, kn, gn + 2)
                    __builtin_amdgcn_sched_barrier(0);
                    P6U_USE(R3, S3, GG + 3)
                    __builtin_amdgcn_sched_barrier(0);
                }
                asm volatile("s_waitcnt lgkmcnt(0)" ::: "memory");
                {
                    const u32x4 tv = *(const LAS u32x4*)(wl + lane * 16);
                    const f32x2_t dd = *(const LAS f32x2_t*)(dotb + 2 * lane);
                    const float da = dd.x * rs, db = dd.y * rs;
                    const float acta = 0.5f * da * (1.f + erff(da * 0.7071067811865476f)), actb = 0.5f * db * (1.f + erff(db * 0.7071067811865476f));
                    const float cfa = __uint_as_float(tv.y) * acta * (1.f / V8_SCALE), cfb = __uint_as_float(tv.w) * actb * (1.f / V8_SCALE);
                    asm volatile("s_waitcnt lgkmcnt(0)" ::: "memory");
                    LAS unsigned char* tq = wl + 1024; const int r0 = 2 * (lane & 3), l0 = lane >> 2;
                    *(LAS unsigned short*)(tq + (r0 * 16 + l0) * 2) = (unsigned short)tv.x; *(LAS unsigned short*)(tq + ((r0 + 1) * 16 + l0) * 2) = (unsigned short)tv.z;
                    const float c0 = fminf(fmaxf(cfa * C8_SCALE, -440.f), 440.f), c1 = fminf(fmaxf(cfb * C8_SCALE, -440.f), 440.f);
                    const unsigned c8 = (unsigned)__builtin_amdgcn_cvt_pk_fp8_f32(c0, c1, 0, false);
                    *(tq + 256 + r0 * 16 + l0) = (unsigned char)(c8 & 0xffu); *(tq + 256 + (r0 + 1) * 16 + l0) = (unsigned char)((c8 >> 8) & 0xffu);
                    asm volatile("s_waitcnt lgkmcnt(0)" ::: "memory");
                    if (lane < 24) { const u32x4 o = *(const LAS u32x4*)(tq + lane * 16); *(u32x4*)(ws + WS_TAB + (size_t)t * 384 + lane * 16) = o; }
                }
                asm volatile("s_waitcnt lgkmcnt(0)" ::: "memory");
                if (lane == 0) pc[1] = (unsigned)(kq + 1);
            }
#undef P6U_USE
#undef P6U_LOAD
        }
    }
    xcd_barrier(xb);

    {
        PHASE_PTRS
        const unsigned sl = blockIdx.x & 7;
        const unsigned char* VS = (const unsigned char*)VBp + (size_t)sl * 16384 * 128;
        const int rho = lane >> 3, chi = lane & 7;
        constexpr float CSCALE = C8_SCALE;
        unsigned selLo[4], selHi[4];
#pragma unroll
        for (int k = 0; k < 4; ++k) { const unsigned sh = 8u * (unsigned)(chi & 3); const unsigned v = (0x0c0c0c0cu & ~(0xffu << sh)) | ((unsigned)k << sh);
            selLo[k] = chi < 4 ? v : 0x0c0c0c0cu; selHi[k] = chi < 4 ? 0x0c0c0c0cu : v; }
        const bool olane = (lane & 0x28) == 0;
        const unsigned voff0 = 16u * (unsigned)chi;
        LAS unsigned char* wl8 = (LAS unsigned char*)lds + wave * 6144;
        const int wstride = (G >> 3) * NWAVES, tg0 = (blockIdx.x >> 3) * NWAVES + wave;
        const int nb = tg0 < T / 8 ? (T / 8 - tg0 + wstride - 1) / wstride : 0, ntok = nb * 8;
#define P6C_TOK(i_) ((tg0 + ((i_) >> 3) * wstride) * 8 + ((i_) & 7))
#define P6C_DMA(b_) { _Pragma("unroll") for (int k = 0; k < 3; ++k) __builtin_amdgcn_global_load_lds((const unsigned*)(ws + WS_TAB + (size_t)((tg0 + (b_) * wstride) * 8) * 384 + k * 1024 + lane * 16), (LAS unsigned*)(wl8 + ((b_) & 1) * 3072 + k * 1024), 16, 0, 0); }
#define P6C_TAB(EL, EH, CW, i_) { const int ii_ = (i_) < ntok ? (i_) : ntok - 1; const LAS unsigned char* tq_ = wl8 + ((ii_ >> 3) & 1) * 3072 + (ii_ & 7) * 384; \
            EL = *(const LAS u32x4*)(tq_ + rho * 32); EH = *(const LAS u32x4*)(tq_ + rho * 32 + 16); CW = *(const LAS u32x4*)(tq_ + 256 + rho * 16); }
#define P6C_EID(ER, j_) (((j_) & 1) ? (ER[(j_) >> 1] >> 16) : (ER[(j_) >> 1] & 0xffffu))
#define P6C_LOAD(VV, ER) { _Pragma("unroll") for (int j = 0; j < 8; ++j) VV[j] = *(const u32x4*)(VS + (size_t)((P6C_EID(ER, j) << 7) | voff0)); }
#define P6C_USE(VV, CWA, CWB) { _Pragma("unroll") for (int j = 0; j < 8; ++j) { const unsigned cwd = (j < 4) ? CWA : CWB; \
            u32x2 xo; xo.x = __builtin_amdgcn_perm(cwd, cwd, selLo[j & 3]); xo.y = __builtin_amdgcn_perm(cwd, cwd, selHi[j & 3]); \
            acc0 = mfma16_fp8(xo, (u32x2){VV[j].x, VV[j].y}, acc0); acc1 = mfma16_fp8(xo, (u32x2){VV[j].z, VV[j].w}, acc1); } }
#define P6C_BODY(i_, VA, VB, EL, EH, CW, VBo, EHo) { \
            const size_t oo_ = (size_t)P6C_TOK(i_) * DM + 128 * sl + 16 * chi + 4 * ((lane >> 4) & 1); float* orow = kp->out + oo_; \
            u32x2 hw0 = (u32x2){0u, 0u}, hw1 = hw0; \
            if (olane) { hw0 = *(const u32x2*)(HB + oo_); hw1 = *(const u32x2*)(HB + oo_ + 8); }        \
            P6C_LOAD(VBo, EHo)                                     \
            const u32x4 cwq = CW; \
            __builtin_amdgcn_sched_barrier(0); \
            f32x4 acc0 = (f32x4){0.f, 0.f, 0.f, 0.f}, acc1 = acc0; \
            P6C_USE(VA, cwq.x, cwq.y) \
            __builtin_amdgcn_sched_barrier(0); \
            P6C_TAB(EL, EH, CW, (i_) + 2) \
            P6C_LOAD(VA, EL)                                       \
            __builtin_amdgcn_sched_barrier(0); \
            P6C_USE(VB, cwq.z, cwq.w) \
            float s[8]; \
            _Pragma("unroll") for (int r = 0; r < 4; ++r) {        \
                { const auto rr = __builtin_amdgcn_permlane32_swap(__float_as_uint(acc0[r]), __float_as_uint(acc0[r]), false, false); s[r] = acc0[r] + dpp_f<0x128>(__uint_as_float(rr[1])); } \
                { const auto rr = __builtin_amdgcn_permlane32_swap(__float_as_uint(acc1[r]), __float_as_uint(acc1[r]), false, false); s[4 + r] = acc1[r] + dpp_f<0x128>(__uint_as_float(rr[1])); } } \
            if (olane) { const f32x4 h0 = (f32x4){bflo(hw0.x), bfhi(hw0.x), bflo(hw0.y), bfhi(hw0.y)}, h1 = (f32x4){bflo(hw1.x), bfhi(hw1.x), bflo(hw1.y), bfhi(hw1.y)}; \
                *(f32x4*)orow = h0 + (f32x4){s[0], s[1], s[2], s[3]} * (1.f / CSCALE); *(f32x4*)(orow + 8) = h1 + (f32x4){s[4], s[5], s[6], s[7]} * (1.f / CSCALE); } \
            __builtin_amdgcn_sched_barrier(0); }
        if (nb > 0) {
            u32x4 vA0[8], vB0[8], vA1[8], vB1[8];
            u32x4 eL0, eH0, cw0, eL1, eH1, cw1;
            P6C_DMA(0)
            if (nb > 1) P6C_DMA(1)
            asm volatile("s_waitcnt vmcnt(0)" ::: "memory");
            P6C_TAB(eL0, eH0, cw0, 0)
            P6C_LOAD(vA0, eL0)
            P6C_LOAD(vB0, eH0)
            P6C_TAB(eL1, eH1, cw1, 1)
            P6C_LOAD(vA1, eL1)
#pragma unroll 1
            for (int i = 0; i < ntok; i += 2) {
                if ((i & 7) == 0 && i > 0 && (i >> 3) + 1 < nb) P6C_DMA((i >> 3) + 1)
                if ((i & 7) == 4) asm volatile("s_waitcnt vmcnt(40)" ::: "memory");
                P6C_BODY(i, vA0, vB0, eL0, eH0, cw0, vB1, eH1)
                P6C_BODY(i + 1, vA1, vB1, eL1, eH1, cw1, vB0, eH0)
            }
            asm volatile("s_waitcnt vmcnt(0) lgkmcnt(0)" ::: "memory");
        }
#undef P6C_BODY
#undef P6C_USE
#undef P6C_LOAD
#undef P6C_EID
#undef P6C_TAB
#undef P6C_DMA
#undef P6C_TOK
    }
}

extern "C" void kernel_launch(void* const* d_in, const int* in_sizes, int n_in, void* d_out, int out_size,
                              void* d_ws, size_t ws_size, hipStream_t stream) {
    static int grid_blocks = 0;
    if (!grid_blocks) {
        int dev = 0, cus = 0, per_cu = 0;
        (void)hipGetDevice(&dev);
        (void)hipDeviceGetAttribute(&cus, hipDeviceAttributeMultiprocessorCount, dev);
        (void)hipFuncSetAttribute((const void*)mega, hipFuncAttributeMaxDynamicSharedMemorySize, LDS_BYTES);
        (void)hipOccupancyMaxActiveBlocksPerMultiprocessor(&per_cu, (const void*)mega, NT, LDS_BYTES);
        if (per_cu < 1) per_cu = 1;
        if (per_cu > 1) per_cu = 1;
        grid_blocks = cus * per_cu;
        if (ws_size < 256 * MiB) fprintf(stderr, "kernel_launch: workspace too small: %zu\n", ws_size);
    }
    Params p{};
    for (int i = 0; i < 31; ++i) p.in[i] = (const float*)d_in[i];
    p.out = (float*)d_out;
    p.ws = (unsigned char*)d_ws;
    void* args[] = {&p};
    (void)hipMemsetAsync((unsigned char*)d_ws + WS_CNT, 0, 65536, stream);
    hipError_t e = hipLaunchCooperativeKernel((const void*)mega, dim3(grid_blocks), dim3(NT), args, LDS_BYTES, stream);
    if (e != hipSuccess) fprintf(stderr, "cooperative launch failed: %s (grid %d)\n", hipGetErrorString(e), grid_blocks);
}
```
